# Optimizing an MI355X kernel written in HIP

```python
import jax, jax.numpy as jnp
from jax import lax
import numpy as np

D_MODEL = 1024
BATCH = 8
SEQ = 2048
DEPTH = 2

CHUNK = 64
N_PREV_CHUNKS = 8
BAND = (N_PREV_CHUNKS + 1) * CHUNK
A_HEADS = 8
A_HEAD_DIM = 64
A_WIDTH = A_HEADS * A_HEAD_DIM
REL_CLIP = 128
B_HEADS = 4
B_KEY_DIM = 64
B_VAL_DIM = 128
B_K_WIDTH = B_HEADS * B_KEY_DIM
B_V_WIDTH = B_HEADS * B_VAL_DIM
GATE_RANK = 16
GATE_TEMP = 16.0
D_FF = 2816
N_EXPERTS = 8
TOP_K = 2
D_FF_EXPERT = 3584
PLE_DIM = 256
NORM_EPS = 1e-6
N_DENSE = (DEPTH + 1) // 2
N_MOE = DEPTH // 2
IN_SPLITS = (A_WIDTH, A_WIDTH, A_WIDTH, B_K_WIDTH, B_K_WIDTH, B_V_WIDTH, GATE_RANK, B_V_WIDTH, D_MODEL, D_MODEL)
IN_WIDTH = 3 * A_WIDTH + 2 * B_K_WIDTH + 2 * B_V_WIDTH + GATE_RANK + 2 * D_MODEL

kernel_name = "hybrid_chunk_attn_gla_moe_block"


def rmsnorm(x, g):
    xf = x.astype(jnp.float32)
    y = xf * lax.rsqrt(jnp.mean(xf * xf, axis=-1, keepdims=True) + NORM_EPS)
    return (y * g.astype(jnp.float32)).astype(x.dtype)


def chunk_band_attention(q, k, v, rel_bias):
    b, s, h, d = q.shape
    nc = s // CHUNK
    qc = q.reshape(b, nc, CHUNK, h, d) * (d ** -0.5)

    def band(t):
        tc = t.reshape(b, nc, CHUNK, h, d)
        tp = jnp.pad(tc, ((0, 0), (N_PREV_CHUNKS, 0), (0, 0), (0, 0), (0, 0)))
        return jnp.concatenate([tp[:, j:j + nc] for j in range(N_PREV_CHUNKS + 1)], axis=2)

    kb, vb = band(k), band(v)
    scores = jnp.einsum('bnqhd,bnkhd->bnhqk', qc, kb).astype(jnp.float32)
    dist = np.arange(CHUNK)[:, None] + N_PREV_CHUNKS * CHUNK - np.arange(BAND)[None, :]
    rel_idx = np.clip(dist, -REL_CLIP, REL_CLIP) + REL_CLIP
    bias = rel_bias.astype(jnp.float32)[:, rel_idx]
    key_chunk = np.arange(nc)[:, None] - N_PREV_CHUNKS + np.arange(BAND)[None, :] // CHUNK
    valid = key_chunk >= 0
    scores = jnp.where(valid[None, :, None, None, :], scores + bias[None, None], -1e30)
    probs = jax.nn.softmax(scores, axis=-1).astype(v.dtype)
    out = jnp.einsum('bnhqk,bnkhd->bnqhd', probs, vb)
    return out.reshape(b, s, h * d)


def gla_chunk_state(q, k, v, log_a):
    b, s, h, dk = q.shape
    dv = v.shape[-1]
    nc = s // CHUNK
    f32 = jnp.float32
    la = log_a.reshape(b, nc, CHUNK, h, dk)
    cum = jnp.cumsum(la, axis=2)
    tot = cum[:, :, -1]
    kdec = k.reshape(b, nc, CHUNK, h, dk).astype(f32) * jnp.exp(tot[:, :, None] - cum)
    d_state = jnp.einsum('bnlhk,bnlhv->nbhkv', kdec, v.reshape(b, nc, CHUNK, h, dv).astype(f32))
    decay = jnp.exp(tot).transpose(1, 0, 2, 3)

    def step(state, inp):
        dec, ds = inp
        state = dec[..., None] * state + ds
        return state, state

    _, states = lax.scan(step, jnp.zeros((b, h, dk, dv), f32), (decay, d_state))
    out = jnp.einsum('bnlhk,nbhkv->bnlhv', q.reshape(b, nc, CHUNK, h, dk).astype(f32), states)
    return out.reshape(b, s, h, dv)


def token_mixer(h, w_in, rel_bias, w_gla_gate_up, b_gla_gate, gla_norm, w_branch_a, w_branch_b, w_out):
    b, s, _ = h.shape
    proj = h @ w_in
    offsets = [int(o) for o in np.cumsum(IN_SPLITS)[:-1]]
    qa, ka, va, qb, kb, vb, g_down, r, ga, gb = jnp.split(proj, offsets, axis=-1)
    ya = chunk_band_attention(qa.reshape(b, s, A_HEADS, A_HEAD_DIM),
                              ka.reshape(b, s, A_HEADS, A_HEAD_DIM),
                              va.reshape(b, s, A_HEADS, A_HEAD_DIM), rel_bias)
    log_a = jax.nn.log_sigmoid((g_down @ w_gla_gate_up + b_gla_gate).astype(jnp.float32)) / GATE_TEMP
    ob = gla_chunk_state(qb.reshape(b, s, B_HEADS, B_KEY_DIM) * (B_KEY_DIM ** -0.5),
                         kb.reshape(b, s, B_HEADS, B_KEY_DIM),
                         vb.reshape(b, s, B_HEADS, B_VAL_DIM),
                         log_a.reshape(b, s, B_HEADS, B_KEY_DIM))
    ob = rmsnorm(ob, gla_norm.reshape(B_HEADS, B_VAL_DIM)).reshape(b, s, B_V_WIDTH).astype(h.dtype)
    yb = ob * jax.nn.silu(r)
    merged = jax.nn.sigmoid(ga) * (ya @ w_branch_a) + jax.nn.sigmoid(gb) * (yb @ w_branch_b)
    return merged @ w_out


def swiglu(h, w_gate, w_up, w_down):
    return (jax.nn.silu(h @ w_gate) * (h @ w_up)) @ w_down


def moe_swiglu(h, router_w, w_gate, w_up, w_down):
    logits = (h @ router_w).astype(jnp.float32)
    top_vals, top_idx = lax.top_k(logits, TOP_K)
    top_w = jax.nn.softmax(top_vals, axis=-1)
    combine = jnp.sum(jax.nn.one_hot(top_idx, N_EXPERTS, dtype=jnp.float32) * top_w[..., None], axis=-2)
    combine = combine.astype(h.dtype)
    out = jnp.zeros_like(h)
    for e in range(N_EXPERTS):
        out = out + combine[..., e:e + 1] * swiglu(h, w_gate[e], w_up[e], w_down[e])
    return out


def setup_inputs(seed: int = 0) -> dict:
    key = jax.random.key(seed)
    ks = jax.random.split(key, 32)
    f32 = jnp.float32

    def nrm(k, shape, fan_in):
        return jax.random.normal(k, shape, f32) * (fan_in ** -0.5)

    def gain(k, shape):
        return 1.0 + 0.05 * jax.random.normal(k, shape, f32)

    return {
        "x": jax.random.normal(ks[0], (BATCH, SEQ, D_MODEL), f32),
        "p": jax.random.normal(ks[1], (DEPTH, BATCH, SEQ, PLE_DIM), f32),
        "w_in": nrm(ks[2], (DEPTH, D_MODEL, IN_WIDTH), D_MODEL),
        "rel_bias": 0.1 * jax.random.normal(ks[3], (DEPTH, A_HEADS, 2 * REL_CLIP + 1), f32),
        "w_gla_gate_up": nrm(ks[4], (DEPTH, GATE_RANK, B_K_WIDTH), GATE_RANK),
        "b_gla_gate": 0.1 * jax.random.normal(ks[5], (DEPTH, B_K_WIDTH), f32),
        "gla_norm": gain(ks[6], (DEPTH, B_V_WIDTH)),
        "w_branch_a": nrm(ks[7], (DEPTH, A_WIDTH, D_MODEL), A_WIDTH),
        "w_branch_b": nrm(ks[8], (DEPTH, B_V_WIDTH, D_MODEL), B_V_WIDTH),
        "w_out": nrm(ks[9], (DEPTH, D_MODEL, D_MODEL), D_MODEL),
        "norm_mix_pre": gain(ks[10], (DEPTH, D_MODEL)),
        "norm_mix_post": gain(ks[11], (DEPTH, D_MODEL)),
        "norm_ffn_pre": gain(ks[12], (DEPTH, D_MODEL)),
        "norm_ffn_post": gain(ks[13], (DEPTH, D_MODEL)),
        "ffn_w_gate": nrm(ks[14], (N_DENSE, D_MODEL, D_FF), D_MODEL),
        "ffn_w_up": nrm(ks[15], (N_DENSE, D_MODEL, D_FF), D_MODEL),
        "ffn_w_down": nrm(ks[16], (N_DENSE, D_FF, D_MODEL), D_FF),
        "router_w": nrm(ks[17], (N_MOE, D_MODEL, N_EXPERTS), D_MODEL),
        "moe_w_gate": nrm(ks[18], (N_MOE, N_EXPERTS, D_MODEL, D_FF_EXPERT), D_MODEL),
        "moe_w_up": nrm(ks[19], (N_MOE, N_EXPERTS, D_MODEL, D_FF_EXPERT), D_MODEL),
        "moe_w_down": nrm(ks[20], (N_MOE, N_EXPERTS, D_FF_EXPERT, D_MODEL), D_FF_EXPERT),
        "ple_w_proj": nrm(ks[21], (DEPTH, PLE_DIM, D_MODEL), PLE_DIM),
        "ple_w_gate": nrm(ks[22], (DEPTH, D_MODEL, D_MODEL), D_MODEL),
        "ple_norm": gain(ks[23], (DEPTH, D_MODEL)),
    }


def reference(x, p, w_in, rel_bias, w_gla_gate_up, b_gla_gate, gla_norm, w_branch_a, w_branch_b, w_out,
              norm_mix_pre, norm_mix_post, norm_ffn_pre, norm_ffn_post,
              ffn_w_gate, ffn_w_up, ffn_w_down, router_w, moe_w_gate, moe_w_up, moe_w_down,
              ple_w_proj, ple_w_gate, ple_norm):
    for i in range(DEPTH):
        h = rmsnorm(x, norm_mix_pre[i])
        y = token_mixer(h, w_in[i], rel_bias[i], w_gla_gate_up[i], b_gla_gate[i], gla_norm[i],
                        w_branch_a[i], w_branch_b[i], w_out[i])
        x = x + rmsnorm(y, norm_mix_post[i])
        h = rmsnorm(x, norm_ffn_pre[i])
        j = i // 2
        if i % 2 == 0:
            y = swiglu(h, ffn_w_gate[j], ffn_w_up[j], ffn_w_down[j])
        else:
            y = moe_swiglu(h, router_w[j], moe_w_gate[j], moe_w_up[j], moe_w_down[j])
        x = x + rmsnorm(y, norm_ffn_post[i])
        e = (p[i] @ ple_w_proj[i]) * jax.nn.sigmoid(x @ ple_w_gate[i])
        x = x + rmsnorm(e, ple_norm[i])
    return x
```

```cpp
#include <hip/hip_runtime.h>
#include <cstdio>
#include <cstdint>

#define LAS __attribute__((address_space(3)))
#define GAS __attribute__((address_space(1)))
typedef unsigned short bf16_t;
typedef short bf16x8 __attribute__((ext_vector_type(8)));
typedef short s16x4 __attribute__((ext_vector_type(4)));
typedef float f32x4 __attribute__((ext_vector_type(4)));
typedef float f32x2 __attribute__((ext_vector_type(2)));
typedef unsigned u32x4 __attribute__((ext_vector_type(4)));
typedef unsigned u32x2 __attribute__((ext_vector_type(2)));

typedef __bf16 bf16x2_t __attribute__((ext_vector_type(2)));
__device__ __forceinline__ unsigned cvt_pk_bf16(float lo, float hi) { f32x2 v = {lo, hi}; const bf16x2_t b = __builtin_convertvector(v, bf16x2_t); return __builtin_bit_cast(unsigned, b); }
__device__ __forceinline__ float bf_lo(unsigned w) { return __uint_as_float(w << 16); }
__device__ __forceinline__ float bf_hi(unsigned w) { return __uint_as_float(w & 0xffff0000u); }
__device__ __forceinline__ float bf2f(bf16_t b) { return __uint_as_float(((unsigned)b) << 16); }
__device__ __forceinline__ float fast_sigmoid(float v) { return __builtin_amdgcn_rcpf(1.0f + __builtin_amdgcn_exp2f(-1.4426950408889634f * v)); }
__device__ __forceinline__ float wave_sum(float v) {
#pragma unroll
    for (int o = 1; o < 64; o <<= 1) v += __shfl_xor(v, o);
    return v;
}

namespace pg8 {
constexpr int BM = 256, BK = 64, HALF = 128, HTB = HALF * BK * 2, STAGE_BYTES = 8 * HTB, NXCD = 8, WGM = 8;
__host__ __device__ __forceinline__ int lds_byte(int r, int c) { const int st = (r >> 4) * 2 + (c >> 5), rr = r & 15, cc = c & 31, ob = rr * 64 + cc * 2; return st * 1024 + (ob ^ (((ob >> 9) & 1) << 5)); }
__host__ __device__ __forceinline__ void stage_rc(int b, int& R, int& C) { const int st = b / 1024, sb = b % 1024, swz = sb ^ (((sb >> 9) & 1) << 5); R = (st >> 1) * 16 + swz / 64; C = (st & 1) * 32 + (swz % 64) / 2; }
__host__ __device__ __forceinline__ int perm32(int rho) { const int n = rho >> 4, i = rho & 15; return 8 * (i >> 2) + 4 * n + (i & 3); }

struct Unit { int pm, pn, e, lr0, cnt; };
struct Gemm { const bf16_t* A; const bf16_t* Bt; int K; size_t b_estride; const int* gidx; };

struct StaticOrder {
    int nM, nN, nwg, G, c;
    __device__ void init(int M, int N, int G_, int c_) { nM = M / BM; nN = N / BM; nwg = nM * nN; G = G_; c = c_; }
    __device__ __forceinline__ bool next(int i, Unit& u) const {
        const long L = (long)i * G + c; if (L >= nwg) return false;
        int wgid = (int)L; { const int q = nwg / NXCD, r = nwg % NXCD, xcd = wgid % NXCD, off = wgid / NXCD; wgid = (xcd < r ? xcd * (q + 1) : r * (q + 1) + (xcd - r) * q) + off; }
        const int nig = WGM * nN, gid = wgid / nig, fm = gid * WGM, gsz = (nM - fm) < WGM ? (nM - fm) : WGM;
        u.pm = fm + ((wgid % nig) % gsz); u.pn = (wgid % nig) / gsz; u.e = 0; u.lr0 = 0; u.cnt = 0; return true;
    }
};
struct GroupedOrder {
    int pb[9]; int cnt[8]; int nN, G, c, nwg;
    __device__ void init(const unsigned* counts, int N, int G_, int c_) {
        int acc = 0;
#pragma unroll
        for (int e = 0; e < 8; ++e) { const int n = (int)counts[e]; cnt[e] = n; pb[e] = acc; acc += (n + 255) >> 8; }
        pb[8] = acc; nN = N / BM; G = G_; c = c_; nwg = acc * nN;
    }
    __device__ __forceinline__ bool next(int i, Unit& u) const {
        const long L = (long)i * G + c; if (L >= nwg) return false;
        const int nig = WGM * nN, gid = (int)L / nig, fm = gid * WGM, gsz = (pb[8] - fm) < WGM ? (pb[8] - fm) : WGM;
        const int pm = fm + (((int)L % nig) % gsz), pn = ((int)L % nig) / gsz;
        int e = 0;
#pragma unroll
        for (int k = 1; k < 8; ++k) e += (pm >= pb[k]) ? 1 : 0;
        int pbe = 0, ce = 0;
#pragma unroll
        for (int k = 0; k < 8; ++k) { pbe = (k == e) ? pb[k] : pbe; ce = (k == e) ? cnt[k] : ce; }
        u.pm = pm; u.pn = pn; u.e = e; u.lr0 = (pm - pbe) * 256; u.cnt = ce; return true;
    }
};

template <class Epi, class Sched, bool GATHER>
__device__ __forceinline__ void gemm_phase(LAS unsigned char* lds, const Gemm g, const Sched& S, const Epi& E) {
    int tid = threadIdx.x; asm volatile("" : "+v"(tid));
    const int wid = __builtin_amdgcn_readfirstlane(tid >> 6), lane = tid & 63, wr = wid >> 2, wc = wid & 3, fr = lane & 15, fq = lane >> 4;
    const int K = g.K, nt = K / BK;
    unsigned voffA[2], voffB[2]; int rA[2];
#pragma unroll
    for (int i = 0; i < 2; ++i) { int R, C; stage_rc(tid * 16 + i * 8192, R, C); const int Rb = Epi::PERM ? ((R & ~31) + perm32(R & 31)) : R;
        voffA[i] = GATHER ? (unsigned)(C * 2) : (unsigned)(R * K + C) * 2u; voffB[i] = (unsigned)(Rb * K + C) * 2u; rA[i] = R; }
    const size_t kstep = (size_t)(BK * 2);
    const size_t hstep = (size_t)HALF * K * 2;
    const size_t tstep = 2 * hstep;
    const unsigned ldsw = (unsigned)wid * 1024u;
    const int aoff = lds_byte(wr * 64 + fr, fq * 8), boff = lds_byte(wc * 32 + fr, fq * 8);
#define PG8_SA(b, h) (((b) * 2 + (h)) * HTB)
#define PG8_SB(b, h) ((4 + (b) * 2 + (h)) * HTB)
#define PG8_STAGE2(bufoff, gbase, v0, v1) do { unsigned _a = (v0), _b = (v1); asm volatile("" : "+v"(_a), "+v"(_b));     \
        __builtin_amdgcn_global_load_lds((const unsigned*)((const char*)(gbase) + _a), (LAS unsigned*)(lds + (bufoff) + ldsw), 16, 0, 0); \
        __builtin_amdgcn_global_load_lds((const unsigned*)((const char*)(gbase) + _b), (LAS unsigned*)(lds + (bufoff) + ldsw + 8192), 16, 0, 0); } while (0)
#define PG8_STAGE(bufoff, gbase, voff) PG8_STAGE2(bufoff, gbase, (voff)[0], (voff)[1])
#define PG8_STAGE_A(bufoff, nx, h, kt) do { \
        if constexpr (GATHER) { const char* _p = (const char*)g.A + (size_t)(kt) * kstep; \
            if (nx) { PG8_STAGE2(bufoff, _p, nG[h][0], nG[h][1]); } else { PG8_STAGE2(bufoff, _p, cG[h][0], cG[h][1]); } } \
        else { const char* _p = ((nx) ? nA : cA) + (size_t)(h) * hstep + (size_t)(kt) * kstep; PG8_STAGE2(bufoff, _p, voffA[0], voffA[1]); } } while (0)
#define PG8_LDA(dst, b, h) do { _Pragma("unroll") for (int m = 0; m < 4; ++m) _Pragma("unroll") for (int k = 0; k < 2; ++k) dst[m][k] = *(const LAS bf16x8*)(lds + PG8_SA(b, h) + aoff + m * 2048 + k * 1024); } while (0)
#define PG8_LDB(dst, b, h) do { _Pragma("unroll") for (int n = 0; n < 2; ++n) _Pragma("unroll") for (int k = 0; k < 2; ++k) dst[n][k] = *(const LAS bf16x8*)(lds + PG8_SB(b, h) + boff + n * 2048 + k * 1024); } while (0)
#define PG8_MMA(ai, bj, At, Bt) do { __builtin_amdgcn_s_setprio(1); _Pragma("unroll") for (int m = 0; m < 4; ++m) _Pragma("unroll") for (int n = 0; n < 2; ++n) _Pragma("unroll") for (int k = 0; k < 2; ++k) \
        acc[ai][bj][m][n] = __builtin_amdgcn_mfma_f32_16x16x32_bf16(Bt[n][k], At[m][k], acc[ai][bj][m][n], 0, 0, 0); __builtin_amdgcn_s_setprio(0); } while (0)
#define PG8_WAIT_V(n) asm volatile("s_waitcnt vmcnt(" #n ")" ::: "memory")
#define PG8_WAIT_L(n) asm volatile("s_waitcnt lgkmcnt(" #n ")" ::: "memory")
#define PG8_BAR __builtin_amdgcn_s_barrier()
#define PG8_SCHED __builtin_amdgcn_sched_barrier(0)
#define PG8_GIDX(dst, u) do { _Pragma("unroll") for (int h = 0; h < 2; ++h) _Pragma("unroll") for (int i = 0; i < 2; ++i) { \
        const int _lr = (u).lr0 + h * HALF + rA[i]; const int _tok = (_lr < (u).cnt) ? g.gidx[(u).e * 16384 + _lr] : 0; dst[h][i] = (unsigned)_tok * (unsigned)(K * 2) + voffA[i]; } } while (0)
    Unit cur, nxt; int ui = 0;
    if (!S.next(0, cur)) return;
    f32x4 acc[2][2][4][2];
#pragma unroll
    for (int a = 0; a < 2; ++a)
#pragma unroll
        for (int b = 0; b < 2; ++b)
#pragma unroll
            for (int m = 0; m < 4; ++m)
#pragma unroll
                for (int n = 0; n < 2; ++n) acc[a][b][m][n] = (f32x4){0.f, 0.f, 0.f, 0.f};
    bf16x8 At[4][2], B0[2][2], B1[2][2];
    unsigned cG[2][2] = {{0u, 0u}, {0u, 0u}}, nG[2][2] = {{0u, 0u}, {0u, 0u}};
    const char* cA = (const char*)g.A + (size_t)cur.pm * tstep; const char* cB = (const char*)g.Bt + ((size_t)cur.e * g.b_estride) * 2 + (size_t)cur.pn * tstep;
    const char* nA = cA;
    if constexpr (GATHER) { PG8_GIDX(cG, cur); }
    PG8_STAGE(PG8_SB(0, 0), cB, voffB); PG8_STAGE(PG8_SB(0, 1), cB + hstep, voffB); PG8_STAGE_A(PG8_SA(0, 0), false, 0, 0); PG8_STAGE_A(PG8_SA(0, 1), false, 1, 0);
    if (wr == 1) PG8_BAR;
    PG8_WAIT_V(2); PG8_BAR;
    PG8_STAGE(PG8_SB(1, 0), cB + kstep, voffB); PG8_STAGE_A(PG8_SA(1, 0), false, 0, 1); PG8_STAGE(PG8_SB(1, 1), cB + hstep + kstep, voffB);
    PG8_WAIT_V(6); PG8_BAR;
    for (;;) {
        const bool has_next = S.next(ui + 1, nxt);
        nA = has_next ? (const char*)g.A + (size_t)nxt.pm * tstep : cA;
        const char* nB = has_next ? (const char*)g.Bt + ((size_t)nxt.e * g.b_estride) * 2 + (size_t)nxt.pn * tstep : cB;
        if constexpr (GATHER) { if (has_next) { PG8_GIDX(nG, nxt); } else {
#pragma unroll
            for (int h = 0; h < 2; ++h)
#pragma unroll
                for (int i = 0; i < 2; ++i) nG[h][i] = cG[h][i]; } }
        for (int t = 0; t < nt; t += 2) {
            const bool last = (t == nt - 2);
            const int kt2 = last ? 0 : t + 2, kt3 = kt2 + 1;
            const char* b2 = last ? nB : cB + (size_t)(t + 2) * kstep;
            const char* b3 = b2 + kstep;
            PG8_LDB(B0, 0, 0); PG8_LDB(B1, 0, 1); PG8_SCHED; PG8_LDA(At, 0, 0); PG8_STAGE_A(PG8_SA(1, 1), false, 1, t + 1);
            PG8_WAIT_V(8); PG8_WAIT_L(0); PG8_BAR; PG8_MMA(0, 0, At, B0); PG8_MMA(0, 1, At, B1); PG8_BAR; PG8_SCHED;
            PG8_LDA(At, 0, 1); PG8_STAGE(PG8_SB(0, 0), b2, voffB); PG8_STAGE(PG8_SB(0, 1), b2 + hstep, voffB); PG8_STAGE_A(PG8_SA(0, 0), last, 0, kt2);
            PG8_WAIT_V(8); PG8_WAIT_L(0); PG8_BAR; PG8_MMA(1, 0, At, B0); PG8_MMA(1, 1, At, B1); PG8_BAR; PG8_SCHED;
            PG8_LDB(B0, 1, 0); PG8_LDB(B1, 1, 1); PG8_SCHED; PG8_LDA(At, 1, 0); PG8_STAGE_A(PG8_SA(0, 1), last, 1, kt2);
            PG8_WAIT_V(8); PG8_WAIT_L(0); PG8_BAR; PG8_MMA(0, 0, At, B0); PG8_MMA(0, 1, At, B1); PG8_BAR; PG8_SCHED;
            PG8_LDA(At, 1, 1); PG8_STAGE(PG8_SB(1, 0), b3, voffB); PG8_STAGE(PG8_SB(1, 1), b3 + hstep, voffB); PG8_STAGE_A(PG8_SA(1, 0), last, 0, kt3);
            PG8_WAIT_V(8); PG8_WAIT_L(0); PG8_BAR; PG8_MMA(1, 0, At, B0); PG8_MMA(1, 1, At, B1); PG8_BAR; PG8_SCHED;
        }
        if (wr == 0) PG8_BAR;
        { Unit eu = cur; asm volatile("" : "+s"(eu.pm), "+s"(eu.pn));
          E(acc, eu, wr, wc, fr, fq); }
        if (!has_next) break;
#pragma unroll
        for (int a = 0; a < 2; ++a)
#pragma unroll
            for (int b = 0; b < 2; ++b)
#pragma unroll
                for (int m = 0; m < 4; ++m)
#pragma unroll
                    for (int n = 0; n < 2; ++n) acc[a][b][m][n] = (f32x4){0.f, 0.f, 0.f, 0.f};
        cur = nxt; cA = nA; cB = nB; ++ui;
        if constexpr (GATHER) {
#pragma unroll
            for (int h = 0; h < 2; ++h)
#pragma unroll
                for (int i = 0; i < 2; ++i) cG[h][i] = nG[h][i]; }
        if (wr == 1) PG8_BAR;
    }
    PG8_WAIT_V(0);
    PG8_BAR;
#undef PG8_SA
#undef PG8_SB
#undef PG8_STAGE
#undef PG8_STAGE2
#undef PG8_STAGE_A
#undef PG8_LDA
#undef PG8_LDB
#undef PG8_MMA
#undef PG8_WAIT_V
#undef PG8_WAIT_L
#undef PG8_BAR
#undef PG8_SCHED
#undef PG8_GIDX
}
}
namespace pg8 {
constexpr float QA_SCALE = 0.125f * 1.4426950408889634f;
constexpr float QB_SCALE = 0.125f;

struct EpiInProj {
    static constexpr bool PERM = true;
    bf16_t* base;
    __device__ __forceinline__ void operator()(const f32x4 (&acc)[2][2][4][2], const Unit& u, int wr, int wc, int fr, int fq) const {
        const int pn = u.pn;
        size_t toff; int ld, ct; float sc = 1.f; int act = 0;
        constexpr size_t Mi = 1u << 20;
        if (pn < 2)       { toff = 16 * Mi; ld = 512; ct = pn; sc = QA_SCALE; }
        else if (pn < 4)  { toff = 24 * Mi; ld = 512; ct = pn - 2; }
        else if (pn < 6)  { toff = 32 * Mi; ld = 512; ct = pn - 4; }
        else if (pn < 7)  { toff = 0; ld = 256; ct = 0; sc = QB_SCALE; }
        else if (pn < 8)  { toff = 4 * Mi; ld = 256; ct = 0; }
        else if (pn < 10) { toff = 8 * Mi; ld = 512; ct = pn - 8; }
        else if (pn < 12) { toff = 40 * Mi; ld = 512; ct = pn - 10; act = 1; }
        else if (pn < 16) { toff = 48 * Mi; ld = 1024; ct = pn - 12; act = 2; }
        else              { toff = 64 * Mi; ld = 1024; ct = pn - 16; act = 2; }
        const int row0 = u.pm * BM + wr * 64 + fr, col0 = ct * BM + wc * 32 + 8 * fq;
        bf16_t* O = base + toff;
#pragma unroll
        for (int ai = 0; ai < 2; ++ai)
#pragma unroll
            for (int m = 0; m < 4; ++m) { bf16_t* rowp = O + (size_t)(row0 + ai * HALF + m * 16) * ld + col0;
#pragma unroll
                for (int bj = 0; bj < 2; ++bj) { f32x4 v0 = acc[ai][bj][m][0] * sc, v1 = acc[ai][bj][m][1] * sc;
                    if (act) {
#pragma unroll
                        for (int j = 0; j < 4; ++j) { const float s0 = fast_sigmoid(v0[j]), s1 = fast_sigmoid(v1[j]); v0[j] = (act == 1) ? v0[j] * s0 : s0; v1[j] = (act == 1) ? v1[j] * s1 : s1; } }
                    u32x4 w; w.x = cvt_pk_bf16(v0[0], v0[1]); w.y = cvt_pk_bf16(v0[2], v0[3]); w.z = cvt_pk_bf16(v1[0], v1[1]); w.w = cvt_pk_bf16(v1[2], v1[3]);
                    *(u32x4*)(rowp + bj * HALF) = w; } }
    }
};

template <int MODE> struct EpiEw {
    static constexpr bool PERM = true;
    bf16_t* O; const bf16_t* G; int ldc;
    __device__ __forceinline__ void operator()(const f32x4 (&acc)[2][2][4][2], const Unit& u, int wr, int wc, int fr, int fq) const {
        const int row0 = u.pm * BM + wr * 64 + fr, col0 = u.pn * BM + wc * 32 + 8 * fq;
#pragma unroll
        for (int ai = 0; ai < 2; ++ai)
#pragma unroll
            for (int m = 0; m < 4; ++m) { const size_t ro = (size_t)(row0 + ai * HALF + m * 16) * ldc + col0;
#pragma unroll
                for (int bj = 0; bj < 2; ++bj) { f32x4 v0 = acc[ai][bj][m][0], v1 = acc[ai][bj][m][1];
                    if (MODE == 1 || MODE == 2) { const u32x4 gw = *(const u32x4*)(G + ro + bj * HALF);
                        v0[0] *= bf_lo(gw.x); v0[1] *= bf_hi(gw.x); v0[2] *= bf_lo(gw.y); v0[3] *= bf_hi(gw.y); v1[0] *= bf_lo(gw.z); v1[1] *= bf_hi(gw.z); v1[2] *= bf_lo(gw.w); v1[3] *= bf_hi(gw.w); }
                    if (MODE == 3) {
#pragma unroll
                        for (int j = 0; j < 4; ++j) { v0[j] = fast_sigmoid(v0[j]); v1[j] = fast_sigmoid(v1[j]); } }
                    if (MODE == 2 || MODE == 4) { const u32x4 ow = *(const u32x4*)(O + ro + bj * HALF);
                        if (MODE == 2) { v0[0] += bf_lo(ow.x); v0[1] += bf_hi(ow.x); v0[2] += bf_lo(ow.y); v0[3] += bf_hi(ow.y); v1[0] += bf_lo(ow.z); v1[1] += bf_hi(ow.z); v1[2] += bf_lo(ow.w); v1[3] += bf_hi(ow.w); }
                        else { v0[0] *= bf_lo(ow.x); v0[1] *= bf_hi(ow.x); v0[2] *= bf_lo(ow.y); v0[3] *= bf_hi(ow.y); v1[0] *= bf_lo(ow.z); v1[1] *= bf_hi(ow.z); v1[2] *= bf_lo(ow.w); v1[3] *= bf_hi(ow.w); } }
                    u32x4 w; w.x = cvt_pk_bf16(v0[0], v0[1]); w.y = cvt_pk_bf16(v0[2], v0[3]); w.z = cvt_pk_bf16(v1[0], v1[1]); w.w = cvt_pk_bf16(v1[2], v1[3]);
                    *(u32x4*)(O + ro + bj * HALF) = w; } }
    }
};

struct EpiGateUp {
    static constexpr bool PERM = true;
    bf16_t* O; int ldc;
    __device__ __forceinline__ void operator()(const f32x4 (&acc)[2][2][4][2], const Unit& u, int wr, int wc, int fr, int fq) const {
        const int row0 = u.pm * BM + wr * 64 + fr, col0 = u.pn * HALF + wc * 32 + 8 * fq;
#pragma unroll
        for (int ai = 0; ai < 2; ++ai)
#pragma unroll
            for (int m = 0; m < 4; ++m) { bf16_t* rowp = O + (size_t)(row0 + ai * HALF + m * 16) * ldc + col0;
                f32x4 v0, v1;
#pragma unroll
                for (int j = 0; j < 4; ++j) { const float g0 = acc[ai][0][m][0][j], g1 = acc[ai][0][m][1][j];
                    v0[j] = g0 * fast_sigmoid(g0) * acc[ai][1][m][0][j]; v1[j] = g1 * fast_sigmoid(g1) * acc[ai][1][m][1][j]; }
                u32x4 w; w.x = cvt_pk_bf16(v0[0], v0[1]); w.y = cvt_pk_bf16(v0[2], v0[3]); w.z = cvt_pk_bf16(v1[0], v1[1]); w.w = cvt_pk_bf16(v1[2], v1[3]);
                *(u32x4*)rowp = w; }
    }
};
}
constexpr int D = 1024, NB = 8, SEQ = 2048, T = NB * SEQ, DEPTH = 2, CH = 64, NCH = SEQ / CH, NPREV = 8;
constexpr int AH = 8, BH = 4, GR = 16, DFF = 2816, NE = 8, DFE = 3584, PLE = 256, INW = 5136, INWG = 5120, RELN = 257;
constexpr float EPS = 1e-6f, LOG2E = 1.4426950408889634f;
constexpr int NWAVES = 8, NTHR = 512;
constexpr int MOE_ROWS = 34816;

constexpr size_t MiB = 1u << 20;
constexpr size_t WS_CTL = 0, CTL_ZERO_BYTES = 256 * 1024;
constexpr size_t WS_TOKINFO = 1 * MiB;
constexpr size_t WS_IDXE = 2 * MiB;
constexpr size_t WS_DEC = 3 * MiB;
constexpr size_t WS_W1 = 4 * MiB;
constexpr size_t WS_PB = 189 * MiB;
constexpr size_t WS_G = 205 * MiB;
constexpr size_t WS_HB = WS_G, WS_DST = WS_G + 32 * MiB, WS_YSLOT = WS_G;
constexpr size_t WS_BIG = 273 * MiB;
constexpr size_t WS_W0 = WS_BIG, WS_PROJ = WS_BIG + 34 * MiB, WS_MACT = WS_BIG;
constexpr size_t WS_Y = WS_PROJ;
constexpr size_t WS_QB = WS_PROJ, WS_KB = WS_PROJ + 8 * MiB, WS_VB = WS_PROJ + 16 * MiB, WS_QA = WS_PROJ + 32 * MiB, WS_KA = WS_PROJ + 48 * MiB, WS_VA = WS_PROJ + 64 * MiB;
constexpr size_t WS_SR = WS_PROJ + 80 * MiB, WS_SGA = WS_PROJ + 96 * MiB, WS_SGB = WS_PROJ + 128 * MiB;
constexpr size_t WS_MERGED = WS_KA;
constexpr size_t WS_ST = WS_KA;
constexpr size_t WS_FACT = WS_QA;
constexpr size_t WS_XB = WS_SGB;
constexpr size_t WS_END = 511 * MiB;
static_assert(WS_FACT + (size_t)T * DFF * 2 <= WS_XB && WS_MACT + (size_t)MOE_ROWS * DFE * 2 <= WS_END && WS_YSLOT + (size_t)MOE_ROWS * D * 2 <= WS_BIG && WS_SGB + 32 * MiB <= WS_END, "d_ws map");
constexpr size_t OFF_WIN = 0, OFF_WGD = 10 * MiB, OFF_WBA = 10 * MiB + 65536, OFF_WBB = OFF_WBA + 1 * MiB, OFF_WOUT = OFF_WBB + 1 * MiB, OFF_WPP = OFF_WOUT + 2 * MiB, OFF_WPG = OFF_WPP + MiB / 2;
constexpr size_t OFF_FFN = 17 * MiB;
constexpr size_t OFF_FDN = OFF_FFN + 11 * MiB, OFF_MDN = OFF_FFN + 8 * 14 * MiB;
static_assert(OFF_WPG + 2 * MiB <= OFF_FFN && WS_W1 + OFF_MDN + 8 * 7 * MiB <= WS_PB && OFF_FDN + (size_t)D * DFF * 2 <= 34 * MiB, "weight map");
constexpr int CW_BAR = 4096;
constexpr int CW_CNT = 8192;
constexpr int CW_DBG = 16384;

constexpr int RING_BYTES = 131072;
constexpr int LDSCTL_OFF = RING_BYTES, MISC_OFF = LDSCTL_OFF + 320;
constexpr int XTRA_OFF = RING_BYTES + 1024;
constexpr int LDS_BYTES = 147456;

typedef GAS unsigned gu32;
#define RLX_AGENT __ATOMIC_RELAXED, __HIP_MEMORY_SCOPE_AGENT
#define LDS_WAIT() asm volatile("s_waitcnt lgkmcnt(0)" ::: "memory")
#define VM_WAIT() asm volatile("s_waitcnt vmcnt(0)" ::: "memory")

#define XB_TMO      128
#define XB_XCNT(j)  (256  + 64 * (j))
#define XB_XSUB(j)  (1280 + 64 * (j))
#define XB_XGEN(j)  (2304 + 64 * (j))
#define XB_TOP      3328
#define XB_TOPGEN   3392
#define XCD_BAR_WORDS 3456
#define XB_SPIN_CAP (1u << 18)
__device__ __forceinline__ unsigned xb_ld(unsigned* p)              { return __hip_atomic_load(p, __ATOMIC_RELAXED, __HIP_MEMORY_SCOPE_AGENT); }
__device__ __forceinline__ unsigned xb_add(unsigned* p, unsigned v) { return __hip_atomic_fetch_add(p, v, __ATOMIC_RELAXED, __HIP_MEMORY_SCOPE_AGENT); }
__device__ __forceinline__ unsigned xb_xcc_id() { return (unsigned)__builtin_amdgcn_s_getreg((3 << 11) | 20) & 0xFu; }
#define XB_SPIN(cond, bar) do { unsigned _sp = 0; while (cond) { __builtin_amdgcn_s_sleep(1); \
    if ((++_sp & 255u) == 0u) { if (xb_ld(&(bar)[XB_TMO])) break; if (_sp > XB_SPIN_CAP) { atomicAdd(&(bar)[XB_TMO], 1u); break; } } } } while (0)
struct XcdBarrier { unsigned* bar; unsigned x; volatile LAS unsigned* st; };
__device__ __forceinline__ XcdBarrier xcd_barrier_post(unsigned* bar, volatile LAS unsigned* st) {
    XcdBarrier b; b.bar = bar; b.x = xb_xcc_id(); b.st = st;
    if (threadIdx.x == 0) (void)xb_add(&bar[XB_XCNT(b.x)], 1u);
    return b;
}
__device__ __forceinline__ void xcd_barrier_complete(unsigned* bar, unsigned x, unsigned& nloc, unsigned& nx) {
    const unsigned G = gridDim.x * gridDim.y * gridDim.z;
    unsigned sum, cnt, mine, sp = 0u;
    for (;;) {
        sum = 0u; cnt = 0u; mine = 0u;
#pragma unroll
        for (unsigned j = 0; j < 16; ++j) { const unsigned c = xb_ld(&bar[XB_XCNT(j)]); sum += c; cnt += (c > 0u) ? 1u : 0u; mine = (j == x) ? c : mine; }
        if (sum == G) break;
        __builtin_amdgcn_s_sleep(1);
        if ((++sp & 255u) == 0u) { if (xb_ld(&bar[XB_TMO])) break; if (sp > XB_SPIN_CAP) { atomicAdd(&bar[XB_TMO], 1u); break; } }
    }
    nloc = mine > 0u ? mine : 1u; nx = cnt > 0u ? cnt : 1u;
}
__device__ __forceinline__ void xcd_barrier(const XcdBarrier& b) {
    asm volatile("s_waitcnt vmcnt(0)" ::: "memory");
    __syncthreads();
    if (threadIdx.x == 0) {
        unsigned* bar = b.bar;
        __builtin_amdgcn_s_waitcnt(0);
        unsigned nloc = b.st[0], nx = b.st[1];
        if (nloc == 0u) { xcd_barrier_complete(bar, b.x, nloc, nx); b.st[0] = nloc; b.st[1] = nx; }
        const unsigned old = xb_add(&bar[XB_XSUB(b.x)], 1u);
        const unsigned gen = old / nloc;
        if (old + 1u == (gen + 1u) * nloc) {
            __builtin_amdgcn_fence(__ATOMIC_RELEASE, "agent");
            asm volatile("s_waitcnt vmcnt(0)" ::: "memory");
            const unsigned og = xb_add(&bar[XB_TOP], 1u);
            const unsigned tg = og / nx;
            if (og + 1u == (tg + 1u) * nx) xb_add(&bar[XB_TOPGEN], 1u);
            else XB_SPIN(xb_ld(&bar[XB_TOPGEN]) == tg, bar);
            __builtin_amdgcn_fence(__ATOMIC_ACQUIRE, "agent");
            xb_add(&bar[XB_XGEN(b.x)], 1u);
            asm volatile("s_waitcnt vmcnt(0)" ::: "memory");
        } else {
            XB_SPIN(xb_ld(&bar[XB_XGEN(b.x)]) == gen, bar);
            __builtin_amdgcn_fence(__ATOMIC_ACQUIRE, "agent");
            asm volatile("s_waitcnt vmcnt(0)" ::: "memory");
        }
    }
    __syncthreads();
}

struct Args { const float* in[24]; float* out; unsigned char* ws; int ph_lo, ph_hi, sub, pad; };
enum { I_X = 0, I_P, I_WIN, I_RELB, I_WGUP, I_BG, I_GNORM, I_WBA, I_WBB, I_WOUT, I_NMPRE, I_NMPOST, I_NFPRE, I_NFPOST, I_FG, I_FU, I_FD, I_RW, I_MG, I_MU, I_MD, I_PP, I_PG, I_PNORM };
#define FRESH(F) do { int _t = threadIdx.x; asm volatile("" : "+v"(_t)); (F).tid = _t; (F).lane = _t & 63; (F).wave = __builtin_amdgcn_readfirstlane(_t >> 6); } while (0)
struct Frame {
    LAS unsigned char* lds;
    volatile LAS unsigned* MISC;
    gu32* ctl;
    unsigned char* ws;
    int tid, lane, wave;
    int vcu, G;
    float* x;
};

__device__ __forceinline__ float sumsq16(const f32x4 (&v)[4]) {
    float s = 0.f;
#pragma unroll
    for (int j = 0; j < 4; ++j) s += (v[j].x * v[j].x + v[j].y * v[j].y) + (v[j].z * v[j].z + v[j].w * v[j].w);
    return wave_sum(s);
}
__device__ __forceinline__ void ld_bf16_row(const bf16_t* row, int lane, f32x4 (&v)[4]) {
#pragma unroll
    for (int j = 0; j < 4; ++j) { const u32x2 w = ((const u32x2*)row)[lane + 64 * j]; v[j] = (f32x4){bf_lo(w.x), bf_hi(w.x), bf_lo(w.y), bf_hi(w.y)}; }
}
__device__ __forceinline__ void st_bf16_row(bf16_t* row, int lane, const f32x4 (&v)[4]) {
#pragma unroll
    for (int j = 0; j < 4; ++j) { u32x2 w; w.x = cvt_pk_bf16(v[j].x, v[j].y); w.y = cvt_pk_bf16(v[j].z, v[j].w); ((u32x2*)row)[lane + 64 * j] = w; }
}
template <int SRC, int OUT, bool ROUTE>
__device__ __forceinline__ void thin_phase(Frame& F, const float* xin, const bf16_t* ysrc, const float* g_add, const float* g_out, bf16_t* obuf, const float* router_w) {
    FRESH(F);
    const int lane = F.lane;
    unsigned* tokinfo = (unsigned*)(F.ws + WS_TOKINFO);
    int* idxe = (int*)(F.ws + WS_IDXE);
    unsigned* gcnt = (unsigned*)(F.ctl + CW_CNT);
    LAS float* rwT = (LAS float*)(F.lds);
    LAS unsigned* lcnt = (LAS unsigned*)(F.lds + 32768);
    LAS unsigned* rinfo = (LAS unsigned*)(F.lds + 32768 + 64);
    if constexpr (ROUTE) {
        for (int i = F.tid; i < D * NE; i += NTHR) rwT[(i & 7) * D + (i >> 3)] = router_w[i];
        if (F.tid < 16) lcnt[F.tid] = 0u;
        __syncthreads();
    }
    int pbase[8];
    if constexpr (SRC == 2) { int acc = 0;
#pragma unroll
        for (int e = 0; e < 8; ++e) { pbase[e] = acc; acc += (((int)gcnt[e] + 255) >> 8) << 8; } }
    f32x4 ga[4], go[4];
#pragma unroll
    for (int j = 0; j < 4; ++j) { ga[j] = (SRC != 0) ? ((const f32x4*)g_add)[lane + 64 * j] : (f32x4){0.f, 0.f, 0.f, 0.f}; go[j] = (OUT == 1) ? ((const f32x4*)g_out)[lane + 64 * j] : (f32x4){0.f, 0.f, 0.f, 0.f}; }
    const int gw = F.vcu * NWAVES + F.wave, NGW = F.G * NWAVES;
    int rs = 0;
    for (int m = gw; m < T; m += NGW, ++rs) {
        f32x4 xv[4];
        if constexpr (SRC == 0) {
#pragma unroll
            for (int j = 0; j < 4; ++j) xv[j] = ((const f32x4*)(xin + (size_t)m * D))[lane + 64 * j];
        } else {
            f32x4 yv[4];
            if constexpr (SRC == 1) ld_bf16_row(ysrc + (size_t)m * D, lane, yv);
            else {
                const unsigned* ti = tokinfo + (size_t)m * 8;
                const int e1 = (int)ti[0], p1 = (int)ti[1], e2 = (int)ti[2], p2 = (int)ti[3]; const float w1 = __uint_as_float(ti[4]), w2 = __uint_as_float(ti[5]);
                int b1 = 0, b2 = 0;
#pragma unroll
                for (int e = 0; e < 8; ++e) { b1 = (e == e1) ? pbase[e] : b1; b2 = (e == e2) ? pbase[e] : b2; }
                f32x4 ya[4], yb[4];
                ld_bf16_row(ysrc + (size_t)(b1 + p1) * D, lane, ya); ld_bf16_row(ysrc + (size_t)(b2 + p2) * D, lane, yb);
#pragma unroll
                for (int j = 0; j < 4; ++j) yv[j] = ya[j] * w1 + yb[j] * w2;
            }
            const float rstd = __builtin_amdgcn_rsqf(sumsq16(yv) * (1.f / D) + EPS);
#pragma unroll
            for (int j = 0; j < 4; ++j) { const f32x4 xo = ((const f32x4*)(F.x + (size_t)m * D))[lane + 64 * j]; xv[j] = xo + yv[j] * rstd * ga[j]; }
        }
#pragma unroll
        for (int j = 0; j < 4; ++j) ((f32x4*)(F.x + (size_t)m * D))[lane + 64 * j] = xv[j];
        if constexpr (OUT == 1) {
            const float rstd = __builtin_amdgcn_rsqf(sumsq16(xv) * (1.f / D) + EPS);
            f32x4 hv[4];
#pragma unroll
            for (int j = 0; j < 4; ++j) hv[j] = xv[j] * rstd * go[j];
            st_bf16_row(obuf + (size_t)m * D, lane, hv);
            if constexpr (ROUTE) {
                float lg[8];
#pragma unroll
                for (int e = 0; e < 8; ++e) { float s = 0.f;
#pragma unroll
                    for (int j = 0; j < 4; ++j) { const f32x4 w = *(const LAS f32x4*)(rwT + e * D + 4 * lane + 256 * j); s += (hv[j].x * w.x + hv[j].y * w.y) + (hv[j].z * w.z + hv[j].w * w.w); }
                    lg[e] = wave_sum(s); }
                int e1 = 0; float v1 = lg[0];
#pragma unroll
                for (int e = 1; e < 8; ++e) if (lg[e] > v1) { v1 = lg[e]; e1 = e; }
                int e2 = -1; float v2 = -3.0e38f;
#pragma unroll
                for (int e = 0; e < 8; ++e) if (e != e1 && lg[e] > v2) { v2 = lg[e]; e2 = e; }
                const float ex = __expf(v2 - v1), w1 = 1.f / (1.f + ex), w2 = ex * w1;
                if (lane == 0) {
                    const unsigned p1 = atomicAdd((unsigned*)&lcnt[e1], 1u), p2 = atomicAdd((unsigned*)&lcnt[e2], 1u);
                    LAS unsigned* ri = rinfo + (F.wave * 8 + rs) * 6;
                    ri[0] = (unsigned)e1; ri[1] = p1; ri[2] = (unsigned)e2; ri[3] = p2; ri[4] = __float_as_uint(w1); ri[5] = __float_as_uint(w2);
                }
            }
        } else if constexpr (OUT == 2) {
            st_bf16_row(obuf + (size_t)m * D, lane, xv);
        }
    }
    if constexpr (ROUTE) {
        __syncthreads();
        if (F.tid < 8) lcnt[8 + F.tid] = __hip_atomic_fetch_add(gcnt + F.tid, lcnt[F.tid], RLX_AGENT);
        __syncthreads();
        if (lane < rs) {
            const int m = gw + lane * NGW; const LAS unsigned* ri = rinfo + (F.wave * 8 + lane) * 6;
            const unsigned e1 = ri[0], e2 = ri[2]; const unsigned p1 = ri[1] + lcnt[8 + e1], p2 = ri[3] + lcnt[8 + e2];
            unsigned* ti = tokinfo + (size_t)m * 8; ti[0] = e1; ti[1] = p1; ti[2] = e2; ti[3] = p2; ti[4] = ri[4]; ti[5] = ri[5];
            idxe[e1 * 16384 + p1] = m; idxe[e2 * 16384 + p2] = m;
        }
    }
}
struct TrItem { const float* src; int pitch; bf16_t* dst; int dstK; int ncols; };
__device__ __forceinline__ void tr_item(const TrItem& t, LAS float* scr, int lane) {
    const int c = lane & 31;
#pragma unroll 8
    for (int i = 0; i < 32; ++i) { const int kk = 2 * i + (lane >> 5); scr[kk * 33 + c] = (c < t.ncols) ? t.src[(size_t)kk * t.pitch + c] : 0.f; }
    LDS_WAIT(); asm volatile("" ::: "memory");
    const int c8 = lane & 7;
#pragma unroll
    for (int j = 0; j < 4; ++j) { const int n = (lane >> 3) + 8 * j; const LAS float* s = scr + (8 * c8) * 33 + n;
        u32x4 o; o.x = cvt_pk_bf16(s[0 * 33], s[1 * 33]); o.y = cvt_pk_bf16(s[2 * 33], s[3 * 33]); o.z = cvt_pk_bf16(s[4 * 33], s[5 * 33]); o.w = cvt_pk_bf16(s[6 * 33], s[7 * 33]);
        if (n < t.ncols) *(u32x4*)(t.dst + (size_t)n * t.dstK + 8 * c8) = o; }
    LDS_WAIT(); asm volatile("" ::: "memory");
}
constexpr int IT_COMMON = 1280 + 1280 + 16 + 256 + 256 + 512 + 128 + 512;
constexpr int IT_FFN = 3 * 1408, IT_MOE1 = 8 * 1792;
constexpr int IT_TOTAL = 2 * IT_COMMON + IT_FFN + 3 * IT_MOE1;
__device__ __forceinline__ TrItem seg_plain(const float* src, int K, int N, int pitch, bf16_t* dst, int r) {
    const int nblk = N / 32, kb = r / nblk, nb = r % nblk;
    return TrItem{src + (size_t)kb * 64 * pitch + nb * 32, pitch, dst + (size_t)(nb * 32) * K + kb * 64, K, 32};
}
__device__ __forceinline__ TrItem seg_gu(const float* src, int N, bf16_t* dst, int up, int r) {
    const int nblk = N / 32, kb = r / nblk, nb = r % nblk, n0 = nb * 32;
    return TrItem{src + (size_t)kb * 64 * N + n0, N, dst + (size_t)((n0 >> 7) * 256 + (n0 & 127) + up * 128) * D + kb * 64, D, 32};
}
__device__ __forceinline__ TrItem decode_item(const Args& a, unsigned char* ws, int it) {
    if (it < 2 * IT_COMMON) {
        const int l = it / IT_COMMON; int r = it % IT_COMMON; unsigned char* wb = ws + (l ? WS_W1 : WS_W0);
        const float* win = a.in[I_WIN] + (size_t)l * D * INW;
        if (r < 1280) return seg_plain(win, D, 2560, INW, (bf16_t*)(wb + OFF_WIN), r); r -= 1280;
        if (r < 1280) return seg_plain(win + 2576, D, 2560, INW, (bf16_t*)(wb + OFF_WIN) + (size_t)2560 * D, r); r -= 1280;
        if (r < 16) return TrItem{win + (size_t)r * 64 * INW + 2560, INW, (bf16_t*)(wb + OFF_WGD) + r * 64, D, 16}; r -= 16;
        if (r < 256) return seg_plain(a.in[I_WBA] + (size_t)l * 512 * D, 512, D, D, (bf16_t*)(wb + OFF_WBA), r); r -= 256;
        if (r < 256) return seg_plain(a.in[I_WBB] + (size_t)l * 512 * D, 512, D, D, (bf16_t*)(wb + OFF_WBB), r); r -= 256;
        if (r < 512) return seg_plain(a.in[I_WOUT] + (size_t)l * D * D, D, D, D, (bf16_t*)(wb + OFF_WOUT), r); r -= 512;
        if (r < 128) return seg_plain(a.in[I_PP] + (size_t)l * PLE * D, PLE, D, D, (bf16_t*)(wb + OFF_WPP), r); r -= 128;
        return seg_plain(a.in[I_PG] + (size_t)l * D * D, D, D, D, (bf16_t*)(wb + OFF_WPG), r);
    }
    it -= 2 * IT_COMMON;
    if (it < IT_FFN) {
        unsigned char* wb = ws + WS_W0;
        if (it < 1408) return seg_gu(a.in[I_FG], DFF, (bf16_t*)(wb + OFF_FFN), 0, it); it -= 1408;
        if (it < 1408) return seg_gu(a.in[I_FU], DFF, (bf16_t*)(wb + OFF_FFN), 1, it); it -= 1408;
        return seg_plain(a.in[I_FD], DFF, D, D, (bf16_t*)(wb + OFF_FDN), it);
    }
    it -= IT_FFN;
    unsigned char* wb = ws + WS_W1;
    const int kind = it / IT_MOE1, r0 = it % IT_MOE1, e = r0 / 1792, r = r0 % 1792;
    if (kind == 0) return seg_gu(a.in[I_MG] + (size_t)e * D * DFE, DFE, (bf16_t*)(wb + OFF_FFN) + (size_t)e * 7168 * D, 0, r);
    if (kind == 1) return seg_gu(a.in[I_MU] + (size_t)e * D * DFE, DFE, (bf16_t*)(wb + OFF_FFN) + (size_t)e * 7168 * D, 1, r);
    return seg_plain(a.in[I_MD] + (size_t)e * DFE * D, DFE, D, D, (bf16_t*)(wb + OFF_MDN) + (size_t)e * D * DFE, r);
}
__device__ __forceinline__ void p0_prologue(Frame& F, const Args& a) {
    FRESH(F);
    LAS float* scr = (LAS float*)(F.lds + F.wave * 16384);
    const int gw = F.vcu * NWAVES + F.wave, NGW = F.G * NWAVES;
    for (int it = gw; it < IT_TOTAL; it += NGW) { const TrItem t = decode_item(a, F.ws, it); tr_item(t, scr, F.lane); }
    { const f32x4* ps = (const f32x4*)a.in[I_P]; u32x4* pd = (u32x4*)(F.ws + WS_PB); const int n8 = 2 * T * PLE / 8;
      for (int i = blockIdx.x * NTHR + F.tid; i < n8; i += F.G * NTHR) { const f32x4 v0 = ps[2 * i], v1 = ps[2 * i + 1];
          u32x4 w; w.x = cvt_pk_bf16(v0.x, v0.y); w.y = cvt_pk_bf16(v0.z, v0.w); w.z = cvt_pk_bf16(v1.x, v1.y); w.w = cvt_pk_bf16(v1.z, v1.w); pd[i] = w; } }
    thin_phase<0, 1, false>(F, a.in[I_X], nullptr, nullptr, a.in[I_NMPRE], (bf16_t*)(F.ws + WS_HB), nullptr);
}
typedef short v4i16_t __attribute__((ext_vector_type(4)));
__device__ __forceinline__ s16x4 lds_tr16(const LAS unsigned char* p) { return __builtin_bit_cast(s16x4, __builtin_amdgcn_ds_read_tr16_b64_v4i16((LAS v4i16_t*)p)); }
__device__ __forceinline__ bf16x8 cat8(s16x4 a, s16x4 b) { return (bf16x8){a[0], a[1], a[2], a[3], b[0], b[1], b[2], b[3]}; }

__device__ __forceinline__ void attn_unit(Frame& F, int b, int c, const float* relb) {
    FRESH(F);
    const int lane = F.lane, h = F.wave, n = lane & 15, mq = lane >> 4;
    const bf16_t* qa = (const bf16_t*)(F.ws + WS_QA); const bf16_t* ka = (const bf16_t*)(F.ws + WS_KA); const bf16_t* va = (const bf16_t*)(F.ws + WS_VA);
    LAS unsigned char* kbuf = F.lds + h * 16384; LAS unsigned char* vbuf = kbuf + 8192;
    LAS float* tbl = (LAS float*)(F.lds + XTRA_OFF + h * 1056);
    for (int i = lane; i < RELN; i += 64) tbl[i] = relb[h * RELN + i] * LOG2E;
    const int tok0 = b * SEQ + c * CH;
    bf16x8 qf[4][2];
#pragma unroll
    for (int qt = 0; qt < 4; ++qt)
#pragma unroll
        for (int ks = 0; ks < 2; ++ks) qf[qt][ks] = *(const bf16x8*)(qa + (size_t)(tok0 + 16 * qt + n) * 512 + h * 64 + 32 * ks + 8 * mq);
    const int koff_e = (lane >> 3) * 512 + (((lane & 7) ^ ((lane >> 4) & 7)) * 8), koff_o = (lane >> 3) * 512 + (((lane & 7) ^ ((4 + (lane >> 4)) & 7)) * 8);
    const int voff = (lane >> 3) * 512 + ((2 * (((lane & 7) >> 1) ^ (lane >> 4)) + (lane & 1)) * 8);
#define ATT_DMA_K(j) do { const bf16_t* _s = ka + (size_t)(b * SEQ + (j) * CH) * 512 + h * 64; _Pragma("unroll") for (int _i = 0; _i < 8; ++_i) \
        __builtin_amdgcn_global_load_lds((const unsigned*)(_s + (size_t)_i * 8 * 512 + ((_i & 1) ? koff_o : koff_e)), (LAS unsigned*)(kbuf + _i * 1024), 16, 0, 0); } while (0)
#define ATT_DMA_V(j) do { const bf16_t* _s = va + (size_t)(b * SEQ + (j) * CH) * 512 + h * 64; _Pragma("unroll") for (int _i = 0; _i < 8; ++_i) \
        __builtin_amdgcn_global_load_lds((const unsigned*)(_s + (size_t)_i * 8 * 512 + voff), (LAS unsigned*)(vbuf + _i * 1024), 16, 0, 0); } while (0)
    const int ka0 = n * 128 + (((0 + mq) ^ (n >> 1)) * 16), ka1 = n * 128 + (((4 + mq) ^ (n >> 1)) * 16);
    const int qp = n >> 2, pp = lane & 3, sw = 2 * (mq & 1) + (qp >> 1);
    const int vrow = (4 * mq + qp) * 128 + 8 * pp;
    f32x4 O[4][4]; float mrun[4], lsum[4];
#pragma unroll
    for (int qt = 0; qt < 4; ++qt) { mrun[qt] = -1.0e30f; lsum[qt] = 0.f;
#pragma unroll
        for (int dt = 0; dt < 4; ++dt) O[qt][dt] = (f32x4){0.f, 0.f, 0.f, 0.f}; }
    const int j0 = (c - NPREV) > 0 ? (c - NPREV) : 0;
    ATT_DMA_K(j0); ATT_DMA_V(j0);
    for (int j = j0; j <= c; ++j) {
        const int dc = c - j;
        asm volatile("s_waitcnt vmcnt(8)" ::: "memory");
#pragma unroll
        for (int qg = 0; qg < 2; ++qg) {
            f32x4 S[4][2];
#pragma unroll
            for (int kt = 0; kt < 4; ++kt) {
                const bf16x8 k0 = *(const LAS bf16x8*)(kbuf + kt * 2048 + ka0), k1 = *(const LAS bf16x8*)(kbuf + kt * 2048 + ka1);
#pragma unroll
                for (int q2 = 0; q2 < 2; ++q2) { f32x4 z = (f32x4){0.f, 0.f, 0.f, 0.f};
                    z = __builtin_amdgcn_mfma_f32_16x16x32_bf16(k0, qf[2 * qg + q2][0], z, 0, 0, 0);
                    S[kt][q2] = __builtin_amdgcn_mfma_f32_16x16x32_bf16(k1, qf[2 * qg + q2][1], z, 0, 0, 0); }
            }
            if (qg == 1) { if (j < c) { LDS_WAIT(); ATT_DMA_K(j + 1); } }
            bf16x8 P[2][2];
#pragma unroll
            for (int q2 = 0; q2 < 2; ++q2) { const int qt = 2 * qg + q2;
                if (dc >= 3) { const float bf = tbl[256];
#pragma unroll
                    for (int kt = 0; kt < 4; ++kt) S[kt][q2] = S[kt][q2] + bf;
                } else {
#pragma unroll
                    for (int kt = 0; kt < 4; ++kt)
#pragma unroll
                        for (int i = 0; i < 4; ++i) { int idx = 64 * dc + 16 * (qt - kt) + n - 4 * mq - i; idx = (idx > 128 ? 128 : idx) + 128; S[kt][q2][i] += tbl[idx]; }
                }
                float cm = S[0][q2][0];
#pragma unroll
                for (int kt = 0; kt < 4; ++kt)
#pragma unroll
                    for (int i = 0; i < 4; ++i) cm = fmaxf(cm, S[kt][q2][i]);
                cm = fmaxf(cm, __shfl_xor(cm, 16)); cm = fmaxf(cm, __shfl_xor(cm, 32));
                const float mn = fmaxf(mrun[qt], cm), alpha = __builtin_amdgcn_exp2f(mrun[qt] - mn); mrun[qt] = mn;
                float ps = 0.f;
#pragma unroll
                for (int kt = 0; kt < 4; ++kt)
#pragma unroll
                    for (int i = 0; i < 4; ++i) { const float p = __builtin_amdgcn_exp2f(S[kt][q2][i] - mn); S[kt][q2][i] = p; ps += p; }
                lsum[qt] = lsum[qt] * alpha + ps;
#pragma unroll
                for (int dt = 0; dt < 4; ++dt) O[qt][dt] = O[qt][dt] * alpha;
#pragma unroll
                for (int u = 0; u < 2; ++u) { u32x4 w; w.x = cvt_pk_bf16(S[2 * u][q2][0], S[2 * u][q2][1]); w.y = cvt_pk_bf16(S[2 * u][q2][2], S[2 * u][q2][3]);
                    w.z = cvt_pk_bf16(S[2 * u + 1][q2][0], S[2 * u + 1][q2][1]); w.w = cvt_pk_bf16(S[2 * u + 1][q2][2], S[2 * u + 1][q2][3]); P[q2][u] = __builtin_bit_cast(bf16x8, w); }
            }
            if (qg == 0) asm volatile("s_waitcnt vmcnt(0)" ::: "memory");
#pragma unroll
            for (int dt = 0; dt < 4; ++dt)
#pragma unroll
                for (int u = 0; u < 2; ++u) {
                    const LAS unsigned char* vp = vbuf + vrow + (32 * u) * 128 + ((dt ^ sw) * 32);
                    const bf16x8 vf = cat8(lds_tr16(vp), lds_tr16(vp + 16 * 128));
#pragma unroll
                    for (int q2 = 0; q2 < 2; ++q2) O[2 * qg + q2][dt] = __builtin_amdgcn_mfma_f32_16x16x32_bf16(vf, P[q2][u], O[2 * qg + q2][dt], 0, 0, 0);
                }
            if (qg == 1) { if (j < c) { LDS_WAIT(); ATT_DMA_V(j + 1); } }
        }
    }
#undef ATT_DMA_K
#undef ATT_DMA_V
    bf16_t* ya = (bf16_t*)(F.ws + WS_QA);
#pragma unroll
    for (int qt = 0; qt < 4; ++qt) { float l = lsum[qt]; l += __shfl_xor(l, 16); l += __shfl_xor(l, 32); const float rl = __builtin_amdgcn_rcpf(l);
#pragma unroll
        for (int dt = 0; dt < 4; ++dt) { const f32x4 o = O[qt][dt] * rl; u32x2 w; w.x = cvt_pk_bf16(o[0], o[1]); w.y = cvt_pk_bf16(o[2], o[3]);
            *(u32x2*)(ya + (size_t)(tok0 + 16 * qt + n) * 512 + h * 64 + 16 * dt + 4 * mq) = w; } }
}

__device__ __forceinline__ void gla_dstate_unit(Frame& F, int b, int c, const bf16_t* wgd_t, const float* wup, const float* bgate) {
    FRESH(F);
    const int lane = F.lane, w = F.wave, tid = F.tid, n = lane & 15, mq = lane >> 4;
    const int tok0 = b * SEQ + c * CH;
    const bf16_t* hb = (const bf16_t*)(F.ws + WS_HB); const bf16_t* kb = (const bf16_t*)(F.ws + WS_KB); const bf16_t* vb = (const bf16_t*)(F.ws + WS_VB);
    LAS float* GD = (LAS float*)(F.lds); LAS unsigned char* VB = F.lds + 8192; LAS unsigned char* KD = F.lds + 73728; LAS float* TOT = (LAS float*)(F.lds + 106496);
    __syncthreads();
#pragma unroll
    for (int i = 0; i < 8; ++i) { const int p = (w * 8 + i) * 64 + lane, row = p >> 6, ch = p & 63;
        __builtin_amdgcn_global_load_lds((const unsigned*)(vb + (size_t)(tok0 + row) * 512 + ch * 8), (LAS unsigned*)(VB + (w * 8 + i) * 1024), 16, 0, 0); }
    { const int mt = w & 3, kh = w >> 2; f32x4 acc = (f32x4){0.f, 0.f, 0.f, 0.f};
      const bf16_t* ap = hb + (size_t)(tok0 + 16 * mt + n) * D + kh * 512 + 8 * mq; const bf16_t* bp = wgd_t + (size_t)n * D + kh * 512 + 8 * mq;
#pragma unroll 4
      for (int ks = 0; ks < 16; ++ks) acc = __builtin_amdgcn_mfma_f32_16x16x32_bf16(*(const bf16x8*)(ap + 32 * ks), *(const bf16x8*)(bp + 32 * ks), acc, 0, 0, 0);
#pragma unroll
      for (int i = 0; i < 4; ++i) GD[(kh * 64 + 16 * mt + 4 * mq + i) * 16 + n] = acc[i]; }
    __syncthreads();
    { const int col = tid & 255;
      const int hf = tid >> 8; float wu[16];
#pragma unroll
      for (int r = 0; r < 16; ++r) wu[r] = wup[r * 256 + col];
      const float bb = bgate[col]; float cum[32]; float run = 0.f;
#pragma unroll
      for (int l = 0; l < 32; ++l) { const int row = 32 * hf + l; float z = bb;
#pragma unroll
          for (int r4 = 0; r4 < 4; ++r4) { const f32x4 a = *(const LAS f32x4*)(GD + row * 16 + 4 * r4), a2 = *(const LAS f32x4*)(GD + (64 + row) * 16 + 4 * r4);
              z += (a.x + a2.x) * wu[4 * r4] + (a.y + a2.y) * wu[4 * r4 + 1] + (a.z + a2.z) * wu[4 * r4 + 2] + (a.w + a2.w) * wu[4 * r4 + 3]; }
          const float la = (fminf(z, 0.f) - __logf(1.f + __expf(-fabsf(z)))) * (1.f / 16.f);
          run += la; cum[l] = run; }
      LAS float* TOT1 = TOT + 256;
      if (hf == 0) TOT[col] = run;
      __syncthreads();
      const float tot = (hf == 1) ? TOT[col] : 0.f;
      if (hf == 1) TOT1[col] = run + tot;
      __syncthreads();
      const float ctot = TOT1[col];
      if (hf == 1) ((float*)(F.ws + WS_DEC))[(size_t)(b * NCH + c) * 256 + col] = __expf(ctot);
      unsigned pk[16];
#pragma unroll
      for (int l = 0; l < 32; l += 2) { const float k0 = bf2f(kb[(size_t)(tok0 + 32 * hf + l) * 256 + col]), k1 = bf2f(kb[(size_t)(tok0 + 32 * hf + l + 1) * 256 + col]);
          pk[l >> 1] = cvt_pk_bf16(k0 * __expf(ctot - (cum[l] + tot)), k1 * __expf(ctot - (cum[l + 1] + tot))); }
#pragma unroll
      for (int q = 0; q < 4; ++q) *(LAS u32x4*)(KD + col * 128 + hf * 64 + q * 16) = (u32x4){pk[4 * q], pk[4 * q + 1], pk[4 * q + 2], pk[4 * q + 3]}; }
    VM_WAIT();
    __syncthreads();
    { const int hh = w >> 1, vh = w & 1, qp = n >> 2, pp = lane & 3;
      f32x4 acc[4][4];
#pragma unroll
      for (int mt = 0; mt < 4; ++mt)
#pragma unroll
          for (int nt = 0; nt < 4; ++nt) acc[mt][nt] = (f32x4){0.f, 0.f, 0.f, 0.f};
#pragma unroll
      for (int ks = 0; ks < 2; ++ks) {
          bf16x8 af[4];
#pragma unroll
          for (int mt = 0; mt < 4; ++mt) af[mt] = *(const LAS bf16x8*)(KD + (hh * 64 + 16 * mt + n) * 128 + (32 * ks + 8 * mq) * 2);
#pragma unroll
          for (int nt = 0; nt < 4; ++nt) {
              const LAS unsigned char* vp = VB + (size_t)(32 * ks + 8 * mq + qp) * 1024 + (hh * 128 + vh * 64 + 16 * nt + 4 * pp) * 2;
              const bf16x8 bfr = cat8(lds_tr16(vp), lds_tr16(vp + 4 * 1024));
#pragma unroll
              for (int mt = 0; mt < 4; ++mt) acc[mt][nt] = __builtin_amdgcn_mfma_f32_16x16x32_bf16(af[mt], bfr, acc[mt][nt], 0, 0, 0);
          }
      }
      float* dst = (float*)(F.ws + WS_DST) + ((size_t)((b * NCH + c) * BH + hh) * 128) * 64;
#pragma unroll
      for (int mt = 0; mt < 4; ++mt)
#pragma unroll
          for (int nt = 0; nt < 4; ++nt) *(f32x4*)(dst + (size_t)(vh * 64 + 16 * nt + n) * 64 + 16 * mt + 4 * mq) = acc[mt][nt]; }
    __syncthreads();
}

__device__ __forceinline__ void gla_scan_phase(Frame& F) {
    FRESH(F);
    const float* ds = (const float*)(F.ws + WS_DST); const float* dec = (const float*)(F.ws + WS_DEC); bf16_t* st = (bf16_t*)(F.ws + WS_ST);
    for (int e2 = blockIdx.x * NTHR + F.tid; e2 < NB * BH * 128 * 32; e2 += F.G * NTHR) {
        const int k2 = e2 & 31, v = (e2 >> 5) & 127, hh = (e2 >> 12) & 3, b = e2 >> 14;
        f32x2 s = (f32x2){0.f, 0.f};
#pragma unroll 8
        for (int c = 0; c < NCH; ++c) {
            const size_t off = ((size_t)((b * NCH + c) * BH + hh) * 128 + v) * 64 + 2 * k2;
            const f32x2 d = *(const f32x2*)(ds + off); const f32x2 a = *(const f32x2*)(dec + (size_t)(b * NCH + c) * 256 + hh * 64 + 2 * k2);
            s = a * s + d;
            *(unsigned*)(st + off) = cvt_pk_bf16(s.x, s.y);
        }
    }
}

__device__ __forceinline__ void gla_out_unit(Frame& F, int b, int c, const float* gnorm) {
    FRESH(F);
    const int lane = F.lane, w = F.wave, n = lane & 15, mq = lane >> 4;
    const int hh = w >> 1, th = w & 1, tok0 = b * SEQ + c * CH + 32 * th;
    const bf16_t* qb = (const bf16_t*)(F.ws + WS_QB); const bf16_t* st = (const bf16_t*)(F.ws + WS_ST) + ((size_t)((b * NCH + c) * BH + hh) * 128) * 64;
    bf16_t* sr = (bf16_t*)(F.ws + WS_SR);
    bf16x8 qf[2][2];
#pragma unroll
    for (int nt = 0; nt < 2; ++nt)
#pragma unroll
        for (int ks = 0; ks < 2; ++ks) qf[nt][ks] = *(const bf16x8*)(qb + (size_t)(tok0 + 16 * nt + n) * 256 + hh * 64 + 32 * ks + 8 * mq);
    f32x4 acc[8][2];
#pragma unroll
    for (int mt = 0; mt < 8; ++mt) {
        const bf16x8 a0 = *(const bf16x8*)(st + (size_t)(16 * mt + n) * 64 + 8 * mq), a1 = *(const bf16x8*)(st + (size_t)(16 * mt + n) * 64 + 32 + 8 * mq);
#pragma unroll
        for (int nt = 0; nt < 2; ++nt) { f32x4 z = (f32x4){0.f, 0.f, 0.f, 0.f};
            z = __builtin_amdgcn_mfma_f32_16x16x32_bf16(a0, qf[nt][0], z, 0, 0, 0);
            acc[mt][nt] = __builtin_amdgcn_mfma_f32_16x16x32_bf16(a1, qf[nt][1], z, 0, 0, 0); }
    }
#pragma unroll
    for (int nt = 0; nt < 2; ++nt) { float ss = 0.f;
#pragma unroll
        for (int mt = 0; mt < 8; ++mt) ss += (acc[mt][nt][0] * acc[mt][nt][0] + acc[mt][nt][1] * acc[mt][nt][1]) + (acc[mt][nt][2] * acc[mt][nt][2] + acc[mt][nt][3] * acc[mt][nt][3]);
        ss += __shfl_xor(ss, 16); ss += __shfl_xor(ss, 32);
        const float rstd = __builtin_amdgcn_rsqf(ss * (1.f / 128.f) + EPS);
#pragma unroll
        for (int mt = 0; mt < 8; ++mt) { const int col = hh * 128 + 16 * mt + 4 * mq; const f32x4 gn = *(const f32x4*)(gnorm + col);
            bf16_t* p = sr + (size_t)(tok0 + 16 * nt + n) * 512 + col; const u32x2 rw = *(const u32x2*)p;
            const f32x4 o = acc[mt][nt] * rstd * gn; u32x2 wv; wv.x = cvt_pk_bf16(o[0] * bf_lo(rw.x), o[1] * bf_hi(rw.x)); wv.y = cvt_pk_bf16(o[2] * bf_lo(rw.y), o[3] * bf_hi(rw.y));
            *(u32x2*)p = wv; } }
}
#ifndef PLE_MODE1
#define PLE_MODE1 3
#endif
constexpr int N_PHASES = 25;
__global__ void __launch_bounds__(NTHR, 2) fwd(Args args) {
    extern __shared__ __attribute__((aligned(16))) unsigned char lds[];
    Frame F;
    F.lds = (LAS unsigned char*)lds;
    F.MISC = (volatile LAS unsigned*)(F.lds + MISC_OFF);
    F.tid = threadIdx.x; F.lane = F.tid & 63; F.wave = __builtin_amdgcn_readfirstlane(F.tid >> 6);
    F.G = gridDim.x; { const int bx = blockIdx.x; F.vcu = (F.G % 8 == 0) ? (bx % 8) * (F.G / 8) + bx / 8 : bx; }
    F.ws = args.ws; F.ctl = (gu32*)(args.ws + WS_CTL); F.x = args.out;
    unsigned char* ws = args.ws;
    for (int u = F.tid; u < (LDS_BYTES - LDSCTL_OFF) / 4; u += NTHR) ((LAS unsigned*)(F.lds + LDSCTL_OFF))[u] = 0u;
    __syncthreads();
    XcdBarrier bar = xcd_barrier_post((unsigned*)(F.ctl + CW_BAR), F.MISC + 8);
    const int lo = args.ph_lo, hi = args.ph_hi;
#ifndef PHMASK
#define PHMASK 0x1fff
#endif
#define EN(i) (((PHMASK) >> (i)) & 1)
#define IN(k) (lo <= (k) && (k) < hi)
#define SEAM(k) do { if (IN(k) && IN((k) + 1)) xcd_barrier(bar); } while (0)

    if (EN(12) && IN(0)) { p0_prologue(F, args); }
    SEAM(0);
    for (int l = 0; l < DEPTH; ++l) {
        const int pb = 1 + 12 * l;
        unsigned char* wb = ws + (l ? WS_W1 : WS_W0);
        bf16_t* hb = (bf16_t*)(ws + WS_HB); bf16_t* Y = (bf16_t*)(ws + WS_Y);
        if (EN(0) && IN(pb + 0)) {
            pg8::Gemm g{hb, (const bf16_t*)(wb + OFF_WIN), D, 0, nullptr}; pg8::StaticOrder S; S.init(T, INWG, F.G, (int)blockIdx.x);
            pg8::EpiInProj E{(bf16_t*)(ws + WS_PROJ)};
            pg8::gemm_phase<pg8::EpiInProj, pg8::StaticOrder, false>(F.lds, g, S, E);
        }
        SEAM(pb + 0);
        if (EN(1) && IN(pb + 1)) {
            for (int u = F.vcu; u < NB * NCH; u += F.G) {
#ifndef NO_ATTN
                attn_unit(F, u / NCH, u % NCH, args.in[I_RELB] + (size_t)l * AH * RELN);
#endif
#ifndef NO_GLA1
                gla_dstate_unit(F, u / NCH, u % NCH, (const bf16_t*)(wb + OFF_WGD), args.in[I_WGUP] + (size_t)l * GR * 256, args.in[I_BG] + (size_t)l * 256);
#endif
            }
        }
        SEAM(pb + 1);
        if (EN(2) && IN(pb + 2)) { gla_scan_phase(F); }
        SEAM(pb + 2);
        if (EN(3) && IN(pb + 3)) { for (int u = F.vcu; u < NB * NCH; u += F.G) gla_out_unit(F, u / NCH, u % NCH, args.in[I_GNORM] + (size_t)l * 512); }
        SEAM(pb + 3);
        if (EN(4) && IN(pb + 4)) {
            pg8::StaticOrder S; S.init(T, D, F.G, (int)blockIdx.x);
            { pg8::Gemm g{(const bf16_t*)(ws + WS_QA), (const bf16_t*)(wb + OFF_WBA), 512, 0, nullptr}; pg8::EpiEw<1> E{(bf16_t*)(ws + WS_MERGED), (const bf16_t*)(ws + WS_SGA), D};
              pg8::gemm_phase<pg8::EpiEw<1>, pg8::StaticOrder, false>(F.lds, g, S, E); }
            { pg8::Gemm g{(const bf16_t*)(ws + WS_SR), (const bf16_t*)(wb + OFF_WBB), 512, 0, nullptr}; pg8::EpiEw<2> E{(bf16_t*)(ws + WS_MERGED), (const bf16_t*)(ws + WS_SGB), D};
              pg8::gemm_phase<pg8::EpiEw<2>, pg8::StaticOrder, false>(F.lds, g, S, E); }
        }
        SEAM(pb + 4);
        if (EN(5) && IN(pb + 5)) {
            pg8::StaticOrder S; S.init(T, D, F.G, (int)blockIdx.x);
            pg8::Gemm g{(const bf16_t*)(ws + WS_MERGED), (const bf16_t*)(wb + OFF_WOUT), D, 0, nullptr}; pg8::EpiEw<0> E{Y, nullptr, D};
            pg8::gemm_phase<pg8::EpiEw<0>, pg8::StaticOrder, false>(F.lds, g, S, E);
        }
        SEAM(pb + 5);
        if (EN(6) && IN(pb + 6)) {
            if (l == 0) thin_phase<1, 1, false>(F, nullptr, Y, args.in[I_NMPOST] + (size_t)l * D, args.in[I_NFPRE] + (size_t)l * D, hb, nullptr);
            else        thin_phase<1, 1, true>(F, nullptr, Y, args.in[I_NMPOST] + (size_t)l * D, args.in[I_NFPRE] + (size_t)l * D, hb, args.in[I_RW]);
        }
        SEAM(pb + 6);
        if (EN(7) && IN(pb + 7)) {
            if (l == 0) { pg8::StaticOrder S; S.init(T, 2 * DFF, F.G, (int)blockIdx.x);
                pg8::Gemm g{hb, (const bf16_t*)(wb + OFF_FFN), D, 0, nullptr}; pg8::EpiGateUp E{(bf16_t*)(ws + WS_FACT), DFF};
                pg8::gemm_phase<pg8::EpiGateUp, pg8::StaticOrder, false>(F.lds, g, S, E);
            } else { pg8::GroupedOrder S; S.init((const unsigned*)(F.ctl + CW_CNT), 2 * DFE, F.G, (int)blockIdx.x);
                pg8::Gemm g{hb, (const bf16_t*)(wb + OFF_FFN), D, (size_t)2 * DFE * D, (const int*)(ws + WS_IDXE)}; pg8::EpiGateUp E{(bf16_t*)(ws + WS_MACT), DFE};
                pg8::gemm_phase<pg8::EpiGateUp, pg8::GroupedOrder, true>(F.lds, g, S, E);
            }
        }
        SEAM(pb + 7);
        if (EN(8) && IN(pb + 8)) {
            if (l == 0) { pg8::StaticOrder S; S.init(T, D, F.G, (int)blockIdx.x);
                pg8::Gemm g{(const bf16_t*)(ws + WS_FACT), (const bf16_t*)(wb + OFF_FDN), DFF, 0, nullptr}; pg8::EpiEw<0> E{Y, nullptr, D};
                pg8::gemm_phase<pg8::EpiEw<0>, pg8::StaticOrder, false>(F.lds, g, S, E);
            } else { pg8::GroupedOrder S; S.init((const unsigned*)(F.ctl + CW_CNT), D, F.G, (int)blockIdx.x);
                pg8::Gemm g{(const bf16_t*)(ws + WS_MACT), (const bf16_t*)(wb + OFF_MDN), DFE, (size_t)D * DFE, nullptr}; pg8::EpiEw<0> E{(bf16_t*)(ws + WS_YSLOT), nullptr, D};
                pg8::gemm_phase<pg8::EpiEw<0>, pg8::GroupedOrder, false>(F.lds, g, S, E);
            }
        }
        SEAM(pb + 8);
        if (EN(9) && IN(pb + 9)) {
            if (l == 0) thin_phase<1, 2, false>(F, nullptr, Y, args.in[I_NFPOST] + (size_t)l * D, nullptr, (bf16_t*)(ws + WS_XB), nullptr);
            else        thin_phase<2, 2, false>(F, nullptr, (const bf16_t*)(ws + WS_YSLOT), args.in[I_NFPOST] + (size_t)l * D, nullptr, (bf16_t*)(ws + WS_XB), nullptr);
        }
        SEAM(pb + 9);
        if (EN(10) && IN(pb + 10)) {
            pg8::StaticOrder S; S.init(T, D, F.G, (int)blockIdx.x);
            if (args.sub != 2) { pg8::Gemm g{(const bf16_t*)(ws + WS_XB), (const bf16_t*)(wb + OFF_WPG), D, 0, nullptr}; pg8::EpiEw<PLE_MODE1> E{Y, nullptr, D};
              pg8::gemm_phase<pg8::EpiEw<PLE_MODE1>, pg8::StaticOrder, false>(F.lds, g, S, E); }
            if (args.sub != 1) { pg8::Gemm g{(const bf16_t*)(ws + WS_PB) + (size_t)l * T * PLE, (const bf16_t*)(wb + OFF_WPP), PLE, 0, nullptr}; pg8::EpiEw<4> E{Y, nullptr, D};
              pg8::gemm_phase<pg8::EpiEw<4>, pg8::StaticOrder, false>(F.lds, g, S, E); }
        }
        SEAM(pb + 10);
        if (EN(11) && IN(pb + 11)) {
            if (l + 1 < DEPTH) thin_phase<1, 1, false>(F, nullptr, Y, args.in[I_PNORM] + (size_t)l * D, args.in[I_NMPRE] + (size_t)(l + 1) * D, hb, nullptr);
            else               thin_phase<1, 0, false>(F, nullptr, Y, args.in[I_PNORM] + (size_t)l * D, nullptr, nullptr, nullptr);
        }
        SEAM(pb + 11);
    }
#undef IN
#undef SEAM
}
#ifndef MK_DBG
#define MK_DBG 0
#endif
#if MK_DBG
#ifndef MK_DBG_SHOW
#define MK_DBG_SHOW -1
#endif
constexpr size_t WS_SNAP = 512 * 1024;
__device__ __forceinline__ unsigned dh(unsigned x) { x ^= x >> 16; x *= 0x7feb352du; x ^= x >> 15; x *= 0x846ca68bu; x ^= x >> 16; return x; }
__device__ __forceinline__ void dbg_acc(float* dbg, int stage, float d2, float e2, int lane) { d2 = wave_sum(d2); e2 = wave_sum(e2); if (lane == 0) { atomicAdd(dbg + 2 * stage, d2); atomicAdd(dbg + 2 * stage + 1, e2); } }
__device__ __forceinline__ float ddot(const bf16_t* arow, const float* W, int K, int pitch, int col, int lane) { float s = 0.f; for (int k = lane; k < K; k += 64) s += bf2f(arow[k]) * W[(size_t)k * pitch + col]; return wave_sum(s); }
__device__ __forceinline__ float dsig(float v) { return 1.f / (1.f + expf(-v)); }
__device__ __forceinline__ int dbg_pbase(const unsigned* gcnt, int e) { int acc = 0; for (int q = 0; q < 8; ++q) if (q < e) acc += (((int)gcnt[q] + 255) >> 8) << 8; return acc; }
#define DBGP float* dbg = (float*)(a.ws + WS_CTL) + CW_DBG; const int lane = threadIdx.x & 63; const unsigned sid = blockIdx.x; (void)sid

__global__ void dbg_t1(Args a, int stage) { DBGP;
    const int r = dh(sid * 3 + 1) % T; const float* x = a.in[I_X] + (size_t)r * D; const bf16_t* hb = (const bf16_t*)(a.ws + WS_HB) + (size_t)r * D;
    float ss = 0.f; for (int k = lane; k < D; k += 64) ss += x[k] * x[k]; ss = wave_sum(ss); const float rstd = 1.f / sqrtf(ss / D + EPS);
    float d2 = 0.f, e2 = 0.f; for (int k = lane; k < D; k += 64) { const float e = x[k] * rstd * a.in[I_NMPRE][k], g = bf2f(hb[k]); d2 += (g - e) * (g - e); e2 += e * e; const float dx = a.out[(size_t)r * D + k] - x[k]; d2 += dx * dx; }
    dbg_acc(dbg, stage, d2, e2, lane); }

__global__ void dbg_gemm(Args a, int kind, int l, int stage) { DBGP;
    unsigned char* ws = a.ws; const unsigned h1 = dh(sid * 7 + 1), h2 = dh(sid * 7 + 2), h3 = dh(sid * 7 + 3);
    const bf16_t* hb = (const bf16_t*)(ws + WS_HB); float e = 0.f, g = 0.f;
    const unsigned* gcnt = (const unsigned*)(ws + WS_CTL) + CW_CNT;
    if (kind == 1) { const int row = h1 % T, col = h2 % INWG, sc = col < 2560 ? col : col + 16; const float v = ddot(hb + (size_t)row * D, a.in[I_WIN] + (size_t)l * D * INW, D, INW, sc, lane);
        const bf16_t* P = (const bf16_t*)(ws + WS_PROJ);
        if (col < 512) { e = v * pg8::QA_SCALE; g = bf2f(((const bf16_t*)(ws + WS_QA))[(size_t)row * 512 + col]); }
        else if (col < 1024) { e = v; g = bf2f(((const bf16_t*)(ws + WS_KA))[(size_t)row * 512 + col - 512]); }
        else if (col < 1536) { e = v; g = bf2f(((const bf16_t*)(ws + WS_VA))[(size_t)row * 512 + col - 1024]); }
        else if (col < 1792) { e = v * 0.125f; g = bf2f(((const bf16_t*)(ws + WS_QB))[(size_t)row * 256 + col - 1536]); }
        else if (col < 2048) { e = v; g = bf2f(((const bf16_t*)(ws + WS_KB))[(size_t)row * 256 + col - 1792]); }
        else if (col < 2560) { e = v; g = bf2f(((const bf16_t*)(ws + WS_VB))[(size_t)row * 512 + col - 2048]); }
        else if (col < 3072) { e = v * dsig(v); g = bf2f(((const bf16_t*)(ws + WS_SR))[(size_t)row * 512 + col - 2560]); }
        else if (col < 4096) { e = dsig(v); g = bf2f(((const bf16_t*)(ws + WS_SGA))[(size_t)row * 1024 + col - 3072]); }
        else { e = dsig(v); g = bf2f(((const bf16_t*)(ws + WS_SGB))[(size_t)row * 1024 + col - 4096]); } (void)P;
    } else if (kind == 2) { const int row = h1 % T, col = h2 % D;
        const float va = ddot((const bf16_t*)(ws + WS_QA) + (size_t)row * 512, a.in[I_WBA] + (size_t)l * 512 * D, 512, D, col, lane), vb = ddot((const bf16_t*)(ws + WS_SR) + (size_t)row * 512, a.in[I_WBB] + (size_t)l * 512 * D, 512, D, col, lane);
        e = bf2f(((const bf16_t*)(ws + WS_SGA))[(size_t)row * D + col]) * va + bf2f(((const bf16_t*)(ws + WS_SGB))[(size_t)row * D + col]) * vb; g = bf2f(((const bf16_t*)(ws + WS_MERGED))[(size_t)row * D + col]);
    } else if (kind == 3) { const int row = h1 % T, col = h2 % D; e = ddot((const bf16_t*)(ws + WS_MERGED) + (size_t)row * D, a.in[I_WOUT] + (size_t)l * D * D, D, D, col, lane); g = bf2f(((const bf16_t*)(ws + WS_Y))[(size_t)row * D + col]);
    } else if (kind == 4) { const int row = h1 % T, c = h2 % DFF; const float vg = ddot(hb + (size_t)row * D, a.in[I_FG], D, DFF, c, lane), vu = ddot(hb + (size_t)row * D, a.in[I_FU], D, DFF, c, lane);
        e = vg * dsig(vg) * vu; g = bf2f(((const bf16_t*)(ws + WS_FACT))[(size_t)row * DFF + c]);
    } else if (kind == 5) { const int row = h1 % T, col = h2 % D; e = ddot((const bf16_t*)(ws + WS_FACT) + (size_t)row * DFF, a.in[I_FD], DFF, D, col, lane); g = bf2f(((const bf16_t*)(ws + WS_Y))[(size_t)row * D + col]);
    } else if (kind == 6 || kind == 7) { const int ex = h1 % NE; const int pbase = dbg_pbase(gcnt, ex); const int cnt = (int)gcnt[ex];
        if (cnt == 0) return; const int i = h2 % cnt, tok = ((const int*)(ws + WS_IDXE))[ex * 16384 + i], row = pbase + i;
        if (kind == 6) { const int c = h3 % DFE; const float vg = ddot(hb + (size_t)tok * D, a.in[I_MG] + (size_t)ex * D * DFE, D, DFE, c, lane), vu = ddot(hb + (size_t)tok * D, a.in[I_MU] + (size_t)ex * D * DFE, D, DFE, c, lane);
            e = vg * dsig(vg) * vu; g = bf2f(((const bf16_t*)(ws + WS_MACT))[(size_t)row * DFE + c]); }
        else { const int col = h3 % D; e = ddot((const bf16_t*)(ws + WS_MACT) + (size_t)row * DFE, a.in[I_MD] + (size_t)ex * DFE * D, DFE, D, col, lane); g = bf2f(((const bf16_t*)(ws + WS_YSLOT))[(size_t)row * D + col]); }
    } else if (kind == 12) { const int row = h1 % T, col = h2 % D; e = a.out[(size_t)row * D + col]; g = bf2f(((const bf16_t*)(ws + WS_XB))[(size_t)row * D + col]);
    } else if (kind == 13) { const int row = h1 % T, col = h2 % D; e = ddot((const bf16_t*)(ws + WS_XB) + (size_t)row * D, a.in[I_PG] + (size_t)l * D * D, D, D, col, lane); g = bf2f(((const bf16_t*)(ws + WS_Y))[(size_t)row * D + col]);
    } else if (kind == 11) { const int n = h1 % D, k = h2 % D; e = a.in[I_PG][(size_t)l * D * D + (size_t)k * D + n]; g = bf2f(((const bf16_t*)(ws + (l ? WS_W1 : WS_W0) + OFF_WPG))[(size_t)n * D + k]);
    } else if (kind == 9) { const int row = h1 % T, col = h2 % D; e = dsig(ddot((const bf16_t*)(ws + WS_XB) + (size_t)row * D, a.in[I_PG] + (size_t)l * D * D, D, D, col, lane)); g = bf2f(((const bf16_t*)(ws + WS_Y))[(size_t)row * D + col]);
    } else { const int row = h1 % T, col = h2 % D; const float vg = ddot((const bf16_t*)(ws + WS_XB) + (size_t)row * D, a.in[I_PG] + (size_t)l * D * D, D, D, col, lane), vp = ddot((const bf16_t*)(ws + WS_PB) + ((size_t)l * T + row) * PLE, a.in[I_PP] + (size_t)l * PLE * D, PLE, D, col, lane);
        e = dsig(vg) * vp; g = bf2f(((const bf16_t*)(ws + WS_Y))[(size_t)row * D + col]); }
    if (lane == 0) { atomicAdd(dbg + 2 * stage, (g - e) * (g - e)); atomicAdd(dbg + 2 * stage + 1, e * e); } }

__global__ void dbg_attn(Args a, int l, int stage) { DBGP;
    unsigned char* ws = a.ws; const unsigned h1 = dh(sid * 5 + 1); const int tok = h1 % T, h = dh(sid * 5 + 2) % AH, b = tok / SEQ, c = (tok % SEQ) / CH, ql = tok % CH;
    const bf16_t* hb = (const bf16_t*)(ws + WS_HB) + (size_t)tok * D; const float* win = a.in[I_WIN] + (size_t)l * D * INW;
    float q = 0.f; for (int k = 0; k < D; ++k) q += bf2f(hb[k]) * win[(size_t)k * INW + h * 64 + lane]; q *= pg8::QA_SCALE;
    const bf16_t* ka = (const bf16_t*)(ws + WS_KA); const bf16_t* va = (const bf16_t*)(ws + WS_VA); const float* rb = a.in[I_RELB] + ((size_t)l * AH + h) * RELN;
    float m = -1e30f, ls = 0.f, o = 0.f;
    for (int kc = (c - 8 > 0 ? c - 8 : 0); kc <= c; ++kc) for (int kl = 0; kl < CH; ++kl) { const int kt = b * SEQ + kc * CH + kl; int dist = (c - kc) * 64 + ql - kl; dist = dist > 128 ? 128 : (dist < -128 ? -128 : dist);
        const float s = wave_sum(q * bf2f(ka[(size_t)kt * 512 + h * 64 + lane])) + rb[dist + 128] * LOG2E; const float mn = fmaxf(m, s), al = exp2f(m - mn), p = exp2f(s - mn); m = mn; ls = ls * al + p; o = o * al + p * bf2f(va[(size_t)kt * 512 + h * 64 + lane]); }
    const float e = o / ls, g = bf2f(((const bf16_t*)(ws + WS_QA))[(size_t)tok * 512 + h * 64 + lane]);
    dbg_acc(dbg, stage, (g - e) * (g - e), e * e, lane); }

__global__ void dbg_dstate(Args a, int l, int stage) { DBGP;
    unsigned char* ws = a.ws; const int b = dh(sid * 5 + 1) % NB, c = dh(sid * 5 + 2) % NCH, hh = dh(sid * 5 + 3) % BH, v = dh(sid * 5 + 4) % 128, k = dh(sid * 5 + 5) % 64, col = hh * 64 + k;
    const int tok = b * SEQ + c * CH + lane; const bf16_t* hb = (const bf16_t*)(ws + WS_HB) + (size_t)tok * D; const float* win = a.in[I_WIN] + (size_t)l * D * INW;
    float z = a.in[I_BG][l * 256 + col];
    for (int r = 0; r < GR; ++r) { float gd = 0.f; for (int kk = 0; kk < D; ++kk) gd += bf2f(hb[kk]) * win[(size_t)kk * INW + 2560 + r]; z += gd * a.in[I_WGUP][((size_t)l * GR + r) * 256 + col]; }
    const float la = (fminf(z, 0.f) - log1pf(expf(-fabsf(z)))) / 16.f; float cum = la;
    for (int o = 1; o < 64; o <<= 1) { const float t = __shfl_up(cum, o); if (lane >= o) cum += t; }
    const float tot = __shfl(cum, 63);
    const float kd = bf2f(((const bf16_t*)(ws + WS_KB))[(size_t)tok * 256 + col]) * expf(tot - cum);
    const float e = wave_sum(kd * bf2f(((const bf16_t*)(ws + WS_VB))[(size_t)tok * 512 + hh * 128 + v]));
    const float g = ((const float*)(ws + WS_DST))[((size_t)((b * NCH + c) * BH + hh) * 128 + v) * 64 + k];
    const float ed = expf(tot), gdc = ((const float*)(ws + WS_DEC))[(size_t)(b * NCH + c) * 256 + col];
    if (lane == 0) { atomicAdd(dbg + 2 * stage, (g - e) * (g - e) + (gdc - ed) * (gdc - ed)); atomicAdd(dbg + 2 * stage + 1, e * e + ed * ed); } }

__global__ void dbg_scan(Args a, int stage) { DBGP;
    unsigned char* ws = a.ws; const unsigned s0 = sid * 64 + lane; const int b = dh(s0 * 5 + 1) % NB, c = dh(s0 * 5 + 2) % NCH, hh = dh(s0 * 5 + 3) % BH, v = dh(s0 * 5 + 4) % 128, k = dh(s0 * 5 + 5) % 64;
    float s = 0.f; for (int cc = 0; cc <= c; ++cc) s = ((const float*)(ws + WS_DEC))[(size_t)(b * NCH + cc) * 256 + hh * 64 + k] * s + ((const float*)(ws + WS_DST))[((size_t)((b * NCH + cc) * BH + hh) * 128 + v) * 64 + k];
    const float g = bf2f(((const bf16_t*)(ws + WS_ST))[((size_t)((b * NCH + c) * BH + hh) * 128 + v) * 64 + k]);
    dbg_acc(dbg, stage, (g - s) * (g - s), s * s, lane); }

__global__ void dbg_glaout(Args a, int l, int stage) { DBGP;
    unsigned char* ws = a.ws; const int tok = dh(sid * 3 + 1) % T, hh = dh(sid * 3 + 2) % BH, b = tok / SEQ, c = (tok % SEQ) / CH;
    const bf16_t* st = (const bf16_t*)(ws + WS_ST) + ((size_t)((b * NCH + c) * BH + hh) * 128) * 64; const bf16_t* qb = (const bf16_t*)(ws + WS_QB) + (size_t)tok * 256 + hh * 64;
    const bf16_t* hb = (const bf16_t*)(ws + WS_HB) + (size_t)tok * D; const float* win = a.in[I_WIN] + (size_t)l * D * INW;
    float o[2], r[2];
#pragma unroll
    for (int j = 0; j < 2; ++j) { const int v = lane + 64 * j; float s = 0.f; for (int k = 0; k < 64; ++k) s += bf2f(qb[k]) * bf2f(st[(size_t)v * 64 + k]); o[j] = s;
        float rr = 0.f; for (int kk = 0; kk < D; ++kk) rr += bf2f(hb[kk]) * win[(size_t)kk * INW + 2576 + hh * 128 + v]; r[j] = rr * dsig(rr); }
    const float ss = wave_sum(o[0] * o[0] + o[1] * o[1]), rstd = 1.f / sqrtf(ss / 128.f + EPS); float d2 = 0.f, e2 = 0.f;
#pragma unroll
    for (int j = 0; j < 2; ++j) { const int v = lane + 64 * j; const float e = o[j] * rstd * a.in[I_GNORM][l * 512 + hh * 128 + v] * r[j], g = bf2f(((const bf16_t*)(ws + WS_SR))[(size_t)tok * 512 + hh * 128 + v]); d2 += (g - e) * (g - e); e2 += e * e; }
    dbg_acc(dbg, stage, d2, e2, lane); }

__device__ __forceinline__ int dbg_row(unsigned i) { return (int)((i * 257u + 11u) % T); }
__global__ void dbg_snap(Args a) { const int i = blockIdx.x, r = dbg_row(i); float* snap = (float*)(a.ws + WS_SNAP) + (size_t)i * D; for (int k = threadIdx.x; k < D; k += 64) snap[k] = a.out[(size_t)r * D + k]; }
__global__ void dbg_thin(Args a, int src, int outk, int route, const float* g_add, const float* g_out, const bf16_t* obuf, int st_x, int st_o, int st_r) { DBGP;
    unsigned char* ws = a.ws; const int i = sid, r = dbg_row(i); const float* snap = (const float*)(ws + WS_SNAP) + (size_t)i * D;
    const unsigned* gcnt = (const unsigned*)(ws + WS_CTL) + CW_CNT; const unsigned* ti = (const unsigned*)(ws + WS_TOKINFO) + (size_t)r * 8;
    float y[16], xn[16]; float ss = 0.f;
#pragma unroll
    for (int j = 0; j < 16; ++j) { const int k = lane + 64 * j; float v;
        if (src == 1) v = bf2f(((const bf16_t*)(ws + WS_Y))[(size_t)r * D + k]);
        else { const bf16_t* ys = (const bf16_t*)(ws + WS_YSLOT); v = __uint_as_float(ti[4]) * bf2f(ys[(size_t)(dbg_pbase(gcnt, (int)ti[0]) + ti[1]) * D + k]) + __uint_as_float(ti[5]) * bf2f(ys[(size_t)(dbg_pbase(gcnt, (int)ti[2]) + ti[3]) * D + k]); }
        y[j] = v; ss += v * v; }
    ss = wave_sum(ss); const float rstd = 1.f / sqrtf(ss / D + EPS); float d2 = 0.f, e2 = 0.f, s2 = 0.f;
#pragma unroll
    for (int j = 0; j < 16; ++j) { const int k = lane + 64 * j; xn[j] = snap[k] + y[j] * rstd * g_add[k]; const float g = a.out[(size_t)r * D + k]; d2 += (g - xn[j]) * (g - xn[j]); e2 += xn[j] * xn[j]; s2 += xn[j] * xn[j]; }
    dbg_acc(dbg, st_x, d2, e2, lane);
    if (outk == 0) return;
    s2 = wave_sum(s2); const float rs2 = 1.f / sqrtf(s2 / D + EPS); d2 = 0.f; e2 = 0.f; float hn[16];
#pragma unroll
    for (int j = 0; j < 16; ++j) { const int k = lane + 64 * j; hn[j] = (outk == 1) ? xn[j] * rs2 * g_out[k] : xn[j]; const float g = bf2f(obuf[(size_t)r * D + k]); d2 += (g - hn[j]) * (g - hn[j]); e2 += hn[j] * hn[j]; }
    dbg_acc(dbg, st_o, d2, e2, lane);
    if (!route) return;
    float lg[8];
#pragma unroll
    for (int e = 0; e < 8; ++e) { float s = 0.f;
#pragma unroll
        for (int j = 0; j < 16; ++j) s += hn[j] * a.in[I_RW][(size_t)(lane + 64 * j) * NE + e]; lg[e] = wave_sum(s); }
    int e1 = 0; float v1 = lg[0];
#pragma unroll
    for (int e = 1; e < 8; ++e) if (lg[e] > v1) { v1 = lg[e]; e1 = e; }
    int e2i = -1; float v2 = -3.0e38f;
#pragma unroll
    for (int e = 0; e < 8; ++e) if (e != e1 && lg[e] > v2) { v2 = lg[e]; e2i = e; }
    const float ex = expf(v2 - v1), w1 = 1.f / (1.f + ex);
    float bad = 0.f; if ((int)ti[0] != e1 || (int)ti[2] != e2i) bad = 1.f; else { bad = fabsf(__uint_as_float(ti[4]) - w1) + fabsf(__uint_as_float(ti[5]) - (1.f - w1));
        const int* idxe = (const int*)(ws + WS_IDXE); if (ti[1] >= gcnt[e1] || ti[3] >= gcnt[e2i] || idxe[e1 * 16384 + ti[1]] != r || idxe[e2i * 16384 + ti[3]] != r) bad = 1.f; }
    if (lane == 0) { atomicAdd(dbg + 2 * st_r, bad * bad); atomicAdd(dbg + 2 * st_r + 1, 1.f); } }

__global__ void dbg_report(Args a) {
    const float* dbg = (const float*)(a.ws + WS_CTL) + CW_DBG; int bad = -1; float errk = 0.f;
    for (int k = 0; k < 33; ++k) { const float d2 = dbg[2 * k], e2 = dbg[2 * k + 1]; if (d2 == 0.f && e2 == 0.f) continue; const float err = d2 / e2; if (MK_DBG_SHOW == k) errk = (err == err) ? err : 1e6f; if (bad < 0 && !(err < 1e-3f)) bad = k; }
    float V = 0.f; bool fill = false;
    if (MK_DBG_SHOW >= 0) { V = sqrtf(7.f * 100.f * errk) + 1e-3f; fill = true; } else if (bad >= 0) { V = exp10f(1.f + 0.25f * (float)bad); fill = true; }
    if (fill) for (size_t i = (size_t)blockIdx.x * blockDim.x + threadIdx.x; i < (size_t)T * D; i += (size_t)gridDim.x * blockDim.x) a.out[i] = V; }

static void dbg_run(Args a, int grid, hipStream_t st) {
    auto ph = [&](int p) { a.ph_lo = p; a.ph_hi = p + 1; hipLaunchKernelGGL(fwd, dim3(grid), dim3(NTHR), LDS_BYTES, st, a); };
    const int NS = 2048;
    ph(0); hipLaunchKernelGGL(dbg_t1, dim3(256), dim3(64), 0, st, a, 0);
    for (int l = 0; l < DEPTH; ++l) { const int pb = 1 + 12 * l, sb = 16 * l; const size_t lo = (size_t)l * D;
        ph(pb + 0); hipLaunchKernelGGL(dbg_gemm, dim3(NS), dim3(64), 0, st, a, 1, l, sb + 1);
        ph(pb + 1); hipLaunchKernelGGL(dbg_attn, dim3(512), dim3(64), 0, st, a, l, sb + 2); hipLaunchKernelGGL(dbg_dstate, dim3(256), dim3(64), 0, st, a, l, sb + 3);
        ph(pb + 2); hipLaunchKernelGGL(dbg_scan, dim3(64), dim3(64), 0, st, a, sb + 4);
        ph(pb + 3); hipLaunchKernelGGL(dbg_glaout, dim3(256), dim3(64), 0, st, a, l, sb + 5);
        ph(pb + 4); hipLaunchKernelGGL(dbg_gemm, dim3(NS), dim3(64), 0, st, a, 2, l, sb + 6);
        ph(pb + 5); hipLaunchKernelGGL(dbg_gemm, dim3(NS), dim3(64), 0, st, a, 3, l, sb + 7);
        hipLaunchKernelGGL(dbg_snap, dim3(64), dim3(64), 0, st, a);
        ph(pb + 6); hipLaunchKernelGGL(dbg_thin, dim3(64), dim3(64), 0, st, a, 1, 1, l == 1 ? 1 : 0, a.in[I_NMPOST] + lo, a.in[I_NFPRE] + lo, (const bf16_t*)(a.ws + WS_HB), sb + 8, sb + 9, sb + 10);
        ph(pb + 7); hipLaunchKernelGGL(dbg_gemm, dim3(NS), dim3(64), 0, st, a, l == 0 ? 4 : 6, l, sb + 11);
        ph(pb + 8); hipLaunchKernelGGL(dbg_gemm, dim3(NS), dim3(64), 0, st, a, l == 0 ? 5 : 7, l, sb + 12);
        hipLaunchKernelGGL(dbg_snap, dim3(64), dim3(64), 0, st, a);
        ph(pb + 9); hipLaunchKernelGGL(dbg_thin, dim3(64), dim3(64), 0, st, a, l == 0 ? 1 : 2, 2, 0, a.in[I_NFPOST] + lo, (const float*)nullptr, (const bf16_t*)(a.ws + WS_XB), sb + 13, sb + 13, 0);
        a.sub = 1; ph(pb + 10); hipLaunchKernelGGL(dbg_gemm, dim3(NS), dim3(64), 0, st, a, 9, l, sb + 14);
        a.sub = 2; ph(pb + 10); a.sub = 0; hipLaunchKernelGGL(dbg_gemm, dim3(NS), dim3(64), 0, st, a, 8, l, sb + 15);
        hipLaunchKernelGGL(dbg_snap, dim3(64), dim3(64), 0, st, a);
        ph(pb + 11); hipLaunchKernelGGL(dbg_thin, dim3(64), dim3(64), 0, st, a, 1, l == 0 ? 1 : 0, 0, a.in[I_PNORM] + lo, l == 0 ? a.in[I_NMPRE] + D : (const float*)nullptr, (const bf16_t*)(a.ws + WS_HB), sb + 16, sb + 16, 0);
    }
    hipLaunchKernelGGL(dbg_report, dim3(1024), dim3(256), 0, st, a);
}
#endif
#ifndef MK_SPLIT
#define MK_SPLIT 0
#endif
#ifndef MK_DBG
#define MK_DBG 0
#endif
extern "C" void kernel_launch(void* const* d_in, const int* in_sizes, int n_in, void* d_out, int out_size, void* d_ws, size_t ws_size, hipStream_t stream) {
    static int grid = 0;
    if (grid == 0) {
        if (n_in != 24 || in_sizes[0] != T * D || out_size != T * D || ws_size < WS_END) { fprintf(stderr, "kernel_launch: unexpected problem (n_in %d, in0 %d, out %d, ws %zu < %zu); nothing launched\n", n_in, n_in > 0 ? in_sizes[0] : -1, out_size, ws_size, (size_t)WS_END); grid = -1; return; }
        int dev = 0, cus = 0, per_cu = 0;
        if (hipGetDevice(&dev) != hipSuccess || hipDeviceGetAttribute(&cus, hipDeviceAttributeMultiprocessorCount, dev) != hipSuccess) { grid = -1; return; }
        if (hipFuncSetAttribute((const void*)fwd, hipFuncAttributeMaxDynamicSharedMemorySize, LDS_BYTES) != hipSuccess) { fprintf(stderr, "kernel_launch: hipFuncSetAttribute failed\n"); grid = -1; return; }
        if (hipOccupancyMaxActiveBlocksPerMultiprocessor(&per_cu, (const void*)fwd, NTHR, LDS_BYTES) != hipSuccess || per_cu < 1) { fprintf(stderr, "kernel_launch: occupancy query says %d blocks per CU\n", per_cu); }
        (void)hipGetLastError();
        grid = cus;
    }
    if (grid < 0) return;
    (void)hipMemsetAsync((char*)d_ws + WS_CTL, 0, CTL_ZERO_BYTES, stream);
    Args a{};
    for (int i = 0; i < 24; ++i) a.in[i] = (const float*)d_in[i];
    a.out = (float*)d_out; a.ws = (unsigned char*)d_ws;
#if MK_DBG
    dbg_run(a, grid, stream);
#elif MK_SPLIT
    for (int p = 0; p < N_PHASES; ++p) { a.ph_lo = p; a.ph_hi = p + 1; hipLaunchKernelGGL(fwd, dim3(grid), dim3(NTHR), LDS_BYTES, stream, a); }
#else
    a.ph_lo = 0; a.ph_hi = N_PHASES;
    hipLaunchKernelGGL(fwd, dim3(grid), dim3(NTHR), LDS_BYTES, stream, a);
#endif
}
```

```cpp
#include <hip/hip_runtime.h>
#include <cstdio>
#include <cstdint>

#define LAS __attribute__((address_space(3)))
#define GAS __attribute__((address_space(1)))
typedef unsigned short bf16_t;
typedef short bf16x8 __attribute__((ext_vector_type(8)));
typedef short s16x4 __attribute__((ext_vector_type(4)));
typedef float f32x4 __attribute__((ext_vector_type(4)));
typedef float f32x2 __attribute__((ext_vector_type(2)));
typedef unsigned u32x4 __attribute__((ext_vector_type(4)));
typedef unsigned u32x2 __attribute__((ext_vector_type(2)));

typedef __bf16 bf16x2_t __attribute__((ext_vector_type(2)));
__device__ __forceinline__ unsigned cvt_pk_bf16(float lo, float hi) { f32x2 v = {lo, hi}; const bf16x2_t b = __builtin_convertvector(v, bf16x2_t); return __builtin_bit_cast(unsigned, b); }
__device__ __forceinline__ float bf_lo(unsigned w) { return __uint_as_float(w << 16); }
__device__ __forceinline__ float bf_hi(unsigned w) { return __uint_as_float(w & 0xffff0000u); }
__device__ __forceinline__ float bf2f(bf16_t b) { return __uint_as_float(((unsigned)b) << 16); }
__device__ __forceinline__ float fast_sigmoid(float v) { return __builtin_amdgcn_rcpf(1.0f + __builtin_amdgcn_exp2f(-1.4426950408889634f * v)); }
__device__ __forceinline__ float wave_sum(float v) {
#pragma unroll
    for (int o = 1; o < 64; o <<= 1) v += __shfl_xor(v, o);
    return v;
}

namespace pg8 {
constexpr int BM = 256, BK = 64, HALF = 128, HTB = HALF * BK * 2, STAGE_BYTES = 8 * HTB, NXCD = 8, WGM = 8;
__host__ __device__ __forceinline__ int lds_byte(int r, int c) { const int st = (r >> 4) * 2 + (c >> 5), rr = r & 15, cc = c & 31, ob = rr * 64 + cc * 2; return st * 1024 + (ob ^ (((ob >> 9) & 1) << 5)); }
__host__ __device__ __forceinline__ void stage_rc(int b, int& R, int& C) { const int st = b / 1024, sb = b % 1024, swz = sb ^ (((sb >> 9) & 1) << 5); R = (st >> 1) * 16 + swz / 64; C = (st & 1) * 32 + (swz % 64) / 2; }
__host__ __device__ __forceinline__ int perm32(int rho) { const int n = rho >> 4, i = rho & 15; return 8 * (i >> 2) + 4 * n + (i & 3); }

struct Unit { int pm, pn, e, lr0, cnt; };
struct Gemm { const bf16_t* A; const bf16_t* Bt; int K; size_t b_estride; const int* gidx; };

struct StaticOrder {
    int nM, nN, nwg, G, c;
    __device__ void init(int M, int N, int G_, int c_) { nM = M / BM; nN = N / BM; nwg = nM * nN; G = G_; c = c_; }
    __device__ __forceinline__ bool next(int i, Unit& u) const {
        const long L = (long)i * G + c; if (L >= nwg) return false;
        int wgid = (int)L; { const int q = nwg / NXCD, r = nwg % NXCD, xcd = wgid % NXCD, off = wgid / NXCD; wgid = (xcd < r ? xcd * (q + 1) : r * (q + 1) + (xcd - r) * q) + off; }
        const int nig = WGM * nN, gid = wgid / nig, fm = gid * WGM, gsz = (nM - fm) < WGM ? (nM - fm) : WGM;
        u.pm = fm + ((wgid % nig) % gsz); u.pn = (wgid % nig) / gsz; u.e = 0; u.lr0 = 0; u.cnt = 0; return true;
    }
};
struct GroupedOrder {
    int pb[9]; int cnt[8]; int nN, G, c, nwg;
    __device__ void init(const unsigned* counts, int N, int G_, int c_) {
        int acc = 0;
#pragma unroll
        for (int e = 0; e < 8; ++e) { const int n = (int)counts[e]; cnt[e] = n; pb[e] = acc; acc += (n + 255) >> 8; }
        pb[8] = acc; nN = N / BM; G = G_; c = c_; nwg = acc * nN;
    }
    __device__ __forceinline__ bool next(int i, Unit& u) const {
        const long L = (long)i * G + c; if (L >= nwg) return false;
        const int nig = WGM * nN, gid = (int)L / nig, fm = gid * WGM, gsz = (pb[8] - fm) < WGM ? (pb[8] - fm) : WGM;
        const int pm = fm + (((int)L % nig) % gsz), pn = ((int)L % nig) / gsz;
        int e = 0;
#pragma unroll
        for (int k = 1; k < 8; ++k) e += (pm >= pb[k]) ? 1 : 0;
        int pbe = 0, ce = 0;
#pragma unroll
        for (int k = 0; k < 8; ++k) { pbe = (k == e) ? pb[k] : pbe; ce = (k == e) ? cnt[k] : ce; }
        u.pm = pm; u.pn = pn; u.e = e; u.lr0 = (pm - pbe) * 256; u.cnt = ce; return true;
    }
};

template <class Epi, class Sched, bool GATHER>
__device__ __forceinline__ void gemm_phase(LAS unsigned char* lds, const Gemm g, const Sched& S, const Epi& E) {
    int tid = threadIdx.x; asm volatile("" : "+v"(tid));
    const int wid = __builtin_amdgcn_readfirstlane(tid >> 6), lane = tid & 63, wr = wid >> 2, wc = wid & 3, fr = lane & 15, fq = lane >> 4;
    const int K = g.K, nt = K / BK;
    unsigned voffA[2], voffB[2]; int rA[2];
#pragma unroll
    for (int i = 0; i < 2; ++i) { int R, C; stage_rc(tid * 16 + i * 8192, R, C); const int Rb = Epi::PERM ? ((R & ~31) + perm32(R & 31)) : R;
        voffA[i] = GATHER ? (unsigned)(C * 2) : (unsigned)(R * K + C) * 2u; voffB[i] = (unsigned)(Rb * K + C) * 2u; rA[i] = R; }
    const size_t kstep = (size_t)(BK * 2);
    const size_t hstep = (size_t)HALF * K * 2;
    const size_t tstep = 2 * hstep;
    const unsigned ldsw = (unsigned)wid * 1024u;
    const int aoff = lds_byte(wr * 64 + fr, fq * 8), boff = lds_byte(wc * 32 + fr, fq * 8);
#define PG8_SA(b, h) (((b) * 2 + (h)) * HTB)
#define PG8_SB(b, h) ((4 + (b) * 2 + (h)) * HTB)
#define PG8_STAGE2(bufoff, gbase, v0, v1) do { unsigned _a = (v0), _b = (v1); asm volatile("" : "+v"(_a), "+v"(_b));     \
        __builtin_amdgcn_global_load_lds((const unsigned*)((const char*)(gbase) + _a), (LAS unsigned*)(lds + (bufoff) + ldsw), 16, 0, 0); \
        __builtin_amdgcn_global_load_lds((const unsigned*)((const char*)(gbase) + _b), (LAS unsigned*)(lds + (bufoff) + ldsw + 8192), 16, 0, 0); } while (0)
#define PG8_STAGE(bufoff, gbase, voff) PG8_STAGE2(bufoff, gbase, (voff)[0], (voff)[1])
#define PG8_STAGE_A(bufoff, nx, h, kt) do { \
        if constexpr (GATHER) { const char* _p = (const char*)g.A + (size_t)(kt) * kstep; \
            if (nx) { PG8_STAGE2(bufoff, _p, nG[h][0], nG[h][1]); } else { PG8_STAGE2(bufoff, _p, cG[h][0], cG[h][1]); } } \
        else { const char* _p = ((nx) ? nA : cA) + (size_t)(h) * hstep + (size_t)(kt) * kstep; PG8_STAGE2(bufoff, _p, voffA[0], voffA[1]); } } while (0)
#define PG8_LDA(dst, b, h) do { _Pragma("unroll") for (int m = 0; m < 4; ++m) _Pragma("unroll") for (int k = 0; k < 2; ++k) dst[m][k] = *(const LAS bf16x8*)(lds + PG8_SA(b, h) + aoff + m * 2048 + k * 1024); } while (0)
#define PG8_LDB(dst, b, h) do { _Pragma("unroll") for (int n = 0; n < 2; ++n) _Pragma("unroll") for (int k = 0; k < 2; ++k) dst[n][k] = *(const LAS bf16x8*)(lds + PG8_SB(b, h) + boff + n * 2048 + k * 1024); } while (0)
#define PG8_MMA(ai, bj, At, Bt) do { __builtin_amdgcn_s_setprio(1); _Pragma("unroll") for (int m = 0; m < 4; ++m) _Pragma("unroll") for (int n = 0; n < 2; ++n) _Pragma("unroll") for (int k = 0; k < 2; ++k) \
        acc[ai][bj][m][n] = __builtin_amdgcn_mfma_f32_16x16x32_bf16(Bt[n][k], At[m][k], acc[ai][bj][m][n], 0, 0, 0); __builtin_amdgcn_s_setprio(0); } while (0)
#define PG8_WAIT_V(n) asm volatile("s_waitcnt vmcnt(" #n ")" ::: "memory")
#define PG8_WAIT_L(n) asm volatile("s_waitcnt lgkmcnt(" #n ")" ::: "memory")
#define PG8_BAR __builtin_amdgcn_s_barrier()
#define PG8_SCHED __builtin_amdgcn_sched_barrier(0)
#define PG8_GIDX(dst, u) do { _Pragma("unroll") for (int h = 0; h < 2; ++h) _Pragma("unroll") for (int i = 0; i < 2; ++i) { \
        const int _lr = (u).lr0 + h * HALF + rA[i]; const int _tok = (_lr < (u).cnt) ? g.gidx[(u).e * 16384 + _lr] : 0; dst[h][i] = (unsigned)_tok * (unsigned)(K * 2) + voffA[i]; } } while (0)
    Unit cur, nxt; int ui = 0;
    if (!S.next(0, cur)) return;
    f32x4 acc[2][2][4][2];
#pragma unroll
    for (int a = 0; a < 2; ++a)
#pragma unroll
        for (int b = 0; b < 2; ++b)
#pragma unroll
            for (int m = 0; m < 4; ++m)
#pragma unroll
                for (int n = 0; n < 2; ++n) acc[a][b][m][n] = (f32x4){0.f, 0.f, 0.f, 0.f};
    bf16x8 At[4][2], B0[2][2], B1[2][2];
    unsigned cG[2][2] = {{0u, 0u}, {0u, 0u}}, nG[2][2] = {{0u, 0u}, {0u, 0u}};
    const char* cA = (const char*)g.A + (size_t)cur.pm * tstep; const char* cB = (const char*)g.Bt + ((size_t)cur.e * g.b_estride) * 2 + (size_t)cur.pn * tstep;
    const char* nA = cA;
    if constexpr (GATHER) { PG8_GIDX(cG, cur); }
    PG8_STAGE(PG8_SB(0, 0), cB, voffB); PG8_STAGE(PG8_SB(0, 1), cB + hstep, voffB); PG8_STAGE_A(PG8_SA(0, 0), false, 0, 0); PG8_STAGE_A(PG8_SA(0, 1), false, 1, 0);
    if (wr == 1) PG8_BAR;
    PG8_WAIT_V(2); PG8_BAR;
    PG8_STAGE(PG8_SB(1, 0), cB + kstep, voffB); PG8_STAGE_A(PG8_SA(1, 0), false, 0, 1); PG8_STAGE(PG8_SB(1, 1), cB + hstep + kstep, voffB);
    PG8_WAIT_V(6); PG8_BAR;
    for (;;) {
        const bool has_next = S.next(ui + 1, nxt);
        nA = has_next ? (const char*)g.A + (size_t)nxt.pm * tstep : cA;
        const char* nB = has_next ? (const char*)g.Bt + ((size_t)nxt.e * g.b_estride) * 2 + (size_t)nxt.pn * tstep : cB;
        if constexpr (GATHER) { if (has_next) { PG8_GIDX(nG, nxt); } else {
#pragma unroll
            for (int h = 0; h < 2; ++h)
#pragma unroll
                for (int i = 0; i < 2; ++i) nG[h][i] = cG[h][i]; } }
        for (int t = 0; t < nt; t += 2) {
            const bool last = (t == nt - 2);
            const int kt2 = last ? 0 : t + 2, kt3 = kt2 + 1;
            const char* b2 = last ? nB : cB + (size_t)(t + 2) * kstep;
            const char* b3 = b2 + kstep;
            PG8_LDB(B0, 0, 0); PG8_LDB(B1, 0, 1); PG8_SCHED; PG8_LDA(At, 0, 0); PG8_STAGE_A(PG8_SA(1, 1), false, 1, t + 1);
            PG8_WAIT_V(8); PG8_WAIT_L(0); PG8_BAR; PG8_MMA(0, 0, At, B0); PG8_MMA(0, 1, At, B1); PG8_BAR; PG8_SCHED;
            PG8_LDA(At, 0, 1); PG8_STAGE(PG8_SB(0, 0), b2, voffB); PG8_STAGE(PG8_SB(0, 1), b2 + hstep, voffB); PG8_STAGE_A(PG8_SA(0, 0), last, 0, kt2);
            PG8_WAIT_V(8); PG8_WAIT_L(0); PG8_BAR; PG8_MMA(1, 0, At, B0); PG8_MMA(1, 1, At, B1); PG8_BAR; PG8_SCHED;
            PG8_LDB(B0, 1, 0); PG8_LDB(B1, 1, 1); PG8_SCHED; PG8_LDA(At, 1, 0); PG8_STAGE_A(PG8_SA(0, 1), last, 1, kt2);
            PG8_WAIT_V(8); PG8_WAIT_L(0); PG8_BAR; PG8_MMA(0, 0, At, B0); PG8_MMA(0, 1, At, B1); PG8_BAR; PG8_SCHED;
            PG8_LDA(At, 1, 1); PG8_STAGE(PG8_SB(1, 0), b3, voffB); PG8_STAGE(PG8_SB(1, 1), b3 + hstep, voffB); PG8_STAGE_A(PG8_SA(1, 0), last, 0, kt3);
            PG8_WAIT_V(8); PG8_WAIT_L(0); PG8_BAR; PG8_MMA(1, 0, At, B0); PG8_MMA(1, 1, At, B1); PG8_BAR; PG8_SCHED;
        }
        if (wr == 0) PG8_BAR;
        { Unit eu = cur; asm volatile("" : "+s"(eu.pm), "+s"(eu.pn));
          E(acc, eu, wr, wc, fr, fq); }
        if (!has_next) break;
#pragma unroll
        for (int a = 0; a < 2; ++a)
#pragma unroll
            for (int b = 0; b < 2; ++b)
#pragma unroll
                for (int m = 0; m < 4; ++m)
#pragma unroll
                    for (int n = 0; n < 2; ++n) acc[a][b][m][n] = (f32x4){0.f, 0.f, 0.f, 0.f};
        cur = nxt; cA = nA; cB = nB; ++ui;
        if constexpr (GATHER) {
#pragma unroll
            for (int h = 0; h < 2; ++h)
#pragma unroll
                for (int i = 0; i < 2; ++i) cG[h][i] = nG[h][i]; }
        if (wr == 1) PG8_BAR;
    }
    PG8_WAIT_V(0);
    PG8_BAR;
#undef PG8_SA
#undef PG8_SB
#undef PG8_STAGE
#undef PG8_STAGE2
#undef PG8_STAGE_A
#undef PG8_LDA
#undef PG8_LDB
#undef PG8_MMA
#undef PG8_WAIT_V
#undef PG8_WAIT_L
#undef PG8_BAR
#undef PG8_SCHED
#undef PG8_GIDX
}
}
namespace pg8 {
constexpr float QA_SCALE = 0.125f * 1.4426950408889634f;
constexpr float QB_SCALE = 0.125f;

struct EpiInProj {
    static constexpr bool PERM = true;
    bf16_t* base;
    __device__ __forceinline__ void operator()(const f32x4 (&acc)[2][2][4][2], const Unit& u, int wr, int wc, int fr, int fq) const {
        const int pn = u.pn;
        size_t toff; int ld, ct; float sc = 1.f; int act = 0;
        constexpr size_t Mi = 1u << 20;
        if (pn < 2)       { toff = 16 * Mi; ld = 512; ct = pn; sc = QA_SCALE; }
        else if (pn < 4)  { toff = 24 * Mi; ld = 512; ct = pn - 2; }
        else if (pn < 6)  { toff = 32 * Mi; ld = 512; ct = pn - 4; }
        else if (pn < 7)  { toff = 0; ld = 256; ct = 0; sc = QB_SCALE; }
        else if (pn < 8)  { toff = 4 * Mi; ld = 256; ct = 0; }
        else if (pn < 10) { toff = 8 * Mi; ld = 512; ct = pn - 8; }
        else if (pn < 12) { toff = 40 * Mi; ld = 512; ct = pn - 10; act = 1; }
        else if (pn < 16) { toff = 48 * Mi; ld = 1024; ct = pn - 12; act = 2; }
        else              { toff = 64 * Mi; ld = 1024; ct = pn - 16; act = 2; }
        const int row0 = u.pm * BM + wr * 64 + fr, col0 = ct * BM + wc * 32 + 8 * fq;
        bf16_t* O = base + toff;
#pragma unroll
        for (int ai = 0; ai < 2; ++ai)
#pragma unroll
            for (int m = 0; m < 4; ++m) { bf16_t* rowp = O + (size_t)(row0 + ai * HALF + m * 16) * ld + col0;
#pragma unroll
                for (int bj = 0; bj < 2; ++bj) { f32x4 v0 = acc[ai][bj][m][0] * sc, v1 = acc[ai][bj][m][1] * sc;
                    if (act) {
#pragma unroll
                        for (int j = 0; j < 4; ++j) { const float s0 = fast_sigmoid(v0[j]), s1 = fast_sigmoid(v1[j]); v0[j] = (act == 1) ? v0[j] * s0 : s0; v1[j] = (act == 1) ? v1[j] * s1 : s1; } }
                    u32x4 w; w.x = cvt_pk_bf16(v0[0], v0[1]); w.y = cvt_pk_bf16(v0[2], v0[3]); w.z = cvt_pk_bf16(v1[0], v1[1]); w.w = cvt_pk_bf16(v1[2], v1[3]);
                    *(u32x4*)(rowp + bj * HALF) = w; } }
    }
};

template <int MODE> struct EpiEw {
    static constexpr bool PERM = true;
    bf16_t* O; const bf16_t* G; int ldc;
    __device__ __forceinline__ void operator()(const f32x4 (&acc)[2][2][4][2], const Unit& u, int wr, int wc, int fr, int fq) const {
        const int row0 = u.pm * BM + wr * 64 + fr, col0 = u.pn * BM + wc * 32 + 8 * fq;
#pragma unroll
        for (int ai = 0; ai < 2; ++ai)
#pragma unroll
            for (int m = 0; m < 4; ++m) { const size_t ro = (size_t)(row0 + ai * HALF + m * 16) * ldc + col0;
#pragma unroll
                for (int bj = 0; bj < 2; ++bj) { f32x4 v0 = acc[ai][bj][m][0], v1 = acc[ai][bj][m][1];
                    if (MODE == 1 || MODE == 2) { const u32x4 gw = *(const u32x4*)(G + ro + bj * HALF);
                        v0[0] *= bf_lo(gw.x); v0[1] *= bf_hi(gw.x); v0[2] *= bf_lo(gw.y); v0[3] *= bf_hi(gw.y); v1[0] *= bf_lo(gw.z); v1[1] *= bf_hi(gw.z); v1[2] *= bf_lo(gw.w); v1[3] *= bf_hi(gw.w); }
                    if (MODE == 3) {
#pragma unroll
                        for (int j = 0; j < 4; ++j) { v0[j] = fast_sigmoid(v0[j]); v1[j] = fast_sigmoid(v1[j]); } }
                    if (MODE == 2 || MODE == 4) { const u32x4 ow = *(const u32x4*)(O + ro + bj * HALF);
                        if (MODE == 2) { v0[0] += bf_lo(ow.x); v0[1] += bf_hi(ow.x); v0[2] += bf_lo(ow.y); v0[3] += bf_hi(ow.y); v1[0] += bf_lo(ow.z); v1[1] += bf_hi(ow.z); v1[2] += bf_lo(ow.w); v1[3] += bf_hi(ow.w); }
                        else { v0[0] *= bf_lo(ow.x); v0[1] *= bf_hi(ow.x); v0[2] *= bf_lo(ow.y); v0[3] *= bf_hi(ow.y); v1[0] *= bf_lo(ow.z); v1[1] *= bf_hi(ow.z); v1[2] *= bf_lo(ow.w); v1[3] *= bf_hi(ow.w); } }
                    u32x4 w; w.x = cvt_pk_bf16(v0[0], v0[1]); w.y = cvt_pk_bf16(v0[2], v0[3]); w.z = cvt_pk_bf16(v1[0], v1[1]); w.w = cvt_pk_bf16(v1[2], v1[3]);
                    *(u32x4*)(O + ro + bj * HALF) = w; } }
    }
};

struct EpiGateUp {
    static constexpr bool PERM = true;
    bf16_t* O; int ldc;
    __device__ __forceinline__ void operator()(const f32x4 (&acc)[2][2][4][2], const Unit& u, int wr, int wc, int fr, int fq) const {
        const int row0 = u.pm * BM + wr * 64 + fr, col0 = u.pn * HALF + wc * 32 + 8 * fq;
#pragma unroll
        for (int ai = 0; ai < 2; ++ai)
#pragma unroll
            for (int m = 0; m < 4; ++m) { bf16_t* rowp = O + (size_t)(row0 + ai * HALF + m * 16) * ldc + col0;
                f32x4 v0, v1;
#pragma unroll
                for (int j = 0; j < 4; ++j) { const float g0 = acc[ai][0][m][0][j], g1 = acc[ai][0][m][1][j];
                    v0[j] = g0 * fast_sigmoid(g0) * acc[ai][1][m][0][j]; v1[j] = g1 * fast_sigmoid(g1) * acc[ai][1][m][1][j]; }
                u32x4 w; w.x = cvt_pk_bf16(v0[0], v0[1]); w.y = cvt_pk_bf16(v0[2], v0[3]); w.z = cvt_pk_bf16(v1[0], v1[1]); w.w = cvt_pk_bf16(v1[2], v1[3]);
                *(u32x4*)rowp = w; }
    }
};
}
constexpr int D = 1024, NB = 8, SEQ = 2048, T = NB * SEQ, DEPTH = 2, CH = 64, NCH = SEQ / CH, NPREV = 8;
constexpr int AH = 8, BH = 4, GR = 16, DFF = 2816, NE = 8, DFE = 3584, PLE = 256, INW = 5136, INWG = 5120, RELN = 257;
constexpr float EPS = 1e-6f, LOG2E = 1.4426950408889634f;
constexpr int NWAVES = 8, NTHR = 512;
constexpr int MOE_ROWS = 34816;

constexpr size_t MiB = 1u << 20;
constexpr size_t WS_CTL = 0, CTL_ZERO_BYTES = 256 * 1024;
constexpr size_t WS_TOKINFO = 1 * MiB;
constexpr size_t WS_IDXE = 2 * MiB;
constexpr size_t WS_DEC = 3 * MiB;
constexpr size_t WS_W1 = 4 * MiB;
constexpr size_t WS_PB = 189 * MiB;
constexpr size_t WS_G = 205 * MiB;
constexpr size_t WS_HB = WS_G, WS_DST = WS_G + 32 * MiB, WS_YSLOT = WS_G;
constexpr size_t WS_BIG = 273 * MiB;
constexpr size_t WS_W0 = WS_BIG, WS_PROJ = WS_BIG + 34 * MiB, WS_MACT = WS_BIG;
constexpr size_t WS_Y = WS_PROJ;
constexpr size_t WS_QB = WS_PROJ, WS_KB = WS_PROJ + 8 * MiB, WS_VB = WS_PROJ + 16 * MiB, WS_QA = WS_PROJ + 32 * MiB, WS_KA = WS_PROJ + 48 * MiB, WS_VA = WS_PROJ + 64 * MiB;
constexpr size_t WS_SR = WS_PROJ + 80 * MiB, WS_SGA = WS_PROJ + 96 * MiB, WS_SGB = WS_PROJ + 128 * MiB;
constexpr size_t WS_MERGED = WS_KA;
constexpr size_t WS_ST = WS_KA;
constexpr size_t WS_FACT = WS_QA;
constexpr size_t WS_YA = WS_PROJ + 160 * MiB, WS_YB = WS_PROJ + 176 * MiB;
constexpr size_t WS_XB = WS_SGB;
constexpr size_t WS_END = 511 * MiB;
static_assert(WS_FACT + (size_t)T * DFF * 2 <= WS_XB && WS_MACT + (size_t)MOE_ROWS * DFE * 2 <= WS_END && WS_YSLOT + (size_t)MOE_ROWS * D * 2 <= WS_BIG && WS_SGB + 32 * MiB <= WS_YA && WS_YB + 16 * MiB <= WS_END, "d_ws map");
constexpr size_t OFF_WIN = 0, OFF_WGD = 10 * MiB, OFF_WBA = 10 * MiB + 65536, OFF_WBB = OFF_WBA + 1 * MiB, OFF_WOUT = OFF_WBB + 1 * MiB, OFF_WPP = OFF_WOUT + 2 * MiB, OFF_WPG = OFF_WPP + MiB / 2;
constexpr size_t OFF_FFN = 17 * MiB;
constexpr size_t OFF_FDN = OFF_FFN + 11 * MiB, OFF_MDN = OFF_FFN + 8 * 14 * MiB;
static_assert(OFF_WPG + 2 * MiB <= OFF_FFN && WS_W1 + OFF_MDN + 8 * 7 * MiB <= WS_PB && OFF_FDN + (size_t)D * DFF * 2 <= 34 * MiB, "weight map");
constexpr int CW_BAR = 4096;
constexpr int CW_CNT = 8192;
constexpr int CW_DBG = 16384;

constexpr int RING_BYTES = 131072;
constexpr int LDSCTL_OFF = RING_BYTES, MISC_OFF = LDSCTL_OFF + 320;
constexpr int XTRA_OFF = RING_BYTES + 1024;
constexpr int LDS_BYTES = 147456;

typedef GAS unsigned gu32;
#define RLX_AGENT __ATOMIC_RELAXED, __HIP_MEMORY_SCOPE_AGENT
#define LDS_WAIT() asm volatile("s_waitcnt lgkmcnt(0)" ::: "memory")
#define VM_WAIT() asm volatile("s_waitcnt vmcnt(0)" ::: "memory")

#define XB_TMO      128
#define XB_XCNT(j)  (256  + 64 * (j))
#define XB_XSUB(j)  (1280 + 64 * (j))
#define XB_XGEN(j)  (2304 + 64 * (j))
#define XB_TOP      3328
#define XB_TOPGEN   3392
#define XCD_BAR_WORDS 3456
#define XB_SPIN_CAP (1u << 18)
__device__ __forceinline__ unsigned xb_ld(unsigned* p)              { return __hip_atomic_load(p, __ATOMIC_RELAXED, __HIP_MEMORY_SCOPE_AGENT); }
__device__ __forceinline__ unsigned xb_add(unsigned* p, unsigned v) { return __hip_atomic_fetch_add(p, v, __ATOMIC_RELAXED, __HIP_MEMORY_SCOPE_AGENT); }
__device__ __forceinline__ unsigned xb_xcc_id() { return (unsigned)__builtin_amdgcn_s_getreg((3 << 11) | 20) & 0xFu; }
#define XB_SPIN(cond, bar) do { unsigned _sp = 0; while (cond) { __builtin_amdgcn_s_sleep(1); \
    if ((++_sp & 255u) == 0u) { if (xb_ld(&(bar)[XB_TMO])) break; if (_sp > XB_SPIN_CAP) { atomicAdd(&(bar)[XB_TMO], 1u); break; } } } } while (0)
struct XcdBarrier { unsigned* bar; unsigned x; volatile LAS unsigned* st; };
__device__ __forceinline__ XcdBarrier xcd_barrier_post(unsigned* bar, volatile LAS unsigned* st) {
    XcdBarrier b; b.bar = bar; b.x = xb_xcc_id(); b.st = st;
    if (threadIdx.x == 0) (void)xb_add(&bar[XB_XCNT(b.x)], 1u);
    return b;
}
__device__ __forceinline__ void xcd_barrier_complete(unsigned* bar, unsigned x, unsigned& nloc, unsigned& nx) {
    const unsigned G = gridDim.x * gridDim.y * gridDim.z;
    unsigned sum, cnt, mine, sp = 0u;
    for (;;) {
        sum = 0u; cnt = 0u; mine = 0u;
#pragma unroll
        for (unsigned j = 0; j < 16; ++j) { const unsigned c = xb_ld(&bar[XB_XCNT(j)]); sum += c; cnt += (c > 0u) ? 1u : 0u; mine = (j == x) ? c : mine; }
        if (sum == G) break;
        __builtin_amdgcn_s_sleep(1);
        if ((++sp & 255u) == 0u) { if (xb_ld(&bar[XB_TMO])) break; if (sp > XB_SPIN_CAP) { atomicAdd(&bar[XB_TMO], 1u); break; } }
    }
    nloc = mine > 0u ? mine : 1u; nx = cnt > 0u ? cnt : 1u;
}
__device__ __forceinline__ void xcd_barrier(const XcdBarrier& b) {
    asm volatile("s_waitcnt vmcnt(0)" ::: "memory");
    __syncthreads();
    if (threadIdx.x == 0) {
        unsigned* bar = b.bar;
        __builtin_amdgcn_s_waitcnt(0);
        unsigned nloc = b.st[0], nx = b.st[1];
        if (nloc == 0u) { xcd_barrier_complete(bar, b.x, nloc, nx); b.st[0] = nloc; b.st[1] = nx; }
        const unsigned old = xb_add(&bar[XB_XSUB(b.x)], 1u);
        const unsigned gen = old / nloc;
        if (old + 1u == (gen + 1u) * nloc) {
            __builtin_amdgcn_fence(__ATOMIC_RELEASE, "agent");
            asm volatile("s_waitcnt vmcnt(0)" ::: "memory");
            const unsigned og = xb_add(&bar[XB_TOP], 1u);
            const unsigned tg = og / nx;
            if (og + 1u == (tg + 1u) * nx) xb_add(&bar[XB_TOPGEN], 1u);
            else XB_SPIN(xb_ld(&bar[XB_TOPGEN]) == tg, bar);
            __builtin_amdgcn_fence(__ATOMIC_ACQUIRE, "agent");
            xb_add(&bar[XB_XGEN(b.x)], 1u);
            asm volatile("s_waitcnt vmcnt(0)" ::: "memory");
        } else {
            XB_SPIN(xb_ld(&bar[XB_XGEN(b.x)]) == gen, bar);
            __builtin_amdgcn_fence(__ATOMIC_ACQUIRE, "agent");
            asm volatile("s_waitcnt vmcnt(0)" ::: "memory");
        }
    }
    __syncthreads();
}

struct Args { const float* in[24]; float* out; unsigned char* ws; int ph_lo, ph_hi, sub, pad; };
enum { I_X = 0, I_P, I_WIN, I_RELB, I_WGUP, I_BG, I_GNORM, I_WBA, I_WBB, I_WOUT, I_NMPRE, I_NMPOST, I_NFPRE, I_NFPOST, I_FG, I_FU, I_FD, I_RW, I_MG, I_MU, I_MD, I_PP, I_PG, I_PNORM };
#define FRESH(F) do { int _t = threadIdx.x; asm volatile("" : "+v"(_t)); (F).tid = _t; (F).lane = _t & 63; (F).wave = __builtin_amdgcn_readfirstlane(_t >> 6); } while (0)
struct Frame {
    LAS unsigned char* lds;
    volatile LAS unsigned* MISC;
    gu32* ctl;
    unsigned char* ws;
    int tid, lane, wave;
    int vcu, G;
    float* x;
};

__device__ __forceinline__ float sumsq16(const f32x4 (&v)[4]) {
    float s = 0.f;
#pragma unroll
    for (int j = 0; j < 4; ++j) s += (v[j].x * v[j].x + v[j].y * v[j].y) + (v[j].z * v[j].z + v[j].w * v[j].w);
    return wave_sum(s);
}
__device__ __forceinline__ void ld_bf16_row(const bf16_t* row, int lane, f32x4 (&v)[4]) {
#pragma unroll
    for (int j = 0; j < 4; ++j) { const u32x2 w = ((const u32x2*)row)[lane + 64 * j]; v[j] = (f32x4){bf_lo(w.x), bf_hi(w.x), bf_lo(w.y), bf_hi(w.y)}; }
}
__device__ __forceinline__ void st_bf16_row(bf16_t* row, int lane, const f32x4 (&v)[4]) {
#pragma unroll
    for (int j = 0; j < 4; ++j) { u32x2 w; w.x = cvt_pk_bf16(v[j].x, v[j].y); w.y = cvt_pk_bf16(v[j].z, v[j].w); ((u32x2*)row)[lane + 64 * j] = w; }
}
template <int SRC, int OUT, bool ROUTE>
__device__ __forceinline__ void thin_phase(Frame& F, const float* xin, const bf16_t* ysrc, const float* g_add, const float* g_out, bf16_t* obuf, const float* router_w) {
    FRESH(F);
    const int lane = F.lane;
    unsigned* tokinfo = (unsigned*)(F.ws + WS_TOKINFO);
    int* idxe = (int*)(F.ws + WS_IDXE);
    unsigned* gcnt = (unsigned*)(F.ctl + CW_CNT);
    LAS float* rwT = (LAS float*)(F.lds);
    LAS unsigned* lcnt = (LAS unsigned*)(F.lds + 32768);
    LAS unsigned* rinfo = (LAS unsigned*)(F.lds + 32768 + 64);
    if constexpr (ROUTE) {
        for (int i = F.tid; i < D * NE; i += NTHR) rwT[(i & 7) * D + (i >> 3)] = router_w[i];
        if (F.tid < 16) lcnt[F.tid] = 0u;
        __syncthreads();
    }
    int pbase[8];
    if constexpr (SRC == 2) { int acc = 0;
#pragma unroll
        for (int e = 0; e < 8; ++e) { pbase[e] = acc; acc += (((int)gcnt[e] + 255) >> 8) << 8; } }
    f32x4 ga[4], go[4];
#pragma unroll
    for (int j = 0; j < 4; ++j) { ga[j] = (SRC != 0) ? ((const f32x4*)g_add)[lane + 64 * j] : (f32x4){0.f, 0.f, 0.f, 0.f}; go[j] = (OUT == 1) ? ((const f32x4*)g_out)[lane + 64 * j] : (f32x4){0.f, 0.f, 0.f, 0.f}; }
    const int gw = F.vcu * NWAVES + F.wave, NGW = F.G * NWAVES;
    int rs = 0;
    for (int m = gw; m < T; m += NGW, ++rs) {
        f32x4 xv[4];
        if constexpr (SRC == 0) {
#pragma unroll
            for (int j = 0; j < 4; ++j) xv[j] = ((const f32x4*)(xin + (size_t)m * D))[lane + 64 * j];
        } else {
            f32x4 yv[4];
            if constexpr (SRC == 1) ld_bf16_row(ysrc + (size_t)m * D, lane, yv);
            else {
                const unsigned* ti = tokinfo + (size_t)m * 8;
                const int e1 = (int)ti[0], p1 = (int)ti[1], e2 = (int)ti[2], p2 = (int)ti[3]; const float w1 = __uint_as_float(ti[4]), w2 = __uint_as_float(ti[5]);
                int b1 = 0, b2 = 0;
#pragma unroll
                for (int e = 0; e < 8; ++e) { b1 = (e == e1) ? pbase[e] : b1; b2 = (e == e2) ? pbase[e] : b2; }
                f32x4 ya[4], yb[4];
                ld_bf16_row(ysrc + (size_t)(b1 + p1) * D, lane, ya); ld_bf16_row(ysrc + (size_t)(b2 + p2) * D, lane, yb);
#pragma unroll
                for (int j = 0; j < 4; ++j) yv[j] = ya[j] * w1 + yb[j] * w2;
            }
            const float rstd = __builtin_amdgcn_rsqf(sumsq16(yv) * (1.f / D) + EPS);
#pragma unroll
            for (int j = 0; j < 4; ++j) { const f32x4 xo = ((const f32x4*)(F.x + (size_t)m * D))[lane + 64 * j]; xv[j] = xo + yv[j] * rstd * ga[j]; }
        }
#pragma unroll
        for (int j = 0; j < 4; ++j) ((f32x4*)(F.x + (size_t)m * D))[lane + 64 * j] = xv[j];
        if constexpr (OUT == 1) {
            const float rstd = __builtin_amdgcn_rsqf(sumsq16(xv) * (1.f / D) + EPS);
            f32x4 hv[4];
#pragma unroll
            for (int j = 0; j < 4; ++j) hv[j] = xv[j] * rstd * go[j];
            st_bf16_row(obuf + (size_t)m * D, lane, hv);
            if constexpr (ROUTE) {
                float lg[8];
#pragma unroll
                for (int e = 0; e < 8; ++e) { float s = 0.f;
#pragma unroll
                    for (int j = 0; j < 4; ++j) { const f32x4 w = *(const LAS f32x4*)(rwT + e * D + 4 * lane + 256 * j); s += (hv[j].x * w.x + hv[j].y * w.y) + (hv[j].z * w.z + hv[j].w * w.w); }
                    lg[e] = wave_sum(s); }
                int e1 = 0; float v1 = lg[0];
#pragma unroll
                for (int e = 1; e < 8; ++e) if (lg[e] > v1) { v1 = lg[e]; e1 = e; }
                int e2 = -1; float v2 = -3.0e38f;
#pragma unroll
                for (int e = 0; e < 8; ++e) if (e != e1 && lg[e] > v2) { v2 = lg[e]; e2 = e; }
                const float ex = __expf(v2 - v1), w1 = 1.f / (1.f + ex), w2 = ex * w1;
                if (lane == 0) {
                    const unsigned p1 = atomicAdd((unsigned*)&lcnt[e1], 1u), p2 = atomicAdd((unsigned*)&lcnt[e2], 1u);
                    LAS unsigned* ri = rinfo + (F.wave * 8 + rs) * 6;
                    ri[0] = (unsigned)e1; ri[1] = p1; ri[2] = (unsigned)e2; ri[3] = p2; ri[4] = __float_as_uint(w1); ri[5] = __float_as_uint(w2);
                }
            }
        } else if constexpr (OUT == 2) {
            st_bf16_row(obuf + (size_t)m * D, lane, xv);
        }
    }
    if constexpr (ROUTE) {
        __syncthreads();
        if (F.tid < 8) lcnt[8 + F.tid] = __hip_atomic_fetch_add(gcnt + F.tid, lcnt[F.tid], RLX_AGENT);
        __syncthreads();
        if (lane < rs) {
            const int m = gw + lane * NGW; const LAS unsigned* ri = rinfo + (F.wave * 8 + lane) * 6;
            const unsigned e1 = ri[0], e2 = ri[2]; const unsigned p1 = ri[1] + lcnt[8 + e1], p2 = ri[3] + lcnt[8 + e2];
            unsigned* ti = tokinfo + (size_t)m * 8; ti[0] = e1; ti[1] = p1; ti[2] = e2; ti[3] = p2; ti[4] = ri[4]; ti[5] = ri[5];
            idxe[e1 * 16384 + p1] = m; idxe[e2 * 16384 + p2] = m;
        }
    }
}
struct TrItem { const float* src; int pitch; bf16_t* dst; int dstK; int ncols; };
__device__ __forceinline__ void tr_item(const TrItem& t, LAS float* scr, int lane) {
    const int c = lane & 31;
    float v[32];
#pragma unroll
    for (int i = 0; i < 32; ++i) { const int kk = 2 * i + (lane >> 5); v[i] = (c < t.ncols) ? t.src[(size_t)kk * t.pitch + c] : 0.f; }
#pragma unroll
    for (int i = 0; i < 32; ++i) { const int kk = 2 * i + (lane >> 5); scr[kk * 33 + c] = v[i]; }
    LDS_WAIT(); asm volatile("" ::: "memory");
    const int c8 = lane & 7;
#pragma unroll
    for (int j = 0; j < 4; ++j) { const int n = (lane >> 3) + 8 * j; const LAS float* s = scr + (8 * c8) * 33 + n;
        u32x4 o; o.x = cvt_pk_bf16(s[0 * 33], s[1 * 33]); o.y = cvt_pk_bf16(s[2 * 33], s[3 * 33]); o.z = cvt_pk_bf16(s[4 * 33], s[5 * 33]); o.w = cvt_pk_bf16(s[6 * 33], s[7 * 33]);
        if (n < t.ncols) *(u32x4*)(t.dst + (size_t)n * t.dstK + 8 * c8) = o; }
    LDS_WAIT(); asm volatile("" ::: "memory");
}
constexpr int IT_COMMON = 1280 + 1280 + 16 + 256 + 256 + 512 + 128 + 512;
constexpr int IT_FFN = 3 * 1408, IT_MOE1 = 8 * 1792;
constexpr int IT_TOTAL = 2 * IT_COMMON + IT_FFN + 3 * IT_MOE1;
__device__ __forceinline__ TrItem seg_plain(const float* src, int K, int N, int pitch, bf16_t* dst, int r) {
    const int nblk = N / 32, kb = r / nblk, nb = r % nblk;
    return TrItem{src + (size_t)kb * 64 * pitch + nb * 32, pitch, dst + (size_t)(nb * 32) * K + kb * 64, K, 32};
}
__device__ __forceinline__ TrItem seg_gu(const float* src, int N, bf16_t* dst, int up, int r) {
    const int nblk = N / 32, kb = r / nblk, nb = r % nblk, n0 = nb * 32;
    return TrItem{src + (size_t)kb * 64 * N + n0, N, dst + (size_t)((n0 >> 7) * 256 + (n0 & 127) + up * 128) * D + kb * 64, D, 32};
}
__device__ __forceinline__ TrItem decode_item(const Args& a, unsigned char* ws, int it) {
    if (it < 2 * IT_COMMON) {
        const int l = it / IT_COMMON; int r = it % IT_COMMON; unsigned char* wb = ws + (l ? WS_W1 : WS_W0);
        const float* win = a.in[I_WIN] + (size_t)l * D * INW;
        if (r < 1280) return seg_plain(win, D, 2560, INW, (bf16_t*)(wb + OFF_WIN), r); r -= 1280;
        if (r < 1280) return seg_plain(win + 2576, D, 2560, INW, (bf16_t*)(wb + OFF_WIN) + (size_t)2560 * D, r); r -= 1280;
        if (r < 16) return TrItem{win + (size_t)r * 64 * INW + 2560, INW, (bf16_t*)(wb + OFF_WGD) + r * 64, D, 16}; r -= 16;
        if (r < 256) return seg_plain(a.in[I_WBA] + (size_t)l * 512 * D, 512, D, D, (bf16_t*)(wb + OFF_WBA), r); r -= 256;
        if (r < 256) return seg_plain(a.in[I_WBB] + (size_t)l * 512 * D, 512, D, D, (bf16_t*)(wb + OFF_WBB), r); r -= 256;
        if (r < 512) return seg_plain(a.in[I_WOUT] + (size_t)l * D * D, D, D, D, (bf16_t*)(wb + OFF_WOUT), r); r -= 512;
        if (r < 128) return seg_plain(a.in[I_PP] + (size_t)l * PLE * D, PLE, D, D, (bf16_t*)(wb + OFF_WPP), r); r -= 128;
        return seg_plain(a.in[I_PG] + (size_t)l * D * D, D, D, D, (bf16_t*)(wb + OFF_WPG), r);
    }
    it -= 2 * IT_COMMON;
    if (it < IT_FFN) {
        unsigned char* wb = ws + WS_W0;
        if (it < 1408) return seg_gu(a.in[I_FG], DFF, (bf16_t*)(wb + OFF_FFN), 0, it); it -= 1408;
        if (it < 1408) return seg_gu(a.in[I_FU], DFF, (bf16_t*)(wb + OFF_FFN), 1, it); it -= 1408;
        return seg_plain(a.in[I_FD], DFF, D, D, (bf16_t*)(wb + OFF_FDN), it);
    }
    it -= IT_FFN;
    unsigned char* wb = ws + WS_W1;
    const int kind = it / IT_MOE1, r0 = it % IT_MOE1, e = r0 / 1792, r = r0 % 1792;
    if (kind == 0) return seg_gu(a.in[I_MG] + (size_t)e * D * DFE, DFE, (bf16_t*)(wb + OFF_FFN) + (size_t)e * 7168 * D, 0, r);
    if (kind == 1) return seg_gu(a.in[I_MU] + (size_t)e * D * DFE, DFE, (bf16_t*)(wb + OFF_FFN) + (size_t)e * 7168 * D, 1, r);
    return seg_plain(a.in[I_MD] + (size_t)e * DFE * D, DFE, D, D, (bf16_t*)(wb + OFF_MDN) + (size_t)e * D * DFE, r);
}
__device__ __forceinline__ void p0_prologue(Frame& F, const Args& a) {
    FRESH(F);
    LAS float* scr = (LAS float*)(F.lds + F.wave * 16384);
    const int gw = F.vcu * NWAVES + F.wave, NGW = F.G * NWAVES;
    for (int it = gw; it < IT_TOTAL; it += NGW) { const TrItem t = decode_item(a, F.ws, it); tr_item(t, scr, F.lane); }
    { const f32x4* ps = (const f32x4*)a.in[I_P]; u32x4* pd = (u32x4*)(F.ws + WS_PB); const int n8 = 2 * T * PLE / 8;
      for (int i = blockIdx.x * NTHR + F.tid; i < n8; i += F.G * NTHR) { const f32x4 v0 = ps[2 * i], v1 = ps[2 * i + 1];
          u32x4 w; w.x = cvt_pk_bf16(v0.x, v0.y); w.y = cvt_pk_bf16(v0.z, v0.w); w.z = cvt_pk_bf16(v1.x, v1.y); w.w = cvt_pk_bf16(v1.z, v1.w); pd[i] = w; } }
    thin_phase<0, 1, false>(F, a.in[I_X], nullptr, nullptr, a.in[I_NMPRE], (bf16_t*)(F.ws + WS_HB), nullptr);
}
typedef short v4i16_t __attribute__((ext_vector_type(4)));
__device__ __forceinline__ s16x4 lds_tr16(const LAS unsigned char* p) { return __builtin_bit_cast(s16x4, __builtin_amdgcn_ds_read_tr16_b64_v4i16((LAS v4i16_t*)p)); }
__device__ __forceinline__ bf16x8 cat8(s16x4 a, s16x4 b) { return (bf16x8){a[0], a[1], a[2], a[3], b[0], b[1], b[2], b[3]}; }

__device__ __forceinline__ void attn_unit(Frame& F, int b, int c, const float* relb) {
    FRESH(F);
    const int lane = F.lane, h = F.wave, n = lane & 15, mq = lane >> 4;
    const bf16_t* qa = (const bf16_t*)(F.ws + WS_QA); const bf16_t* ka = (const bf16_t*)(F.ws + WS_KA); const bf16_t* va = (const bf16_t*)(F.ws + WS_VA);
    LAS unsigned char* kbuf = F.lds + h * 16384; LAS unsigned char* vbuf = kbuf + 8192;
    LAS float* tbl = (LAS float*)(F.lds + XTRA_OFF + h * 1056);
    for (int i = lane; i < RELN; i += 64) tbl[i] = relb[h * RELN + i] * LOG2E;
    const int tok0 = b * SEQ + c * CH;
    bf16x8 qf[4][2];
#pragma unroll
    for (int qt = 0; qt < 4; ++qt)
#pragma unroll
        for (int ks = 0; ks < 2; ++ks) qf[qt][ks] = *(const bf16x8*)(qa + (size_t)(tok0 + 16 * qt + n) * 512 + h * 64 + 32 * ks + 8 * mq);
    const int koff_e = (lane >> 3) * 512 + (((lane & 7) ^ ((lane >> 4) & 7)) * 8), koff_o = (lane >> 3) * 512 + (((lane & 7) ^ ((4 + (lane >> 4)) & 7)) * 8);
    const int voff = (lane >> 3) * 512 + ((2 * (((lane & 7) >> 1) ^ (lane >> 4)) + (lane & 1)) * 8);
#define ATT_DMA_K(j) do { const bf16_t* _s = ka + (size_t)(b * SEQ + (j) * CH) * 512 + h * 64; _Pragma("unroll") for (int _i = 0; _i < 8; ++_i) \
        __builtin_amdgcn_global_load_lds((const unsigned*)(_s + (size_t)_i * 8 * 512 + ((_i & 1) ? koff_o : koff_e)), (LAS unsigned*)(kbuf + _i * 1024), 16, 0, 0); } while (0)
#define ATT_DMA_V(j) do { const bf16_t* _s = va + (size_t)(b * SEQ + (j) * CH) * 512 + h * 64; _Pragma("unroll") for (int _i = 0; _i < 8; ++_i) \
        __builtin_amdgcn_global_load_lds((const unsigned*)(_s + (size_t)_i * 8 * 512 + voff), (LAS unsigned*)(vbuf + _i * 1024), 16, 0, 0); } while (0)
    const int ka0 = n * 128 + (((0 + mq) ^ (n >> 1)) * 16), ka1 = n * 128 + (((4 + mq) ^ (n >> 1)) * 16);
    const int qp = n >> 2, pp = lane & 3, sw = 2 * (mq & 1) + (qp >> 1);
    const int vrow = (4 * mq + qp) * 128 + 8 * pp;
    f32x4 O[4][4]; float mrun[4], lsum[4];
#pragma unroll
    for (int qt = 0; qt < 4; ++qt) { mrun[qt] = -1.0e30f; lsum[qt] = 0.f;
#pragma unroll
        for (int dt = 0; dt < 4; ++dt) O[qt][dt] = (f32x4){0.f, 0.f, 0.f, 0.f}; }
    const int j0 = (c - NPREV) > 0 ? (c - NPREV) : 0;
    ATT_DMA_K(j0); ATT_DMA_V(j0);
    for (int j = j0; j <= c; ++j) {
        const int dc = c - j;
        asm volatile("s_waitcnt vmcnt(8)" ::: "memory");
#pragma unroll
        for (int qg = 0; qg < 2; ++qg) {
            f32x4 S[4][2];
#pragma unroll
            for (int kt = 0; kt < 4; ++kt) {
                const bf16x8 k0 = *(const LAS bf16x8*)(kbuf + kt * 2048 + ka0), k1 = *(const LAS bf16x8*)(kbuf + kt * 2048 + ka1);
#pragma unroll
                for (int q2 = 0; q2 < 2; ++q2) { f32x4 z = (f32x4){0.f, 0.f, 0.f, 0.f};
                    z = __builtin_amdgcn_mfma_f32_16x16x32_bf16(k0, qf[2 * qg + q2][0], z, 0, 0, 0);
                    S[kt][q2] = __builtin_amdgcn_mfma_f32_16x16x32_bf16(k1, qf[2 * qg + q2][1], z, 0, 0, 0); }
            }
            if (qg == 1) { if (j < c) { LDS_WAIT(); ATT_DMA_K(j + 1); } }
            bf16x8 P[2][2];
#pragma unroll
            for (int q2 = 0; q2 < 2; ++q2) { const int qt = 2 * qg + q2;
                if (dc >= 3) { const float bf = tbl[256];
#pragma unroll
                    for (int kt = 0; kt < 4; ++kt) S[kt][q2] = S[kt][q2] + bf;
                } else {
#pragma unroll
                    for (int kt = 0; kt < 4; ++kt)
#pragma unroll
                        for (int i = 0; i < 4; ++i) { int idx = 64 * dc + 16 * (qt - kt) + n - 4 * mq - i; idx = (idx > 128 ? 128 : idx) + 128; S[kt][q2][i] += tbl[idx]; }
                }
                float cm = S[0][q2][0];
#pragma unroll
                for (int kt = 0; kt < 4; ++kt)
#pragma unroll
                    for (int i = 0; i < 4; ++i) cm = fmaxf(cm, S[kt][q2][i]);
                cm = fmaxf(cm, __shfl_xor(cm, 16)); cm = fmaxf(cm, __shfl_xor(cm, 32));
                const float mn = fmaxf(mrun[qt], cm), alpha = __builtin_amdgcn_exp2f(mrun[qt] - mn); mrun[qt] = mn;
                float ps = 0.f;
#pragma unroll
                for (int kt = 0; kt < 4; ++kt)
#pragma unroll
                    for (int i = 0; i < 4; ++i) { const float p = __builtin_amdgcn_exp2f(S[kt][q2][i] - mn); S[kt][q2][i] = p; ps += p; }
                lsum[qt] = lsum[qt] * alpha + ps;
#pragma unroll
                for (int dt = 0; dt < 4; ++dt) O[qt][dt] = O[qt][dt] * alpha;
#pragma unroll
                for (int u = 0; u < 2; ++u) { u32x4 w; w.x = cvt_pk_bf16(S[2 * u][q2][0], S[2 * u][q2][1]); w.y = cvt_pk_bf16(S[2 * u][q2][2], S[2 * u][q2][3]);
                    w.z = cvt_pk_bf16(S[2 * u + 1][q2][0], S[2 * u + 1][q2][1]); w.w = cvt_pk_bf16(S[2 * u + 1][q2][2], S[2 * u + 1][q2][3]); P[q2][u] = __builtin_bit_cast(bf16x8, w); }
            }
            if (qg == 0) asm volatile("s_waitcnt vmcnt(0)" ::: "memory");
#pragma unroll
            for (int dt = 0; dt < 4; ++dt)
#pragma unroll
                for (int u = 0; u < 2; ++u) {
                    const LAS unsigned char* vp = vbuf + vrow + (32 * u) * 128 + ((dt ^ sw) * 32);
                    const bf16x8 vf = cat8(lds_tr16(vp), lds_tr16(vp + 16 * 128));
#pragma unroll
                    for (int q2 = 0; q2 < 2; ++q2) O[2 * qg + q2][dt] = __builtin_amdgcn_mfma_f32_16x16x32_bf16(vf, P[q2][u], O[2 * qg + q2][dt], 0, 0, 0);
                }
            if (qg == 1) { if (j < c) { LDS_WAIT(); ATT_DMA_V(j + 1); } }
        }
    }
#undef ATT_DMA_K
#undef ATT_DMA_V
    bf16_t* ya = (bf16_t*)(F.ws + WS_YA);
#pragma unroll
    for (int qt = 0; qt < 4; ++qt) { float l = lsum[qt]; l += __shfl_xor(l, 16); l += __shfl_xor(l, 32); const float rl = __builtin_amdgcn_rcpf(l);
#pragma unroll
        for (int dt = 0; dt < 4; ++dt) { const f32x4 o = O[qt][dt] * rl; u32x2 w; w.x = cvt_pk_bf16(o[0], o[1]); w.y = cvt_pk_bf16(o[2], o[3]);
            *(u32x2*)(ya + (size_t)(tok0 + 16 * qt + n) * 512 + h * 64 + 16 * dt + 4 * mq) = w; } }
}

__device__ __forceinline__ void gla_dstate_unit(Frame& F, int b, int c, const bf16_t* wgd_t, const float* wup, const float* bgate) {
    FRESH(F);
    const int lane = F.lane, w = F.wave, tid = F.tid, n = lane & 15, mq = lane >> 4;
    const int tok0 = b * SEQ + c * CH;
    const bf16_t* hb = (const bf16_t*)(F.ws + WS_HB); const bf16_t* kb = (const bf16_t*)(F.ws + WS_KB); const bf16_t* vb = (const bf16_t*)(F.ws + WS_VB);
    LAS float* GD = (LAS float*)(F.lds); LAS unsigned char* VB = F.lds + 8192; LAS unsigned char* KD = F.lds + 73728; LAS float* TOT = (LAS float*)(F.lds + 106496);
    __syncthreads();
#pragma unroll
    for (int i = 0; i < 8; ++i) { const int p = (w * 8 + i) * 64 + lane, row = p >> 6, ch = p & 63;
        __builtin_amdgcn_global_load_lds((const unsigned*)(vb + (size_t)(tok0 + row) * 512 + ch * 8), (LAS unsigned*)(VB + (w * 8 + i) * 1024), 16, 0, 0); }
    { const int mt = w & 3, kh = w >> 2; f32x4 acc = (f32x4){0.f, 0.f, 0.f, 0.f};
      const bf16_t* ap = hb + (size_t)(tok0 + 16 * mt + n) * D + kh * 512 + 8 * mq; const bf16_t* bp = wgd_t + (size_t)n * D + kh * 512 + 8 * mq;
#pragma unroll 4
      for (int ks = 0; ks < 16; ++ks) acc = __builtin_amdgcn_mfma_f32_16x16x32_bf16(*(const bf16x8*)(ap + 32 * ks), *(const bf16x8*)(bp + 32 * ks), acc, 0, 0, 0);
#pragma unroll
      for (int i = 0; i < 4; ++i) GD[(kh * 64 + 16 * mt + 4 * mq + i) * 16 + n] = acc[i]; }
    __syncthreads();
    { const int col = tid & 255;
      const int hf = tid >> 8; float wu[16];
#pragma unroll
      for (int r = 0; r < 16; ++r) wu[r] = wup[r * 256 + col];
      const float bb = bgate[col]; float cum[32]; float run = 0.f;
#pragma unroll
      for (int l = 0; l < 32; ++l) { const int row = 32 * hf + l; float z = bb;
#pragma unroll
          for (int r4 = 0; r4 < 4; ++r4) { const f32x4 a = *(const LAS f32x4*)(GD + row * 16 + 4 * r4), a2 = *(const LAS f32x4*)(GD + (64 + row) * 16 + 4 * r4);
              z += (a.x + a2.x) * wu[4 * r4] + (a.y + a2.y) * wu[4 * r4 + 1] + (a.z + a2.z) * wu[4 * r4 + 2] + (a.w + a2.w) * wu[4 * r4 + 3]; }
          const float la = (fminf(z, 0.f) - __logf(1.f + __expf(-fabsf(z)))) * (1.f / 16.f);
          run += la; cum[l] = run; }
      LAS float* TOT1 = TOT + 256;
      if (hf == 0) TOT[col] = run;
      __syncthreads();
      const float tot = (hf == 1) ? TOT[col] : 0.f;
      if (hf == 1) TOT1[col] = run + tot;
      __syncthreads();
      const float ctot = TOT1[col];
      if (hf == 1) ((float*)(F.ws + WS_DEC))[(size_t)(b * NCH + c) * 256 + col] = __expf(ctot);
      unsigned pk[16];
#pragma unroll
      for (int l = 0; l < 32; l += 2) { const float k0 = bf2f(kb[(size_t)(tok0 + 32 * hf + l) * 256 + col]), k1 = bf2f(kb[(size_t)(tok0 + 32 * hf + l + 1) * 256 + col]);
          pk[l >> 1] = cvt_pk_bf16(k0 * __expf(ctot - (cum[l] + tot)), k1 * __expf(ctot - (cum[l + 1] + tot))); }
#pragma unroll
      for (int q = 0; q < 4; ++q) *(LAS u32x4*)(KD + col * 128 + hf * 64 + q * 16) = (u32x4){pk[4 * q], pk[4 * q + 1], pk[4 * q + 2], pk[4 * q + 3]}; }
    VM_WAIT();
    __syncthreads();
    { const int hh = w >> 1, vh = w & 1, qp = n >> 2, pp = lane & 3;
      f32x4 acc[4][4];
#pragma unroll
      for (int mt = 0; mt < 4; ++mt)
#pragma unroll
          for (int nt = 0; nt < 4; ++nt) acc[mt][nt] = (f32x4){0.f, 0.f, 0.f, 0.f};
#pragma unroll
      for (int ks = 0; ks < 2; ++ks) {
          bf16x8 af[4];
#pragma unroll
          for (int mt = 0; mt < 4; ++mt) af[mt] = *(const LAS bf16x8*)(KD + (hh * 64 + 16 * mt + n) * 128 + (32 * ks + 8 * mq) * 2);
#pragma unroll
          for (int nt = 0; nt < 4; ++nt) {
              const LAS unsigned char* vp = VB + (size_t)(32 * ks + 8 * mq + qp) * 1024 + (hh * 128 + vh * 64 + 16 * nt + 4 * pp) * 2;
              const bf16x8 bfr = cat8(lds_tr16(vp), lds_tr16(vp + 4 * 1024));
#pragma unroll
              for (int mt = 0; mt < 4; ++mt) acc[mt][nt] = __builtin_amdgcn_mfma_f32_16x16x32_bf16(af[mt], bfr, acc[mt][nt], 0, 0, 0);
          }
      }
      float* dst = (float*)(F.ws + WS_DST) + ((size_t)((b * NCH + c) * BH + hh) * 128) * 64;
#pragma unroll
      for (int mt = 0; mt < 4; ++mt)
#pragma unroll
          for (int nt = 0; nt < 4; ++nt) *(f32x4*)(dst + (size_t)(vh * 64 + 16 * nt + n) * 64 + 16 * mt + 4 * mq) = acc[mt][nt]; }
    __syncthreads();
}

__device__ __forceinline__ void gla_scan_phase(Frame& F) {
    FRESH(F);
    const float* ds = (const float*)(F.ws + WS_DST); const float* dec = (const float*)(F.ws + WS_DEC); bf16_t* st = (bf16_t*)(F.ws + WS_ST);
    for (int e2 = blockIdx.x * NTHR + F.tid; e2 < NB * BH * 128 * 32; e2 += F.G * NTHR) {
        const int k2 = e2 & 31, v = (e2 >> 5) & 127, hh = (e2 >> 12) & 3, b = e2 >> 14;
        f32x2 s = (f32x2){0.f, 0.f};
#pragma unroll 8
        for (int c = 0; c < NCH; ++c) {
            const size_t off = ((size_t)((b * NCH + c) * BH + hh) * 128 + v) * 64 + 2 * k2;
            const f32x2 d = *(const f32x2*)(ds + off); const f32x2 a = *(const f32x2*)(dec + (size_t)(b * NCH + c) * 256 + hh * 64 + 2 * k2);
            s = a * s + d;
            *(unsigned*)(st + off) = cvt_pk_bf16(s.x, s.y);
        }
    }
}

__device__ __forceinline__ void gla_out_unit(Frame& F, int b, int c, const float* gnorm) {
    FRESH(F);
    const int lane = F.lane, w = F.wave, n = lane & 15, mq = lane >> 4;
    const int hh = w >> 1, th = w & 1, tok0 = b * SEQ + c * CH + 32 * th;
    const bf16_t* qb = (const bf16_t*)(F.ws + WS_QB); const bf16_t* st = (const bf16_t*)(F.ws + WS_ST) + ((size_t)((b * NCH + c) * BH + hh) * 128) * 64;
    const bf16_t* sr = (const bf16_t*)(F.ws + WS_SR); bf16_t* yb = (bf16_t*)(F.ws + WS_YB);
    bf16x8 qf[2][2];
#pragma unroll
    for (int nt = 0; nt < 2; ++nt)
#pragma unroll
        for (int ks = 0; ks < 2; ++ks) qf[nt][ks] = *(const bf16x8*)(qb + (size_t)(tok0 + 16 * nt + n) * 256 + hh * 64 + 32 * ks + 8 * mq);
    f32x4 acc[8][2];
#pragma unroll
    for (int mt = 0; mt < 8; ++mt) {
        const bf16x8 a0 = *(const bf16x8*)(st + (size_t)(16 * mt + n) * 64 + 8 * mq), a1 = *(const bf16x8*)(st + (size_t)(16 * mt + n) * 64 + 32 + 8 * mq);
#pragma unroll
        for (int nt = 0; nt < 2; ++nt) { f32x4 z = (f32x4){0.f, 0.f, 0.f, 0.f};
            z = __builtin_amdgcn_mfma_f32_16x16x32_bf16(a0, qf[nt][0], z, 0, 0, 0);
            acc[mt][nt] = __builtin_amdgcn_mfma_f32_16x16x32_bf16(a1, qf[nt][1], z, 0, 0, 0); }
    }
#pragma unroll
    for (int nt = 0; nt < 2; ++nt) { float ss = 0.f;
#pragma unroll
        for (int mt = 0; mt < 8; ++mt) ss += (acc[mt][nt][0] * acc[mt][nt][0] + acc[mt][nt][1] * acc[mt][nt][1]) + (acc[mt][nt][2] * acc[mt][nt][2] + acc[mt][nt][3] * acc[mt][nt][3]);
        ss += __shfl_xor(ss, 16); ss += __shfl_xor(ss, 32);
        const float rstd = __builtin_amdgcn_rsqf(ss * (1.f / 128.f) + EPS);
#pragma unroll
        for (int mt = 0; mt < 8; ++mt) { const int col = hh * 128 + 16 * mt + 4 * mq; const f32x4 gn = *(const f32x4*)(gnorm + col);
            const size_t po = (size_t)(tok0 + 16 * nt + n) * 512 + col; const u32x2 rw = *(const u32x2*)(sr + po);
            const f32x4 o = acc[mt][nt] * rstd * gn; u32x2 wv; wv.x = cvt_pk_bf16(o[0] * bf_lo(rw.x), o[1] * bf_hi(rw.x)); wv.y = cvt_pk_bf16(o[2] * bf_lo(rw.y), o[3] * bf_hi(rw.y));
            *(u32x2*)(yb + po) = wv; } }
}
#ifndef PLE_MODE1
#define PLE_MODE1 3
#endif
constexpr int N_PHASES = 25;
__global__ void __launch_bounds__(NTHR, 2) fwd(Args args) {
    extern __shared__ __attribute__((aligned(16))) unsigned char lds[];
    Frame F;
    F.lds = (LAS unsigned char*)lds;
    F.MISC = (volatile LAS unsigned*)(F.lds + MISC_OFF);
    F.tid = threadIdx.x; F.lane = F.tid & 63; F.wave = __builtin_amdgcn_readfirstlane(F.tid >> 6);
    F.G = gridDim.x; { const int bx = blockIdx.x; F.vcu = (F.G % 8 == 0) ? (bx % 8) * (F.G / 8) + bx / 8 : bx; }
    F.ws = args.ws; F.ctl = (gu32*)(args.ws + WS_CTL); F.x = args.out;
    unsigned char* ws = args.ws;
    for (int u = F.tid; u < (LDS_BYTES - LDSCTL_OFF) / 4; u += NTHR) ((LAS unsigned*)(F.lds + LDSCTL_OFF))[u] = 0u;
    __syncthreads();
    XcdBarrier bar = xcd_barrier_post((unsigned*)(F.ctl + CW_BAR), F.MISC + 8);
    const int lo = args.ph_lo, hi = args.ph_hi;
#ifndef PHMASK
#define PHMASK 0x1fff
#endif
#define EN(i) (((PHMASK) >> (i)) & 1)
#ifndef REPMASK
#define REPMASK 0
#endif
#ifndef REPLAYER
#define REPLAYER 2
#endif
#define ZEROG ((const float*)(ws + WS_CTL + 131072))
#define REPS(i) (((((REPMASK) >> (i)) & 1) && (REPLAYER == 2 || REPLAYER == l)) ? 2 : 1)
#define IN(k) (lo <= (k) && (k) < hi)
#ifndef SEAMREP
#define SEAMREP 1
#endif
#define SEAM(k) do { if (IN(k) && IN((k) + 1)) for (int _r = 0; _r < SEAMREP; ++_r) xcd_barrier(bar); } while (0)

    { const int l = 0; if (EN(12) && IN(0)) for (int rep = 0; rep < REPS(12); ++rep) { p0_prologue(F, args); } }
    SEAM(0);
    for (int l = 0; l < DEPTH; ++l) {
        const int pb = 1 + 12 * l;
        unsigned char* wb = ws + (l ? WS_W1 : WS_W0);
        bf16_t* hb = (bf16_t*)(ws + WS_HB); bf16_t* Y = (bf16_t*)(ws + WS_Y);
        if (EN(0) && IN(pb + 0)) for (int rep = 0; rep < REPS(0); ++rep) {
            pg8::Gemm g{hb, (const bf16_t*)(wb + OFF_WIN), D, 0, nullptr}; pg8::StaticOrder S; S.init(T, INWG, F.G, (int)blockIdx.x);
            pg8::EpiInProj E{(bf16_t*)(ws + WS_PROJ)};
            pg8::gemm_phase<pg8::EpiInProj, pg8::StaticOrder, false>(F.lds, g, S, E);
        }
        SEAM(pb + 0);
        if (EN(1) && IN(pb + 1)) for (int rep = 0; rep < REPS(1); ++rep) {
            for (int u = F.vcu; u < NB * NCH; u += F.G) {
#ifndef NO_ATTN
                attn_unit(F, u / NCH, u % NCH, args.in[I_RELB] + (size_t)l * AH * RELN);
#endif
#ifndef NO_GLA1
                gla_dstate_unit(F, u / NCH, u % NCH, (const bf16_t*)(wb + OFF_WGD), args.in[I_WGUP] + (size_t)l * GR * 256, args.in[I_BG] + (size_t)l * 256);
#endif
            }
        }
        SEAM(pb + 1);
        if (EN(2) && IN(pb + 2)) for (int rep = 0; rep < REPS(2); ++rep) { gla_scan_phase(F); }
        SEAM(pb + 2);
        if (EN(3) && IN(pb + 3)) for (int rep = 0; rep < REPS(3); ++rep) { for (int u = F.vcu; u < NB * NCH; u += F.G) gla_out_unit(F, u / NCH, u % NCH, args.in[I_GNORM] + (size_t)l * 512); }
        SEAM(pb + 3);
        if (EN(4) && IN(pb + 4)) for (int rep = 0; rep < REPS(4); ++rep) {
            pg8::StaticOrder S; S.init(T, D, F.G, (int)blockIdx.x);
            { pg8::Gemm g{(const bf16_t*)(ws + WS_YA), (const bf16_t*)(wb + OFF_WBA), 512, 0, nullptr}; pg8::EpiEw<1> E{(bf16_t*)(ws + WS_MERGED), (const bf16_t*)(ws + WS_SGA), D};
              pg8::gemm_phase<pg8::EpiEw<1>, pg8::StaticOrder, false>(F.lds, g, S, E); }
            { pg8::Gemm g{(const bf16_t*)(ws + WS_YB), (const bf16_t*)(wb + OFF_WBB), 512, 0, nullptr}; pg8::EpiEw<2> E{(bf16_t*)(ws + WS_MERGED), (const bf16_t*)(ws + WS_SGB), D};
              pg8::gemm_phase<pg8::EpiEw<2>, pg8::StaticOrder, false>(F.lds, g, S, E); }
        }
        SEAM(pb + 4);
        if (EN(5) && IN(pb + 5)) for (int rep = 0; rep < REPS(5); ++rep) {
            pg8::StaticOrder S; S.init(T, D, F.G, (int)blockIdx.x);
            pg8::Gemm g{(const bf16_t*)(ws + WS_MERGED), (const bf16_t*)(wb + OFF_WOUT), D, 0, nullptr}; pg8::EpiEw<0> E{Y, nullptr, D};
            pg8::gemm_phase<pg8::EpiEw<0>, pg8::StaticOrder, false>(F.lds, g, S, E);
        }
        SEAM(pb + 5);
        if (EN(6) && IN(pb + 6)) for (int rep = 0; rep < ((l == 0) ? REPS(6) : 1); ++rep) {
            if (l == 0) thin_phase<1, 1, false>(F, nullptr, Y, (rep + 1 < REPS(6)) ? ZEROG : args.in[I_NMPOST] + (size_t)l * D, args.in[I_NFPRE] + (size_t)l * D, hb, nullptr);
            else        thin_phase<1, 1, true>(F, nullptr, Y, args.in[I_NMPOST] + (size_t)l * D, args.in[I_NFPRE] + (size_t)l * D, hb, args.in[I_RW]);
        }
        SEAM(pb + 6);
        if (EN(7) && IN(pb + 7)) for (int rep = 0; rep < REPS(7); ++rep) {
            if (l == 0) { pg8::StaticOrder S; S.init(T, 2 * DFF, F.G, (int)blockIdx.x);
                pg8::Gemm g{hb, (const bf16_t*)(wb + OFF_FFN), D, 0, nullptr}; pg8::EpiGateUp E{(bf16_t*)(ws + WS_FACT), DFF};
                pg8::gemm_phase<pg8::EpiGateUp, pg8::StaticOrder, false>(F.lds, g, S, E);
            } else { pg8::GroupedOrder S; S.init((const unsigned*)(F.ctl + CW_CNT), 2 * DFE, F.G, (int)blockIdx.x);
                pg8::Gemm g{hb, (const bf16_t*)(wb + OFF_FFN), D, (size_t)2 * DFE * D, (const int*)(ws + WS_IDXE)}; pg8::EpiGateUp E{(bf16_t*)(ws + WS_MACT), DFE};
                pg8::gemm_phase<pg8::EpiGateUp, pg8::GroupedOrder, true>(F.lds, g, S, E);
            }
        }
        SEAM(pb + 7);
        if (EN(8) && IN(pb + 8)) for (int rep = 0; rep < REPS(8); ++rep) {
            if (l == 0) { pg8::StaticOrder S; S.init(T, D, F.G, (int)blockIdx.x);
                pg8::Gemm g{(const bf16_t*)(ws + WS_FACT), (const bf16_t*)(wb + OFF_FDN), DFF, 0, nullptr}; pg8::EpiEw<0> E{Y, nullptr, D};
                pg8::gemm_phase<pg8::EpiEw<0>, pg8::StaticOrder, false>(F.lds, g, S, E);
            } else { pg8::GroupedOrder S; S.init((const unsigned*)(F.ctl + CW_CNT), D, F.G, (int)blockIdx.x);
                pg8::Gemm g{(const bf16_t*)(ws + WS_MACT), (const bf16_t*)(wb + OFF_MDN), DFE, (size_t)D * DFE, nullptr}; pg8::EpiEw<0> E{(bf16_t*)(ws + WS_YSLOT), nullptr, D};
                pg8::gemm_phase<pg8::EpiEw<0>, pg8::GroupedOrder, false>(F.lds, g, S, E);
            }
        }
        SEAM(pb + 8);
        if (EN(9) && IN(pb + 9)) for (int rep = 0; rep < REPS(9); ++rep) {
            if (l == 0) thin_phase<1, 2, false>(F, nullptr, Y, (rep + 1 < REPS(9)) ? ZEROG : args.in[I_NFPOST] + (size_t)l * D, nullptr, (bf16_t*)(ws + WS_XB), nullptr);
            else        thin_phase<2, 2, false>(F, nullptr, (const bf16_t*)(ws + WS_YSLOT), (rep + 1 < REPS(9)) ? ZEROG : args.in[I_NFPOST] + (size_t)l * D, nullptr, (bf16_t*)(ws + WS_XB), nullptr);
        }
        SEAM(pb + 9);
        if (EN(10) && IN(pb + 10)) for (int rep = 0; rep < REPS(10); ++rep) {
            pg8::StaticOrder S; S.init(T, D, F.G, (int)blockIdx.x);
            if (args.sub != 2) { pg8::Gemm g{(const bf16_t*)(ws + WS_XB), (const bf16_t*)(wb + OFF_WPG), D, 0, nullptr}; pg8::EpiEw<PLE_MODE1> E{Y, nullptr, D};
              pg8::gemm_phase<pg8::EpiEw<PLE_MODE1>, pg8::StaticOrder, false>(F.lds, g, S, E); }
            if (args.sub != 1) { pg8::Gemm g{(const bf16_t*)(ws + WS_PB) + (size_t)l * T * PLE, (const bf16_t*)(wb + OFF_WPP), PLE, 0, nullptr}; pg8::EpiEw<4> E{Y, nullptr, D};
              pg8::gemm_phase<pg8::EpiEw<4>, pg8::StaticOrder, false>(F.lds, g, S, E); }
        }
        SEAM(pb + 10);
        if (EN(11) && IN(pb + 11)) for (int rep = 0; rep < REPS(11); ++rep) {
            if (l + 1 < DEPTH) thin_phase<1, 1, false>(F, nullptr, Y, (rep + 1 < REPS(11)) ? ZEROG : args.in[I_PNORM] + (size_t)l * D, args.in[I_NMPRE] + (size_t)(l + 1) * D, hb, nullptr);
            else               thin_phase<1, 0, false>(F, nullptr, Y, (rep + 1 < REPS(11)) ? ZEROG : args.in[I_PNORM] + (size_t)l * D, nullptr, nullptr, nullptr);
        }
        SEAM(pb + 11);
    }
#undef IN
#undef SEAM
}
#ifndef MK_DBG
#define MK_DBG 0
#endif
#if MK_DBG
#ifndef MK_DBG_SHOW
#define MK_DBG_SHOW -1
#endif
constexpr size_t WS_SNAP = 512 * 1024;
__device__ __forceinline__ unsigned dh(unsigned x) { x ^= x >> 16; x *= 0x7feb352du; x ^= x >> 15; x *= 0x846ca68bu; x ^= x >> 16; return x; }
__device__ __forceinline__ void dbg_acc(float* dbg, int stage, float d2, float e2, int lane) { d2 = wave_sum(d2); e2 = wave_sum(e2); if (lane == 0) { atomicAdd(dbg + 2 * stage, d2); atomicAdd(dbg + 2 * stage + 1, e2); } }
__device__ __forceinline__ float ddot(const bf16_t* arow, const float* W, int K, int pitch, int col, int lane) { float s = 0.f; for (int k = lane; k < K; k += 64) s += bf2f(arow[k]) * W[(size_t)k * pitch + col]; return wave_sum(s); }
__device__ __forceinline__ float dsig(float v) { return 1.f / (1.f + expf(-v)); }
__device__ __forceinline__ int dbg_pbase(const unsigned* gcnt, int e) { int acc = 0; for (int q = 0; q < 8; ++q) if (q < e) acc += (((int)gcnt[q] + 255) >> 8) << 8; return acc; }
#define DBGP float* dbg = (float*)(a.ws + WS_CTL) + CW_DBG; const int lane = threadIdx.x & 63; const unsigned sid = blockIdx.x; (void)sid

__global__ void dbg_t1(Args a, int stage) { DBGP;
    const int r = dh(sid * 3 + 1) % T; const float* x = a.in[I_X] + (size_t)r * D; const bf16_t* hb = (const bf16_t*)(a.ws + WS_HB) + (size_t)r * D;
    float ss = 0.f; for (int k = lane; k < D; k += 64) ss += x[k] * x[k]; ss = wave_sum(ss); const float rstd = 1.f / sqrtf(ss / D + EPS);
    float d2 = 0.f, e2 = 0.f; for (int k = lane; k < D; k += 64) { const float e = x[k] * rstd * a.in[I_NMPRE][k], g = bf2f(hb[k]); d2 += (g - e) * (g - e); e2 += e * e; const float dx = a.out[(size_t)r * D + k] - x[k]; d2 += dx * dx; }
    dbg_acc(dbg, stage, d2, e2, lane); }

__global__ void dbg_gemm(Args a, int kind, int l, int stage) { DBGP;
    unsigned char* ws = a.ws; const unsigned h1 = dh(sid * 7 + 1), h2 = dh(sid * 7 + 2), h3 = dh(sid * 7 + 3);
    const bf16_t* hb = (const bf16_t*)(ws + WS_HB); float e = 0.f, g = 0.f;
    const unsigned* gcnt = (const unsigned*)(ws + WS_CTL) + CW_CNT;
    if (kind == 1) { const int row = h1 % T, col = h2 % INWG, sc = col < 2560 ? col : col + 16; const float v = ddot(hb + (size_t)row * D, a.in[I_WIN] + (size_t)l * D * INW, D, INW, sc, lane);
        const bf16_t* P = (const bf16_t*)(ws + WS_PROJ);
        if (col < 512) { e = v * pg8::QA_SCALE; g = bf2f(((const bf16_t*)(ws + WS_QA))[(size_t)row * 512 + col]); }
        else if (col < 1024) { e = v; g = bf2f(((const bf16_t*)(ws + WS_KA))[(size_t)row * 512 + col - 512]); }
        else if (col < 1536) { e = v; g = bf2f(((const bf16_t*)(ws + WS_VA))[(size_t)row * 512 + col - 1024]); }
        else if (col < 1792) { e = v * 0.125f; g = bf2f(((const bf16_t*)(ws + WS_QB))[(size_t)row * 256 + col - 1536]); }
        else if (col < 2048) { e = v; g = bf2f(((const bf16_t*)(ws + WS_KB))[(size_t)row * 256 + col - 1792]); }
        else if (col < 2560) { e = v; g = bf2f(((const bf16_t*)(ws + WS_VB))[(size_t)row * 512 + col - 2048]); }
        else if (col < 3072) { e = v * dsig(v); g = bf2f(((const bf16_t*)(ws + WS_SR))[(size_t)row * 512 + col - 2560]); }
        else if (col < 4096) { e = dsig(v); g = bf2f(((const bf16_t*)(ws + WS_SGA))[(size_t)row * 1024 + col - 3072]); }
        else { e = dsig(v); g = bf2f(((const bf16_t*)(ws + WS_SGB))[(size_t)row * 1024 + col - 4096]); } (void)P;
    } else if (kind == 2) { const int row = h1 % T, col = h2 % D;
        const float va = ddot((const bf16_t*)(ws + WS_YA) + (size_t)row * 512, a.in[I_WBA] + (size_t)l * 512 * D, 512, D, col, lane), vb = ddot((const bf16_t*)(ws + WS_YB) + (size_t)row * 512, a.in[I_WBB] + (size_t)l * 512 * D, 512, D, col, lane);
        e = bf2f(((const bf16_t*)(ws + WS_SGA))[(size_t)row * D + col]) * va + bf2f(((const bf16_t*)(ws + WS_SGB))[(size_t)row * D + col]) * vb; g = bf2f(((const bf16_t*)(ws + WS_MERGED))[(size_t)row * D + col]);
    } else if (kind == 3) { const int row = h1 % T, col = h2 % D; e = ddot((const bf16_t*)(ws + WS_MERGED) + (size_t)row * D, a.in[I_WOUT] + (size_t)l * D * D, D, D, col, lane); g = bf2f(((const bf16_t*)(ws + WS_Y))[(size_t)row * D + col]);
    } else if (kind == 4) { const int row = h1 % T, c = h2 % DFF; const float vg = ddot(hb + (size_t)row * D, a.in[I_FG], D, DFF, c, lane), vu = ddot(hb + (size_t)row * D, a.in[I_FU], D, DFF, c, lane);
        e = vg * dsig(vg) * vu; g = bf2f(((const bf16_t*)(ws + WS_FACT))[(size_t)row * DFF + c]);
    } else if (kind == 5) { const int row = h1 % T, col = h2 % D; e = ddot((const bf16_t*)(ws + WS_FACT) + (size_t)row * DFF, a.in[I_FD], DFF, D, col, lane); g = bf2f(((const bf16_t*)(ws + WS_Y))[(size_t)row * D + col]);
    } else if (kind == 6 || kind == 7) { const int ex = h1 % NE; const int pbase = dbg_pbase(gcnt, ex); const int cnt = (int)gcnt[ex];
        if (cnt == 0) return; const int i = h2 % cnt, tok = ((const int*)(ws + WS_IDXE))[ex * 16384 + i], row = pbase + i;
        if (kind == 6) { const int c = h3 % DFE; const float vg = ddot(hb + (size_t)tok * D, a.in[I_MG] + (size_t)ex * D * DFE, D, DFE, c, lane), vu = ddot(hb + (size_t)tok * D, a.in[I_MU] + (size_t)ex * D * DFE, D, DFE, c, lane);
            e = vg * dsig(vg) * vu; g = bf2f(((const bf16_t*)(ws + WS_MACT))[(size_t)row * DFE + c]); }
        else { const int col = h3 % D; e = ddot((const bf16_t*)(ws + WS_MACT) + (size_t)row * DFE, a.in[I_MD] + (size_t)ex * DFE * D, DFE, D, col, lane); g = bf2f(((const bf16_t*)(ws + WS_YSLOT))[(size_t)row * D + col]); }
    } else if (kind == 12) { const int row = h1 % T, col = h2 % D; e = a.out[(size_t)row * D + col]; g = bf2f(((const bf16_t*)(ws + WS_XB))[(size_t)row * D + col]);
    } else if (kind == 13) { const int row = h1 % T, col = h2 % D; e = ddot((const bf16_t*)(ws + WS_XB) + (size_t)row * D, a.in[I_PG] + (size_t)l * D * D, D, D, col, lane); g = bf2f(((const bf16_t*)(ws + WS_Y))[(size_t)row * D + col]);
    } else if (kind == 11) { const int n = h1 % D, k = h2 % D; e = a.in[I_PG][(size_t)l * D * D + (size_t)k * D + n]; g = bf2f(((const bf16_t*)(ws + (l ? WS_W1 : WS_W0) + OFF_WPG))[(size_t)n * D + k]);
    } else if (kind == 9) { const int row = h1 % T, col = h2 % D; e = dsig(ddot((const bf16_t*)(ws + WS_XB) + (size_t)row * D, a.in[I_PG] + (size_t)l * D * D, D, D, col, lane)); g = bf2f(((const bf16_t*)(ws + WS_Y))[(size_t)row * D + col]);
    } else { const int row = h1 % T, col = h2 % D; const float vg = ddot((const bf16_t*)(ws + WS_XB) + (size_t)row * D, a.in[I_PG] + (size_t)l * D * D, D, D, col, lane), vp = ddot((const bf16_t*)(ws + WS_PB) + ((size_t)l * T + row) * PLE, a.in[I_PP] + (size_t)l * PLE * D, PLE, D, col, lane);
        e = dsig(vg) * vp; g = bf2f(((const bf16_t*)(ws + WS_Y))[(size_t)row * D + col]); }
    if (lane == 0) { atomicAdd(dbg + 2 * stage, (g - e) * (g - e)); atomicAdd(dbg + 2 * stage + 1, e * e); } }

__global__ void dbg_attn(Args a, int l, int stage) { DBGP;
    unsigned char* ws = a.ws; const unsigned h1 = dh(sid * 5 + 1); const int tok = h1 % T, h = dh(sid * 5 + 2) % AH, b = tok / SEQ, c = (tok % SEQ) / CH, ql = tok % CH;
    const bf16_t* hb = (const bf16_t*)(ws + WS_HB) + (size_t)tok * D; const float* win = a.in[I_WIN] + (size_t)l * D * INW;
    float q = 0.f; for (int k = 0; k < D; ++k) q += bf2f(hb[k]) * win[(size_t)k * INW + h * 64 + lane]; q *= pg8::QA_SCALE;
    const bf16_t* ka = (const bf16_t*)(ws + WS_KA); const bf16_t* va = (const bf16_t*)(ws + WS_VA); const float* rb = a.in[I_RELB] + ((size_t)l * AH + h) * RELN;
    float m = -1e30f, ls = 0.f, o = 0.f;
    for (int kc = (c - 8 > 0 ? c - 8 : 0); kc <= c; ++kc) for (int kl = 0; kl < CH; ++kl) { const int kt = b * SEQ + kc * CH + kl; int dist = (c - kc) * 64 + ql - kl; dist = dist > 128 ? 128 : (dist < -128 ? -128 : dist);
        const float s = wave_sum(q * bf2f(ka[(size_t)kt * 512 + h * 64 + lane])) + rb[dist + 128] * LOG2E; const float mn = fmaxf(m, s), al = exp2f(m - mn), p = exp2f(s - mn); m = mn; ls = ls * al + p; o = o * al + p * bf2f(va[(size_t)kt * 512 + h * 64 + lane]); }
    const float e = o / ls, g = bf2f(((const bf16_t*)(ws + WS_YA))[(size_t)tok * 512 + h * 64 + lane]);
    dbg_acc(dbg, stage, (g - e) * (g - e), e * e, lane); }

__global__ void dbg_dstate(Args a, int l, int stage) { DBGP;
    unsigned char* ws = a.ws; const int b = dh(sid * 5 + 1) % NB, c = dh(sid * 5 + 2) % NCH, hh = dh(sid * 5 + 3) % BH, v = dh(sid * 5 + 4) % 128, k = dh(sid * 5 + 5) % 64, col = hh * 64 + k;
    const int tok = b * SEQ + c * CH + lane; const bf16_t* hb = (const bf16_t*)(ws + WS_HB) + (size_t)tok * D; const float* win = a.in[I_WIN] + (size_t)l * D * INW;
    float z = a.in[I_BG][l * 256 + col];
    for (int r = 0; r < GR; ++r) { float gd = 0.f; for (int kk = 0; kk < D; ++kk) gd += bf2f(hb[kk]) * win[(size_t)kk * INW + 2560 + r]; z += gd * a.in[I_WGUP][((size_t)l * GR + r) * 256 + col]; }
    const float la = (fminf(z, 0.f) - log1pf(expf(-fabsf(z)))) / 16.f; float cum = la;
    for (int o = 1; o < 64; o <<= 1) { const float t = __shfl_up(cum, o); if (lane >= o) cum += t; }
    const float tot = __shfl(cum, 63);
    const float kd = bf2f(((const bf16_t*)(ws + WS_KB))[(size_t)tok * 256 + col]) * expf(tot - cum);
    const float e = wave_sum(kd * bf2f(((const bf16_t*)(ws + WS_VB))[(size_t)tok * 512 + hh * 128 + v]));
    const float g = ((const float*)(ws + WS_DST))[((size_t)((b * NCH + c) * BH + hh) * 128 + v) * 64 + k];
    const float ed = expf(tot), gdc = ((const float*)(ws + WS_DEC))[(size_t)(b * NCH + c) * 256 + col];
    if (lane == 0) { atomicAdd(dbg + 2 * stage, (g - e) * (g - e) + (gdc - ed) * (gdc - ed)); atomicAdd(dbg + 2 * stage + 1, e * e + ed * ed); } }

__global__ void dbg_scan(Args a, int stage) { DBGP;
    unsigned char* ws = a.ws; const unsigned s0 = sid * 64 + lane; const int b = dh(s0 * 5 + 1) % NB, c = dh(s0 * 5 + 2) % NCH, hh = dh(s0 * 5 + 3) % BH, v = dh(s0 * 5 + 4) % 128, k = dh(s0 * 5 + 5) % 64;
    float s = 0.f; for (int cc = 0; cc <= c; ++cc) s = ((const float*)(ws + WS_DEC))[(size_t)(b * NCH + cc) * 256 + hh * 64 + k] * s + ((const float*)(ws + WS_DST))[((size_t)((b * NCH + cc) * BH + hh) * 128 + v) * 64 + k];
    const float g = bf2f(((const bf16_t*)(ws + WS_ST))[((size_t)((b * NCH + c) * BH + hh) * 128 + v) * 64 + k]);
    dbg_acc(dbg, stage, (g - s) * (g - s), s * s, lane); }

__global__ void dbg_glaout(Args a, int l, int stage) { DBGP;
    unsigned char* ws = a.ws; const int tok = dh(sid * 3 + 1) % T, hh = dh(sid * 3 + 2) % BH, b = tok / SEQ, c = (tok % SEQ) / CH;
    const bf16_t* st = (const bf16_t*)(ws + WS_ST) + ((size_t)((b * NCH + c) * BH + hh) * 128) * 64; const bf16_t* qb = (const bf16_t*)(ws + WS_QB) + (size_t)tok * 256 + hh * 64;
    const bf16_t* hb = (const bf16_t*)(ws + WS_HB) + (size_t)tok * D; const float* win = a.in[I_WIN] + (size_t)l * D * INW;
    float o[2], r[2];
#pragma unroll
    for (int j = 0; j < 2; ++j) { const int v = lane + 64 * j; float s = 0.f; for (int k = 0; k < 64; ++k) s += bf2f(qb[k]) * bf2f(st[(size_t)v * 64 + k]); o[j] = s;
        float rr = 0.f; for (int kk = 0; kk < D; ++kk) rr += bf2f(hb[kk]) * win[(size_t)kk * INW + 2576 + hh * 128 + v]; r[j] = rr * dsig(rr); }
    const float ss = wave_sum(o[0] * o[0] + o[1] * o[1]), rstd = 1.f / sqrtf(ss / 128.f + EPS); float d2 = 0.f, e2 = 0.f;
#pragma unroll
    for (int j = 0; j < 2; ++j) { const int v = lane + 64 * j; const float e = o[j] * rstd * a.in[I_GNORM][l * 512 + hh * 128 + v] * r[j], g = bf2f(((const bf16_t*)(ws + WS_YB))[(size_t)tok * 512 + hh * 128 + v]); d2 += (g - e) * (g - e); e2 += e * e; }
    dbg_acc(dbg, stage, d2, e2, lane); }

__device__ __forceinline__ int dbg_row(unsigned i) { return (int)((i * 257u + 11u) % T); }
__global__ void dbg_snap(Args a) { const int i = blockIdx.x, r = dbg_row(i); float* snap = (float*)(a.ws + WS_SNAP) + (size_t)i * D; for (int k = threadIdx.x; k < D; k += 64) snap[k] = a.out[(size_t)r * D + k]; }
__global__ void dbg_thin(Args a, int src, int outk, int route, const float* g_add, const float* g_out, const bf16_t* obuf, int st_x, int st_o, int st_r) { DBGP;
    unsigned char* ws = a.ws; const int i = sid, r = dbg_row(i); const float* snap = (const float*)(ws + WS_SNAP) + (size_t)i * D;
    const unsigned* gcnt = (const unsigned*)(ws + WS_CTL) + CW_CNT; const unsigned* ti = (const unsigned*)(ws + WS_TOKINFO) + (size_t)r * 8;
    float y[16], xn[16]; float ss = 0.f;
#pragma unroll
    for (int j = 0; j < 16; ++j) { const int k = lane + 64 * j; float v;
        if (src == 1) v = bf2f(((const bf16_t*)(ws + WS_Y))[(size_t)r * D + k]);
        else { const bf16_t* ys = (const bf16_t*)(ws + WS_YSLOT); v = __uint_as_float(ti[4]) * bf2f(ys[(size_t)(dbg_pbase(gcnt, (int)ti[0]) + ti[1]) * D + k]) + __uint_as_float(ti[5]) * bf2f(ys[(size_t)(dbg_pbase(gcnt, (int)ti[2]) + ti[3]) * D + k]); }
        y[j] = v; ss += v * v; }
    ss = wave_sum(ss); const float rstd = 1.f / sqrtf(ss / D + EPS); float d2 = 0.f, e2 = 0.f, s2 = 0.f;
#pragma unroll
    for (int j = 0; j < 16; ++j) { const int k = lane + 64 * j; xn[j] = snap[k] + y[j] * rstd * g_add[k]; const float g = a.out[(size_t)r * D + k]; d2 += (g - xn[j]) * (g - xn[j]); e2 += xn[j] * xn[j]; s2 += xn[j] * xn[j]; }
    dbg_acc(dbg, st_x, d2, e2, lane);
    if (outk == 0) return;
    s2 = wave_sum(s2); const float rs2 = 1.f / sqrtf(s2 / D + EPS); d2 = 0.f; e2 = 0.f; float hn[16];
#pragma unroll
    for (int j = 0; j < 16; ++j) { const int k = lane + 64 * j; hn[j] = (outk == 1) ? xn[j] * rs2 * g_out[k] : xn[j]; const float g = bf2f(obuf[(size_t)r * D + k]); d2 += (g - hn[j]) * (g - hn[j]); e2 += hn[j] * hn[j]; }
    dbg_acc(dbg, st_o, d2, e2, lane);
    if (!route) return;
    float lg[8];
#pragma unroll
    for (int e = 0; e < 8; ++e) { float s = 0.f;
#pragma unroll
        for (int j = 0; j < 16; ++j) s += hn[j] * a.in[I_RW][(size_t)(lane + 64 * j) * NE + e]; lg[e] = wave_sum(s); }
    int e1 = 0; float v1 = lg[0];
#pragma unroll
    for (int e = 1; e < 8; ++e) if (lg[e] > v1) { v1 = lg[e]; e1 = e; }
    int e2i = -1; float v2 = -3.0e38f;
#pragma unroll
    for (int e = 0; e < 8; ++e) if (e != e1 && lg[e] > v2) { v2 = lg[e]; e2i = e; }
    const float ex = expf(v2 - v1), w1 = 1.f / (1.f + ex);
    float bad = 0.f; if ((int)ti[0] != e1 || (int)ti[2] != e2i) bad = 1.f; else { bad = fabsf(__uint_as_float(ti[4]) - w1) + fabsf(__uint_as_float(ti[5]) - (1.f - w1));
        const int* idxe = (const int*)(ws + WS_IDXE); if (ti[1] >= gcnt[e1] || ti[3] >= gcnt[e2i] || idxe[e1 * 16384 + ti[1]] != r || idxe[e2i * 16384 + ti[3]] != r) bad = 1.f; }
    if (lane == 0) { atomicAdd(dbg + 2 * st_r, bad * bad); atomicAdd(dbg + 2 * st_r + 1, 1.f); } }

__global__ void dbg_report(Args a) {
    const float* dbg = (const float*)(a.ws + WS_CTL) + CW_DBG; int bad = -1; float errk = 0.f;
    for (int k = 0; k < 33; ++k) { const float d2 = dbg[2 * k], e2 = dbg[2 * k + 1]; if (d2 == 0.f && e2 == 0.f) continue; const float err = d2 / e2; if (MK_DBG_SHOW == k) errk = (err == err) ? err : 1e6f; if (bad < 0 && !(err < 1e-3f)) bad = k; }
    float V = 0.f; bool fill = false;
    if (MK_DBG_SHOW >= 0) { V = sqrtf(7.f * 100.f * errk) + 1e-3f; fill = true; } else if (bad >= 0) { V = exp10f(1.f + 0.25f * (float)bad); fill = true; }
    if (fill) for (size_t i = (size_t)blockIdx.x * blockDim.x + threadIdx.x; i < (size_t)T * D; i += (size_t)gridDim.x * blockDim.x) a.out[i] = V; }

static void dbg_run(Args a, int grid, hipStream_t st) {
    auto ph = [&](int p) { a.ph_lo = p; a.ph_hi = p + 1; hipLaunchKernelGGL(fwd, dim3(grid), dim3(NTHR), LDS_BYTES, st, a); };
    const int NS = 2048;
    ph(0); hipLaunchKernelGGL(dbg_t1, dim3(256), dim3(64), 0, st, a, 0);
    for (int l = 0; l < DEPTH; ++l) { const int pb = 1 + 12 * l, sb = 16 * l; const size_t lo = (size_t)l * D;
        ph(pb + 0); hipLaunchKernelGGL(dbg_gemm, dim3(NS), dim3(64), 0, st, a, 1, l, sb + 1);
        ph(pb + 1); hipLaunchKernelGGL(dbg_attn, dim3(512), dim3(64), 0, st, a, l, sb + 2); hipLaunchKernelGGL(dbg_dstate, dim3(256), dim3(64), 0, st, a, l, sb + 3);
        ph(pb + 2); hipLaunchKernelGGL(dbg_scan, dim3(64), dim3(64), 0, st, a, sb + 4);
        ph(pb + 3); hipLaunchKernelGGL(dbg_glaout, dim3(256), dim3(64), 0, st, a, l, sb + 5);
        ph(pb + 4); hipLaunchKernelGGL(dbg_gemm, dim3(NS), dim3(64), 0, st, a, 2, l, sb + 6);
        ph(pb + 5); hipLaunchKernelGGL(dbg_gemm, dim3(NS), dim3(64), 0, st, a, 3, l, sb + 7);
        hipLaunchKernelGGL(dbg_snap, dim3(64), dim3(64), 0, st, a);
        ph(pb + 6); hipLaunchKernelGGL(dbg_thin, dim3(64), dim3(64), 0, st, a, 1, 1, l == 1 ? 1 : 0, a.in[I_NMPOST] + lo, a.in[I_NFPRE] + lo, (const bf16_t*)(a.ws + WS_HB), sb + 8, sb + 9, sb + 10);
        ph(pb + 7); hipLaunchKernelGGL(dbg_gemm, dim3(NS), dim3(64), 0, st, a, l == 0 ? 4 : 6, l, sb + 11);
        ph(pb + 8); hipLaunchKernelGGL(dbg_gemm, dim3(NS), dim3(64), 0, st, a, l == 0 ? 5 : 7, l, sb + 12);
        hipLaunchKernelGGL(dbg_snap, dim3(64), dim3(64), 0, st, a);
        ph(pb + 9); hipLaunchKernelGGL(dbg_thin, dim3(64), dim3(64), 0, st, a, l == 0 ? 1 : 2, 2, 0, a.in[I_NFPOST] + lo, (const float*)nullptr, (const bf16_t*)(a.ws + WS_XB), sb + 13, sb + 13, 0);
        a.sub = 1; ph(pb + 10); hipLaunchKernelGGL(dbg_gemm, dim3(NS), dim3(64), 0, st, a, 9, l, sb + 14);
        a.sub = 2; ph(pb + 10); a.sub = 0; hipLaunchKernelGGL(dbg_gemm, dim3(NS), dim3(64), 0, st, a, 8, l, sb + 15);
        hipLaunchKernelGGL(dbg_snap, dim3(64), dim3(64), 0, st, a);
        ph(pb + 11); hipLaunchKernelGGL(dbg_thin, dim3(64), dim3(64), 0, st, a, 1, l == 0 ? 1 : 0, 0, a.in[I_PNORM] + lo, l == 0 ? a.in[I_NMPRE] + D : (const float*)nullptr, (const bf16_t*)(a.ws + WS_HB), sb + 16, sb + 16, 0);
    }
    hipLaunchKernelGGL(dbg_report, dim3(1024), dim3(256), 0, st, a);
}
#endif
#ifndef MK_SPLIT
#define MK_SPLIT 0
#endif
#ifndef MK_DBG
#define MK_DBG 0
#endif
extern "C" void kernel_launch(void* const* d_in, const int* in_sizes, int n_in, void* d_out, int out_size, void* d_ws, size_t ws_size, hipStream_t stream) {
    static int grid = 0;
    if (grid == 0) {
        if (n_in != 24 || in_sizes[0] != T * D || out_size != T * D || ws_size < WS_END) { fprintf(stderr, "kernel_launch: unexpected problem (n_in %d, in0 %d, out %d, ws %zu < %zu); nothing launched\n", n_in, n_in > 0 ? in_sizes[0] : -1, out_size, ws_size, (size_t)WS_END); grid = -1; return; }
        int dev = 0, cus = 0, per_cu = 0;
        if (hipGetDevice(&dev) != hipSuccess || hipDeviceGetAttribute(&cus, hipDeviceAttributeMultiprocessorCount, dev) != hipSuccess) { grid = -1; return; }
        if (hipFuncSetAttribute((const void*)fwd, hipFuncAttributeMaxDynamicSharedMemorySize, LDS_BYTES) != hipSuccess) { fprintf(stderr, "kernel_launch: hipFuncSetAttribute failed\n"); grid = -1; return; }
        if (hipOccupancyMaxActiveBlocksPerMultiprocessor(&per_cu, (const void*)fwd, NTHR, LDS_BYTES) != hipSuccess || per_cu < 1) { fprintf(stderr, "kernel_launch: occupancy query says %d blocks per CU\n", per_cu); }
        (void)hipGetLastError();
        grid = cus;
    }
    if (grid < 0) return;
    (void)hipMemsetAsync((char*)d_ws + WS_CTL, 0, CTL_ZERO_BYTES, stream);
    Args a{};
    for (int i = 0; i < 24; ++i) a.in[i] = (const float*)d_in[i];
    a.out = (float*)d_out; a.ws = (unsigned char*)d_ws;
#if MK_DBG
    dbg_run(a, grid, stream);
#elif MK_SPLIT
    for (int p = 0; p < N_PHASES; ++p) { a.ph_lo = p; a.ph_hi = p + 1; hipLaunchKernelGGL(fwd, dim3(grid), dim3(NTHR), LDS_BYTES, stream, a); }
#else
    a.ph_lo = 0; a.ph_hi = N_PHASES;
    hipLaunchKernelGGL(fwd, dim3(grid), dim3(NTHR), LDS_BYTES, stream, a);
#endif
}
```

```cpp
#include <hip/hip_runtime.h>
#include <cstdio>
#include <cstdint>

#define LAS __attribute__((address_space(3)))
#define GAS __attribute__((address_space(1)))
typedef unsigned short bf16_t;
typedef short bf16x8 __attribute__((ext_vector_type(8)));
typedef short s16x4 __attribute__((ext_vector_type(4)));
typedef float f32x4 __attribute__((ext_vector_type(4)));
typedef float f32x2 __attribute__((ext_vector_type(2)));
typedef unsigned u32x4 __attribute__((ext_vector_type(4)));
typedef unsigned u32x2 __attribute__((ext_vector_type(2)));

typedef __bf16 bf16x2_t __attribute__((ext_vector_type(2)));
__device__ __forceinline__ unsigned cvt_pk_bf16(float lo, float hi) { f32x2 v = {lo, hi}; const bf16x2_t b = __builtin_convertvector(v, bf16x2_t); return __builtin_bit_cast(unsigned, b); }
#ifndef WT_STORES
#define WT_STORES 1
#endif
struct WT { __amdgpu_buffer_rsrc_t rs; const char* base; };
__device__ __forceinline__ WT make_wt(void* ws_base, unsigned nbytes) { WT w; w.rs = __builtin_amdgcn_make_buffer_rsrc(ws_base, 0, (int)nbytes, 0x00020000); w.base = (const char*)ws_base; return w; }
__device__ __forceinline__ void st16(const WT& w, void* p, u32x4 v) {
#if WT_STORES
    __builtin_amdgcn_raw_buffer_store_b128(v, w.rs, (int)(unsigned)((const char*)p - w.base), 0, 16);
#else
    *(u32x4*)p = v;
#endif
}
__device__ __forceinline__ void st8(const WT& w, void* p, u32x2 v) {
#if WT_STORES
    __builtin_amdgcn_raw_buffer_store_b64(v, w.rs, (int)(unsigned)((const char*)p - w.base), 0, 16);
#else
    *(u32x2*)p = v;
#endif
}
__device__ __forceinline__ float clamp8(float v) { return __builtin_amdgcn_fmed3f(v, -448.f, 448.f); }
__device__ __forceinline__ unsigned pk4_fp8(float a, float b, float c, float d) { int w = __builtin_amdgcn_cvt_pk_fp8_f32(clamp8(a), clamp8(b), 0, false); w = __builtin_amdgcn_cvt_pk_fp8_f32(clamp8(c), clamp8(d), w, true); return (unsigned)w; }
__device__ __forceinline__ float q8(float x, float s) { const int w = __builtin_amdgcn_cvt_pk_fp8_f32(x * s, 0.f, 0, false); return __builtin_amdgcn_cvt_f32_fp8(w, 0) * (1.0f / s); }
__device__ __forceinline__ float bf_lo(unsigned w) { return __uint_as_float(w << 16); }
__device__ __forceinline__ float bf_hi(unsigned w) { return __uint_as_float(w & 0xffff0000u); }
__device__ __forceinline__ float bf2f(bf16_t b) { return __uint_as_float(((unsigned)b) << 16); }
__device__ __forceinline__ float fast_sigmoid(float v) { return __builtin_amdgcn_rcpf(1.0f + __builtin_amdgcn_exp2f(-1.4426950408889634f * v)); }
__device__ __forceinline__ float wave_sum(float v) {
#pragma unroll
    for (int o = 1; o < 64; o <<= 1) v += __shfl_xor(v, o);
    return v;
}

typedef int v8i32 __attribute__((ext_vector_type(8)));
typedef int v4i32 __attribute__((ext_vector_type(4)));
__device__ __forceinline__ v8i32 cat8i(bf16x8 a, bf16x8 b) { const v4i32 x = __builtin_bit_cast(v4i32, a), y = __builtin_bit_cast(v4i32, b); return (v8i32){x[0], x[1], x[2], x[3], y[0], y[1], y[2], y[3]}; }
namespace pg8 {
constexpr int BM = 256, BK = 64, HALF = 128, HTB = HALF * BK * 2, STAGE_BYTES = 8 * HTB, NXCD = 8, WGM = 8;
__host__ __device__ __forceinline__ int lds_byte(int r, int c) { const int st = (r >> 4) * 2 + (c >> 5), rr = r & 15, cc = c & 31, ob = rr * 64 + cc * 2; return st * 1024 + (ob ^ (((ob >> 9) & 1) << 5)); }
__host__ __device__ __forceinline__ void stage_rc(int b, int& R, int& C) { const int st = b / 1024, sb = b % 1024, swz = sb ^ (((sb >> 9) & 1) << 5); R = (st >> 1) * 16 + swz / 64; C = (st & 1) * 32 + (swz % 64) / 2; }
__host__ __device__ __forceinline__ int perm32(int rho) { const int n = rho >> 4, i = rho & 15; return 8 * (i >> 2) + 4 * n + (i & 3); }

struct Unit { int pm, pn, e, lr0, cnt, koff; };
struct Gemm { const bf16_t* A; const bf16_t* Bt; int K; size_t b_estride; const int* gidx; int ld; };

struct StaticOrder {
    int nM, nN, nwg, G, c;
    __device__ __forceinline__ void init(int M, int N, int G_, int c_) { nM = M / BM; nN = N / BM; nwg = nM * nN; G = G_; c = c_; }
    __device__ __forceinline__ bool short_deal() const { const int r = nwg % G; return r != 0 && c >= r; }
    __device__ __forceinline__ bool next(int i, Unit& u) const {
        const long L = (long)i * G + c; if (L >= nwg) return false;
        int wgid = (int)L; { const int q = nwg / NXCD, r = nwg % NXCD, xcd = wgid % NXCD, off = wgid / NXCD; wgid = (xcd < r ? xcd * (q + 1) : r * (q + 1) + (xcd - r) * q) + off; }
        const int nig = WGM * nN, gid = wgid / nig, fm = gid * WGM, gsz = (nM - fm) < WGM ? (nM - fm) : WGM;
        u.pm = fm + ((wgid % nig) % gsz); u.pn = (wgid % nig) / gsz; u.e = 0; u.lr0 = 0; u.cnt = 0; u.koff = 0; return true;
    }
};
struct GroupedOrder {
    int pb[9]; int cnt[8]; int nN, G, c, nwg, np;
    __device__ __forceinline__ void init(const unsigned* counts, int N, int G_, int c_, int pmax = 1 << 30) {
        int acc = 0;
#pragma unroll
        for (int e = 0; e < 8; ++e) { const int n = (int)counts[e]; cnt[e] = n; pb[e] = acc; acc += (n + 255) >> 8; }
        pb[8] = acc; nN = N / BM; G = G_; c = c_; np = acc < pmax ? acc : pmax; nwg = np * nN;
    }
    __device__ __forceinline__ bool short_deal() const { const int r = nwg % G; return r != 0 && c >= r; }
    __device__ __forceinline__ bool next(int i, Unit& u) const {
        const long L = (long)i * G + c; if (L >= nwg) return false;
        const int nig = WGM * nN, gid = (int)L / nig, fm = gid * WGM, gsz = (np - fm) < WGM ? (np - fm) : WGM;
        const int pm = fm + (((int)L % nig) % gsz), pn = ((int)L % nig) / gsz;
        int e = 0;
#pragma unroll
        for (int k = 1; k < 8; ++k) e += (pm >= pb[k]) ? 1 : 0;
        int pbe = 0, ce = 0;
#pragma unroll
        for (int k = 0; k < 8; ++k) { pbe = (k == e) ? pb[k] : pbe; ce = (k == e) ? cnt[k] : ce; }
        u.pm = pm; u.pn = pn; u.e = e; u.lr0 = (pm - pbe) * 256; u.cnt = ce; u.koff = 0; return true;
    }
};

struct TailOrder {
    int pb[9]; int nN, G, c, nwg, p0, KC, KCH;
    __device__ __forceinline__ void init(const unsigned* counts, int N, int G_, int c_, int p0_, int KC_, int KCH_) {
        int acc = 0;
#pragma unroll
        for (int e = 0; e < 8; ++e) { pb[e] = acc; acc += ((int)counts[e] + 255) >> 8; }
        pb[8] = acc; nN = N / BM; G = G_; c = c_; p0 = p0_; KC = KC_; KCH = KCH_; nwg = acc > p0 ? (acc - p0) * nN * KC : 0;
    }
    __device__ __forceinline__ bool short_deal() const { return false; }
    __device__ __forceinline__ bool next(int i, Unit& u) const {
        const long L = (long)i * G + c; if (L >= nwg) return false;
        const int kc = (int)L % KC, t = (int)L / KC, pm = p0 + t / nN, pn = t % nN;
        int e = 0;
#pragma unroll
        for (int k = 1; k < 8; ++k) e += (pm >= pb[k]) ? 1 : 0;
        u.pm = pm; u.pn = pn; u.e = e; u.lr0 = 0; u.cnt = 0; u.koff = kc * KCH; return true;
    }
};

template <class Epi, class Sched, bool GATHER, bool F8 = false>
__device__ __forceinline__ void gemm_phase(LAS unsigned char* lds, const Gemm g, const Sched& S, const Epi& E) {
    int tid = threadIdx.x; asm volatile("" : "+v"(tid));
    const int wid = __builtin_amdgcn_readfirstlane(tid >> 6), lane = tid & 63, wr = wid >> 2, wc = wid & 3, fr = lane & 15, fq = lane >> 4;
    const int K = g.K, nt = K / BK, LD = g.ld ? g.ld : g.K;
    unsigned voffA[2], voffB[2]; int rA[2];
#pragma unroll
    for (int i = 0; i < 2; ++i) { int R, C; stage_rc(tid * 16 + i * 8192, R, C); const int Rb = Epi::PERM ? ((R & ~31) + perm32(R & 31)) : R;
        voffA[i] = GATHER ? (unsigned)(C * 2) : (unsigned)(R * LD + C) * 2u; voffB[i] = (unsigned)(Rb * LD + C) * 2u; rA[i] = R; }
    const size_t kstep = (size_t)(BK * 2);
    const size_t hstep = (size_t)HALF * LD * 2;
    const size_t tstep = 2 * hstep;
    const unsigned ldsw = (unsigned)wid * 1024u;
    const int aoff = F8 ? lds_byte(wr * 64 + fr, fq * 16) : lds_byte(wr * 64 + fr, fq * 8), boff = F8 ? lds_byte(wc * 32 + fr, fq * 16) : lds_byte(wc * 32 + fr, fq * 8);
    const int aof1 = F8 ? lds_byte(wr * 64 + fr, fq * 16 + 8) : aoff + 1024, bof1 = F8 ? lds_byte(wc * 32 + fr, fq * 16 + 8) : boff + 1024;
#define PG8_SA(b, h) (((b) * 2 + (h)) * HTB)
#define PG8_SB(b, h) ((4 + (b) * 2 + (h)) * HTB)
#define PG8_STAGE2(bufoff, gbase, v0, v1) do { unsigned _a = (v0), _b = (v1); asm volatile("" : "+v"(_a), "+v"(_b));     \
        __builtin_amdgcn_global_load_lds((const unsigned*)((const char*)(gbase) + _a), (LAS unsigned*)(lds + (bufoff) + ldsw), 16, 0, 0); \
        __builtin_amdgcn_global_load_lds((const unsigned*)((const char*)(gbase) + _b), (LAS unsigned*)(lds + (bufoff) + ldsw + 8192), 16, 0, 0); } while (0)
#define PG8_STAGE(bufoff, gbase, voff) PG8_STAGE2(bufoff, gbase, (voff)[0], (voff)[1])
#define PG8_STAGE_A(bufoff, nx, h, kt) do { \
        if constexpr (GATHER) { const char* _p = (const char*)g.A + (size_t)(kt) * kstep; \
            if (nx) { PG8_STAGE2(bufoff, _p, nG[h][0], nG[h][1]); } else { PG8_STAGE2(bufoff, _p, cG[h][0], cG[h][1]); } } \
        else { const char* _p = ((nx) ? nA : cA) + (size_t)(h) * hstep + (size_t)(kt) * kstep; PG8_STAGE2(bufoff, _p, voffA[0], voffA[1]); } } while (0)
#define PG8_LDA(dst, b, h) do { _Pragma("unroll") for (int m = 0; m < 4; ++m) { \
        if constexpr (F8) { dst##8[m].lo = *(const LAS v4i32*)(lds + PG8_SA(b, h) + aoff + m * 2048); dst##8[m].hi = *(const LAS v4i32*)(lds + PG8_SA(b, h) + aof1 + m * 2048); } \
        else { dst[m][0] = *(const LAS bf16x8*)(lds + PG8_SA(b, h) + aoff + m * 2048); dst[m][1] = *(const LAS bf16x8*)(lds + PG8_SA(b, h) + aof1 + m * 2048); } } } while (0)
#define PG8_LDB(dst, b, h) do { _Pragma("unroll") for (int n = 0; n < 2; ++n) { \
        if constexpr (F8) { dst##8[n].lo = *(const LAS v4i32*)(lds + PG8_SB(b, h) + boff + n * 2048); dst##8[n].hi = *(const LAS v4i32*)(lds + PG8_SB(b, h) + bof1 + n * 2048); } \
        else { dst[n][0] = *(const LAS bf16x8*)(lds + PG8_SB(b, h) + boff + n * 2048); dst[n][1] = *(const LAS bf16x8*)(lds + PG8_SB(b, h) + bof1 + n * 2048); } } } while (0)
#define PG8_MMA(ai, bj, At, Bt) do { __builtin_amdgcn_s_setprio(1); _Pragma("unroll") for (int m = 0; m < 4; ++m) _Pragma("unroll") for (int n = 0; n < 2; ++n) { \
        if constexpr (F8) asm volatile("v_mfma_scale_f32_16x16x128_f8f6f4 %0, %1, %2, %0, %3, %3 op_sel_hi:[0,0,0]" : "+v"(acc[ai][bj][m][n]) : "v"(Bt##8[n]), "v"(At##8[m]), "v"(one8));   \
        else { _Pragma("unroll") for (int k = 0; k < 2; ++k) acc[ai][bj][m][n] = __builtin_amdgcn_mfma_f32_16x16x32_bf16(Bt[n][k], At[m][k], acc[ai][bj][m][n], 0, 0, 0); } } __builtin_amdgcn_s_setprio(0); } while (0)
#define PG8_WAIT_V(n) asm volatile("s_waitcnt vmcnt(" #n ")" ::: "memory")
#define PG8_WAIT_L(n) asm volatile("s_waitcnt lgkmcnt(" #n ")" ::: "memory")
#define PG8_BAR __builtin_amdgcn_s_barrier()
#define PG8_SCHED __builtin_amdgcn_sched_barrier(0)
#define PG8_GIDX(dst, u) do { _Pragma("unroll") for (int h = 0; h < 2; ++h) _Pragma("unroll") for (int i = 0; i < 2; ++i) { \
        const int _lr = (u).lr0 + h * HALF + rA[i]; const int _tok = (_lr < (u).cnt) ? g.gidx[(u).e * 16384 + _lr] : 0; dst[h][i] = (unsigned)_tok * (unsigned)(LD * 2) + voffA[i]; } } while (0)
    Unit cur, nxt; int ui = 0;
    if (!S.next(0, cur)) return;
#ifdef STAGGER_TICKS
    if (S.short_deal()) { const unsigned long long t0 = __builtin_amdgcn_s_memrealtime(); while (__builtin_amdgcn_s_memrealtime() - t0 < (unsigned long long)(STAGGER_TICKS)) __builtin_amdgcn_s_sleep(8); }
#endif
    f32x4 acc[2][2][4][2];
#pragma unroll
    for (int a = 0; a < 2; ++a)
#pragma unroll
        for (int b = 0; b < 2; ++b)
#pragma unroll
            for (int m = 0; m < 4; ++m)
#pragma unroll
                for (int n = 0; n < 2; ++n) acc[a][b][m][n] = (f32x4){0.f, 0.f, 0.f, 0.f};
    const int one8 = 0x7f7f7f7f;
    bf16x8 At[4][2], B0[2][2], B1[2][2]; v8i32 At8[4], B08[2], B18[2];
    unsigned cG[2][2] = {{0u, 0u}, {0u, 0u}}, nG[2][2] = {{0u, 0u}, {0u, 0u}};
    const char* cA = (const char*)g.A + (size_t)cur.pm * tstep + (size_t)cur.koff * 2; const char* cB = (const char*)g.Bt + ((size_t)cur.e * g.b_estride + (size_t)cur.koff) * 2 + (size_t)cur.pn * tstep;
    const char* nA = cA;
    if constexpr (GATHER) { PG8_GIDX(cG, cur); }
    PG8_STAGE(PG8_SB(0, 0), cB, voffB); PG8_STAGE(PG8_SB(0, 1), cB + hstep, voffB); PG8_STAGE_A(PG8_SA(0, 0), false, 0, 0); PG8_STAGE_A(PG8_SA(0, 1), false, 1, 0);
    if (wr == 1) PG8_BAR;
    PG8_WAIT_V(2); PG8_BAR;
    PG8_STAGE(PG8_SB(1, 0), cB + kstep, voffB); PG8_STAGE_A(PG8_SA(1, 0), false, 0, 1); PG8_STAGE(PG8_SB(1, 1), cB + hstep + kstep, voffB);
    PG8_WAIT_V(6); PG8_BAR;
    for (;;) {
        const bool has_next = S.next(ui + 1, nxt);
        nA = has_next ? (const char*)g.A + (size_t)nxt.pm * tstep + (size_t)nxt.koff * 2 : cA;
        const char* nB = has_next ? (const char*)g.Bt + ((size_t)nxt.e * g.b_estride + (size_t)nxt.koff) * 2 + (size_t)nxt.pn * tstep : cB;
        if constexpr (GATHER) { if (has_next) { PG8_GIDX(nG, nxt); } else {
#pragma unroll
            for (int h = 0; h < 2; ++h)
#pragma unroll
                for (int i = 0; i < 2; ++i) nG[h][i] = cG[h][i]; } }
#pragma nounroll
        for (int t = 0; t < nt; t += 2) {
            const bool last = (t == nt - 2);
            const int kt2 = last ? 0 : t + 2, kt3 = kt2 + 1;
            const char* b2 = last ? nB : cB + (size_t)(t + 2) * kstep;
            const char* b3 = b2 + kstep;
            PG8_LDB(B0, 0, 0); PG8_LDB(B1, 0, 1); PG8_SCHED; PG8_LDA(At, 0, 0); PG8_STAGE_A(PG8_SA(1, 1), false, 1, t + 1);
            PG8_WAIT_V(8); PG8_WAIT_L(0); PG8_BAR; PG8_MMA(0, 0, At, B0); PG8_MMA(0, 1, At, B1); PG8_BAR; PG8_SCHED;
            PG8_LDA(At, 0, 1); PG8_STAGE(PG8_SB(0, 0), b2, voffB); PG8_STAGE(PG8_SB(0, 1), b2 + hstep, voffB); PG8_STAGE_A(PG8_SA(0, 0), last, 0, kt2);
            PG8_WAIT_V(8); PG8_WAIT_L(0); PG8_BAR; PG8_MMA(1, 0, At, B0); PG8_MMA(1, 1, At, B1); PG8_BAR; PG8_SCHED;
            PG8_LDB(B0, 1, 0); PG8_LDB(B1, 1, 1); PG8_SCHED; PG8_LDA(At, 1, 0); PG8_STAGE_A(PG8_SA(0, 1), last, 1, kt2);
            PG8_WAIT_V(8); PG8_WAIT_L(0); PG8_BAR; PG8_MMA(0, 0, At, B0); PG8_MMA(0, 1, At, B1); PG8_BAR; PG8_SCHED;
            PG8_LDA(At, 1, 1); PG8_STAGE(PG8_SB(1, 0), b3, voffB); PG8_STAGE(PG8_SB(1, 1), b3 + hstep, voffB); PG8_STAGE_A(PG8_SA(1, 0), last, 0, kt3);
            PG8_WAIT_V(8); PG8_WAIT_L(0); PG8_BAR; PG8_MMA(1, 0, At, B0); PG8_MMA(1, 1, At, B1); PG8_BAR; PG8_SCHED;
        }
        if constexpr (F8) asm volatile("s_nop 15\n\ts_nop 15" ::: "memory");
        if (wr == 0) PG8_BAR;
        { Unit eu = cur; eu.pm = __builtin_amdgcn_readfirstlane(eu.pm); eu.pn = __builtin_amdgcn_readfirstlane(eu.pn); asm volatile("" : "+s"(eu.pm), "+s"(eu.pn));
          E(acc, eu, wr, wc, fr, fq);
#ifdef EPI2
          if constexpr (Epi::IDEM) E(acc, eu, wr, wc, fr, fq);
#endif
        }
        if (!has_next) break;
#pragma unroll
        for (int a = 0; a < 2; ++a)
#pragma unroll
            for (int b = 0; b < 2; ++b)
#pragma unroll
                for (int m = 0; m < 4; ++m)
#pragma unroll
                    for (int n = 0; n < 2; ++n) acc[a][b][m][n] = (f32x4){0.f, 0.f, 0.f, 0.f};
        cur = nxt; cA = nA; cB = nB; ++ui;
        if constexpr (GATHER) {
#pragma unroll
            for (int h = 0; h < 2; ++h)
#pragma unroll
                for (int i = 0; i < 2; ++i) cG[h][i] = nG[h][i]; }
        if (wr == 1) PG8_BAR;
    }
    PG8_WAIT_V(0);
    PG8_BAR;
#undef PG8_SA
#undef PG8_SB
#undef PG8_STAGE
#undef PG8_STAGE2
#undef PG8_STAGE_A
#undef PG8_LDA
#undef PG8_LDB
#undef PG8_MMA
#undef PG8_WAIT_V
#undef PG8_WAIT_L
#undef PG8_BAR
#undef PG8_SCHED
#undef PG8_GIDX
}
}
namespace pg8 {
constexpr float QA_SCALE = 0.125f * 1.4426950408889634f;
constexpr float QB_SCALE = 0.125f;

struct EpiInProj {
    static constexpr bool PERM = true, IDEM = true;
    bf16_t* base; WT wt;
    __device__ __forceinline__ void operator()(const f32x4 (&acc)[2][2][4][2], const Unit& u, int wr, int wc, int fr, int fq) const {
        const int pn = u.pn;
        size_t toff; int ld, ct; float sc = 1.f; int act = 0;
        constexpr size_t Mi = 1u << 20;
        if (pn < 2)       { toff = 16 * Mi; ld = 512; ct = pn; sc = QA_SCALE; }
        else if (pn < 4)  { toff = 24 * Mi; ld = 512; ct = pn - 2; }
        else if (pn < 6)  { toff = 32 * Mi; ld = 512; ct = pn - 4; }
        else if (pn < 7)  { toff = 0; ld = 256; ct = 0; sc = QB_SCALE; }
        else if (pn < 8)  { toff = 4 * Mi; ld = 256; ct = 0; }
        else if (pn < 10) { toff = 8 * Mi; ld = 512; ct = pn - 8; }
        else if (pn < 12) { toff = 40 * Mi; ld = 512; ct = pn - 10; act = 1; }
        else if (pn < 16) { toff = 48 * Mi; ld = 1024; ct = pn - 12; act = 2; }
        else              { toff = 64 * Mi; ld = 1024; ct = pn - 16; act = 2; }
        const int row0 = u.pm * BM + wr * 64 + fr, col0 = ct * BM + wc * 32 + 8 * fq;
        bf16_t* O = base + toff;
#pragma unroll
        for (int ai = 0; ai < 2; ++ai)
#pragma unroll
            for (int m = 0; m < 4; ++m) { bf16_t* rowp = O + (size_t)(row0 + ai * HALF + m * 16) * ld + col0;
#pragma unroll
                for (int bj = 0; bj < 2; ++bj) { f32x4 v0 = acc[ai][bj][m][0] * sc, v1 = acc[ai][bj][m][1] * sc;
                    if (act) {
#pragma unroll
                        for (int j = 0; j < 4; ++j) { const float s0 = fast_sigmoid(v0[j]), s1 = fast_sigmoid(v1[j]); v0[j] = (act == 1) ? v0[j] * s0 : s0; v1[j] = (act == 1) ? v1[j] * s1 : s1; } }
                    u32x4 w; w.x = cvt_pk_bf16(v0[0], v0[1]); w.y = cvt_pk_bf16(v0[2], v0[3]); w.z = cvt_pk_bf16(v1[0], v1[1]); w.w = cvt_pk_bf16(v1[2], v1[3]);
                    st16(wt, rowp + bj * HALF, w); } }
    }
};

template <int MODE> struct EpiEw {
    static constexpr bool PERM = true, IDEM = (MODE != 2 && MODE != 4);
    bf16_t* O; const bf16_t* G; int ldc; WT wt; float sc = 1.f;
    __device__ __forceinline__ void operator()(const f32x4 (&acc)[2][2][4][2], const Unit& u, int wr, int wc, int fr, int fq) const {
        const int row0 = u.pm * BM + wr * 64 + fr, col0 = u.pn * BM + wc * 32 + 8 * fq;
#pragma unroll
        for (int ai = 0; ai < 2; ++ai)
#pragma unroll
            for (int m = 0; m < 4; ++m) { const size_t ro = (size_t)(row0 + ai * HALF + m * 16) * ldc + col0;
#pragma unroll
                for (int bj = 0; bj < 2; ++bj) { f32x4 v0 = acc[ai][bj][m][0], v1 = acc[ai][bj][m][1];
                    if (MODE == 0) { v0 = v0 * sc; v1 = v1 * sc; }
                    if (MODE == 1 || MODE == 2) { const u32x4 gw = *(const u32x4*)(G + ro + bj * HALF);
                        v0[0] *= bf_lo(gw.x); v0[1] *= bf_hi(gw.x); v0[2] *= bf_lo(gw.y); v0[3] *= bf_hi(gw.y); v1[0] *= bf_lo(gw.z); v1[1] *= bf_hi(gw.z); v1[2] *= bf_lo(gw.w); v1[3] *= bf_hi(gw.w); }
                    if (MODE == 3) {
#pragma unroll
                        for (int j = 0; j < 4; ++j) { v0[j] = fast_sigmoid(v0[j]); v1[j] = fast_sigmoid(v1[j]); } }
                    if (MODE == 2 || MODE == 4) { const u32x4 ow = *(const u32x4*)(O + ro + bj * HALF);
                        if (MODE == 2) { v0[0] += bf_lo(ow.x); v0[1] += bf_hi(ow.x); v0[2] += bf_lo(ow.y); v0[3] += bf_hi(ow.y); v1[0] += bf_lo(ow.z); v1[1] += bf_hi(ow.z); v1[2] += bf_lo(ow.w); v1[3] += bf_hi(ow.w); }
                        else { v0[0] *= bf_lo(ow.x); v0[1] *= bf_hi(ow.x); v0[2] *= bf_lo(ow.y); v0[3] *= bf_hi(ow.y); v1[0] *= bf_lo(ow.z); v1[1] *= bf_hi(ow.z); v1[2] *= bf_lo(ow.w); v1[3] *= bf_hi(ow.w); } }
                    u32x4 w; w.x = cvt_pk_bf16(v0[0], v0[1]); w.y = cvt_pk_bf16(v0[2], v0[3]); w.z = cvt_pk_bf16(v1[0], v1[1]); w.w = cvt_pk_bf16(v1[2], v1[3]);
                    st16(wt, O + ro + bj * HALF, w); } }
    }
};

struct EpiPart {
    static constexpr bool PERM = true, IDEM = true;
    bf16_t* P; int ldc, p0, KCH; size_t plane; WT wt; float sc = 1.f;
    __device__ __forceinline__ void operator()(const f32x4 (&acc)[2][2][4][2], const Unit& u, int wr, int wc, int fr, int fq) const {
        const int row0 = (u.pm - p0) * BM + wr * 64 + fr, col0 = u.pn * BM + wc * 32 + 8 * fq;
        bf16_t* O = P + (size_t)(u.koff / KCH) * plane;
#pragma unroll
        for (int ai = 0; ai < 2; ++ai)
#pragma unroll
            for (int m = 0; m < 4; ++m) { const size_t ro = (size_t)(row0 + ai * HALF + m * 16) * ldc + col0;
#pragma unroll
                for (int bj = 0; bj < 2; ++bj) { const f32x4 v0 = acc[ai][bj][m][0] * sc, v1 = acc[ai][bj][m][1] * sc;
                    u32x4 w; w.x = cvt_pk_bf16(v0[0], v0[1]); w.y = cvt_pk_bf16(v0[2], v0[3]); w.z = cvt_pk_bf16(v1[0], v1[1]); w.w = cvt_pk_bf16(v1[2], v1[3]);
                    st16(wt, O + ro + bj * HALF, w); } }
    }
};

struct EpiGateUp {
    static constexpr bool PERM = true, IDEM = true;
    bf16_t* O; int ldc; WT wt; float qs;
    __device__ __forceinline__ void operator()(const f32x4 (&acc)[2][2][4][2], const Unit& u, int wr, int wc, int fr, int fq) const {
        const int row0 = u.pm * BM + wr * 64 + fr, col0 = u.pn * HALF + wc * 32 + 8 * fq;
#pragma unroll
        for (int ai = 0; ai < 2; ++ai)
#pragma unroll
            for (int m = 0; m < 4; ++m) { bf16_t* rowp = O + (size_t)(row0 + ai * HALF + m * 16) * ldc + col0;
                f32x4 v0, v1;
#pragma unroll
                for (int j = 0; j < 4; ++j) { const float g0 = acc[ai][0][m][0][j], g1 = acc[ai][0][m][1][j];
                    v0[j] = g0 * fast_sigmoid(g0) * acc[ai][1][m][0][j]; v1[j] = g1 * fast_sigmoid(g1) * acc[ai][1][m][1][j];
#ifdef SIM_FP8
                    if (qs != 0.f) { v0[j] = q8(v0[j], qs); v1[j] = q8(v1[j], qs); }
#endif
                }
                u32x4 w; w.x = cvt_pk_bf16(v0[0], v0[1]); w.y = cvt_pk_bf16(v0[2], v0[3]); w.z = cvt_pk_bf16(v1[0], v1[1]); w.w = cvt_pk_bf16(v1[2], v1[3]);
                st16(wt, rowp, w); }
    }
};
struct EpiGateUp8 {
    static constexpr bool PERM = true, IDEM = true;
    unsigned char* O; int ldc; WT wt; float sin, sout;
    __device__ __forceinline__ void operator()(const f32x4 (&acc)[2][2][4][2], const Unit& u, int wr, int wc, int fr, int fq) const {
        const int row0 = u.pm * BM + wr * 64 + fr, col0 = u.pn * HALF + wc * 32 + 8 * fq;
#pragma unroll
        for (int ai = 0; ai < 2; ++ai)
#pragma unroll
            for (int m = 0; m < 4; ++m) { unsigned char* rowp = O + (size_t)(row0 + ai * HALF + m * 16) * ldc + col0;
                f32x4 v0, v1;
#pragma unroll
                for (int j = 0; j < 4; ++j) { const float g0 = acc[ai][0][m][0][j] * sin, g1 = acc[ai][0][m][1][j] * sin;
                    v0[j] = g0 * fast_sigmoid(g0) * (acc[ai][1][m][0][j] * (sin * sout)); v1[j] = g1 * fast_sigmoid(g1) * (acc[ai][1][m][1][j] * (sin * sout)); }
                u32x2 w; w.x = pk4_fp8(v0[0], v0[1], v0[2], v0[3]); w.y = pk4_fp8(v1[0], v1[1], v1[2], v1[3]);
                *(u32x2*)rowp = w; }
    }
};
}
#ifndef MK_DBG
#define MK_DBG 0
#endif
#ifndef MOE_FP8
#define MOE_FP8 1
#endif
constexpr int D = 1024, NB = 8, SEQ = 2048, T = NB * SEQ, DEPTH = 2, CH = 64, NCH = SEQ / CH, NPREV = 8;
constexpr int AH = 8, BH = 4, GR = 16, DFF = 2816, NE = 8, DFE = 3584, PLE = 256, INW = 5136, INWG = 5120, RELN = 257;
constexpr float EPS = 1e-6f, LOG2E = 1.4426950408889634f;
constexpr int NWAVES = 8, NTHR = 512;
constexpr int MOE_ROWS = 34816;

constexpr size_t MiB = 1u << 20;
constexpr size_t WS_CTL = 0, CTL_ZERO_BYTES = 256 * 1024;
constexpr size_t WS_TOKINFO = 1 * MiB;
constexpr size_t WS_IDXE = 2 * MiB;
constexpr size_t WS_DEC = 3 * MiB;
constexpr size_t WS_W1 = 4 * MiB;
constexpr size_t WS_PB = 189 * MiB;
constexpr size_t WS_G = 205 * MiB;
constexpr size_t WS_HB = WS_G, WS_DST = WS_G + 32 * MiB, WS_YSLOT = WS_G;
constexpr size_t WS_BIG = 273 * MiB;
constexpr size_t WS_W0 = WS_BIG, WS_PROJ = WS_BIG + 34 * MiB, WS_MACT = WS_BIG;
constexpr size_t WS_Y = WS_PROJ;
constexpr size_t WS_QB = WS_PROJ, WS_KB = WS_PROJ + 8 * MiB, WS_VB = WS_PROJ + 16 * MiB, WS_QA = WS_PROJ + 32 * MiB, WS_KA = WS_PROJ + 48 * MiB, WS_VA = WS_PROJ + 64 * MiB;
constexpr size_t WS_SR = WS_PROJ + 80 * MiB, WS_SGA = WS_PROJ + 96 * MiB, WS_SGB = WS_PROJ + 128 * MiB;
constexpr size_t WS_MERGED = WS_KA;
constexpr size_t WS_ST = WS_KA;
constexpr size_t WS_FACT = WS_QA;
constexpr size_t WS_YA = WS_PROJ + 160 * MiB, WS_YB = WS_PROJ + 176 * MiB;
constexpr size_t WS_XB = WS_SGB;
constexpr int MOE_MAIN_PANELS = 128, MOE_MAIN_ROWS = MOE_MAIN_PANELS * 256, TAIL_KC = MOE_FP8 ? 7 : 14, TAIL_KCH = 256  , TAIL_ROWS = MOE_ROWS - MOE_MAIN_ROWS;
constexpr size_t WS_END = 511 * MiB;
static_assert(WS_FACT + (size_t)T * DFF * 2 <= WS_XB && WS_MACT + (size_t)MOE_ROWS * DFE * 2 <= WS_END && WS_YSLOT + (size_t)MOE_ROWS * D * 2 <= WS_BIG && WS_SGB + 32 * MiB <= WS_YA && WS_YB + 16 * MiB <= WS_END, "d_ws map");
constexpr size_t OFF_WIN = 0, OFF_WGD = 10 * MiB, OFF_WBA = 10 * MiB + 65536, OFF_WBB = OFF_WBA + 1 * MiB, OFF_WOUT = OFF_WBB + 1 * MiB, OFF_WPP = OFF_WOUT + 2 * MiB, OFF_WPG = OFF_WPP + MiB / 2;
constexpr size_t OFF_FFN = 17 * MiB;
constexpr size_t OFF_FDN = OFF_FFN + 11 * MiB, OFF_MDN = OFF_FFN + 8 * 14 * MiB;
constexpr size_t OFF_MDN8 = OFF_FFN + 8 * 7 * MiB;
constexpr float W8_SCALE = 64.f, ACT8_SCALE = 8.f;
constexpr size_t WS_XS = WS_W1 + OFF_MDN8 + 8 * 7 * MiB / 2;
static_assert(MOE_FP8 && WS_XS + (size_t)T * D * 2 <= WS_PB, "x stream placement needs the e4m3 weight layout");
constexpr size_t WS_PBUF = WS_W1 + OFF_FFN;
static_assert((size_t)TAIL_KC * TAIL_ROWS * D * 2 <= (MOE_FP8 ? 8 * 7 : 8 * 14) * MiB, "partial planes");
static_assert(OFF_WPG + 2 * MiB <= OFF_FFN && WS_W1 + OFF_MDN + 8 * 7 * MiB <= WS_PB && OFF_FDN + (size_t)D * DFF * 2 <= 34 * MiB, "weight map");
constexpr int CW_BAR = 4096;
constexpr int CW_CNT = 8192;
constexpr int CW_DBG = 16384;

constexpr int RING_BYTES = 131072;
constexpr int LDSCTL_OFF = RING_BYTES, MISC_OFF = LDSCTL_OFF + 320;
constexpr int XTRA_OFF = RING_BYTES + 1024;
constexpr int LDS_BYTES = 147456;

typedef GAS unsigned gu32;
#define RLX_AGENT __ATOMIC_RELAXED, __HIP_MEMORY_SCOPE_AGENT
#define LDS_WAIT() asm volatile("s_waitcnt lgkmcnt(0)" ::: "memory")
#define VM_WAIT() asm volatile("s_waitcnt vmcnt(0)" ::: "memory")

#define XB_TMO      128
#define XB_XCNT(j)  (256  + 64 * (j))
#define XB_XSUB(j)  (1280 + 64 * (j))
#define XB_XGEN(j)  (2304 + 64 * (j))
#define XB_TOP      3328
#define XB_TOPGEN   3392
#define XCD_BAR_WORDS 3456
#define XB_SPIN_CAP (1u << 18)
__device__ __forceinline__ unsigned xb_ld(unsigned* p)              { return __hip_atomic_load(p, __ATOMIC_RELAXED, __HIP_MEMORY_SCOPE_AGENT); }
__device__ __forceinline__ unsigned xb_add(unsigned* p, unsigned v) { return __hip_atomic_fetch_add(p, v, __ATOMIC_RELAXED, __HIP_MEMORY_SCOPE_AGENT); }
__device__ __forceinline__ unsigned xb_xcc_id() { return (unsigned)__builtin_amdgcn_s_getreg((3 << 11) | 20) & 0xFu; }
#define XB_SPIN(cond, bar) do { unsigned _sp = 0; while (cond) { __builtin_amdgcn_s_sleep(1); \
    if ((++_sp & 255u) == 0u) { if (xb_ld(&(bar)[XB_TMO])) break; if (_sp > XB_SPIN_CAP) { atomicAdd(&(bar)[XB_TMO], 1u); break; } } } } while (0)
struct XcdBarrier { unsigned* bar; unsigned x; volatile LAS unsigned* st; };
__device__ __forceinline__ XcdBarrier xcd_barrier_post(unsigned* bar, volatile LAS unsigned* st) {
    XcdBarrier b; b.bar = bar; b.x = xb_xcc_id(); b.st = st;
    if (threadIdx.x == 0) (void)xb_add(&bar[XB_XCNT(b.x)], 1u);
    return b;
}
__device__ __forceinline__ void xcd_barrier_complete(unsigned* bar, unsigned x, unsigned& nloc, unsigned& nx) {
    const unsigned G = gridDim.x * gridDim.y * gridDim.z;
    unsigned sum, cnt, mine, sp = 0u;
    for (;;) {
        sum = 0u; cnt = 0u; mine = 0u;
#pragma unroll
        for (unsigned j = 0; j < 16; ++j) { const unsigned c = xb_ld(&bar[XB_XCNT(j)]); sum += c; cnt += (c > 0u) ? 1u : 0u; mine = (j == x) ? c : mine; }
        if (sum == G) break;
        __builtin_amdgcn_s_sleep(1);
        if ((++sp & 255u) == 0u) { if (xb_ld(&bar[XB_TMO])) break; if (sp > XB_SPIN_CAP) { atomicAdd(&bar[XB_TMO], 1u); break; } }
    }
    nloc = mine > 0u ? mine : 1u; nx = cnt > 0u ? cnt : 1u;
}
__device__ __forceinline__ void xcd_barrier(const XcdBarrier& b) {
    asm volatile("s_waitcnt vmcnt(0)" ::: "memory");
    __syncthreads();
    if (threadIdx.x == 0) {
        unsigned* bar = b.bar;
        __builtin_amdgcn_s_waitcnt(0);
        unsigned nloc = b.st[0], nx = b.st[1];
        if (nloc == 0u) { xcd_barrier_complete(bar, b.x, nloc, nx); b.st[0] = nloc; b.st[1] = nx; }
        const unsigned old = xb_add(&bar[XB_XSUB(b.x)], 1u);
        const unsigned gen = old / nloc;
        if (old + 1u == (gen + 1u) * nloc) {
            __builtin_amdgcn_fence(__ATOMIC_RELEASE, "agent");
            asm volatile("s_waitcnt vmcnt(0)" ::: "memory");
            const unsigned og = xb_add(&bar[XB_TOP], 1u);
            const unsigned tg = og / nx;
            if (og + 1u == (tg + 1u) * nx) xb_add(&bar[XB_TOPGEN], 1u);
            else XB_SPIN(xb_ld(&bar[XB_TOPGEN]) == tg, bar);
            __builtin_amdgcn_fence(__ATOMIC_ACQUIRE, "agent");
            xb_add(&bar[XB_XGEN(b.x)], 1u);
            asm volatile("s_waitcnt vmcnt(0)" ::: "memory");
        } else {
            XB_SPIN(xb_ld(&bar[XB_XGEN(b.x)]) == gen, bar);
            __builtin_amdgcn_fence(__ATOMIC_ACQUIRE, "agent");
            asm volatile("s_waitcnt vmcnt(0)" ::: "memory");
        }
    }
    __syncthreads();
}

struct Args { const float* in[24]; float* out; unsigned char* ws; int ph_lo, ph_hi, sub, pad; };
enum { I_X = 0, I_P, I_WIN, I_RELB, I_WGUP, I_BG, I_GNORM, I_WBA, I_WBB, I_WOUT, I_NMPRE, I_NMPOST, I_NFPRE, I_NFPOST, I_FG, I_FU, I_FD, I_RW, I_MG, I_MU, I_MD, I_PP, I_PG, I_PNORM };
#define FRESH(F) do { int _t = threadIdx.x; asm volatile("" : "+v"(_t)); (F).tid = _t; (F).lane = _t & 63; (F).wave = __builtin_amdgcn_readfirstlane(_t >> 6); } while (0)
struct Frame {
    LAS unsigned char* lds;
    volatile LAS unsigned* MISC;
    gu32* ctl;
    unsigned char* ws;
    int tid, lane, wave;
    int vcu, G;
    float* x;
    bf16_t* xs;
};

__device__ __forceinline__ float sumsq16(const f32x4 (&v)[4]) {
    float s = 0.f;
#pragma unroll
    for (int j = 0; j < 4; ++j) s += (v[j].x * v[j].x + v[j].y * v[j].y) + (v[j].z * v[j].z + v[j].w * v[j].w);
    return wave_sum(s);
}
__device__ __forceinline__ void ld_bf16_row(const bf16_t* row, int lane, f32x4 (&v)[4]) {
#pragma unroll
    for (int j = 0; j < 4; ++j) { const u32x2 w = ((const u32x2*)row)[lane + 64 * j]; v[j] = (f32x4){bf_lo(w.x), bf_hi(w.x), bf_lo(w.y), bf_hi(w.y)}; }
}
__device__ __forceinline__ void st_bf16_row(bf16_t* row, int lane, const f32x4 (&v)[4]) {
#pragma unroll
    for (int j = 0; j < 4; ++j) { u32x2 w; w.x = cvt_pk_bf16(v[j].x, v[j].y); w.y = cvt_pk_bf16(v[j].z, v[j].w); ((u32x2*)row)[lane + 64 * j] = w; }
}
__device__ __forceinline__ void ld_moe_row(const unsigned char* ws, int s, int lane, f32x4 (&v)[4]) {
    if (s < MOE_MAIN_ROWS) { ld_bf16_row((const bf16_t*)(ws + WS_YSLOT) + (size_t)s * D, lane, v); return; }
    const bf16_t* p = (const bf16_t*)(ws + WS_PBUF) + (size_t)(s - MOE_MAIN_ROWS) * D;
#pragma unroll
    for (int j = 0; j < 4; ++j) v[j] = (f32x4){0.f, 0.f, 0.f, 0.f};
#pragma unroll 1
    for (int k0 = 0; k0 < TAIL_KC; k0 += 7) {
        u32x2 w[7][4];
#pragma unroll
        for (int q = 0; q < 7; ++q)
#pragma unroll
            for (int j = 0; j < 4; ++j) w[q][j] = ((const u32x2*)(p + (size_t)(k0 + q) * TAIL_ROWS * D))[lane + 64 * j];
#pragma unroll
        for (int q = 0; q < 7; ++q)
#pragma unroll
            for (int j = 0; j < 4; ++j) v[j] = v[j] + (f32x4){bf_lo(w[q][j].x), bf_hi(w[q][j].x), bf_lo(w[q][j].y), bf_hi(w[q][j].y)};
    }
}
template <int SRC, int OUT, bool ROUTE>
__device__ __forceinline__ void thin_phase(Frame& F, const float* xin, const bf16_t* ysrc, const float* g_add, const float* g_out, bf16_t* obuf, const float* router_w) {
    FRESH(F);
    const int lane = F.lane;
    unsigned* tokinfo = (unsigned*)(F.ws + WS_TOKINFO);
    int* idxe = (int*)(F.ws + WS_IDXE);
    unsigned* gcnt = (unsigned*)(F.ctl + CW_CNT);
    LAS float* rwT = (LAS float*)(F.lds);
    LAS unsigned* lcnt = (LAS unsigned*)(F.lds + 32768);
    LAS unsigned* rinfo = (LAS unsigned*)(F.lds + 32768 + 64);
    if constexpr (ROUTE) {
        for (int i = F.tid; i < D * NE; i += NTHR) rwT[(i & 7) * D + (i >> 3)] = router_w[i];
        if (F.tid < 16) lcnt[F.tid] = 0u;
        __syncthreads();
    }
    int pbase[8];
    if constexpr (SRC == 2) { int acc = 0;
#pragma unroll
        for (int e = 0; e < 8; ++e) { pbase[e] = acc; acc += (((int)gcnt[e] + 255) >> 8) << 8; } }
    f32x4 ga[4], go[4];
#pragma unroll
    for (int j = 0; j < 4; ++j) { ga[j] = (SRC != 0) ? ((const f32x4*)g_add)[lane + 64 * j] : (f32x4){0.f, 0.f, 0.f, 0.f}; go[j] = (OUT == 1) ? ((const f32x4*)g_out)[lane + 64 * j] : (f32x4){0.f, 0.f, 0.f, 0.f}; }
    const int gw = F.vcu * NWAVES + F.wave, NGW = F.G * NWAVES;
    int rs = 0;
    for (int m = gw; m < T; m += NGW, ++rs) {
        f32x4 xv[4];
        if constexpr (SRC == 0) {
#pragma unroll
            for (int j = 0; j < 4; ++j) xv[j] = ((const f32x4*)(xin + (size_t)m * D))[lane + 64 * j];
        } else {
            f32x4 yv[4];
            if constexpr (SRC == 1) ld_bf16_row(ysrc + (size_t)m * D, lane, yv);
            else {
                const unsigned* ti = tokinfo + (size_t)m * 8;
                const int e1 = (int)ti[0], p1 = (int)ti[1], e2 = (int)ti[2], p2 = (int)ti[3]; const float w1 = __uint_as_float(ti[4]), w2 = __uint_as_float(ti[5]);
                int b1 = 0, b2 = 0;
#pragma unroll
                for (int e = 0; e < 8; ++e) { b1 = (e == e1) ? pbase[e] : b1; b2 = (e == e2) ? pbase[e] : b2; }
                f32x4 ya[4], yb[4];
                ld_moe_row(F.ws, b1 + p1, lane, ya); ld_moe_row(F.ws, b2 + p2, lane, yb);
#pragma unroll
                for (int j = 0; j < 4; ++j) yv[j] = ya[j] * w1 + yb[j] * w2;
            }
            const float rstd = __builtin_amdgcn_rsqf(sumsq16(yv) * (1.f / D) + EPS);
            if (xin) {
#pragma unroll
                for (int j = 0; j < 4; ++j) { const f32x4 xo = ((const f32x4*)(xin + (size_t)m * D))[lane + 64 * j]; xv[j] = xo + yv[j] * rstd * ga[j]; }
            } else { f32x4 xo[4]; ld_bf16_row(F.xs + (size_t)m * D, lane, xo);
#pragma unroll
                for (int j = 0; j < 4; ++j) xv[j] = xo[j] + yv[j] * rstd * ga[j]; }
        }
#ifdef SIM_XBF16
        if constexpr (SRC != 0 && OUT != 0) {
#pragma unroll
            for (int j = 0; j < 4; ++j) { const unsigned a = cvt_pk_bf16(xv[j].x, xv[j].y), b = cvt_pk_bf16(xv[j].z, xv[j].w); xv[j] = (f32x4){bf_lo(a), bf_hi(a), bf_lo(b), bf_hi(b)}; } }
#endif
        if constexpr (SRC != 0) {
#pragma unroll
            for (int j = 0; j < 4; ++j) { if constexpr (OUT == 0) ((f32x4*)(F.x + (size_t)m * D))[lane + 64 * j] = xv[j]; }
            if constexpr (OUT != 0) st_bf16_row(F.xs + (size_t)m * D, lane, xv); }
        if constexpr (OUT == 1) {
            const float rstd = __builtin_amdgcn_rsqf(sumsq16(xv) * (1.f / D) + EPS);
            f32x4 hv[4];
#pragma unroll
            for (int j = 0; j < 4; ++j) hv[j] = xv[j] * rstd * go[j];
#if MOE_FP8
            if constexpr (ROUTE) {
#pragma unroll
                for (int j = 0; j < 4; ++j) ((unsigned*)((unsigned char*)obuf + (size_t)m * D))[lane + 64 * j] = pk4_fp8(hv[j].x, hv[j].y, hv[j].z, hv[j].w);
            } else
#elif defined(SIM_FP8)
            if constexpr (ROUTE) { f32x4 hq[4];
#pragma unroll
                for (int j = 0; j < 4; ++j) hq[j] = (f32x4){q8(hv[j].x, 1.f), q8(hv[j].y, 1.f), q8(hv[j].z, 1.f), q8(hv[j].w, 1.f)};
                st_bf16_row(obuf + (size_t)m * D, lane, hq); } else
#endif

            st_bf16_row(obuf + (size_t)m * D, lane, hv);
            if constexpr (ROUTE) {
                float lg[8];
#pragma unroll
                for (int e = 0; e < 8; ++e) { float s = 0.f;
#pragma unroll
                    for (int j = 0; j < 4; ++j) { const f32x4 w = *(const LAS f32x4*)(rwT + e * D + 4 * lane + 256 * j); s += (hv[j].x * w.x + hv[j].y * w.y) + (hv[j].z * w.z + hv[j].w * w.w); }
                    lg[e] = wave_sum(s); }
                int e1 = 0; float v1 = lg[0];
#pragma unroll
                for (int e = 1; e < 8; ++e) if (lg[e] > v1) { v1 = lg[e]; e1 = e; }
                int e2 = -1; float v2 = -3.0e38f;
#pragma unroll
                for (int e = 0; e < 8; ++e) if (e != e1 && lg[e] > v2) { v2 = lg[e]; e2 = e; }
                const float ex = __expf(v2 - v1), w1 = 1.f / (1.f + ex), w2 = ex * w1;
                if (lane == 0) {
                    const unsigned p1 = atomicAdd((unsigned*)&lcnt[e1], 1u), p2 = atomicAdd((unsigned*)&lcnt[e2], 1u);
                    LAS unsigned* ri = rinfo + (F.wave * 8 + rs) * 6;
                    ri[0] = (unsigned)e1; ri[1] = p1; ri[2] = (unsigned)e2; ri[3] = p2; ri[4] = __float_as_uint(w1); ri[5] = __float_as_uint(w2);
                }
            }
        }
    }
    if constexpr (ROUTE) {
        __syncthreads();
        if (F.tid < 8) lcnt[8 + F.tid] = __hip_atomic_fetch_add(gcnt + F.tid, lcnt[F.tid], RLX_AGENT);
        __syncthreads();
        if (lane < rs) {
            const int m = gw + lane * NGW; const LAS unsigned* ri = rinfo + (F.wave * 8 + lane) * 6;
            const unsigned e1 = ri[0], e2 = ri[2]; const unsigned p1 = ri[1] + lcnt[8 + e1], p2 = ri[3] + lcnt[8 + e2];
            unsigned* ti = tokinfo + (size_t)m * 8; ti[0] = e1; ti[1] = p1; ti[2] = e2; ti[3] = p2; ti[4] = ri[4]; ti[5] = ri[5];
            idxe[e1 * 16384 + p1] = m; idxe[e2 * 16384 + p2] = m;
        }
    }
}
#ifdef SIM_FP8
#define SIMQ(x, s) (((s) != 0.f) ? q8((x), (s)) : (x))
#else
#define SIMQ(x, s) (x)
#endif
struct TrItem { const float* src; int pitch; bf16_t* dst; int dstK; int ncols; float qs; int f8; };
#define TR_LOAD(t, v) do { _Pragma("unroll") for (int i = 0; i < 64; ++i) { const int kk = 2 * i + (lane >> 5); v[i] = ((lane & 31) < (t).ncols) ? (t).src[(size_t)kk * (t).pitch + (lane & 31)] : 0.f; } } while (0)
__device__ __forceinline__ void tr_finish(const TrItem& t, float (&v)[64], LAS float* scr, int lane) {
    const int c = lane & 31;
#pragma unroll
    for (int p = 0; p < 2; ++p) {
#pragma unroll
        for (int i = 0; i < 32; ++i) { const int kk = 2 * i + (lane >> 5); scr[kk * 33 + c] = SIMQ(v[32 * p + i], t.qs); }
        LDS_WAIT(); asm volatile("" ::: "memory");
        if (t.f8) {
            const int c4 = lane & 3;
#pragma unroll
            for (int j = 0; j < 2; ++j) { const int n = (lane >> 2) + 16 * j; const LAS float* s = scr + (16 * c4) * 33 + n;
                u32x4 o; o.x = pk4_fp8(s[0 * 33] * W8_SCALE, s[1 * 33] * W8_SCALE, s[2 * 33] * W8_SCALE, s[3 * 33] * W8_SCALE); o.y = pk4_fp8(s[4 * 33] * W8_SCALE, s[5 * 33] * W8_SCALE, s[6 * 33] * W8_SCALE, s[7 * 33] * W8_SCALE);
                o.z = pk4_fp8(s[8 * 33] * W8_SCALE, s[9 * 33] * W8_SCALE, s[10 * 33] * W8_SCALE, s[11 * 33] * W8_SCALE); o.w = pk4_fp8(s[12 * 33] * W8_SCALE, s[13 * 33] * W8_SCALE, s[14 * 33] * W8_SCALE, s[15 * 33] * W8_SCALE);
                *(u32x4*)((unsigned char*)t.dst + (size_t)n * t.dstK + 64 * p + 16 * c4) = o; }
        } else {
            const int c8 = lane & 7;
#pragma unroll
            for (int j = 0; j < 4; ++j) { const int n = (lane >> 3) + 8 * j; const LAS float* s = scr + (8 * c8) * 33 + n;
                u32x4 o; o.x = cvt_pk_bf16(s[0 * 33], s[1 * 33]); o.y = cvt_pk_bf16(s[2 * 33], s[3 * 33]); o.z = cvt_pk_bf16(s[4 * 33], s[5 * 33]); o.w = cvt_pk_bf16(s[6 * 33], s[7 * 33]);
                if (n < t.ncols) *(u32x4*)(t.dst + (size_t)n * t.dstK + 64 * p + 8 * c8) = o; }
        }
        LDS_WAIT(); asm volatile("" ::: "memory");
    }
}
constexpr int IT_COMMON = 640 + 640 + 8 + 128 + 128 + 256 + 64 + 256;
constexpr int IT_FFN = 3 * 704, IT_MOE1 = 8 * 896;
constexpr int IT_TOTAL = 2 * IT_COMMON + IT_FFN + 3 * IT_MOE1;
__device__ __forceinline__ TrItem seg_plain(const float* src, int K, int N, int pitch, bf16_t* dst, int r) {
    const int nkb = K / 128, nb = r / nkb, kb = r % nkb;
    return TrItem{src + (size_t)kb * 128 * pitch + nb * 32, pitch, dst + (size_t)(nb * 32) * K + kb * 128, K, 32, 0.f, 0};
}
__device__ __forceinline__ TrItem seg_gu(const float* src, int N, bf16_t* dst, int up, int r) {
    const int nb = r / (D / 128), kb = r % (D / 128), n0 = nb * 32;
    return TrItem{src + (size_t)kb * 128 * N + n0, N, dst + (size_t)((n0 >> 7) * 256 + (n0 & 127) + up * 128) * D + kb * 128, D, 32, 0.f, 0};
}
__device__ __forceinline__ TrItem decode_item(const Args& a, unsigned char* ws, int it) {
    if (it < 2 * IT_COMMON) {
        const int l = it / IT_COMMON; int r = it % IT_COMMON; unsigned char* wb = ws + (l ? WS_W1 : WS_W0);
        const float* win = a.in[I_WIN] + (size_t)l * D * INW;
        if (r < 640) return seg_plain(win, D, 2560, INW, (bf16_t*)(wb + OFF_WIN), r); r -= 640;
        if (r < 640) return seg_plain(win + 2576, D, 2560, INW, (bf16_t*)(wb + OFF_WIN) + (size_t)2560 * D, r); r -= 640;
        if (r < 8) return TrItem{win + (size_t)r * 128 * INW + 2560, INW, (bf16_t*)(wb + OFF_WGD) + r * 128, D, 16, 0.f, 0}; r -= 8;
        if (r < 128) return seg_plain(a.in[I_WBA] + (size_t)l * 512 * D, 512, D, D, (bf16_t*)(wb + OFF_WBA), r); r -= 128;
        if (r < 128) return seg_plain(a.in[I_WBB] + (size_t)l * 512 * D, 512, D, D, (bf16_t*)(wb + OFF_WBB), r); r -= 128;
        if (r < 256) return seg_plain(a.in[I_WOUT] + (size_t)l * D * D, D, D, D, (bf16_t*)(wb + OFF_WOUT), r); r -= 256;
        if (r < 64) return seg_plain(a.in[I_PP] + (size_t)l * PLE * D, PLE, D, D, (bf16_t*)(wb + OFF_WPP), r); r -= 64;
        return seg_plain(a.in[I_PG] + (size_t)l * D * D, D, D, D, (bf16_t*)(wb + OFF_WPG), r);
    }
    it -= 2 * IT_COMMON;
    if (it < IT_FFN) {
        unsigned char* wb = ws + WS_W0;
        if (it < 704) return seg_gu(a.in[I_FG], DFF, (bf16_t*)(wb + OFF_FFN), 0, it); it -= 704;
        if (it < 704) return seg_gu(a.in[I_FU], DFF, (bf16_t*)(wb + OFF_FFN), 1, it); it -= 704;
        return seg_plain(a.in[I_FD], DFF, D, D, (bf16_t*)(wb + OFF_FDN), it);
    }
    it -= IT_FFN;
    unsigned char* wb = ws + WS_W1;
    const int kind = it / IT_MOE1, r0 = it % IT_MOE1, e = r0 / 896, r = r0 % 896;
    TrItem t;
#if MOE_FP8
    { const int nkb8 = (kind == 2 ? DFE : D) / 128, nb8 = r / nkb8, kb8 = r % nkb8, n0 = nb8 * 32;
      if (kind == 2) return TrItem{a.in[I_MD] + (size_t)e * DFE * D + (size_t)kb8 * 128 * D + n0, D, (bf16_t*)(wb + OFF_MDN8 + (size_t)e * D * DFE + (size_t)n0 * DFE + kb8 * 128), DFE, 32, 0.f, 1};
      const float* src = (kind == 0 ? a.in[I_MG] : a.in[I_MU]) + (size_t)e * D * DFE + (size_t)kb8 * 128 * DFE + n0;
      return TrItem{src, DFE, (bf16_t*)(wb + OFF_FFN + (size_t)e * 7168 * D + (size_t)((n0 >> 7) * 256 + (n0 & 127) + (kind == 1 ? 128 : 0)) * D + kb8 * 128), D, 32, 0.f, 1}; }
#endif
    if (kind == 0) t = seg_gu(a.in[I_MG] + (size_t)e * D * DFE, DFE, (bf16_t*)(wb + OFF_FFN) + (size_t)e * 7168 * D, 0, r);
    else if (kind == 1) t = seg_gu(a.in[I_MU] + (size_t)e * D * DFE, DFE, (bf16_t*)(wb + OFF_FFN) + (size_t)e * 7168 * D, 1, r);
    else t = seg_plain(a.in[I_MD] + (size_t)e * DFE * D, DFE, D, D, (bf16_t*)(wb + OFF_MDN) + (size_t)e * D * DFE, r);
#ifdef SIM_FP8
    t.qs = 64.f;
#endif
    return t;
}
__device__ __forceinline__ void p0_prologue(Frame& F, const Args& a) {
    FRESH(F);
    LAS float* scr = (LAS float*)(F.lds + F.wave * 16384);
    const int gw = F.vcu * NWAVES + F.wave, NGW = F.G * NWAVES;
    { const int lane = F.lane;
      for (int it = gw; it < IT_TOTAL; it += NGW) { const TrItem t = decode_item(a, F.ws, it); float v[64]; TR_LOAD(t, v); tr_finish(t, v, scr, lane); } }
    { const f32x4* ps = (const f32x4*)a.in[I_P]; u32x4* pd = (u32x4*)(F.ws + WS_PB); const int n8 = 2 * T * PLE / 8;
      for (int i = blockIdx.x * NTHR + F.tid; i < n8; i += F.G * NTHR) { const f32x4 v0 = ps[2 * i], v1 = ps[2 * i + 1];
          u32x4 w; w.x = cvt_pk_bf16(v0.x, v0.y); w.y = cvt_pk_bf16(v0.z, v0.w); w.z = cvt_pk_bf16(v1.x, v1.y); w.w = cvt_pk_bf16(v1.z, v1.w); pd[i] = w; } }
    thin_phase<0, 1, false>(F, a.in[I_X], nullptr, nullptr, a.in[I_NMPRE], (bf16_t*)(F.ws + WS_HB), nullptr);
}
typedef short v4i16_t __attribute__((ext_vector_type(4)));
__device__ __forceinline__ s16x4 lds_tr16(const LAS unsigned char* p) { return __builtin_bit_cast(s16x4, __builtin_amdgcn_ds_read_tr16_b64_v4i16((LAS v4i16_t*)p)); }
__device__ __forceinline__ bf16x8 cat8(s16x4 a, s16x4 b) { return (bf16x8){a[0], a[1], a[2], a[3], b[0], b[1], b[2], b[3]}; }

__device__ __forceinline__ void attn_unit(Frame& F, int b, int c, const float* relb) {
    FRESH(F);
    const int lane = F.lane, h = F.wave, n = lane & 15, mq = lane >> 4;
    const bf16_t* qa = (const bf16_t*)(F.ws + WS_QA); const bf16_t* ka = (const bf16_t*)(F.ws + WS_KA); const bf16_t* va = (const bf16_t*)(F.ws + WS_VA);
    LAS unsigned char* kbuf = F.lds + h * 16384; LAS unsigned char* vbuf = kbuf + 8192;
    LAS float* rt = (LAS float*)(F.lds + XTRA_OFF + h * 1056);
    for (int i = lane; i < 256; i += 64) { const int j = i - 64; rt[i] = relb[h * RELN + 256 - (j > 0 ? j : 0)] * LOG2E; }
    const float bfar = relb[h * RELN + 256] * LOG2E;
    const int tok0 = b * SEQ + c * CH;
    bf16x8 qf[4][2];
#pragma unroll
    for (int qt = 0; qt < 4; ++qt)
#pragma unroll
        for (int ks = 0; ks < 2; ++ks) qf[qt][ks] = *(const bf16x8*)(qa + (size_t)(tok0 + 16 * qt + n) * 512 + h * 64 + 32 * ks + 8 * mq);
    const int koff_e = (lane >> 3) * 512 + (((lane & 7) ^ ((lane >> 4) & 7)) * 8), koff_o = (lane >> 3) * 512 + (((lane & 7) ^ ((4 + (lane >> 4)) & 7)) * 8);
    const int voff = (lane >> 3) * 512 + ((2 * (((lane & 7) >> 1) ^ (lane >> 4)) + (lane & 1)) * 8);
#define ATT_DMA_K(j) do { const bf16_t* _s = ka + (size_t)(b * SEQ + (j) * CH) * 512 + h * 64; _Pragma("unroll") for (int _i = 0; _i < 8; ++_i) \
        __builtin_amdgcn_global_load_lds((const unsigned*)(_s + (size_t)_i * 8 * 512 + ((_i & 1) ? koff_o : koff_e)), (LAS unsigned*)(kbuf + _i * 1024), 16, 0, 0); } while (0)
#define ATT_DMA_V(j) do { const bf16_t* _s = va + (size_t)(b * SEQ + (j) * CH) * 512 + h * 64; _Pragma("unroll") for (int _i = 0; _i < 8; ++_i) \
        __builtin_amdgcn_global_load_lds((const unsigned*)(_s + (size_t)_i * 8 * 512 + voff), (LAS unsigned*)(vbuf + _i * 1024), 16, 0, 0); } while (0)
    const int ka0 = n * 128 + (((0 + mq) ^ (n >> 1)) * 16), ka1 = n * 128 + (((4 + mq) ^ (n >> 1)) * 16);
    const int qp = n >> 2, pp = lane & 3, sw = 2 * (mq & 1) + (qp >> 1);
    const int vrow = (4 * mq + qp) * 128 + 8 * pp;
    f32x4 O[4][4]; float mrun[4], lsum[4];
#pragma unroll
    for (int qt = 0; qt < 4; ++qt) { mrun[qt] = -1.0e30f; lsum[qt] = 0.f;
#pragma unroll
        for (int dt = 0; dt < 4; ++dt) O[qt][dt] = (f32x4){0.f, 0.f, 0.f, 0.f}; }
    const int j0 = (c - NPREV) > 0 ? (c - NPREV) : 0;
    ATT_DMA_K(j0); ATT_DMA_V(j0);
    for (int j = j0; j <= c; ++j) {
        const int dc = c - j;
        asm volatile("s_waitcnt vmcnt(8)" ::: "memory");
#pragma unroll
        for (int qg = 0; qg < 2; ++qg) {
            f32x4 S[4][2];
#pragma unroll
            for (int kt = 0; kt < 4; ++kt) {
                const bf16x8 k0 = *(const LAS bf16x8*)(kbuf + kt * 2048 + ka0), k1 = *(const LAS bf16x8*)(kbuf + kt * 2048 + ka1);
#pragma unroll
                for (int q2 = 0; q2 < 2; ++q2) { f32x4 z = (f32x4){0.f, 0.f, 0.f, 0.f};
                    z = __builtin_amdgcn_mfma_f32_16x16x32_bf16(k0, qf[2 * qg + q2][0], z, 0, 0, 0);
                    S[kt][q2] = __builtin_amdgcn_mfma_f32_16x16x32_bf16(k1, qf[2 * qg + q2][1], z, 0, 0, 0); }
            }
            if (qg == 1) { if (j < c) { LDS_WAIT(); ATT_DMA_K(j + 1); } }
            bf16x8 P[2][2];
#pragma unroll
            for (int q2 = 0; q2 < 2; ++q2) { const int qt = 2 * qg + q2;
                if (dc >= 3) {
                    asm volatile("" ::: "memory");
#pragma unroll
                    for (int kt = 0; kt < 4; ++kt) S[kt][q2] = S[kt][q2] + bfar;
                } else {
                    asm volatile("" ::: "memory");
                    const LAS float* rp = rt + (64 + 128 - (64 * dc + 16 * qt + n - 4 * mq));
                    float bv[4][4];
#pragma unroll
                    for (int kt = 0; kt < 4; ++kt)
#pragma unroll
                        for (int i = 0; i < 4; ++i) bv[kt][i] = rp[16 * kt + i];
#pragma unroll
                    for (int kt = 0; kt < 4; ++kt)
#pragma unroll
                        for (int i = 0; i < 4; ++i) S[kt][q2][i] += bv[kt][i];
                }
                float cm = S[0][q2][0];
#pragma unroll
                for (int kt = 0; kt < 4; ++kt)
#pragma unroll
                    for (int i = 0; i < 4; ++i) cm = fmaxf(cm, S[kt][q2][i]);
                cm = fmaxf(cm, __shfl_xor(cm, 16)); cm = fmaxf(cm, __shfl_xor(cm, 32));
                const float mn = fmaxf(mrun[qt], cm), alpha = __builtin_amdgcn_exp2f(mrun[qt] - mn); mrun[qt] = mn;
                float ps = 0.f;
#pragma unroll
                for (int kt = 0; kt < 4; ++kt)
#pragma unroll
                    for (int i = 0; i < 4; ++i) { const float p = __builtin_amdgcn_exp2f(S[kt][q2][i] - mn); S[kt][q2][i] = p; ps += p; }
                lsum[qt] = lsum[qt] * alpha + ps;
#pragma unroll
                for (int dt = 0; dt < 4; ++dt) O[qt][dt] = O[qt][dt] * alpha;
#pragma unroll
                for (int u = 0; u < 2; ++u) { u32x4 w; w.x = cvt_pk_bf16(S[2 * u][q2][0], S[2 * u][q2][1]); w.y = cvt_pk_bf16(S[2 * u][q2][2], S[2 * u][q2][3]);
                    w.z = cvt_pk_bf16(S[2 * u + 1][q2][0], S[2 * u + 1][q2][1]); w.w = cvt_pk_bf16(S[2 * u + 1][q2][2], S[2 * u + 1][q2][3]); P[q2][u] = __builtin_bit_cast(bf16x8, w); }
            }
            if (qg == 0) asm volatile("s_waitcnt vmcnt(0)" ::: "memory");
#pragma unroll
            for (int dt = 0; dt < 4; ++dt)
#pragma unroll
                for (int u = 0; u < 2; ++u) {
                    const LAS unsigned char* vp = vbuf + vrow + (32 * u) * 128 + ((dt ^ sw) * 32);
                    const bf16x8 vf = cat8(lds_tr16(vp), lds_tr16(vp + 16 * 128));
#pragma unroll
                    for (int q2 = 0; q2 < 2; ++q2) O[2 * qg + q2][dt] = __builtin_amdgcn_mfma_f32_16x16x32_bf16(vf, P[q2][u], O[2 * qg + q2][dt], 0, 0, 0);
                }
            if (qg == 1) { if (j < c) { LDS_WAIT(); ATT_DMA_V(j + 1); } }
        }
    }
#undef ATT_DMA_K
#undef ATT_DMA_V
    bf16_t* ya = (bf16_t*)(F.ws + WS_YA);
#pragma unroll
    for (int qt = 0; qt < 4; ++qt) { float l = lsum[qt]; l += __shfl_xor(l, 16); l += __shfl_xor(l, 32); const float rl = __builtin_amdgcn_rcpf(l);
#pragma unroll
        for (int dt = 0; dt < 4; ++dt) { const f32x4 o = O[qt][dt] * rl; u32x2 w; w.x = cvt_pk_bf16(o[0], o[1]); w.y = cvt_pk_bf16(o[2], o[3]);
            *(u32x2*)(ya + (size_t)(tok0 + 16 * qt + n) * 512 + h * 64 + 16 * dt + 4 * mq) = w; } }
}

__device__ __forceinline__ void gla_dstate_unit(Frame& F, int b, int c, const bf16_t* wgd_t, const float* wup, const float* bgate) {
    FRESH(F);
    const int lane = F.lane, w = F.wave, tid = F.tid, n = lane & 15, mq = lane >> 4;
    const int tok0 = b * SEQ + c * CH;
    const bf16_t* hb = (const bf16_t*)(F.ws + WS_HB); const bf16_t* kb = (const bf16_t*)(F.ws + WS_KB); const bf16_t* vb = (const bf16_t*)(F.ws + WS_VB);
    LAS float* GD8 = (LAS float*)(F.lds); LAS unsigned char* VB = F.lds + 32768; LAS unsigned char* KD = F.lds + 98304;
    LAS float* GDF = (LAS float*)(F.lds + XTRA_OFF); LAS float* TOT = (LAS float*)(F.lds + XTRA_OFF + 4096);
    __syncthreads();
    const int col = tid & 255, hf = tid >> 8;
    float wu[16];
#pragma unroll
    for (int r = 0; r < 16; ++r) wu[r] = wup[r * 256 + col];
    const float bb = bgate[col];
    unsigned short kraw[32];
#pragma unroll
    for (int l = 0; l < 32; ++l) kraw[l] = kb[(size_t)(tok0 + 32 * hf + l) * 256 + col];
#pragma unroll
    for (int i = 0; i < 8; ++i) { const int p = (w * 8 + i) * 64 + lane, row = p >> 6, ch = p & 63;
        __builtin_amdgcn_global_load_lds((const unsigned*)(vb + (size_t)(tok0 + row) * 512 + ch * 8), (LAS unsigned*)(VB + (w * 8 + i) * 1024), 16, 0, 0); }
    { bf16x8 af[4][4], bf[4];
#pragma unroll
      for (int ks = 0; ks < 4; ++ks) { bf[ks] = *(const bf16x8*)(wgd_t + (size_t)n * D + 128 * w + 32 * ks + 8 * mq);
#pragma unroll
          for (int mt = 0; mt < 4; ++mt) af[mt][ks] = *(const bf16x8*)(hb + (size_t)(tok0 + 16 * mt + n) * D + 128 * w + 32 * ks + 8 * mq); }
#pragma unroll
      for (int mt = 0; mt < 4; ++mt) { f32x4 acc = (f32x4){0.f, 0.f, 0.f, 0.f};
#pragma unroll
          for (int ks = 0; ks < 4; ++ks) acc = __builtin_amdgcn_mfma_f32_16x16x32_bf16(af[mt][ks], bf[ks], acc, 0, 0, 0);
#pragma unroll
          for (int i = 0; i < 4; ++i) GD8[(w * 64 + 16 * mt + 4 * mq + i) * 16 + n] = acc[i]; } }
    __syncthreads();
    { const f32x2 z2 = (f32x2){0.f, 0.f}; f32x2 sacc = z2;
#pragma unroll
      for (int q = 0; q < 8; ++q) sacc = sacc + *(const LAS f32x2*)(GD8 + q * 1024 + 2 * tid);
      *(LAS f32x2*)(GDF + 2 * tid) = sacc; }
    __syncthreads();
    { float cum[32]; float run = 0.f;
#pragma unroll
      for (int l = 0; l < 32; ++l) { const int row = 32 * hf + l; float z = bb;
#pragma unroll
          for (int r4 = 0; r4 < 4; ++r4) { const f32x4 a = *(const LAS f32x4*)(GDF + row * 16 + 4 * r4);
              z += a.x * wu[4 * r4] + a.y * wu[4 * r4 + 1] + a.z * wu[4 * r4 + 2] + a.w * wu[4 * r4 + 3]; }
          const float la = (fminf(z, 0.f) - __logf(1.f + __expf(-fabsf(z)))) * (1.f / 16.f);
          run += la; cum[l] = run; }
      LAS float* TOT1 = TOT + 256;
      if (hf == 0) TOT[col] = run;
      __syncthreads();
      const float tot = (hf == 1) ? TOT[col] : 0.f;
      if (hf == 1) TOT1[col] = run + tot;
      __syncthreads();
      const float ctot = TOT1[col];
      if (hf == 1) ((float*)(F.ws + WS_DEC))[(size_t)(b * NCH + c) * 256 + col] = __expf(ctot);
      unsigned pk[16];
#pragma unroll
      for (int l = 0; l < 32; l += 2) { const float k0 = bf2f(kraw[l]), k1 = bf2f(kraw[l + 1]);
          pk[l >> 1] = cvt_pk_bf16(k0 * __expf(ctot - (cum[l] + tot)), k1 * __expf(ctot - (cum[l + 1] + tot))); }
#pragma unroll
      for (int q = 0; q < 4; ++q) *(LAS u32x4*)(KD + col * 128 + hf * 64 + q * 16) = (u32x4){pk[4 * q], pk[4 * q + 1], pk[4 * q + 2], pk[4 * q + 3]}; }
    VM_WAIT();
    __syncthreads();
    { const int hh = w >> 1, vh = w & 1, qp = n >> 2, pp = lane & 3;
      f32x4 acc[4][4];
#pragma unroll
      for (int mt = 0; mt < 4; ++mt)
#pragma unroll
          for (int nt = 0; nt < 4; ++nt) acc[mt][nt] = (f32x4){0.f, 0.f, 0.f, 0.f};
#pragma unroll
      for (int ks = 0; ks < 2; ++ks) {
          bf16x8 af[4];
#pragma unroll
          for (int mt = 0; mt < 4; ++mt) af[mt] = *(const LAS bf16x8*)(KD + (hh * 64 + 16 * mt + n) * 128 + (32 * ks + 8 * mq) * 2);
#pragma unroll
          for (int nt = 0; nt < 4; ++nt) {
              const LAS unsigned char* vp = VB + (size_t)(32 * ks + 8 * mq + qp) * 1024 + (hh * 128 + vh * 64 + 16 * nt + 4 * pp) * 2;
              const bf16x8 bfr = cat8(lds_tr16(vp), lds_tr16(vp + 4 * 1024));
#pragma unroll
              for (int mt = 0; mt < 4; ++mt) acc[mt][nt] = __builtin_amdgcn_mfma_f32_16x16x32_bf16(af[mt], bfr, acc[mt][nt], 0, 0, 0);
          }
      }
      float* dst = (float*)(F.ws + WS_DST) + ((size_t)((b * NCH + c) * BH + hh) * 128) * 64;
#pragma unroll
      for (int mt = 0; mt < 4; ++mt)
#pragma unroll
          for (int nt = 0; nt < 4; ++nt) *(f32x4*)(dst + (size_t)(vh * 64 + 16 * nt + n) * 64 + 16 * mt + 4 * mq) = acc[mt][nt]; }
    __syncthreads();
}

__device__ __forceinline__ void gla_scan_phase(Frame& F) {
    FRESH(F);
    const float* ds = (const float*)(F.ws + WS_DST); const float* dec = (const float*)(F.ws + WS_DEC); bf16_t* st = (bf16_t*)(F.ws + WS_ST);
    for (int e2 = blockIdx.x * NTHR + F.tid; e2 < NB * BH * 128 * 32; e2 += F.G * NTHR) {
        const int k2 = e2 & 31, v = (e2 >> 5) & 127, hh = (e2 >> 12) & 3, b = e2 >> 14;
        f32x2 s = (f32x2){0.f, 0.f};
#pragma unroll 8
        for (int c = 0; c < NCH; ++c) {
            const size_t off = ((size_t)((b * NCH + c) * BH + hh) * 128 + v) * 64 + 2 * k2;
            const f32x2 d = *(const f32x2*)(ds + off); const f32x2 a = *(const f32x2*)(dec + (size_t)(b * NCH + c) * 256 + hh * 64 + 2 * k2);
            s = a * s + d;
            *(unsigned*)(st + off) = cvt_pk_bf16(s.x, s.y);
        }
    }
}

__device__ __forceinline__ void gla_out_unit(Frame& F, int b, int c, const float* gnorm) {
    FRESH(F);
    const int lane = F.lane, w = F.wave, n = lane & 15, mq = lane >> 4;
    const int hh = w >> 1, th = w & 1, tok0 = b * SEQ + c * CH + 32 * th;
    const bf16_t* qb = (const bf16_t*)(F.ws + WS_QB); const bf16_t* st = (const bf16_t*)(F.ws + WS_ST) + ((size_t)((b * NCH + c) * BH + hh) * 128) * 64;
    const bf16_t* sr = (const bf16_t*)(F.ws + WS_SR); bf16_t* yb = (bf16_t*)(F.ws + WS_YB);
    bf16x8 qf[2][2];
#pragma unroll
    for (int nt = 0; nt < 2; ++nt)
#pragma unroll
        for (int ks = 0; ks < 2; ++ks) qf[nt][ks] = *(const bf16x8*)(qb + (size_t)(tok0 + 16 * nt + n) * 256 + hh * 64 + 32 * ks + 8 * mq);
    f32x4 acc[8][2];
#pragma unroll
    for (int mt = 0; mt < 8; ++mt) {
        const bf16x8 a0 = *(const bf16x8*)(st + (size_t)(16 * mt + n) * 64 + 8 * mq), a1 = *(const bf16x8*)(st + (size_t)(16 * mt + n) * 64 + 32 + 8 * mq);
#pragma unroll
        for (int nt = 0; nt < 2; ++nt) { f32x4 z = (f32x4){0.f, 0.f, 0.f, 0.f};
            z = __builtin_amdgcn_mfma_f32_16x16x32_bf16(a0, qf[nt][0], z, 0, 0, 0);
            acc[mt][nt] = __builtin_amdgcn_mfma_f32_16x16x32_bf16(a1, qf[nt][1], z, 0, 0, 0); }
    }
#pragma unroll
    for (int nt = 0; nt < 2; ++nt) { float ss = 0.f;
#pragma unroll
        for (int mt = 0; mt < 8; ++mt) ss += (acc[mt][nt][0] * acc[mt][nt][0] + acc[mt][nt][1] * acc[mt][nt][1]) + (acc[mt][nt][2] * acc[mt][nt][2] + acc[mt][nt][3] * acc[mt][nt][3]);
        ss += __shfl_xor(ss, 16); ss += __shfl_xor(ss, 32);
        const float rstd = __builtin_amdgcn_rsqf(ss * (1.f / 128.f) + EPS);
#pragma unroll
        for (int mt = 0; mt < 8; ++mt) { const int col = hh * 128 + 16 * mt + 4 * mq; const f32x4 gn = *(const f32x4*)(gnorm + col);
            const size_t po = (size_t)(tok0 + 16 * nt + n) * 512 + col; const u32x2 rw = *(const u32x2*)(sr + po);
            const f32x4 o = acc[mt][nt] * rstd * gn; u32x2 wv; wv.x = cvt_pk_bf16(o[0] * bf_lo(rw.x), o[1] * bf_hi(rw.x)); wv.y = cvt_pk_bf16(o[2] * bf_lo(rw.y), o[3] * bf_hi(rw.y));
            *(u32x2*)(yb + po) = wv; } }
}
#ifndef PLE_MODE1
#define PLE_MODE1 3
#endif
#ifdef SIM_FP8
constexpr float MOE_ACT_QS = 8.f;
#else
constexpr float MOE_ACT_QS = 0.f;
#endif
constexpr int N_PHASES = 25;
__global__ void __launch_bounds__(NTHR, 2) fwd(Args args) {
    extern __shared__ __attribute__((aligned(16))) unsigned char lds[];
    Frame F;
    F.lds = (LAS unsigned char*)lds;
    F.MISC = (volatile LAS unsigned*)(F.lds + MISC_OFF);
    F.tid = threadIdx.x; F.lane = F.tid & 63; F.wave = __builtin_amdgcn_readfirstlane(F.tid >> 6);
    F.G = gridDim.x; { const int bx = blockIdx.x; F.vcu = (F.G % 8 == 0) ? (bx % 8) * (F.G / 8) + bx / 8 : bx; }
    F.ws = args.ws; F.ctl = (gu32*)(args.ws + WS_CTL); F.x = args.out; F.xs = (bf16_t*)(args.ws + WS_XS);
    unsigned char* ws = args.ws;
    for (int u = F.tid; u < (LDS_BYTES - LDSCTL_OFF) / 4; u += NTHR) ((LAS unsigned*)(F.lds + LDSCTL_OFF))[u] = 0u;
    __syncthreads();
    XcdBarrier bar = xcd_barrier_post((unsigned*)(F.ctl + CW_BAR), F.MISC + 8);
    const WT wt = make_wt(ws, (unsigned)WS_END);
    const int lo = args.ph_lo, hi = args.ph_hi;
#define PH_BEGIN const __attribute__((address_space(4))) Args* _ap = (const __attribute__((address_space(4))) Args*)__builtin_amdgcn_kernarg_segment_ptr(); asm volatile("" : "+s"(_ap)); const __attribute__((address_space(4))) Args& A = *_ap; unsigned char* ws = A.ws; \
    unsigned char* wb = ws + (l ? WS_W1 : WS_W0); bf16_t* hb = (bf16_t*)(ws + WS_HB); bf16_t* Y = (bf16_t*)(ws + WS_Y); const WT wt = make_wt(ws, (unsigned)WS_END); (void)wb; (void)hb; (void)Y; (void)wt; (void)A
#ifndef PHMASK
#define PHMASK 0x1fff
#endif
#define EN(i) (((PHMASK) >> (i)) & 1)
#ifndef REPMASK
#define REPMASK 0
#endif
#ifndef REPLAYER
#define REPLAYER 2
#endif
#define ZEROG ((const float*)(ws + WS_CTL + 131072))
#ifndef ZSKIP
#define ZSKIP 0
#endif
#define REPS(i) (((((REPMASK) >> (i)) & 1) && (REPLAYER == 2 || REPLAYER == l)) ? 2 : 1)
#define IN(k) (lo <= (k) && (k) < hi)
#ifndef SEAMREP
#define SEAMREP 1
#endif
#ifndef MK_STAMP
#define MK_STAMP 0
#endif
#ifndef STAMP_SEL
#define STAMP_SEL -1
#endif
#define SEAM(k) do { if (MK_STAMP && IN(k) && F.tid == 0) ((unsigned long long*)(ws + WS_CTL + 786432))[(k) * 256 + blockIdx.x] = __builtin_amdgcn_s_memrealtime(); \
    if (IN(k) && IN((k) + 1)) for (int _r = 0; _r < SEAMREP; ++_r) xcd_barrier(bar); } while (0)

    { const int l = 0; if (EN(12) && IN(0)) for (int rep = 0; rep < REPS(12); ++rep) { p0_prologue(F, args); } }
    SEAM(0);
#ifndef LAYERREP
#define LAYERREP 0
#endif
    for (int l2 = 0; l2 < DEPTH + LAYERREP; ++l2) {
        const int l = (l2 < LAYERREP) ? 0 : l2 - LAYERREP; const bool zpass = (l2 < LAYERREP);
        const int pb = 1 + 12 * l;
        if (EN(0) && IN(pb + 0) && !(zpass && ((ZSKIP >> 0) & 1))) for (int rep = 0; rep < REPS(0); ++rep) { PH_BEGIN;
            pg8::Gemm g{hb, (const bf16_t*)(wb + OFF_WIN), D, 0, nullptr}; pg8::StaticOrder S; S.init(T, INWG, F.G, (int)blockIdx.x);
            pg8::EpiInProj E{(bf16_t*)(ws + WS_PROJ), wt};
            pg8::gemm_phase<pg8::EpiInProj, pg8::StaticOrder, false>(F.lds, g, S, E);
        }
        SEAM(pb + 0);
        if (EN(1) && IN(pb + 1) && !(zpass && ((ZSKIP >> 1) & 1))) for (int rep = 0; rep < REPS(1); ++rep) { PH_BEGIN;
            for (int u = F.vcu; u < NB * NCH; u += F.G) {
#ifndef NO_ATTN
#ifdef REP1_NO_ATTN
                if (rep == 0)
#endif
                attn_unit(F, u / NCH, u % NCH, A.in[I_RELB] + (size_t)l * AH * RELN);
#endif
#ifndef NO_GLA1
#ifdef REP1_NO_GLA
                if (rep == 0)
#endif
                gla_dstate_unit(F, u / NCH, u % NCH, (const bf16_t*)(wb + OFF_WGD), A.in[I_WGUP] + (size_t)l * GR * 256, A.in[I_BG] + (size_t)l * 256);
#endif
            }
        }
        SEAM(pb + 1);
        if (EN(2) && IN(pb + 2) && !(zpass && ((ZSKIP >> 2) & 1))) for (int rep = 0; rep < REPS(2); ++rep) { PH_BEGIN; gla_scan_phase(F); }
        SEAM(pb + 2);
        if (EN(3) && IN(pb + 3) && !(zpass && ((ZSKIP >> 3) & 1))) for (int rep = 0; rep < REPS(3); ++rep) { PH_BEGIN; for (int u = F.vcu; u < NB * NCH; u += F.G) gla_out_unit(F, u / NCH, u % NCH, A.in[I_GNORM] + (size_t)l * 512); }
        SEAM(pb + 3);
        if (EN(4) && IN(pb + 4) && !(zpass && ((ZSKIP >> 4) & 1))) for (int rep = 0; rep < REPS(4); ++rep) { PH_BEGIN;
            pg8::StaticOrder S; S.init(T, D, F.G, (int)blockIdx.x);
            { pg8::Gemm g{(const bf16_t*)(ws + WS_YA), (const bf16_t*)(wb + OFF_WBA), 512, 0, nullptr}; pg8::EpiEw<1> E{(bf16_t*)(ws + WS_MERGED), (const bf16_t*)(ws + WS_SGA), D, wt};
              pg8::gemm_phase<pg8::EpiEw<1>, pg8::StaticOrder, false>(F.lds, g, S, E); }
            { pg8::Gemm g{(const bf16_t*)(ws + WS_YB), (const bf16_t*)(wb + OFF_WBB), 512, 0, nullptr}; pg8::EpiEw<2> E{(bf16_t*)(ws + WS_MERGED), (const bf16_t*)(ws + WS_SGB), D, wt};
              pg8::gemm_phase<pg8::EpiEw<2>, pg8::StaticOrder, false>(F.lds, g, S, E); }
        }
        SEAM(pb + 4);
        if (EN(5) && IN(pb + 5) && !(zpass && ((ZSKIP >> 5) & 1))) for (int rep = 0; rep < REPS(5); ++rep) { PH_BEGIN;
            pg8::StaticOrder S; S.init(T, D, F.G, (int)blockIdx.x);
            pg8::Gemm g{(const bf16_t*)(ws + WS_MERGED), (const bf16_t*)(wb + OFF_WOUT), D, 0, nullptr}; pg8::EpiEw<0> E{Y, nullptr, D, wt};
            pg8::gemm_phase<pg8::EpiEw<0>, pg8::StaticOrder, false>(F.lds, g, S, E);
        }
        SEAM(pb + 5);
        if (EN(6) && IN(pb + 6) && !(zpass && ((ZSKIP >> 6) & 1))) for (int rep = 0; rep < ((l == 0) ? REPS(6) : 1); ++rep) { PH_BEGIN;
            if (l == 0) thin_phase<1, 1, false>(F, (LAYERREP == 0 && REPS(6) == 1) ? A.in[I_X] : nullptr, Y, (zpass || rep + 1 < REPS(6)) ? ZEROG : A.in[I_NMPOST] + (size_t)l * D, A.in[I_NFPRE] + (size_t)l * D, hb, nullptr);
            else        thin_phase<1, 1, true>(F, nullptr, Y, A.in[I_NMPOST] + (size_t)l * D, A.in[I_NFPRE] + (size_t)l * D, hb, A.in[I_RW]);
        }
        SEAM(pb + 6);
        if (EN(7) && IN(pb + 7) && !(zpass && ((ZSKIP >> 7) & 1))) for (int rep = 0; rep < REPS(7); ++rep) { PH_BEGIN;
            if (l == 0) { pg8::StaticOrder S; S.init(T, 2 * DFF, F.G, (int)blockIdx.x);
                pg8::Gemm g{hb, (const bf16_t*)(wb + OFF_FFN), D, 0, nullptr}; pg8::EpiGateUp E{(bf16_t*)(ws + WS_FACT), DFF, wt, 0.f};
                pg8::gemm_phase<pg8::EpiGateUp, pg8::StaticOrder, false>(F.lds, g, S, E);
            } else { pg8::GroupedOrder S; S.init((const unsigned*)(F.ctl + CW_CNT), 2 * DFE, F.G, (int)blockIdx.x);
#if MOE_FP8
                pg8::Gemm g{hb, (const bf16_t*)(wb + OFF_FFN), D / 2, (size_t)2 * DFE * D / 2, (const int*)(ws + WS_IDXE), D / 2}; pg8::EpiGateUp8 E{ws + WS_MACT, DFE, wt, 1.f / W8_SCALE, ACT8_SCALE};
                pg8::gemm_phase<pg8::EpiGateUp8, pg8::GroupedOrder, true, true>(F.lds, g, S, E);
#else
                pg8::Gemm g{hb, (const bf16_t*)(wb + OFF_FFN), D, (size_t)2 * DFE * D, (const int*)(ws + WS_IDXE)}; pg8::EpiGateUp E{(bf16_t*)(ws + WS_MACT), DFE, wt, MOE_ACT_QS};
                pg8::gemm_phase<pg8::EpiGateUp, pg8::GroupedOrder, true>(F.lds, g, S, E);
#endif
            }
        }
        SEAM(pb + 7);
        if (EN(8) && IN(pb + 8) && !(zpass && ((ZSKIP >> 8) & 1))) for (int rep = 0; rep < REPS(8); ++rep) { PH_BEGIN;
            if (l == 0) { pg8::StaticOrder S; S.init(T, D, F.G, (int)blockIdx.x);
                pg8::Gemm g{(const bf16_t*)(ws + WS_FACT), (const bf16_t*)(wb + OFF_FDN), DFF, 0, nullptr}; pg8::EpiEw<0> E{Y, nullptr, D, wt};
                pg8::gemm_phase<pg8::EpiEw<0>, pg8::StaticOrder, false>(F.lds, g, S, E);
            } else {
#if MOE_FP8
                constexpr float dsc = 1.f / (W8_SCALE * ACT8_SCALE);
                { pg8::GroupedOrder S; S.init((const unsigned*)(F.ctl + CW_CNT), D, F.G, (int)blockIdx.x, MOE_MAIN_PANELS);
                  pg8::Gemm g{(const bf16_t*)(ws + WS_MACT), (const bf16_t*)(wb + OFF_MDN8), DFE / 2, (size_t)D * DFE / 2, nullptr}; pg8::EpiEw<0> E{(bf16_t*)(ws + WS_YSLOT), nullptr, D, wt, dsc};
                  pg8::gemm_phase<pg8::EpiEw<0>, pg8::GroupedOrder, false, true>(F.lds, g, S, E); }
                { pg8::TailOrder S; S.init((const unsigned*)(F.ctl + CW_CNT), D, F.G, (int)blockIdx.x, MOE_MAIN_PANELS, TAIL_KC, TAIL_KCH);
                  pg8::Gemm g{(const bf16_t*)(ws + WS_MACT), (const bf16_t*)(wb + OFF_MDN8), TAIL_KCH, (size_t)D * DFE / 2, nullptr, DFE / 2}; pg8::EpiPart E{(bf16_t*)(ws + WS_PBUF), D, MOE_MAIN_PANELS, TAIL_KCH, (size_t)TAIL_ROWS * D, wt, dsc};
                  pg8::gemm_phase<pg8::EpiPart, pg8::TailOrder, false, true>(F.lds, g, S, E); }
#else
                { pg8::GroupedOrder S; S.init((const unsigned*)(F.ctl + CW_CNT), D, F.G, (int)blockIdx.x, MOE_MAIN_PANELS);
                  pg8::Gemm g{(const bf16_t*)(ws + WS_MACT), (const bf16_t*)(wb + OFF_MDN), DFE, (size_t)D * DFE, nullptr}; pg8::EpiEw<0> E{(bf16_t*)(ws + WS_YSLOT), nullptr, D, wt};
                  pg8::gemm_phase<pg8::EpiEw<0>, pg8::GroupedOrder, false>(F.lds, g, S, E); }
                { pg8::TailOrder S; S.init((const unsigned*)(F.ctl + CW_CNT), D, F.G, (int)blockIdx.x, MOE_MAIN_PANELS, TAIL_KC, TAIL_KCH);
                  pg8::Gemm g{(const bf16_t*)(ws + WS_MACT), (const bf16_t*)(wb + OFF_MDN), TAIL_KCH, (size_t)D * DFE, nullptr, DFE}; pg8::EpiPart E{(bf16_t*)(ws + WS_PBUF), D, MOE_MAIN_PANELS, TAIL_KCH, (size_t)TAIL_ROWS * D, wt};
                  pg8::gemm_phase<pg8::EpiPart, pg8::TailOrder, false>(F.lds, g, S, E); }
#endif
            }
        }
        SEAM(pb + 8);
        if (EN(9) && IN(pb + 9) && !(zpass && ((ZSKIP >> 9) & 1))) for (int rep = 0; rep < REPS(9); ++rep) { PH_BEGIN;
            if (l == 0) thin_phase<1, 2, false>(F, nullptr, Y, (zpass || rep + 1 < REPS(9)) ? ZEROG : A.in[I_NFPOST] + (size_t)l * D, nullptr, nullptr, nullptr);
            else        thin_phase<2, 2, false>(F, nullptr, (const bf16_t*)(ws + WS_YSLOT), (zpass || rep + 1 < REPS(9)) ? ZEROG : A.in[I_NFPOST] + (size_t)l * D, nullptr, nullptr, nullptr);
        }
        SEAM(pb + 9);
        if (EN(10) && IN(pb + 10) && !(zpass && ((ZSKIP >> 10) & 1))) for (int rep = 0; rep < REPS(10); ++rep) { PH_BEGIN;
            pg8::StaticOrder S; S.init(T, D, F.G, (int)blockIdx.x);
            if (MK_DBG == 0 || A.sub != 2) { pg8::Gemm g{(const bf16_t*)(ws + WS_XS), (const bf16_t*)(wb + OFF_WPG), D, 0, nullptr}; pg8::EpiEw<PLE_MODE1> E{Y, nullptr, D, wt};
              pg8::gemm_phase<pg8::EpiEw<PLE_MODE1>, pg8::StaticOrder, false>(F.lds, g, S, E); }
            if (MK_DBG == 0 || A.sub != 1) { pg8::Gemm g{(const bf16_t*)(ws + WS_PB) + (size_t)l * T * PLE, (const bf16_t*)(wb + OFF_WPP), PLE, 0, nullptr}; pg8::EpiEw<4> E{Y, nullptr, D, wt};
              pg8::gemm_phase<pg8::EpiEw<4>, pg8::StaticOrder, false>(F.lds, g, S, E); }
        }
        SEAM(pb + 10);
        if (EN(11) && IN(pb + 11) && !(zpass && ((ZSKIP >> 11) & 1))) for (int rep = 0; rep < REPS(11); ++rep) { PH_BEGIN;
            if (l + 1 < DEPTH) thin_phase<1, 1, false>(F, nullptr, Y, (zpass || rep + 1 < REPS(11)) ? ZEROG : A.in[I_PNORM] + (size_t)l * D, A.in[I_NMPRE] + (size_t)(zpass ? 0 : l + 1) * D, hb, nullptr);
            else               thin_phase<1, 0, false>(F, nullptr, Y, (zpass || rep + 1 < REPS(11)) ? ZEROG : A.in[I_PNORM] + (size_t)l * D, nullptr, nullptr, nullptr);
        }
        SEAM(pb + 11);
    }
#if MK_STAMP
    {
        xcd_barrier(bar);
        const unsigned long long* st = (const unsigned long long*)(ws + WS_CTL + 786432);
        LAS float* res = (LAS float*)(F.lds);
        if (F.tid < N_PHASES) { const int k = F.tid; unsigned long long mx = 0, mxp = 0; double sum = 0.0;
            for (int g = 0; g < F.G; ++g) { const unsigned long long t = st[k * 256 + g]; mx = t > mx ? t : mx; sum += (double)t; if (k > 0) { const unsigned long long tp = st[(k - 1) * 256 + g]; mxp = tp > mxp ? tp : mxp; } }
            if (k == 0) { mxp = ~0ull; for (int g = 0; g < F.G; ++g) { const unsigned long long t = st[g]; mxp = t < mxp ? t : mxp; } mxp -= 0; }
            res[k] = (float)((double)(mx - mxp) * 0.01); res[32 + k] = (float)(((double)mx - sum / F.G) * 0.01); }
        __syncthreads();
        float t1, t2;
        if (STAMP_SEL < 0) { t1 = 0.f; t2 = 0.f; for (int k = 1; k < N_PHASES; ++k) { t1 += res[32 + k]; t2 += res[k]; } }
        else { t1 = res[STAMP_SEL]; t2 = res[32 + STAMP_SEL]; }
        const float A = 300.f * t1 + 1000.f, B = 10.f * t2 + 20.f;
        for (size_t i = (size_t)blockIdx.x * NTHR + F.tid; i < (size_t)T * D; i += (size_t)F.G * NTHR) args.out[i] = (i == 0) ? A : B;
    }
#endif
#undef IN
#undef SEAM
}
#ifndef MK_DBG
#define MK_DBG 0
#endif
#if MK_DBG
#ifndef MK_DBG_SHOW
#define MK_DBG_SHOW -1
#endif
constexpr size_t WS_SNAP = 512 * 1024;
__device__ __forceinline__ unsigned dh(unsigned x) { x ^= x >> 16; x *= 0x7feb352du; x ^= x >> 15; x *= 0x846ca68bu; x ^= x >> 16; return x; }
__device__ __forceinline__ void dbg_acc(float* dbg, int stage, float d2, float e2, int lane) { d2 = wave_sum(d2); e2 = wave_sum(e2); if (lane == 0) { atomicAdd(dbg + 2 * stage, d2); atomicAdd(dbg + 2 * stage + 1, e2); } }
__device__ __forceinline__ float ddot(const bf16_t* arow, const float* W, int K, int pitch, int col, int lane) { float s = 0.f; for (int k = lane; k < K; k += 64) s += bf2f(arow[k]) * W[(size_t)k * pitch + col]; return wave_sum(s); }
__device__ __forceinline__ float dsig(float v) { return 1.f / (1.f + expf(-v)); }
__device__ __forceinline__ int dbg_pbase(const unsigned* gcnt, int e) { int acc = 0; for (int q = 0; q < 8; ++q) if (q < e) acc += (((int)gcnt[q] + 255) >> 8) << 8; return acc; }
__device__ __forceinline__ float dbg_moe_el(const unsigned char* ws, int s, int k) { if (s < MOE_MAIN_ROWS) return bf2f(((const bf16_t*)(ws + WS_YSLOT))[(size_t)s * D + k]); float a = 0.f; for (int kc = 0; kc < TAIL_KC; ++kc) a += bf2f(((const bf16_t*)(ws + WS_PBUF))[((size_t)kc * TAIL_ROWS + (s - MOE_MAIN_ROWS)) * D + k]); return a; }
__device__ __forceinline__ float dbg_f8(const unsigned char* p, size_t i) { return __builtin_amdgcn_cvt_f32_fp8((int)p[i], 0); }
__device__ __forceinline__ float ddot8(const unsigned char* arow, float ascale, const float* W, int K, int pitch, int col, int lane) { float s = 0.f; for (int k = lane; k < K; k += 64) s += dbg_f8(arow, k) * ascale * W[(size_t)k * pitch + col]; return wave_sum(s); }
#define DBGP float* dbg = (float*)(a.ws + WS_CTL) + CW_DBG; const int lane = threadIdx.x & 63; const unsigned sid = blockIdx.x; (void)sid

__global__ void dbg_t1(Args a, int stage) { DBGP;
    const int r = dh(sid * 3 + 1) % T; const float* x = a.in[I_X] + (size_t)r * D; const bf16_t* hb = (const bf16_t*)(a.ws + WS_HB) + (size_t)r * D;
    float ss = 0.f; for (int k = lane; k < D; k += 64) ss += x[k] * x[k]; ss = wave_sum(ss); const float rstd = 1.f / sqrtf(ss / D + EPS);
    float d2 = 0.f, e2 = 0.f; for (int k = lane; k < D; k += 64) { const float e = x[k] * rstd * a.in[I_NMPRE][k], g = bf2f(hb[k]); d2 += (g - e) * (g - e); e2 += e * e; }
    dbg_acc(dbg, stage, d2, e2, lane); }

__global__ void dbg_gemm(Args a, int kind, int l, int stage) { DBGP;
    unsigned char* ws = a.ws; const unsigned h1 = dh(sid * 7 + 1), h2 = dh(sid * 7 + 2), h3 = dh(sid * 7 + 3);
    const bf16_t* hb = (const bf16_t*)(ws + WS_HB); float e = 0.f, g = 0.f;
    const unsigned* gcnt = (const unsigned*)(ws + WS_CTL) + CW_CNT;
    if (kind == 1) { const int row = h1 % T, col = h2 % INWG, sc = col < 2560 ? col : col + 16; const float v = ddot(hb + (size_t)row * D, a.in[I_WIN] + (size_t)l * D * INW, D, INW, sc, lane);
        const bf16_t* P = (const bf16_t*)(ws + WS_PROJ);
        if (col < 512) { e = v * pg8::QA_SCALE; g = bf2f(((const bf16_t*)(ws + WS_QA))[(size_t)row * 512 + col]); }
        else if (col < 1024) { e = v; g = bf2f(((const bf16_t*)(ws + WS_KA))[(size_t)row * 512 + col - 512]); }
        else if (col < 1536) { e = v; g = bf2f(((const bf16_t*)(ws + WS_VA))[(size_t)row * 512 + col - 1024]); }
        else if (col < 1792) { e = v * 0.125f; g = bf2f(((const bf16_t*)(ws + WS_QB))[(size_t)row * 256 + col - 1536]); }
        else if (col < 2048) { e = v; g = bf2f(((const bf16_t*)(ws + WS_KB))[(size_t)row * 256 + col - 1792]); }
        else if (col < 2560) { e = v; g = bf2f(((const bf16_t*)(ws + WS_VB))[(size_t)row * 512 + col - 2048]); }
        else if (col < 3072) { e = v * dsig(v); g = bf2f(((const bf16_t*)(ws + WS_SR))[(size_t)row * 512 + col - 2560]); }
        else if (col < 4096) { e = dsig(v); g = bf2f(((const bf16_t*)(ws + WS_SGA))[(size_t)row * 1024 + col - 3072]); }
        else { e = dsig(v); g = bf2f(((const bf16_t*)(ws + WS_SGB))[(size_t)row * 1024 + col - 4096]); } (void)P;
    } else if (kind == 2) { const int row = h1 % T, col = h2 % D;
        const float va = ddot((const bf16_t*)(ws + WS_YA) + (size_t)row * 512, a.in[I_WBA] + (size_t)l * 512 * D, 512, D, col, lane), vb = ddot((const bf16_t*)(ws + WS_YB) + (size_t)row * 512, a.in[I_WBB] + (size_t)l * 512 * D, 512, D, col, lane);
        e = bf2f(((const bf16_t*)(ws + WS_SGA))[(size_t)row * D + col]) * va + bf2f(((const bf16_t*)(ws + WS_SGB))[(size_t)row * D + col]) * vb; g = bf2f(((const bf16_t*)(ws + WS_MERGED))[(size_t)row * D + col]);
    } else if (kind == 3) { const int row = h1 % T, col = h2 % D; e = ddot((const bf16_t*)(ws + WS_MERGED) + (size_t)row * D, a.in[I_WOUT] + (size_t)l * D * D, D, D, col, lane); g = bf2f(((const bf16_t*)(ws + WS_Y))[(size_t)row * D + col]);
    } else if (kind == 4) { const int row = h1 % T, c = h2 % DFF; const float vg = ddot(hb + (size_t)row * D, a.in[I_FG], D, DFF, c, lane), vu = ddot(hb + (size_t)row * D, a.in[I_FU], D, DFF, c, lane);
        e = vg * dsig(vg) * vu; g = bf2f(((const bf16_t*)(ws + WS_FACT))[(size_t)row * DFF + c]);
    } else if (kind == 5) { const int row = h1 % T, col = h2 % D; e = ddot((const bf16_t*)(ws + WS_FACT) + (size_t)row * DFF, a.in[I_FD], DFF, D, col, lane); g = bf2f(((const bf16_t*)(ws + WS_Y))[(size_t)row * D + col]);
    } else if (kind == 6 || kind == 7) { const int ex = h1 % NE; const int pbase = dbg_pbase(gcnt, ex); const int cnt = (int)gcnt[ex];
        if (cnt == 0) return; const int i = h2 % cnt, tok = ((const int*)(ws + WS_IDXE))[ex * 16384 + i], row = pbase + i;
#if MOE_FP8
        const unsigned char* hb8 = ws + WS_HB; const unsigned char* act8 = ws + WS_MACT;
        if (kind == 6) { const int c = h3 % DFE; const float vg = ddot8(hb8 + (size_t)tok * D, 1.f, a.in[I_MG] + (size_t)ex * D * DFE, D, DFE, c, lane), vu = ddot8(hb8 + (size_t)tok * D, 1.f, a.in[I_MU] + (size_t)ex * D * DFE, D, DFE, c, lane);
            e = vg * dsig(vg) * vu; g = dbg_f8(act8, (size_t)row * DFE + c) * (1.f / ACT8_SCALE); }
        else { const int col = h3 % D; e = ddot8(act8 + (size_t)row * DFE, 1.f / ACT8_SCALE, a.in[I_MD] + (size_t)ex * DFE * D, DFE, D, col, lane); g = dbg_moe_el(ws, row, col); }
#else
        if (kind == 6) { const int c = h3 % DFE; const float vg = ddot(hb + (size_t)tok * D, a.in[I_MG] + (size_t)ex * D * DFE, D, DFE, c, lane), vu = ddot(hb + (size_t)tok * D, a.in[I_MU] + (size_t)ex * D * DFE, D, DFE, c, lane);
            e = vg * dsig(vg) * vu; g = bf2f(((const bf16_t*)(ws + WS_MACT))[(size_t)row * DFE + c]); }
        else { const int col = h3 % D; e = ddot((const bf16_t*)(ws + WS_MACT) + (size_t)row * DFE, a.in[I_MD] + (size_t)ex * DFE * D, DFE, D, col, lane); g = dbg_moe_el(ws, row, col); }
#endif
    } else if (kind == 12) { const int row = h1 % T, col = h2 % D; e = a.out[(size_t)row * D + col]; g = bf2f(((const bf16_t*)(ws + WS_XS))[(size_t)row * D + col]);
    } else if (kind == 13) { const int row = h1 % T, col = h2 % D; e = ddot((const bf16_t*)(ws + WS_XS) + (size_t)row * D, a.in[I_PG] + (size_t)l * D * D, D, D, col, lane); g = bf2f(((const bf16_t*)(ws + WS_Y))[(size_t)row * D + col]);
    } else if (kind == 11) { const int n = h1 % D, k = h2 % D; e = a.in[I_PG][(size_t)l * D * D + (size_t)k * D + n]; g = bf2f(((const bf16_t*)(ws + (l ? WS_W1 : WS_W0) + OFF_WPG))[(size_t)n * D + k]);
    } else if (kind == 9) { const int row = h1 % T, col = h2 % D; e = dsig(ddot((const bf16_t*)(ws + WS_XS) + (size_t)row * D, a.in[I_PG] + (size_t)l * D * D, D, D, col, lane)); g = bf2f(((const bf16_t*)(ws + WS_Y))[(size_t)row * D + col]);
    } else { const int row = h1 % T, col = h2 % D; const float vg = ddot((const bf16_t*)(ws + WS_XS) + (size_t)row * D, a.in[I_PG] + (size_t)l * D * D, D, D, col, lane), vp = ddot((const bf16_t*)(ws + WS_PB) + ((size_t)l * T + row) * PLE, a.in[I_PP] + (size_t)l * PLE * D, PLE, D, col, lane);
        e = dsig(vg) * vp; g = bf2f(((const bf16_t*)(ws + WS_Y))[(size_t)row * D + col]); }
    if (lane == 0) { atomicAdd(dbg + 2 * stage, (g - e) * (g - e)); atomicAdd(dbg + 2 * stage + 1, e * e); } }

__global__ void dbg_attn(Args a, int l, int stage) { DBGP;
    unsigned char* ws = a.ws; const unsigned h1 = dh(sid * 5 + 1); const int tok = h1 % T, h = dh(sid * 5 + 2) % AH, b = tok / SEQ, c = (tok % SEQ) / CH, ql = tok % CH;
    const bf16_t* hb = (const bf16_t*)(ws + WS_HB) + (size_t)tok * D; const float* win = a.in[I_WIN] + (size_t)l * D * INW;
    float q = 0.f; for (int k = 0; k < D; ++k) q += bf2f(hb[k]) * win[(size_t)k * INW + h * 64 + lane]; q *= pg8::QA_SCALE;
    const bf16_t* ka = (const bf16_t*)(ws + WS_KA); const bf16_t* va = (const bf16_t*)(ws + WS_VA); const float* rb = a.in[I_RELB] + ((size_t)l * AH + h) * RELN;
    float m = -1e30f, ls = 0.f, o = 0.f;
    for (int kc = (c - 8 > 0 ? c - 8 : 0); kc <= c; ++kc) for (int kl = 0; kl < CH; ++kl) { const int kt = b * SEQ + kc * CH + kl; int dist = (c - kc) * 64 + ql - kl; dist = dist > 128 ? 128 : (dist < -128 ? -128 : dist);
        const float s = wave_sum(q * bf2f(ka[(size_t)kt * 512 + h * 64 + lane])) + rb[dist + 128] * LOG2E; const float mn = fmaxf(m, s), al = exp2f(m - mn), p = exp2f(s - mn); m = mn; ls = ls * al + p; o = o * al + p * bf2f(va[(size_t)kt * 512 + h * 64 + lane]); }
    const float e = o / ls, g = bf2f(((const bf16_t*)(ws + WS_YA))[(size_t)tok * 512 + h * 64 + lane]);
    dbg_acc(dbg, stage, (g - e) * (g - e), e * e, lane); }

__global__ void dbg_dstate(Args a, int l, int stage) { DBGP;
    unsigned char* ws = a.ws; const int b = dh(sid * 5 + 1) % NB, c = dh(sid * 5 + 2) % NCH, hh = dh(sid * 5 + 3) % BH, v = dh(sid * 5 + 4) % 128, k = dh(sid * 5 + 5) % 64, col = hh * 64 + k;
    const int tok = b * SEQ + c * CH + lane; const bf16_t* hb = (const bf16_t*)(ws + WS_HB) + (size_t)tok * D; const float* win = a.in[I_WIN] + (size_t)l * D * INW;
    float z = a.in[I_BG][l * 256 + col];
    for (int r = 0; r < GR; ++r) { float gd = 0.f; for (int kk = 0; kk < D; ++kk) gd += bf2f(hb[kk]) * win[(size_t)kk * INW + 2560 + r]; z += gd * a.in[I_WGUP][((size_t)l * GR + r) * 256 + col]; }
    const float la = (fminf(z, 0.f) - log1pf(expf(-fabsf(z)))) / 16.f; float cum = la;
    for (int o = 1; o < 64; o <<= 1) { const float t = __shfl_up(cum, o); if (lane >= o) cum += t; }
    const float tot = __shfl(cum, 63);
    const float kd = bf2f(((const bf16_t*)(ws + WS_KB))[(size_t)tok * 256 + col]) * expf(tot - cum);
    const float e = wave_sum(kd * bf2f(((const bf16_t*)(ws + WS_VB))[(size_t)tok * 512 + hh * 128 + v]));
    const float g = ((const float*)(ws + WS_DST))[((size_t)((b * NCH + c) * BH + hh) * 128 + v) * 64 + k];
    const float ed = expf(tot), gdc = ((const float*)(ws + WS_DEC))[(size_t)(b * NCH + c) * 256 + col];
    if (lane == 0) { atomicAdd(dbg + 2 * stage, (g - e) * (g - e) + (gdc - ed) * (gdc - ed)); atomicAdd(dbg + 2 * stage + 1, e * e + ed * ed); } }

__global__ void dbg_scan(Args a, int stage) { DBGP;
    unsigned char* ws = a.ws; const unsigned s0 = sid * 64 + lane; const int b = dh(s0 * 5 + 1) % NB, c = dh(s0 * 5 + 2) % NCH, hh = dh(s0 * 5 + 3) % BH, v = dh(s0 * 5 + 4) % 128, k = dh(s0 * 5 + 5) % 64;
    float s = 0.f; for (int cc = 0; cc <= c; ++cc) s = ((const float*)(ws + WS_DEC))[(size_t)(b * NCH + cc) * 256 + hh * 64 + k] * s + ((const float*)(ws + WS_DST))[((size_t)((b * NCH + cc) * BH + hh) * 128 + v) * 64 + k];
    const float g = bf2f(((const bf16_t*)(ws + WS_ST))[((size_t)((b * NCH + c) * BH + hh) * 128 + v) * 64 + k]);
    dbg_acc(dbg, stage, (g - s) * (g - s), s * s, lane); }

__global__ void dbg_glaout(Args a, int l, int stage) { DBGP;
    unsigned char* ws = a.ws; const int tok = dh(sid * 3 + 1) % T, hh = dh(sid * 3 + 2) % BH, b = tok / SEQ, c = (tok % SEQ) / CH;
    const bf16_t* st = (const bf16_t*)(ws + WS_ST) + ((size_t)((b * NCH + c) * BH + hh) * 128) * 64; const bf16_t* qb = (const bf16_t*)(ws + WS_QB) + (size_t)tok * 256 + hh * 64;
    const bf16_t* hb = (const bf16_t*)(ws + WS_HB) + (size_t)tok * D; const float* win = a.in[I_WIN] + (size_t)l * D * INW;
    float o[2], r[2];
#pragma unroll
    for (int j = 0; j < 2; ++j) { const int v = lane + 64 * j; float s = 0.f; for (int k = 0; k < 64; ++k) s += bf2f(qb[k]) * bf2f(st[(size_t)v * 64 + k]); o[j] = s;
        float rr = 0.f; for (int kk = 0; kk < D; ++kk) rr += bf2f(hb[kk]) * win[(size_t)kk * INW + 2576 + hh * 128 + v]; r[j] = rr * dsig(rr); }
    const float ss = wave_sum(o[0] * o[0] + o[1] * o[1]), rstd = 1.f / sqrtf(ss / 128.f + EPS); float d2 = 0.f, e2 = 0.f;
#pragma unroll
    for (int j = 0; j < 2; ++j) { const int v = lane + 64 * j; const float e = o[j] * rstd * a.in[I_GNORM][l * 512 + hh * 128 + v] * r[j], g = bf2f(((const bf16_t*)(ws + WS_YB))[(size_t)tok * 512 + hh * 128 + v]); d2 += (g - e) * (g - e); e2 += e * e; }
    dbg_acc(dbg, stage, d2, e2, lane); }

__device__ __forceinline__ int dbg_row(unsigned i) { return (int)((i * 257u + 11u) % T); }
__global__ void dbg_snap(Args a, int from_in) { const int i = blockIdx.x, r = dbg_row(i); float* snap = (float*)(a.ws + WS_SNAP) + (size_t)i * D; const bf16_t* xs = (const bf16_t*)(a.ws + WS_XS); for (int k = threadIdx.x; k < D; k += 64) snap[k] = from_in ? a.in[I_X][(size_t)r * D + k] : bf2f(xs[(size_t)r * D + k]); }
__global__ void dbg_thin(Args a, int src, int outk, int route, const float* g_add, const float* g_out, const bf16_t* obuf, int st_x, int st_o, int st_r) { DBGP;
    unsigned char* ws = a.ws; const int i = sid, r = dbg_row(i); const float* snap = (const float*)(ws + WS_SNAP) + (size_t)i * D;
    const unsigned* gcnt = (const unsigned*)(ws + WS_CTL) + CW_CNT; const unsigned* ti = (const unsigned*)(ws + WS_TOKINFO) + (size_t)r * 8;
    float y[16], xn[16]; float ss = 0.f;
#pragma unroll
    for (int j = 0; j < 16; ++j) { const int k = lane + 64 * j; float v;
        if (src == 1) v = bf2f(((const bf16_t*)(ws + WS_Y))[(size_t)r * D + k]);
        else { v = __uint_as_float(ti[4]) * dbg_moe_el(ws, dbg_pbase(gcnt, (int)ti[0]) + (int)ti[1], k) + __uint_as_float(ti[5]) * dbg_moe_el(ws, dbg_pbase(gcnt, (int)ti[2]) + (int)ti[3], k); }
        y[j] = v; ss += v * v; }
    ss = wave_sum(ss); const float rstd = 1.f / sqrtf(ss / D + EPS); float d2 = 0.f, e2 = 0.f, s2 = 0.f;
#pragma unroll
    for (int j = 0; j < 16; ++j) { const int k = lane + 64 * j; xn[j] = snap[k] + y[j] * rstd * g_add[k]; const float g = (outk == 0) ? a.out[(size_t)r * D + k] : bf2f(((const bf16_t*)(ws + WS_XS))[(size_t)r * D + k]); d2 += (g - xn[j]) * (g - xn[j]); e2 += xn[j] * xn[j]; s2 += xn[j] * xn[j]; }
    dbg_acc(dbg, st_x, d2, e2, lane);
    if (outk != 1) return;
    s2 = wave_sum(s2); const float rs2 = 1.f / sqrtf(s2 / D + EPS); d2 = 0.f; e2 = 0.f; float hn[16];
#pragma unroll
    for (int j = 0; j < 16; ++j) { const int k = lane + 64 * j; hn[j] = (outk == 1) ? xn[j] * rs2 * g_out[k] : xn[j]; const float g = (MOE_FP8 && route) ? dbg_f8((const unsigned char*)obuf, (size_t)r * D + k) : bf2f(obuf[(size_t)r * D + k]); d2 += (g - hn[j]) * (g - hn[j]); e2 += hn[j] * hn[j]; }
    dbg_acc(dbg, st_o, d2, e2, lane);
    if (!route) return;
    float lg[8];
#pragma unroll
    for (int e = 0; e < 8; ++e) { float s = 0.f;
#pragma unroll
        for (int j = 0; j < 16; ++j) s += hn[j] * a.in[I_RW][(size_t)(lane + 64 * j) * NE + e]; lg[e] = wave_sum(s); }
    int e1 = 0; float v1 = lg[0];
#pragma unroll
    for (int e = 1; e < 8; ++e) if (lg[e] > v1) { v1 = lg[e]; e1 = e; }
    int e2i = -1; float v2 = -3.0e38f;
#pragma unroll
    for (int e = 0; e < 8; ++e) if (e != e1 && lg[e] > v2) { v2 = lg[e]; e2i = e; }
    const float ex = expf(v2 - v1), w1 = 1.f / (1.f + ex);
    float bad = 0.f; if ((int)ti[0] != e1 || (int)ti[2] != e2i) bad = 1.f; else { bad = fabsf(__uint_as_float(ti[4]) - w1) + fabsf(__uint_as_float(ti[5]) - (1.f - w1));
        const int* idxe = (const int*)(ws + WS_IDXE); if (ti[1] >= gcnt[e1] || ti[3] >= gcnt[e2i] || idxe[e1 * 16384 + ti[1]] != r || idxe[e2i * 16384 + ti[3]] != r) bad = 1.f; }
    if (lane == 0) { atomicAdd(dbg + 2 * st_r, bad * bad); atomicAdd(dbg + 2 * st_r + 1, 1.f); } }

__global__ void dbg_report(Args a) {
    const float* dbg = (const float*)(a.ws + WS_CTL) + CW_DBG; int bad = -1; float errk = 0.f;
    for (int k = 0; k < 33; ++k) { const float d2 = dbg[2 * k], e2 = dbg[2 * k + 1]; if (d2 == 0.f && e2 == 0.f) continue; const float err = d2 / e2; if (MK_DBG_SHOW == k) errk = (err == err) ? err : 1e6f; const float thr = (MOE_FP8 && (k == 25 || k == 27 || k == 28)) ? 3e-2f : 1e-3f; if (bad < 0 && !(err < thr)) bad = k; }
    float V = 0.f; bool fill = false;
    if (MK_DBG_SHOW >= 0) { V = sqrtf(7.f * 100.f * errk) + 1e-3f; fill = true; } else if (bad >= 0) { V = exp10f(1.f + 0.25f * (float)bad); fill = true; }
    if (fill) for (size_t i = (size_t)blockIdx.x * blockDim.x + threadIdx.x; i < (size_t)T * D; i += (size_t)gridDim.x * blockDim.x) a.out[i] = V; }

static void dbg_run(Args a, int grid, hipStream_t st) {
    auto ph = [&](int p) { a.ph_lo = p; a.ph_hi = p + 1; hipLaunchKernelGGL(fwd, dim3(grid), dim3(NTHR), LDS_BYTES, st, a); };
    const int NS = 2048;
    ph(0); hipLaunchKernelGGL(dbg_t1, dim3(256), dim3(64), 0, st, a, 0);
    for (int l = 0; l < DEPTH; ++l) { const int pb = 1 + 12 * l, sb = 16 * l; const size_t lo = (size_t)l * D;
        ph(pb + 0); hipLaunchKernelGGL(dbg_gemm, dim3(NS), dim3(64), 0, st, a, 1, l, sb + 1);
        ph(pb + 1); hipLaunchKernelGGL(dbg_attn, dim3(512), dim3(64), 0, st, a, l, sb + 2); hipLaunchKernelGGL(dbg_dstate, dim3(256), dim3(64), 0, st, a, l, sb + 3);
        ph(pb + 2); hipLaunchKernelGGL(dbg_scan, dim3(64), dim3(64), 0, st, a, sb + 4);
        ph(pb + 3); hipLaunchKernelGGL(dbg_glaout, dim3(256), dim3(64), 0, st, a, l, sb + 5);
        ph(pb + 4); hipLaunchKernelGGL(dbg_gemm, dim3(NS), dim3(64), 0, st, a, 2, l, sb + 6);
        ph(pb + 5); hipLaunchKernelGGL(dbg_gemm, dim3(NS), dim3(64), 0, st, a, 3, l, sb + 7);
        hipLaunchKernelGGL(dbg_snap, dim3(64), dim3(64), 0, st, a, l == 0 ? 1 : 0);
        ph(pb + 6); hipLaunchKernelGGL(dbg_thin, dim3(64), dim3(64), 0, st, a, 1, 1, l == 1 ? 1 : 0, a.in[I_NMPOST] + lo, a.in[I_NFPRE] + lo, (const bf16_t*)(a.ws + WS_HB), sb + 8, sb + 9, sb + 10);
        ph(pb + 7); hipLaunchKernelGGL(dbg_gemm, dim3(NS), dim3(64), 0, st, a, l == 0 ? 4 : 6, l, sb + 11);
        ph(pb + 8); hipLaunchKernelGGL(dbg_gemm, dim3(NS), dim3(64), 0, st, a, l == 0 ? 5 : 7, l, sb + 12);
        hipLaunchKernelGGL(dbg_snap, dim3(64), dim3(64), 0, st, a, 0);
        ph(pb + 9); hipLaunchKernelGGL(dbg_thin, dim3(64), dim3(64), 0, st, a, l == 0 ? 1 : 2, 2, 0, a.in[I_NFPOST] + lo, (const float*)nullptr, (const bf16_t*)nullptr, sb + 13, sb + 13, 0);
        a.sub = 1; ph(pb + 10); hipLaunchKernelGGL(dbg_gemm, dim3(NS), dim3(64), 0, st, a, 9, l, sb + 14);
        a.sub = 2; ph(pb + 10); a.sub = 0; hipLaunchKernelGGL(dbg_gemm, dim3(NS), dim3(64), 0, st, a, 8, l, sb + 15);
        hipLaunchKernelGGL(dbg_snap, dim3(64), dim3(64), 0, st, a, 0);
        ph(pb + 11); hipLaunchKernelGGL(dbg_thin, dim3(64), dim3(64), 0, st, a, 1, l == 0 ? 1 : 0, 0, a.in[I_PNORM] + lo, l == 0 ? a.in[I_NMPRE] + D : (const float*)nullptr, (const bf16_t*)(a.ws + WS_HB), sb + 16, sb + 16, 0);
    }
    hipLaunchKernelGGL(dbg_report, dim3(1024), dim3(256), 0, st, a);
}
#endif
#ifndef MK_SPLIT
#define MK_SPLIT 0
#endif
#ifndef MK_DBG
#define MK_DBG 0
#endif
extern "C" void kernel_launch(void* const* d_in, const int* in_sizes, int n_in, void* d_out, int out_size, void* d_ws, size_t ws_size, hipStream_t stream) {
    static int grid = 0;
    if (grid == 0) {
        if (n_in != 24 || in_sizes[0] != T * D || out_size != T * D || ws_size < WS_END) { fprintf(stderr, "kernel_launch: unexpected problem (n_in %d, in0 %d, out %d, ws %zu < %zu); nothing launched\n", n_in, n_in > 0 ? in_sizes[0] : -1, out_size, ws_size, (size_t)WS_END); grid = -1; return; }
        int dev = 0, cus = 0, per_cu = 0;
        if (hipGetDevice(&dev) != hipSuccess || hipDeviceGetAttribute(&cus, hipDeviceAttributeMultiprocessorCount, dev) != hipSuccess) { grid = -1; return; }
        if (hipFuncSetAttribute((const void*)fwd, hipFuncAttributeMaxDynamicSharedMemorySize, LDS_BYTES) != hipSuccess) { fprintf(stderr, "kernel_launch: hipFuncSetAttribute failed\n"); grid = -1; return; }
        if (hipOccupancyMaxActiveBlocksPerMultiprocessor(&per_cu, (const void*)fwd, NTHR, LDS_BYTES) != hipSuccess || per_cu < 1) { fprintf(stderr, "kernel_launch: occupancy query says %d blocks per CU\n", per_cu); }
        (void)hipGetLastError();
        grid = cus;
    }
    if (grid < 0) return;
    (void)hipMemsetAsync((char*)d_ws + WS_CTL, 0, CTL_ZERO_BYTES, stream);
    Args a{};
    for (int i = 0; i < 24; ++i) a.in[i] = (const float*)d_in[i];
    a.out = (float*)d_out; a.ws = (unsigned char*)d_ws;
#if MK_DBG
    dbg_run(a, grid, stream);
#elif MK_SPLIT
    for (int p = 0; p < N_PHASES; ++p) { a.ph_lo = p; a.ph_hi = p + 1; hipLaunchKernelGGL(fwd, dim3(grid), dim3(NTHR), LDS_BYTES, stream, a); }
#else
    a.ph_lo = 0; a.ph_hi = N_PHASES;
    hipLaunchKernelGGL(fwd, dim3(grid), dim3(NTHR), LDS_BYTES, stream, a);
#endif
}
```

```cpp
#include <hip/hip_runtime.h>
#include <cstdio>
#include <cstdint>

#define LAS __attribute__((address_space(3)))
#define GAS __attribute__((address_space(1)))
typedef unsigned short bf16_t;
typedef short bf16x8 __attribute__((ext_vector_type(8)));
typedef short s16x4 __attribute__((ext_vector_type(4)));
typedef float f32x4 __attribute__((ext_vector_type(4)));
typedef float f32x2 __attribute__((ext_vector_type(2)));
typedef unsigned u32x4 __attribute__((ext_vector_type(4)));
typedef unsigned u32x2 __attribute__((ext_vector_type(2)));

typedef __bf16 bf16x2_t __attribute__((ext_vector_type(2)));
__device__ __forceinline__ unsigned cvt_pk_bf16(float lo, float hi) { f32x2 v = {lo, hi}; const bf16x2_t b = __builtin_convertvector(v, bf16x2_t); return __builtin_bit_cast(unsigned, b); }
#ifndef WT_STORES
#define WT_STORES 1
#endif
struct WT { __amdgpu_buffer_rsrc_t rs; const char* base; };
__device__ __forceinline__ WT make_wt(void* ws_base, unsigned nbytes) { WT w; w.rs = __builtin_amdgcn_make_buffer_rsrc(ws_base, 0, (int)nbytes, 0x00020000); w.base = (const char*)ws_base; return w; }
__device__ __forceinline__ void st16(const WT& w, void* p, u32x4 v) {
#if WT_STORES
    __builtin_amdgcn_raw_buffer_store_b128(v, w.rs, (int)(unsigned)((const char*)p - w.base), 0, 16);
#else
    *(u32x4*)p = v;
#endif
}
__device__ __forceinline__ void st8(const WT& w, void* p, u32x2 v) {
#if WT_STORES
    __builtin_amdgcn_raw_buffer_store_b64(v, w.rs, (int)(unsigned)((const char*)p - w.base), 0, 16);
#else
    *(u32x2*)p = v;
#endif
}
__device__ __forceinline__ float clamp8(float v) { return __builtin_amdgcn_fmed3f(v, -448.f, 448.f); }
__device__ __forceinline__ unsigned pk4_fp8(float a, float b, float c, float d) { int w = __builtin_amdgcn_cvt_pk_fp8_f32(clamp8(a), clamp8(b), 0, false); w = __builtin_amdgcn_cvt_pk_fp8_f32(clamp8(c), clamp8(d), w, true); return (unsigned)w; }
__device__ __forceinline__ float q8(float x, float s) { const int w = __builtin_amdgcn_cvt_pk_fp8_f32(x * s, 0.f, 0, false); return __builtin_amdgcn_cvt_f32_fp8(w, 0) * (1.0f / s); }
__device__ __forceinline__ float bf_lo(unsigned w) { return __uint_as_float(w << 16); }
__device__ __forceinline__ float bf_hi(unsigned w) { return __uint_as_float(w & 0xffff0000u); }
__device__ __forceinline__ float bf2f(bf16_t b) { return __uint_as_float(((unsigned)b) << 16); }
__device__ __forceinline__ float fast_sigmoid(float v) { return __builtin_amdgcn_rcpf(1.0f + __builtin_amdgcn_exp2f(-1.4426950408889634f * v)); }
__device__ __forceinline__ float wave_sum(float v) {
#pragma unroll
    for (int o = 1; o < 64; o <<= 1) v += __shfl_xor(v, o);
    return v;
}

typedef int v8i32 __attribute__((ext_vector_type(8)));
typedef int v4i32 __attribute__((ext_vector_type(4)));
__device__ __forceinline__ v8i32 cat8i(bf16x8 a, bf16x8 b) { const v4i32 x = __builtin_bit_cast(v4i32, a), y = __builtin_bit_cast(v4i32, b); return (v8i32){x[0], x[1], x[2], x[3], y[0], y[1], y[2], y[3]}; }
namespace pg8 {
constexpr int BM = 256, BK = 64, HALF = 128, HTB = HALF * BK * 2, STAGE_BYTES = 8 * HTB, NXCD = 8, WGM = 8;
__host__ __device__ __forceinline__ int lds_byte(int r, int c) { const int st = (r >> 4) * 2 + (c >> 5), rr = r & 15, cc = c & 31, ob = rr * 64 + cc * 2; return st * 1024 + (ob ^ (((ob >> 9) & 1) << 5)); }
__host__ __device__ __forceinline__ void stage_rc(int b, int& R, int& C) { const int st = b / 1024, sb = b % 1024, swz = sb ^ (((sb >> 9) & 1) << 5); R = (st >> 1) * 16 + swz / 64; C = (st & 1) * 32 + (swz % 64) / 2; }
__host__ __device__ __forceinline__ int perm32(int rho) { const int n = rho >> 4, i = rho & 15; return 8 * (i >> 2) + 4 * n + (i & 3); }

struct Unit { int pm, pn, e, lr0, cnt, koff; };
struct Gemm { const bf16_t* A; const bf16_t* Bt; int K; size_t b_estride; const int* gidx; int ld; };

struct StaticOrder {
    int nM, nN, nwg, G, c;
    __device__ __forceinline__ void init(int M, int N, int G_, int c_) { nM = M / BM; nN = N / BM; nwg = nM * nN; G = G_; c = c_; }
    __device__ __forceinline__ bool short_deal() const { const int r = nwg % G; return r != 0 && c >= r; }
    __device__ __forceinline__ bool next(int i, Unit& u) const {
        const long L = (long)i * G + c; if (L >= nwg) return false;
        int wgid = (int)L; { const int q = nwg / NXCD, r = nwg % NXCD, xcd = wgid % NXCD, off = wgid / NXCD; wgid = (xcd < r ? xcd * (q + 1) : r * (q + 1) + (xcd - r) * q) + off; }
        const int nig = WGM * nN, gid = wgid / nig, fm = gid * WGM, gsz = (nM - fm) < WGM ? (nM - fm) : WGM;
        u.pm = fm + ((wgid % nig) % gsz); u.pn = (wgid % nig) / gsz; u.e = 0; u.lr0 = 0; u.cnt = 0; u.koff = 0; return true;
    }
};
struct GroupedOrder {
    int pb[9]; int cnt[8]; int nN, G, c, nwg, np;
    __device__ __forceinline__ void init(const unsigned* counts, int N, int G_, int c_, int pmax = 1 << 30) {
        int acc = 0;
#pragma unroll
        for (int e = 0; e < 8; ++e) { const int n = (int)counts[e]; cnt[e] = n; pb[e] = acc; acc += (n + 255) >> 8; }
        pb[8] = acc; nN = N / BM; G = G_; c = c_; np = acc < pmax ? acc : pmax; nwg = np * nN;
    }
    __device__ __forceinline__ bool short_deal() const { const int r = nwg % G; return r != 0 && c >= r; }
    __device__ __forceinline__ bool next(int i, Unit& u) const {
        const long L = (long)i * G + c; if (L >= nwg) return false;
        const int nig = WGM * nN, gid = (int)L / nig, fm = gid * WGM, gsz = (np - fm) < WGM ? (np - fm) : WGM;
        const int pm = fm + (((int)L % nig) % gsz), pn = ((int)L % nig) / gsz;
        int e = 0;
#pragma unroll
        for (int k = 1; k < 8; ++k) e += (pm >= pb[k]) ? 1 : 0;
        int pbe = 0, ce = 0;
#pragma unroll
        for (int k = 0; k < 8; ++k) { pbe = (k == e) ? pb[k] : pbe; ce = (k == e) ? cnt[k] : ce; }
        u.pm = pm; u.pn = pn; u.e = e; u.lr0 = (pm - pbe) * 256; u.cnt = ce; u.koff = 0; return true;
    }
};

struct TailOrder {
    int pb[9]; int nN, G, c, nwg, p0, KC, KCH;
    __device__ __forceinline__ void init(const unsigned* counts, int N, int G_, int c_, int p0_, int KC_, int KCH_) {
        int acc = 0;
#pragma unroll
        for (int e = 0; e < 8; ++e) { pb[e] = acc; acc += ((int)counts[e] + 255) >> 8; }
        pb[8] = acc; nN = N / BM; G = G_; c = c_; p0 = p0_; KC = KC_; KCH = KCH_; nwg = acc > p0 ? (acc - p0) * nN * KC : 0;
    }
    __device__ __forceinline__ bool short_deal() const { return false; }
    __device__ __forceinline__ bool next(int i, Unit& u) const {
        const long L = (long)i * G + c; if (L >= nwg) return false;
        const int kc = (int)L % KC, t = (int)L / KC, pm = p0 + t / nN, pn = t % nN;
        int e = 0;
#pragma unroll
        for (int k = 1; k < 8; ++k) e += (pm >= pb[k]) ? 1 : 0;
        u.pm = pm; u.pn = pn; u.e = e; u.lr0 = 0; u.cnt = 0; u.koff = kc * KCH; return true;
    }
};

template <class Epi, class Sched, bool GATHER, bool F8 = false>
__device__ __forceinline__ void gemm_phase(LAS unsigned char* lds, const Gemm g, const Sched& S, const Epi& E) {
    int tid = threadIdx.x; asm volatile("" : "+v"(tid));
    const int wid = __builtin_amdgcn_readfirstlane(tid >> 6), lane = tid & 63, wr = wid >> 2, wc = wid & 3, fr = lane & 15, fq = lane >> 4;
    const int K = g.K, nt = K / BK, LD = g.ld ? g.ld : g.K;
    unsigned voffA[2], voffB[2]; int rA[2];
#pragma unroll
    for (int i = 0; i < 2; ++i) { int R, C; stage_rc(tid * 16 + i * 8192, R, C); const int Rb = Epi::PERM ? ((R & ~31) + perm32(R & 31)) : R;
        voffA[i] = GATHER ? (unsigned)(C * 2) : (unsigned)(R * LD + C) * 2u; voffB[i] = (unsigned)(Rb * LD + C) * 2u; rA[i] = R; }
    const size_t kstep = (size_t)(BK * 2);
    const size_t hstep = (size_t)HALF * LD * 2;
    const size_t tstep = 2 * hstep;
    const unsigned ldsw = (unsigned)wid * 1024u;
    const int aoff = F8 ? lds_byte(wr * 64 + fr, fq * 16) : lds_byte(wr * 64 + fr, fq * 8), boff = F8 ? lds_byte(wc * 32 + fr, fq * 16) : lds_byte(wc * 32 + fr, fq * 8);
    const int aof1 = F8 ? lds_byte(wr * 64 + fr, fq * 16 + 8) : aoff + 1024, bof1 = F8 ? lds_byte(wc * 32 + fr, fq * 16 + 8) : boff + 1024;
#define PG8_SA(b, h) (((b) * 2 + (h)) * HTB)
#define PG8_SB(b, h) ((4 + (b) * 2 + (h)) * HTB)
#define PG8_STAGE2(bufoff, gbase, v0, v1) do { unsigned _a = (v0), _b = (v1); asm volatile("" : "+v"(_a), "+v"(_b));     \
        __builtin_amdgcn_global_load_lds((const unsigned*)((const char*)(gbase) + _a), (LAS unsigned*)(lds + (bufoff) + ldsw), 16, 0, 0); \
        __builtin_amdgcn_global_load_lds((const unsigned*)((const char*)(gbase) + _b), (LAS unsigned*)(lds + (bufoff) + ldsw + 8192), 16, 0, 0); } while (0)
#define PG8_STAGE(bufoff, gbase, voff) PG8_STAGE2(bufoff, gbase, (voff)[0], (voff)[1])
#define PG8_STAGE_A(bufoff, nx, h, kt) do { \
        if constexpr (GATHER) { const char* _p = (const char*)g.A + (size_t)(kt) * kstep; \
            if (nx) { PG8_STAGE2(bufoff, _p, nG[h][0], nG[h][1]); } else { PG8_STAGE2(bufoff, _p, cG[h][0], cG[h][1]); } } \
        else { const char* _p = ((nx) ? nA : cA) + (size_t)(h) * hstep + (size_t)(kt) * kstep; PG8_STAGE2(bufoff, _p, voffA[0], voffA[1]); } } while (0)
#define PG8_LDA(dst, b, h) do { _Pragma("unroll") for (int m = 0; m < 4; ++m) { \
        if constexpr (F8) { dst##8[m].lo = *(const LAS v4i32*)(lds + PG8_SA(b, h) + aoff + m * 2048); dst##8[m].hi = *(const LAS v4i32*)(lds + PG8_SA(b, h) + aof1 + m * 2048); } \
        else { dst[m][0] = *(const LAS bf16x8*)(lds + PG8_SA(b, h) + aoff + m * 2048); dst[m][1] = *(const LAS bf16x8*)(lds + PG8_SA(b, h) + aof1 + m * 2048); } } } while (0)
#define PG8_LDB(dst, b, h) do { _Pragma("unroll") for (int n = 0; n < 2; ++n) { \
        if constexpr (F8) { dst##8[n].lo = *(const LAS v4i32*)(lds + PG8_SB(b, h) + boff + n * 2048); dst##8[n].hi = *(const LAS v4i32*)(lds + PG8_SB(b, h) + bof1 + n * 2048); } \
        else { dst[n][0] = *(const LAS bf16x8*)(lds + PG8_SB(b, h) + boff + n * 2048); dst[n][1] = *(const LAS bf16x8*)(lds + PG8_SB(b, h) + bof1 + n * 2048); } } } while (0)
#define PG8_MMA(ai, bj, At, Bt) do { __builtin_amdgcn_s_setprio(1); _Pragma("unroll") for (int m = 0; m < 4; ++m) _Pragma("unroll") for (int n = 0; n < 2; ++n) { \
        if constexpr (F8) asm volatile("v_mfma_scale_f32_16x16x128_f8f6f4 %0, %1, %2, %0, %3, %3 op_sel_hi:[0,0,0]" : "+v"(acc[ai][bj][m][n]) : "v"(Bt##8[n]), "v"(At##8[m]), "v"(one8));   \
        else { _Pragma("unroll") for (int k = 0; k < 2; ++k) acc[ai][bj][m][n] = __builtin_amdgcn_mfma_f32_16x16x32_bf16(Bt[n][k], At[m][k], acc[ai][bj][m][n], 0, 0, 0); } } __builtin_amdgcn_s_setprio(0); } while (0)
#define PG8_WAIT_V(n) asm volatile("s_waitcnt vmcnt(" #n ")" ::: "memory")
#define PG8_WAIT_L(n) asm volatile("s_waitcnt lgkmcnt(" #n ")" ::: "memory")
#define PG8_BAR __builtin_amdgcn_s_barrier()
#define PG8_SCHED __builtin_amdgcn_sched_barrier(0)
#define PG8_GIDX(dst, u) do { _Pragma("unroll") for (int h = 0; h < 2; ++h) _Pragma("unroll") for (int i = 0; i < 2; ++i) { \
        const int _lr = (u).lr0 + h * HALF + rA[i]; const int _tok = (_lr < (u).cnt) ? g.gidx[(u).e * 16384 + _lr] : 0; dst[h][i] = (unsigned)_tok * (unsigned)(LD * 2) + voffA[i]; } } while (0)
    Unit cur, nxt; int ui = 0;
    if (!S.next(0, cur)) return;
#ifdef STAGGER_TICKS
    if (S.short_deal()) { const unsigned long long t0 = __builtin_amdgcn_s_memrealtime(); while (__builtin_amdgcn_s_memrealtime() - t0 < (unsigned long long)(STAGGER_TICKS)) __builtin_amdgcn_s_sleep(8); }
#endif
    f32x4 acc[2][2][4][2];
#pragma unroll
    for (int a = 0; a < 2; ++a)
#pragma unroll
        for (int b = 0; b < 2; ++b)
#pragma unroll
            for (int m = 0; m < 4; ++m)
#pragma unroll
                for (int n = 0; n < 2; ++n) acc[a][b][m][n] = (f32x4){0.f, 0.f, 0.f, 0.f};
    const int one8 = 0x7f7f7f7f;
    bf16x8 At[4][2], B0[2][2], B1[2][2]; v8i32 At8[4], B08[2], B18[2];
    unsigned cG[2][2] = {{0u, 0u}, {0u, 0u}}, nG[2][2] = {{0u, 0u}, {0u, 0u}};
    const char* cA = (const char*)g.A + (size_t)cur.pm * tstep + (size_t)cur.koff * 2; const char* cB = (const char*)g.Bt + ((size_t)cur.e * g.b_estride + (size_t)cur.koff) * 2 + (size_t)cur.pn * tstep;
    const char* nA = cA;
    if constexpr (GATHER) { PG8_GIDX(cG, cur); }
    PG8_STAGE(PG8_SB(0, 0), cB, voffB); PG8_STAGE(PG8_SB(0, 1), cB + hstep, voffB); PG8_STAGE_A(PG8_SA(0, 0), false, 0, 0); PG8_STAGE_A(PG8_SA(0, 1), false, 1, 0);
    if (wr == 1) PG8_BAR;
    PG8_WAIT_V(2); PG8_BAR;
    PG8_STAGE(PG8_SB(1, 0), cB + kstep, voffB); PG8_STAGE_A(PG8_SA(1, 0), false, 0, 1); PG8_STAGE(PG8_SB(1, 1), cB + hstep + kstep, voffB);
    PG8_WAIT_V(6); PG8_BAR;
    for (;;) {
        const bool has_next = S.next(ui + 1, nxt);
        nA = has_next ? (const char*)g.A + (size_t)nxt.pm * tstep + (size_t)nxt.koff * 2 : cA;
        const char* nB = has_next ? (const char*)g.Bt + ((size_t)nxt.e * g.b_estride + (size_t)nxt.koff) * 2 + (size_t)nxt.pn * tstep : cB;
        if constexpr (GATHER) { if (has_next) { PG8_GIDX(nG, nxt); } else {
#pragma unroll
            for (int h = 0; h < 2; ++h)
#pragma unroll
                for (int i = 0; i < 2; ++i) nG[h][i] = cG[h][i]; } }
#pragma nounroll
        for (int t = 0; t < nt; t += 2) {
            const bool last = (t == nt - 2);
            const int kt2 = last ? 0 : t + 2, kt3 = kt2 + 1;
            const char* b2 = last ? nB : cB + (size_t)(t + 2) * kstep;
            const char* b3 = b2 + kstep;
            PG8_LDB(B0, 0, 0); PG8_LDB(B1, 0, 1); PG8_SCHED; PG8_LDA(At, 0, 0); PG8_STAGE_A(PG8_SA(1, 1), false, 1, t + 1);
            PG8_WAIT_V(8); PG8_WAIT_L(0); PG8_BAR; PG8_MMA(0, 0, At, B0); PG8_MMA(0, 1, At, B1); PG8_BAR; PG8_SCHED;
            PG8_LDA(At, 0, 1); PG8_STAGE(PG8_SB(0, 0), b2, voffB); PG8_STAGE(PG8_SB(0, 1), b2 + hstep, voffB); PG8_STAGE_A(PG8_SA(0, 0), last, 0, kt2);
            PG8_WAIT_V(8); PG8_WAIT_L(0); PG8_BAR; PG8_MMA(1, 0, At, B0); PG8_MMA(1, 1, At, B1); PG8_BAR; PG8_SCHED;
            PG8_LDB(B0, 1, 0); PG8_LDB(B1, 1, 1); PG8_SCHED; PG8_LDA(At, 1, 0); PG8_STAGE_A(PG8_SA(0, 1), last, 1, kt2);
            PG8_WAIT_V(8); PG8_WAIT_L(0); PG8_BAR; PG8_MMA(0, 0, At, B0); PG8_MMA(0, 1, At, B1); PG8_BAR; PG8_SCHED;
            PG8_LDA(At, 1, 1); PG8_STAGE(PG8_SB(1, 0), b3, voffB); PG8_STAGE(PG8_SB(1, 1), b3 + hstep, voffB); PG8_STAGE_A(PG8_SA(1, 0), last, 0, kt3);
            PG8_WAIT_V(8); PG8_WAIT_L(0); PG8_BAR; PG8_MMA(1, 0, At, B0); PG8_MMA(1, 1, At, B1); PG8_BAR; PG8_SCHED;
        }
        if constexpr (F8) asm volatile("s_nop 15\n\ts_nop 15" ::: "memory");
        if (wr == 0) PG8_BAR;
        { Unit eu = cur; eu.pm = __builtin_amdgcn_readfirstlane(eu.pm); eu.pn = __builtin_amdgcn_readfirstlane(eu.pn); asm volatile("" : "+s"(eu.pm), "+s"(eu.pn));
          E(acc, eu, wr, wc, fr, fq);
#ifdef EPI2
          if constexpr (Epi::IDEM) E(acc, eu, wr, wc, fr, fq);
#endif
        }
        if (!has_next) break;
#pragma unroll
        for (int a = 0; a < 2; ++a)
#pragma unroll
            for (int b = 0; b < 2; ++b)
#pragma unroll
                for (int m = 0; m < 4; ++m)
#pragma unroll
                    for (int n = 0; n < 2; ++n) acc[a][b][m][n] = (f32x4){0.f, 0.f, 0.f, 0.f};
        cur = nxt; cA = nA; cB = nB; ++ui;
        if constexpr (GATHER) {
#pragma unroll
            for (int h = 0; h < 2; ++h)
#pragma unroll
                for (int i = 0; i < 2; ++i) cG[h][i] = nG[h][i]; }
        if (wr == 1) PG8_BAR;
    }
    PG8_WAIT_V(0);
    PG8_BAR;
#undef PG8_SA
#undef PG8_SB
#undef PG8_STAGE
#undef PG8_STAGE2
#undef PG8_STAGE_A
#undef PG8_LDA
#undef PG8_LDB
#undef PG8_MMA
#undef PG8_WAIT_V
#undef PG8_WAIT_L
#undef PG8_BAR
#undef PG8_SCHED
#undef PG8_GIDX
}
}
namespace pg8 {
constexpr float QA_SCALE = 0.125f * 1.4426950408889634f;
constexpr float QB_SCALE = 0.125f;

struct EpiInProj {
    static constexpr bool PERM = true, IDEM = true;
    bf16_t* base; WT wt;
    __device__ __forceinline__ void operator()(const f32x4 (&acc)[2][2][4][2], const Unit& u, int wr, int wc, int fr, int fq) const {
        const int pn = u.pn;
        size_t toff; int ld, ct; float sc = 1.f; int act = 0;
        constexpr size_t Mi = 1u << 20;
        if (pn < 2)       { toff = 16 * Mi; ld = 512; ct = pn; sc = QA_SCALE; }
        else if (pn < 4)  { toff = 24 * Mi; ld = 512; ct = pn - 2; }
        else if (pn < 6)  { toff = 32 * Mi; ld = 512; ct = pn - 4; }
        else if (pn < 7)  { toff = 0; ld = 256; ct = 0; sc = QB_SCALE; }
        else if (pn < 8)  { toff = 4 * Mi; ld = 256; ct = 0; }
        else if (pn < 10) { toff = 8 * Mi; ld = 512; ct = pn - 8; }
        else if (pn < 12) { toff = 40 * Mi; ld = 512; ct = pn - 10; act = 1; }
        else if (pn < 16) { toff = 48 * Mi; ld = 1024; ct = pn - 12; act = 2; }
        else              { toff = 64 * Mi; ld = 1024; ct = pn - 16; act = 2; }
        const int row0 = u.pm * BM + wr * 64 + fr, col0 = ct * BM + wc * 32 + 8 * fq;
        bf16_t* O = base + toff;
#pragma unroll
        for (int ai = 0; ai < 2; ++ai)
#pragma unroll
            for (int m = 0; m < 4; ++m) { bf16_t* rowp = O + (size_t)(row0 + ai * HALF + m * 16) * ld + col0;
#pragma unroll
                for (int bj = 0; bj < 2; ++bj) { f32x4 v0 = acc[ai][bj][m][0] * sc, v1 = acc[ai][bj][m][1] * sc;
                    if (act) {
#pragma unroll
                        for (int j = 0; j < 4; ++j) { const float s0 = fast_sigmoid(v0[j]), s1 = fast_sigmoid(v1[j]); v0[j] = (act == 1) ? v0[j] * s0 : s0; v1[j] = (act == 1) ? v1[j] * s1 : s1; } }
                    u32x4 w; w.x = cvt_pk_bf16(v0[0], v0[1]); w.y = cvt_pk_bf16(v0[2], v0[3]); w.z = cvt_pk_bf16(v1[0], v1[1]); w.w = cvt_pk_bf16(v1[2], v1[3]);
                    st16(wt, rowp + bj * HALF, w); } }
    }
};

template <int MODE> struct EpiEw {
    static constexpr bool PERM = true, IDEM = (MODE != 2 && MODE != 4);
    bf16_t* O; const bf16_t* G; int ldc; WT wt; float sc = 1.f;
    __device__ __forceinline__ void operator()(const f32x4 (&acc)[2][2][4][2], const Unit& u, int wr, int wc, int fr, int fq) const {
        const int row0 = u.pm * BM + wr * 64 + fr, col0 = u.pn * BM + wc * 32 + 8 * fq;
#pragma unroll
        for (int ai = 0; ai < 2; ++ai)
#pragma unroll
            for (int m = 0; m < 4; ++m) { const size_t ro = (size_t)(row0 + ai * HALF + m * 16) * ldc + col0;
#pragma unroll
                for (int bj = 0; bj < 2; ++bj) { f32x4 v0 = acc[ai][bj][m][0], v1 = acc[ai][bj][m][1];
                    if (MODE == 0) { v0 = v0 * sc; v1 = v1 * sc; }
                    if (MODE == 1 || MODE == 2) { const u32x4 gw = *(const u32x4*)(G + ro + bj * HALF);
                        v0[0] *= bf_lo(gw.x); v0[1] *= bf_hi(gw.x); v0[2] *= bf_lo(gw.y); v0[3] *= bf_hi(gw.y); v1[0] *= bf_lo(gw.z); v1[1] *= bf_hi(gw.z); v1[2] *= bf_lo(gw.w); v1[3] *= bf_hi(gw.w); }
                    if (MODE == 3) {
#pragma unroll
                        for (int j = 0; j < 4; ++j) { v0[j] = fast_sigmoid(v0[j]); v1[j] = fast_sigmoid(v1[j]); } }
                    if (MODE == 2 || MODE == 4) { const u32x4 ow = *(const u32x4*)(O + ro + bj * HALF);
                        if (MODE == 2) { v0[0] += bf_lo(ow.x); v0[1] += bf_hi(ow.x); v0[2] += bf_lo(ow.y); v0[3] += bf_hi(ow.y); v1[0] += bf_lo(ow.z); v1[1] += bf_hi(ow.z); v1[2] += bf_lo(ow.w); v1[3] += bf_hi(ow.w); }
                        else { v0[0] *= bf_lo(ow.x); v0[1] *= bf_hi(ow.x); v0[2] *= bf_lo(ow.y); v0[3] *= bf_hi(ow.y); v1[0] *= bf_lo(ow.z); v1[1] *= bf_hi(ow.z); v1[2] *= bf_lo(ow.w); v1[3] *= bf_hi(ow.w); } }
                    u32x4 w; w.x = cvt_pk_bf16(v0[0], v0[1]); w.y = cvt_pk_bf16(v0[2], v0[3]); w.z = cvt_pk_bf16(v1[0], v1[1]); w.w = cvt_pk_bf16(v1[2], v1[3]);
                    st16(wt, O + ro + bj * HALF, w); } }
    }
};

struct EpiPart {
    static constexpr bool PERM = true, IDEM = true;
    bf16_t* P; int ldc, p0, KCH; size_t plane; WT wt; float sc = 1.f;
    __device__ __forceinline__ void operator()(const f32x4 (&acc)[2][2][4][2], const Unit& u, int wr, int wc, int fr, int fq) const {
        const int row0 = (u.pm - p0) * BM + wr * 64 + fr, col0 = u.pn * BM + wc * 32 + 8 * fq;
        bf16_t* O = P + (size_t)(u.koff / KCH) * plane;
#pragma unroll
        for (int ai = 0; ai < 2; ++ai)
#pragma unroll
            for (int m = 0; m < 4; ++m) { const size_t ro = (size_t)(row0 + ai * HALF + m * 16) * ldc + col0;
#pragma unroll
                for (int bj = 0; bj < 2; ++bj) { const f32x4 v0 = acc[ai][bj][m][0] * sc, v1 = acc[ai][bj][m][1] * sc;
                    u32x4 w; w.x = cvt_pk_bf16(v0[0], v0[1]); w.y = cvt_pk_bf16(v0[2], v0[3]); w.z = cvt_pk_bf16(v1[0], v1[1]); w.w = cvt_pk_bf16(v1[2], v1[3]);
                    st16(wt, O + ro + bj * HALF, w); } }
    }
};

struct EpiGateUp {
    static constexpr bool PERM = true, IDEM = true;
    bf16_t* O; int ldc; WT wt; float qs;
    __device__ __forceinline__ void operator()(const f32x4 (&acc)[2][2][4][2], const Unit& u, int wr, int wc, int fr, int fq) const {
        const int row0 = u.pm * BM + wr * 64 + fr, col0 = u.pn * HALF + wc * 32 + 8 * fq;
#pragma unroll
        for (int ai = 0; ai < 2; ++ai)
#pragma unroll
            for (int m = 0; m < 4; ++m) { bf16_t* rowp = O + (size_t)(row0 + ai * HALF + m * 16) * ldc + col0;
                f32x4 v0, v1;
#pragma unroll
                for (int j = 0; j < 4; ++j) { const float g0 = acc[ai][0][m][0][j], g1 = acc[ai][0][m][1][j];
                    v0[j] = g0 * fast_sigmoid(g0) * acc[ai][1][m][0][j]; v1[j] = g1 * fast_sigmoid(g1) * acc[ai][1][m][1][j];
#if defined(SIM_FP8) || defined(SIM_FFN0)
                    if (qs != 0.f) { v0[j] = q8(v0[j], qs); v1[j] = q8(v1[j], qs); }
#endif
                }
                u32x4 w; w.x = cvt_pk_bf16(v0[0], v0[1]); w.y = cvt_pk_bf16(v0[2], v0[3]); w.z = cvt_pk_bf16(v1[0], v1[1]); w.w = cvt_pk_bf16(v1[2], v1[3]);
                st16(wt, rowp, w); }
    }
};
struct EpiGateUp8 {
    static constexpr bool PERM = true, IDEM = true;
    unsigned char* O; int ldc; WT wt; float sin, sout;
    __device__ __forceinline__ void operator()(const f32x4 (&acc)[2][2][4][2], const Unit& u, int wr, int wc, int fr, int fq) const {
        const int row0 = u.pm * BM + wr * 64 + fr, col0 = u.pn * HALF + wc * 32 + 8 * fq;
#pragma unroll
        for (int ai = 0; ai < 2; ++ai)
#pragma unroll
            for (int m = 0; m < 4; ++m) { unsigned char* rowp = O + (size_t)(row0 + ai * HALF + m * 16) * ldc + col0;
                f32x4 v0, v1;
#pragma unroll
                for (int j = 0; j < 4; ++j) { const float g0 = acc[ai][0][m][0][j] * sin, g1 = acc[ai][0][m][1][j] * sin;
                    v0[j] = g0 * fast_sigmoid(g0) * (acc[ai][1][m][0][j] * (sin * sout)); v1[j] = g1 * fast_sigmoid(g1) * (acc[ai][1][m][1][j] * (sin * sout)); }
                u32x2 w; w.x = pk4_fp8(v0[0], v0[1], v0[2], v0[3]); w.y = pk4_fp8(v1[0], v1[1], v1[2], v1[3]);
                *(u32x2*)rowp = w; }
    }
};
}
#ifndef MK_DBG
#define MK_DBG 0
#endif
#ifndef MOE_FP8
#define MOE_FP8 1
#endif
constexpr int D = 1024, NB = 8, SEQ = 2048, T = NB * SEQ, DEPTH = 2, CH = 64, NCH = SEQ / CH, NPREV = 8;
constexpr int AH = 8, BH = 4, GR = 16, DFF = 2816, NE = 8, DFE = 3584, PLE = 256, INW = 5136, INWG = 5120, RELN = 257;
constexpr float EPS = 1e-6f, LOG2E = 1.4426950408889634f;
constexpr int NWAVES = 8, NTHR = 512;
constexpr int MOE_ROWS = 34816;

constexpr size_t MiB = 1u << 20;
constexpr size_t WS_CTL = 0, CTL_ZERO_BYTES = 256 * 1024;
constexpr size_t WS_TOKINFO = 1 * MiB;
constexpr size_t WS_IDXE = 2 * MiB;
constexpr size_t WS_DEC = 3 * MiB;
constexpr size_t WS_W1 = 4 * MiB;
constexpr size_t WS_PB = 189 * MiB;
constexpr size_t WS_G = 205 * MiB;
constexpr size_t WS_HB = WS_G, WS_DST = WS_G + 32 * MiB, WS_YSLOT = WS_G;
constexpr size_t WS_BIG = 273 * MiB;
constexpr size_t WS_W0 = WS_BIG, WS_PROJ = WS_BIG + 34 * MiB, WS_MACT = WS_BIG;
constexpr size_t WS_Y = WS_PROJ;
constexpr size_t WS_QB = WS_PROJ, WS_KB = WS_PROJ + 8 * MiB, WS_VB = WS_PROJ + 16 * MiB, WS_QA = WS_PROJ + 32 * MiB, WS_KA = WS_PROJ + 48 * MiB, WS_VA = WS_PROJ + 64 * MiB;
constexpr size_t WS_SR = WS_PROJ + 80 * MiB, WS_SGA = WS_PROJ + 96 * MiB, WS_SGB = WS_PROJ + 128 * MiB;
constexpr size_t WS_MERGED = WS_KA;
constexpr size_t WS_ST = WS_KA;
constexpr size_t WS_FACT = WS_QA;
constexpr size_t WS_YA = WS_PROJ + 160 * MiB, WS_YB = WS_PROJ + 176 * MiB;
constexpr size_t WS_XB = WS_SGB;
constexpr int MOE_MAIN_PANELS = 128, MOE_MAIN_ROWS = MOE_MAIN_PANELS * 256, TAIL_KC = MOE_FP8 ? 7 : 14, TAIL_KCH = 256  , TAIL_ROWS = MOE_ROWS - MOE_MAIN_ROWS;
constexpr size_t WS_END = 511 * MiB;
static_assert(WS_FACT + (size_t)T * DFF * 2 <= WS_XB && WS_MACT + (size_t)MOE_ROWS * DFE * 2 <= WS_END && WS_YSLOT + (size_t)MOE_ROWS * D * 2 <= WS_BIG && WS_SGB + 32 * MiB <= WS_YA && WS_YB + 16 * MiB <= WS_END, "d_ws map");
constexpr size_t OFF_WIN = 0, OFF_WGD = 10 * MiB, OFF_WBA = 10 * MiB + 65536, OFF_WBB = OFF_WBA + 1 * MiB, OFF_WOUT = OFF_WBB + 1 * MiB, OFF_WPP = OFF_WOUT + 2 * MiB, OFF_WPG = OFF_WPP + MiB / 2;
constexpr size_t OFF_FFN = 17 * MiB;
constexpr size_t OFF_FDN = OFF_FFN + 11 * MiB, OFF_MDN = OFF_FFN + 8 * 14 * MiB;
constexpr size_t OFF_MDN8 = OFF_FFN + 8 * 7 * MiB;
constexpr float W8_SCALE = 64.f, ACT8_SCALE = 8.f;
constexpr size_t WS_XS = WS_W1 + OFF_MDN8 + 8 * 7 * MiB / 2;
static_assert(MOE_FP8 && WS_XS + (size_t)T * D * 2 <= WS_PB, "x stream placement needs the e4m3 weight layout");
constexpr size_t WS_PBUF = WS_W1 + OFF_FFN;
static_assert((size_t)TAIL_KC * TAIL_ROWS * D * 2 <= (MOE_FP8 ? 8 * 7 : 8 * 14) * MiB, "partial planes");
static_assert(OFF_WPG + 2 * MiB <= OFF_FFN && WS_W1 + OFF_MDN + 8 * 7 * MiB <= WS_PB && OFF_FDN + (size_t)D * DFF * 2 <= 34 * MiB, "weight map");
constexpr int CW_BAR = 4096;
constexpr int CW_CNT = 8192;
constexpr int CW_DBG = 16384;

constexpr int RING_BYTES = 131072;
constexpr int LDSCTL_OFF = RING_BYTES, MISC_OFF = LDSCTL_OFF + 320;
constexpr int XTRA_OFF = RING_BYTES + 1024;
constexpr int LDS_BYTES = 147456;

typedef GAS unsigned gu32;
#define RLX_AGENT __ATOMIC_RELAXED, __HIP_MEMORY_SCOPE_AGENT
#define LDS_WAIT() asm volatile("s_waitcnt lgkmcnt(0)" ::: "memory")
#define VM_WAIT() asm volatile("s_waitcnt vmcnt(0)" ::: "memory")

#define XB_TMO      128
#define XB_XCNT(j)  (256  + 64 * (j))
#define XB_XSUB(j)  (1280 + 64 * (j))
#define XB_XGEN(j)  (2304 + 64 * (j))
#define XB_TOP      3328
#define XB_TOPGEN   3392
#define XCD_BAR_WORDS 3456
#define XB_SPIN_CAP (1u << 18)
__device__ __forceinline__ unsigned xb_ld(unsigned* p)              { return __hip_atomic_load(p, __ATOMIC_RELAXED, __HIP_MEMORY_SCOPE_AGENT); }
__device__ __forceinline__ unsigned xb_add(unsigned* p, unsigned v) { return __hip_atomic_fetch_add(p, v, __ATOMIC_RELAXED, __HIP_MEMORY_SCOPE_AGENT); }
__device__ __forceinline__ unsigned xb_xcc_id() { return (unsigned)__builtin_amdgcn_s_getreg((3 << 11) | 20) & 0xFu; }
#define XB_SPIN(cond, bar) do { unsigned _sp = 0; while (cond) { __builtin_amdgcn_s_sleep(1); \
    if ((++_sp & 255u) == 0u) { if (xb_ld(&(bar)[XB_TMO])) break; if (_sp > XB_SPIN_CAP) { atomicAdd(&(bar)[XB_TMO], 1u); break; } } } } while (0)
struct XcdBarrier { unsigned* bar; unsigned x; volatile LAS unsigned* st; };
__device__ __forceinline__ XcdBarrier xcd_barrier_post(unsigned* bar, volatile LAS unsigned* st) {
    XcdBarrier b; b.bar = bar; b.x = xb_xcc_id(); b.st = st;
    if (threadIdx.x == 0) (void)xb_add(&bar[XB_XCNT(b.x)], 1u);
    return b;
}
__device__ __forceinline__ void xcd_barrier_complete(unsigned* bar, unsigned x, unsigned& nloc, unsigned& nx) {
    const unsigned G = gridDim.x * gridDim.y * gridDim.z;
    unsigned sum, cnt, mine, sp = 0u;
    for (;;) {
        sum = 0u; cnt = 0u; mine = 0u;
#pragma unroll
        for (unsigned j = 0; j < 16; ++j) { const unsigned c = xb_ld(&bar[XB_XCNT(j)]); sum += c; cnt += (c > 0u) ? 1u : 0u; mine = (j == x) ? c : mine; }
        if (sum == G) break;
        __builtin_amdgcn_s_sleep(1);
        if ((++sp & 255u) == 0u) { if (xb_ld(&bar[XB_TMO])) break; if (sp > XB_SPIN_CAP) { atomicAdd(&bar[XB_TMO], 1u); break; } }
    }
    nloc = mine > 0u ? mine : 1u; nx = cnt > 0u ? cnt : 1u;
}
__device__ __forceinline__ void xcd_barrier(const XcdBarrier& b) {
    asm volatile("s_waitcnt vmcnt(0)" ::: "memory");
    __syncthreads();
    if (threadIdx.x == 0) {
        unsigned* bar = b.bar;
        __builtin_amdgcn_s_waitcnt(0);
        unsigned nloc = b.st[0], nx = b.st[1];
        if (nloc == 0u) { xcd_barrier_complete(bar, b.x, nloc, nx); b.st[0] = nloc; b.st[1] = nx; }
        const unsigned old = xb_add(&bar[XB_XSUB(b.x)], 1u);
        const unsigned gen = old / nloc;
        if (old + 1u == (gen + 1u) * nloc) {
            __builtin_amdgcn_fence(__ATOMIC_RELEASE, "agent");
            asm volatile("s_waitcnt vmcnt(0)" ::: "memory");
            const unsigned og = xb_add(&bar[XB_TOP], 1u);
            const unsigned tg = og / nx;
            if (og + 1u == (tg + 1u) * nx) xb_add(&bar[XB_TOPGEN], 1u);
            else XB_SPIN(xb_ld(&bar[XB_TOPGEN]) == tg, bar);
            __builtin_amdgcn_fence(__ATOMIC_ACQUIRE, "agent");
            xb_add(&bar[XB_XGEN(b.x)], 1u);
            asm volatile("s_waitcnt vmcnt(0)" ::: "memory");
        } else {
            XB_SPIN(xb_ld(&bar[XB_XGEN(b.x)]) == gen, bar);
            __builtin_amdgcn_fence(__ATOMIC_ACQUIRE, "agent");
            asm volatile("s_waitcnt vmcnt(0)" ::: "memory");
        }
    }
    __syncthreads();
}

struct Args { const float* in[24]; float* out; unsigned char* ws; int ph_lo, ph_hi, sub, pad; };
enum { I_X = 0, I_P, I_WIN, I_RELB, I_WGUP, I_BG, I_GNORM, I_WBA, I_WBB, I_WOUT, I_NMPRE, I_NMPOST, I_NFPRE, I_NFPOST, I_FG, I_FU, I_FD, I_RW, I_MG, I_MU, I_MD, I_PP, I_PG, I_PNORM };
#define FRESH(F) do { int _t = threadIdx.x; asm volatile("" : "+v"(_t)); (F).tid = _t; (F).lane = _t & 63; (F).wave = __builtin_amdgcn_readfirstlane(_t >> 6); } while (0)
struct Frame {
    LAS unsigned char* lds;
    volatile LAS unsigned* MISC;
    gu32* ctl;
    unsigned char* ws;
    int tid, lane, wave;
    int vcu, G;
    float* x;
    bf16_t* xs;
};

__device__ __forceinline__ float sumsq16(const f32x4 (&v)[4]) {
    float s = 0.f;
#pragma unroll
    for (int j = 0; j < 4; ++j) s += (v[j].x * v[j].x + v[j].y * v[j].y) + (v[j].z * v[j].z + v[j].w * v[j].w);
    return wave_sum(s);
}
__device__ __forceinline__ void ld_bf16_row(const bf16_t* row, int lane, f32x4 (&v)[4]) {
#pragma unroll
    for (int j = 0; j < 4; ++j) { const u32x2 w = ((const u32x2*)row)[lane + 64 * j]; v[j] = (f32x4){bf_lo(w.x), bf_hi(w.x), bf_lo(w.y), bf_hi(w.y)}; }
}
__device__ __forceinline__ void st_bf16_row(bf16_t* row, int lane, const f32x4 (&v)[4]) {
#pragma unroll
    for (int j = 0; j < 4; ++j) { u32x2 w; w.x = cvt_pk_bf16(v[j].x, v[j].y); w.y = cvt_pk_bf16(v[j].z, v[j].w); ((u32x2*)row)[lane + 64 * j] = w; }
}
__device__ __forceinline__ void ld_moe_row(const unsigned char* ws, int s, int lane, f32x4 (&v)[4]) {
    if (s < MOE_MAIN_ROWS) { ld_bf16_row((const bf16_t*)(ws + WS_YSLOT) + (size_t)s * D, lane, v); return; }
    const bf16_t* p = (const bf16_t*)(ws + WS_PBUF) + (size_t)(s - MOE_MAIN_ROWS) * D;
#pragma unroll
    for (int j = 0; j < 4; ++j) v[j] = (f32x4){0.f, 0.f, 0.f, 0.f};
#pragma unroll 1
    for (int k0 = 0; k0 < TAIL_KC; k0 += 7) {
        u32x2 w[7][4];
#pragma unroll
        for (int q = 0; q < 7; ++q)
#pragma unroll
            for (int j = 0; j < 4; ++j) w[q][j] = ((const u32x2*)(p + (size_t)(k0 + q) * TAIL_ROWS * D))[lane + 64 * j];
#pragma unroll
        for (int q = 0; q < 7; ++q)
#pragma unroll
            for (int j = 0; j < 4; ++j) v[j] = v[j] + (f32x4){bf_lo(w[q][j].x), bf_hi(w[q][j].x), bf_lo(w[q][j].y), bf_hi(w[q][j].y)};
    }
}
template <int SRC, int OUT, bool ROUTE>
__device__ __forceinline__ void thin_phase(Frame& F, const float* xin, const bf16_t* ysrc, const float* g_add, const float* g_out, bf16_t* obuf, const float* router_w) {
    FRESH(F);
    const int lane = F.lane;
    unsigned* tokinfo = (unsigned*)(F.ws + WS_TOKINFO);
    int* idxe = (int*)(F.ws + WS_IDXE);
    unsigned* gcnt = (unsigned*)(F.ctl + CW_CNT);
    LAS float* rwT = (LAS float*)(F.lds);
    LAS unsigned* lcnt = (LAS unsigned*)(F.lds + 32768);
    LAS unsigned* rinfo = (LAS unsigned*)(F.lds + 32768 + 64);
    if constexpr (ROUTE) {
        for (int i = F.tid; i < D * NE; i += NTHR) rwT[(i & 7) * D + (i >> 3)] = router_w[i];
        if (F.tid < 16) lcnt[F.tid] = 0u;
        __syncthreads();
    }
    int pbase[8];
    if constexpr (SRC == 2) { int acc = 0;
#pragma unroll
        for (int e = 0; e < 8; ++e) { pbase[e] = acc; acc += (((int)gcnt[e] + 255) >> 8) << 8; } }
    f32x4 ga[4], go[4];
#pragma unroll
    for (int j = 0; j < 4; ++j) { ga[j] = (SRC != 0) ? ((const f32x4*)g_add)[lane + 64 * j] : (f32x4){0.f, 0.f, 0.f, 0.f}; go[j] = (OUT == 1) ? ((const f32x4*)g_out)[lane + 64 * j] : (f32x4){0.f, 0.f, 0.f, 0.f}; }
    const int gw = F.vcu * NWAVES + F.wave, NGW = F.G * NWAVES;
    int rs = 0;
    for (int m = gw; m < T; m += NGW, ++rs) {
        f32x4 xv[4];
        if constexpr (SRC == 0) {
#pragma unroll
            for (int j = 0; j < 4; ++j) xv[j] = ((const f32x4*)(xin + (size_t)m * D))[lane + 64 * j];
        } else {
            f32x4 yv[4];
            if constexpr (SRC == 1) ld_bf16_row(ysrc + (size_t)m * D, lane, yv);
            else {
                const unsigned* ti = tokinfo + (size_t)m * 8;
                const int e1 = (int)ti[0], p1 = (int)ti[1], e2 = (int)ti[2], p2 = (int)ti[3]; const float w1 = __uint_as_float(ti[4]), w2 = __uint_as_float(ti[5]);
                int b1 = 0, b2 = 0;
#pragma unroll
                for (int e = 0; e < 8; ++e) { b1 = (e == e1) ? pbase[e] : b1; b2 = (e == e2) ? pbase[e] : b2; }
                f32x4 ya[4], yb[4];
                ld_moe_row(F.ws, b1 + p1, lane, ya); ld_moe_row(F.ws, b2 + p2, lane, yb);
#pragma unroll
                for (int j = 0; j < 4; ++j) yv[j] = ya[j] * w1 + yb[j] * w2;
            }
            const float rstd = __builtin_amdgcn_rsqf(sumsq16(yv) * (1.f / D) + EPS);
            if (xin) {
#pragma unroll
                for (int j = 0; j < 4; ++j) { const f32x4 xo = ((const f32x4*)(xin + (size_t)m * D))[lane + 64 * j]; xv[j] = xo + yv[j] * rstd * ga[j]; }
            } else { f32x4 xo[4]; ld_bf16_row(F.xs + (size_t)m * D, lane, xo);
#pragma unroll
                for (int j = 0; j < 4; ++j) xv[j] = xo[j] + yv[j] * rstd * ga[j]; }
        }
#ifdef SIM_XBF16
        if constexpr (SRC != 0 && OUT != 0) {
#pragma unroll
            for (int j = 0; j < 4; ++j) { const unsigned a = cvt_pk_bf16(xv[j].x, xv[j].y), b = cvt_pk_bf16(xv[j].z, xv[j].w); xv[j] = (f32x4){bf_lo(a), bf_hi(a), bf_lo(b), bf_hi(b)}; } }
#endif
        if constexpr (SRC != 0) {
#pragma unroll
            for (int j = 0; j < 4; ++j) { if constexpr (OUT == 0) ((f32x4*)(F.x + (size_t)m * D))[lane + 64 * j] = xv[j]; }
            if constexpr (OUT != 0) st_bf16_row(F.xs + (size_t)m * D, lane, xv); }
        if constexpr (OUT == 1) {
            const float rstd = __builtin_amdgcn_rsqf(sumsq16(xv) * (1.f / D) + EPS);
            f32x4 hv[4];
#pragma unroll
            for (int j = 0; j < 4; ++j) hv[j] = xv[j] * rstd * go[j];
#ifdef SIM_FFN0
            if (!ROUTE && xin != nullptr) {
#pragma unroll
                for (int j = 0; j < 4; ++j) hv[j] = (f32x4){q8(hv[j].x, 1.f), q8(hv[j].y, 1.f), q8(hv[j].z, 1.f), q8(hv[j].w, 1.f)}; }
#endif
#if MOE_FP8
            if constexpr (ROUTE) {
#pragma unroll
                for (int j = 0; j < 4; ++j) ((unsigned*)((unsigned char*)obuf + (size_t)m * D))[lane + 64 * j] = pk4_fp8(hv[j].x, hv[j].y, hv[j].z, hv[j].w);
            } else
#elif defined(SIM_FP8)
            if constexpr (ROUTE) { f32x4 hq[4];
#pragma unroll
                for (int j = 0; j < 4; ++j) hq[j] = (f32x4){q8(hv[j].x, 1.f), q8(hv[j].y, 1.f), q8(hv[j].z, 1.f), q8(hv[j].w, 1.f)};
                st_bf16_row(obuf + (size_t)m * D, lane, hq); } else
#endif

            st_bf16_row(obuf + (size_t)m * D, lane, hv);
            if constexpr (ROUTE) {
                float lg[8];
#pragma unroll
                for (int e = 0; e < 8; ++e) { float s = 0.f;
#pragma unroll
                    for (int j = 0; j < 4; ++j) { const f32x4 w = *(const LAS f32x4*)(rwT + e * D + 4 * lane + 256 * j); s += (hv[j].x * w.x + hv[j].y * w.y) + (hv[j].z * w.z + hv[j].w * w.w); }
                    lg[e] = wave_sum(s); }
                int e1 = 0; float v1 = lg[0];
#pragma unroll
                for (int e = 1; e < 8; ++e) if (lg[e] > v1) { v1 = lg[e]; e1 = e; }
                int e2 = -1; float v2 = -3.0e38f;
#pragma unroll
                for (int e = 0; e < 8; ++e) if (e != e1 && lg[e] > v2) { v2 = lg[e]; e2 = e; }
                const float ex = __expf(v2 - v1), w1 = 1.f / (1.f + ex), w2 = ex * w1;
                if (lane == 0) {
                    const unsigned p1 = atomicAdd((unsigned*)&lcnt[e1], 1u), p2 = atomicAdd((unsigned*)&lcnt[e2], 1u);
                    LAS unsigned* ri = rinfo + (F.wave * 8 + rs) * 6;
                    ri[0] = (unsigned)e1; ri[1] = p1; ri[2] = (unsigned)e2; ri[3] = p2; ri[4] = __float_as_uint(w1); ri[5] = __float_as_uint(w2);
                }
            }
        }
    }
    if constexpr (ROUTE) {
        __syncthreads();
        if (F.tid < 8) lcnt[8 + F.tid] = __hip_atomic_fetch_add(gcnt + F.tid, lcnt[F.tid], RLX_AGENT);
        __syncthreads();
        if (lane < rs) {
            const int m = gw + lane * NGW; const LAS unsigned* ri = rinfo + (F.wave * 8 + lane) * 6;
            const unsigned e1 = ri[0], e2 = ri[2]; const unsigned p1 = ri[1] + lcnt[8 + e1], p2 = ri[3] + lcnt[8 + e2];
            unsigned* ti = tokinfo + (size_t)m * 8; ti[0] = e1; ti[1] = p1; ti[2] = e2; ti[3] = p2; ti[4] = ri[4]; ti[5] = ri[5];
            idxe[e1 * 16384 + p1] = m; idxe[e2 * 16384 + p2] = m;
        }
    }
}
#if defined(SIM_FP8) || defined(SIM_FFN0)
#define SIMQ(x, s) (((s) != 0.f) ? q8((x), (s)) : (x))
#else
#define SIMQ(x, s) (x)
#endif
struct TrItem { const float* src; int pitch; bf16_t* dst; int dstK; int ncols; float qs; int f8; };
#define TR_LOAD(t, v) do { _Pragma("unroll") for (int i = 0; i < 64; ++i) { const int kk = 2 * i + (lane >> 5); v[i] = ((lane & 31) < (t).ncols) ? (t).src[(size_t)kk * (t).pitch + (lane & 31)] : 0.f; } } while (0)
__device__ __forceinline__ void tr_finish(const TrItem& t, float (&v)[64], LAS float* scr, int lane) {
    const int c = lane & 31;
#pragma unroll
    for (int p = 0; p < 2; ++p) {
#pragma unroll
        for (int i = 0; i < 32; ++i) { const int kk = 2 * i + (lane >> 5); scr[kk * 33 + c] = SIMQ(v[32 * p + i], t.qs); }
        LDS_WAIT(); asm volatile("" ::: "memory");
        if (t.f8) {
            const int c4 = lane & 3;
#pragma unroll
            for (int j = 0; j < 2; ++j) { const int n = (lane >> 2) + 16 * j; const LAS float* s = scr + (16 * c4) * 33 + n;
                u32x4 o; o.x = pk4_fp8(s[0 * 33] * W8_SCALE, s[1 * 33] * W8_SCALE, s[2 * 33] * W8_SCALE, s[3 * 33] * W8_SCALE); o.y = pk4_fp8(s[4 * 33] * W8_SCALE, s[5 * 33] * W8_SCALE, s[6 * 33] * W8_SCALE, s[7 * 33] * W8_SCALE);
                o.z = pk4_fp8(s[8 * 33] * W8_SCALE, s[9 * 33] * W8_SCALE, s[10 * 33] * W8_SCALE, s[11 * 33] * W8_SCALE); o.w = pk4_fp8(s[12 * 33] * W8_SCALE, s[13 * 33] * W8_SCALE, s[14 * 33] * W8_SCALE, s[15 * 33] * W8_SCALE);
                *(u32x4*)((unsigned char*)t.dst + (size_t)n * t.dstK + 64 * p + 16 * c4) = o; }
        } else {
            const int c8 = lane & 7;
#pragma unroll
            for (int j = 0; j < 4; ++j) { const int n = (lane >> 3) + 8 * j; const LAS float* s = scr + (8 * c8) * 33 + n;
                u32x4 o; o.x = cvt_pk_bf16(s[0 * 33], s[1 * 33]); o.y = cvt_pk_bf16(s[2 * 33], s[3 * 33]); o.z = cvt_pk_bf16(s[4 * 33], s[5 * 33]); o.w = cvt_pk_bf16(s[6 * 33], s[7 * 33]);
                if (n < t.ncols) *(u32x4*)(t.dst + (size_t)n * t.dstK + 64 * p + 8 * c8) = o; }
        }
        LDS_WAIT(); asm volatile("" ::: "memory");
    }
}
constexpr int IT_COMMON = 640 + 640 + 8 + 128 + 128 + 256 + 64 + 256;
constexpr int IT_FFN = 3 * 704, IT_MOE1 = 8 * 896;
constexpr int IT_TOTAL = 2 * IT_COMMON + IT_FFN + 3 * IT_MOE1;
__device__ __forceinline__ TrItem seg_plain(const float* src, int K, int N, int pitch, bf16_t* dst, int r) {
    const int nkb = K / 128, nb = r / nkb, kb = r % nkb;
    return TrItem{src + (size_t)kb * 128 * pitch + nb * 32, pitch, dst + (size_t)(nb * 32) * K + kb * 128, K, 32, 0.f, 0};
}
__device__ __forceinline__ TrItem seg_gu(const float* src, int N, bf16_t* dst, int up, int r) {
    const int nb = r / (D / 128), kb = r % (D / 128), n0 = nb * 32;
    return TrItem{src + (size_t)kb * 128 * N + n0, N, dst + (size_t)((n0 >> 7) * 256 + (n0 & 127) + up * 128) * D + kb * 128, D, 32, 0.f, 0};
}
__device__ __forceinline__ TrItem decode_item(const Args& a, unsigned char* ws, int it) {
    if (it < 2 * IT_COMMON) {
        const int l = it / IT_COMMON; int r = it % IT_COMMON; unsigned char* wb = ws + (l ? WS_W1 : WS_W0);
        const float* win = a.in[I_WIN] + (size_t)l * D * INW;
        if (r < 640) return seg_plain(win, D, 2560, INW, (bf16_t*)(wb + OFF_WIN), r); r -= 640;
        if (r < 640) return seg_plain(win + 2576, D, 2560, INW, (bf16_t*)(wb + OFF_WIN) + (size_t)2560 * D, r); r -= 640;
        if (r < 8) return TrItem{win + (size_t)r * 128 * INW + 2560, INW, (bf16_t*)(wb + OFF_WGD) + r * 128, D, 16, 0.f, 0}; r -= 8;
        if (r < 128) return seg_plain(a.in[I_WBA] + (size_t)l * 512 * D, 512, D, D, (bf16_t*)(wb + OFF_WBA), r); r -= 128;
        if (r < 128) return seg_plain(a.in[I_WBB] + (size_t)l * 512 * D, 512, D, D, (bf16_t*)(wb + OFF_WBB), r); r -= 128;
        if (r < 256) return seg_plain(a.in[I_WOUT] + (size_t)l * D * D, D, D, D, (bf16_t*)(wb + OFF_WOUT), r); r -= 256;
        if (r < 64) return seg_plain(a.in[I_PP] + (size_t)l * PLE * D, PLE, D, D, (bf16_t*)(wb + OFF_WPP), r); r -= 64;
        return seg_plain(a.in[I_PG] + (size_t)l * D * D, D, D, D, (bf16_t*)(wb + OFF_WPG), r);
    }
    it -= 2 * IT_COMMON;
    if (it < IT_FFN) {
        unsigned char* wb = ws + WS_W0;
        TrItem t;
        if (it < 704) t = seg_gu(a.in[I_FG], DFF, (bf16_t*)(wb + OFF_FFN), 0, it);
        else if (it < 1408) t = seg_gu(a.in[I_FU], DFF, (bf16_t*)(wb + OFF_FFN), 1, it - 704);
        else t = seg_plain(a.in[I_FD], DFF, D, D, (bf16_t*)(wb + OFF_FDN), it - 1408);
#ifdef SIM_FFN0
        t.qs = 64.f;
#endif
        return t;
    }
    it -= IT_FFN;
    unsigned char* wb = ws + WS_W1;
    const int kind = it / IT_MOE1, r0 = it % IT_MOE1, e = r0 / 896, r = r0 % 896;
    TrItem t;
#if MOE_FP8
    { const int nkb8 = (kind == 2 ? DFE : D) / 128, nb8 = r / nkb8, kb8 = r % nkb8, n0 = nb8 * 32;
      if (kind == 2) return TrItem{a.in[I_MD] + (size_t)e * DFE * D + (size_t)kb8 * 128 * D + n0, D, (bf16_t*)(wb + OFF_MDN8 + (size_t)e * D * DFE + (size_t)n0 * DFE + kb8 * 128), DFE, 32, 0.f, 1};
      const float* src = (kind == 0 ? a.in[I_MG] : a.in[I_MU]) + (size_t)e * D * DFE + (size_t)kb8 * 128 * DFE + n0;
      return TrItem{src, DFE, (bf16_t*)(wb + OFF_FFN + (size_t)e * 7168 * D + (size_t)((n0 >> 7) * 256 + (n0 & 127) + (kind == 1 ? 128 : 0)) * D + kb8 * 128), D, 32, 0.f, 1}; }
#endif
    if (kind == 0) t = seg_gu(a.in[I_MG] + (size_t)e * D * DFE, DFE, (bf16_t*)(wb + OFF_FFN) + (size_t)e * 7168 * D, 0, r);
    else if (kind == 1) t = seg_gu(a.in[I_MU] + (size_t)e * D * DFE, DFE, (bf16_t*)(wb + OFF_FFN) + (size_t)e * 7168 * D, 1, r);
    else t = seg_plain(a.in[I_MD] + (size_t)e * DFE * D, DFE, D, D, (bf16_t*)(wb + OFF_MDN) + (size_t)e * D * DFE, r);
#ifdef SIM_FP8
    t.qs = 64.f;
#endif
    return t;
}
__device__ __forceinline__ void p0_prologue(Frame& F, const Args& a) {
    FRESH(F);
    LAS float* scr = (LAS float*)(F.lds + F.wave * 16384);
    const int gw = F.vcu * NWAVES + F.wave, NGW = F.G * NWAVES;
    { const int lane = F.lane;
      for (int it = gw; it < IT_TOTAL; it += NGW) { const TrItem t = decode_item(a, F.ws, it); float v[64]; TR_LOAD(t, v); tr_finish(t, v, scr, lane); } }
    { const f32x4* ps = (const f32x4*)a.in[I_P]; u32x4* pd = (u32x4*)(F.ws + WS_PB); const int n8 = 2 * T * PLE / 8;
      for (int i = blockIdx.x * NTHR + F.tid; i < n8; i += F.G * NTHR) { const f32x4 v0 = ps[2 * i], v1 = ps[2 * i + 1];
          u32x4 w; w.x = cvt_pk_bf16(v0.x, v0.y); w.y = cvt_pk_bf16(v0.z, v0.w); w.z = cvt_pk_bf16(v1.x, v1.y); w.w = cvt_pk_bf16(v1.z, v1.w); pd[i] = w; } }
    thin_phase<0, 1, false>(F, a.in[I_X], nullptr, nullptr, a.in[I_NMPRE], (bf16_t*)(F.ws + WS_HB), nullptr);
}
typedef short v4i16_t __attribute__((ext_vector_type(4)));
__device__ __forceinline__ s16x4 lds_tr16(const LAS unsigned char* p) { return __builtin_bit_cast(s16x4, __builtin_amdgcn_ds_read_tr16_b64_v4i16((LAS v4i16_t*)p)); }
__device__ __forceinline__ bf16x8 cat8(s16x4 a, s16x4 b) { return (bf16x8){a[0], a[1], a[2], a[3], b[0], b[1], b[2], b[3]}; }

__device__ __forceinline__ void attn_unit(Frame& F, int b, int c, const float* relb) {
    FRESH(F);
    const int lane = F.lane, h = F.wave, n = lane & 15, mq = lane >> 4;
    const bf16_t* qa = (const bf16_t*)(F.ws + WS_QA); const bf16_t* ka = (const bf16_t*)(F.ws + WS_KA); const bf16_t* va = (const bf16_t*)(F.ws + WS_VA);
    LAS unsigned char* kbuf = F.lds + h * 16384; LAS unsigned char* vbuf = kbuf + 8192;
    LAS float* rt = (LAS float*)(F.lds + XTRA_OFF + h * 1056);
    for (int i = lane; i < 256; i += 64) { const int j = i - 64; rt[i] = relb[h * RELN + 256 - (j > 0 ? j : 0)] * LOG2E; }
    const float bfar = relb[h * RELN + 256] * LOG2E;
    const int tok0 = b * SEQ + c * CH;
    bf16x8 qf[4][2];
#pragma unroll
    for (int qt = 0; qt < 4; ++qt)
#pragma unroll
        for (int ks = 0; ks < 2; ++ks) qf[qt][ks] = *(const bf16x8*)(qa + (size_t)(tok0 + 16 * qt + n) * 512 + h * 64 + 32 * ks + 8 * mq);
    const int koff_e = (lane >> 3) * 512 + (((lane & 7) ^ ((lane >> 4) & 7)) * 8), koff_o = (lane >> 3) * 512 + (((lane & 7) ^ ((4 + (lane >> 4)) & 7)) * 8);
    const int voff = (lane >> 3) * 512 + ((2 * (((lane & 7) >> 1) ^ (lane >> 4)) + (lane & 1)) * 8);
#define ATT_DMA_K(j) do { const bf16_t* _s = ka + (size_t)(b * SEQ + (j) * CH) * 512 + h * 64; _Pragma("unroll") for (int _i = 0; _i < 8; ++_i) \
        __builtin_amdgcn_global_load_lds((const unsigned*)(_s + (size_t)_i * 8 * 512 + ((_i & 1) ? koff_o : koff_e)), (LAS unsigned*)(kbuf + _i * 1024), 16, 0, 0); } while (0)
#define ATT_DMA_V(j) do { const bf16_t* _s = va + (size_t)(b * SEQ + (j) * CH) * 512 + h * 64; _Pragma("unroll") for (int _i = 0; _i < 8; ++_i) \
        __builtin_amdgcn_global_load_lds((const unsigned*)(_s + (size_t)_i * 8 * 512 + voff), (LAS unsigned*)(vbuf + _i * 1024), 16, 0, 0); } while (0)
    const int ka0 = n * 128 + (((0 + mq) ^ (n >> 1)) * 16), ka1 = n * 128 + (((4 + mq) ^ (n >> 1)) * 16);
    const int qp = n >> 2, pp = lane & 3, sw = 2 * (mq & 1) + (qp >> 1);
    const int vrow = (4 * mq + qp) * 128 + 8 * pp;
    f32x4 O[4][4]; float mrun[4], lsum[4];
#pragma unroll
    for (int qt = 0; qt < 4; ++qt) { mrun[qt] = -1.0e30f; lsum[qt] = 0.f;
#pragma unroll
        for (int dt = 0; dt < 4; ++dt) O[qt][dt] = (f32x4){0.f, 0.f, 0.f, 0.f}; }
    const int j0 = (c - NPREV) > 0 ? (c - NPREV) : 0;
    ATT_DMA_K(j0); ATT_DMA_V(j0);
    for (int j = j0; j <= c; ++j) {
        const int dc = c - j;
        asm volatile("s_waitcnt vmcnt(8)" ::: "memory");
#pragma unroll
        for (int qg = 0; qg < 2; ++qg) {
            f32x4 S[4][2];
#pragma unroll
            for (int kt = 0; kt < 4; ++kt) {
                const bf16x8 k0 = *(const LAS bf16x8*)(kbuf + kt * 2048 + ka0), k1 = *(const LAS bf16x8*)(kbuf + kt * 2048 + ka1);
#pragma unroll
                for (int q2 = 0; q2 < 2; ++q2) { f32x4 z = (f32x4){0.f, 0.f, 0.f, 0.f};
                    z = __builtin_amdgcn_mfma_f32_16x16x32_bf16(k0, qf[2 * qg + q2][0], z, 0, 0, 0);
                    S[kt][q2] = __builtin_amdgcn_mfma_f32_16x16x32_bf16(k1, qf[2 * qg + q2][1], z, 0, 0, 0); }
            }
            if (qg == 1) { if (j < c) { LDS_WAIT(); ATT_DMA_K(j + 1); } }
            bf16x8 P[2][2];
#pragma unroll
            for (int q2 = 0; q2 < 2; ++q2) { const int qt = 2 * qg + q2;
                if (dc >= 3) {
                    asm volatile("" ::: "memory");
#pragma unroll
                    for (int kt = 0; kt < 4; ++kt) S[kt][q2] = S[kt][q2] + bfar;
                } else {
                    asm volatile("" ::: "memory");
                    const LAS float* rp = rt + (64 + 128 - (64 * dc + 16 * qt + n - 4 * mq));
                    float bv[4][4];
#pragma unroll
                    for (int kt = 0; kt < 4; ++kt)
#pragma unroll
                        for (int i = 0; i < 4; ++i) bv[kt][i] = rp[16 * kt + i];
#pragma unroll
                    for (int kt = 0; kt < 4; ++kt)
#pragma unroll
                        for (int i = 0; i < 4; ++i) S[kt][q2][i] += bv[kt][i];
                }
                float cm = S[0][q2][0];
#pragma unroll
                for (int kt = 0; kt < 4; ++kt)
#pragma unroll
                    for (int i = 0; i < 4; ++i) cm = fmaxf(cm, S[kt][q2][i]);
                cm = fmaxf(cm, __shfl_xor(cm, 16)); cm = fmaxf(cm, __shfl_xor(cm, 32));
                const float mn = fmaxf(mrun[qt], cm), alpha = __builtin_amdgcn_exp2f(mrun[qt] - mn); mrun[qt] = mn;
                float ps = 0.f;
#pragma unroll
                for (int kt = 0; kt < 4; ++kt)
#pragma unroll
                    for (int i = 0; i < 4; ++i) { const float p = __builtin_amdgcn_exp2f(S[kt][q2][i] - mn); S[kt][q2][i] = p; ps += p; }
                lsum[qt] = lsum[qt] * alpha + ps;
#pragma unroll
                for (int dt = 0; dt < 4; ++dt) O[qt][dt] = O[qt][dt] * alpha;
#pragma unroll
                for (int u = 0; u < 2; ++u) { u32x4 w; w.x = cvt_pk_bf16(S[2 * u][q2][0], S[2 * u][q2][1]); w.y = cvt_pk_bf16(S[2 * u][q2][2], S[2 * u][q2][3]);
                    w.z = cvt_pk_bf16(S[2 * u + 1][q2][0], S[2 * u + 1][q2][1]); w.w = cvt_pk_bf16(S[2 * u + 1][q2][2], S[2 * u + 1][q2][3]); P[q2][u] = __builtin_bit_cast(bf16x8, w); }
            }
            if (qg == 0) asm volatile("s_waitcnt vmcnt(0)" ::: "memory");
#pragma unroll
            for (int dt = 0; dt < 4; ++dt)
#pragma unroll
                for (int u = 0; u < 2; ++u) {
                    const LAS unsigned char* vp = vbuf + vrow + (32 * u) * 128 + ((dt ^ sw) * 32);
                    const bf16x8 vf = cat8(lds_tr16(vp), lds_tr16(vp + 16 * 128));
#pragma unroll
                    for (int q2 = 0; q2 < 2; ++q2) O[2 * qg + q2][dt] = __builtin_amdgcn_mfma_f32_16x16x32_bf16(vf, P[q2][u], O[2 * qg + q2][dt], 0, 0, 0);
                }
            if (qg == 1) { if (j < c) { LDS_WAIT(); ATT_DMA_V(j + 1); } }
        }
    }
#undef ATT_DMA_K
#undef ATT_DMA_V
    bf16_t* ya = (bf16_t*)(F.ws + WS_YA);
#pragma unroll
    for (int qt = 0; qt < 4; ++qt) { float l = lsum[qt]; l += __shfl_xor(l, 16); l += __shfl_xor(l, 32); const float rl = __builtin_amdgcn_rcpf(l);
#pragma unroll
        for (int dt = 0; dt < 4; ++dt) { const f32x4 o = O[qt][dt] * rl; u32x2 w; w.x = cvt_pk_bf16(o[0], o[1]); w.y = cvt_pk_bf16(o[2], o[3]);
            *(u32x2*)(ya + (size_t)(tok0 + 16 * qt + n) * 512 + h * 64 + 16 * dt + 4 * mq) = w; } }
}

__device__ __forceinline__ void gla_dstate_unit(Frame& F, int b, int c, const bf16_t* wgd_t, const float* wup, const float* bgate) {
    FRESH(F);
    const int lane = F.lane, w = F.wave, tid = F.tid, n = lane & 15, mq = lane >> 4;
    const int tok0 = b * SEQ + c * CH;
    const bf16_t* hb = (const bf16_t*)(F.ws + WS_HB); const bf16_t* kb = (const bf16_t*)(F.ws + WS_KB); const bf16_t* vb = (const bf16_t*)(F.ws + WS_VB);
    LAS float* GD8 = (LAS float*)(F.lds); LAS unsigned char* VB = F.lds + 32768; LAS unsigned char* KD = F.lds + 98304;
    LAS float* GDF = (LAS float*)(F.lds + XTRA_OFF); LAS float* TOT = (LAS float*)(F.lds + XTRA_OFF + 4096);
    __syncthreads();
    const int col = tid & 255, hf = tid >> 8;
    float wu[16];
#pragma unroll
    for (int r = 0; r < 16; ++r) wu[r] = wup[r * 256 + col];
    const float bb = bgate[col];
    unsigned short kraw[32];
#pragma unroll
    for (int l = 0; l < 32; ++l) kraw[l] = kb[(size_t)(tok0 + 32 * hf + l) * 256 + col];
#pragma unroll
    for (int i = 0; i < 8; ++i) { const int p = (w * 8 + i) * 64 + lane, row = p >> 6, ch = p & 63;
        __builtin_amdgcn_global_load_lds((const unsigned*)(vb + (size_t)(tok0 + row) * 512 + ch * 8), (LAS unsigned*)(VB + (w * 8 + i) * 1024), 16, 0, 0); }
    { bf16x8 af[4][4], bf[4];
#pragma unroll
      for (int ks = 0; ks < 4; ++ks) { bf[ks] = *(const bf16x8*)(wgd_t + (size_t)n * D + 128 * w + 32 * ks + 8 * mq);
#pragma unroll
          for (int mt = 0; mt < 4; ++mt) af[mt][ks] = *(const bf16x8*)(hb + (size_t)(tok0 + 16 * mt + n) * D + 128 * w + 32 * ks + 8 * mq); }
#pragma unroll
      for (int mt = 0; mt < 4; ++mt) { f32x4 acc = (f32x4){0.f, 0.f, 0.f, 0.f};
#pragma unroll
          for (int ks = 0; ks < 4; ++ks) acc = __builtin_amdgcn_mfma_f32_16x16x32_bf16(af[mt][ks], bf[ks], acc, 0, 0, 0);
#pragma unroll
          for (int i = 0; i < 4; ++i) GD8[(w * 64 + 16 * mt + 4 * mq + i) * 16 + n] = acc[i]; } }
    __syncthreads();
    { const f32x2 z2 = (f32x2){0.f, 0.f}; f32x2 sacc = z2;
#pragma unroll
      for (int q = 0; q < 8; ++q) sacc = sacc + *(const LAS f32x2*)(GD8 + q * 1024 + 2 * tid);
      *(LAS f32x2*)(GDF + 2 * tid) = sacc; }
    __syncthreads();
    { float cum[32]; float run = 0.f;
#pragma unroll
      for (int l = 0; l < 32; ++l) { const int row = 32 * hf + l; float z = bb;
#pragma unroll
          for (int r4 = 0; r4 < 4; ++r4) { const f32x4 a = *(const LAS f32x4*)(GDF + row * 16 + 4 * r4);
              z += a.x * wu[4 * r4] + a.y * wu[4 * r4 + 1] + a.z * wu[4 * r4 + 2] + a.w * wu[4 * r4 + 3]; }
          const float la = (fminf(z, 0.f) - __logf(1.f + __expf(-fabsf(z)))) * (1.f / 16.f);
          run += la; cum[l] = run; }
      LAS float* TOT1 = TOT + 256;
      if (hf == 0) TOT[col] = run;
      __syncthreads();
      const float tot = (hf == 1) ? TOT[col] : 0.f;
      if (hf == 1) TOT1[col] = run + tot;
      __syncthreads();
      const float ctot = TOT1[col];
      if (hf == 1) ((float*)(F.ws + WS_DEC))[(size_t)(b * NCH + c) * 256 + col] = __expf(ctot);
      unsigned pk[16];
#pragma unroll
      for (int l = 0; l < 32; l += 2) { const float k0 = bf2f(kraw[l]), k1 = bf2f(kraw[l + 1]);
          pk[l >> 1] = cvt_pk_bf16(k0 * __expf(ctot - (cum[l] + tot)), k1 * __expf(ctot - (cum[l + 1] + tot))); }
#pragma unroll
      for (int q = 0; q < 4; ++q) *(LAS u32x4*)(KD + col * 128 + hf * 64 + q * 16) = (u32x4){pk[4 * q], pk[4 * q + 1], pk[4 * q + 2], pk[4 * q + 3]}; }
    VM_WAIT();
    __syncthreads();
    { const int hh = w >> 1, vh = w & 1, qp = n >> 2, pp = lane & 3;
      f32x4 acc[4][4];
#pragma unroll
      for (int mt = 0; mt < 4; ++mt)
#pragma unroll
          for (int nt = 0; nt < 4; ++nt) acc[mt][nt] = (f32x4){0.f, 0.f, 0.f, 0.f};
#pragma unroll
      for (int ks = 0; ks < 2; ++ks) {
          bf16x8 af[4];
#pragma unroll
          for (int mt = 0; mt < 4; ++mt) af[mt] = *(const LAS bf16x8*)(KD + (hh * 64 + 16 * mt + n) * 128 + (32 * ks + 8 * mq) * 2);
#pragma unroll
          for (int nt = 0; nt < 4; ++nt) {
              const LAS unsigned char* vp = VB + (size_t)(32 * ks + 8 * mq + qp) * 1024 + (hh * 128 + vh * 64 + 16 * nt + 4 * pp) * 2;
              const bf16x8 bfr = cat8(lds_tr16(vp), lds_tr16(vp + 4 * 1024));
#pragma unroll
              for (int mt = 0; mt < 4; ++mt) acc[mt][nt] = __builtin_amdgcn_mfma_f32_16x16x32_bf16(af[mt], bfr, acc[mt][nt], 0, 0, 0);
          }
      }
      float* dst = (float*)(F.ws + WS_DST) + ((size_t)((b * NCH + c) * BH + hh) * 128) * 64;
#pragma unroll
      for (int mt = 0; mt < 4; ++mt)
#pragma unroll
          for (int nt = 0; nt < 4; ++nt) *(f32x4*)(dst + (size_t)(vh * 64 + 16 * nt + n) * 64 + 16 * mt + 4 * mq) = acc[mt][nt]; }
    __syncthreads();
}

__device__ __forceinline__ void gla_scan_phase(Frame& F) {
    FRESH(F);
    const float* ds = (const float*)(F.ws + WS_DST); const float* dec = (const float*)(F.ws + WS_DEC); bf16_t* st = (bf16_t*)(F.ws + WS_ST);
    for (int e2 = blockIdx.x * NTHR + F.tid; e2 < NB * BH * 128 * 32; e2 += F.G * NTHR) {
        const int k2 = e2 & 31, v = (e2 >> 5) & 127, hh = (e2 >> 12) & 3, b = e2 >> 14;
        f32x2 s = (f32x2){0.f, 0.f};
#pragma unroll 8
        for (int c = 0; c < NCH; ++c) {
            const size_t off = ((size_t)((b * NCH + c) * BH + hh) * 128 + v) * 64 + 2 * k2;
            const f32x2 d = *(const f32x2*)(ds + off); const f32x2 a = *(const f32x2*)(dec + (size_t)(b * NCH + c) * 256 + hh * 64 + 2 * k2);
            s = a * s + d;
            *(unsigned*)(st + off) = cvt_pk_bf16(s.x, s.y);
        }
    }
}

__device__ __forceinline__ void gla_out_unit(Frame& F, int b, int c, const float* gnorm) {
    FRESH(F);
    const int lane = F.lane, w = F.wave, n = lane & 15, mq = lane >> 4;
    const int hh = w >> 1, th = w & 1, tok0 = b * SEQ + c * CH + 32 * th;
    const bf16_t* qb = (const bf16_t*)(F.ws + WS_QB); const bf16_t* st = (const bf16_t*)(F.ws + WS_ST) + ((size_t)((b * NCH + c) * BH + hh) * 128) * 64;
    const bf16_t* sr = (const bf16_t*)(F.ws + WS_SR); bf16_t* yb = (bf16_t*)(F.ws + WS_YB);
    bf16x8 qf[2][2];
#pragma unroll
    for (int nt = 0; nt < 2; ++nt)
#pragma unroll
        for (int ks = 0; ks < 2; ++ks) qf[nt][ks] = *(const bf16x8*)(qb + (size_t)(tok0 + 16 * nt + n) * 256 + hh * 64 + 32 * ks + 8 * mq);
    f32x4 acc[8][2];
#pragma unroll
    for (int mt = 0; mt < 8; ++mt) {
        const bf16x8 a0 = *(const bf16x8*)(st + (size_t)(16 * mt + n) * 64 + 8 * mq), a1 = *(const bf16x8*)(st + (size_t)(16 * mt + n) * 64 + 32 + 8 * mq);
#pragma unroll
        for (int nt = 0; nt < 2; ++nt) { f32x4 z = (f32x4){0.f, 0.f, 0.f, 0.f};
            z = __builtin_amdgcn_mfma_f32_16x16x32_bf16(a0, qf[nt][0], z, 0, 0, 0);
            acc[mt][nt] = __builtin_amdgcn_mfma_f32_16x16x32_bf16(a1, qf[nt][1], z, 0, 0, 0); }
    }
#pragma unroll
    for (int nt = 0; nt < 2; ++nt) { float ss = 0.f;
#pragma unroll
        for (int mt = 0; mt < 8; ++mt) ss += (acc[mt][nt][0] * acc[mt][nt][0] + acc[mt][nt][1] * acc[mt][nt][1]) + (acc[mt][nt][2] * acc[mt][nt][2] + acc[mt][nt][3] * acc[mt][nt][3]);
        ss += __shfl_xor(ss, 16); ss += __shfl_xor(ss, 32);
        const float rstd = __builtin_amdgcn_rsqf(ss * (1.f / 128.f) + EPS);
#pragma unroll
        for (int mt = 0; mt < 8; ++mt) { const int col = hh * 128 + 16 * mt + 4 * mq; const f32x4 gn = *(const f32x4*)(gnorm + col);
            const size_t po = (size_t)(tok0 + 16 * nt + n) * 512 + col; const u32x2 rw = *(const u32x2*)(sr + po);
            const f32x4 o = acc[mt][nt] * rstd * gn; u32x2 wv; wv.x = cvt_pk_bf16(o[0] * bf_lo(rw.x), o[1] * bf_hi(rw.x)); wv.y = cvt_pk_bf16(o[2] * bf_lo(rw.y), o[3] * bf_hi(rw.y));
            *(u32x2*)(yb + po) = wv; } }
}
#ifndef PLE_MODE1
#define PLE_MODE1 3
#endif
#ifdef SIM_FP8
constexpr float MOE_ACT_QS = 8.f;
#else
constexpr float MOE_ACT_QS = 0.f;
#endif
#ifdef SIM_FFN0
constexpr float FFN0_ACT_QS = 8.f;
#else
constexpr float FFN0_ACT_QS = 0.f;
#endif
constexpr int N_PHASES = 25;
__global__ void __launch_bounds__(NTHR, 2) fwd(Args args) {
    extern __shared__ __attribute__((aligned(16))) unsigned char lds[];
    Frame F;
    F.lds = (LAS unsigned char*)lds;
    F.MISC = (volatile LAS unsigned*)(F.lds + MISC_OFF);
    F.tid = threadIdx.x; F.lane = F.tid & 63; F.wave = __builtin_amdgcn_readfirstlane(F.tid >> 6);
    F.G = gridDim.x; { const int bx = blockIdx.x; F.vcu = (F.G % 8 == 0) ? (bx % 8) * (F.G / 8) + bx / 8 : bx; }
    F.ws = args.ws; F.ctl = (gu32*)(args.ws + WS_CTL); F.x = args.out; F.xs = (bf16_t*)(args.ws + WS_XS);
    unsigned char* ws = args.ws;
    for (int u = F.tid; u < (LDS_BYTES - LDSCTL_OFF) / 4; u += NTHR) ((LAS unsigned*)(F.lds + LDSCTL_OFF))[u] = 0u;
    __syncthreads();
    XcdBarrier bar = xcd_barrier_post((unsigned*)(F.ctl + CW_BAR), F.MISC + 8);
    const WT wt = make_wt(ws, (unsigned)WS_END);
    const int lo = args.ph_lo, hi = args.ph_hi;
#define PH_BEGIN const __attribute__((address_space(4))) Args* _ap = (const __attribute__((address_space(4))) Args*)__builtin_amdgcn_kernarg_segment_ptr(); asm volatile("" : "+s"(_ap)); const __attribute__((address_space(4))) Args& A = *_ap; unsigned char* ws = A.ws; \
    unsigned char* wb = ws + (l ? WS_W1 : WS_W0); bf16_t* hb = (bf16_t*)(ws + WS_HB); bf16_t* Y = (bf16_t*)(ws + WS_Y); const WT wt = make_wt(ws, (unsigned)WS_END); (void)wb; (void)hb; (void)Y; (void)wt; (void)A
#ifndef PHMASK
#define PHMASK 0x1fff
#endif
#define EN(i) (((PHMASK) >> (i)) & 1)
#ifndef REPMASK
#define REPMASK 0
#endif
#ifndef REPLAYER
#define REPLAYER 2
#endif
#define ZEROG ((const float*)(ws + WS_CTL + 131072))
#ifndef ZSKIP
#define ZSKIP 0
#endif
#define REPS(i) (((((REPMASK) >> (i)) & 1) && (REPLAYER == 2 || REPLAYER == l)) ? 2 : 1)
#define IN(k) (lo <= (k) && (k) < hi)
#ifndef SEAMREP
#define SEAMREP 1
#endif
#ifndef MK_STAMP
#define MK_STAMP 0
#endif
#ifndef STAMP_SEL
#define STAMP_SEL -1
#endif
#define SEAM(k) do { if (MK_STAMP && IN(k) && F.tid == 0) ((unsigned long long*)(ws + WS_CTL + 786432))[(k) * 256 + blockIdx.x] = __builtin_amdgcn_s_memrealtime(); \
    if (IN(k) && IN((k) + 1)) for (int _r = 0; _r < SEAMREP; ++_r) xcd_barrier(bar); } while (0)

    { const int l = 0; if (EN(12) && IN(0)) for (int rep = 0; rep < REPS(12); ++rep) { p0_prologue(F, args); } }
    SEAM(0);
#ifndef LAYERREP
#define LAYERREP 0
#endif
    for (int l2 = 0; l2 < DEPTH + LAYERREP; ++l2) {
        const int l = (l2 < LAYERREP) ? 0 : l2 - LAYERREP; const bool zpass = (l2 < LAYERREP);
        const int pb = 1 + 12 * l;
        if (EN(0) && IN(pb + 0) && !(zpass && ((ZSKIP >> 0) & 1))) for (int rep = 0; rep < REPS(0); ++rep) { PH_BEGIN;
            pg8::Gemm g{hb, (const bf16_t*)(wb + OFF_WIN), D, 0, nullptr}; pg8::StaticOrder S; S.init(T, INWG, F.G, (int)blockIdx.x);
            pg8::EpiInProj E{(bf16_t*)(ws + WS_PROJ), wt};
            pg8::gemm_phase<pg8::EpiInProj, pg8::StaticOrder, false>(F.lds, g, S, E);
        }
        SEAM(pb + 0);
        if (EN(1) && IN(pb + 1) && !(zpass && ((ZSKIP >> 1) & 1))) for (int rep = 0; rep < REPS(1); ++rep) { PH_BEGIN;
            for (int u = F.vcu; u < NB * NCH; u += F.G) {
#ifndef NO_ATTN
#ifdef REP1_NO_ATTN
                if (rep == 0)
#endif
                attn_unit(F, u / NCH, u % NCH, A.in[I_RELB] + (size_t)l * AH * RELN);
#endif
#ifndef NO_GLA1
#ifdef REP1_NO_GLA
                if (rep == 0)
#endif
                gla_dstate_unit(F, u / NCH, u % NCH, (const bf16_t*)(wb + OFF_WGD), A.in[I_WGUP] + (size_t)l * GR * 256, A.in[I_BG] + (size_t)l * 256);
#endif
            }
        }
        SEAM(pb + 1);
        if (EN(2) && IN(pb + 2) && !(zpass && ((ZSKIP >> 2) & 1))) for (int rep = 0; rep < REPS(2); ++rep) { PH_BEGIN; gla_scan_phase(F); }
        SEAM(pb + 2);
        if (EN(3) && IN(pb + 3) && !(zpass && ((ZSKIP >> 3) & 1))) for (int rep = 0; rep < REPS(3); ++rep) { PH_BEGIN; for (int u = F.vcu; u < NB * NCH; u += F.G) gla_out_unit(F, u / NCH, u % NCH, A.in[I_GNORM] + (size_t)l * 512); }
        SEAM(pb + 3);
        if (EN(4) && IN(pb + 4) && !(zpass && ((ZSKIP >> 4) & 1))) for (int rep = 0; rep < REPS(4); ++rep) { PH_BEGIN;
            pg8::StaticOrder S; S.init(T, D, F.G, (int)blockIdx.x);
            { pg8::Gemm g{(const bf16_t*)(ws + WS_YA), (const bf16_t*)(wb + OFF_WBA), 512, 0, nullptr}; pg8::EpiEw<1> E{(bf16_t*)(ws + WS_MERGED), (const bf16_t*)(ws + WS_SGA), D, wt};
              pg8::gemm_phase<pg8::EpiEw<1>, pg8::StaticOrder, false>(F.lds, g, S, E); }
            { pg8::Gemm g{(const bf16_t*)(ws + WS_YB), (const bf16_t*)(wb + OFF_WBB), 512, 0, nullptr}; pg8::EpiEw<2> E{(bf16_t*)(ws + WS_MERGED), (const bf16_t*)(ws + WS_SGB), D, wt};
              pg8::gemm_phase<pg8::EpiEw<2>, pg8::StaticOrder, false>(F.lds, g, S, E); }
        }
        SEAM(pb + 4);
        if (EN(5) && IN(pb + 5) && !(zpass && ((ZSKIP >> 5) & 1))) for (int rep = 0; rep < REPS(5); ++rep) { PH_BEGIN;
            pg8::StaticOrder S; S.init(T, D, F.G, (int)blockIdx.x);
            pg8::Gemm g{(const bf16_t*)(ws + WS_MERGED), (const bf16_t*)(wb + OFF_WOUT), D, 0, nullptr}; pg8::EpiEw<0> E{Y, nullptr, D, wt};
            pg8::gemm_phase<pg8::EpiEw<0>, pg8::StaticOrder, false>(F.lds, g, S, E);
        }
        SEAM(pb + 5);
        if (EN(6) && IN(pb + 6) && !(zpass && ((ZSKIP >> 6) & 1))) for (int rep = 0; rep < ((l == 0) ? REPS(6) : 1); ++rep) { PH_BEGIN;
            if (l == 0) thin_phase<1, 1, false>(F, (LAYERREP == 0 && REPS(6) == 1) ? A.in[I_X] : nullptr, Y, (zpass || rep + 1 < REPS(6)) ? ZEROG : A.in[I_NMPOST] + (size_t)l * D, A.in[I_NFPRE] + (size_t)l * D, hb, nullptr);
            else        thin_phase<1, 1, true>(F, nullptr, Y, A.in[I_NMPOST] + (size_t)l * D, A.in[I_NFPRE] + (size_t)l * D, hb, A.in[I_RW]);
        }
        SEAM(pb + 6);
        if (EN(7) && IN(pb + 7) && !(zpass && ((ZSKIP >> 7) & 1))) for (int rep = 0; rep < REPS(7); ++rep) { PH_BEGIN;
            if (l == 0) { pg8::StaticOrder S; S.init(T, 2 * DFF, F.G, (int)blockIdx.x);
                pg8::Gemm g{hb, (const bf16_t*)(wb + OFF_FFN), D, 0, nullptr}; pg8::EpiGateUp E{(bf16_t*)(ws + WS_FACT), DFF, wt, FFN0_ACT_QS};
                pg8::gemm_phase<pg8::EpiGateUp, pg8::StaticOrder, false>(F.lds, g, S, E);
            } else { pg8::GroupedOrder S; S.init((const unsigned*)(F.ctl + CW_CNT), 2 * DFE, F.G, (int)blockIdx.x);
#if MOE_FP8
                pg8::Gemm g{hb, (const bf16_t*)(wb + OFF_FFN), D / 2, (size_t)2 * DFE * D / 2, (const int*)(ws + WS_IDXE), D / 2}; pg8::EpiGateUp8 E{ws + WS_MACT, DFE, wt, 1.f / W8_SCALE, ACT8_SCALE};
                pg8::gemm_phase<pg8::EpiGateUp8, pg8::GroupedOrder, true, true>(F.lds, g, S, E);
#else
                pg8::Gemm g{hb, (const bf16_t*)(wb + OFF_FFN), D, (size_t)2 * DFE * D, (const int*)(ws + WS_IDXE)}; pg8::EpiGateUp E{(bf16_t*)(ws + WS_MACT), DFE, wt, MOE_ACT_QS};
                pg8::gemm_phase<pg8::EpiGateUp, pg8::GroupedOrder, true>(F.lds, g, S, E);
#endif
            }
        }
        SEAM(pb + 7);
        if (EN(8) && IN(pb + 8) && !(zpass && ((ZSKIP >> 8) & 1))) for (int rep = 0; rep < REPS(8); ++rep) { PH_BEGIN;
            if (l == 0) { pg8::StaticOrder S; S.init(T, D, F.G, (int)blockIdx.x);
                pg8::Gemm g{(const bf16_t*)(ws + WS_FACT), (const bf16_t*)(wb + OFF_FDN), DFF, 0, nullptr}; pg8::EpiEw<0> E{Y, nullptr, D, wt};
                pg8::gemm_phase<pg8::EpiEw<0>, pg8::StaticOrder, false>(F.lds, g, S, E);
            } else {
#if MOE_FP8
                constexpr float dsc = 1.f / (W8_SCALE * ACT8_SCALE);
                { pg8::GroupedOrder S; S.init((const unsigned*)(F.ctl + CW_CNT), D, F.G, (int)blockIdx.x, MOE_MAIN_PANELS);
                  pg8::Gemm g{(const bf16_t*)(ws + WS_MACT), (const bf16_t*)(wb + OFF_MDN8), DFE / 2, (size_t)D * DFE / 2, nullptr}; pg8::EpiEw<0> E{(bf16_t*)(ws + WS_YSLOT), nullptr, D, wt, dsc};
                  pg8::gemm_phase<pg8::EpiEw<0>, pg8::GroupedOrder, false, true>(F.lds, g, S, E); }
                { pg8::TailOrder S; S.init((const unsigned*)(F.ctl + CW_CNT), D, F.G, (int)blockIdx.x, MOE_MAIN_PANELS, TAIL_KC, TAIL_KCH);
                  pg8::Gemm g{(const bf16_t*)(ws + WS_MACT), (const bf16_t*)(wb + OFF_MDN8), TAIL_KCH, (size_t)D * DFE / 2, nullptr, DFE / 2}; pg8::EpiPart E{(bf16_t*)(ws + WS_PBUF), D, MOE_MAIN_PANELS, TAIL_KCH, (size_t)TAIL_ROWS * D, wt, dsc};
                  pg8::gemm_phase<pg8::EpiPart, pg8::TailOrder, false, true>(F.lds, g, S, E); }
#else
                { pg8::GroupedOrder S; S.init((const unsigned*)(F.ctl + CW_CNT), D, F.G, (int)blockIdx.x, MOE_MAIN_PANELS);
                  pg8::Gemm g{(const bf16_t*)(ws + WS_MACT), (const bf16_t*)(wb + OFF_MDN), DFE, (size_t)D * DFE, nullptr}; pg8::EpiEw<0> E{(bf16_t*)(ws + WS_YSLOT), nullptr, D, wt};
                  pg8::gemm_phase<pg8::EpiEw<0>, pg8::GroupedOrder, false>(F.lds, g, S, E); }
                { pg8::TailOrder S; S.init((const unsigned*)(F.ctl + CW_CNT), D, F.G, (int)blockIdx.x, MOE_MAIN_PANELS, TAIL_KC, TAIL_KCH);
                  pg8::Gemm g{(const bf16_t*)(ws + WS_MACT), (const bf16_t*)(wb + OFF_MDN), TAIL_KCH, (size_t)D * DFE, nullptr, DFE}; pg8::EpiPart E{(bf16_t*)(ws + WS_PBUF), D, MOE_MAIN_PANELS, TAIL_KCH, (size_t)TAIL_ROWS * D, wt};
                  pg8::gemm_phase<pg8::EpiPart, pg8::TailOrder, false>(F.lds, g, S, E); }
#endif
            }
        }
        SEAM(pb + 8);
        if (EN(9) && IN(pb + 9) && !(zpass && ((ZSKIP >> 9) & 1))) for (int rep = 0; rep < REPS(9); ++rep) { PH_BEGIN;
            if (l == 0) thin_phase<1, 2, false>(F, nullptr, Y, (zpass || rep + 1 < REPS(9)) ? ZEROG : A.in[I_NFPOST] + (size_t)l * D, nullptr, nullptr, nullptr);
            else        thin_phase<2, 2, false>(F, nullptr, (const bf16_t*)(ws + WS_YSLOT), (zpass || rep + 1 < REPS(9)) ? ZEROG : A.in[I_NFPOST] + (size_t)l * D, nullptr, nullptr, nullptr);
        }
        SEAM(pb + 9);
        if (EN(10) && IN(pb + 10) && !(zpass && ((ZSKIP >> 10) & 1))) for (int rep = 0; rep < REPS(10); ++rep) { PH_BEGIN;
            pg8::StaticOrder S; S.init(T, D, F.G, (int)blockIdx.x);
            if (MK_DBG == 0 || A.sub != 2) { pg8::Gemm g{(const bf16_t*)(ws + WS_XS), (const bf16_t*)(wb + OFF_WPG), D, 0, nullptr}; pg8::EpiEw<PLE_MODE1> E{Y, nullptr, D, wt};
              pg8::gemm_phase<pg8::EpiEw<PLE_MODE1>, pg8::StaticOrder, false>(F.lds, g, S, E); }
            if (MK_DBG == 0 || A.sub != 1) { pg8::Gemm g{(const bf16_t*)(ws + WS_PB) + (size_t)l * T * PLE, (const bf16_t*)(wb + OFF_WPP), PLE, 0, nullptr}; pg8::EpiEw<4> E{Y, nullptr, D, wt};
              pg8::gemm_phase<pg8::EpiEw<4>, pg8::StaticOrder, false>(F.lds, g, S, E); }
        }
        SEAM(pb + 10);
        if (EN(11) && IN(pb + 11) && !(zpass && ((ZSKIP >> 11) & 1))) for (int rep = 0; rep < REPS(11); ++rep) { PH_BEGIN;
            if (l + 1 < DEPTH) thin_phase<1, 1, false>(F, nullptr, Y, (zpass || rep + 1 < REPS(11)) ? ZEROG : A.in[I_PNORM] + (size_t)l * D, A.in[I_NMPRE] + (size_t)(zpass ? 0 : l + 1) * D, hb, nullptr);
            else               thin_phase<1, 0, false>(F, nullptr, Y, (zpass || rep + 1 < REPS(11)) ? ZEROG : A.in[I_PNORM] + (size_t)l * D, nullptr, nullptr, nullptr);
        }
        SEAM(pb + 11);
    }
#if MK_STAMP
    {
        xcd_barrier(bar);
        const unsigned long long* st = (const unsigned long long*)(ws + WS_CTL + 786432);
        LAS float* res = (LAS float*)(F.lds);
        if (F.tid < N_PHASES) { const int k = F.tid; unsigned long long mx = 0, mxp = 0; double sum = 0.0;
            for (int g = 0; g < F.G; ++g) { const unsigned long long t = st[k * 256 + g]; mx = t > mx ? t : mx; sum += (double)t; if (k > 0) { const unsigned long long tp = st[(k - 1) * 256 + g]; mxp = tp > mxp ? tp : mxp; } }
            if (k == 0) { mxp = ~0ull; for (int g = 0; g < F.G; ++g) { const unsigned long long t = st[g]; mxp = t < mxp ? t : mxp; } mxp -= 0; }
            res[k] = (float)((double)(mx - mxp) * 0.01); res[32 + k] = (float)(((double)mx - sum / F.G) * 0.01); }
        __syncthreads();
        float t1, t2;
        if (STAMP_SEL < 0) { t1 = 0.f; t2 = 0.f; for (int k = 1; k < N_PHASES; ++k) { t1 += res[32 + k]; t2 += res[k]; } }
        else { t1 = res[STAMP_SEL]; t2 = res[32 + STAMP_SEL]; }
        const float A = 300.f * t1 + 1000.f, B = 10.f * t2 + 20.f;
        for (size_t i = (size_t)blockIdx.x * NTHR + F.tid; i < (size_t)T * D; i += (size_t)F.G * NTHR) args.out[i] = (i == 0) ? A : B;
    }
#endif
#undef IN
#undef SEAM
}
#ifndef MK_DBG
#define MK_DBG 0
#endif
#if MK_DBG
#ifndef MK_DBG_SHOW
#define MK_DBG_SHOW -1
#endif
constexpr size_t WS_SNAP = 512 * 1024;
__device__ __forceinline__ unsigned dh(unsigned x) { x ^= x >> 16; x *= 0x7feb352du; x ^= x >> 15; x *= 0x846ca68bu; x ^= x >> 16; return x; }
__device__ __forceinline__ void dbg_acc(float* dbg, int stage, float d2, float e2, int lane) { d2 = wave_sum(d2); e2 = wave_sum(e2); if (lane == 0) { atomicAdd(dbg + 2 * stage, d2); atomicAdd(dbg + 2 * stage + 1, e2); } }
__device__ __forceinline__ float ddot(const bf16_t* arow, const float* W, int K, int pitch, int col, int lane) { float s = 0.f; for (int k = lane; k < K; k += 64) s += bf2f(arow[k]) * W[(size_t)k * pitch + col]; return wave_sum(s); }
__device__ __forceinline__ float dsig(float v) { return 1.f / (1.f + expf(-v)); }
__device__ __forceinline__ int dbg_pbase(const unsigned* gcnt, int e) { int acc = 0; for (int q = 0; q < 8; ++q) if (q < e) acc += (((int)gcnt[q] + 255) >> 8) << 8; return acc; }
__device__ __forceinline__ float dbg_moe_el(const unsigned char* ws, int s, int k) { if (s < MOE_MAIN_ROWS) return bf2f(((const bf16_t*)(ws + WS_YSLOT))[(size_t)s * D + k]); float a = 0.f; for (int kc = 0; kc < TAIL_KC; ++kc) a += bf2f(((const bf16_t*)(ws + WS_PBUF))[((size_t)kc * TAIL_ROWS + (s - MOE_MAIN_ROWS)) * D + k]); return a; }
__device__ __forceinline__ float dbg_f8(const unsigned char* p, size_t i) { return __builtin_amdgcn_cvt_f32_fp8((int)p[i], 0); }
__device__ __forceinline__ float ddot8(const unsigned char* arow, float ascale, const float* W, int K, int pitch, int col, int lane) { float s = 0.f; for (int k = lane; k < K; k += 64) s += dbg_f8(arow, k) * ascale * W[(size_t)k * pitch + col]; return wave_sum(s); }
#define DBGP float* dbg = (float*)(a.ws + WS_CTL) + CW_DBG; const int lane = threadIdx.x & 63; const unsigned sid = blockIdx.x; (void)sid

__global__ void dbg_t1(Args a, int stage) { DBGP;
    const int r = dh(sid * 3 + 1) % T; const float* x = a.in[I_X] + (size_t)r * D; const bf16_t* hb = (const bf16_t*)(a.ws + WS_HB) + (size_t)r * D;
    float ss = 0.f; for (int k = lane; k < D; k += 64) ss += x[k] * x[k]; ss = wave_sum(ss); const float rstd = 1.f / sqrtf(ss / D + EPS);
    float d2 = 0.f, e2 = 0.f; for (int k = lane; k < D; k += 64) { const float e = x[k] * rstd * a.in[I_NMPRE][k], g = bf2f(hb[k]); d2 += (g - e) * (g - e); e2 += e * e; }
    dbg_acc(dbg, stage, d2, e2, lane); }

__global__ void dbg_gemm(Args a, int kind, int l, int stage) { DBGP;
    unsigned char* ws = a.ws; const unsigned h1 = dh(sid * 7 + 1), h2 = dh(sid * 7 + 2), h3 = dh(sid * 7 + 3);
    const bf16_t* hb = (const bf16_t*)(ws + WS_HB); float e = 0.f, g = 0.f;
    const unsigned* gcnt = (const unsigned*)(ws + WS_CTL) + CW_CNT;
    if (kind == 1) { const int row = h1 % T, col = h2 % INWG, sc = col < 2560 ? col : col + 16; const float v = ddot(hb + (size_t)row * D, a.in[I_WIN] + (size_t)l * D * INW, D, INW, sc, lane);
        const bf16_t* P = (const bf16_t*)(ws + WS_PROJ);
        if (col < 512) { e = v * pg8::QA_SCALE; g = bf2f(((const bf16_t*)(ws + WS_QA))[(size_t)row * 512 + col]); }
        else if (col < 1024) { e = v; g = bf2f(((const bf16_t*)(ws + WS_KA))[(size_t)row * 512 + col - 512]); }
        else if (col < 1536) { e = v; g = bf2f(((const bf16_t*)(ws + WS_VA))[(size_t)row * 512 + col - 1024]); }
        else if (col < 1792) { e = v * 0.125f; g = bf2f(((const bf16_t*)(ws + WS_QB))[(size_t)row * 256 + col - 1536]); }
        else if (col < 2048) { e = v; g = bf2f(((const bf16_t*)(ws + WS_KB))[(size_t)row * 256 + col - 1792]); }
        else if (col < 2560) { e = v; g = bf2f(((const bf16_t*)(ws + WS_VB))[(size_t)row * 512 + col - 2048]); }
        else if (col < 3072) { e = v * dsig(v); g = bf2f(((const bf16_t*)(ws + WS_SR))[(size_t)row * 512 + col - 2560]); }
        else if (col < 4096) { e = dsig(v); g = bf2f(((const bf16_t*)(ws + WS_SGA))[(size_t)row * 1024 + col - 3072]); }
        else { e = dsig(v); g = bf2f(((const bf16_t*)(ws + WS_SGB))[(size_t)row * 1024 + col - 4096]); } (void)P;
    } else if (kind == 2) { const int row = h1 % T, col = h2 % D;
        const float va = ddot((const bf16_t*)(ws + WS_YA) + (size_t)row * 512, a.in[I_WBA] + (size_t)l * 512 * D, 512, D, col, lane), vb = ddot((const bf16_t*)(ws + WS_YB) + (size_t)row * 512, a.in[I_WBB] + (size_t)l * 512 * D, 512, D, col, lane);
        e = bf2f(((const bf16_t*)(ws + WS_SGA))[(size_t)row * D + col]) * va + bf2f(((const bf16_t*)(ws + WS_SGB))[(size_t)row * D + col]) * vb; g = bf2f(((const bf16_t*)(ws + WS_MERGED))[(size_t)row * D + col]);
    } else if (kind == 3) { const int row = h1 % T, col = h2 % D; e = ddot((const bf16_t*)(ws + WS_MERGED) + (size_t)row * D, a.in[I_WOUT] + (size_t)l * D * D, D, D, col, lane); g = bf2f(((const bf16_t*)(ws + WS_Y))[(size_t)row * D + col]);
    } else if (kind == 4) { const int row = h1 % T, c = h2 % DFF; const float vg = ddot(hb + (size_t)row * D, a.in[I_FG], D, DFF, c, lane), vu = ddot(hb + (size_t)row * D, a.in[I_FU], D, DFF, c, lane);
        e = vg * dsig(vg) * vu; g = bf2f(((const bf16_t*)(ws + WS_FACT))[(size_t)row * DFF + c]);
    } else if (kind == 5) { const int row = h1 % T, col = h2 % D; e = ddot((const bf16_t*)(ws + WS_FACT) + (size_t)row * DFF, a.in[I_FD], DFF, D, col, lane); g = bf2f(((const bf16_t*)(ws + WS_Y))[(size_t)row * D + col]);
    } else if (kind == 6 || kind == 7) { const int ex = h1 % NE; const int pbase = dbg_pbase(gcnt, ex); const int cnt = (int)gcnt[ex];
        if (cnt == 0) return; const int i = h2 % cnt, tok = ((const int*)(ws + WS_IDXE))[ex * 16384 + i], row = pbase + i;
#if MOE_FP8
        const unsigned char* hb8 = ws + WS_HB; const unsigned char* act8 = ws + WS_MACT;
        if (kind == 6) { const int c = h3 % DFE; const float vg = ddot8(hb8 + (size_t)tok * D, 1.f, a.in[I_MG] + (size_t)ex * D * DFE, D, DFE, c, lane), vu = ddot8(hb8 + (size_t)tok * D, 1.f, a.in[I_MU] + (size_t)ex * D * DFE, D, DFE, c, lane);
            e = vg * dsig(vg) * vu; g = dbg_f8(act8, (size_t)row * DFE + c) * (1.f / ACT8_SCALE); }
        else { const int col = h3 % D; e = ddot8(act8 + (size_t)row * DFE, 1.f / ACT8_SCALE, a.in[I_MD] + (size_t)ex * DFE * D, DFE, D, col, lane); g = dbg_moe_el(ws, row, col); }
#else
        if (kind == 6) { const int c = h3 % DFE; const float vg = ddot(hb + (size_t)tok * D, a.in[I_MG] + (size_t)ex * D * DFE, D, DFE, c, lane), vu = ddot(hb + (size_t)tok * D, a.in[I_MU] + (size_t)ex * D * DFE, D, DFE, c, lane);
            e = vg * dsig(vg) * vu; g = bf2f(((const bf16_t*)(ws + WS_MACT))[(size_t)row * DFE + c]); }
        else { const int col = h3 % D; e = ddot((const bf16_t*)(ws + WS_MACT) + (size_t)row * DFE, a.in[I_MD] + (size_t)ex * DFE * D, DFE, D, col, lane); g = dbg_moe_el(ws, row, col); }
#endif
    } else if (kind == 12) { const int row = h1 % T, col = h2 % D; e = a.out[(size_t)row * D + col]; g = bf2f(((const bf16_t*)(ws + WS_XS))[(size_t)row * D + col]);
    } else if (kind == 13) { const int row = h1 % T, col = h2 % D; e = ddot((const bf16_t*)(ws + WS_XS) + (size_t)row * D, a.in[I_PG] + (size_t)l * D * D, D, D, col, lane); g = bf2f(((const bf16_t*)(ws + WS_Y))[(size_t)row * D + col]);
    } else if (kind == 11) { const int n = h1 % D, k = h2 % D; e = a.in[I_PG][(size_t)l * D * D + (size_t)k * D + n]; g = bf2f(((const bf16_t*)(ws + (l ? WS_W1 : WS_W0) + OFF_WPG))[(size_t)n * D + k]);
    } else if (kind == 9) { const int row = h1 % T, col = h2 % D; e = dsig(ddot((const bf16_t*)(ws + WS_XS) + (size_t)row * D, a.in[I_PG] + (size_t)l * D * D, D, D, col, lane)); g = bf2f(((const bf16_t*)(ws + WS_Y))[(size_t)row * D + col]);
    } else { const int row = h1 % T, col = h2 % D; const float vg = ddot((const bf16_t*)(ws + WS_XS) + (size_t)row * D, a.in[I_PG] + (size_t)l * D * D, D, D, col, lane), vp = ddot((const bf16_t*)(ws + WS_PB) + ((size_t)l * T + row) * PLE, a.in[I_PP] + (size_t)l * PLE * D, PLE, D, col, lane);
        e = dsig(vg) * vp; g = bf2f(((const bf16_t*)(ws + WS_Y))[(size_t)row * D + col]); }
    if (lane == 0) { atomicAdd(dbg + 2 * stage, (g - e) * (g - e)); atomicAdd(dbg + 2 * stage + 1, e * e); } }

__global__ void dbg_attn(Args a, int l, int stage) { DBGP;
    unsigned char* ws = a.ws; const unsigned h1 = dh(sid * 5 + 1); const int tok = h1 % T, h = dh(sid * 5 + 2) % AH, b = tok / SEQ, c = (tok % SEQ) / CH, ql = tok % CH;
    const bf16_t* hb = (const bf16_t*)(ws + WS_HB) + (size_t)tok * D; const float* win = a.in[I_WIN] + (size_t)l * D * INW;
    float q = 0.f; for (int k = 0; k < D; ++k) q += bf2f(hb[k]) * win[(size_t)k * INW + h * 64 + lane]; q *= pg8::QA_SCALE;
    const bf16_t* ka = (const bf16_t*)(ws + WS_KA); const bf16_t* va = (const bf16_t*)(ws + WS_VA); const float* rb = a.in[I_RELB] + ((size_t)l * AH + h) * RELN;
    float m = -1e30f, ls = 0.f, o = 0.f;
    for (int kc = (c - 8 > 0 ? c - 8 : 0); kc <= c; ++kc) for (int kl = 0; kl < CH; ++kl) { const int kt = b * SEQ + kc * CH + kl; int dist = (c - kc) * 64 + ql - kl; dist = dist > 128 ? 128 : (dist < -128 ? -128 : dist);
        const float s = wave_sum(q * bf2f(ka[(size_t)kt * 512 + h * 64 + lane])) + rb[dist + 128] * LOG2E; const float mn = fmaxf(m, s), al = exp2f(m - mn), p = exp2f(s - mn); m = mn; ls = ls * al + p; o = o * al + p * bf2f(va[(size_t)kt * 512 + h * 64 + lane]); }
    const float e = o / ls, g = bf2f(((const bf16_t*)(ws + WS_YA))[(size_t)tok * 512 + h * 64 + lane]);
    dbg_acc(dbg, stage, (g - e) * (g - e), e * e, lane); }

__global__ void dbg_dstate(Args a, int l, int stage) { DBGP;
    unsigned char* ws = a.ws; const int b = dh(sid * 5 + 1) % NB, c = dh(sid * 5 + 2) % NCH, hh = dh(sid * 5 + 3) % BH, v = dh(sid * 5 + 4) % 128, k = dh(sid * 5 + 5) % 64, col = hh * 64 + k;
    const int tok = b * SEQ + c * CH + lane; const bf16_t* hb = (const bf16_t*)(ws + WS_HB) + (size_t)tok * D; const float* win = a.in[I_WIN] + (size_t)l * D * INW;
    float z = a.in[I_BG][l * 256 + col];
    for (int r = 0; r < GR; ++r) { float gd = 0.f; for (int kk = 0; kk < D; ++kk) gd += bf2f(hb[kk]) * win[(size_t)kk * INW + 2560 + r]; z += gd * a.in[I_WGUP][((size_t)l * GR + r) * 256 + col]; }
    const float la = (fminf(z, 0.f) - log1pf(expf(-fabsf(z)))) / 16.f; float cum = la;
    for (int o = 1; o < 64; o <<= 1) { const float t = __shfl_up(cum, o); if (lane >= o) cum += t; }
    const float tot = __shfl(cum, 63);
    const float kd = bf2f(((const bf16_t*)(ws + WS_KB))[(size_t)tok * 256 + col]) * expf(tot - cum);
    const float e = wave_sum(kd * bf2f(((const bf16_t*)(ws + WS_VB))[(size_t)tok * 512 + hh * 128 + v]));
    const float g = ((const float*)(ws + WS_DST))[((size_t)((b * NCH + c) * BH + hh) * 128 + v) * 64 + k];
    const float ed = expf(tot), gdc = ((const float*)(ws + WS_DEC))[(size_t)(b * NCH + c) * 256 + col];
    if (lane == 0) { atomicAdd(dbg + 2 * stage, (g - e) * (g - e) + (gdc - ed) * (gdc - ed)); atomicAdd(dbg + 2 * stage + 1, e * e + ed * ed); } }

__global__ void dbg_scan(Args a, int stage) { DBGP;
    unsigned char* ws = a.ws; const unsigned s0 = sid * 64 + lane; const int b = dh(s0 * 5 + 1) % NB, c = dh(s0 * 5 + 2) % NCH, hh = dh(s0 * 5 + 3) % BH, v = dh(s0 * 5 + 4) % 128, k = dh(s0 * 5 + 5) % 64;
    float s = 0.f; for (int cc = 0; cc <= c; ++cc) s = ((const float*)(ws + WS_DEC))[(size_t)(b * NCH + cc) * 256 + hh * 64 + k] * s + ((const float*)(ws + WS_DST))[((size_t)((b * NCH + cc) * BH + hh) * 128 + v) * 64 + k];
    const float g = bf2f(((const bf16_t*)(ws + WS_ST))[((size_t)((b * NCH + c) * BH + hh) * 128 + v) * 64 + k]);
    dbg_acc(dbg, stage, (g - s) * (g - s), s * s, lane); }

__global__ void dbg_glaout(Args a, int l, int stage) { DBGP;
    unsigned char* ws = a.ws; const int tok = dh(sid * 3 + 1) % T, hh = dh(sid * 3 + 2) % BH, b = tok / SEQ, c = (tok % SEQ) / CH;
    const bf16_t* st = (const bf16_t*)(ws + WS_ST) + ((size_t)((b * NCH + c) * BH + hh) * 128) * 64; const bf16_t* qb = (const bf16_t*)(ws + WS_QB) + (size_t)tok * 256 + hh * 64;
    const bf16_t* hb = (const bf16_t*)(ws + WS_HB) + (size_t)tok * D; const float* win = a.in[I_WIN] + (size_t)l * D * INW;
    float o[2], r[2];
#pragma unroll
    for (int j = 0; j < 2; ++j) { const int v = lane + 64 * j; float s = 0.f; for (int k = 0; k < 64; ++k) s += bf2f(qb[k]) * bf2f(st[(size_t)v * 64 + k]); o[j] = s;
        float rr = 0.f; for (int kk = 0; kk < D; ++kk) rr += bf2f(hb[kk]) * win[(size_t)kk * INW + 2576 + hh * 128 + v]; r[j] = rr * dsig(rr); }
    const float ss = wave_sum(o[0] * o[0] + o[1] * o[1]), rstd = 1.f / sqrtf(ss / 128.f + EPS); float d2 = 0.f, e2 = 0.f;
#pragma unroll
    for (int j = 0; j < 2; ++j) { const int v = lane + 64 * j; const float e = o[j] * rstd * a.in[I_GNORM][l * 512 + hh * 128 + v] * r[j], g = bf2f(((const bf16_t*)(ws + WS_YB))[(size_t)tok * 512 + hh * 128 + v]); d2 += (g - e) * (g - e); e2 += e * e; }
    dbg_acc(dbg, stage, d2, e2, lane); }

__device__ __forceinline__ int dbg_row(unsigned i) { return (int)((i * 257u + 11u) % T); }
__global__ void dbg_snap(Args a, int from_in) { const int i = blockIdx.x, r = dbg_row(i); float* snap = (float*)(a.ws + WS_SNAP) + (size_t)i * D; const bf16_t* xs = (const bf16_t*)(a.ws + WS_XS); for (int k = threadIdx.x; k < D; k += 64) snap[k] = from_in ? a.in[I_X][(size_t)r * D + k] : bf2f(xs[(size_t)r * D + k]); }
__global__ void dbg_thin(Args a, int src, int outk, int route, const float* g_add, const float* g_out, const bf16_t* obuf, int st_x, int st_o, int st_r) { DBGP;
    unsigned char* ws = a.ws; const int i = sid, r = dbg_row(i); const float* snap = (const float*)(ws + WS_SNAP) + (size_t)i * D;
    const unsigned* gcnt = (const unsigned*)(ws + WS_CTL) + CW_CNT; const unsigned* ti = (const unsigned*)(ws + WS_TOKINFO) + (size_t)r * 8;
    float y[16], xn[16]; float ss = 0.f;
#pragma unroll
    for (int j = 0; j < 16; ++j) { const int k = lane + 64 * j; float v;
        if (src == 1) v = bf2f(((const bf16_t*)(ws + WS_Y))[(size_t)r * D + k]);
        else { v = __uint_as_float(ti[4]) * dbg_moe_el(ws, dbg_pbase(gcnt, (int)ti[0]) + (int)ti[1], k) + __uint_as_float(ti[5]) * dbg_moe_el(ws, dbg_pbase(gcnt, (int)ti[2]) + (int)ti[3], k); }
        y[j] = v; ss += v * v; }
    ss = wave_sum(ss); const float rstd = 1.f / sqrtf(ss / D + EPS); float d2 = 0.f, e2 = 0.f, s2 = 0.f;
#pragma unroll
    for (int j = 0; j < 16; ++j) { const int k = lane + 64 * j; xn[j] = snap[k] + y[j] * rstd * g_add[k]; const float g = (outk == 0) ? a.out[(size_t)r * D + k] : bf2f(((const bf16_t*)(ws + WS_XS))[(size_t)r * D + k]); d2 += (g - xn[j]) * (g - xn[j]); e2 += xn[j] * xn[j]; s2 += xn[j] * xn[j]; }
    dbg_acc(dbg, st_x, d2, e2, lane);
    if (outk != 1) return;
    s2 = wave_sum(s2); const float rs2 = 1.f / sqrtf(s2 / D + EPS); d2 = 0.f; e2 = 0.f; float hn[16];
#pragma unroll
    for (int j = 0; j < 16; ++j) { const int k = lane + 64 * j; hn[j] = (outk == 1) ? xn[j] * rs2 * g_out[k] : xn[j]; const float g = (MOE_FP8 && route) ? dbg_f8((const unsigned char*)obuf, (size_t)r * D + k) : bf2f(obuf[(size_t)r * D + k]); d2 += (g - hn[j]) * (g - hn[j]); e2 += hn[j] * hn[j]; }
    dbg_acc(dbg, st_o, d2, e2, lane);
    if (!route) return;
    float lg[8];
#pragma unroll
    for (int e = 0; e < 8; ++e) { float s = 0.f;
#pragma unroll
        for (int j = 0; j < 16; ++j) s += hn[j] * a.in[I_RW][(size_t)(lane + 64 * j) * NE + e]; lg[e] = wave_sum(s); }
    int e1 = 0; float v1 = lg[0];
#pragma unroll
    for (int e = 1; e < 8; ++e) if (lg[e] > v1) { v1 = lg[e]; e1 = e; }
    int e2i = -1; float v2 = -3.0e38f;
#pragma unroll
    for (int e = 0; e < 8; ++e) if (e != e1 && lg[e] > v2) { v2 = lg[e]; e2i = e; }
    const float ex = expf(v2 - v1), w1 = 1.f / (1.f + ex);
    float bad = 0.f; if ((int)ti[0] != e1 || (int)ti[2] != e2i) bad = 1.f; else { bad = fabsf(__uint_as_float(ti[4]) - w1) + fabsf(__uint_as_float(ti[5]) - (1.f - w1));
        const int* idxe = (const int*)(ws + WS_IDXE); if (ti[1] >= gcnt[e1] || ti[3] >= gcnt[e2i] || idxe[e1 * 16384 + ti[1]] != r || idxe[e2i * 16384 + ti[3]] != r) bad = 1.f; }
    if (lane == 0) { atomicAdd(dbg + 2 * st_r, bad * bad); atomicAdd(dbg + 2 * st_r + 1, 1.f); } }

__global__ void dbg_report(Args a) {
    const float* dbg = (const float*)(a.ws + WS_CTL) + CW_DBG; int bad = -1; float errk = 0.f;
    for (int k = 0; k < 33; ++k) { const float d2 = dbg[2 * k], e2 = dbg[2 * k + 1]; if (d2 == 0.f && e2 == 0.f) continue; const float err = d2 / e2; if (MK_DBG_SHOW == k) errk = (err == err) ? err : 1e6f; const float thr = (MOE_FP8 && (k == 25 || k == 27 || k == 28)) ? 3e-2f : 1e-3f; if (bad < 0 && !(err < thr)) bad = k; }
    float V = 0.f; bool fill = false;
    if (MK_DBG_SHOW >= 0) { V = sqrtf(7.f * 100.f * errk) + 1e-3f; fill = true; } else if (bad >= 0) { V = exp10f(1.f + 0.25f * (float)bad); fill = true; }
    if (fill) for (size_t i = (size_t)blockIdx.x * blockDim.x + threadIdx.x; i < (size_t)T * D; i += (size_t)gridDim.x * blockDim.x) a.out[i] = V; }

static void dbg_run(Args a, int grid, hipStream_t st) {
    auto ph = [&](int p) { a.ph_lo = p; a.ph_hi = p + 1; hipLaunchKernelGGL(fwd, dim3(grid), dim3(NTHR), LDS_BYTES, st, a); };
    const int NS = 2048;
    ph(0); hipLaunchKernelGGL(dbg_t1, dim3(256), dim3(64), 0, st, a, 0);
    for (int l = 0; l < DEPTH; ++l) { const int pb = 1 + 12 * l, sb = 16 * l; const size_t lo = (size_t)l * D;
        ph(pb + 0); hipLaunchKernelGGL(dbg_gemm, dim3(NS), dim3(64), 0, st, a, 1, l, sb + 1);
        ph(pb + 1); hipLaunchKernelGGL(dbg_attn, dim3(512), dim3(64), 0, st, a, l, sb + 2); hipLaunchKernelGGL(dbg_dstate, dim3(256), dim3(64), 0, st, a, l, sb + 3);
        ph(pb + 2); hipLaunchKernelGGL(dbg_scan, dim3(64), dim3(64), 0, st, a, sb + 4);
        ph(pb + 3); hipLaunchKernelGGL(dbg_glaout, dim3(256), dim3(64), 0, st, a, l, sb + 5);
        ph(pb + 4); hipLaunchKernelGGL(dbg_gemm, dim3(NS), dim3(64), 0, st, a, 2, l, sb + 6);
        ph(pb + 5); hipLaunchKernelGGL(dbg_gemm, dim3(NS), dim3(64), 0, st, a, 3, l, sb + 7);
        hipLaunchKernelGGL(dbg_snap, dim3(64), dim3(64), 0, st, a, l == 0 ? 1 : 0);
        ph(pb + 6); hipLaunchKernelGGL(dbg_thin, dim3(64), dim3(64), 0, st, a, 1, 1, l == 1 ? 1 : 0, a.in[I_NMPOST] + lo, a.in[I_NFPRE] + lo, (const bf16_t*)(a.ws + WS_HB), sb + 8, sb + 9, sb + 10);
        ph(pb + 7); hipLaunchKernelGGL(dbg_gemm, dim3(NS), dim3(64), 0, st, a, l == 0 ? 4 : 6, l, sb + 11);
        ph(pb + 8); hipLaunchKernelGGL(dbg_gemm, dim3(NS), dim3(64), 0, st, a, l == 0 ? 5 : 7, l, sb + 12);
        hipLaunchKernelGGL(dbg_snap, dim3(64), dim3(64), 0, st, a, 0);
        ph(pb + 9); hipLaunchKernelGGL(dbg_thin, dim3(64), dim3(64), 0, st, a, l == 0 ? 1 : 2, 2, 0, a.in[I_NFPOST] + lo, (const float*)nullptr, (const bf16_t*)nullptr, sb + 13, sb + 13, 0);
        a.sub = 1; ph(pb + 10); hipLaunchKernelGGL(dbg_gemm, dim3(NS), dim3(64), 0, st, a, 9, l, sb + 14);
        a.sub = 2; ph(pb + 10); a.sub = 0; hipLaunchKernelGGL(dbg_gemm, dim3(NS), dim3(64), 0, st, a, 8, l, sb + 15);
        hipLaunchKernelGGL(dbg_snap, dim3(64), dim3(64), 0, st, a, 0);
        ph(pb + 11); hipLaunchKernelGGL(dbg_thin, dim3(64), dim3(64), 0, st, a, 1, l == 0 ? 1 : 0, 0, a.in[I_PNORM] + lo, l == 0 ? a.in[I_NMPRE] + D : (const float*)nullptr, (const bf16_t*)(a.ws + WS_HB), sb + 16, sb + 16, 0);
    }
    hipLaunchKernelGGL(dbg_report, dim3(1024), dim3(256), 0, st, a);
}
#endif
#ifndef MK_SPLIT
#define MK_SPLIT 0
#endif
#ifndef MK_DBG
#define MK_DBG 0
#endif
extern "C" void kernel_launch(void* const* d_in, const int* in_sizes, int n_in, void* d_out, int out_size, void* d_ws, size_t ws_size, hipStream_t stream) {
    static int grid = 0;
    if (grid == 0) {
        if (n_in != 24 || in_sizes[0] != T * D || out_size != T * D || ws_size < WS_END) { fprintf(stderr, "kernel_launch: unexpected problem (n_in %d, in0 %d, out %d, ws %zu < %zu); nothing launched\n", n_in, n_in > 0 ? in_sizes[0] : -1, out_size, ws_size, (size_t)WS_END); grid = -1; return; }
        int dev = 0, cus = 0, per_cu = 0;
        if (hipGetDevice(&dev) != hipSuccess || hipDeviceGetAttribute(&cus, hipDeviceAttributeMultiprocessorCount, dev) != hipSuccess) { grid = -1; return; }
        if (hipFuncSetAttribute((const void*)fwd, hipFuncAttributeMaxDynamicSharedMemorySize, LDS_BYTES) != hipSuccess) { fprintf(stderr, "kernel_launch: hipFuncSetAttribute failed\n"); grid = -1; return; }
        if (hipOccupancyMaxActiveBlocksPerMultiprocessor(&per_cu, (const void*)fwd, NTHR, LDS_BYTES) != hipSuccess || per_cu < 1) { fprintf(stderr, "kernel_launch: occupancy query says %d blocks per CU\n", per_cu); }
        (void)hipGetLastError();
        grid = cus;
    }
    if (grid < 0) return;
    (void)hipMemsetAsync((char*)d_ws + WS_CTL, 0, CTL_ZERO_BYTES, stream);
    Args a{};
    for (int i = 0; i < 24; ++i) a.in[i] = (const float*)d_in[i];
    a.out = (float*)d_out; a.ws = (unsigned char*)d_ws;
#if MK_DBG
    dbg_run(a, grid, stream);
#elif MK_SPLIT
    for (int p = 0; p < N_PHASES; ++p) { a.ph_lo = p; a.ph_hi = p + 1; hipLaunchKernelGGL(fwd, dim3(grid), dim3(NTHR), LDS_BYTES, stream, a); }
#else
    a.ph_lo = 0; a.ph_hi = N_PHASES;
    hipLaunchKernelGGL(fwd, dim3(grid), dim3(NTHR), LDS_BYTES, stream, a);
#endif
}
```

```cpp
#define TR_NFAST 1
#define THIN_PF 1
#include <hip/hip_runtime.h>
#include <cstdio>
#include <cstdint>

#define LAS __attribute__((address_space(3)))
#define GAS __attribute__((address_space(1)))
typedef unsigned short bf16_t;
typedef short bf16x8 __attribute__((ext_vector_type(8)));
typedef short s16x4 __attribute__((ext_vector_type(4)));
typedef float f32x4 __attribute__((ext_vector_type(4)));
typedef float f32x2 __attribute__((ext_vector_type(2)));
typedef unsigned u32x4 __attribute__((ext_vector_type(4)));
typedef unsigned u32x2 __attribute__((ext_vector_type(2)));

typedef __bf16 bf16x2_t __attribute__((ext_vector_type(2)));
__device__ __forceinline__ unsigned cvt_pk_bf16(float lo, float hi) { f32x2 v = {lo, hi}; const bf16x2_t b = __builtin_convertvector(v, bf16x2_t); return __builtin_bit_cast(unsigned, b); }
#ifndef WT_STORES
#define WT_STORES 1
#endif
struct WT { __amdgpu_buffer_rsrc_t rs; const char* base; };
__device__ __forceinline__ WT make_wt(void* ws_base, unsigned nbytes) { WT w; w.rs = __builtin_amdgcn_make_buffer_rsrc(ws_base, 0, (int)nbytes, 0x00020000); w.base = (const char*)ws_base; return w; }
__device__ __forceinline__ void st16(const WT& w, void* p, u32x4 v) {
#if WT_STORES
    __builtin_amdgcn_raw_buffer_store_b128(v, w.rs, (int)(unsigned)((const char*)p - w.base), 0, 16);
#else
    *(u32x4*)p = v;
#endif
}
__device__ __forceinline__ void st8(const WT& w, void* p, u32x2 v) {
#if WT_STORES
    __builtin_amdgcn_raw_buffer_store_b64(v, w.rs, (int)(unsigned)((const char*)p - w.base), 0, 16);
#else
    *(u32x2*)p = v;
#endif
}
__device__ __forceinline__ float clamp8(float v) { return __builtin_amdgcn_fmed3f(v, -448.f, 448.f); }
__device__ __forceinline__ unsigned pk4_fp8(float a, float b, float c, float d) { int w = __builtin_amdgcn_cvt_pk_fp8_f32(clamp8(a), clamp8(b), 0, false); w = __builtin_amdgcn_cvt_pk_fp8_f32(clamp8(c), clamp8(d), w, true); return (unsigned)w; }
__device__ __forceinline__ float q8(float x, float s) { const int w = __builtin_amdgcn_cvt_pk_fp8_f32(x * s, 0.f, 0, false); return __builtin_amdgcn_cvt_f32_fp8(w, 0) * (1.0f / s); }
__device__ __forceinline__ float bf_lo(unsigned w) { return __uint_as_float(w << 16); }
__device__ __forceinline__ float bf_hi(unsigned w) { return __uint_as_float(w & 0xffff0000u); }
__device__ __forceinline__ float bf2f(bf16_t b) { return __uint_as_float(((unsigned)b) << 16); }
__device__ __forceinline__ float fast_sigmoid(float v) { return __builtin_amdgcn_rcpf(1.0f + __builtin_amdgcn_exp2f(-1.4426950408889634f * v)); }
__device__ __forceinline__ float wave_sum(float v) {
#pragma unroll
    for (int o = 1; o < 64; o <<= 1) v += __shfl_xor(v, o);
    return v;
}

typedef int v8i32 __attribute__((ext_vector_type(8)));
typedef int v4i32 __attribute__((ext_vector_type(4)));
__device__ __forceinline__ v8i32 cat8i(bf16x8 a, bf16x8 b) { const v4i32 x = __builtin_bit_cast(v4i32, a), y = __builtin_bit_cast(v4i32, b); return (v8i32){x[0], x[1], x[2], x[3], y[0], y[1], y[2], y[3]}; }
namespace pg8 {
constexpr int BM = 256, BK = 64, HALF = 128, HTB = HALF * BK * 2, STAGE_BYTES = 8 * HTB, NXCD = 8, WGM = 8;
__host__ __device__ __forceinline__ int lds_byte(int r, int c) { const int st = (r >> 4) * 2 + (c >> 5), rr = r & 15, cc = c & 31, ob = rr * 64 + cc * 2; return st * 1024 + (ob ^ (((ob >> 9) & 1) << 5)); }
__host__ __device__ __forceinline__ void stage_rc(int b, int& R, int& C) { const int st = b / 1024, sb = b % 1024, swz = sb ^ (((sb >> 9) & 1) << 5); R = (st >> 1) * 16 + swz / 64; C = (st & 1) * 32 + (swz % 64) / 2; }
__host__ __device__ __forceinline__ int perm32(int rho) { const int n = rho >> 4, i = rho & 15; return 8 * (i >> 2) + 4 * n + (i & 3); }

struct Unit { int pm, pn, e, lr0, cnt, koff; };
struct Gemm { const bf16_t* A; const bf16_t* Bt; int K; size_t b_estride; const int* gidx; int ld; };

struct StaticOrder {
    int nM, nN, nwg, G, c;
    __device__ __forceinline__ void init(int M, int N, int G_, int c_) { nM = M / BM; nN = N / BM; nwg = nM * nN; G = G_; c = c_; }
    __device__ __forceinline__ bool short_deal() const { const int r = nwg % G; return r != 0 && c >= r; }
    __device__ __forceinline__ bool next(int i, Unit& u) const {
        const long L = (long)i * G + c; if (L >= nwg) return false;
        int wgid = (int)L; { const int q = nwg / NXCD, r = nwg % NXCD, xcd = wgid % NXCD, off = wgid / NXCD; wgid = (xcd < r ? xcd * (q + 1) : r * (q + 1) + (xcd - r) * q) + off; }
        const int nig = WGM * nN, gid = wgid / nig, fm = gid * WGM, gsz = (nM - fm) < WGM ? (nM - fm) : WGM;
        u.pm = fm + ((wgid % nig) % gsz); u.pn = (wgid % nig) / gsz; u.e = 0; u.lr0 = 0; u.cnt = 0; u.koff = 0; return true;
    }
};
struct GroupedOrder {
    int pb[9]; int cnt[8]; int nN, G, c, nwg, np;
    int i0 = 0, i1 = 1 << 30;
    __device__ __forceinline__ void init(const unsigned* counts, int N, int G_, int c_, int pmax = 1 << 30) {
        int acc = 0;
#pragma unroll
        for (int e = 0; e < 8; ++e) { const int n = (int)counts[e]; cnt[e] = n; pb[e] = acc; acc += (n + 255) >> 8; }
        pb[8] = acc; nN = N / BM; G = G_; c = c_; np = acc < pmax ? acc : pmax; nwg = np * nN;
    }
    __device__ __forceinline__ bool short_deal() const { const int r = nwg % G; return r != 0 && c >= r; }
    __device__ __forceinline__ bool next(int i, Unit& u) const {
        if (i + i0 >= i1) return false;
        const long L = (long)(i + i0) * G + c; if (L >= nwg) return false;
        const int nig = WGM * nN, gid = (int)L / nig, fm = gid * WGM, gsz = (np - fm) < WGM ? (np - fm) : WGM;
        const int pm = fm + (((int)L % nig) % gsz), pn = ((int)L % nig) / gsz;
        int e = 0;
#pragma unroll
        for (int k = 1; k < 8; ++k) e += (pm >= pb[k]) ? 1 : 0;
        int pbe = 0, ce = 0;
#pragma unroll
        for (int k = 0; k < 8; ++k) { pbe = (k == e) ? pb[k] : pbe; ce = (k == e) ? cnt[k] : ce; }
        u.pm = pm; u.pn = pn; u.e = e; u.lr0 = (pm - pbe) * 256; u.cnt = ce; u.koff = 0; return true;
    }
};

struct TailOrder {
    int pb[9]; int nN, G, c, nwg, p0, KC, KCH;
    __device__ __forceinline__ void init(const unsigned* counts, int N, int G_, int c_, int p0_, int KC_, int KCH_) {
        int acc = 0;
#pragma unroll
        for (int e = 0; e < 8; ++e) { pb[e] = acc; acc += ((int)counts[e] + 255) >> 8; }
        pb[8] = acc; nN = N / BM; G = G_; c = c_; p0 = p0_; KC = KC_; KCH = KCH_; nwg = acc > p0 ? (acc - p0) * nN * KC : 0;
    }
    __device__ __forceinline__ bool short_deal() const { return false; }
    __device__ __forceinline__ bool next(int i, Unit& u) const {
        const long L = (long)i * G + c; if (L >= nwg) return false;
        const int kc = (int)L % KC, t = (int)L / KC, pm = p0 + t / nN, pn = t % nN;
        int e = 0;
#pragma unroll
        for (int k = 1; k < 8; ++k) e += (pm >= pb[k]) ? 1 : 0;
        u.pm = pm; u.pn = pn; u.e = e; u.lr0 = 0; u.cnt = 0; u.koff = kc * KCH; return true;
    }
};

template <class Epi, class Sched, bool GATHER, bool F8 = false>
__device__ __forceinline__ void gemm_phase(LAS unsigned char* lds, const Gemm g, const Sched& S, const Epi& E) {
    int tid = threadIdx.x; asm volatile("" : "+v"(tid));
    const int wid = __builtin_amdgcn_readfirstlane(tid >> 6), lane = tid & 63, wr = wid >> 2, wc = wid & 3, fr = lane & 15, fq = lane >> 4;
    const int K = g.K, nt = K / BK, LD = g.ld ? g.ld : g.K;
    unsigned voffA[2], voffB[2]; int rA[2];
#pragma unroll
    for (int i = 0; i < 2; ++i) { int R, C; stage_rc(tid * 16 + i * 8192, R, C); const int Rb = Epi::PERM ? ((R & ~31) + perm32(R & 31)) : R;
        voffA[i] = GATHER ? (unsigned)(C * 2) : (unsigned)(R * LD + C) * 2u; voffB[i] = (unsigned)(Rb * LD + C) * 2u; rA[i] = R; }
    const size_t kstep = (size_t)(BK * 2);
    const size_t hstep = (size_t)HALF * LD * 2;
    const size_t tstep = 2 * hstep;
    const unsigned ldsw = (unsigned)wid * 1024u;
    const int aoff = F8 ? lds_byte(wr * 64 + fr, fq * 16) : lds_byte(wr * 64 + fr, fq * 8), boff = F8 ? lds_byte(wc * 32 + fr, fq * 16) : lds_byte(wc * 32 + fr, fq * 8);
    const int aof1 = F8 ? lds_byte(wr * 64 + fr, fq * 16 + 8) : aoff + 1024, bof1 = F8 ? lds_byte(wc * 32 + fr, fq * 16 + 8) : boff + 1024;
#define PG8_SA(b, h) (((b) * 2 + (h)) * HTB)
#define PG8_SB(b, h) ((4 + (b) * 2 + (h)) * HTB)
#define PG8_STAGE2(bufoff, gbase, v0, v1) do { unsigned _a = (v0), _b = (v1); asm volatile("" : "+v"(_a), "+v"(_b));     \
        __builtin_amdgcn_global_load_lds((const unsigned*)((const char*)(gbase) + _a), (LAS unsigned*)(lds + (bufoff) + ldsw), 16, 0, 0); \
        __builtin_amdgcn_global_load_lds((const unsigned*)((const char*)(gbase) + _b), (LAS unsigned*)(lds + (bufoff) + ldsw + 8192), 16, 0, 0); } while (0)
#define PG8_STAGE(bufoff, gbase, voff) PG8_STAGE2(bufoff, gbase, (voff)[0], (voff)[1])
#define PG8_STAGE_A(bufoff, nx, h, kt) do { \
        if constexpr (GATHER) { const char* _p = (const char*)g.A + (size_t)(kt) * kstep; \
            if (nx) { PG8_STAGE2(bufoff, _p, nG[h][0], nG[h][1]); } else { PG8_STAGE2(bufoff, _p, cG[h][0], cG[h][1]); } } \
        else { const char* _p = ((nx) ? nA : cA) + (size_t)(h) * hstep + (size_t)(kt) * kstep; PG8_STAGE2(bufoff, _p, voffA[0], voffA[1]); } } while (0)
#define PG8_LDA(dst, b, h) do { _Pragma("unroll") for (int m = 0; m < 4; ++m) { \
        if constexpr (F8) { dst##8[m].lo = *(const LAS v4i32*)(lds + PG8_SA(b, h) + aoff + m * 2048); dst##8[m].hi = *(const LAS v4i32*)(lds + PG8_SA(b, h) + aof1 + m * 2048); } \
        else { dst[m][0] = *(const LAS bf16x8*)(lds + PG8_SA(b, h) + aoff + m * 2048); dst[m][1] = *(const LAS bf16x8*)(lds + PG8_SA(b, h) + aof1 + m * 2048); } } } while (0)
#define PG8_LDB(dst, b, h) do { _Pragma("unroll") for (int n = 0; n < 2; ++n) { \
        if constexpr (F8) { dst##8[n].lo = *(const LAS v4i32*)(lds + PG8_SB(b, h) + boff + n * 2048); dst##8[n].hi = *(const LAS v4i32*)(lds + PG8_SB(b, h) + bof1 + n * 2048); } \
        else { dst[n][0] = *(const LAS bf16x8*)(lds + PG8_SB(b, h) + boff + n * 2048); dst[n][1] = *(const LAS bf16x8*)(lds + PG8_SB(b, h) + bof1 + n * 2048); } } } while (0)
#define PG8_MMA(ai, bj, At, Bt) do { __builtin_amdgcn_s_setprio(1); _Pragma("unroll") for (int m = 0; m < 4; ++m) _Pragma("unroll") for (int n = 0; n < 2; ++n) { \
        if constexpr (F8) asm volatile("v_mfma_scale_f32_16x16x128_f8f6f4 %0, %1, %2, %0, %3, %3 op_sel_hi:[0,0,0]" : "+v"(acc[ai][bj][m][n]) : "v"(Bt##8[n]), "v"(At##8[m]), "v"(one8));   \
        else { _Pragma("unroll") for (int k = 0; k < 2; ++k) acc[ai][bj][m][n] = __builtin_amdgcn_mfma_f32_16x16x32_bf16(Bt[n][k], At[m][k], acc[ai][bj][m][n], 0, 0, 0); } } __builtin_amdgcn_s_setprio(0); } while (0)
#define PG8_WAIT_V(n) asm volatile("s_waitcnt vmcnt(" #n ")" ::: "memory")
#define PG8_WAIT_L(n) asm volatile("s_waitcnt lgkmcnt(" #n ")" ::: "memory")
#define PG8_BAR __builtin_amdgcn_s_barrier()
#define PG8_SCHED __builtin_amdgcn_sched_barrier(0)
#define PG8_GIDX(dst, u) do { _Pragma("unroll") for (int h = 0; h < 2; ++h) _Pragma("unroll") for (int i = 0; i < 2; ++i) { \
        const int _lr = (u).lr0 + h * HALF + rA[i]; const int _tok = (_lr < (u).cnt) ? g.gidx[(u).e * 16384 + _lr] : 0; dst[h][i] = (unsigned)_tok * (unsigned)(LD * 2) + voffA[i]; } } while (0)
    Unit cur, nxt; int ui = 0;
    if (!S.next(0, cur)) return;
#ifdef STAGGER_TICKS
    if (S.short_deal()) { const unsigned long long t0 = __builtin_amdgcn_s_memrealtime(); while (__builtin_amdgcn_s_memrealtime() - t0 < (unsigned long long)(STAGGER_TICKS)) __builtin_amdgcn_s_sleep(8); }
#endif
    f32x4 acc[2][2][4][2];
#pragma unroll
    for (int a = 0; a < 2; ++a)
#pragma unroll
        for (int b = 0; b < 2; ++b)
#pragma unroll
            for (int m = 0; m < 4; ++m)
#pragma unroll
                for (int n = 0; n < 2; ++n) acc[a][b][m][n] = (f32x4){0.f, 0.f, 0.f, 0.f};
    const int one8 = 0x7f7f7f7f;
    bf16x8 At[4][2], B0[2][2], B1[2][2]; v8i32 At8[4], B08[2], B18[2];
    unsigned cG[2][2] = {{0u, 0u}, {0u, 0u}}, nG[2][2] = {{0u, 0u}, {0u, 0u}};
    const char* cA = (const char*)g.A + (size_t)cur.pm * tstep + (size_t)cur.koff * 2; const char* cB = (const char*)g.Bt + ((size_t)cur.e * g.b_estride + (size_t)cur.koff) * 2 + (size_t)cur.pn * tstep;
    const char* nA = cA;
    if constexpr (GATHER) { PG8_GIDX(cG, cur); }
    PG8_STAGE(PG8_SB(0, 0), cB, voffB); PG8_STAGE(PG8_SB(0, 1), cB + hstep, voffB); PG8_STAGE_A(PG8_SA(0, 0), false, 0, 0); PG8_STAGE_A(PG8_SA(0, 1), false, 1, 0);
    if (wr == 1) PG8_BAR;
    PG8_WAIT_V(2); PG8_BAR;
    PG8_STAGE(PG8_SB(1, 0), cB + kstep, voffB); PG8_STAGE_A(PG8_SA(1, 0), false, 0, 1); PG8_STAGE(PG8_SB(1, 1), cB + hstep + kstep, voffB);
    PG8_WAIT_V(6); PG8_BAR;
    for (;;) {
        const bool has_next = S.next(ui + 1, nxt);
        nA = has_next ? (const char*)g.A + (size_t)nxt.pm * tstep + (size_t)nxt.koff * 2 : cA;
        const char* nB = has_next ? (const char*)g.Bt + ((size_t)nxt.e * g.b_estride + (size_t)nxt.koff) * 2 + (size_t)nxt.pn * tstep : cB;
        if constexpr (GATHER) { if (has_next) { PG8_GIDX(nG, nxt); } else {
#pragma unroll
            for (int h = 0; h < 2; ++h)
#pragma unroll
                for (int i = 0; i < 2; ++i) nG[h][i] = cG[h][i]; } }
#pragma nounroll
        for (int t = 0; t < nt; t += 2) {
            const bool last = (t == nt - 2);
            const int kt2 = last ? 0 : t + 2, kt3 = kt2 + 1;
            const char* b2 = last ? nB : cB + (size_t)(t + 2) * kstep;
            const char* b3 = b2 + kstep;
            PG8_LDB(B0, 0, 0); PG8_LDB(B1, 0, 1); PG8_SCHED; PG8_LDA(At, 0, 0); PG8_STAGE_A(PG8_SA(1, 1), false, 1, t + 1);
            PG8_WAIT_V(8); PG8_WAIT_L(0); PG8_BAR; PG8_MMA(0, 0, At, B0); PG8_MMA(0, 1, At, B1); PG8_BAR; PG8_SCHED;
            PG8_LDA(At, 0, 1); PG8_STAGE(PG8_SB(0, 0), b2, voffB); PG8_STAGE(PG8_SB(0, 1), b2 + hstep, voffB); PG8_STAGE_A(PG8_SA(0, 0), last, 0, kt2);
            PG8_WAIT_V(8); PG8_WAIT_L(0); PG8_BAR; PG8_MMA(1, 0, At, B0); PG8_MMA(1, 1, At, B1); PG8_BAR; PG8_SCHED;
            PG8_LDB(B0, 1, 0); PG8_LDB(B1, 1, 1); PG8_SCHED; PG8_LDA(At, 1, 0); PG8_STAGE_A(PG8_SA(0, 1), last, 1, kt2);
            PG8_WAIT_V(8); PG8_WAIT_L(0); PG8_BAR; PG8_MMA(0, 0, At, B0); PG8_MMA(0, 1, At, B1); PG8_BAR; PG8_SCHED;
            PG8_LDA(At, 1, 1); PG8_STAGE(PG8_SB(1, 0), b3, voffB); PG8_STAGE(PG8_SB(1, 1), b3 + hstep, voffB); PG8_STAGE_A(PG8_SA(1, 0), last, 0, kt3);
            PG8_WAIT_V(8); PG8_WAIT_L(0); PG8_BAR; PG8_MMA(1, 0, At, B0); PG8_MMA(1, 1, At, B1); PG8_BAR; PG8_SCHED;
        }
        if constexpr (F8) asm volatile("s_nop 15\n\ts_nop 15" ::: "memory");
        if (wr == 0) PG8_BAR;
        { Unit eu = cur; eu.pm = __builtin_amdgcn_readfirstlane(eu.pm); eu.pn = __builtin_amdgcn_readfirstlane(eu.pn); asm volatile("" : "+s"(eu.pm), "+s"(eu.pn));
          E(acc, eu, wr, wc, fr, fq);
#ifdef EPI2
          if constexpr (Epi::IDEM) E(acc, eu, wr, wc, fr, fq);
#endif
        }
        if (!has_next) break;
#pragma unroll
        for (int a = 0; a < 2; ++a)
#pragma unroll
            for (int b = 0; b < 2; ++b)
#pragma unroll
                for (int m = 0; m < 4; ++m)
#pragma unroll
                    for (int n = 0; n < 2; ++n) acc[a][b][m][n] = (f32x4){0.f, 0.f, 0.f, 0.f};
        cur = nxt; cA = nA; cB = nB; ++ui;
        if constexpr (GATHER) {
#pragma unroll
            for (int h = 0; h < 2; ++h)
#pragma unroll
                for (int i = 0; i < 2; ++i) cG[h][i] = nG[h][i]; }
        if (wr == 1) PG8_BAR;
    }
    PG8_WAIT_V(0);
    PG8_BAR;
#undef PG8_SA
#undef PG8_SB
#undef PG8_STAGE
#undef PG8_STAGE2
#undef PG8_STAGE_A
#undef PG8_LDA
#undef PG8_LDB
#undef PG8_MMA
#undef PG8_WAIT_V
#undef PG8_WAIT_L
#undef PG8_BAR
#undef PG8_SCHED
#undef PG8_GIDX
}
}
namespace pg8 {
constexpr float QA_SCALE = 0.125f * 1.4426950408889634f;
constexpr float QB_SCALE = 0.125f;

struct EpiInProj {
    static constexpr bool PERM = true, IDEM = true;
    bf16_t* base; WT wt;
    __device__ __forceinline__ void operator()(const f32x4 (&acc)[2][2][4][2], const Unit& u, int wr, int wc, int fr, int fq) const {
        const int pn = u.pn;
        size_t toff; int ld, ct; float sc = 1.f; int act = 0;
        constexpr size_t Mi = 1u << 20;
        if (pn < 2)       { toff = 16 * Mi; ld = 512; ct = pn; sc = QA_SCALE; }
        else if (pn < 4)  { toff = 24 * Mi; ld = 512; ct = pn - 2; }
        else if (pn < 6)  { toff = 32 * Mi; ld = 512; ct = pn - 4; }
        else if (pn < 7)  { toff = 0; ld = 256; ct = 0; sc = QB_SCALE; }
        else if (pn < 8)  { toff = 4 * Mi; ld = 256; ct = 0; }
        else if (pn < 10) { toff = 8 * Mi; ld = 512; ct = pn - 8; }
        else if (pn < 12) { toff = 40 * Mi; ld = 512; ct = pn - 10; act = 1; }
        else if (pn < 16) { toff = 48 * Mi; ld = 1024; ct = pn - 12; act = 2; }
        else              { toff = 64 * Mi; ld = 1024; ct = pn - 16; act = 2; }
        const int row0 = u.pm * BM + wr * 64 + fr, col0 = ct * BM + wc * 32 + 8 * fq;
        bf16_t* O = base + toff;
#pragma unroll
        for (int ai = 0; ai < 2; ++ai)
#pragma unroll
            for (int m = 0; m < 4; ++m) { bf16_t* rowp = O + (size_t)(row0 + ai * HALF + m * 16) * ld + col0;
#pragma unroll
                for (int bj = 0; bj < 2; ++bj) { f32x4 v0 = acc[ai][bj][m][0] * sc, v1 = acc[ai][bj][m][1] * sc;
                    if (act) {
#pragma unroll
                        for (int j = 0; j < 4; ++j) { const float s0 = fast_sigmoid(v0[j]), s1 = fast_sigmoid(v1[j]); v0[j] = (act == 1) ? v0[j] * s0 : s0; v1[j] = (act == 1) ? v1[j] * s1 : s1; } }
                    u32x4 w; w.x = cvt_pk_bf16(v0[0], v0[1]); w.y = cvt_pk_bf16(v0[2], v0[3]); w.z = cvt_pk_bf16(v1[0], v1[1]); w.w = cvt_pk_bf16(v1[2], v1[3]);
                    st16(wt, rowp + bj * HALF, w); } }
    }
};

template <int MODE> struct EpiEw {
    static constexpr bool PERM = true, IDEM = (MODE != 2 && MODE != 4);
    bf16_t* O; const bf16_t* G; int ldc; WT wt; float sc = 1.f;
    __device__ __forceinline__ void operator()(const f32x4 (&acc)[2][2][4][2], const Unit& u, int wr, int wc, int fr, int fq) const {
        const int row0 = u.pm * BM + wr * 64 + fr, col0 = u.pn * BM + wc * 32 + 8 * fq;
#pragma unroll
        for (int ai = 0; ai < 2; ++ai)
#pragma unroll
            for (int m = 0; m < 4; ++m) { const size_t ro = (size_t)(row0 + ai * HALF + m * 16) * ldc + col0;
#pragma unroll
                for (int bj = 0; bj < 2; ++bj) { f32x4 v0 = acc[ai][bj][m][0], v1 = acc[ai][bj][m][1];
                    if (MODE == 0) { v0 = v0 * sc; v1 = v1 * sc; }
                    if (MODE == 1 || MODE == 2) { const u32x4 gw = *(const u32x4*)(G + ro + bj * HALF);
                        v0[0] *= bf_lo(gw.x); v0[1] *= bf_hi(gw.x); v0[2] *= bf_lo(gw.y); v0[3] *= bf_hi(gw.y); v1[0] *= bf_lo(gw.z); v1[1] *= bf_hi(gw.z); v1[2] *= bf_lo(gw.w); v1[3] *= bf_hi(gw.w); }
                    if (MODE == 3) {
#pragma unroll
                        for (int j = 0; j < 4; ++j) { v0[j] = fast_sigmoid(v0[j]); v1[j] = fast_sigmoid(v1[j]); } }
                    if (MODE == 2 || MODE == 4) { const u32x4 ow = *(const u32x4*)(O + ro + bj * HALF);
                        if (MODE == 2) { v0[0] += bf_lo(ow.x); v0[1] += bf_hi(ow.x); v0[2] += bf_lo(ow.y); v0[3] += bf_hi(ow.y); v1[0] += bf_lo(ow.z); v1[1] += bf_hi(ow.z); v1[2] += bf_lo(ow.w); v1[3] += bf_hi(ow.w); }
                        else { v0[0] *= bf_lo(ow.x); v0[1] *= bf_hi(ow.x); v0[2] *= bf_lo(ow.y); v0[3] *= bf_hi(ow.y); v1[0] *= bf_lo(ow.z); v1[1] *= bf_hi(ow.z); v1[2] *= bf_lo(ow.w); v1[3] *= bf_hi(ow.w); } }
                    u32x4 w; w.x = cvt_pk_bf16(v0[0], v0[1]); w.y = cvt_pk_bf16(v0[2], v0[3]); w.z = cvt_pk_bf16(v1[0], v1[1]); w.w = cvt_pk_bf16(v1[2], v1[3]);
                    st16(wt, O + ro + bj * HALF, w); } }
    }
};

struct EpiPart {
    static constexpr bool PERM = true, IDEM = true;
    bf16_t* P; int ldc, p0, KCH; size_t plane; WT wt; float sc = 1.f;
    __device__ __forceinline__ void operator()(const f32x4 (&acc)[2][2][4][2], const Unit& u, int wr, int wc, int fr, int fq) const {
        const int row0 = (u.pm - p0) * BM + wr * 64 + fr, col0 = u.pn * BM + wc * 32 + 8 * fq;
        bf16_t* O = P + (size_t)(u.koff / KCH) * plane;
#pragma unroll
        for (int ai = 0; ai < 2; ++ai)
#pragma unroll
            for (int m = 0; m < 4; ++m) { const size_t ro = (size_t)(row0 + ai * HALF + m * 16) * ldc + col0;
#pragma unroll
                for (int bj = 0; bj < 2; ++bj) { const f32x4 v0 = acc[ai][bj][m][0] * sc, v1 = acc[ai][bj][m][1] * sc;
                    u32x4 w; w.x = cvt_pk_bf16(v0[0], v0[1]); w.y = cvt_pk_bf16(v0[2], v0[3]); w.z = cvt_pk_bf16(v1[0], v1[1]); w.w = cvt_pk_bf16(v1[2], v1[3]);
                    st16(wt, O + ro + bj * HALF, w); } }
    }
};

struct EpiGateUp {
    static constexpr bool PERM = true, IDEM = true;
    bf16_t* O; int ldc; WT wt; float qs;
    __device__ __forceinline__ void operator()(const f32x4 (&acc)[2][2][4][2], const Unit& u, int wr, int wc, int fr, int fq) const {
        const int row0 = u.pm * BM + wr * 64 + fr, col0 = u.pn * HALF + wc * 32 + 8 * fq;
#pragma unroll
        for (int ai = 0; ai < 2; ++ai)
#pragma unroll
            for (int m = 0; m < 4; ++m) { bf16_t* rowp = O + (size_t)(row0 + ai * HALF + m * 16) * ldc + col0;
                f32x4 v0, v1;
#pragma unroll
                for (int j = 0; j < 4; ++j) { const float g0 = acc[ai][0][m][0][j], g1 = acc[ai][0][m][1][j];
                    v0[j] = g0 * fast_sigmoid(g0) * acc[ai][1][m][0][j]; v1[j] = g1 * fast_sigmoid(g1) * acc[ai][1][m][1][j];
#if defined(SIM_FP8) || defined(SIM_FFN0)
                    if (qs != 0.f) { v0[j] = q8(v0[j], qs); v1[j] = q8(v1[j], qs); }
#endif
                }
                u32x4 w; w.x = cvt_pk_bf16(v0[0], v0[1]); w.y = cvt_pk_bf16(v0[2], v0[3]); w.z = cvt_pk_bf16(v1[0], v1[1]); w.w = cvt_pk_bf16(v1[2], v1[3]);
                st16(wt, rowp, w); }
    }
};
struct EpiGateUp8 {
    static constexpr bool PERM = true, IDEM = true;
    unsigned char* O; int ldc; WT wt; float sin, sout;
    __device__ __forceinline__ void operator()(const f32x4 (&acc)[2][2][4][2], const Unit& u, int wr, int wc, int fr, int fq) const {
        const int row0 = u.pm * BM + wr * 64 + fr, col0 = u.pn * HALF + wc * 32 + 8 * fq;
#pragma unroll
        for (int ai = 0; ai < 2; ++ai)
#pragma unroll
            for (int m = 0; m < 4; ++m) { unsigned char* rowp = O + (size_t)(row0 + ai * HALF + m * 16) * ldc + col0;
                f32x4 v0, v1;
#pragma unroll
                for (int j = 0; j < 4; ++j) { const float g0 = acc[ai][0][m][0][j] * sin, g1 = acc[ai][0][m][1][j] * sin;
                    v0[j] = g0 * fast_sigmoid(g0) * (acc[ai][1][m][0][j] * (sin * sout)); v1[j] = g1 * fast_sigmoid(g1) * (acc[ai][1][m][1][j] * (sin * sout)); }
                u32x2 w; w.x = pk4_fp8(v0[0], v0[1], v0[2], v0[3]); w.y = pk4_fp8(v1[0], v1[1], v1[2], v1[3]);
                *(u32x2*)rowp = w; }
    }
};
}
#ifndef MK_DBG
#define MK_DBG 0
#endif
#ifndef MOE_FP8
#define MOE_FP8 1
#endif
constexpr int D = 1024, NB = 8, SEQ = 2048, T = NB * SEQ, DEPTH = 2, CH = 64, NCH = SEQ / CH, NPREV = 8;
constexpr int AH = 8, BH = 4, GR = 16, DFF = 2816, NE = 8, DFE = 3584, PLE = 256, INW = 5136, INWG = 5120, RELN = 257;
constexpr float EPS = 1e-6f, LOG2E = 1.4426950408889634f;
constexpr int NWAVES = 8, NTHR = 512;
constexpr int MOE_ROWS = 34816;

constexpr size_t MiB = 1u << 20;
constexpr size_t WS_CTL = 0, CTL_ZERO_BYTES = 256 * 1024;
constexpr size_t WS_TOKINFO = 1 * MiB;
constexpr size_t WS_IDXE = 2 * MiB;
constexpr size_t WS_DEC = 3 * MiB;
constexpr size_t WS_W1 = 4 * MiB;
constexpr size_t WS_PB = 189 * MiB;
constexpr size_t WS_G = 205 * MiB;
constexpr size_t WS_HB = WS_G, WS_DST = WS_G + 32 * MiB, WS_YSLOT = WS_G;
constexpr size_t WS_BIG = 273 * MiB;
constexpr size_t WS_W0 = WS_BIG, WS_PROJ = WS_BIG + 34 * MiB, WS_MACT = WS_BIG;
constexpr size_t WS_Y = WS_PROJ;
constexpr size_t WS_QB = WS_PROJ, WS_KB = WS_PROJ + 8 * MiB, WS_VB = WS_PROJ + 16 * MiB, WS_QA = WS_PROJ + 32 * MiB, WS_KA = WS_PROJ + 48 * MiB, WS_VA = WS_PROJ + 64 * MiB;
constexpr size_t WS_SR = WS_PROJ + 80 * MiB, WS_SGA = WS_PROJ + 96 * MiB, WS_SGB = WS_PROJ + 128 * MiB;
constexpr size_t WS_MERGED = WS_KA;
constexpr size_t WS_ST = WS_KA;
constexpr size_t WS_FACT = WS_QA;
constexpr size_t WS_YA = WS_PROJ + 160 * MiB, WS_YB = WS_PROJ + 176 * MiB;
constexpr size_t WS_XB = WS_SGB;
constexpr int MOE_MAIN_PANELS = 128, MOE_MAIN_ROWS = MOE_MAIN_PANELS * 256, TAIL_KC = MOE_FP8 ? 7 : 14, TAIL_KCH = 256  , TAIL_ROWS = MOE_ROWS - MOE_MAIN_ROWS;
constexpr size_t WS_END = 511 * MiB;
static_assert(WS_FACT + (size_t)T * DFF * 2 <= WS_XB && WS_MACT + (size_t)MOE_ROWS * DFE * 2 <= WS_END && WS_YSLOT + (size_t)MOE_ROWS * D * 2 <= WS_BIG && WS_SGB + 32 * MiB <= WS_YA && WS_YB + 16 * MiB <= WS_END, "d_ws map");
constexpr size_t OFF_WIN = 0, OFF_WGD = 10 * MiB, OFF_WBA = 10 * MiB + 65536, OFF_WBB = OFF_WBA + 1 * MiB, OFF_WOUT = OFF_WBB + 1 * MiB, OFF_WPP = OFF_WOUT + 2 * MiB, OFF_WPG = OFF_WPP + MiB / 2;
constexpr size_t OFF_FFN = 17 * MiB;
constexpr size_t OFF_FDN = OFF_FFN + 11 * MiB, OFF_MDN = OFF_FFN + 8 * 14 * MiB;
constexpr size_t OFF_MDN8 = OFF_FFN + 8 * 7 * MiB;
constexpr float W8_SCALE = 64.f, ACT8_SCALE = 8.f;
constexpr size_t WS_XS = WS_W1 + OFF_MDN8 + 8 * 7 * MiB / 2;
static_assert(MOE_FP8 && WS_XS + (size_t)T * D * 2 <= WS_PB, "x stream placement needs the e4m3 weight layout");
constexpr size_t WS_PBUF = WS_W1 + OFF_FFN;
static_assert((size_t)TAIL_KC * TAIL_ROWS * D * 2 <= (MOE_FP8 ? 8 * 7 : 8 * 14) * MiB, "partial planes");
static_assert(OFF_WPG + 2 * MiB <= OFF_FFN && WS_W1 + OFF_MDN + 8 * 7 * MiB <= WS_PB && OFF_FDN + (size_t)D * DFF * 2 <= 34 * MiB, "weight map");
constexpr int CW_BAR = 4096;
constexpr int CW_CNT = 8192;
constexpr int CW_DBG = 16384;

constexpr int RING_BYTES = 131072;
constexpr int LDSCTL_OFF = RING_BYTES, MISC_OFF = LDSCTL_OFF + 320;
constexpr int XTRA_OFF = RING_BYTES + 1024;
constexpr int LDS_BYTES = 147456;

typedef GAS unsigned gu32;
#define RLX_AGENT __ATOMIC_RELAXED, __HIP_MEMORY_SCOPE_AGENT
#define LDS_WAIT() asm volatile("s_waitcnt lgkmcnt(0)" ::: "memory")
#define VM_WAIT() asm volatile("s_waitcnt vmcnt(0)" ::: "memory")

#define XB_TMO      128
#define XB_XCNT(j)  (256  + 64 * (j))
#define XB_XSUB(j)  (1280 + 64 * (j))
#define XB_XGEN(j)  (2304 + 64 * (j))
#define XB_TOP      3328
#define XB_TOPGEN   3392
#define XCD_BAR_WORDS 3456
#define XB_SPIN_CAP (1u << 18)
__device__ __forceinline__ unsigned xb_ld(unsigned* p)              { return __hip_atomic_load(p, __ATOMIC_RELAXED, __HIP_MEMORY_SCOPE_AGENT); }
__device__ __forceinline__ unsigned xb_add(unsigned* p, unsigned v) { return __hip_atomic_fetch_add(p, v, __ATOMIC_RELAXED, __HIP_MEMORY_SCOPE_AGENT); }
__device__ __forceinline__ unsigned xb_xcc_id() { return (unsigned)__builtin_amdgcn_s_getreg((3 << 11) | 20) & 0xFu; }
#define XB_SPIN(cond, bar) do { unsigned _sp = 0; while (cond) { __builtin_amdgcn_s_sleep(1); \
    if ((++_sp & 255u) == 0u) { if (xb_ld(&(bar)[XB_TMO])) break; if (_sp > XB_SPIN_CAP) { atomicAdd(&(bar)[XB_TMO], 1u); break; } } } } while (0)
struct XcdBarrier { unsigned* bar; unsigned x; volatile LAS unsigned* st; };
__device__ __forceinline__ XcdBarrier xcd_barrier_post(unsigned* bar, volatile LAS unsigned* st) {
    XcdBarrier b; b.bar = bar; b.x = xb_xcc_id(); b.st = st;
    if (threadIdx.x == 0) (void)xb_add(&bar[XB_XCNT(b.x)], 1u);
    return b;
}
__device__ __forceinline__ void xcd_barrier_complete(unsigned* bar, unsigned x, unsigned& nloc, unsigned& nx) {
    const unsigned G = gridDim.x * gridDim.y * gridDim.z;
    unsigned sum, cnt, mine, sp = 0u;
    for (;;) {
        sum = 0u; cnt = 0u; mine = 0u;
#pragma unroll
        for (unsigned j = 0; j < 16; ++j) { const unsigned c = xb_ld(&bar[XB_XCNT(j)]); sum += c; cnt += (c > 0u) ? 1u : 0u; mine = (j == x) ? c : mine; }
        if (sum == G) break;
        __builtin_amdgcn_s_sleep(1);
        if ((++sp & 255u) == 0u) { if (xb_ld(&bar[XB_TMO])) break; if (sp > XB_SPIN_CAP) { atomicAdd(&bar[XB_TMO], 1u); break; } }
    }
    nloc = mine > 0u ? mine : 1u; nx = cnt > 0u ? cnt : 1u;
}
__device__ __forceinline__ void xcd_barrier(const XcdBarrier& b) {
    asm volatile("s_waitcnt vmcnt(0)" ::: "memory");
    __syncthreads();
    if (threadIdx.x == 0) {
        unsigned* bar = b.bar;
        __builtin_amdgcn_s_waitcnt(0);
        unsigned nloc = b.st[0], nx = b.st[1];
        if (nloc == 0u) { xcd_barrier_complete(bar, b.x, nloc, nx); b.st[0] = nloc; b.st[1] = nx; }
        const unsigned old = xb_add(&bar[XB_XSUB(b.x)], 1u);
        const unsigned gen = old / nloc;
        if (old + 1u == (gen + 1u) * nloc) {
            __builtin_amdgcn_fence(__ATOMIC_RELEASE, "agent");
            asm volatile("s_waitcnt vmcnt(0)" ::: "memory");
            const unsigned og = xb_add(&bar[XB_TOP], 1u);
            const unsigned tg = og / nx;
            if (og + 1u == (tg + 1u) * nx) xb_add(&bar[XB_TOPGEN], 1u);
            else XB_SPIN(xb_ld(&bar[XB_TOPGEN]) == tg, bar);
            __builtin_amdgcn_fence(__ATOMIC_ACQUIRE, "agent");
            xb_add(&bar[XB_XGEN(b.x)], 1u);
            asm volatile("s_waitcnt vmcnt(0)" ::: "memory");
        } else {
            XB_SPIN(xb_ld(&bar[XB_XGEN(b.x)]) == gen, bar);
            __builtin_amdgcn_fence(__ATOMIC_ACQUIRE, "agent");
            asm volatile("s_waitcnt vmcnt(0)" ::: "memory");
        }
    }
    __syncthreads();
}

struct Args { const float* in[24]; float* out; unsigned char* ws; int ph_lo, ph_hi, sub, pad; };
enum { I_X = 0, I_P, I_WIN, I_RELB, I_WGUP, I_BG, I_GNORM, I_WBA, I_WBB, I_WOUT, I_NMPRE, I_NMPOST, I_NFPRE, I_NFPOST, I_FG, I_FU, I_FD, I_RW, I_MG, I_MU, I_MD, I_PP, I_PG, I_PNORM };
#define FRESH(F) do { int _t = threadIdx.x; asm volatile("" : "+v"(_t)); (F).tid = _t; (F).lane = _t & 63; (F).wave = __builtin_amdgcn_readfirstlane(_t >> 6); } while (0)
struct Frame {
    LAS unsigned char* lds;
    volatile LAS unsigned* MISC;
    gu32* ctl;
    unsigned char* ws;
    int tid, lane, wave;
    int vcu, G;
    float* x;
    bf16_t* xs;
};

__device__ __forceinline__ float sumsq16(const f32x4 (&v)[4]) {
    float s = 0.f;
#pragma unroll
    for (int j = 0; j < 4; ++j) s += (v[j].x * v[j].x + v[j].y * v[j].y) + (v[j].z * v[j].z + v[j].w * v[j].w);
    return wave_sum(s);
}
__device__ __forceinline__ void ld_bf16_row(const bf16_t* row, int lane, f32x4 (&v)[4]) {
#pragma unroll
    for (int j = 0; j < 4; ++j) { const u32x2 w = ((const u32x2*)row)[lane + 64 * j]; v[j] = (f32x4){bf_lo(w.x), bf_hi(w.x), bf_lo(w.y), bf_hi(w.y)}; }
}
__device__ __forceinline__ void st_bf16_row(bf16_t* row, int lane, const f32x4 (&v)[4]) {
#pragma unroll
    for (int j = 0; j < 4; ++j) { u32x2 w; w.x = cvt_pk_bf16(v[j].x, v[j].y); w.y = cvt_pk_bf16(v[j].z, v[j].w); ((u32x2*)row)[lane + 64 * j] = w; }
}
__device__ __forceinline__ void ld_moe_row(const unsigned char* ws, int s, int lane, f32x4 (&v)[4]) {
    if (s < MOE_MAIN_ROWS) { ld_bf16_row((const bf16_t*)(ws + WS_YSLOT) + (size_t)s * D, lane, v); return; }
    const bf16_t* p = (const bf16_t*)(ws + WS_PBUF) + (size_t)(s - MOE_MAIN_ROWS) * D;
#pragma unroll
    for (int j = 0; j < 4; ++j) v[j] = (f32x4){0.f, 0.f, 0.f, 0.f};
#pragma unroll 1
    for (int k0 = 0; k0 < TAIL_KC; k0 += 7) {
        u32x2 w[7][4];
#pragma unroll
        for (int q = 0; q < 7; ++q)
#pragma unroll
            for (int j = 0; j < 4; ++j) w[q][j] = ((const u32x2*)(p + (size_t)(k0 + q) * TAIL_ROWS * D))[lane + 64 * j];
#pragma unroll
        for (int q = 0; q < 7; ++q)
#pragma unroll
            for (int j = 0; j < 4; ++j) v[j] = v[j] + (f32x4){bf_lo(w[q][j].x), bf_hi(w[q][j].x), bf_lo(w[q][j].y), bf_hi(w[q][j].y)};
    }
}
template <int SRC, int OUT, bool ROUTE>
__device__ __forceinline__ void thin_phase(Frame& F, const float* xin, const bf16_t* ysrc, const float* g_add, const float* g_out, bf16_t* obuf, const float* router_w) {
    FRESH(F);
    const int lane = F.lane;
    unsigned* tokinfo = (unsigned*)(F.ws + WS_TOKINFO);
    int* idxe = (int*)(F.ws + WS_IDXE);
    unsigned* gcnt = (unsigned*)(F.ctl + CW_CNT);
    LAS float* rwT = (LAS float*)(F.lds);
    LAS unsigned* lcnt = (LAS unsigned*)(F.lds + 32768);
    LAS unsigned* rinfo = (LAS unsigned*)(F.lds + 32768 + 64);
    if constexpr (ROUTE) {
        for (int i = F.tid; i < D * NE; i += NTHR) rwT[(i & 7) * D + (i >> 3)] = router_w[i];
        if (F.tid < 16) lcnt[F.tid] = 0u;
        __syncthreads();
    }
    int pbase[8];
    if constexpr (SRC == 2) { int acc = 0;
#pragma unroll
        for (int e = 0; e < 8; ++e) { pbase[e] = acc; acc += (((int)gcnt[e] + 255) >> 8) << 8; } }
    f32x4 ga[4], go[4];
#pragma unroll
    for (int j = 0; j < 4; ++j) { ga[j] = (SRC != 0) ? ((const f32x4*)g_add)[lane + 64 * j] : (f32x4){0.f, 0.f, 0.f, 0.f}; go[j] = (OUT == 1) ? ((const f32x4*)g_out)[lane + 64 * j] : (f32x4){0.f, 0.f, 0.f, 0.f}; }
    const int gw = F.vcu * NWAVES + F.wave, NGW = F.G * NWAVES;
    int rs = 0;
#ifdef THIN_PF
    f32x4 nxf[4]; u32x2 nxb[4], nyb[4];
#define THIN_LOAD(mm) do { const int m_ = (mm); \
        if (SRC == 0 || xin != nullptr) { _Pragma("unroll") for (int j = 0; j < 4; ++j) nxf[j] = ((const f32x4*)(xin + (size_t)m_ * D))[lane + 64 * j]; } \
        else { _Pragma("unroll") for (int j = 0; j < 4; ++j) nxb[j] = ((const u32x2*)(F.xs + (size_t)m_ * D))[lane + 64 * j]; } \
        if (SRC == 1) { _Pragma("unroll") for (int j = 0; j < 4; ++j) nyb[j] = ((const u32x2*)(ysrc + (size_t)m_ * D))[lane + 64 * j]; } } while (0)
    if (gw < T) THIN_LOAD(gw);
#endif
    for (int m = gw; m < T; m += NGW, ++rs) {
        f32x4 xv[4];
#ifdef THIN_PF
        f32x4 cxf[4]; u32x2 cxb[4], cyb[4];
#pragma unroll
        for (int j = 0; j < 4; ++j) { cxf[j] = nxf[j]; cxb[j] = nxb[j]; cyb[j] = nyb[j]; }
        if (m + NGW < T) THIN_LOAD(m + NGW);
#endif
        if constexpr (SRC == 0) {
#pragma unroll
#ifdef THIN_PF
            for (int j = 0; j < 4; ++j) xv[j] = cxf[j];
#else
            for (int j = 0; j < 4; ++j) xv[j] = ((const f32x4*)(xin + (size_t)m * D))[lane + 64 * j];
#endif
        } else {
            f32x4 yv[4];
#ifdef THIN_PF
            if constexpr (SRC == 1) {
#pragma unroll
                for (int j = 0; j < 4; ++j) yv[j] = (f32x4){bf_lo(cyb[j].x), bf_hi(cyb[j].x), bf_lo(cyb[j].y), bf_hi(cyb[j].y)}; }
#else
            if constexpr (SRC == 1) ld_bf16_row(ysrc + (size_t)m * D, lane, yv);
#endif
            else {
                const unsigned* ti = tokinfo + (size_t)m * 8;
                const int e1 = (int)ti[0], p1 = (int)ti[1], e2 = (int)ti[2], p2 = (int)ti[3]; const float w1 = __uint_as_float(ti[4]), w2 = __uint_as_float(ti[5]);
                int b1 = 0, b2 = 0;
#pragma unroll
                for (int e = 0; e < 8; ++e) { b1 = (e == e1) ? pbase[e] : b1; b2 = (e == e2) ? pbase[e] : b2; }
                f32x4 ya[4], yb[4];
                ld_moe_row(F.ws, b1 + p1, lane, ya); ld_moe_row(F.ws, b2 + p2, lane, yb);
#pragma unroll
                for (int j = 0; j < 4; ++j) yv[j] = ya[j] * w1 + yb[j] * w2;
            }
            const float rstd = __builtin_amdgcn_rsqf(sumsq16(yv) * (1.f / D) + EPS);
#ifdef THIN_PF
            if (xin) {
#pragma unroll
                for (int j = 0; j < 4; ++j) xv[j] = cxf[j] + yv[j] * rstd * ga[j];
            } else {
#pragma unroll
                for (int j = 0; j < 4; ++j) xv[j] = (f32x4){bf_lo(cxb[j].x), bf_hi(cxb[j].x), bf_lo(cxb[j].y), bf_hi(cxb[j].y)} + yv[j] * rstd * ga[j]; }
#else
            if (xin) {
#pragma unroll
                for (int j = 0; j < 4; ++j) { const f32x4 xo = ((const f32x4*)(xin + (size_t)m * D))[lane + 64 * j]; xv[j] = xo + yv[j] * rstd * ga[j]; }
            } else { f32x4 xo[4]; ld_bf16_row(F.xs + (size_t)m * D, lane, xo);
#pragma unroll
                for (int j = 0; j < 4; ++j) xv[j] = xo[j] + yv[j] * rstd * ga[j]; }
#endif
        }
#ifdef SIM_XBF16
        if constexpr (SRC != 0 && OUT != 0) {
#pragma unroll
            for (int j = 0; j < 4; ++j) { const unsigned a = cvt_pk_bf16(xv[j].x, xv[j].y), b = cvt_pk_bf16(xv[j].z, xv[j].w); xv[j] = (f32x4){bf_lo(a), bf_hi(a), bf_lo(b), bf_hi(b)}; } }
#endif
        if constexpr (SRC != 0) {
#pragma unroll
            for (int j = 0; j < 4; ++j) { if constexpr (OUT == 0) ((f32x4*)(F.x + (size_t)m * D))[lane + 64 * j] = xv[j]; }
            if constexpr (OUT != 0) st_bf16_row(F.xs + (size_t)m * D, lane, xv); }
        if constexpr (OUT == 1) {
            const float rstd = __builtin_amdgcn_rsqf(sumsq16(xv) * (1.f / D) + EPS);
            f32x4 hv[4];
#pragma unroll
            for (int j = 0; j < 4; ++j) hv[j] = xv[j] * rstd * go[j];
#ifdef SIM_FFN0
            if (!ROUTE && xin != nullptr) {
#pragma unroll
                for (int j = 0; j < 4; ++j) hv[j] = (f32x4){q8(hv[j].x, 1.f), q8(hv[j].y, 1.f), q8(hv[j].z, 1.f), q8(hv[j].w, 1.f)}; }
#endif
#if MOE_FP8
            if constexpr (ROUTE) {
#pragma unroll
                for (int j = 0; j < 4; ++j) ((unsigned*)((unsigned char*)obuf + (size_t)m * D))[lane + 64 * j] = pk4_fp8(hv[j].x, hv[j].y, hv[j].z, hv[j].w);
            } else
#elif defined(SIM_FP8)
            if constexpr (ROUTE) { f32x4 hq[4];
#pragma unroll
                for (int j = 0; j < 4; ++j) hq[j] = (f32x4){q8(hv[j].x, 1.f), q8(hv[j].y, 1.f), q8(hv[j].z, 1.f), q8(hv[j].w, 1.f)};
                st_bf16_row(obuf + (size_t)m * D, lane, hq); } else
#endif

            st_bf16_row(obuf + (size_t)m * D, lane, hv);
            if constexpr (ROUTE) {
                float lg[8];
#pragma unroll
                for (int e = 0; e < 8; ++e) { float s = 0.f;
#pragma unroll
                    for (int j = 0; j < 4; ++j) { const f32x4 w = *(const LAS f32x4*)(rwT + e * D + 4 * lane + 256 * j); s += (hv[j].x * w.x + hv[j].y * w.y) + (hv[j].z * w.z + hv[j].w * w.w); }
                    lg[e] = wave_sum(s); }
                int e1 = 0; float v1 = lg[0];
#pragma unroll
                for (int e = 1; e < 8; ++e) if (lg[e] > v1) { v1 = lg[e]; e1 = e; }
                int e2 = -1; float v2 = -3.0e38f;
#pragma unroll
                for (int e = 0; e < 8; ++e) if (e != e1 && lg[e] > v2) { v2 = lg[e]; e2 = e; }
                const float ex = __expf(v2 - v1), w1 = 1.f / (1.f + ex), w2 = ex * w1;
                if (lane == 0) {
                    const unsigned p1 = atomicAdd((unsigned*)&lcnt[e1], 1u), p2 = atomicAdd((unsigned*)&lcnt[e2], 1u);
                    LAS unsigned* ri = rinfo + (F.wave * 8 + rs) * 6;
                    ri[0] = (unsigned)e1; ri[1] = p1; ri[2] = (unsigned)e2; ri[3] = p2; ri[4] = __float_as_uint(w1); ri[5] = __float_as_uint(w2);
                }
            }
        }
    }
    if constexpr (ROUTE) {
        __syncthreads();
        if (F.tid < 8) lcnt[8 + F.tid] = __hip_atomic_fetch_add(gcnt + F.tid, lcnt[F.tid], RLX_AGENT);
        __syncthreads();
        if (lane < rs) {
            const int m = gw + lane * NGW; const LAS unsigned* ri = rinfo + (F.wave * 8 + lane) * 6;
            const unsigned e1 = ri[0], e2 = ri[2]; const unsigned p1 = ri[1] + lcnt[8 + e1], p2 = ri[3] + lcnt[8 + e2];
            unsigned* ti = tokinfo + (size_t)m * 8; ti[0] = e1; ti[1] = p1; ti[2] = e2; ti[3] = p2; ti[4] = ri[4]; ti[5] = ri[5];
            idxe[e1 * 16384 + p1] = m; idxe[e2 * 16384 + p2] = m;
        }
    }
}
#if defined(SIM_FP8) || defined(SIM_FFN0)
#define SIMQ(x, s) (((s) != 0.f) ? q8((x), (s)) : (x))
#else
#define SIMQ(x, s) (x)
#endif
struct TrItem { const float* src; int pitch; bf16_t* dst; int dstK; int ncols; float qs; int f8; };
#ifdef TR_NT
#define TR_LD(p) __builtin_nontemporal_load(p)
#else
#define TR_LD(p) (*(p))
#endif
#define TR_LOAD(t, v) do { _Pragma("unroll") for (int i = 0; i < 64; ++i) { const int kk = 2 * i + (lane >> 5); v[i] = ((lane & 31) < (t).ncols) ? TR_LD((t).src + (size_t)kk * (t).pitch + (lane & 31)) : 0.f; } } while (0)
__device__ __forceinline__ void tr_finish(const TrItem& t, float (&v)[64], LAS float* scr, int lane, bool nostore = false) {
    const int c = lane & 31;
#pragma unroll
    for (int p = 0; p < 2; ++p) {
#pragma unroll
        for (int i = 0; i < 32; ++i) { const int kk = 2 * i + (lane >> 5); scr[kk * 33 + c] = SIMQ(v[32 * p + i], t.qs); }
        LDS_WAIT(); asm volatile("" ::: "memory");
        if (t.f8) {
            const int c4 = lane & 3;
#pragma unroll
            for (int j = 0; j < 2; ++j) { const int n = (lane >> 2) + 16 * j; const LAS float* s = scr + (16 * c4) * 33 + n;
                u32x4 o; o.x = pk4_fp8(s[0 * 33] * W8_SCALE, s[1 * 33] * W8_SCALE, s[2 * 33] * W8_SCALE, s[3 * 33] * W8_SCALE); o.y = pk4_fp8(s[4 * 33] * W8_SCALE, s[5 * 33] * W8_SCALE, s[6 * 33] * W8_SCALE, s[7 * 33] * W8_SCALE);
                o.z = pk4_fp8(s[8 * 33] * W8_SCALE, s[9 * 33] * W8_SCALE, s[10 * 33] * W8_SCALE, s[11 * 33] * W8_SCALE); o.w = pk4_fp8(s[12 * 33] * W8_SCALE, s[13 * 33] * W8_SCALE, s[14 * 33] * W8_SCALE, s[15 * 33] * W8_SCALE);
                if (!nostore) *(u32x4*)((unsigned char*)t.dst + (size_t)n * t.dstK + 64 * p + 16 * c4) = o; }
        } else {
            const int c8 = lane & 7;
#pragma unroll
            for (int j = 0; j < 4; ++j) { const int n = (lane >> 3) + 8 * j; const LAS float* s = scr + (8 * c8) * 33 + n;
                u32x4 o; o.x = cvt_pk_bf16(s[0 * 33], s[1 * 33]); o.y = cvt_pk_bf16(s[2 * 33], s[3 * 33]); o.z = cvt_pk_bf16(s[4 * 33], s[5 * 33]); o.w = cvt_pk_bf16(s[6 * 33], s[7 * 33]);
                if (n < t.ncols && !nostore) *(u32x4*)(t.dst + (size_t)n * t.dstK + 64 * p + 8 * c8) = o; }
        }
        LDS_WAIT(); asm volatile("" ::: "memory");
    }
}
constexpr int IT_COMMON = 640 + 640 + 8 + 128 + 128 + 256 + 64 + 256;
constexpr int IT_FFN = 3 * 704, IT_MOE1 = 8 * 896;
constexpr int IT_TOTAL = 2 * IT_COMMON + IT_FFN + 3 * IT_MOE1;
__device__ __forceinline__ TrItem seg_plain(const float* src, int K, int N, int pitch, bf16_t* dst, int r) {
#ifdef TR_NFAST
    const int nnb = N / 32, kb = r / nnb, nb = r % nnb;
#else
    const int nkb = K / 128, nb = r / nkb, kb = r % nkb;
#endif
    return TrItem{src + (size_t)kb * 128 * pitch + nb * 32, pitch, dst + (size_t)(nb * 32) * K + kb * 128, K, 32, 0.f, 0};
}
__device__ __forceinline__ TrItem seg_gu(const float* src, int N, bf16_t* dst, int up, int r) {
#ifdef TR_NFAST
    const int kb = r / (N / 32), nb = r % (N / 32), n0 = nb * 32;
#else
    const int nb = r / (D / 128), kb = r % (D / 128), n0 = nb * 32;
#endif
    return TrItem{src + (size_t)kb * 128 * N + n0, N, dst + (size_t)((n0 >> 7) * 256 + (n0 & 127) + up * 128) * D + kb * 128, D, 32, 0.f, 0};
}
__device__ __forceinline__ TrItem decode_item(const Args& a, unsigned char* ws, int it) {
    if (it < 2 * IT_COMMON) {
        const int l = it / IT_COMMON; int r = it % IT_COMMON; unsigned char* wb = ws + (l ? WS_W1 : WS_W0);
        const float* win = a.in[I_WIN] + (size_t)l * D * INW;
        if (r < 640) return seg_plain(win, D, 2560, INW, (bf16_t*)(wb + OFF_WIN), r); r -= 640;
        if (r < 640) return seg_plain(win + 2576, D, 2560, INW, (bf16_t*)(wb + OFF_WIN) + (size_t)2560 * D, r); r -= 640;
        if (r < 8) return TrItem{win + (size_t)r * 128 * INW + 2560, INW, (bf16_t*)(wb + OFF_WGD) + r * 128, D, 16, 0.f, 0}; r -= 8;
        if (r < 128) return seg_plain(a.in[I_WBA] + (size_t)l * 512 * D, 512, D, D, (bf16_t*)(wb + OFF_WBA), r); r -= 128;
        if (r < 128) return seg_plain(a.in[I_WBB] + (size_t)l * 512 * D, 512, D, D, (bf16_t*)(wb + OFF_WBB), r); r -= 128;
        if (r < 256) return seg_plain(a.in[I_WOUT] + (size_t)l * D * D, D, D, D, (bf16_t*)(wb + OFF_WOUT), r); r -= 256;
        if (r < 64) return seg_plain(a.in[I_PP] + (size_t)l * PLE * D, PLE, D, D, (bf16_t*)(wb + OFF_WPP), r); r -= 64;
        return seg_plain(a.in[I_PG] + (size_t)l * D * D, D, D, D, (bf16_t*)(wb + OFF_WPG), r);
    }
    it -= 2 * IT_COMMON;
    if (it < IT_FFN) {
        unsigned char* wb = ws + WS_W0;
        TrItem t;
        if (it < 704) t = seg_gu(a.in[I_FG], DFF, (bf16_t*)(wb + OFF_FFN), 0, it);
        else if (it < 1408) t = seg_gu(a.in[I_FU], DFF, (bf16_t*)(wb + OFF_FFN), 1, it - 704);
        else t = seg_plain(a.in[I_FD], DFF, D, D, (bf16_t*)(wb + OFF_FDN), it - 1408);
#ifdef SIM_FFN0
        t.qs = 64.f;
#endif
        return t;
    }
    it -= IT_FFN;
    unsigned char* wb = ws + WS_W1;
    const int kind = it / IT_MOE1, r0 = it % IT_MOE1, e = r0 / 896, r = r0 % 896;
    TrItem t;
#if MOE_FP8
    {
#ifdef TR_NFAST
      const int nnb8 = (kind == 2 ? D : DFE) / 32, kb8 = r / nnb8, nb8 = r % nnb8, n0 = nb8 * 32;
#else
      const int nkb8 = (kind == 2 ? DFE : D) / 128, nb8 = r / nkb8, kb8 = r % nkb8, n0 = nb8 * 32;
#endif
      if (kind == 2) return TrItem{a.in[I_MD] + (size_t)e * DFE * D + (size_t)kb8 * 128 * D + n0, D, (bf16_t*)(wb + OFF_MDN8 + (size_t)e * D * DFE + (size_t)n0 * DFE + kb8 * 128), DFE, 32, 0.f, 1};
      const float* src = (kind == 0 ? a.in[I_MG] : a.in[I_MU]) + (size_t)e * D * DFE + (size_t)kb8 * 128 * DFE + n0;
      return TrItem{src, DFE, (bf16_t*)(wb + OFF_FFN + (size_t)e * 7168 * D + (size_t)((n0 >> 7) * 256 + (n0 & 127) + (kind == 1 ? 128 : 0)) * D + kb8 * 128), D, 32, 0.f, 1}; }
#endif
    if (kind == 0) t = seg_gu(a.in[I_MG] + (size_t)e * D * DFE, DFE, (bf16_t*)(wb + OFF_FFN) + (size_t)e * 7168 * D, 0, r);
    else if (kind == 1) t = seg_gu(a.in[I_MU] + (size_t)e * D * DFE, DFE, (bf16_t*)(wb + OFF_FFN) + (size_t)e * 7168 * D, 1, r);
    else t = seg_plain(a.in[I_MD] + (size_t)e * DFE * D, DFE, D, D, (bf16_t*)(wb + OFF_MDN) + (size_t)e * D * DFE, r);
#ifdef SIM_FP8
    t.qs = 64.f;
#endif
    return t;
}
__device__ __forceinline__ void p0_prologue(Frame& F, const Args& a, int probe = 0) {
    FRESH(F);
    LAS float* scr = (LAS float*)(F.lds + F.wave * 16384);
    const int gw = F.vcu * NWAVES + F.wave, NGW = F.G * NWAVES;
    { const int lane = F.lane;
      for (int it = gw; it < IT_TOTAL; it += NGW) { const TrItem t = decode_item(a, F.ws, it); float v[64]; TR_LOAD(t, v); tr_finish(t, v, scr, lane, probe == 1); } }
    if (probe) return;
    { const f32x4* ps = (const f32x4*)a.in[I_P]; u32x4* pd = (u32x4*)(F.ws + WS_PB); const int n8 = 2 * T * PLE / 8;
      for (int i = blockIdx.x * NTHR + F.tid; i < n8; i += F.G * NTHR) { const f32x4 v0 = ps[2 * i], v1 = ps[2 * i + 1];
          u32x4 w; w.x = cvt_pk_bf16(v0.x, v0.y); w.y = cvt_pk_bf16(v0.z, v0.w); w.z = cvt_pk_bf16(v1.x, v1.y); w.w = cvt_pk_bf16(v1.z, v1.w); pd[i] = w; } }
    thin_phase<0, 1, false>(F, a.in[I_X], nullptr, nullptr, a.in[I_NMPRE], (bf16_t*)(F.ws + WS_HB), nullptr);
}
typedef short v4i16_t __attribute__((ext_vector_type(4)));
__device__ __forceinline__ s16x4 lds_tr16(const LAS unsigned char* p) { return __builtin_bit_cast(s16x4, __builtin_amdgcn_ds_read_tr16_b64_v4i16((LAS v4i16_t*)p)); }
__device__ __forceinline__ bf16x8 cat8(s16x4 a, s16x4 b) { return (bf16x8){a[0], a[1], a[2], a[3], b[0], b[1], b[2], b[3]}; }

__device__ __forceinline__ void attn_unit(Frame& F, int b, int c, const float* relb) {
    FRESH(F);
    const int lane = F.lane, h = F.wave, n = lane & 15, mq = lane >> 4;
    const bf16_t* qa = (const bf16_t*)(F.ws + WS_QA); const bf16_t* ka = (const bf16_t*)(F.ws + WS_KA); const bf16_t* va = (const bf16_t*)(F.ws + WS_VA);
    LAS unsigned char* kbuf = F.lds + h * 16384; LAS unsigned char* vbuf = kbuf + 8192;
    LAS float* rt = (LAS float*)(F.lds + XTRA_OFF + h * 1056);
    for (int i = lane; i < 256; i += 64) { const int j = i - 64; rt[i] = relb[h * RELN + 256 - (j > 0 ? j : 0)] * LOG2E; }
    const float bfar = relb[h * RELN + 256] * LOG2E;
    const int tok0 = b * SEQ + c * CH;
    bf16x8 qf[4][2];
#pragma unroll
    for (int qt = 0; qt < 4; ++qt)
#pragma unroll
        for (int ks = 0; ks < 2; ++ks) qf[qt][ks] = *(const bf16x8*)(qa + (size_t)(tok0 + 16 * qt + n) * 512 + h * 64 + 32 * ks + 8 * mq);
    const int koff_e = (lane >> 3) * 512 + (((lane & 7) ^ ((lane >> 4) & 7)) * 8), koff_o = (lane >> 3) * 512 + (((lane & 7) ^ ((4 + (lane >> 4)) & 7)) * 8);
    const int voff = (lane >> 3) * 512 + ((2 * (((lane & 7) >> 1) ^ (lane >> 4)) + (lane & 1)) * 8);
#define ATT_DMA_K(j) do { const bf16_t* _s = ka + (size_t)(b * SEQ + (j) * CH) * 512 + h * 64; _Pragma("unroll") for (int _i = 0; _i < 8; ++_i) \
        __builtin_amdgcn_global_load_lds((const unsigned*)(_s + (size_t)_i * 8 * 512 + ((_i & 1) ? koff_o : koff_e)), (LAS unsigned*)(kbuf + _i * 1024), 16, 0, 0); } while (0)
#define ATT_DMA_V(j) do { const bf16_t* _s = va + (size_t)(b * SEQ + (j) * CH) * 512 + h * 64; _Pragma("unroll") for (int _i = 0; _i < 8; ++_i) \
        __builtin_amdgcn_global_load_lds((const unsigned*)(_s + (size_t)_i * 8 * 512 + voff), (LAS unsigned*)(vbuf + _i * 1024), 16, 0, 0); } while (0)
    const int ka0 = n * 128 + (((0 + mq) ^ (n >> 1)) * 16), ka1 = n * 128 + (((4 + mq) ^ (n >> 1)) * 16);
    const int qp = n >> 2, pp = lane & 3, sw = 2 * (mq & 1) + (qp >> 1);
    const int vrow = (4 * mq + qp) * 128 + 8 * pp;
    f32x4 O[4][4]; float mrun[4], lsum[4];
#pragma unroll
    for (int qt = 0; qt < 4; ++qt) { mrun[qt] = -1.0e30f; lsum[qt] = 0.f;
#pragma unroll
        for (int dt = 0; dt < 4; ++dt) O[qt][dt] = (f32x4){0.f, 0.f, 0.f, 0.f}; }
    const int j0 = (c - NPREV) > 0 ? (c - NPREV) : 0;
    ATT_DMA_K(j0); ATT_DMA_V(j0);
    for (int j = j0; j <= c; ++j) {
        const int dc = c - j;
        asm volatile("s_waitcnt vmcnt(8)" ::: "memory");
#pragma unroll
        for (int qg = 0; qg < 2; ++qg) {
            f32x4 S[4][2];
#pragma unroll
            for (int kt = 0; kt < 4; ++kt) {
                const bf16x8 k0 = *(const LAS bf16x8*)(kbuf + kt * 2048 + ka0), k1 = *(const LAS bf16x8*)(kbuf + kt * 2048 + ka1);
#pragma unroll
                for (int q2 = 0; q2 < 2; ++q2) { f32x4 z = (f32x4){0.f, 0.f, 0.f, 0.f};
                    z = __builtin_amdgcn_mfma_f32_16x16x32_bf16(k0, qf[2 * qg + q2][0], z, 0, 0, 0);
                    S[kt][q2] = __builtin_amdgcn_mfma_f32_16x16x32_bf16(k1, qf[2 * qg + q2][1], z, 0, 0, 0); }
            }
            if (qg == 1) { if (j < c) { LDS_WAIT(); ATT_DMA_K(j + 1); } }
            bf16x8 P[2][2];
#pragma unroll
            for (int q2 = 0; q2 < 2; ++q2) { const int qt = 2 * qg + q2;
                if (dc >= 3) {
                    asm volatile("" ::: "memory");
#pragma unroll
                    for (int kt = 0; kt < 4; ++kt) S[kt][q2] = S[kt][q2] + bfar;
                } else {
                    asm volatile("" ::: "memory");
                    const LAS float* rp = rt + (64 + 128 - (64 * dc + 16 * qt + n - 4 * mq));
                    float bv[4][4];
#pragma unroll
                    for (int kt = 0; kt < 4; ++kt)
#pragma unroll
                        for (int i = 0; i < 4; ++i) bv[kt][i] = rp[16 * kt + i];
#pragma unroll
                    for (int kt = 0; kt < 4; ++kt)
#pragma unroll
                        for (int i = 0; i < 4; ++i) S[kt][q2][i] += bv[kt][i];
                }
                float cm = S[0][q2][0];
#pragma unroll
                for (int kt = 0; kt < 4; ++kt)
#pragma unroll
                    for (int i = 0; i < 4; ++i) cm = fmaxf(cm, S[kt][q2][i]);
                cm = fmaxf(cm, __shfl_xor(cm, 16)); cm = fmaxf(cm, __shfl_xor(cm, 32));
                const float mn = fmaxf(mrun[qt], cm), alpha = __builtin_amdgcn_exp2f(mrun[qt] - mn); mrun[qt] = mn;
                float ps = 0.f;
#pragma unroll
                for (int kt = 0; kt < 4; ++kt)
#pragma unroll
                    for (int i = 0; i < 4; ++i) { const float p = __builtin_amdgcn_exp2f(S[kt][q2][i] - mn); S[kt][q2][i] = p; ps += p; }
                lsum[qt] = lsum[qt] * alpha + ps;
#pragma unroll
                for (int dt = 0; dt < 4; ++dt) O[qt][dt] = O[qt][dt] * alpha;
#pragma unroll
                for (int u = 0; u < 2; ++u) { u32x4 w; w.x = cvt_pk_bf16(S[2 * u][q2][0], S[2 * u][q2][1]); w.y = cvt_pk_bf16(S[2 * u][q2][2], S[2 * u][q2][3]);
                    w.z = cvt_pk_bf16(S[2 * u + 1][q2][0], S[2 * u + 1][q2][1]); w.w = cvt_pk_bf16(S[2 * u + 1][q2][2], S[2 * u + 1][q2][3]); P[q2][u] = __builtin_bit_cast(bf16x8, w); }
            }
            if (qg == 0) asm volatile("s_waitcnt vmcnt(0)" ::: "memory");
#pragma unroll
            for (int dt = 0; dt < 4; ++dt)
#pragma unroll
                for (int u = 0; u < 2; ++u) {
                    const LAS unsigned char* vp = vbuf + vrow + (32 * u) * 128 + ((dt ^ sw) * 32);
                    const bf16x8 vf = cat8(lds_tr16(vp), lds_tr16(vp + 16 * 128));
#pragma unroll
                    for (int q2 = 0; q2 < 2; ++q2) O[2 * qg + q2][dt] = __builtin_amdgcn_mfma_f32_16x16x32_bf16(vf, P[q2][u], O[2 * qg + q2][dt], 0, 0, 0);
                }
            if (qg == 1) { if (j < c) { LDS_WAIT(); ATT_DMA_V(j + 1); } }
        }
    }
#undef ATT_DMA_K
#undef ATT_DMA_V
    bf16_t* ya = (bf16_t*)(F.ws + WS_YA);
#pragma unroll
    for (int qt = 0; qt < 4; ++qt) { float l = lsum[qt]; l += __shfl_xor(l, 16); l += __shfl_xor(l, 32); const float rl = __builtin_amdgcn_rcpf(l);
#pragma unroll
        for (int dt = 0; dt < 4; ++dt) { const f32x4 o = O[qt][dt] * rl; u32x2 w; w.x = cvt_pk_bf16(o[0], o[1]); w.y = cvt_pk_bf16(o[2], o[3]);
            *(u32x2*)(ya + (size_t)(tok0 + 16 * qt + n) * 512 + h * 64 + 16 * dt + 4 * mq) = w; } }
}

__device__ __forceinline__ void gla_dstate_unit(Frame& F, int b, int c, const bf16_t* wgd_t, const float* wup, const float* bgate) {
    FRESH(F);
    const int lane = F.lane, w = F.wave, tid = F.tid, n = lane & 15, mq = lane >> 4;
    const int tok0 = b * SEQ + c * CH;
    const bf16_t* hb = (const bf16_t*)(F.ws + WS_HB); const bf16_t* kb = (const bf16_t*)(F.ws + WS_KB); const bf16_t* vb = (const bf16_t*)(F.ws + WS_VB);
    LAS float* GD8 = (LAS float*)(F.lds); LAS unsigned char* VB = F.lds + 32768; LAS unsigned char* KD = F.lds + 98304;
    LAS float* GDF = (LAS float*)(F.lds + XTRA_OFF); LAS float* TOT = (LAS float*)(F.lds + XTRA_OFF + 4096);
    __syncthreads();
    const int col = tid & 255, hf = tid >> 8;
    float wu[16];
#pragma unroll
    for (int r = 0; r < 16; ++r) wu[r] = wup[r * 256 + col];
    const float bb = bgate[col];
    unsigned short kraw[32];
#pragma unroll
    for (int l = 0; l < 32; ++l) kraw[l] = kb[(size_t)(tok0 + 32 * hf + l) * 256 + col];
#pragma unroll
    for (int i = 0; i < 8; ++i) { const int p = (w * 8 + i) * 64 + lane, row = p >> 6, ch = p & 63;
        __builtin_amdgcn_global_load_lds((const unsigned*)(vb + (size_t)(tok0 + row) * 512 + ch * 8), (LAS unsigned*)(VB + (w * 8 + i) * 1024), 16, 0, 0); }
    { bf16x8 af[4][4], bf[4];
#pragma unroll
      for (int ks = 0; ks < 4; ++ks) { bf[ks] = *(const bf16x8*)(wgd_t + (size_t)n * D + 128 * w + 32 * ks + 8 * mq);
#pragma unroll
          for (int mt = 0; mt < 4; ++mt) af[mt][ks] = *(const bf16x8*)(hb + (size_t)(tok0 + 16 * mt + n) * D + 128 * w + 32 * ks + 8 * mq); }
#pragma unroll
      for (int mt = 0; mt < 4; ++mt) { f32x4 acc = (f32x4){0.f, 0.f, 0.f, 0.f};
#pragma unroll
          for (int ks = 0; ks < 4; ++ks) acc = __builtin_amdgcn_mfma_f32_16x16x32_bf16(af[mt][ks], bf[ks], acc, 0, 0, 0);
#pragma unroll
          for (int i = 0; i < 4; ++i) GD8[(w * 64 + 16 * mt + 4 * mq + i) * 16 + n] = acc[i]; } }
    __syncthreads();
    { const f32x2 z2 = (f32x2){0.f, 0.f}; f32x2 sacc = z2;
#pragma unroll
      for (int q = 0; q < 8; ++q) sacc = sacc + *(const LAS f32x2*)(GD8 + q * 1024 + 2 * tid);
      *(LAS f32x2*)(GDF + 2 * tid) = sacc; }
    __syncthreads();
    { float cum[32]; float run = 0.f;
#pragma unroll
      for (int l = 0; l < 32; ++l) { const int row = 32 * hf + l; float z = bb;
#pragma unroll
          for (int r4 = 0; r4 < 4; ++r4) { const f32x4 a = *(const LAS f32x4*)(GDF + row * 16 + 4 * r4);
              z += a.x * wu[4 * r4] + a.y * wu[4 * r4 + 1] + a.z * wu[4 * r4 + 2] + a.w * wu[4 * r4 + 3]; }
          const float la = (fminf(z, 0.f) - __logf(1.f + __expf(-fabsf(z)))) * (1.f / 16.f);
          run += la; cum[l] = run; }
      LAS float* TOT1 = TOT + 256;
      if (hf == 0) TOT[col] = run;
      __syncthreads();
      const float tot = (hf == 1) ? TOT[col] : 0.f;
      if (hf == 1) TOT1[col] = run + tot;
      __syncthreads();
      const float ctot = TOT1[col];
      if (hf == 1) ((float*)(F.ws + WS_DEC))[(size_t)(b * NCH + c) * 256 + col] = __expf(ctot);
      unsigned pk[16];
#pragma unroll
      for (int l = 0; l < 32; l += 2) { const float k0 = bf2f(kraw[l]), k1 = bf2f(kraw[l + 1]);
          pk[l >> 1] = cvt_pk_bf16(k0 * __expf(ctot - (cum[l] + tot)), k1 * __expf(ctot - (cum[l + 1] + tot))); }
#pragma unroll
      for (int q = 0; q < 4; ++q) *(LAS u32x4*)(KD + col * 128 + hf * 64 + q * 16) = (u32x4){pk[4 * q], pk[4 * q + 1], pk[4 * q + 2], pk[4 * q + 3]}; }
    VM_WAIT();
    __syncthreads();
    { const int hh = w >> 1, vh = w & 1, qp = n >> 2, pp = lane & 3;
      f32x4 acc[4][4];
#pragma unroll
      for (int mt = 0; mt < 4; ++mt)
#pragma unroll
          for (int nt = 0; nt < 4; ++nt) acc[mt][nt] = (f32x4){0.f, 0.f, 0.f, 0.f};
#pragma unroll
      for (int ks = 0; ks < 2; ++ks) {
          bf16x8 af[4];
#pragma unroll
          for (int mt = 0; mt < 4; ++mt) af[mt] = *(const LAS bf16x8*)(KD + (hh * 64 + 16 * mt + n) * 128 + (32 * ks + 8 * mq) * 2);
#pragma unroll
          for (int nt = 0; nt < 4; ++nt) {
              const LAS unsigned char* vp = VB + (size_t)(32 * ks + 8 * mq + qp) * 1024 + (hh * 128 + vh * 64 + 16 * nt + 4 * pp) * 2;
              const bf16x8 bfr = cat8(lds_tr16(vp), lds_tr16(vp + 4 * 1024));
#pragma unroll
              for (int mt = 0; mt < 4; ++mt) acc[mt][nt] = __builtin_amdgcn_mfma_f32_16x16x32_bf16(af[mt], bfr, acc[mt][nt], 0, 0, 0);
          }
      }
      float* dst = (float*)(F.ws + WS_DST) + ((size_t)((b * NCH + c) * BH + hh) * 128) * 64;
#pragma unroll
      for (int mt = 0; mt < 4; ++mt)
#pragma unroll
          for (int nt = 0; nt < 4; ++nt) *(f32x4*)(dst + (size_t)(vh * 64 + 16 * nt + n) * 64 + 16 * mt + 4 * mq) = acc[mt][nt]; }
    __syncthreads();
}

__device__ __forceinline__ void gla_scan_phase(Frame& F) {
    FRESH(F);
    const float* ds = (const float*)(F.ws + WS_DST); const float* dec = (const float*)(F.ws + WS_DEC); bf16_t* st = (bf16_t*)(F.ws + WS_ST);
    for (int e2 = blockIdx.x * NTHR + F.tid; e2 < NB * BH * 128 * 32; e2 += F.G * NTHR) {
        const int k2 = e2 & 31, v = (e2 >> 5) & 127, hh = (e2 >> 12) & 3, b = e2 >> 14;
        f32x2 s = (f32x2){0.f, 0.f};
#pragma unroll 8
        for (int c = 0; c < NCH; ++c) {
            const size_t off = ((size_t)((b * NCH + c) * BH + hh) * 128 + v) * 64 + 2 * k2;
            const f32x2 d = *(const f32x2*)(ds + off); const f32x2 a = *(const f32x2*)(dec + (size_t)(b * NCH + c) * 256 + hh * 64 + 2 * k2);
            s = a * s + d;
            *(unsigned*)(st + off) = cvt_pk_bf16(s.x, s.y);
        }
    }
}

__device__ __forceinline__ void gla_out_unit(Frame& F, int b, int c, const float* gnorm) {
    FRESH(F);
    const int lane = F.lane, w = F.wave, n = lane & 15, mq = lane >> 4;
    const int hh = w >> 1, th = w & 1, tok0 = b * SEQ + c * CH + 32 * th;
    const bf16_t* qb = (const bf16_t*)(F.ws + WS_QB); const bf16_t* st = (const bf16_t*)(F.ws + WS_ST) + ((size_t)((b * NCH + c) * BH + hh) * 128) * 64;
    const bf16_t* sr = (const bf16_t*)(F.ws + WS_SR); bf16_t* yb = (bf16_t*)(F.ws + WS_YB);
    bf16x8 qf[2][2];
#pragma unroll
    for (int nt = 0; nt < 2; ++nt)
#pragma unroll
        for (int ks = 0; ks < 2; ++ks) qf[nt][ks] = *(const bf16x8*)(qb + (size_t)(tok0 + 16 * nt + n) * 256 + hh * 64 + 32 * ks + 8 * mq);
    f32x4 acc[8][2];
#pragma unroll
    for (int mt = 0; mt < 8; ++mt) {
        const bf16x8 a0 = *(const bf16x8*)(st + (size_t)(16 * mt + n) * 64 + 8 * mq), a1 = *(const bf16x8*)(st + (size_t)(16 * mt + n) * 64 + 32 + 8 * mq);
#pragma unroll
        for (int nt = 0; nt < 2; ++nt) { f32x4 z = (f32x4){0.f, 0.f, 0.f, 0.f};
            z = __builtin_amdgcn_mfma_f32_16x16x32_bf16(a0, qf[nt][0], z, 0, 0, 0);
            acc[mt][nt] = __builtin_amdgcn_mfma_f32_16x16x32_bf16(a1, qf[nt][1], z, 0, 0, 0); }
    }
#pragma unroll
    for (int nt = 0; nt < 2; ++nt) { float ss = 0.f;
#pragma unroll
        for (int mt = 0; mt < 8; ++mt) ss += (acc[mt][nt][0] * acc[mt][nt][0] + acc[mt][nt][1] * acc[mt][nt][1]) + (acc[mt][nt][2] * acc[mt][nt][2] + acc[mt][nt][3] * acc[mt][nt][3]);
        ss += __shfl_xor(ss, 16); ss += __shfl_xor(ss, 32);
        const float rstd = __builtin_amdgcn_rsqf(ss * (1.f / 128.f) + EPS);
#pragma unroll
        for (int mt = 0; mt < 8; ++mt) { const int col = hh * 128 + 16 * mt + 4 * mq; const f32x4 gn = *(const f32x4*)(gnorm + col);
            const size_t po = (size_t)(tok0 + 16 * nt + n) * 512 + col; const u32x2 rw = *(const u32x2*)(sr + po);
            const f32x4 o = acc[mt][nt] * rstd * gn; u32x2 wv; wv.x = cvt_pk_bf16(o[0] * bf_lo(rw.x), o[1] * bf_hi(rw.x)); wv.y = cvt_pk_bf16(o[2] * bf_lo(rw.y), o[3] * bf_hi(rw.y));
            *(u32x2*)(yb + po) = wv; } }
}
#ifndef PLE_MODE1
#define PLE_MODE1 3
#endif
#ifdef SIM_FP8
constexpr float MOE_ACT_QS = 8.f;
#else
constexpr float MOE_ACT_QS = 0.f;
#endif
#ifdef SIM_FFN0
constexpr float FFN0_ACT_QS = 8.f;
#else
constexpr float FFN0_ACT_QS = 0.f;
#endif
#ifndef PRO_PROBE
#define PRO_PROBE 0
#endif
constexpr int N_PHASES = 25;
__global__ void __launch_bounds__(NTHR, 2) fwd(Args args) {
    extern __shared__ __attribute__((aligned(16))) unsigned char lds[];
    Frame F;
    F.lds = (LAS unsigned char*)lds;
    F.MISC = (volatile LAS unsigned*)(F.lds + MISC_OFF);
    F.tid = threadIdx.x; F.lane = F.tid & 63; F.wave = __builtin_amdgcn_readfirstlane(F.tid >> 6);
    F.G = gridDim.x; { const int bx = blockIdx.x; F.vcu = (F.G % 8 == 0) ? (bx % 8) * (F.G / 8) + bx / 8 : bx; }
    F.ws = args.ws; F.ctl = (gu32*)(args.ws + WS_CTL); F.x = args.out; F.xs = (bf16_t*)(args.ws + WS_XS);
    unsigned char* ws = args.ws;
    for (int u = F.tid; u < (LDS_BYTES - LDSCTL_OFF) / 4; u += NTHR) ((LAS unsigned*)(F.lds + LDSCTL_OFF))[u] = 0u;
    __syncthreads();
    XcdBarrier bar = xcd_barrier_post((unsigned*)(F.ctl + CW_BAR), F.MISC + 8);
    const WT wt = make_wt(ws, (unsigned)WS_END);
    const int lo = args.ph_lo, hi = args.ph_hi;
#define PH_BEGIN const __attribute__((address_space(4))) Args* _ap = (const __attribute__((address_space(4))) Args*)__builtin_amdgcn_kernarg_segment_ptr(); asm volatile("" : "+s"(_ap)); const __attribute__((address_space(4))) Args& A = *_ap; unsigned char* ws = A.ws; \
    unsigned char* wb = ws + (l ? WS_W1 : WS_W0); bf16_t* hb = (bf16_t*)(ws + WS_HB); bf16_t* Y = (bf16_t*)(ws + WS_Y); const WT wt = make_wt(ws, (unsigned)WS_END); (void)wb; (void)hb; (void)Y; (void)wt; (void)A
#ifndef PHMASK
#define PHMASK 0x1fff
#endif
#define EN(i) (((PHMASK) >> (i)) & 1)
#ifndef REPMASK
#define REPMASK 0
#endif
#ifndef REPLAYER
#define REPLAYER 2
#endif
#define ZEROG ((const float*)(ws + WS_CTL + 131072))
#ifndef ZSKIP
#define ZSKIP 0
#endif
#define REPS(i) (((((REPMASK) >> (i)) & 1) && (REPLAYER == 2 || REPLAYER == l)) ? 2 : 1)
#define IN(k) (lo <= (k) && (k) < hi)
#ifndef SEAMREP
#define SEAMREP 1
#endif
#ifndef MK_STAMP
#define MK_STAMP 0
#endif
#ifndef STAMP_SEL
#define STAMP_SEL -1
#endif
#define SEAM(k) do { if (MK_STAMP && IN(k) && F.tid == 0) ((unsigned long long*)(ws + WS_CTL + 786432))[(k) * 256 + blockIdx.x] = __builtin_amdgcn_s_memrealtime(); \
    if (IN(k) && IN((k) + 1)) for (int _r = 0; _r < SEAMREP; ++_r) xcd_barrier(bar); } while (0)

    { const int l = 0; if (EN(12) && IN(0)) for (int rep = 0; rep < REPS(12); ++rep) { p0_prologue(F, args, rep == 0 ? 0 : PRO_PROBE); } }
    SEAM(0);
#ifndef LAYERREP
#define LAYERREP 0
#endif
    for (int l2 = 0; l2 < DEPTH + LAYERREP; ++l2) {
        const int l = (l2 < LAYERREP) ? 0 : l2 - LAYERREP; const bool zpass = (l2 < LAYERREP);
        const int pb = 1 + 12 * l;
        if (EN(0) && IN(pb + 0) && !(zpass && ((ZSKIP >> 0) & 1))) for (int rep = 0; rep < REPS(0); ++rep) { PH_BEGIN;
            pg8::Gemm g{hb, (const bf16_t*)(wb + OFF_WIN), D, 0, nullptr}; pg8::StaticOrder S; S.init(T, INWG, F.G, (int)blockIdx.x);
            pg8::EpiInProj E{(bf16_t*)(ws + WS_PROJ), wt};
            pg8::gemm_phase<pg8::EpiInProj, pg8::StaticOrder, false>(F.lds, g, S, E);
        }
        SEAM(pb + 0);
        if (EN(1) && IN(pb + 1) && !(zpass && ((ZSKIP >> 1) & 1))) for (int rep = 0; rep < REPS(1); ++rep) { PH_BEGIN;
            for (int u = F.vcu; u < NB * NCH; u += F.G) {
#ifndef NO_ATTN
#ifdef REP1_NO_ATTN
                if (rep == 0)
#endif
                attn_unit(F, u / NCH, u % NCH, A.in[I_RELB] + (size_t)l * AH * RELN);
#endif
#ifndef NO_GLA1
#ifdef REP1_NO_GLA
                if (rep == 0)
#endif
                gla_dstate_unit(F, u / NCH, u % NCH, (const bf16_t*)(wb + OFF_WGD), A.in[I_WGUP] + (size_t)l * GR * 256, A.in[I_BG] + (size_t)l * 256);
#endif
            }
        }
        SEAM(pb + 1);
        if (EN(2) && IN(pb + 2) && !(zpass && ((ZSKIP >> 2) & 1))) for (int rep = 0; rep < REPS(2); ++rep) { PH_BEGIN; gla_scan_phase(F); }
        SEAM(pb + 2);
        if (EN(3) && IN(pb + 3) && !(zpass && ((ZSKIP >> 3) & 1))) for (int rep = 0; rep < REPS(3); ++rep) { PH_BEGIN; for (int u = F.vcu; u < NB * NCH; u += F.G) gla_out_unit(F, u / NCH, u % NCH, A.in[I_GNORM] + (size_t)l * 512); }
        SEAM(pb + 3);
        if (EN(4) && IN(pb + 4) && !(zpass && ((ZSKIP >> 4) & 1))) for (int rep = 0; rep < REPS(4); ++rep) { PH_BEGIN;
            pg8::StaticOrder S; S.init(T, D, F.G, (int)blockIdx.x);
            { pg8::Gemm g{(const bf16_t*)(ws + WS_YA), (const bf16_t*)(wb + OFF_WBA), 512, 0, nullptr}; pg8::EpiEw<1> E{(bf16_t*)(ws + WS_MERGED), (const bf16_t*)(ws + WS_SGA), D, wt};
              pg8::gemm_phase<pg8::EpiEw<1>, pg8::StaticOrder, false>(F.lds, g, S, E); }
            { pg8::Gemm g{(const bf16_t*)(ws + WS_YB), (const bf16_t*)(wb + OFF_WBB), 512, 0, nullptr}; pg8::EpiEw<2> E{(bf16_t*)(ws + WS_MERGED), (const bf16_t*)(ws + WS_SGB), D, wt};
              pg8::gemm_phase<pg8::EpiEw<2>, pg8::StaticOrder, false>(F.lds, g, S, E); }
        }
        SEAM(pb + 4);
        if (EN(5) && IN(pb + 5) && !(zpass && ((ZSKIP >> 5) & 1))) for (int rep = 0; rep < REPS(5); ++rep) { PH_BEGIN;
            pg8::StaticOrder S; S.init(T, D, F.G, (int)blockIdx.x);
            pg8::Gemm g{(const bf16_t*)(ws + WS_MERGED), (const bf16_t*)(wb + OFF_WOUT), D, 0, nullptr}; pg8::EpiEw<0> E{Y, nullptr, D, wt};
            pg8::gemm_phase<pg8::EpiEw<0>, pg8::StaticOrder, false>(F.lds, g, S, E);
        }
        SEAM(pb + 5);
        if (EN(6) && IN(pb + 6) && !(zpass && ((ZSKIP >> 6) & 1))) for (int rep = 0; rep < ((l == 0) ? REPS(6) : 1); ++rep) { PH_BEGIN;
            if (l == 0) thin_phase<1, 1, false>(F, (LAYERREP == 0 && REPS(6) == 1) ? A.in[I_X] : nullptr, Y, (zpass || rep + 1 < REPS(6)) ? ZEROG : A.in[I_NMPOST] + (size_t)l * D, A.in[I_NFPRE] + (size_t)l * D, hb, nullptr);
            else        thin_phase<1, 1, true>(F, nullptr, Y, A.in[I_NMPOST] + (size_t)l * D, A.in[I_NFPRE] + (size_t)l * D, hb, A.in[I_RW]);
        }
        SEAM(pb + 6);
        if (EN(7) && IN(pb + 7) && !(zpass && ((ZSKIP >> 7) & 1))) for (int rep = 0; rep < REPS(7); ++rep) { PH_BEGIN;
            if (l == 0) { pg8::StaticOrder S; S.init(T, 2 * DFF, F.G, (int)blockIdx.x);
                pg8::Gemm g{hb, (const bf16_t*)(wb + OFF_FFN), D, 0, nullptr}; pg8::EpiGateUp E{(bf16_t*)(ws + WS_FACT), DFF, wt, FFN0_ACT_QS};
                pg8::gemm_phase<pg8::EpiGateUp, pg8::StaticOrder, false>(F.lds, g, S, E);
            } else { pg8::GroupedOrder S; S.init((const unsigned*)(F.ctl + CW_CNT), 2 * DFE, F.G, (int)blockIdx.x);
#if MOE_FP8
                pg8::Gemm g{hb, (const bf16_t*)(wb + OFF_FFN), D / 2, (size_t)2 * DFE * D / 2, (const int*)(ws + WS_IDXE), D / 2}; pg8::EpiGateUp8 E{ws + WS_MACT, DFE, wt, 1.f / W8_SCALE, ACT8_SCALE};
#ifdef SPLIT_GU
                S.i1 = SPLIT_GU; pg8::gemm_phase<pg8::EpiGateUp8, pg8::GroupedOrder, true, true>(F.lds, g, S, E);
                xcd_barrier(bar);
                S.i0 = SPLIT_GU; S.i1 = 1 << 30;
#endif
                pg8::gemm_phase<pg8::EpiGateUp8, pg8::GroupedOrder, true, true>(F.lds, g, S, E);
#else
                pg8::Gemm g{hb, (const bf16_t*)(wb + OFF_FFN), D, (size_t)2 * DFE * D, (const int*)(ws + WS_IDXE)}; pg8::EpiGateUp E{(bf16_t*)(ws + WS_MACT), DFE, wt, MOE_ACT_QS};
                pg8::gemm_phase<pg8::EpiGateUp, pg8::GroupedOrder, true>(F.lds, g, S, E);
#endif
            }
        }
        SEAM(pb + 7);
        if (EN(8) && IN(pb + 8) && !(zpass && ((ZSKIP >> 8) & 1))) for (int rep = 0; rep < REPS(8); ++rep) { PH_BEGIN;
            if (l == 0) { pg8::StaticOrder S; S.init(T, D, F.G, (int)blockIdx.x);
                pg8::Gemm g{(const bf16_t*)(ws + WS_FACT), (const bf16_t*)(wb + OFF_FDN), DFF, 0, nullptr}; pg8::EpiEw<0> E{Y, nullptr, D, wt};
                pg8::gemm_phase<pg8::EpiEw<0>, pg8::StaticOrder, false>(F.lds, g, S, E);
            } else {
#if MOE_FP8
                constexpr float dsc = 1.f / (W8_SCALE * ACT8_SCALE);
                { pg8::GroupedOrder S; S.init((const unsigned*)(F.ctl + CW_CNT), D, F.G, (int)blockIdx.x, MOE_MAIN_PANELS);
                  pg8::Gemm g{(const bf16_t*)(ws + WS_MACT), (const bf16_t*)(wb + OFF_MDN8), DFE / 2, (size_t)D * DFE / 2, nullptr}; pg8::EpiEw<0> E{(bf16_t*)(ws + WS_YSLOT), nullptr, D, wt, dsc};
                  pg8::gemm_phase<pg8::EpiEw<0>, pg8::GroupedOrder, false, true>(F.lds, g, S, E); }
                { pg8::TailOrder S; S.init((const unsigned*)(F.ctl + CW_CNT), D, F.G, (int)blockIdx.x, MOE_MAIN_PANELS, TAIL_KC, TAIL_KCH);
                  pg8::Gemm g{(const bf16_t*)(ws + WS_MACT), (const bf16_t*)(wb + OFF_MDN8), TAIL_KCH, (size_t)D * DFE / 2, nullptr, DFE / 2}; pg8::EpiPart E{(bf16_t*)(ws + WS_PBUF), D, MOE_MAIN_PANELS, TAIL_KCH, (size_t)TAIL_ROWS * D, wt, dsc};
                  pg8::gemm_phase<pg8::EpiPart, pg8::TailOrder, false, true>(F.lds, g, S, E); }
#else
                { pg8::GroupedOrder S; S.init((const unsigned*)(F.ctl + CW_CNT), D, F.G, (int)blockIdx.x, MOE_MAIN_PANELS);
                  pg8::Gemm g{(const bf16_t*)(ws + WS_MACT), (const bf16_t*)(wb + OFF_MDN), DFE, (size_t)D * DFE, nullptr}; pg8::EpiEw<0> E{(bf16_t*)(ws + WS_YSLOT), nullptr, D, wt};
                  pg8::gemm_phase<pg8::EpiEw<0>, pg8::GroupedOrder, false>(F.lds, g, S, E); }
                { pg8::TailOrder S; S.init((const unsigned*)(F.ctl + CW_CNT), D, F.G, (int)blockIdx.x, MOE_MAIN_PANELS, TAIL_KC, TAIL_KCH);
                  pg8::Gemm g{(const bf16_t*)(ws + WS_MACT), (const bf16_t*)(wb + OFF_MDN), TAIL_KCH, (size_t)D * DFE, nullptr, DFE}; pg8::EpiPart E{(bf16_t*)(ws + WS_PBUF), D, MOE_MAIN_PANELS, TAIL_KCH, (size_t)TAIL_ROWS * D, wt};
                  pg8::gemm_phase<pg8::EpiPart, pg8::TailOrder, false>(F.lds, g, S, E); }
#endif
            }
        }
        SEAM(pb + 8);
        if (EN(9) && IN(pb + 9) && !(zpass && ((ZSKIP >> 9) & 1))) for (int rep = 0; rep < REPS(9); ++rep) { PH_BEGIN;
            if (l == 0) thin_phase<1, 2, false>(F, nullptr, Y, (zpass || rep + 1 < REPS(9)) ? ZEROG : A.in[I_NFPOST] + (size_t)l * D, nullptr, nullptr, nullptr);
            else        thin_phase<2, 2, false>(F, nullptr, (const bf16_t*)(ws + WS_YSLOT), (zpass || rep + 1 < REPS(9)) ? ZEROG : A.in[I_NFPOST] + (size_t)l * D, nullptr, nullptr, nullptr);
        }
        SEAM(pb + 9);
        if (EN(10) && IN(pb + 10) && !(zpass && ((ZSKIP >> 10) & 1))) for (int rep = 0; rep < REPS(10); ++rep) { PH_BEGIN;
            pg8::StaticOrder S; S.init(T, D, F.G, (int)blockIdx.x);
            if (MK_DBG == 0 || A.sub != 2) { pg8::Gemm g{(const bf16_t*)(ws + WS_XS), (const bf16_t*)(wb + OFF_WPG), D, 0, nullptr}; pg8::EpiEw<PLE_MODE1> E{Y, nullptr, D, wt};
              pg8::gemm_phase<pg8::EpiEw<PLE_MODE1>, pg8::StaticOrder, false>(F.lds, g, S, E); }
            if (MK_DBG == 0 || A.sub != 1) { pg8::Gemm g{(const bf16_t*)(ws + WS_PB) + (size_t)l * T * PLE, (const bf16_t*)(wb + OFF_WPP), PLE, 0, nullptr}; pg8::EpiEw<4> E{Y, nullptr, D, wt};
              pg8::gemm_phase<pg8::EpiEw<4>, pg8::StaticOrder, false>(F.lds, g, S, E); }
        }
        SEAM(pb + 10);
        if (EN(11) && IN(pb + 11) && !(zpass && ((ZSKIP >> 11) & 1))) for (int rep = 0; rep < REPS(11); ++rep) { PH_BEGIN;
            if (l + 1 < DEPTH) thin_phase<1, 1, false>(F, nullptr, Y, (zpass || rep + 1 < REPS(11)) ? ZEROG : A.in[I_PNORM] + (size_t)l * D, A.in[I_NMPRE] + (size_t)(zpass ? 0 : l + 1) * D, hb, nullptr);
            else               thin_phase<1, 0, false>(F, nullptr, Y, (zpass || rep + 1 < REPS(11)) ? ZEROG : A.in[I_PNORM] + (size_t)l * D, nullptr, nullptr, nullptr);
        }
        SEAM(pb + 11);
    }
#if MK_STAMP
    {
        xcd_barrier(bar);
        const unsigned long long* st = (const unsigned long long*)(ws + WS_CTL + 786432);
        LAS float* res = (LAS float*)(F.lds);
        if (F.tid < N_PHASES) { const int k = F.tid; unsigned long long mx = 0, mxp = 0; double sum = 0.0;
            for (int g = 0; g < F.G; ++g) { const unsigned long long t = st[k * 256 + g]; mx = t > mx ? t : mx; sum += (double)t; if (k > 0) { const unsigned long long tp = st[(k - 1) * 256 + g]; mxp = tp > mxp ? tp : mxp; } }
            if (k == 0) { mxp = ~0ull; for (int g = 0; g < F.G; ++g) { const unsigned long long t = st[g]; mxp = t < mxp ? t : mxp; } mxp -= 0; }
            res[k] = (float)((double)(mx - mxp) * 0.01); res[32 + k] = (float)(((double)mx - sum / F.G) * 0.01); }
        __syncthreads();
        float t1, t2;
        if (STAMP_SEL < 0) { t1 = 0.f; t2 = 0.f; for (int k = 1; k < N_PHASES; ++k) { t1 += res[32 + k]; t2 += res[k]; } }
        else { t1 = res[STAMP_SEL]; t2 = res[32 + STAMP_SEL]; }
        const float A = 300.f * t1 + 1000.f, B = 10.f * t2 + 20.f;
        for (size_t i = (size_t)blockIdx.x * NTHR + F.tid; i < (size_t)T * D; i += (size_t)F.G * NTHR) args.out[i] = (i == 0) ? A : B;
    }
#endif
#undef IN
#undef SEAM
}
#ifndef MK_DBG
#define MK_DBG 0
#endif
#if MK_DBG
#ifndef MK_DBG_SHOW
#define MK_DBG_SHOW -1
#endif
constexpr size_t WS_SNAP = 512 * 1024;
__device__ __forceinline__ unsigned dh(unsigned x) { x ^= x >> 16; x *= 0x7feb352du; x ^= x >> 15; x *= 0x846ca68bu; x ^= x >> 16; return x; }
__device__ __forceinline__ void dbg_acc(float* dbg, int stage, float d2, float e2, int lane) { d2 = wave_sum(d2); e2 = wave_sum(e2); if (lane == 0) { atomicAdd(dbg + 2 * stage, d2); atomicAdd(dbg + 2 * stage + 1, e2); } }
__device__ __forceinline__ float ddot(const bf16_t* arow, const float* W, int K, int pitch, int col, int lane) { float s = 0.f; for (int k = lane; k < K; k += 64) s += bf2f(arow[k]) * W[(size_t)k * pitch + col]; return wave_sum(s); }
__device__ __forceinline__ float dsig(float v) { return 1.f / (1.f + expf(-v)); }
__device__ __forceinline__ int dbg_pbase(const unsigned* gcnt, int e) { int acc = 0; for (int q = 0; q < 8; ++q) if (q < e) acc += (((int)gcnt[q] + 255) >> 8) << 8; return acc; }
__device__ __forceinline__ float dbg_moe_el(const unsigned char* ws, int s, int k) { if (s < MOE_MAIN_ROWS) return bf2f(((const bf16_t*)(ws + WS_YSLOT))[(size_t)s * D + k]); float a = 0.f; for (int kc = 0; kc < TAIL_KC; ++kc) a += bf2f(((const bf16_t*)(ws + WS_PBUF))[((size_t)kc * TAIL_ROWS + (s - MOE_MAIN_ROWS)) * D + k]); return a; }
__device__ __forceinline__ float dbg_f8(const unsigned char* p, size_t i) { return __builtin_amdgcn_cvt_f32_fp8((int)p[i], 0); }
__device__ __forceinline__ float ddot8(const unsigned char* arow, float ascale, const float* W, int K, int pitch, int col, int lane) { float s = 0.f; for (int k = lane; k < K; k += 64) s += dbg_f8(arow, k) * ascale * W[(size_t)k * pitch + col]; return wave_sum(s); }
#define DBGP float* dbg = (float*)(a.ws + WS_CTL) + CW_DBG; const int lane = threadIdx.x & 63; const unsigned sid = blockIdx.x; (void)sid

__global__ void dbg_t1(Args a, int stage) { DBGP;
    const int r = dh(sid * 3 + 1) % T; const float* x = a.in[I_X] + (size_t)r * D; const bf16_t* hb = (const bf16_t*)(a.ws + WS_HB) + (size_t)r * D;
    float ss = 0.f; for (int k = lane; k < D; k += 64) ss += x[k] * x[k]; ss = wave_sum(ss); const float rstd = 1.f / sqrtf(ss / D + EPS);
    float d2 = 0.f, e2 = 0.f; for (int k = lane; k < D; k += 64) { const float e = x[k] * rstd * a.in[I_NMPRE][k], g = bf2f(hb[k]); d2 += (g - e) * (g - e); e2 += e * e; }
    dbg_acc(dbg, stage, d2, e2, lane); }

__global__ void dbg_gemm(Args a, int kind, int l, int stage) { DBGP;
    unsigned char* ws = a.ws; const unsigned h1 = dh(sid * 7 + 1), h2 = dh(sid * 7 + 2), h3 = dh(sid * 7 + 3);
    const bf16_t* hb = (const bf16_t*)(ws + WS_HB); float e = 0.f, g = 0.f;
    const unsigned* gcnt = (const unsigned*)(ws + WS_CTL) + CW_CNT;
    if (kind == 1) { const int row = h1 % T, col = h2 % INWG, sc = col < 2560 ? col : col + 16; const float v = ddot(hb + (size_t)row * D, a.in[I_WIN] + (size_t)l * D * INW, D, INW, sc, lane);
        const bf16_t* P = (const bf16_t*)(ws + WS_PROJ);
        if (col < 512) { e = v * pg8::QA_SCALE; g = bf2f(((const bf16_t*)(ws + WS_QA))[(size_t)row * 512 + col]); }
        else if (col < 1024) { e = v; g = bf2f(((const bf16_t*)(ws + WS_KA))[(size_t)row * 512 + col - 512]); }
        else if (col < 1536) { e = v; g = bf2f(((const bf16_t*)(ws + WS_VA))[(size_t)row * 512 + col - 1024]); }
        else if (col < 1792) { e = v * 0.125f; g = bf2f(((const bf16_t*)(ws + WS_QB))[(size_t)row * 256 + col - 1536]); }
        else if (col < 2048) { e = v; g = bf2f(((const bf16_t*)(ws + WS_KB))[(size_t)row * 256 + col - 1792]); }
        else if (col < 2560) { e = v; g = bf2f(((const bf16_t*)(ws + WS_VB))[(size_t)row * 512 + col - 2048]); }
        else if (col < 3072) { e = v * dsig(v); g = bf2f(((const bf16_t*)(ws + WS_SR))[(size_t)row * 512 + col - 2560]); }
        else if (col < 4096) { e = dsig(v); g = bf2f(((const bf16_t*)(ws + WS_SGA))[(size_t)row * 1024 + col - 3072]); }
        else { e = dsig(v); g = bf2f(((const bf16_t*)(ws + WS_SGB))[(size_t)row * 1024 + col - 4096]); } (void)P;
    } else if (kind == 2) { const int row = h1 % T, col = h2 % D;
        const float va = ddot((const bf16_t*)(ws + WS_YA) + (size_t)row * 512, a.in[I_WBA] + (size_t)l * 512 * D, 512, D, col, lane), vb = ddot((const bf16_t*)(ws + WS_YB) + (size_t)row * 512, a.in[I_WBB] + (size_t)l * 512 * D, 512, D, col, lane);
        e = bf2f(((const bf16_t*)(ws + WS_SGA))[(size_t)row * D + col]) * va + bf2f(((const bf16_t*)(ws + WS_SGB))[(size_t)row * D + col]) * vb; g = bf2f(((const bf16_t*)(ws + WS_MERGED))[(size_t)row * D + col]);
    } else if (kind == 3) { const int row = h1 % T, col = h2 % D; e = ddot((const bf16_t*)(ws + WS_MERGED) + (size_t)row * D, a.in[I_WOUT] + (size_t)l * D * D, D, D, col, lane); g = bf2f(((const bf16_t*)(ws + WS_Y))[(size_t)row * D + col]);
    } else if (kind == 4) { const int row = h1 % T, c = h2 % DFF; const float vg = ddot(hb + (size_t)row * D, a.in[I_FG], D, DFF, c, lane), vu = ddot(hb + (size_t)row * D, a.in[I_FU], D, DFF, c, lane);
        e = vg * dsig(vg) * vu; g = bf2f(((const bf16_t*)(ws + WS_FACT))[(size_t)row * DFF + c]);
    } else if (kind == 5) { const int row = h1 % T, col = h2 % D; e = ddot((const bf16_t*)(ws + WS_FACT) + (size_t)row * DFF, a.in[I_FD], DFF, D, col, lane); g = bf2f(((const bf16_t*)(ws + WS_Y))[(size_t)row * D + col]);
    } else if (kind == 6 || kind == 7) { const int ex = h1 % NE; const int pbase = dbg_pbase(gcnt, ex); const int cnt = (int)gcnt[ex];
        if (cnt == 0) return; const int i = h2 % cnt, tok = ((const int*)(ws + WS_IDXE))[ex * 16384 + i], row = pbase + i;
#if MOE_FP8
        const unsigned char* hb8 = ws + WS_HB; const unsigned char* act8 = ws + WS_MACT;
        if (kind == 6) { const int c = h3 % DFE; const float vg = ddot8(hb8 + (size_t)tok * D, 1.f, a.in[I_MG] + (size_t)ex * D * DFE, D, DFE, c, lane), vu = ddot8(hb8 + (size_t)tok * D, 1.f, a.in[I_MU] + (size_t)ex * D * DFE, D, DFE, c, lane);
            e = vg * dsig(vg) * vu; g = dbg_f8(act8, (size_t)row * DFE + c) * (1.f / ACT8_SCALE); }
        else { const int col = h3 % D; e = ddot8(act8 + (size_t)row * DFE, 1.f / ACT8_SCALE, a.in[I_MD] + (size_t)ex * DFE * D, DFE, D, col, lane); g = dbg_moe_el(ws, row, col); }
#else
        if (kind == 6) { const int c = h3 % DFE; const float vg = ddot(hb + (size_t)tok * D, a.in[I_MG] + (size_t)ex * D * DFE, D, DFE, c, lane), vu = ddot(hb + (size_t)tok * D, a.in[I_MU] + (size_t)ex * D * DFE, D, DFE, c, lane);
            e = vg * dsig(vg) * vu; g = bf2f(((const bf16_t*)(ws + WS_MACT))[(size_t)row * DFE + c]); }
        else { const int col = h3 % D; e = ddot((const bf16_t*)(ws + WS_MACT) + (size_t)row * DFE, a.in[I_MD] + (size_t)ex * DFE * D, DFE, D, col, lane); g = dbg_moe_el(ws, row, col); }
#endif
    } else if (kind == 12) { const int row = h1 % T, col = h2 % D; e = a.out[(size_t)row * D + col]; g = bf2f(((const bf16_t*)(ws + WS_XS))[(size_t)row * D + col]);
    } else if (kind == 13) { const int row = h1 % T, col = h2 % D; e = ddot((const bf16_t*)(ws + WS_XS) + (size_t)row * D, a.in[I_PG] + (size_t)l * D * D, D, D, col, lane); g = bf2f(((const bf16_t*)(ws + WS_Y))[(size_t)row * D + col]);
    } else if (kind == 11) { const int n = h1 % D, k = h2 % D; e = a.in[I_PG][(size_t)l * D * D + (size_t)k * D + n]; g = bf2f(((const bf16_t*)(ws + (l ? WS_W1 : WS_W0) + OFF_WPG))[(size_t)n * D + k]);
    } else if (kind == 9) { const int row = h1 % T, col = h2 % D; e = dsig(ddot((const bf16_t*)(ws + WS_XS) + (size_t)row * D, a.in[I_PG] + (size_t)l * D * D, D, D, col, lane)); g = bf2f(((const bf16_t*)(ws + WS_Y))[(size_t)row * D + col]);
    } else { const int row = h1 % T, col = h2 % D; const float vg = ddot((const bf16_t*)(ws + WS_XS) + (size_t)row * D, a.in[I_PG] + (size_t)l * D * D, D, D, col, lane), vp = ddot((const bf16_t*)(ws + WS_PB) + ((size_t)l * T + row) * PLE, a.in[I_PP] + (size_t)l * PLE * D, PLE, D, col, lane);
        e = dsig(vg) * vp; g = bf2f(((const bf16_t*)(ws + WS_Y))[(size_t)row * D + col]); }
    if (lane == 0) { atomicAdd(dbg + 2 * stage, (g - e) * (g - e)); atomicAdd(dbg + 2 * stage + 1, e * e); } }

__global__ void dbg_attn(Args a, int l, int stage) { DBGP;
    unsigned char* ws = a.ws; const unsigned h1 = dh(sid * 5 + 1); const int tok = h1 % T, h = dh(sid * 5 + 2) % AH, b = tok / SEQ, c = (tok % SEQ) / CH, ql = tok % CH;
    const bf16_t* hb = (const bf16_t*)(ws + WS_HB) + (size_t)tok * D; const float* win = a.in[I_WIN] + (size_t)l * D * INW;
    float q = 0.f; for (int k = 0; k < D; ++k) q += bf2f(hb[k]) * win[(size_t)k * INW + h * 64 + lane]; q *= pg8::QA_SCALE;
    const bf16_t* ka = (const bf16_t*)(ws + WS_KA); const bf16_t* va = (const bf16_t*)(ws + WS_VA); const float* rb = a.in[I_RELB] + ((size_t)l * AH + h) * RELN;
    float m = -1e30f, ls = 0.f, o = 0.f;
    for (int kc = (c - 8 > 0 ? c - 8 : 0); kc <= c; ++kc) for (int kl = 0; kl < CH; ++kl) { const int kt = b * SEQ + kc * CH + kl; int dist = (c - kc) * 64 + ql - kl; dist = dist > 128 ? 128 : (dist < -128 ? -128 : dist);
        const float s = wave_sum(q * bf2f(ka[(size_t)kt * 512 + h * 64 + lane])) + rb[dist + 128] * LOG2E; const float mn = fmaxf(m, s), al = exp2f(m - mn), p = exp2f(s - mn); m = mn; ls = ls * al + p; o = o * al + p * bf2f(va[(size_t)kt * 512 + h * 64 + lane]); }
    const float e = o / ls, g = bf2f(((const bf16_t*)(ws + WS_YA))[(size_t)tok * 512 + h * 64 + lane]);
    dbg_acc(dbg, stage, (g - e) * (g - e), e * e, lane); }

__global__ void dbg_dstate(Args a, int l, int stage) { DBGP;
    unsigned char* ws = a.ws; const int b = dh(sid * 5 + 1) % NB, c = dh(sid * 5 + 2) % NCH, hh = dh(sid * 5 + 3) % BH, v = dh(sid * 5 + 4) % 128, k = dh(sid * 5 + 5) % 64, col = hh * 64 + k;
    const int tok = b * SEQ + c * CH + lane; const bf16_t* hb = (const bf16_t*)(ws + WS_HB) + (size_t)tok * D; const float* win = a.in[I_WIN] + (size_t)l * D * INW;
    float z = a.in[I_BG][l * 256 + col];
    for (int r = 0; r < GR; ++r) { float gd = 0.f; for (int kk = 0; kk < D; ++kk) gd += bf2f(hb[kk]) * win[(size_t)kk * INW + 2560 + r]; z += gd * a.in[I_WGUP][((size_t)l * GR + r) * 256 + col]; }
    const float la = (fminf(z, 0.f) - log1pf(expf(-fabsf(z)))) / 16.f; float cum = la;
    for (int o = 1; o < 64; o <<= 1) { const float t = __shfl_up(cum, o); if (lane >= o) cum += t; }
    const float tot = __shfl(cum, 63);
    const float kd = bf2f(((const bf16_t*)(ws + WS_KB))[(size_t)tok * 256 + col]) * expf(tot - cum);
    const float e = wave_sum(kd * bf2f(((const bf16_t*)(ws + WS_VB))[(size_t)tok * 512 + hh * 128 + v]));
    const float g = ((const float*)(ws + WS_DST))[((size_t)((b * NCH + c) * BH + hh) * 128 + v) * 64 + k];
    const float ed = expf(tot), gdc = ((const float*)(ws + WS_DEC))[(size_t)(b * NCH + c) * 256 + col];
    if (lane == 0) { atomicAdd(dbg + 2 * stage, (g - e) * (g - e) + (gdc - ed) * (gdc - ed)); atomicAdd(dbg + 2 * stage + 1, e * e + ed * ed); } }

__global__ void dbg_scan(Args a, int stage) { DBGP;
    unsigned char* ws = a.ws; const unsigned s0 = sid * 64 + lane; const int b = dh(s0 * 5 + 1) % NB, c = dh(s0 * 5 + 2) % NCH, hh = dh(s0 * 5 + 3) % BH, v = dh(s0 * 5 + 4) % 128, k = dh(s0 * 5 + 5) % 64;
    float s = 0.f; for (int cc = 0; cc <= c; ++cc) s = ((const float*)(ws + WS_DEC))[(size_t)(b * NCH + cc) * 256 + hh * 64 + k] * s + ((const float*)(ws + WS_DST))[((size_t)((b * NCH + cc) * BH + hh) * 128 + v) * 64 + k];
    const float g = bf2f(((const bf16_t*)(ws + WS_ST))[((size_t)((b * NCH + c) * BH + hh) * 128 + v) * 64 + k]);
    dbg_acc(dbg, stage, (g - s) * (g - s), s * s, lane); }

__global__ void dbg_glaout(Args a, int l, int stage) { DBGP;
    unsigned char* ws = a.ws; const int tok = dh(sid * 3 + 1) % T, hh = dh(sid * 3 + 2) % BH, b = tok / SEQ, c = (tok % SEQ) / CH;
    const bf16_t* st = (const bf16_t*)(ws + WS_ST) + ((size_t)((b * NCH + c) * BH + hh) * 128) * 64; const bf16_t* qb = (const bf16_t*)(ws + WS_QB) + (size_t)tok * 256 + hh * 64;
    const bf16_t* hb = (const bf16_t*)(ws + WS_HB) + (size_t)tok * D; const float* win = a.in[I_WIN] + (size_t)l * D * INW;
    float o[2], r[2];
#pragma unroll
    for (int j = 0; j < 2; ++j) { const int v = lane + 64 * j; float s = 0.f; for (int k = 0; k < 64; ++k) s += bf2f(qb[k]) * bf2f(st[(size_t)v * 64 + k]); o[j] = s;
        float rr = 0.f; for (int kk = 0; kk < D; ++kk) rr += bf2f(hb[kk]) * win[(size_t)kk * INW + 2576 + hh * 128 + v]; r[j] = rr * dsig(rr); }
    const float ss = wave_sum(o[0] * o[0] + o[1] * o[1]), rstd = 1.f / sqrtf(ss / 128.f + EPS); float d2 = 0.f, e2 = 0.f;
#pragma unroll
    for (int j = 0; j < 2; ++j) { const int v = lane + 64 * j; const float e = o[j] * rstd * a.in[I_GNORM][l * 512 + hh * 128 + v] * r[j], g = bf2f(((const bf16_t*)(ws + WS_YB))[(size_t)tok * 512 + hh * 128 + v]); d2 += (g - e) * (g - e); e2 += e * e; }
    dbg_acc(dbg, stage, d2, e2, lane); }

__device__ __forceinline__ int dbg_row(unsigned i) { return (int)((i * 257u + 11u) % T); }
__global__ void dbg_snap(Args a, int from_in) { const int i = blockIdx.x, r = dbg_row(i); float* snap = (float*)(a.ws + WS_SNAP) + (size_t)i * D; const bf16_t* xs = (const bf16_t*)(a.ws + WS_XS); for (int k = threadIdx.x; k < D; k += 64) snap[k] = from_in ? a.in[I_X][(size_t)r * D + k] : bf2f(xs[(size_t)r * D + k]); }
__global__ void dbg_thin(Args a, int src, int outk, int route, const float* g_add, const float* g_out, const bf16_t* obuf, int st_x, int st_o, int st_r) { DBGP;
    unsigned char* ws = a.ws; const int i = sid, r = dbg_row(i); const float* snap = (const float*)(ws + WS_SNAP) + (size_t)i * D;
    const unsigned* gcnt = (const unsigned*)(ws + WS_CTL) + CW_CNT; const unsigned* ti = (const unsigned*)(ws + WS_TOKINFO) + (size_t)r * 8;
    float y[16], xn[16]; float ss = 0.f;
#pragma unroll
    for (int j = 0; j < 16; ++j) { const int k = lane + 64 * j; float v;
        if (src == 1) v = bf2f(((const bf16_t*)(ws + WS_Y))[(size_t)r * D + k]);
        else { v = __uint_as_float(ti[4]) * dbg_moe_el(ws, dbg_pbase(gcnt, (int)ti[0]) + (int)ti[1], k) + __uint_as_float(ti[5]) * dbg_moe_el(ws, dbg_pbase(gcnt, (int)ti[2]) + (int)ti[3], k); }
        y[j] = v; ss += v * v; }
    ss = wave_sum(ss); const float rstd = 1.f / sqrtf(ss / D + EPS); float d2 = 0.f, e2 = 0.f, s2 = 0.f;
#pragma unroll
    for (int j = 0; j < 16; ++j) { const int k = lane + 64 * j; xn[j] = snap[k] + y[j] * rstd * g_add[k]; const float g = (outk == 0) ? a.out[(size_t)r * D + k] : bf2f(((const bf16_t*)(ws + WS_XS))[(size_t)r * D + k]); d2 += (g - xn[j]) * (g - xn[j]); e2 += xn[j] * xn[j]; s2 += xn[j] * xn[j]; }
    dbg_acc(dbg, st_x, d2, e2, lane);
    if (outk != 1) return;
    s2 = wave_sum(s2); const float rs2 = 1.f / sqrtf(s2 / D + EPS); d2 = 0.f; e2 = 0.f; float hn[16];
#pragma unroll
    for (int j = 0; j < 16; ++j) { const int k = lane + 64 * j; hn[j] = (outk == 1) ? xn[j] * rs2 * g_out[k] : xn[j]; const float g = (MOE_FP8 && route) ? dbg_f8((const unsigned char*)obuf, (size_t)r * D + k) : bf2f(obuf[(size_t)r * D + k]); d2 += (g - hn[j]) * (g - hn[j]); e2 += hn[j] * hn[j]; }
    dbg_acc(dbg, st_o, d2, e2, lane);
    if (!route) return;
    float lg[8];
#pragma unroll
    for (int e = 0; e < 8; ++e) { float s = 0.f;
#pragma unroll
        for (int j = 0; j < 16; ++j) s += hn[j] * a.in[I_RW][(size_t)(lane + 64 * j) * NE + e]; lg[e] = wave_sum(s); }
    int e1 = 0; float v1 = lg[0];
#pragma unroll
    for (int e = 1; e < 8; ++e) if (lg[e] > v1) { v1 = lg[e]; e1 = e; }
    int e2i = -1; float v2 = -3.0e38f;
#pragma unroll
    for (int e = 0; e < 8; ++e) if (e != e1 && lg[e] > v2) { v2 = lg[e]; e2i = e; }
    const float ex = expf(v2 - v1), w1 = 1.f / (1.f + ex);
    float bad = 0.f; if ((int)ti[0] != e1 || (int)ti[2] != e2i) bad = 1.f; else { bad = fabsf(__uint_as_float(ti[4]) - w1) + fabsf(__uint_as_float(ti[5]) - (1.f - w1));
        const int* idxe = (const int*)(ws + WS_IDXE); if (ti[1] >= gcnt[e1] || ti[3] >= gcnt[e2i] || idxe[e1 * 16384 + ti[1]] != r || idxe[e2i * 16384 + ti[3]] != r) bad = 1.f; }
    if (lane == 0) { atomicAdd(dbg + 2 * st_r, bad * bad); atomicAdd(dbg + 2 * st_r + 1, 1.f); } }

__global__ void dbg_report(Args a) {
    const float* dbg = (const float*)(a.ws + WS_CTL) + CW_DBG; int bad = -1; float errk = 0.f;
    for (int k = 0; k < 33; ++k) { const float d2 = dbg[2 * k], e2 = dbg[2 * k + 1]; if (d2 == 0.f && e2 == 0.f) continue; const float err = d2 / e2; if (MK_DBG_SHOW == k) errk = (err == err) ? err : 1e6f; const float thr = (MOE_FP8 && (k == 25 || k == 27 || k == 28)) ? 3e-2f : 1e-3f; if (bad < 0 && !(err < thr)) bad = k; }
    float V = 0.f; bool fill = false;
    if (MK_DBG_SHOW >= 0) { V = sqrtf(7.f * 100.f * errk) + 1e-3f; fill = true; } else if (bad >= 0) { V = exp10f(1.f + 0.25f * (float)bad); fill = true; }
    if (fill) for (size_t i = (size_t)blockIdx.x * blockDim.x + threadIdx.x; i < (size_t)T * D; i += (size_t)gridDim.x * blockDim.x) a.out[i] = V; }

static void dbg_run(Args a, int grid, hipStream_t st) {
    auto ph = [&](int p) { a.ph_lo = p; a.ph_hi = p + 1; hipLaunchKernelGGL(fwd, dim3(grid), dim3(NTHR), LDS_BYTES, st, a); };
    const int NS = 2048;
    ph(0); hipLaunchKernelGGL(dbg_t1, dim3(256), dim3(64), 0, st, a, 0);
    for (int l = 0; l < DEPTH; ++l) { const int pb = 1 + 12 * l, sb = 16 * l; const size_t lo = (size_t)l * D;
        ph(pb + 0); hipLaunchKernelGGL(dbg_gemm, dim3(NS), dim3(64), 0, st, a, 1, l, sb + 1);
        ph(pb + 1); hipLaunchKernelGGL(dbg_attn, dim3(512), dim3(64), 0, st, a, l, sb + 2); hipLaunchKernelGGL(dbg_dstate, dim3(256), dim3(64), 0, st, a, l, sb + 3);
        ph(pb + 2); hipLaunchKernelGGL(dbg_scan, dim3(64), dim3(64), 0, st, a, sb + 4);
        ph(pb + 3); hipLaunchKernelGGL(dbg_glaout, dim3(256), dim3(64), 0, st, a, l, sb + 5);
        ph(pb + 4); hipLaunchKernelGGL(dbg_gemm, dim3(NS), dim3(64), 0, st, a, 2, l, sb + 6);
        ph(pb + 5); hipLaunchKernelGGL(dbg_gemm, dim3(NS), dim3(64), 0, st, a, 3, l, sb + 7);
        hipLaunchKernelGGL(dbg_snap, dim3(64), dim3(64), 0, st, a, l == 0 ? 1 : 0);
        ph(pb + 6); hipLaunchKernelGGL(dbg_thin, dim3(64), dim3(64), 0, st, a, 1, 1, l == 1 ? 1 : 0, a.in[I_NMPOST] + lo, a.in[I_NFPRE] + lo, (const bf16_t*)(a.ws + WS_HB), sb + 8, sb + 9, sb + 10);
        ph(pb + 7); hipLaunchKernelGGL(dbg_gemm, dim3(NS), dim3(64), 0, st, a, l == 0 ? 4 : 6, l, sb + 11);
        ph(pb + 8); hipLaunchKernelGGL(dbg_gemm, dim3(NS), dim3(64), 0, st, a, l == 0 ? 5 : 7, l, sb + 12);
        hipLaunchKernelGGL(dbg_snap, dim3(64), dim3(64), 0, st, a, 0);
        ph(pb + 9); hipLaunchKernelGGL(dbg_thin, dim3(64), dim3(64), 0, st, a, l == 0 ? 1 : 2, 2, 0, a.in[I_NFPOST] + lo, (const float*)nullptr, (const bf16_t*)nullptr, sb + 13, sb + 13, 0);
        a.sub = 1; ph(pb + 10); hipLaunchKernelGGL(dbg_gemm, dim3(NS), dim3(64), 0, st, a, 9, l, sb + 14);
        a.sub = 2; ph(pb + 10); a.sub = 0; hipLaunchKernelGGL(dbg_gemm, dim3(NS), dim3(64), 0, st, a, 8, l, sb + 15);
        hipLaunchKernelGGL(dbg_snap, dim3(64), dim3(64), 0, st, a, 0);
        ph(pb + 11); hipLaunchKernelGGL(dbg_thin, dim3(64), dim3(64), 0, st, a, 1, l == 0 ? 1 : 0, 0, a.in[I_PNORM] + lo, l == 0 ? a.in[I_NMPRE] + D : (const float*)nullptr, (const bf16_t*)(a.ws + WS_HB), sb + 16, sb + 16, 0);
    }
    hipLaunchKernelGGL(dbg_report, dim3(1024), dim3(256), 0, st, a);
}
#endif
#ifndef MK_SPLIT
#define MK_SPLIT 0
#endif
#ifndef MK_DBG
#define MK_DBG 0
#endif
extern "C" void kernel_launch(void* const* d_in, const int* in_sizes, int n_in, void* d_out, int out_size, void* d_ws, size_t ws_size, hipStream_t stream) {
    static int grid = 0;
    if (grid == 0) {
        if (n_in != 24 || in_sizes[0] != T * D || out_size != T * D || ws_size < WS_END) { fprintf(stderr, "kernel_launch: unexpected problem (n_in %d, in0 %d, out %d, ws %zu < %zu); nothing launched\n", n_in, n_in > 0 ? in_sizes[0] : -1, out_size, ws_size, (size_t)WS_END); grid = -1; return; }
        int dev = 0, cus = 0, per_cu = 0;
        if (hipGetDevice(&dev) != hipSuccess || hipDeviceGetAttribute(&cus, hipDeviceAttributeMultiprocessorCount, dev) != hipSuccess) { grid = -1; return; }
        if (hipFuncSetAttribute((const void*)fwd, hipFuncAttributeMaxDynamicSharedMemorySize, LDS_BYTES) != hipSuccess) { fprintf(stderr, "kernel_launch: hipFuncSetAttribute failed\n"); grid = -1; return; }
        if (hipOccupancyMaxActiveBlocksPerMultiprocessor(&per_cu, (const void*)fwd, NTHR, LDS_BYTES) != hipSuccess || per_cu < 1) { fprintf(stderr, "kernel_launch: occupancy query says %d blocks per CU\n", per_cu); }
        (void)hipGetLastError();
        grid = cus;
    }
    if (grid < 0) return;
    (void)hipMemsetAsync((char*)d_ws + WS_CTL, 0, CTL_ZERO_BYTES, stream);
    Args a{};
    for (int i = 0; i < 24; ++i) a.in[i] = (const float*)d_in[i];
    a.out = (float*)d_out; a.ws = (unsigned char*)d_ws;
#if MK_DBG
    dbg_run(a, grid, stream);
#elif MK_SPLIT
    for (int p = 0; p < N_PHASES; ++p) { a.ph_lo = p; a.ph_hi = p + 1; hipLaunchKernelGGL(fwd, dim3(grid), dim3(NTHR), LDS_BYTES, stream, a); }
#else
    a.ph_lo = 0; a.ph_hi = N_PHASES;
    hipLaunchKernelGGL(fwd, dim3(grid), dim3(NTHR), LDS_BYTES, stream, a);
#endif
}
```

```cpp
#define TR_NFAST 1
#define THIN_PF 1
#define EPI_PK 1
#include <hip/hip_runtime.h>
#include <cstdio>
#include <cstdint>

#define LAS __attribute__((address_space(3)))
#define GAS __attribute__((address_space(1)))
typedef unsigned short bf16_t;
typedef short bf16x8 __attribute__((ext_vector_type(8)));
typedef short s16x4 __attribute__((ext_vector_type(4)));
typedef float f32x4 __attribute__((ext_vector_type(4)));
typedef float f32x2 __attribute__((ext_vector_type(2)));
typedef unsigned u32x4 __attribute__((ext_vector_type(4)));
typedef unsigned u32x2 __attribute__((ext_vector_type(2)));

typedef __bf16 bf16x2_t __attribute__((ext_vector_type(2)));
__device__ __forceinline__ unsigned cvt_pk_bf16(float lo, float hi) { f32x2 v = {lo, hi}; const bf16x2_t b = __builtin_convertvector(v, bf16x2_t); return __builtin_bit_cast(unsigned, b); }
#ifndef WT_STORES
#define WT_STORES 1
#endif
#ifndef WT_AUX
#define WT_AUX 16
#endif
struct WT { __amdgpu_buffer_rsrc_t rs; const char* base; };
__device__ __forceinline__ WT make_wt(void* ws_base, unsigned nbytes) { WT w; w.rs = __builtin_amdgcn_make_buffer_rsrc(ws_base, 0, (int)nbytes, 0x00020000); w.base = (const char*)ws_base; return w; }
__device__ __forceinline__ void st16(const WT& w, void* p, u32x4 v) {
#if WT_STORES
    __builtin_amdgcn_raw_buffer_store_b128(v, w.rs, (int)(unsigned)((const char*)p - w.base), 0, WT_AUX);
#else
    *(u32x4*)p = v;
#endif
}
__device__ __forceinline__ void st8(const WT& w, void* p, u32x2 v) {
#if WT_STORES
    __builtin_amdgcn_raw_buffer_store_b64(v, w.rs, (int)(unsigned)((const char*)p - w.base), 0, WT_AUX);
#else
    *(u32x2*)p = v;
#endif
}
__device__ __forceinline__ float clamp8(float v) { return __builtin_amdgcn_fmed3f(v, -448.f, 448.f); }
__device__ __forceinline__ unsigned pk4_fp8(float a, float b, float c, float d) { int w = __builtin_amdgcn_cvt_pk_fp8_f32(clamp8(a), clamp8(b), 0, false); w = __builtin_amdgcn_cvt_pk_fp8_f32(clamp8(c), clamp8(d), w, true); return (unsigned)w; }
__device__ __forceinline__ float q8(float x, float s) { const int w = __builtin_amdgcn_cvt_pk_fp8_f32(x * s, 0.f, 0, false); return __builtin_amdgcn_cvt_f32_fp8(w, 0) * (1.0f / s); }
__device__ __forceinline__ float bf_lo(unsigned w) { return __uint_as_float(w << 16); }
__device__ __forceinline__ float bf_hi(unsigned w) { return __uint_as_float(w & 0xffff0000u); }
__device__ __forceinline__ float bf2f(bf16_t b) { return __uint_as_float(((unsigned)b) << 16); }
__device__ __forceinline__ float fast_sigmoid(float v) { return __builtin_amdgcn_rcpf(1.0f + __builtin_amdgcn_exp2f(-1.4426950408889634f * v)); }
__device__ __forceinline__ f32x2 lo2(f32x4 v) { return __builtin_shufflevector(v, v, 0, 1); }
__device__ __forceinline__ f32x2 hi2(f32x4 v) { return __builtin_shufflevector(v, v, 2, 3); }
__device__ __forceinline__ f32x4 cat2(f32x2 a, f32x2 b) { return __builtin_shufflevector(a, b, 0, 1, 2, 3); }
__device__ __forceinline__ f32x2 rcp_1p_exp2(f32x2 a) { const f32x2 d = (f32x2){__builtin_amdgcn_exp2f(a.x), __builtin_amdgcn_exp2f(a.y)} + (f32x2){1.0f, 1.0f}; return (f32x2){__builtin_amdgcn_rcpf(d.x), __builtin_amdgcn_rcpf(d.y)}; }
__device__ __forceinline__ f32x2 sigmoid2(f32x2 v) { return rcp_1p_exp2(v * (f32x2){-1.4426950408889634f, -1.4426950408889634f}); }
__device__ __forceinline__ f32x4 sigmoid4(f32x4 v) { return cat2(sigmoid2(lo2(v)), sigmoid2(hi2(v))); }
__device__ __forceinline__ float wave_sum(float v) {
#pragma unroll
    for (int o = 1; o < 64; o <<= 1) v += __shfl_xor(v, o);
    return v;
}

typedef int v8i32 __attribute__((ext_vector_type(8)));
typedef int v4i32 __attribute__((ext_vector_type(4)));
__device__ __forceinline__ v8i32 cat8i(bf16x8 a, bf16x8 b) { const v4i32 x = __builtin_bit_cast(v4i32, a), y = __builtin_bit_cast(v4i32, b); return (v8i32){x[0], x[1], x[2], x[3], y[0], y[1], y[2], y[3]}; }
namespace pg8 {
constexpr int BM = 256, BK = 64, HALF = 128, HTB = HALF * BK * 2, STAGE_BYTES = 8 * HTB, NXCD = 8, WGM = 8;
__host__ __device__ __forceinline__ int lds_byte(int r, int c) { const int st = (r >> 4) * 2 + (c >> 5), rr = r & 15, cc = c & 31, ob = rr * 64 + cc * 2; return st * 1024 + (ob ^ (((ob >> 9) & 1) << 5)); }
__host__ __device__ __forceinline__ void stage_rc(int b, int& R, int& C) { const int st = b / 1024, sb = b % 1024, swz = sb ^ (((sb >> 9) & 1) << 5); R = (st >> 1) * 16 + swz / 64; C = (st & 1) * 32 + (swz % 64) / 2; }
__host__ __device__ __forceinline__ int perm32(int rho) { const int n = rho >> 4, i = rho & 15; return 8 * (i >> 2) + 4 * n + (i & 3); }

struct Unit { int pm, pn, e, lr0, cnt, koff; };
struct Gemm { const bf16_t* A; const bf16_t* Bt; int K; size_t b_estride; const int* gidx; int ld; };

struct StaticOrder {
    int nM, nN, nwg, G, c;
    __device__ __forceinline__ void init(int M, int N, int G_, int c_) { nM = M / BM; nN = N / BM; nwg = nM * nN; G = G_; c = c_; }
    __device__ __forceinline__ bool short_deal() const { const int r = nwg % G; return r != 0 && c >= r; }
    __device__ __forceinline__ bool next(int i, Unit& u) const {
        const long L = (long)i * G + c; if (L >= nwg) return false;
        int wgid = (int)L; { const int q = nwg / NXCD, r = nwg % NXCD, xcd = wgid % NXCD, off = wgid / NXCD; wgid = (xcd < r ? xcd * (q + 1) : r * (q + 1) + (xcd - r) * q) + off; }
        const int nig = WGM * nN, gid = wgid / nig, fm = gid * WGM, gsz = (nM - fm) < WGM ? (nM - fm) : WGM;
        u.pm = fm + ((wgid % nig) % gsz); u.pn = (wgid % nig) / gsz; u.e = 0; u.lr0 = 0; u.cnt = 0; u.koff = 0; return true;
    }
};
struct GroupedOrder {
    int pb[9]; int cnt[8]; int nN, G, c, nwg, np;
    int i0 = 0, i1 = 1 << 30;
    __device__ __forceinline__ void init(const unsigned* counts, int N, int G_, int c_, int pmax = 1 << 30) {
        int acc = 0;
#pragma unroll
        for (int e = 0; e < 8; ++e) { const int n = (int)counts[e]; cnt[e] = n; pb[e] = acc; acc += (n + 255) >> 8; }
        pb[8] = acc; nN = N / BM; G = G_; c = c_; np = acc < pmax ? acc : pmax; nwg = np * nN;
    }
    __device__ __forceinline__ bool short_deal() const { const int r = nwg % G; return r != 0 && c >= r; }
    __device__ __forceinline__ bool next(int i, Unit& u) const {
        if (i + i0 >= i1) return false;
        const long L = (long)(i + i0) * G + c; if (L >= nwg) return false;
        const int nig = WGM * nN, gid = (int)L / nig, fm = gid * WGM, gsz = (np - fm) < WGM ? (np - fm) : WGM;
        const int pm = fm + (((int)L % nig) % gsz), pn = ((int)L % nig) / gsz;
        int e = 0;
#pragma unroll
        for (int k = 1; k < 8; ++k) e += (pm >= pb[k]) ? 1 : 0;
        int pbe = 0, ce = 0;
#pragma unroll
        for (int k = 0; k < 8; ++k) { pbe = (k == e) ? pb[k] : pbe; ce = (k == e) ? cnt[k] : ce; }
        u.pm = pm; u.pn = pn; u.e = e; u.lr0 = (pm - pbe) * 256; u.cnt = ce; u.koff = 0; return true;
    }
};

struct TailOrder {
    int pb[9]; int nN, G, c, nwg, p0, KC, KCH;
    __device__ __forceinline__ void init(const unsigned* counts, int N, int G_, int c_, int p0_, int KC_, int KCH_) {
        int acc = 0;
#pragma unroll
        for (int e = 0; e < 8; ++e) { pb[e] = acc; acc += ((int)counts[e] + 255) >> 8; }
        pb[8] = acc; nN = N / BM; G = G_; c = c_; p0 = p0_; KC = KC_; KCH = KCH_; nwg = acc > p0 ? (acc - p0) * nN * KC : 0;
    }
    __device__ __forceinline__ bool short_deal() const { return false; }
    __device__ __forceinline__ bool next(int i, Unit& u) const {
        const long L = (long)i * G + c; if (L >= nwg) return false;
        const int kc = (int)L % KC, t = (int)L / KC, pm = p0 + t / nN, pn = t % nN;
        int e = 0;
#pragma unroll
        for (int k = 1; k < 8; ++k) e += (pm >= pb[k]) ? 1 : 0;
        u.pm = pm; u.pn = pn; u.e = e; u.lr0 = 0; u.cnt = 0; u.koff = kc * KCH; return true;
    }
};

template <class Epi, class Sched, bool GATHER, bool F8 = false>
__device__ __forceinline__ void gemm_phase(LAS unsigned char* lds, const Gemm g, const Sched& S, const Epi& E, int stag = 0) {
    int tid = threadIdx.x; asm volatile("" : "+v"(tid));
    const int wid = __builtin_amdgcn_readfirstlane(tid >> 6), lane = tid & 63, wr = wid >> 2, wc = wid & 3, fr = lane & 15, fq = lane >> 4;
    const int K = g.K, nt = K / BK, LD = g.ld ? g.ld : g.K;
    unsigned voffA[2], voffB[2]; int rA[2];
#pragma unroll
    for (int i = 0; i < 2; ++i) { int R, C; stage_rc(tid * 16 + i * 8192, R, C); const int Rb = Epi::PERM ? ((R & ~31) + perm32(R & 31)) : R;
        voffA[i] = GATHER ? (unsigned)(C * 2) : (unsigned)(R * LD + C) * 2u; voffB[i] = (unsigned)(Rb * LD + C) * 2u; rA[i] = R; }
    const size_t kstep = (size_t)(BK * 2);
    const size_t hstep = (size_t)HALF * LD * 2;
    const size_t tstep = 2 * hstep;
    const unsigned ldsw = (unsigned)wid * 1024u;
    const int aoff = F8 ? lds_byte(wr * 64 + fr, fq * 16) : lds_byte(wr * 64 + fr, fq * 8), boff = F8 ? lds_byte(wc * 32 + fr, fq * 16) : lds_byte(wc * 32 + fr, fq * 8);
    const int aof1 = F8 ? lds_byte(wr * 64 + fr, fq * 16 + 8) : aoff + 1024, bof1 = F8 ? lds_byte(wc * 32 + fr, fq * 16 + 8) : boff + 1024;
#define PG8_SA(b, h) (((b) * 2 + (h)) * HTB)
#define PG8_SB(b, h) ((4 + (b) * 2 + (h)) * HTB)
#define PG8_STAGE2(bufoff, gbase, v0, v1) do { unsigned _a = (v0), _b = (v1); asm volatile("" : "+v"(_a), "+v"(_b));     \
        __builtin_amdgcn_global_load_lds((const unsigned*)((const char*)(gbase) + _a), (LAS unsigned*)(lds + (bufoff) + ldsw), 16, 0, 0); \
        __builtin_amdgcn_global_load_lds((const unsigned*)((const char*)(gbase) + _b), (LAS unsigned*)(lds + (bufoff) + ldsw + 8192), 16, 0, 0); } while (0)
#define PG8_STAGE(bufoff, gbase, voff) PG8_STAGE2(bufoff, gbase, (voff)[0], (voff)[1])
#define PG8_STAGE_A(bufoff, nx, h, kt) do { \
        if constexpr (GATHER) { const char* _p = (const char*)g.A + (size_t)(kt) * kstep; \
            if (nx) { PG8_STAGE2(bufoff, _p, nG[h][0], nG[h][1]); } else { PG8_STAGE2(bufoff, _p, cG[h][0], cG[h][1]); } } \
        else { const char* _p = ((nx) ? nA : cA) + (size_t)(h) * hstep + (size_t)(kt) * kstep; PG8_STAGE2(bufoff, _p, voffA[0], voffA[1]); } } while (0)
#define PG8_LDA(dst, b, h) do { _Pragma("unroll") for (int m = 0; m < 4; ++m) { \
        if constexpr (F8) { dst##8[m].lo = *(const LAS v4i32*)(lds + PG8_SA(b, h) + aoff + m * 2048); dst##8[m].hi = *(const LAS v4i32*)(lds + PG8_SA(b, h) + aof1 + m * 2048); } \
        else { dst[m][0] = *(const LAS bf16x8*)(lds + PG8_SA(b, h) + aoff + m * 2048); dst[m][1] = *(const LAS bf16x8*)(lds + PG8_SA(b, h) + aof1 + m * 2048); } } } while (0)
#define PG8_LDB(dst, b, h) do { _Pragma("unroll") for (int n = 0; n < 2; ++n) { \
        if constexpr (F8) { dst##8[n].lo = *(const LAS v4i32*)(lds + PG8_SB(b, h) + boff + n * 2048); dst##8[n].hi = *(const LAS v4i32*)(lds + PG8_SB(b, h) + bof1 + n * 2048); } \
        else { dst[n][0] = *(const LAS bf16x8*)(lds + PG8_SB(b, h) + boff + n * 2048); dst[n][1] = *(const LAS bf16x8*)(lds + PG8_SB(b, h) + bof1 + n * 2048); } } } while (0)
#define PG8_MMA(ai, bj, At, Bt) do { __builtin_amdgcn_s_setprio(1); _Pragma("unroll") for (int m = 0; m < 4; ++m) _Pragma("unroll") for (int n = 0; n < 2; ++n) { \
        if constexpr (F8) asm volatile("v_mfma_scale_f32_16x16x128_f8f6f4 %0, %1, %2, %0, %3, %3 op_sel_hi:[0,0,0]" : "+v"(acc[ai][bj][m][n]) : "v"(Bt##8[n]), "v"(At##8[m]), "v"(one8));   \
        else { _Pragma("unroll") for (int k = 0; k < 2; ++k) acc[ai][bj][m][n] = __builtin_amdgcn_mfma_f32_16x16x32_bf16(Bt[n][k], At[m][k], acc[ai][bj][m][n], 0, 0, 0); } } __builtin_amdgcn_s_setprio(0); } while (0)
#define PG8_WAIT_V(n) asm volatile("s_waitcnt vmcnt(" #n ")" ::: "memory")
#define PG8_WAIT_L(n) asm volatile("s_waitcnt lgkmcnt(" #n ")" ::: "memory")
#ifndef GRACE
#define GRACE 0
#endif
#define PG8_WAIT_VG(first) do { if (first) { asm volatile("s_waitcnt vmcnt(%0)" :: "n"(8 + Epi::NVM) : "memory"); } else { PG8_WAIT_V(8); } } while (0)
#define PG8_BAR __builtin_amdgcn_s_barrier()
#define PG8_SCHED __builtin_amdgcn_sched_barrier(0)
#define PG8_GIDX(dst, u) do { _Pragma("unroll") for (int h = 0; h < 2; ++h) _Pragma("unroll") for (int i = 0; i < 2; ++i) { \
        const int _lr = (u).lr0 + h * HALF + rA[i]; const int _tok = (_lr < (u).cnt) ? g.gidx[(u).e * 16384 + _lr] : 0; dst[h][i] = (unsigned)_tok * (unsigned)(LD * 2) + voffA[i]; } } while (0)
    Unit cur, nxt; int ui = 0;
    if (!S.next(0, cur)) return;
    if (stag > 0) { const int grp = ((int)blockIdx.x >> 3) & 3;
        if (grp) { const unsigned long long t0 = __builtin_amdgcn_s_memrealtime(); while (__builtin_amdgcn_s_memrealtime() - t0 < (unsigned long long)(grp * stag)) __builtin_amdgcn_s_sleep(2); } }
#ifdef STAGGER_TICKS
    if (S.short_deal()) { const unsigned long long t0 = __builtin_amdgcn_s_memrealtime(); while (__builtin_amdgcn_s_memrealtime() - t0 < (unsigned long long)(STAGGER_TICKS)) __builtin_amdgcn_s_sleep(8); }
#endif
    f32x4 acc[2][2][4][2];
#pragma unroll
    for (int a = 0; a < 2; ++a)
#pragma unroll
        for (int b = 0; b < 2; ++b)
#pragma unroll
            for (int m = 0; m < 4; ++m)
#pragma unroll
                for (int n = 0; n < 2; ++n) acc[a][b][m][n] = (f32x4){0.f, 0.f, 0.f, 0.f};
    const int one8 = 0x7f7f7f7f;
    bf16x8 At[4][2], B0[2][2], B1[2][2]; v8i32 At8[4], B08[2], B18[2];
    unsigned cG[2][2] = {{0u, 0u}, {0u, 0u}}, nG[2][2] = {{0u, 0u}, {0u, 0u}};
    const char* cA = (const char*)g.A + (size_t)cur.pm * tstep + (size_t)cur.koff * 2; const char* cB = (const char*)g.Bt + ((size_t)cur.e * g.b_estride + (size_t)cur.koff) * 2 + (size_t)cur.pn * tstep;
    const char* nA = cA;
    if constexpr (GATHER) { PG8_GIDX(cG, cur); }
    PG8_STAGE(PG8_SB(0, 0), cB, voffB); PG8_STAGE(PG8_SB(0, 1), cB + hstep, voffB); PG8_STAGE_A(PG8_SA(0, 0), false, 0, 0); PG8_STAGE_A(PG8_SA(0, 1), false, 1, 0);
    if (wr == 1) PG8_BAR;
    PG8_WAIT_V(2); PG8_BAR;
    PG8_STAGE(PG8_SB(1, 0), cB + kstep, voffB); PG8_STAGE_A(PG8_SA(1, 0), false, 0, 1); PG8_STAGE(PG8_SB(1, 1), cB + hstep + kstep, voffB);
    PG8_WAIT_V(6); PG8_BAR;
    for (;;) {
        const bool has_next = S.next(ui + 1, nxt);
        nA = has_next ? (const char*)g.A + (size_t)nxt.pm * tstep + (size_t)nxt.koff * 2 : cA;
        const char* nB = has_next ? (const char*)g.Bt + ((size_t)nxt.e * g.b_estride + (size_t)nxt.koff) * 2 + (size_t)nxt.pn * tstep : cB;
        if constexpr (GATHER) { if (has_next) { PG8_GIDX(nG, nxt); } else {
#pragma unroll
            for (int h = 0; h < 2; ++h)
#pragma unroll
                for (int i = 0; i < 2; ++i) nG[h][i] = cG[h][i]; } }
#pragma nounroll
        for (int t = 0; t < nt; t += 2) {
            const bool last = (t == nt - 2);
            const bool first = GRACE && (t == 0) && (ui > 0);
            const int kt2 = last ? 0 : t + 2, kt3 = kt2 + 1;
            const char* b2 = last ? nB : cB + (size_t)(t + 2) * kstep;
            const char* b3 = b2 + kstep;
            PG8_LDB(B0, 0, 0); PG8_LDB(B1, 0, 1); PG8_SCHED; PG8_LDA(At, 0, 0); if (!first) { PG8_STAGE_A(PG8_SA(1, 1), false, 1, t + 1); }
            PG8_WAIT_VG(first); PG8_WAIT_L(0); PG8_BAR; PG8_MMA(0, 0, At, B0); PG8_MMA(0, 1, At, B1); PG8_BAR; PG8_SCHED;
            PG8_LDA(At, 0, 1); PG8_STAGE(PG8_SB(0, 0), b2, voffB); PG8_STAGE(PG8_SB(0, 1), b2 + hstep, voffB); PG8_STAGE_A(PG8_SA(0, 0), last, 0, kt2);
            PG8_WAIT_VG(first); PG8_WAIT_L(0); PG8_BAR; PG8_MMA(1, 0, At, B0); PG8_MMA(1, 1, At, B1); PG8_BAR; PG8_SCHED;
            PG8_LDB(B0, 1, 0); PG8_LDB(B1, 1, 1); PG8_SCHED; PG8_LDA(At, 1, 0); PG8_STAGE_A(PG8_SA(0, 1), last, 1, kt2);
            PG8_WAIT_VG(first); PG8_WAIT_L(0); PG8_BAR; PG8_MMA(0, 0, At, B0); PG8_MMA(0, 1, At, B1); PG8_BAR; PG8_SCHED;
            PG8_LDA(At, 1, 1); PG8_STAGE(PG8_SB(1, 0), b3, voffB); PG8_STAGE(PG8_SB(1, 1), b3 + hstep, voffB); PG8_STAGE_A(PG8_SA(1, 0), last, 0, kt3);
            PG8_WAIT_V(8); PG8_WAIT_L(0); PG8_BAR; PG8_MMA(1, 0, At, B0); PG8_MMA(1, 1, At, B1); PG8_BAR; PG8_SCHED;
        }
        if (GRACE && has_next) { PG8_STAGE_A(PG8_SA(1, 1), true, 1, 1); }
        if constexpr (F8) asm volatile("s_nop 15\n\ts_nop 15" ::: "memory");
        if (wr == 0) PG8_BAR;
        { Unit eu = cur; eu.pm = __builtin_amdgcn_readfirstlane(eu.pm); eu.pn = __builtin_amdgcn_readfirstlane(eu.pn); asm volatile("" : "+s"(eu.pm), "+s"(eu.pn));
          E(acc, eu, wr, wc, fr, fq);
#ifdef EPI2
          if constexpr (Epi::P2) { if (EPI2 == 1) E(acc, eu, wr, wc, fr, fq); else E.template run<EPI2 == 2 ? 0 : EPI2 - 1>(acc, eu, wr, wc, fr, fq); }
#endif
        }
        if (!has_next) break;
#pragma unroll
        for (int a = 0; a < 2; ++a)
#pragma unroll
            for (int b = 0; b < 2; ++b)
#pragma unroll
                for (int m = 0; m < 4; ++m)
#pragma unroll
                    for (int n = 0; n < 2; ++n) acc[a][b][m][n] = (f32x4){0.f, 0.f, 0.f, 0.f};
        cur = nxt; cA = nA; cB = nB; ++ui;
        if constexpr (GATHER) {
#pragma unroll
            for (int h = 0; h < 2; ++h)
#pragma unroll
                for (int i = 0; i < 2; ++i) cG[h][i] = nG[h][i]; }
        if (wr == 1) PG8_BAR;
    }
    PG8_WAIT_V(0);
    PG8_BAR;
#undef PG8_SA
#undef PG8_SB
#undef PG8_STAGE
#undef PG8_STAGE2
#undef PG8_STAGE_A
#undef PG8_LDA
#undef PG8_LDB
#undef PG8_MMA
#undef PG8_WAIT_V
#undef PG8_WAIT_VG
#undef PG8_WAIT_L
#undef PG8_BAR
#undef PG8_SCHED
#undef PG8_GIDX
}
}
namespace pg8 {
constexpr size_t WS_DUMMY = (size_t)467 << 20;
constexpr float QA_SCALE = 0.125f * 1.4426950408889634f;
constexpr float QB_SCALE = 0.125f;

struct EpiInProj {
    static constexpr bool PERM = true, IDEM = true; static constexpr bool P2 = true; static constexpr int NVM = 16;
    bf16_t* base; WT wt;
    template <int ACT>
    __device__ __forceinline__ void body(const f32x4 (&acc)[2][2][4][2], bf16_t* O, int row0, int col0, int ld, float sc) const {
#pragma unroll
        for (int ai = 0; ai < 2; ++ai)
#pragma unroll
            for (int m = 0; m < 4; ++m) { bf16_t* rowp = O + (size_t)(row0 + ai * HALF + m * 16) * ld + col0;
#pragma unroll
                for (int bj = 0; bj < 2; ++bj) { f32x4 v0 = acc[ai][bj][m][0], v1 = acc[ai][bj][m][1];
                    if (ACT == 3) { v0 = v0 * sc; v1 = v1 * sc; }
                    if (ACT == 2) { v0 = sigmoid4(v0); v1 = sigmoid4(v1); }
                    if (ACT == 1) { v0 = v0 * sigmoid4(v0); v1 = v1 * sigmoid4(v1); }
                    u32x4 w; w.x = cvt_pk_bf16(v0[0], v0[1]); w.y = cvt_pk_bf16(v0[2], v0[3]); w.z = cvt_pk_bf16(v1[0], v1[1]); w.w = cvt_pk_bf16(v1[2], v1[3]);
                    st16(wt, rowp + bj * HALF, w); } }
    }
    __device__ __forceinline__ void operator()(const f32x4 (&acc)[2][2][4][2], const Unit& u, int wr, int wc, int fr, int fq) const { run<1>(acc, u, wr, wc, fr, fq); }
    template <int ST> __device__ __forceinline__ void run(const f32x4 (&acc)[2][2][4][2], const Unit& u, int wr, int wc, int fr, int fq) const {
        const int pn = u.pn;
        size_t toff; int ld, ct; float sc = 1.f; int act = 0;
        constexpr size_t Mi = 1u << 20;
        if (pn < 2)       { toff = 16 * Mi; ld = 512; ct = pn; sc = QA_SCALE; }
        else if (pn < 4)  { toff = 24 * Mi; ld = 512; ct = pn - 2; }
        else if (pn < 6)  { toff = 32 * Mi; ld = 512; ct = pn - 4; }
        else if (pn < 7)  { toff = 0; ld = 256; ct = 0; sc = QB_SCALE; }
        else if (pn < 8)  { toff = 4 * Mi; ld = 256; ct = 0; }
        else if (pn < 10) { toff = 8 * Mi; ld = 512; ct = pn - 8; }
        else if (pn < 12) { toff = 40 * Mi; ld = 512; ct = pn - 10; act = 1; }
        else if (pn < 16) { toff = 48 * Mi; ld = 1024; ct = pn - 12; act = 2; }
        else              { toff = 64 * Mi; ld = 1024; ct = pn - 16; act = 2; }
        const int row0 = u.pm * BM + wr * 64 + fr, col0 = ct * BM + wc * 32 + 8 * fq;
        bf16_t* O = base + toff;
#ifdef EPI_PK
        if (ST == 1) {
            if (act == 2) body<2>(acc, O, row0, col0, ld, 1.f); else if (act == 1) body<1>(acc, O, row0, col0, ld, 1.f); else if (sc != 1.f) body<3>(acc, O, row0, col0, ld, sc); else body<0>(acc, O, row0, col0, ld, 1.f);
            return; }
#endif
#pragma unroll
        for (int ai = 0; ai < 2; ++ai)
#pragma unroll
            for (int m = 0; m < 4; ++m) { bf16_t* rowp = O + (size_t)(row0 + ai * HALF + m * 16) * ld + col0;
#pragma unroll
                for (int bj = 0; bj < 2; ++bj) { f32x4 v0 = acc[ai][bj][m][0] * sc, v1 = acc[ai][bj][m][1] * sc;
                    if (act) {
#pragma unroll
                        for (int j = 0; j < 4; ++j) { const float s0 = fast_sigmoid(v0[j]), s1 = fast_sigmoid(v1[j]); v0[j] = (act == 1) ? v0[j] * s0 : s0; v1[j] = (act == 1) ? v1[j] * s1 : s1; } }
                    u32x4 w; w.x = cvt_pk_bf16(v0[0], v0[1]); w.y = cvt_pk_bf16(v0[2], v0[3]); w.z = cvt_pk_bf16(v1[0], v1[1]); w.w = cvt_pk_bf16(v1[2], v1[3]);
                    if (ST == 1) st16(wt, rowp + bj * HALF, w);
                    else if (ST == 0) asm volatile("" :: "v"(w.x), "v"(w.y), "v"(w.z), "v"(w.w), "v"(rowp));
                    else { unsigned char* db = (unsigned char*)wt.base + WS_DUMMY + (size_t)blockIdx.x * 131072 + (wr * 4 + wc) * 16384; const int k = (ai * 4 + m) * 2 + bj;
                        st16(wt, db + (ST == 2 ? fr * 1024 + k * 64 + fq * 16 : k * 1024 + (fq * 16 + fr) * 16), w); } } }
    }
};

template <int MODE> struct EpiEw {
    static constexpr bool PERM = true, IDEM = (MODE != 2 && MODE != 4); static constexpr bool P2 = false; static constexpr int NVM = 16;
    bf16_t* O; const bf16_t* G; int ldc; WT wt; float sc = 1.f;
    __device__ __forceinline__ void operator()(const f32x4 (&acc)[2][2][4][2], const Unit& u, int wr, int wc, int fr, int fq) const {
        const int row0 = u.pm * BM + wr * 64 + fr, col0 = u.pn * BM + wc * 32 + 8 * fq;
#pragma unroll
        for (int ai = 0; ai < 2; ++ai)
#pragma unroll
            for (int m = 0; m < 4; ++m) { const size_t ro = (size_t)(row0 + ai * HALF + m * 16) * ldc + col0;
#pragma unroll
                for (int bj = 0; bj < 2; ++bj) { f32x4 v0 = acc[ai][bj][m][0], v1 = acc[ai][bj][m][1];
                    if (MODE == 0) { v0 = v0 * sc; v1 = v1 * sc; }
                    if (MODE == 1 || MODE == 2) { const u32x4 gw = *(const u32x4*)(G + ro + bj * HALF);
                        v0[0] *= bf_lo(gw.x); v0[1] *= bf_hi(gw.x); v0[2] *= bf_lo(gw.y); v0[3] *= bf_hi(gw.y); v1[0] *= bf_lo(gw.z); v1[1] *= bf_hi(gw.z); v1[2] *= bf_lo(gw.w); v1[3] *= bf_hi(gw.w); }
                    if (MODE == 3) {
#ifdef EPI_PK
                        v0 = sigmoid4(v0); v1 = sigmoid4(v1);
#else
#pragma unroll
                        for (int j = 0; j < 4; ++j) { v0[j] = fast_sigmoid(v0[j]); v1[j] = fast_sigmoid(v1[j]); }
#endif
                    }
                    if (MODE == 2 || MODE == 4) { const u32x4 ow = *(const u32x4*)(O + ro + bj * HALF);
                        if (MODE == 2) { v0[0] += bf_lo(ow.x); v0[1] += bf_hi(ow.x); v0[2] += bf_lo(ow.y); v0[3] += bf_hi(ow.y); v1[0] += bf_lo(ow.z); v1[1] += bf_hi(ow.z); v1[2] += bf_lo(ow.w); v1[3] += bf_hi(ow.w); }
                        else { v0[0] *= bf_lo(ow.x); v0[1] *= bf_hi(ow.x); v0[2] *= bf_lo(ow.y); v0[3] *= bf_hi(ow.y); v1[0] *= bf_lo(ow.z); v1[1] *= bf_hi(ow.z); v1[2] *= bf_lo(ow.w); v1[3] *= bf_hi(ow.w); } }
                    u32x4 w; w.x = cvt_pk_bf16(v0[0], v0[1]); w.y = cvt_pk_bf16(v0[2], v0[3]); w.z = cvt_pk_bf16(v1[0], v1[1]); w.w = cvt_pk_bf16(v1[2], v1[3]);
                    st16(wt, O + ro + bj * HALF, w); } }
    }
};

struct EpiPart {
    static constexpr bool PERM = true, IDEM = true, P2 = false; static constexpr int NVM = 16;
    bf16_t* P; int ldc, p0, KCH; size_t plane; WT wt; float sc = 1.f;
    __device__ __forceinline__ void operator()(const f32x4 (&acc)[2][2][4][2], const Unit& u, int wr, int wc, int fr, int fq) const {
        const int row0 = (u.pm - p0) * BM + wr * 64 + fr, col0 = u.pn * BM + wc * 32 + 8 * fq;
        bf16_t* O = P + (size_t)(u.koff / KCH) * plane;
#pragma unroll
        for (int ai = 0; ai < 2; ++ai)
#pragma unroll
            for (int m = 0; m < 4; ++m) { const size_t ro = (size_t)(row0 + ai * HALF + m * 16) * ldc + col0;
#pragma unroll
                for (int bj = 0; bj < 2; ++bj) { const f32x4 v0 = acc[ai][bj][m][0] * sc, v1 = acc[ai][bj][m][1] * sc;
                    u32x4 w; w.x = cvt_pk_bf16(v0[0], v0[1]); w.y = cvt_pk_bf16(v0[2], v0[3]); w.z = cvt_pk_bf16(v1[0], v1[1]); w.w = cvt_pk_bf16(v1[2], v1[3]);
                    st16(wt, O + ro + bj * HALF, w); } }
    }
};

struct EpiGateUp {
    static constexpr bool PERM = true, IDEM = true, P2 = false; static constexpr int NVM = 8;
    bf16_t* O; int ldc; WT wt; float qs;
    __device__ __forceinline__ void operator()(const f32x4 (&acc)[2][2][4][2], const Unit& u, int wr, int wc, int fr, int fq) const {
        const int row0 = u.pm * BM + wr * 64 + fr, col0 = u.pn * HALF + wc * 32 + 8 * fq;
#pragma unroll
        for (int ai = 0; ai < 2; ++ai)
#pragma unroll
            for (int m = 0; m < 4; ++m) { bf16_t* rowp = O + (size_t)(row0 + ai * HALF + m * 16) * ldc + col0;
                f32x4 v0, v1;
#if defined(EPI_PK) && !defined(SIM_FP8) && !defined(SIM_FFN0)
                v0 = acc[ai][0][m][0] * acc[ai][1][m][0] * sigmoid4(acc[ai][0][m][0]); v1 = acc[ai][0][m][1] * acc[ai][1][m][1] * sigmoid4(acc[ai][0][m][1]);
#endif
#pragma unroll
                for (int j = 0; j < 4; ++j) {
#if defined(EPI_PK) && !defined(SIM_FP8) && !defined(SIM_FFN0)
                    break;
#endif
                    const float g0 = acc[ai][0][m][0][j], g1 = acc[ai][0][m][1][j];
                    v0[j] = g0 * fast_sigmoid(g0) * acc[ai][1][m][0][j]; v1[j] = g1 * fast_sigmoid(g1) * acc[ai][1][m][1][j];
#if defined(SIM_FP8) || defined(SIM_FFN0)
                    if (qs != 0.f) { v0[j] = q8(v0[j], qs); v1[j] = q8(v1[j], qs); }
#endif
                }
                u32x4 w; w.x = cvt_pk_bf16(v0[0], v0[1]); w.y = cvt_pk_bf16(v0[2], v0[3]); w.z = cvt_pk_bf16(v1[0], v1[1]); w.w = cvt_pk_bf16(v1[2], v1[3]);
                st16(wt, rowp, w); }
    }
};
struct EpiGateUp8 {
    static constexpr bool PERM = true, IDEM = true, P2 = false; static constexpr int NVM = 8;
    unsigned char* O; int ldc; WT wt; float sin, sout;
    __device__ __forceinline__ void operator()(const f32x4 (&acc)[2][2][4][2], const Unit& u, int wr, int wc, int fr, int fq) const {
        const int row0 = u.pm * BM + wr * 64 + fr, col0 = u.pn * HALF + wc * 32 + 8 * fq;
#pragma unroll
        for (int ai = 0; ai < 2; ++ai)
#pragma unroll
            for (int m = 0; m < 4; ++m) { unsigned char* rowp = O + (size_t)(row0 + ai * HALF + m * 16) * ldc + col0;
                f32x4 v0, v1;
#ifdef EPI_PK
                { const float ca = -1.4426950408889634f * sin, cs = sin * sin * sout;
                  const f32x4 g0 = acc[ai][0][m][0], g1 = acc[ai][0][m][1];
                  v0 = (g0 * acc[ai][1][m][0]) * cs * cat2(rcp_1p_exp2(lo2(g0) * (f32x2){ca, ca}), rcp_1p_exp2(hi2(g0) * (f32x2){ca, ca}));
                  v1 = (g1 * acc[ai][1][m][1]) * cs * cat2(rcp_1p_exp2(lo2(g1) * (f32x2){ca, ca}), rcp_1p_exp2(hi2(g1) * (f32x2){ca, ca})); }
#else
#pragma unroll
                for (int j = 0; j < 4; ++j) { const float g0 = acc[ai][0][m][0][j] * sin, g1 = acc[ai][0][m][1][j] * sin;
                    v0[j] = g0 * fast_sigmoid(g0) * (acc[ai][1][m][0][j] * (sin * sout)); v1[j] = g1 * fast_sigmoid(g1) * (acc[ai][1][m][1][j] * (sin * sout)); }
#endif
                u32x2 w; w.x = pk4_fp8(v0[0], v0[1], v0[2], v0[3]); w.y = pk4_fp8(v1[0], v1[1], v1[2], v1[3]);
                *(u32x2*)rowp = w; }
    }
};
}
#ifndef MK_DBG
#define MK_DBG 0
#endif
#ifndef MOE_FP8
#define MOE_FP8 1
#endif
constexpr int D = 1024, NB = 8, SEQ = 2048, T = NB * SEQ, DEPTH = 2, CH = 64, NCH = SEQ / CH, NPREV = 8;
constexpr int AH = 8, BH = 4, GR = 16, DFF = 2816, NE = 8, DFE = 3584, PLE = 256, INW = 5136, INWG = 5120, RELN = 257;
constexpr float EPS = 1e-6f, LOG2E = 1.4426950408889634f;
constexpr int NWAVES = 8, NTHR = 512;
constexpr int MOE_ROWS = 34816;

constexpr size_t MiB = 1u << 20;
constexpr size_t WS_CTL = 0, CTL_ZERO_BYTES = 256 * 1024;
constexpr size_t WS_TOKINFO = 1 * MiB;
constexpr size_t WS_IDXE = 2 * MiB;
constexpr size_t WS_DEC = 3 * MiB;
constexpr size_t WS_W1 = 4 * MiB;
constexpr size_t WS_PB = 189 * MiB;
constexpr size_t WS_G = 205 * MiB;
constexpr size_t WS_HB = WS_G, WS_DST = WS_G + 32 * MiB, WS_YSLOT = WS_G;
constexpr size_t WS_BIG = 273 * MiB;
constexpr size_t WS_W0 = WS_BIG, WS_PROJ = WS_BIG + 34 * MiB, WS_MACT = WS_BIG;
constexpr size_t WS_Y = WS_PROJ;
constexpr size_t WS_QB = WS_PROJ, WS_KB = WS_PROJ + 8 * MiB, WS_VB = WS_PROJ + 16 * MiB, WS_QA = WS_PROJ + 32 * MiB, WS_KA = WS_PROJ + 48 * MiB, WS_VA = WS_PROJ + 64 * MiB;
constexpr size_t WS_SR = WS_PROJ + 80 * MiB, WS_SGA = WS_PROJ + 96 * MiB, WS_SGB = WS_PROJ + 128 * MiB;
constexpr size_t WS_MERGED = WS_KA;
constexpr size_t WS_ST = WS_KA;
constexpr size_t WS_FACT = WS_QA;
constexpr size_t WS_YA = WS_PROJ + 160 * MiB, WS_YB = WS_PROJ + 176 * MiB;
constexpr size_t WS_XB = WS_SGB;
constexpr int MOE_MAIN_PANELS = 128, MOE_MAIN_ROWS = MOE_MAIN_PANELS * 256, TAIL_KC = MOE_FP8 ? 7 : 14, TAIL_KCH = 256  , TAIL_ROWS = MOE_ROWS - MOE_MAIN_ROWS;
constexpr size_t WS_END = 511 * MiB;
static_assert(WS_FACT + (size_t)T * DFF * 2 <= WS_XB && WS_MACT + (size_t)MOE_ROWS * DFE * 2 <= WS_END && WS_YSLOT + (size_t)MOE_ROWS * D * 2 <= WS_BIG && WS_SGB + 32 * MiB <= WS_YA && WS_YB + 16 * MiB <= WS_END, "d_ws map");
constexpr size_t OFF_WIN = 0, OFF_WGD = 10 * MiB, OFF_WBA = 10 * MiB + 65536, OFF_WBB = OFF_WBA + 1 * MiB, OFF_WOUT = OFF_WBB + 1 * MiB, OFF_WPP = OFF_WOUT + 2 * MiB, OFF_WPG = OFF_WPP + MiB / 2;
constexpr size_t OFF_FFN = 17 * MiB;
constexpr size_t OFF_FDN = OFF_FFN + 11 * MiB, OFF_MDN = OFF_FFN + 8 * 14 * MiB;
constexpr size_t OFF_MDN8 = OFF_FFN + 8 * 7 * MiB;
constexpr float W8_SCALE = 64.f, ACT8_SCALE = 8.f;
constexpr size_t WS_XS = WS_W1 + OFF_MDN8 + 8 * 7 * MiB / 2;
static_assert(MOE_FP8 && WS_XS + (size_t)T * D * 2 <= WS_PB, "x stream placement needs the e4m3 weight layout");
constexpr size_t WS_PBUF = WS_W1 + OFF_FFN;
static_assert((size_t)TAIL_KC * TAIL_ROWS * D * 2 <= (MOE_FP8 ? 8 * 7 : 8 * 14) * MiB, "partial planes");
static_assert(OFF_WPG + 2 * MiB <= OFF_FFN && WS_W1 + OFF_MDN + 8 * 7 * MiB <= WS_PB && OFF_FDN + (size_t)D * DFF * 2 <= 34 * MiB, "weight map");
constexpr int CW_BAR = 4096;
constexpr int CW_CNT = 8192;
constexpr int CW_DBG = 16384;

constexpr int RING_BYTES = 131072;
constexpr int LDSCTL_OFF = RING_BYTES, MISC_OFF = LDSCTL_OFF + 320;
constexpr int XTRA_OFF = RING_BYTES + 1024;
constexpr int LDS_BYTES = 147456;

typedef GAS unsigned gu32;
#define RLX_AGENT __ATOMIC_RELAXED, __HIP_MEMORY_SCOPE_AGENT
#define LDS_WAIT() asm volatile("s_waitcnt lgkmcnt(0)" ::: "memory")
#define VM_WAIT() asm volatile("s_waitcnt vmcnt(0)" ::: "memory")

#define XB_TMO      128
#define XB_XCNT(j)  (256  + 64 * (j))
#define XB_XSUB(j)  (1280 + 64 * (j))
#define XB_XGEN(j)  (2304 + 64 * (j))
#define XB_TOP      3328
#define XB_TOPGEN   3392
#define XCD_BAR_WORDS 3456
#define XB_SPIN_CAP (1u << 18)
__device__ __forceinline__ unsigned xb_ld(unsigned* p)              { return __hip_atomic_load(p, __ATOMIC_RELAXED, __HIP_MEMORY_SCOPE_AGENT); }
__device__ __forceinline__ unsigned xb_add(unsigned* p, unsigned v) { return __hip_atomic_fetch_add(p, v, __ATOMIC_RELAXED, __HIP_MEMORY_SCOPE_AGENT); }
__device__ __forceinline__ unsigned xb_xcc_id() { return (unsigned)__builtin_amdgcn_s_getreg((3 << 11) | 20) & 0xFu; }
#define XB_SPIN(cond, bar) do { unsigned _sp = 0; while (cond) { __builtin_amdgcn_s_sleep(1); \
    if ((++_sp & 255u) == 0u) { if (xb_ld(&(bar)[XB_TMO])) break; if (_sp > XB_SPIN_CAP) { atomicAdd(&(bar)[XB_TMO], 1u); break; } } } } while (0)
struct XcdBarrier { unsigned* bar; unsigned x; volatile LAS unsigned* st; };
__device__ __forceinline__ XcdBarrier xcd_barrier_post(unsigned* bar, volatile LAS unsigned* st) {
    XcdBarrier b; b.bar = bar; b.x = xb_xcc_id(); b.st = st;
    if (threadIdx.x == 0) (void)xb_add(&bar[XB_XCNT(b.x)], 1u);
    return b;
}
__device__ __forceinline__ void xcd_barrier_complete(unsigned* bar, unsigned x, unsigned& nloc, unsigned& nx) {
    const unsigned G = gridDim.x * gridDim.y * gridDim.z;
    unsigned sum, cnt, mine, sp = 0u;
    for (;;) {
        sum = 0u; cnt = 0u; mine = 0u;
#pragma unroll
        for (unsigned j = 0; j < 16; ++j) { const unsigned c = xb_ld(&bar[XB_XCNT(j)]); sum += c; cnt += (c > 0u) ? 1u : 0u; mine = (j == x) ? c : mine; }
        if (sum == G) break;
        __builtin_amdgcn_s_sleep(1);
        if ((++sp & 255u) == 0u) { if (xb_ld(&bar[XB_TMO])) break; if (sp > XB_SPIN_CAP) { atomicAdd(&bar[XB_TMO], 1u); break; } }
    }
    nloc = mine > 0u ? mine : 1u; nx = cnt > 0u ? cnt : 1u;
}
__device__ __forceinline__ void xcd_barrier(const XcdBarrier& b) {
    asm volatile("s_waitcnt vmcnt(0)" ::: "memory");
    __syncthreads();
    if (threadIdx.x == 0) {
        unsigned* bar = b.bar;
        __builtin_amdgcn_s_waitcnt(0);
        unsigned nloc = b.st[0], nx = b.st[1];
        if (nloc == 0u) { xcd_barrier_complete(bar, b.x, nloc, nx); b.st[0] = nloc; b.st[1] = nx; }
        const unsigned old = xb_add(&bar[XB_XSUB(b.x)], 1u);
        const unsigned gen = old / nloc;
        if (old + 1u == (gen + 1u) * nloc) {
            __builtin_amdgcn_fence(__ATOMIC_RELEASE, "agent");
            asm volatile("s_waitcnt vmcnt(0)" ::: "memory");
            const unsigned og = xb_add(&bar[XB_TOP], 1u);
            const unsigned tg = og / nx;
            if (og + 1u == (tg + 1u) * nx) xb_add(&bar[XB_TOPGEN], 1u);
            else XB_SPIN(xb_ld(&bar[XB_TOPGEN]) == tg, bar);
            __builtin_amdgcn_fence(__ATOMIC_ACQUIRE, "agent");
            xb_add(&bar[XB_XGEN(b.x)], 1u);
            asm volatile("s_waitcnt vmcnt(0)" ::: "memory");
        } else {
            XB_SPIN(xb_ld(&bar[XB_XGEN(b.x)]) == gen, bar);
            __builtin_amdgcn_fence(__ATOMIC_ACQUIRE, "agent");
            asm volatile("s_waitcnt vmcnt(0)" ::: "memory");
        }
    }
    __syncthreads();
}

struct Args { const float* in[24]; float* out; unsigned char* ws; int ph_lo, ph_hi, sub, pad; };
enum { I_X = 0, I_P, I_WIN, I_RELB, I_WGUP, I_BG, I_GNORM, I_WBA, I_WBB, I_WOUT, I_NMPRE, I_NMPOST, I_NFPRE, I_NFPOST, I_FG, I_FU, I_FD, I_RW, I_MG, I_MU, I_MD, I_PP, I_PG, I_PNORM };
#define FRESH(F) do { int _t = threadIdx.x; asm volatile("" : "+v"(_t)); (F).tid = _t; (F).lane = _t & 63; (F).wave = __builtin_amdgcn_readfirstlane(_t >> 6); } while (0)
struct Frame {
    LAS unsigned char* lds;
    volatile LAS unsigned* MISC;
    gu32* ctl;
    unsigned char* ws;
    int tid, lane, wave;
    int vcu, G;
    float* x;
    bf16_t* xs;
};

__device__ __forceinline__ float sumsq16(const f32x4 (&v)[4]) {
    float s = 0.f;
#pragma unroll
    for (int j = 0; j < 4; ++j) s += (v[j].x * v[j].x + v[j].y * v[j].y) + (v[j].z * v[j].z + v[j].w * v[j].w);
    return wave_sum(s);
}
__device__ __forceinline__ void ld_bf16_row(const bf16_t* row, int lane, f32x4 (&v)[4]) {
#pragma unroll
    for (int j = 0; j < 4; ++j) { const u32x2 w = ((const u32x2*)row)[lane + 64 * j]; v[j] = (f32x4){bf_lo(w.x), bf_hi(w.x), bf_lo(w.y), bf_hi(w.y)}; }
}
__device__ __forceinline__ void st_bf16_row(bf16_t* row, int lane, const f32x4 (&v)[4]) {
#pragma unroll
    for (int j = 0; j < 4; ++j) { u32x2 w; w.x = cvt_pk_bf16(v[j].x, v[j].y); w.y = cvt_pk_bf16(v[j].z, v[j].w); ((u32x2*)row)[lane + 64 * j] = w; }
}
__device__ __forceinline__ void ld_moe_row(const unsigned char* ws, int s, int lane, f32x4 (&v)[4]) {
    if (s < MOE_MAIN_ROWS) { ld_bf16_row((const bf16_t*)(ws + WS_YSLOT) + (size_t)s * D, lane, v); return; }
    const bf16_t* p = (const bf16_t*)(ws + WS_PBUF) + (size_t)(s - MOE_MAIN_ROWS) * D;
#pragma unroll
    for (int j = 0; j < 4; ++j) v[j] = (f32x4){0.f, 0.f, 0.f, 0.f};
#pragma unroll 1
    for (int k0 = 0; k0 < TAIL_KC; k0 += 7) {
        u32x2 w[7][4];
#pragma unroll
        for (int q = 0; q < 7; ++q)
#pragma unroll
            for (int j = 0; j < 4; ++j) w[q][j] = ((const u32x2*)(p + (size_t)(k0 + q) * TAIL_ROWS * D))[lane + 64 * j];
#pragma unroll
        for (int q = 0; q < 7; ++q)
#pragma unroll
            for (int j = 0; j < 4; ++j) v[j] = v[j] + (f32x4){bf_lo(w[q][j].x), bf_hi(w[q][j].x), bf_lo(w[q][j].y), bf_hi(w[q][j].y)};
    }
}
template <int SRC, int OUT, bool ROUTE>
__device__ __forceinline__ void thin_phase(Frame& F, const float* xin, const bf16_t* ysrc, const float* g_add, const float* g_out, bf16_t* obuf, const float* router_w) {
    FRESH(F);
    const int lane = F.lane;
    unsigned* tokinfo = (unsigned*)(F.ws + WS_TOKINFO);
    int* idxe = (int*)(F.ws + WS_IDXE);
    unsigned* gcnt = (unsigned*)(F.ctl + CW_CNT);
    LAS float* rwT = (LAS float*)(F.lds);
    LAS unsigned* lcnt = (LAS unsigned*)(F.lds + 32768);
    LAS unsigned* rinfo = (LAS unsigned*)(F.lds + 32768 + 64);
    if constexpr (ROUTE) {
        for (int i = F.tid; i < D * NE; i += NTHR) rwT[(i & 7) * D + (i >> 3)] = router_w[i];
        if (F.tid < 16) lcnt[F.tid] = 0u;
        __syncthreads();
    }
    int pbase[8];
    if constexpr (SRC == 2) { int acc = 0;
#pragma unroll
        for (int e = 0; e < 8; ++e) { pbase[e] = acc; acc += (((int)gcnt[e] + 255) >> 8) << 8; } }
    f32x4 ga[4], go[4];
#pragma unroll
    for (int j = 0; j < 4; ++j) { ga[j] = (SRC != 0) ? ((const f32x4*)g_add)[lane + 64 * j] : (f32x4){0.f, 0.f, 0.f, 0.f}; go[j] = (OUT == 1) ? ((const f32x4*)g_out)[lane + 64 * j] : (f32x4){0.f, 0.f, 0.f, 0.f}; }
    const int gw = F.vcu * NWAVES + F.wave, NGW = F.G * NWAVES;
    int rs = 0;
#ifdef THIN_PF
    f32x4 nxf[4]; u32x2 nxb[4], nyb[4];
#define THIN_LOAD(mm) do { const int m_ = (mm); \
        if (SRC == 0 || xin != nullptr) { _Pragma("unroll") for (int j = 0; j < 4; ++j) nxf[j] = ((const f32x4*)(xin + (size_t)m_ * D))[lane + 64 * j]; } \
        else { _Pragma("unroll") for (int j = 0; j < 4; ++j) nxb[j] = ((const u32x2*)(F.xs + (size_t)m_ * D))[lane + 64 * j]; } \
        if (SRC == 1) { _Pragma("unroll") for (int j = 0; j < 4; ++j) nyb[j] = ((const u32x2*)(ysrc + (size_t)m_ * D))[lane + 64 * j]; } } while (0)
    if (gw < T) THIN_LOAD(gw);
#endif
    for (int m = gw; m < T; m += NGW, ++rs) {
        f32x4 xv[4];
#ifdef THIN_PF
        f32x4 cxf[4]; u32x2 cxb[4], cyb[4];
#pragma unroll
        for (int j = 0; j < 4; ++j) { cxf[j] = nxf[j]; cxb[j] = nxb[j]; cyb[j] = nyb[j]; }
        if (m + NGW < T) THIN_LOAD(m + NGW);
#endif
        if constexpr (SRC == 0) {
#pragma unroll
#ifdef THIN_PF
            for (int j = 0; j < 4; ++j) xv[j] = cxf[j];
#else
            for (int j = 0; j < 4; ++j) xv[j] = ((const f32x4*)(xin + (size_t)m * D))[lane + 64 * j];
#endif
        } else {
            f32x4 yv[4];
#ifdef THIN_PF
            if constexpr (SRC == 1) {
#pragma unroll
                for (int j = 0; j < 4; ++j) yv[j] = (f32x4){bf_lo(cyb[j].x), bf_hi(cyb[j].x), bf_lo(cyb[j].y), bf_hi(cyb[j].y)}; }
#else
            if constexpr (SRC == 1) ld_bf16_row(ysrc + (size_t)m * D, lane, yv);
#endif
            else {
                const unsigned* ti = tokinfo + (size_t)m * 8;
                const int e1 = (int)ti[0], p1 = (int)ti[1], e2 = (int)ti[2], p2 = (int)ti[3]; const float w1 = __uint_as_float(ti[4]), w2 = __uint_as_float(ti[5]);
                int b1 = 0, b2 = 0;
#pragma unroll
                for (int e = 0; e < 8; ++e) { b1 = (e == e1) ? pbase[e] : b1; b2 = (e == e2) ? pbase[e] : b2; }
                f32x4 ya[4], yb[4];
                ld_moe_row(F.ws, b1 + p1, lane, ya); ld_moe_row(F.ws, b2 + p2, lane, yb);
#pragma unroll
                for (int j = 0; j < 4; ++j) yv[j] = ya[j] * w1 + yb[j] * w2;
            }
            const float rstd = __builtin_amdgcn_rsqf(sumsq16(yv) * (1.f / D) + EPS);
#ifdef THIN_PF
            if (xin) {
#pragma unroll
                for (int j = 0; j < 4; ++j) xv[j] = cxf[j] + yv[j] * rstd * ga[j];
            } else {
#pragma unroll
                for (int j = 0; j < 4; ++j) xv[j] = (f32x4){bf_lo(cxb[j].x), bf_hi(cxb[j].x), bf_lo(cxb[j].y), bf_hi(cxb[j].y)} + yv[j] * rstd * ga[j]; }
#else
            if (xin) {
#pragma unroll
                for (int j = 0; j < 4; ++j) { const f32x4 xo = ((const f32x4*)(xin + (size_t)m * D))[lane + 64 * j]; xv[j] = xo + yv[j] * rstd * ga[j]; }
            } else { f32x4 xo[4]; ld_bf16_row(F.xs + (size_t)m * D, lane, xo);
#pragma unroll
                for (int j = 0; j < 4; ++j) xv[j] = xo[j] + yv[j] * rstd * ga[j]; }
#endif
        }
#ifdef SIM_XBF16
        if constexpr (SRC != 0 && OUT != 0) {
#pragma unroll
            for (int j = 0; j < 4; ++j) { const unsigned a = cvt_pk_bf16(xv[j].x, xv[j].y), b = cvt_pk_bf16(xv[j].z, xv[j].w); xv[j] = (f32x4){bf_lo(a), bf_hi(a), bf_lo(b), bf_hi(b)}; } }
#endif
        if constexpr (SRC != 0) {
#pragma unroll
            for (int j = 0; j < 4; ++j) { if constexpr (OUT == 0) ((f32x4*)(F.x + (size_t)m * D))[lane + 64 * j] = xv[j]; }
            if constexpr (OUT != 0) st_bf16_row(F.xs + (size_t)m * D, lane, xv); }
        if constexpr (OUT == 1) {
            const float rstd = __builtin_amdgcn_rsqf(sumsq16(xv) * (1.f / D) + EPS);
            f32x4 hv[4];
#pragma unroll
            for (int j = 0; j < 4; ++j) hv[j] = xv[j] * rstd * go[j];
#ifdef SIM_FFN0
            if (!ROUTE && xin != nullptr) {
#pragma unroll
                for (int j = 0; j < 4; ++j) hv[j] = (f32x4){q8(hv[j].x, 1.f), q8(hv[j].y, 1.f), q8(hv[j].z, 1.f), q8(hv[j].w, 1.f)}; }
#endif
#if MOE_FP8
            if constexpr (ROUTE) {
#pragma unroll
                for (int j = 0; j < 4; ++j) ((unsigned*)((unsigned char*)obuf + (size_t)m * D))[lane + 64 * j] = pk4_fp8(hv[j].x, hv[j].y, hv[j].z, hv[j].w);
            } else
#elif defined(SIM_FP8)
            if constexpr (ROUTE) { f32x4 hq[4];
#pragma unroll
                for (int j = 0; j < 4; ++j) hq[j] = (f32x4){q8(hv[j].x, 1.f), q8(hv[j].y, 1.f), q8(hv[j].z, 1.f), q8(hv[j].w, 1.f)};
                st_bf16_row(obuf + (size_t)m * D, lane, hq); } else
#endif

            st_bf16_row(obuf + (size_t)m * D, lane, hv);
            if constexpr (ROUTE) {
                float lg[8];
#pragma unroll
                for (int e = 0; e < 8; ++e) { float s = 0.f;
#pragma unroll
                    for (int j = 0; j < 4; ++j) { const f32x4 w = *(const LAS f32x4*)(rwT + e * D + 4 * lane + 256 * j); s += (hv[j].x * w.x + hv[j].y * w.y) + (hv[j].z * w.z + hv[j].w * w.w); }
                    lg[e] = wave_sum(s); }
                int e1 = 0; float v1 = lg[0];
#pragma unroll
                for (int e = 1; e < 8; ++e) if (lg[e] > v1) { v1 = lg[e]; e1 = e; }
                int e2 = -1; float v2 = -3.0e38f;
#pragma unroll
                for (int e = 0; e < 8; ++e) if (e != e1 && lg[e] > v2) { v2 = lg[e]; e2 = e; }
                const float ex = __expf(v2 - v1), w1 = 1.f / (1.f + ex), w2 = ex * w1;
                if (lane == 0) {
                    const unsigned p1 = atomicAdd((unsigned*)&lcnt[e1], 1u), p2 = atomicAdd((unsigned*)&lcnt[e2], 1u);
                    LAS unsigned* ri = rinfo + (F.wave * 8 + rs) * 6;
                    ri[0] = (unsigned)e1; ri[1] = p1; ri[2] = (unsigned)e2; ri[3] = p2; ri[4] = __float_as_uint(w1); ri[5] = __float_as_uint(w2);
                }
            }
        }
    }
    if constexpr (ROUTE) {
        __syncthreads();
        if (F.tid < 8) lcnt[8 + F.tid] = __hip_atomic_fetch_add(gcnt + F.tid, lcnt[F.tid], RLX_AGENT);
        __syncthreads();
        if (lane < rs) {
            const int m = gw + lane * NGW; const LAS unsigned* ri = rinfo + (F.wave * 8 + lane) * 6;
            const unsigned e1 = ri[0], e2 = ri[2]; const unsigned p1 = ri[1] + lcnt[8 + e1], p2 = ri[3] + lcnt[8 + e2];
            unsigned* ti = tokinfo + (size_t)m * 8; ti[0] = e1; ti[1] = p1; ti[2] = e2; ti[3] = p2; ti[4] = ri[4]; ti[5] = ri[5];
            idxe[e1 * 16384 + p1] = m; idxe[e2 * 16384 + p2] = m;
        }
    }
}
#if defined(SIM_FP8) || defined(SIM_FFN0)
#define SIMQ(x, s) (((s) != 0.f) ? q8((x), (s)) : (x))
#else
#define SIMQ(x, s) (x)
#endif
struct TrItem { const float* src; int pitch; bf16_t* dst; int dstK; int ncols; float qs; int f8; };
#ifdef TR_NT
#define TR_LD(p) __builtin_nontemporal_load(p)
#else
#define TR_LD(p) (*(p))
#endif
#define TR_LOAD(t, v) do { _Pragma("unroll") for (int i = 0; i < 64; ++i) { const int kk = 2 * i + (lane >> 5); v[i] = ((lane & 31) < (t).ncols) ? TR_LD((t).src + (size_t)kk * (t).pitch + (lane & 31)) : 0.f; } } while (0)
__device__ __forceinline__ void tr_finish(const TrItem& t, float (&v)[64], LAS float* scr, int lane, bool nostore = false) {
    const int c = lane & 31;
#pragma unroll
    for (int p = 0; p < 2; ++p) {
#pragma unroll
        for (int i = 0; i < 32; ++i) { const int kk = 2 * i + (lane >> 5); scr[kk * 33 + c] = SIMQ(v[32 * p + i], t.qs); }
        LDS_WAIT(); asm volatile("" ::: "memory");
        if (t.f8) {
            const int c4 = lane & 3;
#pragma unroll
            for (int j = 0; j < 2; ++j) { const int n = (lane >> 2) + 16 * j; const LAS float* s = scr + (16 * c4) * 33 + n;
                u32x4 o; o.x = pk4_fp8(s[0 * 33] * W8_SCALE, s[1 * 33] * W8_SCALE, s[2 * 33] * W8_SCALE, s[3 * 33] * W8_SCALE); o.y = pk4_fp8(s[4 * 33] * W8_SCALE, s[5 * 33] * W8_SCALE, s[6 * 33] * W8_SCALE, s[7 * 33] * W8_SCALE);
                o.z = pk4_fp8(s[8 * 33] * W8_SCALE, s[9 * 33] * W8_SCALE, s[10 * 33] * W8_SCALE, s[11 * 33] * W8_SCALE); o.w = pk4_fp8(s[12 * 33] * W8_SCALE, s[13 * 33] * W8_SCALE, s[14 * 33] * W8_SCALE, s[15 * 33] * W8_SCALE);
                if (!nostore) *(u32x4*)((unsigned char*)t.dst + (size_t)n * t.dstK + 64 * p + 16 * c4) = o; }
        } else {
            const int c8 = lane & 7;
#pragma unroll
            for (int j = 0; j < 4; ++j) { const int n = (lane >> 3) + 8 * j; const LAS float* s = scr + (8 * c8) * 33 + n;
                u32x4 o; o.x = cvt_pk_bf16(s[0 * 33], s[1 * 33]); o.y = cvt_pk_bf16(s[2 * 33], s[3 * 33]); o.z = cvt_pk_bf16(s[4 * 33], s[5 * 33]); o.w = cvt_pk_bf16(s[6 * 33], s[7 * 33]);
                if (n < t.ncols && !nostore) *(u32x4*)(t.dst + (size_t)n * t.dstK + 64 * p + 8 * c8) = o; }
        }
        LDS_WAIT(); asm volatile("" ::: "memory");
    }
}
constexpr int IT_COMMON = 640 + 640 + 8 + 128 + 128 + 256 + 64 + 256;
constexpr int IT_FFN = 3 * 704, IT_MOE1 = 8 * 896;
constexpr int IT_TOTAL = 2 * IT_COMMON + IT_FFN + 3 * IT_MOE1;
__device__ __forceinline__ TrItem seg_plain(const float* src, int K, int N, int pitch, bf16_t* dst, int r) {
#ifdef TR_NFAST
    const int nnb = N / 32, kb = r / nnb, nb = r % nnb;
#else
    const int nkb = K / 128, nb = r / nkb, kb = r % nkb;
#endif
    return TrItem{src + (size_t)kb * 128 * pitch + nb * 32, pitch, dst + (size_t)(nb * 32) * K + kb * 128, K, 32, 0.f, 0};
}
__device__ __forceinline__ TrItem seg_gu(const float* src, int N, bf16_t* dst, int up, int r) {
#ifdef TR_NFAST
    const int kb = r / (N / 32), nb = r % (N / 32), n0 = nb * 32;
#else
    const int nb = r / (D / 128), kb = r % (D / 128), n0 = nb * 32;
#endif
    return TrItem{src + (size_t)kb * 128 * N + n0, N, dst + (size_t)((n0 >> 7) * 256 + (n0 & 127) + up * 128) * D + kb * 128, D, 32, 0.f, 0};
}
__device__ __forceinline__ TrItem decode_item(const Args& a, unsigned char* ws, int it) {
    if (it < 2 * IT_COMMON) {
        const int l = it / IT_COMMON; int r = it % IT_COMMON; unsigned char* wb = ws + (l ? WS_W1 : WS_W0);
        const float* win = a.in[I_WIN] + (size_t)l * D * INW;
        if (r < 640) return seg_plain(win, D, 2560, INW, (bf16_t*)(wb + OFF_WIN), r); r -= 640;
        if (r < 640) return seg_plain(win + 2576, D, 2560, INW, (bf16_t*)(wb + OFF_WIN) + (size_t)2560 * D, r); r -= 640;
        if (r < 8) return TrItem{win + (size_t)r * 128 * INW + 2560, INW, (bf16_t*)(wb + OFF_WGD) + r * 128, D, 16, 0.f, 0}; r -= 8;
        if (r < 128) return seg_plain(a.in[I_WBA] + (size_t)l * 512 * D, 512, D, D, (bf16_t*)(wb + OFF_WBA), r); r -= 128;
        if (r < 128) return seg_plain(a.in[I_WBB] + (size_t)l * 512 * D, 512, D, D, (bf16_t*)(wb + OFF_WBB), r); r -= 128;
        if (r < 256) return seg_plain(a.in[I_WOUT] + (size_t)l * D * D, D, D, D, (bf16_t*)(wb + OFF_WOUT), r); r -= 256;
        if (r < 64) return seg_plain(a.in[I_PP] + (size_t)l * PLE * D, PLE, D, D, (bf16_t*)(wb + OFF_WPP), r); r -= 64;
        return seg_plain(a.in[I_PG] + (size_t)l * D * D, D, D, D, (bf16_t*)(wb + OFF_WPG), r);
    }
    it -= 2 * IT_COMMON;
    if (it < IT_FFN) {
        unsigned char* wb = ws + WS_W0;
        TrItem t;
        if (it < 704) t = seg_gu(a.in[I_FG], DFF, (bf16_t*)(wb + OFF_FFN), 0, it);
        else if (it < 1408) t = seg_gu(a.in[I_FU], DFF, (bf16_t*)(wb + OFF_FFN), 1, it - 704);
        else t = seg_plain(a.in[I_FD], DFF, D, D, (bf16_t*)(wb + OFF_FDN), it - 1408);
#ifdef SIM_FFN0
        t.qs = 64.f;
#endif
        return t;
    }
    it -= IT_FFN;
    unsigned char* wb = ws + WS_W1;
    const int kind = it / IT_MOE1, r0 = it % IT_MOE1, e = r0 / 896, r = r0 % 896;
    TrItem t;
#if MOE_FP8
    {
#ifdef TR_NFAST
      const int nnb8 = (kind == 2 ? D : DFE) / 32, kb8 = r / nnb8, nb8 = r % nnb8, n0 = nb8 * 32;
#else
      const int nkb8 = (kind == 2 ? DFE : D) / 128, nb8 = r / nkb8, kb8 = r % nkb8, n0 = nb8 * 32;
#endif
      if (kind == 2) return TrItem{a.in[I_MD] + (size_t)e * DFE * D + (size_t)kb8 * 128 * D + n0, D, (bf16_t*)(wb + OFF_MDN8 + (size_t)e * D * DFE + (size_t)n0 * DFE + kb8 * 128), DFE, 32, 0.f, 1};
      const float* src = (kind == 0 ? a.in[I_MG] : a.in[I_MU]) + (size_t)e * D * DFE + (size_t)kb8 * 128 * DFE + n0;
      return TrItem{src, DFE, (bf16_t*)(wb + OFF_FFN + (size_t)e * 7168 * D + (size_t)((n0 >> 7) * 256 + (n0 & 127) + (kind == 1 ? 128 : 0)) * D + kb8 * 128), D, 32, 0.f, 1}; }
#endif
    if (kind == 0) t = seg_gu(a.in[I_MG] + (size_t)e * D * DFE, DFE, (bf16_t*)(wb + OFF_FFN) + (size_t)e * 7168 * D, 0, r);
    else if (kind == 1) t = seg_gu(a.in[I_MU] + (size_t)e * D * DFE, DFE, (bf16_t*)(wb + OFF_FFN) + (size_t)e * 7168 * D, 1, r);
    else t = seg_plain(a.in[I_MD] + (size_t)e * DFE * D, DFE, D, D, (bf16_t*)(wb + OFF_MDN) + (size_t)e * D * DFE, r);
#ifdef SIM_FP8
    t.qs = 64.f;
#endif
    return t;
}
__device__ __forceinline__ void p0_prologue(Frame& F, const Args& a, int probe = 0) {
    FRESH(F);
    LAS float* scr = (LAS float*)(F.lds + F.wave * 16384);
    const int gw = F.vcu * NWAVES + F.wave, NGW = F.G * NWAVES;
    { const int lane = F.lane;
      for (int it = gw; it < IT_TOTAL; it += NGW) { const TrItem t = decode_item(a, F.ws, it); float v[64]; TR_LOAD(t, v); tr_finish(t, v, scr, lane, probe == 1); } }
    if (probe) return;
    { const f32x4* ps = (const f32x4*)a.in[I_P]; u32x4* pd = (u32x4*)(F.ws + WS_PB); const int n8 = 2 * T * PLE / 8;
      for (int i = blockIdx.x * NTHR + F.tid; i < n8; i += F.G * NTHR) { const f32x4 v0 = ps[2 * i], v1 = ps[2 * i + 1];
          u32x4 w; w.x = cvt_pk_bf16(v0.x, v0.y); w.y = cvt_pk_bf16(v0.z, v0.w); w.z = cvt_pk_bf16(v1.x, v1.y); w.w = cvt_pk_bf16(v1.z, v1.w); pd[i] = w; } }
    thin_phase<0, 1, false>(F, a.in[I_X], nullptr, nullptr, a.in[I_NMPRE], (bf16_t*)(F.ws + WS_HB), nullptr);
}
typedef short v4i16_t __attribute__((ext_vector_type(4)));
__device__ __forceinline__ s16x4 lds_tr16(const LAS unsigned char* p) { return __builtin_bit_cast(s16x4, __builtin_amdgcn_ds_read_tr16_b64_v4i16((LAS v4i16_t*)p)); }
__device__ __forceinline__ bf16x8 cat8(s16x4 a, s16x4 b) { return (bf16x8){a[0], a[1], a[2], a[3], b[0], b[1], b[2], b[3]}; }

__device__ __forceinline__ void attn_unit(Frame& F, int b, int c, const float* relb) {
    FRESH(F);
    const int lane = F.lane, h = F.wave, n = lane & 15, mq = lane >> 4;
    const bf16_t* qa = (const bf16_t*)(F.ws + WS_QA); const bf16_t* ka = (const bf16_t*)(F.ws + WS_KA); const bf16_t* va = (const bf16_t*)(F.ws + WS_VA);
    LAS unsigned char* kbuf = F.lds + h * 16384; LAS unsigned char* vbuf = kbuf + 8192;
    LAS float* rt = (LAS float*)(F.lds + XTRA_OFF + h * 1056);
    for (int i = lane; i < 256; i += 64) { const int j = i - 64; rt[i] = relb[h * RELN + 256 - (j > 0 ? j : 0)] * LOG2E; }
    const float bfar = relb[h * RELN + 256] * LOG2E;
    const int tok0 = b * SEQ + c * CH;
    bf16x8 qf[4][2];
#pragma unroll
    for (int qt = 0; qt < 4; ++qt)
#pragma unroll
        for (int ks = 0; ks < 2; ++ks) qf[qt][ks] = *(const bf16x8*)(qa + (size_t)(tok0 + 16 * qt + n) * 512 + h * 64 + 32 * ks + 8 * mq);
    const int koff_e = (lane >> 3) * 512 + (((lane & 7) ^ ((lane >> 4) & 7)) * 8), koff_o = (lane >> 3) * 512 + (((lane & 7) ^ ((4 + (lane >> 4)) & 7)) * 8);
    const int voff = (lane >> 3) * 512 + ((2 * (((lane & 7) >> 1) ^ (lane >> 4)) + (lane & 1)) * 8);
#define ATT_DMA_K(j) do { const bf16_t* _s = ka + (size_t)(b * SEQ + (j) * CH) * 512 + h * 64; _Pragma("unroll") for (int _i = 0; _i < 8; ++_i) \
        __builtin_amdgcn_global_load_lds((const unsigned*)(_s + (size_t)_i * 8 * 512 + ((_i & 1) ? koff_o : koff_e)), (LAS unsigned*)(kbuf + _i * 1024), 16, 0, 0); } while (0)
#define ATT_DMA_V(j) do { const bf16_t* _s = va + (size_t)(b * SEQ + (j) * CH) * 512 + h * 64; _Pragma("unroll") for (int _i = 0; _i < 8; ++_i) \
        __builtin_amdgcn_global_load_lds((const unsigned*)(_s + (size_t)_i * 8 * 512 + voff), (LAS unsigned*)(vbuf + _i * 1024), 16, 0, 0); } while (0)
    const int ka0 = n * 128 + (((0 + mq) ^ (n >> 1)) * 16), ka1 = n * 128 + (((4 + mq) ^ (n >> 1)) * 16);
    const int qp = n >> 2, pp = lane & 3, sw = 2 * (mq & 1) + (qp >> 1);
    const int vrow = (4 * mq + qp) * 128 + 8 * pp;
    f32x4 O[4][4]; float mrun[4], lsum[4];
#pragma unroll
    for (int qt = 0; qt < 4; ++qt) { mrun[qt] = -1.0e30f; lsum[qt] = 0.f;
#pragma unroll
        for (int dt = 0; dt < 4; ++dt) O[qt][dt] = (f32x4){0.f, 0.f, 0.f, 0.f}; }
    const int j0 = (c - NPREV) > 0 ? (c - NPREV) : 0;
    ATT_DMA_K(j0); ATT_DMA_V(j0);
    for (int j = j0; j <= c; ++j) {
        const int dc = c - j;
        asm volatile("s_waitcnt vmcnt(8)" ::: "memory");
#pragma unroll
        for (int qg = 0; qg < 2; ++qg) {
            f32x4 S[4][2];
#pragma unroll
            for (int kt = 0; kt < 4; ++kt) {
                const bf16x8 k0 = *(const LAS bf16x8*)(kbuf + kt * 2048 + ka0), k1 = *(const LAS bf16x8*)(kbuf + kt * 2048 + ka1);
#pragma unroll
                for (int q2 = 0; q2 < 2; ++q2) { f32x4 z = (f32x4){0.f, 0.f, 0.f, 0.f};
                    z = __builtin_amdgcn_mfma_f32_16x16x32_bf16(k0, qf[2 * qg + q2][0], z, 0, 0, 0);
                    S[kt][q2] = __builtin_amdgcn_mfma_f32_16x16x32_bf16(k1, qf[2 * qg + q2][1], z, 0, 0, 0); }
            }
            if (qg == 1) { if (j < c) { LDS_WAIT(); ATT_DMA_K(j + 1); } }
            bf16x8 P[2][2];
#pragma unroll
            for (int q2 = 0; q2 < 2; ++q2) { const int qt = 2 * qg + q2;
                if (dc >= 3) {
                    asm volatile("" ::: "memory");
#pragma unroll
                    for (int kt = 0; kt < 4; ++kt) S[kt][q2] = S[kt][q2] + bfar;
                } else {
                    asm volatile("" ::: "memory");
                    const LAS float* rp = rt + (64 + 128 - (64 * dc + 16 * qt + n - 4 * mq));
                    float bv[4][4];
#pragma unroll
                    for (int kt = 0; kt < 4; ++kt)
#pragma unroll
                        for (int i = 0; i < 4; ++i) bv[kt][i] = rp[16 * kt + i];
#pragma unroll
                    for (int kt = 0; kt < 4; ++kt)
#pragma unroll
                        for (int i = 0; i < 4; ++i) S[kt][q2][i] += bv[kt][i];
                }
                float cm = S[0][q2][0];
#pragma unroll
                for (int kt = 0; kt < 4; ++kt)
#pragma unroll
                    for (int i = 0; i < 4; ++i) cm = fmaxf(cm, S[kt][q2][i]);
                cm = fmaxf(cm, __shfl_xor(cm, 16)); cm = fmaxf(cm, __shfl_xor(cm, 32));
                const float mn = fmaxf(mrun[qt], cm), alpha = __builtin_amdgcn_exp2f(mrun[qt] - mn); mrun[qt] = mn;
                float ps = 0.f;
#pragma unroll
                for (int kt = 0; kt < 4; ++kt)
#pragma unroll
                    for (int i = 0; i < 4; ++i) { const float p = __builtin_amdgcn_exp2f(S[kt][q2][i] - mn); S[kt][q2][i] = p; ps += p; }
                lsum[qt] = lsum[qt] * alpha + ps;
#pragma unroll
                for (int dt = 0; dt < 4; ++dt) O[qt][dt] = O[qt][dt] * alpha;
#pragma unroll
                for (int u = 0; u < 2; ++u) { u32x4 w; w.x = cvt_pk_bf16(S[2 * u][q2][0], S[2 * u][q2][1]); w.y = cvt_pk_bf16(S[2 * u][q2][2], S[2 * u][q2][3]);
                    w.z = cvt_pk_bf16(S[2 * u + 1][q2][0], S[2 * u + 1][q2][1]); w.w = cvt_pk_bf16(S[2 * u + 1][q2][2], S[2 * u + 1][q2][3]); P[q2][u] = __builtin_bit_cast(bf16x8, w); }
            }
            if (qg == 0) asm volatile("s_waitcnt vmcnt(0)" ::: "memory");
#pragma unroll
            for (int dt = 0; dt < 4; ++dt)
#pragma unroll
                for (int u = 0; u < 2; ++u) {
                    const LAS unsigned char* vp = vbuf + vrow + (32 * u) * 128 + ((dt ^ sw) * 32);
                    const bf16x8 vf = cat8(lds_tr16(vp), lds_tr16(vp + 16 * 128));
#pragma unroll
                    for (int q2 = 0; q2 < 2; ++q2) O[2 * qg + q2][dt] = __builtin_amdgcn_mfma_f32_16x16x32_bf16(vf, P[q2][u], O[2 * qg + q2][dt], 0, 0, 0);
                }
            if (qg == 1) { if (j < c) { LDS_WAIT(); ATT_DMA_V(j + 1); } }
        }
    }
#undef ATT_DMA_K
#undef ATT_DMA_V
    bf16_t* ya = (bf16_t*)(F.ws + WS_YA);
#pragma unroll
    for (int qt = 0; qt < 4; ++qt) { float l = lsum[qt]; l += __shfl_xor(l, 16); l += __shfl_xor(l, 32); const float rl = __builtin_amdgcn_rcpf(l);
#pragma unroll
        for (int dt = 0; dt < 4; ++dt) { const f32x4 o = O[qt][dt] * rl; u32x2 w; w.x = cvt_pk_bf16(o[0], o[1]); w.y = cvt_pk_bf16(o[2], o[3]);
            *(u32x2*)(ya + (size_t)(tok0 + 16 * qt + n) * 512 + h * 64 + 16 * dt + 4 * mq) = w; } }
}

__device__ __forceinline__ void gla_dstate_unit(Frame& F, int b, int c, const bf16_t* wgd_t, const float* wup, const float* bgate) {
    FRESH(F);
    const int lane = F.lane, w = F.wave, tid = F.tid, n = lane & 15, mq = lane >> 4;
    const int tok0 = b * SEQ + c * CH;
    const bf16_t* hb = (const bf16_t*)(F.ws + WS_HB); const bf16_t* kb = (const bf16_t*)(F.ws + WS_KB); const bf16_t* vb = (const bf16_t*)(F.ws + WS_VB);
    LAS float* GD8 = (LAS float*)(F.lds); LAS unsigned char* VB = F.lds + 32768; LAS unsigned char* KD = F.lds + 98304;
    LAS float* GDF = (LAS float*)(F.lds + XTRA_OFF); LAS float* TOT = (LAS float*)(F.lds + XTRA_OFF + 4096);
    __syncthreads();
    const int col = tid & 255, hf = tid >> 8;
    float wu[16];
#pragma unroll
    for (int r = 0; r < 16; ++r) wu[r] = wup[r * 256 + col];
    const float bb = bgate[col];
    unsigned short kraw[32];
#pragma unroll
    for (int l = 0; l < 32; ++l) kraw[l] = kb[(size_t)(tok0 + 32 * hf + l) * 256 + col];
#pragma unroll
    for (int i = 0; i < 8; ++i) { const int p = (w * 8 + i) * 64 + lane, row = p >> 6, ch = p & 63;
        __builtin_amdgcn_global_load_lds((const unsigned*)(vb + (size_t)(tok0 + row) * 512 + ch * 8), (LAS unsigned*)(VB + (w * 8 + i) * 1024), 16, 0, 0); }
    { bf16x8 af[4][4], bf[4];
#pragma unroll
      for (int ks = 0; ks < 4; ++ks) { bf[ks] = *(const bf16x8*)(wgd_t + (size_t)n * D + 128 * w + 32 * ks + 8 * mq);
#pragma unroll
          for (int mt = 0; mt < 4; ++mt) af[mt][ks] = *(const bf16x8*)(hb + (size_t)(tok0 + 16 * mt + n) * D + 128 * w + 32 * ks + 8 * mq); }
#pragma unroll
      for (int mt = 0; mt < 4; ++mt) { f32x4 acc = (f32x4){0.f, 0.f, 0.f, 0.f};
#pragma unroll
          for (int ks = 0; ks < 4; ++ks) acc = __builtin_amdgcn_mfma_f32_16x16x32_bf16(af[mt][ks], bf[ks], acc, 0, 0, 0);
#pragma unroll
          for (int i = 0; i < 4; ++i) GD8[(w * 64 + 16 * mt + 4 * mq + i) * 16 + n] = acc[i]; } }
    __syncthreads();
    { const f32x2 z2 = (f32x2){0.f, 0.f}; f32x2 sacc = z2;
#pragma unroll
      for (int q = 0; q < 8; ++q) sacc = sacc + *(const LAS f32x2*)(GD8 + q * 1024 + 2 * tid);
      *(LAS f32x2*)(GDF + 2 * tid) = sacc; }
    __syncthreads();
    { float cum[32]; float run = 0.f;
#pragma unroll
      for (int l = 0; l < 32; ++l) { const int row = 32 * hf + l; float z = bb;
#pragma unroll
          for (int r4 = 0; r4 < 4; ++r4) { const f32x4 a = *(const LAS f32x4*)(GDF + row * 16 + 4 * r4);
              z += a.x * wu[4 * r4] + a.y * wu[4 * r4 + 1] + a.z * wu[4 * r4 + 2] + a.w * wu[4 * r4 + 3]; }
          const float la = (fminf(z, 0.f) - __logf(1.f + __expf(-fabsf(z)))) * (1.f / 16.f);
          run += la; cum[l] = run; }
      LAS float* TOT1 = TOT + 256;
      if (hf == 0) TOT[col] = run;
      __syncthreads();
      const float tot = (hf == 1) ? TOT[col] : 0.f;
      if (hf == 1) TOT1[col] = run + tot;
      __syncthreads();
      const float ctot = TOT1[col];
      if (hf == 1) ((float*)(F.ws + WS_DEC))[(size_t)(b * NCH + c) * 256 + col] = __expf(ctot);
      unsigned pk[16];
#pragma unroll
      for (int l = 0; l < 32; l += 2) { const float k0 = bf2f(kraw[l]), k1 = bf2f(kraw[l + 1]);
          pk[l >> 1] = cvt_pk_bf16(k0 * __expf(ctot - (cum[l] + tot)), k1 * __expf(ctot - (cum[l + 1] + tot))); }
#pragma unroll
      for (int q = 0; q < 4; ++q) *(LAS u32x4*)(KD + col * 128 + hf * 64 + q * 16) = (u32x4){pk[4 * q], pk[4 * q + 1], pk[4 * q + 2], pk[4 * q + 3]}; }
    VM_WAIT();
    __syncthreads();
    { const int hh = w >> 1, vh = w & 1, qp = n >> 2, pp = lane & 3;
      f32x4 acc[4][4];
#pragma unroll
      for (int mt = 0; mt < 4; ++mt)
#pragma unroll
          for (int nt = 0; nt < 4; ++nt) acc[mt][nt] = (f32x4){0.f, 0.f, 0.f, 0.f};
#pragma unroll
      for (int ks = 0; ks < 2; ++ks) {
          bf16x8 af[4];
#pragma unroll
          for (int mt = 0; mt < 4; ++mt) af[mt] = *(const LAS bf16x8*)(KD + (hh * 64 + 16 * mt + n) * 128 + (32 * ks + 8 * mq) * 2);
#pragma unroll
          for (int nt = 0; nt < 4; ++nt) {
              const LAS unsigned char* vp = VB + (size_t)(32 * ks + 8 * mq + qp) * 1024 + (hh * 128 + vh * 64 + 16 * nt + 4 * pp) * 2;
              const bf16x8 bfr = cat8(lds_tr16(vp), lds_tr16(vp + 4 * 1024));
#pragma unroll
              for (int mt = 0; mt < 4; ++mt) acc[mt][nt] = __builtin_amdgcn_mfma_f32_16x16x32_bf16(af[mt], bfr, acc[mt][nt], 0, 0, 0);
          }
      }
      float* dst = (float*)(F.ws + WS_DST) + ((size_t)((b * NCH + c) * BH + hh) * 128) * 64;
#pragma unroll
      for (int mt = 0; mt < 4; ++mt)
#pragma unroll
          for (int nt = 0; nt < 4; ++nt) *(f32x4*)(dst + (size_t)(vh * 64 + 16 * nt + n) * 64 + 16 * mt + 4 * mq) = acc[mt][nt]; }
    __syncthreads();
}

__device__ __forceinline__ void gla_scan_phase(Frame& F) {
    FRESH(F);
    const float* ds = (const float*)(F.ws + WS_DST); const float* dec = (const float*)(F.ws + WS_DEC); bf16_t* st = (bf16_t*)(F.ws + WS_ST);
    for (int e2 = blockIdx.x * NTHR + F.tid; e2 < NB * BH * 128 * 32; e2 += F.G * NTHR) {
        const int k2 = e2 & 31, v = (e2 >> 5) & 127, hh = (e2 >> 12) & 3, b = e2 >> 14;
        f32x2 s = (f32x2){0.f, 0.f};
#pragma unroll 8
        for (int c = 0; c < NCH; ++c) {
            const size_t off = ((size_t)((b * NCH + c) * BH + hh) * 128 + v) * 64 + 2 * k2;
            const f32x2 d = *(const f32x2*)(ds + off); const f32x2 a = *(const f32x2*)(dec + (size_t)(b * NCH + c) * 256 + hh * 64 + 2 * k2);
            s = a * s + d;
            *(unsigned*)(st + off) = cvt_pk_bf16(s.x, s.y);
        }
    }
}

__device__ __forceinline__ void gla_out_unit(Frame& F, int b, int c, const float* gnorm) {
    FRESH(F);
    const int lane = F.lane, w = F.wave, n = lane & 15, mq = lane >> 4;
    const int hh = w >> 1, th = w & 1, tok0 = b * SEQ + c * CH + 32 * th;
    const bf16_t* qb = (const bf16_t*)(F.ws + WS_QB); const bf16_t* st = (const bf16_t*)(F.ws + WS_ST) + ((size_t)((b * NCH + c) * BH + hh) * 128) * 64;
    const bf16_t* sr = (const bf16_t*)(F.ws + WS_SR); bf16_t* yb = (bf16_t*)(F.ws + WS_YB);
    bf16x8 qf[2][2];
#pragma unroll
    for (int nt = 0; nt < 2; ++nt)
#pragma unroll
        for (int ks = 0; ks < 2; ++ks) qf[nt][ks] = *(const bf16x8*)(qb + (size_t)(tok0 + 16 * nt + n) * 256 + hh * 64 + 32 * ks + 8 * mq);
    f32x4 acc[8][2];
#pragma unroll
    for (int mt = 0; mt < 8; ++mt) {
        const bf16x8 a0 = *(const bf16x8*)(st + (size_t)(16 * mt + n) * 64 + 8 * mq), a1 = *(const bf16x8*)(st + (size_t)(16 * mt + n) * 64 + 32 + 8 * mq);
#pragma unroll
        for (int nt = 0; nt < 2; ++nt) { f32x4 z = (f32x4){0.f, 0.f, 0.f, 0.f};
            z = __builtin_amdgcn_mfma_f32_16x16x32_bf16(a0, qf[nt][0], z, 0, 0, 0);
            acc[mt][nt] = __builtin_amdgcn_mfma_f32_16x16x32_bf16(a1, qf[nt][1], z, 0, 0, 0); }
    }
#pragma unroll
    for (int nt = 0; nt < 2; ++nt) { float ss = 0.f;
#pragma unroll
        for (int mt = 0; mt < 8; ++mt) ss += (acc[mt][nt][0] * acc[mt][nt][0] + acc[mt][nt][1] * acc[mt][nt][1]) + (acc[mt][nt][2] * acc[mt][nt][2] + acc[mt][nt][3] * acc[mt][nt][3]);
        ss += __shfl_xor(ss, 16); ss += __shfl_xor(ss, 32);
        const float rstd = __builtin_amdgcn_rsqf(ss * (1.f / 128.f) + EPS);
#pragma unroll
        for (int mt = 0; mt < 8; ++mt) { const int col = hh * 128 + 16 * mt + 4 * mq; const f32x4 gn = *(const f32x4*)(gnorm + col);
            const size_t po = (size_t)(tok0 + 16 * nt + n) * 512 + col; const u32x2 rw = *(const u32x2*)(sr + po);
            const f32x4 o = acc[mt][nt] * rstd * gn; u32x2 wv; wv.x = cvt_pk_bf16(o[0] * bf_lo(rw.x), o[1] * bf_hi(rw.x)); wv.y = cvt_pk_bf16(o[2] * bf_lo(rw.y), o[3] * bf_hi(rw.y));
            *(u32x2*)(yb + po) = wv; } }
}
#ifndef PLE_MODE1
#define PLE_MODE1 3
#endif
#ifdef SIM_FP8
constexpr float MOE_ACT_QS = 8.f;
#else
constexpr float MOE_ACT_QS = 0.f;
#endif
#ifdef SIM_FFN0
constexpr float FFN0_ACT_QS = 8.f;
#else
constexpr float FFN0_ACT_QS = 0.f;
#endif
#ifndef PRO_PROBE
#define PRO_PROBE 0
#endif
#ifndef STAG_INPROJ
#define STAG_INPROJ 0
#endif
constexpr int N_PHASES = 25;
__global__ void __launch_bounds__(NTHR, 2) fwd(Args args) {
    extern __shared__ __attribute__((aligned(16))) unsigned char lds[];
    Frame F;
    F.lds = (LAS unsigned char*)lds;
    F.MISC = (volatile LAS unsigned*)(F.lds + MISC_OFF);
    F.tid = threadIdx.x; F.lane = F.tid & 63; F.wave = __builtin_amdgcn_readfirstlane(F.tid >> 6);
    F.G = gridDim.x; { const int bx = blockIdx.x; F.vcu = (F.G % 8 == 0) ? (bx % 8) * (F.G / 8) + bx / 8 : bx; }
    F.ws = args.ws; F.ctl = (gu32*)(args.ws + WS_CTL); F.x = args.out; F.xs = (bf16_t*)(args.ws + WS_XS);
    unsigned char* ws = args.ws;
    for (int u = F.tid; u < (LDS_BYTES - LDSCTL_OFF) / 4; u += NTHR) ((LAS unsigned*)(F.lds + LDSCTL_OFF))[u] = 0u;
    __syncthreads();
    XcdBarrier bar = xcd_barrier_post((unsigned*)(F.ctl + CW_BAR), F.MISC + 8);
    const WT wt = make_wt(ws, (unsigned)WS_END);
    const int lo = args.ph_lo, hi = args.ph_hi;
#define PH_BEGIN const __attribute__((address_space(4))) Args* _ap = (const __attribute__((address_space(4))) Args*)__builtin_amdgcn_kernarg_segment_ptr(); asm volatile("" : "+s"(_ap)); const __attribute__((address_space(4))) Args& A = *_ap; unsigned char* ws = A.ws; \
    unsigned char* wb = ws + (l ? WS_W1 : WS_W0); bf16_t* hb = (bf16_t*)(ws + WS_HB); bf16_t* Y = (bf16_t*)(ws + WS_Y); const WT wt = make_wt(ws, (unsigned)WS_END); (void)wb; (void)hb; (void)Y; (void)wt; (void)A
#ifndef PHMASK
#define PHMASK 0x1fff
#endif
#define EN(i) (((PHMASK) >> (i)) & 1)
#ifndef REPMASK
#define REPMASK 0
#endif
#ifndef REPLAYER
#define REPLAYER 2
#endif
#define ZEROG ((const float*)(ws + WS_CTL + 131072))
#ifndef ZSKIP
#define ZSKIP 0
#endif
#define REPS(i) (((((REPMASK) >> (i)) & 1) && (REPLAYER == 2 || REPLAYER == l)) ? 2 : 1)
#define IN(k) (lo <= (k) && (k) < hi)
#ifndef SEAMREP
#define SEAMREP 1
#endif
#ifndef MK_STAMP
#define MK_STAMP 0
#endif
#ifndef STAMP_SEL
#define STAMP_SEL -1
#endif
#define SEAM(k) do { if (MK_STAMP && IN(k) && F.tid == 0) ((unsigned long long*)(ws + WS_CTL + 786432))[(k) * 256 + blockIdx.x] = __builtin_amdgcn_s_memrealtime(); \
    if (IN(k) && IN((k) + 1)) for (int _r = 0; _r < SEAMREP; ++_r) xcd_barrier(bar); } while (0)

    { const int l = 0; if (EN(12) && IN(0)) for (int rep = 0; rep < REPS(12); ++rep) { p0_prologue(F, args, rep == 0 ? 0 : PRO_PROBE); } }
    SEAM(0);
#ifndef LAYERREP
#define LAYERREP 0
#endif
    for (int l2 = 0; l2 < DEPTH + LAYERREP; ++l2) {
        const int l = (l2 < LAYERREP) ? 0 : l2 - LAYERREP; const bool zpass = (l2 < LAYERREP);
        const int pb = 1 + 12 * l;
        if (EN(0) && IN(pb + 0) && !(zpass && ((ZSKIP >> 0) & 1))) for (int rep = 0; rep < REPS(0); ++rep) { PH_BEGIN;
            pg8::Gemm g{hb, (const bf16_t*)(wb + OFF_WIN), D, 0, nullptr}; pg8::StaticOrder S; S.init(T, INWG, F.G, (int)blockIdx.x);
            pg8::EpiInProj E{(bf16_t*)(ws + WS_PROJ), wt};
            pg8::gemm_phase<pg8::EpiInProj, pg8::StaticOrder, false>(F.lds, g, S, E, STAG_INPROJ);
        }
        SEAM(pb + 0);
        if (EN(1) && IN(pb + 1) && !(zpass && ((ZSKIP >> 1) & 1))) for (int rep = 0; rep < REPS(1); ++rep) { PH_BEGIN;
            for (int u = F.vcu; u < NB * NCH; u += F.G) {
#ifndef NO_ATTN
#ifdef REP1_NO_ATTN
                if (rep == 0)
#endif
                attn_unit(F, u / NCH, u % NCH, A.in[I_RELB] + (size_t)l * AH * RELN);
#endif
#ifndef NO_GLA1
#ifdef REP1_NO_GLA
                if (rep == 0)
#endif
                gla_dstate_unit(F, u / NCH, u % NCH, (const bf16_t*)(wb + OFF_WGD), A.in[I_WGUP] + (size_t)l * GR * 256, A.in[I_BG] + (size_t)l * 256);
#endif
            }
        }
        SEAM(pb + 1);
        if (EN(2) && IN(pb + 2) && !(zpass && ((ZSKIP >> 2) & 1))) for (int rep = 0; rep < REPS(2); ++rep) { PH_BEGIN; gla_scan_phase(F); }
        SEAM(pb + 2);
        if (EN(3) && IN(pb + 3) && !(zpass && ((ZSKIP >> 3) & 1))) for (int rep = 0; rep < REPS(3); ++rep) { PH_BEGIN; for (int u = F.vcu; u < NB * NCH; u += F.G) gla_out_unit(F, u / NCH, u % NCH, A.in[I_GNORM] + (size_t)l * 512); }
        SEAM(pb + 3);
        if (EN(4) && IN(pb + 4) && !(zpass && ((ZSKIP >> 4) & 1))) for (int rep = 0; rep < REPS(4); ++rep) { PH_BEGIN;
            pg8::StaticOrder S; S.init(T, D, F.G, (int)blockIdx.x);
            { pg8::Gemm g{(const bf16_t*)(ws + WS_YA), (const bf16_t*)(wb + OFF_WBA), 512, 0, nullptr}; pg8::EpiEw<1> E{(bf16_t*)(ws + WS_MERGED), (const bf16_t*)(ws + WS_SGA), D, wt};
              pg8::gemm_phase<pg8::EpiEw<1>, pg8::StaticOrder, false>(F.lds, g, S, E); }
            { pg8::Gemm g{(const bf16_t*)(ws + WS_YB), (const bf16_t*)(wb + OFF_WBB), 512, 0, nullptr}; pg8::EpiEw<2> E{(bf16_t*)(ws + WS_MERGED), (const bf16_t*)(ws + WS_SGB), D, wt};
              pg8::gemm_phase<pg8::EpiEw<2>, pg8::StaticOrder, false>(F.lds, g, S, E); }
        }
        SEAM(pb + 4);
        if (EN(5) && IN(pb + 5) && !(zpass && ((ZSKIP >> 5) & 1))) for (int rep = 0; rep < REPS(5); ++rep) { PH_BEGIN;
            pg8::StaticOrder S; S.init(T, D, F.G, (int)blockIdx.x);
            pg8::Gemm g{(const bf16_t*)(ws + WS_MERGED), (const bf16_t*)(wb + OFF_WOUT), D, 0, nullptr}; pg8::EpiEw<0> E{Y, nullptr, D, wt};
            pg8::gemm_phase<pg8::EpiEw<0>, pg8::StaticOrder, false>(F.lds, g, S, E);
        }
        SEAM(pb + 5);
        if (EN(6) && IN(pb + 6) && !(zpass && ((ZSKIP >> 6) & 1))) for (int rep = 0; rep < ((l == 0) ? REPS(6) : 1); ++rep) { PH_BEGIN;
            if (l == 0) thin_phase<1, 1, false>(F, (LAYERREP == 0 && REPS(6) == 1) ? A.in[I_X] : nullptr, Y, (zpass || rep + 1 < REPS(6)) ? ZEROG : A.in[I_NMPOST] + (size_t)l * D, A.in[I_NFPRE] + (size_t)l * D, hb, nullptr);
            else        thin_phase<1, 1, true>(F, nullptr, Y, A.in[I_NMPOST] + (size_t)l * D, A.in[I_NFPRE] + (size_t)l * D, hb, A.in[I_RW]);
        }
        SEAM(pb + 6);
        if (EN(7) && IN(pb + 7) && !(zpass && ((ZSKIP >> 7) & 1))) for (int rep = 0; rep < REPS(7); ++rep) { PH_BEGIN;
            if (l == 0) { pg8::StaticOrder S; S.init(T, 2 * DFF, F.G, (int)blockIdx.x);
                pg8::Gemm g{hb, (const bf16_t*)(wb + OFF_FFN), D, 0, nullptr}; pg8::EpiGateUp E{(bf16_t*)(ws + WS_FACT), DFF, wt, FFN0_ACT_QS};
                pg8::gemm_phase<pg8::EpiGateUp, pg8::StaticOrder, false>(F.lds, g, S, E);
            } else { pg8::GroupedOrder S; S.init((const unsigned*)(F.ctl + CW_CNT), 2 * DFE, F.G, (int)blockIdx.x);
#if MOE_FP8
                pg8::Gemm g{hb, (const bf16_t*)(wb + OFF_FFN), D / 2, (size_t)2 * DFE * D / 2, (const int*)(ws + WS_IDXE), D / 2}; pg8::EpiGateUp8 E{ws + WS_MACT, DFE, wt, 1.f / W8_SCALE, ACT8_SCALE};
#ifdef SPLIT_GU
                S.i1 = SPLIT_GU; pg8::gemm_phase<pg8::EpiGateUp8, pg8::GroupedOrder, true, true>(F.lds, g, S, E);
                xcd_barrier(bar);
                S.i0 = SPLIT_GU; S.i1 = 1 << 30;
#endif
                pg8::gemm_phase<pg8::EpiGateUp8, pg8::GroupedOrder, true, true>(F.lds, g, S, E);
#else
                pg8::Gemm g{hb, (const bf16_t*)(wb + OFF_FFN), D, (size_t)2 * DFE * D, (const int*)(ws + WS_IDXE)}; pg8::EpiGateUp E{(bf16_t*)(ws + WS_MACT), DFE, wt, MOE_ACT_QS};
                pg8::gemm_phase<pg8::EpiGateUp, pg8::GroupedOrder, true>(F.lds, g, S, E);
#endif
            }
        }
        SEAM(pb + 7);
        if (EN(8) && IN(pb + 8) && !(zpass && ((ZSKIP >> 8) & 1))) for (int rep = 0; rep < REPS(8); ++rep) { PH_BEGIN;
            if (l == 0) { pg8::StaticOrder S; S.init(T, D, F.G, (int)blockIdx.x);
                pg8::Gemm g{(const bf16_t*)(ws + WS_FACT), (const bf16_t*)(wb + OFF_FDN), DFF, 0, nullptr}; pg8::EpiEw<0> E{Y, nullptr, D, wt};
                pg8::gemm_phase<pg8::EpiEw<0>, pg8::StaticOrder, false>(F.lds, g, S, E);
            } else {
#if MOE_FP8
                constexpr float dsc = 1.f / (W8_SCALE * ACT8_SCALE);
                { pg8::GroupedOrder S; S.init((const unsigned*)(F.ctl + CW_CNT), D, F.G, (int)blockIdx.x, MOE_MAIN_PANELS);
                  pg8::Gemm g{(const bf16_t*)(ws + WS_MACT), (const bf16_t*)(wb + OFF_MDN8), DFE / 2, (size_t)D * DFE / 2, nullptr}; pg8::EpiEw<0> E{(bf16_t*)(ws + WS_YSLOT), nullptr, D, wt, dsc};
                  pg8::gemm_phase<pg8::EpiEw<0>, pg8::GroupedOrder, false, true>(F.lds, g, S, E); }
                { pg8::TailOrder S; S.init((const unsigned*)(F.ctl + CW_CNT), D, F.G, (int)blockIdx.x, MOE_MAIN_PANELS, TAIL_KC, TAIL_KCH);
                  pg8::Gemm g{(const bf16_t*)(ws + WS_MACT), (const bf16_t*)(wb + OFF_MDN8), TAIL_KCH, (size_t)D * DFE / 2, nullptr, DFE / 2}; pg8::EpiPart E{(bf16_t*)(ws + WS_PBUF), D, MOE_MAIN_PANELS, TAIL_KCH, (size_t)TAIL_ROWS * D, wt, dsc};
                  pg8::gemm_phase<pg8::EpiPart, pg8::TailOrder, false, true>(F.lds, g, S, E); }
#else
                { pg8::GroupedOrder S; S.init((const unsigned*)(F.ctl + CW_CNT), D, F.G, (int)blockIdx.x, MOE_MAIN_PANELS);
                  pg8::Gemm g{(const bf16_t*)(ws + WS_MACT), (const bf16_t*)(wb + OFF_MDN), DFE, (size_t)D * DFE, nullptr}; pg8::EpiEw<0> E{(bf16_t*)(ws + WS_YSLOT), nullptr, D, wt};
                  pg8::gemm_phase<pg8::EpiEw<0>, pg8::GroupedOrder, false>(F.lds, g, S, E); }
                { pg8::TailOrder S; S.init((const unsigned*)(F.ctl + CW_CNT), D, F.G, (int)blockIdx.x, MOE_MAIN_PANELS, TAIL_KC, TAIL_KCH);
                  pg8::Gemm g{(const bf16_t*)(ws + WS_MACT), (const bf16_t*)(wb + OFF_MDN), TAIL_KCH, (size_t)D * DFE, nullptr, DFE}; pg8::EpiPart E{(bf16_t*)(ws + WS_PBUF), D, MOE_MAIN_PANELS, TAIL_KCH, (size_t)TAIL_ROWS * D, wt};
                  pg8::gemm_phase<pg8::EpiPart, pg8::TailOrder, false>(F.lds, g, S, E); }
#endif
            }
        }
        SEAM(pb + 8);
        if (EN(9) && IN(pb + 9) && !(zpass && ((ZSKIP >> 9) & 1))) for (int rep = 0; rep < REPS(9); ++rep) { PH_BEGIN;
            if (l == 0) thin_phase<1, 2, false>(F, nullptr, Y, (zpass || rep + 1 < REPS(9)) ? ZEROG : A.in[I_NFPOST] + (size_t)l * D, nullptr, nullptr, nullptr);
            else        thin_phase<2, 2, false>(F, nullptr, (const bf16_t*)(ws + WS_YSLOT), (zpass || rep + 1 < REPS(9)) ? ZEROG : A.in[I_NFPOST] + (size_t)l * D, nullptr, nullptr, nullptr);
        }
        SEAM(pb + 9);
        if (EN(10) && IN(pb + 10) && !(zpass && ((ZSKIP >> 10) & 1))) for (int rep = 0; rep < REPS(10); ++rep) { PH_BEGIN;
            pg8::StaticOrder S; S.init(T, D, F.G, (int)blockIdx.x);
            if (MK_DBG == 0 || A.sub != 2) { pg8::Gemm g{(const bf16_t*)(ws + WS_XS), (const bf16_t*)(wb + OFF_WPG), D, 0, nullptr}; pg8::EpiEw<PLE_MODE1> E{Y, nullptr, D, wt};
              pg8::gemm_phase<pg8::EpiEw<PLE_MODE1>, pg8::StaticOrder, false>(F.lds, g, S, E); }
            if (MK_DBG == 0 || A.sub != 1) { pg8::Gemm g{(const bf16_t*)(ws + WS_PB) + (size_t)l * T * PLE, (const bf16_t*)(wb + OFF_WPP), PLE, 0, nullptr}; pg8::EpiEw<4> E{Y, nullptr, D, wt};
              pg8::gemm_phase<pg8::EpiEw<4>, pg8::StaticOrder, false>(F.lds, g, S, E); }
        }
        SEAM(pb + 10);
        if (EN(11) && IN(pb + 11) && !(zpass && ((ZSKIP >> 11) & 1))) for (int rep = 0; rep < REPS(11); ++rep) { PH_BEGIN;
            if (l + 1 < DEPTH) thin_phase<1, 1, false>(F, nullptr, Y, (zpass || rep + 1 < REPS(11)) ? ZEROG : A.in[I_PNORM] + (size_t)l * D, A.in[I_NMPRE] + (size_t)(zpass ? 0 : l + 1) * D, hb, nullptr);
            else               thin_phase<1, 0, false>(F, nullptr, Y, (zpass || rep + 1 < REPS(11)) ? ZEROG : A.in[I_PNORM] + (size_t)l * D, nullptr, nullptr, nullptr);
        }
        SEAM(pb + 11);
    }
#if MK_STAMP
    {
        xcd_barrier(bar);
        const unsigned long long* st = (const unsigned long long*)(ws + WS_CTL + 786432);
        LAS float* res = (LAS float*)(F.lds);
        if (F.tid < N_PHASES) { const int k = F.tid; unsigned long long mx = 0, mxp = 0; double sum = 0.0;
            for (int g = 0; g < F.G; ++g) { const unsigned long long t = st[k * 256 + g]; mx = t > mx ? t : mx; sum += (double)t; if (k > 0) { const unsigned long long tp = st[(k - 1) * 256 + g]; mxp = tp > mxp ? tp : mxp; } }
            if (k == 0) { mxp = ~0ull; for (int g = 0; g < F.G; ++g) { const unsigned long long t = st[g]; mxp = t < mxp ? t : mxp; } mxp -= 0; }
            res[k] = (float)((double)(mx - mxp) * 0.01); res[32 + k] = (float)(((double)mx - sum / F.G) * 0.01); }
        __syncthreads();
        float t1, t2;
        if (STAMP_SEL < 0) { t1 = 0.f; t2 = 0.f; for (int k = 1; k < N_PHASES; ++k) { t1 += res[32 + k]; t2 += res[k]; } }
        else { t1 = res[STAMP_SEL]; t2 = res[32 + STAMP_SEL]; }
        const float A = 300.f * t1 + 1000.f, B = 10.f * t2 + 20.f;
        for (size_t i = (size_t)blockIdx.x * NTHR + F.tid; i < (size_t)T * D; i += (size_t)F.G * NTHR) args.out[i] = (i == 0) ? A : B;
    }
#endif
#undef IN
#undef SEAM
}
#ifndef MK_DBG
#define MK_DBG 0
#endif
#if MK_DBG
#ifndef MK_DBG_SHOW
#define MK_DBG_SHOW -1
#endif
constexpr size_t WS_SNAP = 512 * 1024;
__device__ __forceinline__ unsigned dh(unsigned x) { x ^= x >> 16; x *= 0x7feb352du; x ^= x >> 15; x *= 0x846ca68bu; x ^= x >> 16; return x; }
__device__ __forceinline__ void dbg_acc(float* dbg, int stage, float d2, float e2, int lane) { d2 = wave_sum(d2); e2 = wave_sum(e2); if (lane == 0) { atomicAdd(dbg + 2 * stage, d2); atomicAdd(dbg + 2 * stage + 1, e2); } }
__device__ __forceinline__ float ddot(const bf16_t* arow, const float* W, int K, int pitch, int col, int lane) { float s = 0.f; for (int k = lane; k < K; k += 64) s += bf2f(arow[k]) * W[(size_t)k * pitch + col]; return wave_sum(s); }
__device__ __forceinline__ float dsig(float v) { return 1.f / (1.f + expf(-v)); }
__device__ __forceinline__ int dbg_pbase(const unsigned* gcnt, int e) { int acc = 0; for (int q = 0; q < 8; ++q) if (q < e) acc += (((int)gcnt[q] + 255) >> 8) << 8; return acc; }
__device__ __forceinline__ float dbg_moe_el(const unsigned char* ws, int s, int k) { if (s < MOE_MAIN_ROWS) return bf2f(((const bf16_t*)(ws + WS_YSLOT))[(size_t)s * D + k]); float a = 0.f; for (int kc = 0; kc < TAIL_KC; ++kc) a += bf2f(((const bf16_t*)(ws + WS_PBUF))[((size_t)kc * TAIL_ROWS + (s - MOE_MAIN_ROWS)) * D + k]); return a; }
__device__ __forceinline__ float dbg_f8(const unsigned char* p, size_t i) { return __builtin_amdgcn_cvt_f32_fp8((int)p[i], 0); }
__device__ __forceinline__ float ddot8(const unsigned char* arow, float ascale, const float* W, int K, int pitch, int col, int lane) { float s = 0.f; for (int k = lane; k < K; k += 64) s += dbg_f8(arow, k) * ascale * W[(size_t)k * pitch + col]; return wave_sum(s); }
#define DBGP float* dbg = (float*)(a.ws + WS_CTL) + CW_DBG; const int lane = threadIdx.x & 63; const unsigned sid = blockIdx.x; (void)sid

__global__ void dbg_t1(Args a, int stage) { DBGP;
    const int r = dh(sid * 3 + 1) % T; const float* x = a.in[I_X] + (size_t)r * D; const bf16_t* hb = (const bf16_t*)(a.ws + WS_HB) + (size_t)r * D;
    float ss = 0.f; for (int k = lane; k < D; k += 64) ss += x[k] * x[k]; ss = wave_sum(ss); const float rstd = 1.f / sqrtf(ss / D + EPS);
    float d2 = 0.f, e2 = 0.f; for (int k = lane; k < D; k += 64) { const float e = x[k] * rstd * a.in[I_NMPRE][k], g = bf2f(hb[k]); d2 += (g - e) * (g - e); e2 += e * e; }
    dbg_acc(dbg, stage, d2, e2, lane); }

__global__ void dbg_gemm(Args a, int kind, int l, int stage) { DBGP;
    unsigned char* ws = a.ws; const unsigned h1 = dh(sid * 7 + 1), h2 = dh(sid * 7 + 2), h3 = dh(sid * 7 + 3);
    const bf16_t* hb = (const bf16_t*)(ws + WS_HB); float e = 0.f, g = 0.f;
    const unsigned* gcnt = (const unsigned*)(ws + WS_CTL) + CW_CNT;
    if (kind == 1) { const int row = h1 % T, col = h2 % INWG, sc = col < 2560 ? col : col + 16; const float v = ddot(hb + (size_t)row * D, a.in[I_WIN] + (size_t)l * D * INW, D, INW, sc, lane);
        const bf16_t* P = (const bf16_t*)(ws + WS_PROJ);
        if (col < 512) { e = v * pg8::QA_SCALE; g = bf2f(((const bf16_t*)(ws + WS_QA))[(size_t)row * 512 + col]); }
        else if (col < 1024) { e = v; g = bf2f(((const bf16_t*)(ws + WS_KA))[(size_t)row * 512 + col - 512]); }
        else if (col < 1536) { e = v; g = bf2f(((const bf16_t*)(ws + WS_VA))[(size_t)row * 512 + col - 1024]); }
        else if (col < 1792) { e = v * 0.125f; g = bf2f(((const bf16_t*)(ws + WS_QB))[(size_t)row * 256 + col - 1536]); }
        else if (col < 2048) { e = v; g = bf2f(((const bf16_t*)(ws + WS_KB))[(size_t)row * 256 + col - 1792]); }
        else if (col < 2560) { e = v; g = bf2f(((const bf16_t*)(ws + WS_VB))[(size_t)row * 512 + col - 2048]); }
        else if (col < 3072) { e = v * dsig(v); g = bf2f(((const bf16_t*)(ws + WS_SR))[(size_t)row * 512 + col - 2560]); }
        else if (col < 4096) { e = dsig(v); g = bf2f(((const bf16_t*)(ws + WS_SGA))[(size_t)row * 1024 + col - 3072]); }
        else { e = dsig(v); g = bf2f(((const bf16_t*)(ws + WS_SGB))[(size_t)row * 1024 + col - 4096]); } (void)P;
    } else if (kind == 2) { const int row = h1 % T, col = h2 % D;
        const float va = ddot((const bf16_t*)(ws + WS_YA) + (size_t)row * 512, a.in[I_WBA] + (size_t)l * 512 * D, 512, D, col, lane), vb = ddot((const bf16_t*)(ws + WS_YB) + (size_t)row * 512, a.in[I_WBB] + (size_t)l * 512 * D, 512, D, col, lane);
        e = bf2f(((const bf16_t*)(ws + WS_SGA))[(size_t)row * D + col]) * va + bf2f(((const bf16_t*)(ws + WS_SGB))[(size_t)row * D + col]) * vb; g = bf2f(((const bf16_t*)(ws + WS_MERGED))[(size_t)row * D + col]);
    } else if (kind == 3) { const int row = h1 % T, col = h2 % D; e = ddot((const bf16_t*)(ws + WS_MERGED) + (size_t)row * D, a.in[I_WOUT] + (size_t)l * D * D, D, D, col, lane); g = bf2f(((const bf16_t*)(ws + WS_Y))[(size_t)row * D + col]);
    } else if (kind == 4) { const int row = h1 % T, c = h2 % DFF; const float vg = ddot(hb + (size_t)row * D, a.in[I_FG], D, DFF, c, lane), vu = ddot(hb + (size_t)row * D, a.in[I_FU], D, DFF, c, lane);
        e = vg * dsig(vg) * vu; g = bf2f(((const bf16_t*)(ws + WS_FACT))[(size_t)row * DFF + c]);
    } else if (kind == 5) { const int row = h1 % T, col = h2 % D; e = ddot((const bf16_t*)(ws + WS_FACT) + (size_t)row * DFF, a.in[I_FD], DFF, D, col, lane); g = bf2f(((const bf16_t*)(ws + WS_Y))[(size_t)row * D + col]);
    } else if (kind == 6 || kind == 7) { const int ex = h1 % NE; const int pbase = dbg_pbase(gcnt, ex); const int cnt = (int)gcnt[ex];
        if (cnt == 0) return; const int i = h2 % cnt, tok = ((const int*)(ws + WS_IDXE))[ex * 16384 + i], row = pbase + i;
#if MOE_FP8
        const unsigned char* hb8 = ws + WS_HB; const unsigned char* act8 = ws + WS_MACT;
        if (kind == 6) { const int c = h3 % DFE; const float vg = ddot8(hb8 + (size_t)tok * D, 1.f, a.in[I_MG] + (size_t)ex * D * DFE, D, DFE, c, lane), vu = ddot8(hb8 + (size_t)tok * D, 1.f, a.in[I_MU] + (size_t)ex * D * DFE, D, DFE, c, lane);
            e = vg * dsig(vg) * vu; g = dbg_f8(act8, (size_t)row * DFE + c) * (1.f / ACT8_SCALE); }
        else { const int col = h3 % D; e = ddot8(act8 + (size_t)row * DFE, 1.f / ACT8_SCALE, a.in[I_MD] + (size_t)ex * DFE * D, DFE, D, col, lane); g = dbg_moe_el(ws, row, col); }
#else
        if (kind == 6) { const int c = h3 % DFE; const float vg = ddot(hb + (size_t)tok * D, a.in[I_MG] + (size_t)ex * D * DFE, D, DFE, c, lane), vu = ddot(hb + (size_t)tok * D, a.in[I_MU] + (size_t)ex * D * DFE, D, DFE, c, lane);
            e = vg * dsig(vg) * vu; g = bf2f(((const bf16_t*)(ws + WS_MACT))[(size_t)row * DFE + c]); }
        else { const int col = h3 % D; e = ddot((const bf16_t*)(ws + WS_MACT) + (size_t)row * DFE, a.in[I_MD] + (size_t)ex * DFE * D, DFE, D, col, lane); g = dbg_moe_el(ws, row, col); }
#endif
    } else if (kind == 12) { const int row = h1 % T, col = h2 % D; e = a.out[(size_t)row * D + col]; g = bf2f(((const bf16_t*)(ws + WS_XS))[(size_t)row * D + col]);
    } else if (kind == 13) { const int row = h1 % T, col = h2 % D; e = ddot((const bf16_t*)(ws + WS_XS) + (size_t)row * D, a.in[I_PG] + (size_t)l * D * D, D, D, col, lane); g = bf2f(((const bf16_t*)(ws + WS_Y))[(size_t)row * D + col]);
    } else if (kind == 11) { const int n = h1 % D, k = h2 % D; e = a.in[I_PG][(size_t)l * D * D + (size_t)k * D + n]; g = bf2f(((const bf16_t*)(ws + (l ? WS_W1 : WS_W0) + OFF_WPG))[(size_t)n * D + k]);
    } else if (kind == 9) { const int row = h1 % T, col = h2 % D; e = dsig(ddot((const bf16_t*)(ws + WS_XS) + (size_t)row * D, a.in[I_PG] + (size_t)l * D * D, D, D, col, lane)); g = bf2f(((const bf16_t*)(ws + WS_Y))[(size_t)row * D + col]);
    } else { const int row = h1 % T, col = h2 % D; const float vg = ddot((const bf16_t*)(ws + WS_XS) + (size_t)row * D, a.in[I_PG] + (size_t)l * D * D, D, D, col, lane), vp = ddot((const bf16_t*)(ws + WS_PB) + ((size_t)l * T + row) * PLE, a.in[I_PP] + (size_t)l * PLE * D, PLE, D, col, lane);
        e = dsig(vg) * vp; g = bf2f(((const bf16_t*)(ws + WS_Y))[(size_t)row * D + col]); }
    if (lane == 0) { atomicAdd(dbg + 2 * stage, (g - e) * (g - e)); atomicAdd(dbg + 2 * stage + 1, e * e); } }

__global__ void dbg_attn(Args a, int l, int stage) { DBGP;
    unsigned char* ws = a.ws; const unsigned h1 = dh(sid * 5 + 1); const int tok = h1 % T, h = dh(sid * 5 + 2) % AH, b = tok / SEQ, c = (tok % SEQ) / CH, ql = tok % CH;
    const bf16_t* hb = (const bf16_t*)(ws + WS_HB) + (size_t)tok * D; const float* win = a.in[I_WIN] + (size_t)l * D * INW;
    float q = 0.f; for (int k = 0; k < D; ++k) q += bf2f(hb[k]) * win[(size_t)k * INW + h * 64 + lane]; q *= pg8::QA_SCALE;
    const bf16_t* ka = (const bf16_t*)(ws + WS_KA); const bf16_t* va = (const bf16_t*)(ws + WS_VA); const float* rb = a.in[I_RELB] + ((size_t)l * AH + h) * RELN;
    float m = -1e30f, ls = 0.f, o = 0.f;
    for (int kc = (c - 8 > 0 ? c - 8 : 0); kc <= c; ++kc) for (int kl = 0; kl < CH; ++kl) { const int kt = b * SEQ + kc * CH + kl; int dist = (c - kc) * 64 + ql - kl; dist = dist > 128 ? 128 : (dist < -128 ? -128 : dist);
        const float s = wave_sum(q * bf2f(ka[(size_t)kt * 512 + h * 64 + lane])) + rb[dist + 128] * LOG2E; const float mn = fmaxf(m, s), al = exp2f(m - mn), p = exp2f(s - mn); m = mn; ls = ls * al + p; o = o * al + p * bf2f(va[(size_t)kt * 512 + h * 64 + lane]); }
    const float e = o / ls, g = bf2f(((const bf16_t*)(ws + WS_YA))[(size_t)tok * 512 + h * 64 + lane]);
    dbg_acc(dbg, stage, (g - e) * (g - e), e * e, lane); }

__global__ void dbg_dstate(Args a, int l, int stage) { DBGP;
    unsigned char* ws = a.ws; const int b = dh(sid * 5 + 1) % NB, c = dh(sid * 5 + 2) % NCH, hh = dh(sid * 5 + 3) % BH, v = dh(sid * 5 + 4) % 128, k = dh(sid * 5 + 5) % 64, col = hh * 64 + k;
    const int tok = b * SEQ + c * CH + lane; const bf16_t* hb = (const bf16_t*)(ws + WS_HB) + (size_t)tok * D; const float* win = a.in[I_WIN] + (size_t)l * D * INW;
    float z = a.in[I_BG][l * 256 + col];
    for (int r = 0; r < GR; ++r) { float gd = 0.f; for (int kk = 0; kk < D; ++kk) gd += bf2f(hb[kk]) * win[(size_t)kk * INW + 2560 + r]; z += gd * a.in[I_WGUP][((size_t)l * GR + r) * 256 + col]; }
    const float la = (fminf(z, 0.f) - log1pf(expf(-fabsf(z)))) / 16.f; float cum = la;
    for (int o = 1; o < 64; o <<= 1) { const float t = __shfl_up(cum, o); if (lane >= o) cum += t; }
    const float tot = __shfl(cum, 63);
    const float kd = bf2f(((const bf16_t*)(ws + WS_KB))[(size_t)tok * 256 + col]) * expf(tot - cum);
    const float e = wave_sum(kd * bf2f(((const bf16_t*)(ws + WS_VB))[(size_t)tok * 512 + hh * 128 + v]));
    const float g = ((const float*)(ws + WS_DST))[((size_t)((b * NCH + c) * BH + hh) * 128 + v) * 64 + k];
    const float ed = expf(tot), gdc = ((const float*)(ws + WS_DEC))[(size_t)(b * NCH + c) * 256 + col];
    if (lane == 0) { atomicAdd(dbg + 2 * stage, (g - e) * (g - e) + (gdc - ed) * (gdc - ed)); atomicAdd(dbg + 2 * stage + 1, e * e + ed * ed); } }

__global__ void dbg_scan(Args a, int stage) { DBGP;
    unsigned char* ws = a.ws; const unsigned s0 = sid * 64 + lane; const int b = dh(s0 * 5 + 1) % NB, c = dh(s0 * 5 + 2) % NCH, hh = dh(s0 * 5 + 3) % BH, v = dh(s0 * 5 + 4) % 128, k = dh(s0 * 5 + 5) % 64;
    float s = 0.f; for (int cc = 0; cc <= c; ++cc) s = ((const float*)(ws + WS_DEC))[(size_t)(b * NCH + cc) * 256 + hh * 64 + k] * s + ((const float*)(ws + WS_DST))[((size_t)((b * NCH + cc) * BH + hh) * 128 + v) * 64 + k];
    const float g = bf2f(((const bf16_t*)(ws + WS_ST))[((size_t)((b * NCH + c) * BH + hh) * 128 + v) * 64 + k]);
    dbg_acc(dbg, stage, (g - s) * (g - s), s * s, lane); }

__global__ void dbg_glaout(Args a, int l, int stage) { DBGP;
    unsigned char* ws = a.ws; const int tok = dh(sid * 3 + 1) % T, hh = dh(sid * 3 + 2) % BH, b = tok / SEQ, c = (tok % SEQ) / CH;
    const bf16_t* st = (const bf16_t*)(ws + WS_ST) + ((size_t)((b * NCH + c) * BH + hh) * 128) * 64; const bf16_t* qb = (const bf16_t*)(ws + WS_QB) + (size_t)tok * 256 + hh * 64;
    const bf16_t* hb = (const bf16_t*)(ws + WS_HB) + (size_t)tok * D; const float* win = a.in[I_WIN] + (size_t)l * D * INW;
    float o[2], r[2];
#pragma unroll
    for (int j = 0; j < 2; ++j) { const int v = lane + 64 * j; float s = 0.f; for (int k = 0; k < 64; ++k) s += bf2f(qb[k]) * bf2f(st[(size_t)v * 64 + k]); o[j] = s;
        float rr = 0.f; for (int kk = 0; kk < D; ++kk) rr += bf2f(hb[kk]) * win[(size_t)kk * INW + 2576 + hh * 128 + v]; r[j] = rr * dsig(rr); }
    const float ss = wave_sum(o[0] * o[0] + o[1] * o[1]), rstd = 1.f / sqrtf(ss / 128.f + EPS); float d2 = 0.f, e2 = 0.f;
#pragma unroll
    for (int j = 0; j < 2; ++j) { const int v = lane + 64 * j; const float e = o[j] * rstd * a.in[I_GNORM][l * 512 + hh * 128 + v] * r[j], g = bf2f(((const bf16_t*)(ws + WS_YB))[(size_t)tok * 512 + hh * 128 + v]); d2 += (g - e) * (g - e); e2 += e * e; }
    dbg_acc(dbg, stage, d2, e2, lane); }

__device__ __forceinline__ int dbg_row(unsigned i) { return (int)((i * 257u + 11u) % T); }
__global__ void dbg_snap(Args a, int from_in) { const int i = blockIdx.x, r = dbg_row(i); float* snap = (float*)(a.ws + WS_SNAP) + (size_t)i * D; const bf16_t* xs = (const bf16_t*)(a.ws + WS_XS); for (int k = threadIdx.x; k < D; k += 64) snap[k] = from_in ? a.in[I_X][(size_t)r * D + k] : bf2f(xs[(size_t)r * D + k]); }
__global__ void dbg_thin(Args a, int src, int outk, int route, const float* g_add, const float* g_out, const bf16_t* obuf, int st_x, int st_o, int st_r) { DBGP;
    unsigned char* ws = a.ws; const int i = sid, r = dbg_row(i); const float* snap = (const float*)(ws + WS_SNAP) + (size_t)i * D;
    const unsigned* gcnt = (const unsigned*)(ws + WS_CTL) + CW_CNT; const unsigned* ti = (const unsigned*)(ws + WS_TOKINFO) + (size_t)r * 8;
    float y[16], xn[16]; float ss = 0.f;
#pragma unroll
    for (int j = 0; j < 16; ++j) { const int k = lane + 64 * j; float v;
        if (src == 1) v = bf2f(((const bf16_t*)(ws + WS_Y))[(size_t)r * D + k]);
        else { v = __uint_as_float(ti[4]) * dbg_moe_el(ws, dbg_pbase(gcnt, (int)ti[0]) + (int)ti[1], k) + __uint_as_float(ti[5]) * dbg_moe_el(ws, dbg_pbase(gcnt, (int)ti[2]) + (int)ti[3], k); }
        y[j] = v; ss += v * v; }
    ss = wave_sum(ss); const float rstd = 1.f / sqrtf(ss / D + EPS); float d2 = 0.f, e2 = 0.f, s2 = 0.f;
#pragma unroll
    for (int j = 0; j < 16; ++j) { const int k = lane + 64 * j; xn[j] = snap[k] + y[j] * rstd * g_add[k]; const float g = (outk == 0) ? a.out[(size_t)r * D + k] : bf2f(((const bf16_t*)(ws + WS_XS))[(size_t)r * D + k]); d2 += (g - xn[j]) * (g - xn[j]); e2 += xn[j] * xn[j]; s2 += xn[j] * xn[j]; }
    dbg_acc(dbg, st_x, d2, e2, lane);
    if (outk != 1) return;
    s2 = wave_sum(s2); const float rs2 = 1.f / sqrtf(s2 / D + EPS); d2 = 0.f; e2 = 0.f; float hn[16];
#pragma unroll
    for (int j = 0; j < 16; ++j) { const int k = lane + 64 * j; hn[j] = (outk == 1) ? xn[j] * rs2 * g_out[k] : xn[j]; const float g = (MOE_FP8 && route) ? dbg_f8((const unsigned char*)obuf, (size_t)r * D + k) : bf2f(obuf[(size_t)r * D + k]); d2 += (g - hn[j]) * (g - hn[j]); e2 += hn[j] * hn[j]; }
    dbg_acc(dbg, st_o, d2, e2, lane);
    if (!route) return;
    float lg[8];
#pragma unroll
    for (int e = 0; e < 8; ++e) { float s = 0.f;
#pragma unroll
        for (int j = 0; j < 16; ++j) s += hn[j] * a.in[I_RW][(size_t)(lane + 64 * j) * NE + e]; lg[e] = wave_sum(s); }
    int e1 = 0; float v1 = lg[0];
#pragma unroll
    for (int e = 1; e < 8; ++e) if (lg[e] > v1) { v1 = lg[e]; e1 = e; }
    int e2i = -1; float v2 = -3.0e38f;
#pragma unroll
    for (int e = 0; e < 8; ++e) if (e != e1 && lg[e] > v2) { v2 = lg[e]; e2i = e; }
    const float ex = expf(v2 - v1), w1 = 1.f / (1.f + ex);
    float bad = 0.f; if ((int)ti[0] != e1 || (int)ti[2] != e2i) bad = 1.f; else { bad = fabsf(__uint_as_float(ti[4]) - w1) + fabsf(__uint_as_float(ti[5]) - (1.f - w1));
        const int* idxe = (const int*)(ws + WS_IDXE); if (ti[1] >= gcnt[e1] || ti[3] >= gcnt[e2i] || idxe[e1 * 16384 + ti[1]] != r || idxe[e2i * 16384 + ti[3]] != r) bad = 1.f; }
    if (lane == 0) { atomicAdd(dbg + 2 * st_r, bad * bad); atomicAdd(dbg + 2 * st_r + 1, 1.f); } }

__global__ void dbg_report(Args a) {
    const float* dbg = (const float*)(a.ws + WS_CTL) + CW_DBG; int bad = -1; float errk = 0.f;
    for (int k = 0; k < 33; ++k) { const float d2 = dbg[2 * k], e2 = dbg[2 * k + 1]; if (d2 == 0.f && e2 == 0.f) continue; const float err = d2 / e2; if (MK_DBG_SHOW == k) errk = (err == err) ? err : 1e6f; const float thr = (MOE_FP8 && (k == 25 || k == 27 || k == 28)) ? 3e-2f : 1e-3f; if (bad < 0 && !(err < thr)) bad = k; }
    float V = 0.f; bool fill = false;
    if (MK_DBG_SHOW >= 0) { V = sqrtf(7.f * 100.f * errk) + 1e-3f; fill = true; } else if (bad >= 0) { V = exp10f(1.f + 0.25f * (float)bad); fill = true; }
    if (fill) for (size_t i = (size_t)blockIdx.x * blockDim.x + threadIdx.x; i < (size_t)T * D; i += (size_t)gridDim.x * blockDim.x) a.out[i] = V; }

static void dbg_run(Args a, int grid, hipStream_t st) {
    auto ph = [&](int p) { a.ph_lo = p; a.ph_hi = p + 1; hipLaunchKernelGGL(fwd, dim3(grid), dim3(NTHR), LDS_BYTES, st, a); };
    const int NS = 2048;
    ph(0); hipLaunchKernelGGL(dbg_t1, dim3(256), dim3(64), 0, st, a, 0);
    for (int l = 0; l < DEPTH; ++l) { const int pb = 1 + 12 * l, sb = 16 * l; const size_t lo = (size_t)l * D;
        ph(pb + 0); hipLaunchKernelGGL(dbg_gemm, dim3(NS), dim3(64), 0, st, a, 1, l, sb + 1);
        ph(pb + 1); hipLaunchKernelGGL(dbg_attn, dim3(512), dim3(64), 0, st, a, l, sb + 2); hipLaunchKernelGGL(dbg_dstate, dim3(256), dim3(64), 0, st, a, l, sb + 3);
        ph(pb + 2); hipLaunchKernelGGL(dbg_scan, dim3(64), dim3(64), 0, st, a, sb + 4);
        ph(pb + 3); hipLaunchKernelGGL(dbg_glaout, dim3(256), dim3(64), 0, st, a, l, sb + 5);
        ph(pb + 4); hipLaunchKernelGGL(dbg_gemm, dim3(NS), dim3(64), 0, st, a, 2, l, sb + 6);
        ph(pb + 5); hipLaunchKernelGGL(dbg_gemm, dim3(NS), dim3(64), 0, st, a, 3, l, sb + 7);
        hipLaunchKernelGGL(dbg_snap, dim3(64), dim3(64), 0, st, a, l == 0 ? 1 : 0);
        ph(pb + 6); hipLaunchKernelGGL(dbg_thin, dim3(64), dim3(64), 0, st, a, 1, 1, l == 1 ? 1 : 0, a.in[I_NMPOST] + lo, a.in[I_NFPRE] + lo, (const bf16_t*)(a.ws + WS_HB), sb + 8, sb + 9, sb + 10);
        ph(pb + 7); hipLaunchKernelGGL(dbg_gemm, dim3(NS), dim3(64), 0, st, a, l == 0 ? 4 : 6, l, sb + 11);
        ph(pb + 8); hipLaunchKernelGGL(dbg_gemm, dim3(NS), dim3(64), 0, st, a, l == 0 ? 5 : 7, l, sb + 12);
        hipLaunchKernelGGL(dbg_snap, dim3(64), dim3(64), 0, st, a, 0);
        ph(pb + 9); hipLaunchKernelGGL(dbg_thin, dim3(64), dim3(64), 0, st, a, l == 0 ? 1 : 2, 2, 0, a.in[I_NFPOST] + lo, (const float*)nullptr, (const bf16_t*)nullptr, sb + 13, sb + 13, 0);
        a.sub = 1; ph(pb + 10); hipLaunchKernelGGL(dbg_gemm, dim3(NS), dim3(64), 0, st, a, 9, l, sb + 14);
        a.sub = 2; ph(pb + 10); a.sub = 0; hipLaunchKernelGGL(dbg_gemm, dim3(NS), dim3(64), 0, st, a, 8, l, sb + 15);
        hipLaunchKernelGGL(dbg_snap, dim3(64), dim3(64), 0, st, a, 0);
        ph(pb + 11); hipLaunchKernelGGL(dbg_thin, dim3(64), dim3(64), 0, st, a, 1, l == 0 ? 1 : 0, 0, a.in[I_PNORM] + lo, l == 0 ? a.in[I_NMPRE] + D : (const float*)nullptr, (const bf16_t*)(a.ws + WS_HB), sb + 16, sb + 16, 0);
    }
    hipLaunchKernelGGL(dbg_report, dim3(1024), dim3(256), 0, st, a);
}
#endif
#ifndef MK_SPLIT
#define MK_SPLIT 0
#endif
#ifndef MK_DBG
#define MK_DBG 0
#endif
extern "C" void kernel_launch(void* const* d_in, const int* in_sizes, int n_in, void* d_out, int out_size, void* d_ws, size_t ws_size, hipStream_t stream) {
    static int grid = 0;
    if (grid == 0) {
        if (n_in != 24 || in_sizes[0] != T * D || out_size != T * D || ws_size < WS_END) { fprintf(stderr, "kernel_launch: unexpected problem (n_in %d, in0 %d, out %d, ws %zu < %zu); nothing launched\n", n_in, n_in > 0 ? in_sizes[0] : -1, out_size, ws_size, (size_t)WS_END); grid = -1; return; }
        int dev = 0, cus = 0, per_cu = 0;
        if (hipGetDevice(&dev) != hipSuccess || hipDeviceGetAttribute(&cus, hipDeviceAttributeMultiprocessorCount, dev) != hipSuccess) { grid = -1; return; }
        if (hipFuncSetAttribute((const void*)fwd, hipFuncAttributeMaxDynamicSharedMemorySize, LDS_BYTES) != hipSuccess) { fprintf(stderr, "kernel_launch: hipFuncSetAttribute failed\n"); grid = -1; return; }
        if (hipOccupancyMaxActiveBlocksPerMultiprocessor(&per_cu, (const void*)fwd, NTHR, LDS_BYTES) != hipSuccess || per_cu < 1) { fprintf(stderr, "kernel_launch: occupancy query says %d blocks per CU\n", per_cu); }
        (void)hipGetLastError();
        grid = cus;
    }
    if (grid < 0) return;
    (void)hipMemsetAsync((char*)d_ws + WS_CTL, 0, CTL_ZERO_BYTES, stream);
    Args a{};
    for (int i = 0; i < 24; ++i) a.in[i] = (const float*)d_in[i];
    a.out = (float*)d_out; a.ws = (unsigned char*)d_ws;
#if MK_DBG
    dbg_run(a, grid, stream);
#elif MK_SPLIT
    for (int p = 0; p < N_PHASES; ++p) { a.ph_lo = p; a.ph_hi = p + 1; hipLaunchKernelGGL(fwd, dim3(grid), dim3(NTHR), LDS_BYTES, stream, a); }
#else
    a.ph_lo = 0; a.ph_hi = N_PHASES;
    hipLaunchKernelGGL(fwd, dim3(grid), dim3(NTHR), LDS_BYTES, stream, a);
#endif
}
```

```cpp
#define TR_NFAST 1
#define THIN_PF 1
#define EPI_PK 1
#define XL_DPP 1
#include <hip/hip_runtime.h>
#include <cstdio>
#include <cstdint>

#define LAS __attribute__((address_space(3)))
#define GAS __attribute__((address_space(1)))
typedef unsigned short bf16_t;
typedef short bf16x8 __attribute__((ext_vector_type(8)));
typedef short s16x4 __attribute__((ext_vector_type(4)));
typedef float f32x4 __attribute__((ext_vector_type(4)));
typedef float f32x2 __attribute__((ext_vector_type(2)));
typedef unsigned u32x4 __attribute__((ext_vector_type(4)));
typedef unsigned u32x2 __attribute__((ext_vector_type(2)));

typedef __bf16 bf16x2_t __attribute__((ext_vector_type(2)));
__device__ __forceinline__ unsigned cvt_pk_bf16(float lo, float hi) { f32x2 v = {lo, hi}; const bf16x2_t b = __builtin_convertvector(v, bf16x2_t); return __builtin_bit_cast(unsigned, b); }
#ifndef WT_STORES
#define WT_STORES 1
#endif
#ifndef WT_AUX
#define WT_AUX 16
#endif
struct WT { __amdgpu_buffer_rsrc_t rs; const char* base; };
__device__ __forceinline__ WT make_wt(void* ws_base, unsigned nbytes) { WT w; w.rs = __builtin_amdgcn_make_buffer_rsrc(ws_base, 0, (int)nbytes, 0x00020000); w.base = (const char*)ws_base; return w; }
__device__ __forceinline__ void st16(const WT& w, void* p, u32x4 v) {
#if WT_STORES
    __builtin_amdgcn_raw_buffer_store_b128(v, w.rs, (int)(unsigned)((const char*)p - w.base), 0, WT_AUX);
#else
    *(u32x4*)p = v;
#endif
}
__device__ __forceinline__ void st8(const WT& w, void* p, u32x2 v) {
#if WT_STORES
    __builtin_amdgcn_raw_buffer_store_b64(v, w.rs, (int)(unsigned)((const char*)p - w.base), 0, WT_AUX);
#else
    *(u32x2*)p = v;
#endif
}
__device__ __forceinline__ float clamp8(float v) { return __builtin_amdgcn_fmed3f(v, -448.f, 448.f); }
__device__ __forceinline__ unsigned pk4_fp8(float a, float b, float c, float d) { int w = __builtin_amdgcn_cvt_pk_fp8_f32(clamp8(a), clamp8(b), 0, false); w = __builtin_amdgcn_cvt_pk_fp8_f32(clamp8(c), clamp8(d), w, true); return (unsigned)w; }
__device__ __forceinline__ float q8(float x, float s) { const int w = __builtin_amdgcn_cvt_pk_fp8_f32(x * s, 0.f, 0, false); return __builtin_amdgcn_cvt_f32_fp8(w, 0) * (1.0f / s); }
__device__ __forceinline__ float bf_lo(unsigned w) { return __uint_as_float(w << 16); }
__device__ __forceinline__ float bf_hi(unsigned w) { return __uint_as_float(w & 0xffff0000u); }
__device__ __forceinline__ float bf2f(bf16_t b) { return __uint_as_float(((unsigned)b) << 16); }
__device__ __forceinline__ float fast_sigmoid(float v) { return __builtin_amdgcn_rcpf(1.0f + __builtin_amdgcn_exp2f(-1.4426950408889634f * v)); }
__device__ __forceinline__ f32x2 lo2(f32x4 v) { return __builtin_shufflevector(v, v, 0, 1); }
__device__ __forceinline__ f32x2 hi2(f32x4 v) { return __builtin_shufflevector(v, v, 2, 3); }
__device__ __forceinline__ f32x4 cat2(f32x2 a, f32x2 b) { return __builtin_shufflevector(a, b, 0, 1, 2, 3); }
__device__ __forceinline__ f32x2 rcp_1p_exp2(f32x2 a) { const f32x2 d = (f32x2){__builtin_amdgcn_exp2f(a.x), __builtin_amdgcn_exp2f(a.y)} + (f32x2){1.0f, 1.0f}; return (f32x2){__builtin_amdgcn_rcpf(d.x), __builtin_amdgcn_rcpf(d.y)}; }
__device__ __forceinline__ f32x2 sigmoid2(f32x2 v) { return rcp_1p_exp2(v * (f32x2){-1.4426950408889634f, -1.4426950408889634f}); }
__device__ __forceinline__ f32x4 sigmoid4(f32x4 v) { return cat2(sigmoid2(lo2(v)), sigmoid2(hi2(v))); }
#ifdef XL_DPP
template <int CTRL> __device__ __forceinline__ float dpp_f(float v) { return __builtin_bit_cast(float, __builtin_amdgcn_update_dpp(0, __builtin_bit_cast(int, v), CTRL, 0xF, 0xF, true)); }
#define XL_SWAP16(v, a, b) do { const auto _r = __builtin_amdgcn_permlane16_swap(__builtin_bit_cast(unsigned, (v)), __builtin_bit_cast(unsigned, (v)), false, false); a = __builtin_bit_cast(float, (unsigned)_r[0]); b = __builtin_bit_cast(float, (unsigned)_r[1]); } while (0)
#define XL_SWAP32(v, a, b) do { const auto _r = __builtin_amdgcn_permlane32_swap(__builtin_bit_cast(unsigned, (v)), __builtin_bit_cast(unsigned, (v)), false, false); a = __builtin_bit_cast(float, (unsigned)_r[0]); b = __builtin_bit_cast(float, (unsigned)_r[1]); } while (0)
__device__ __forceinline__ float sum_x16_x32(float v) { float a, b; XL_SWAP16(v, a, b); v = a + b; XL_SWAP32(v, a, b); return a + b; }
__device__ __forceinline__ float max_x16_x32(float v) { float a, b; XL_SWAP16(v, a, b); v = fmaxf(a, b); XL_SWAP32(v, a, b); return fmaxf(a, b); }
__device__ __forceinline__ float wave_sum(float v) {
    v += dpp_f<0xB1>(v);
    v += dpp_f<0x4E>(v);
    v += dpp_f<0x141>(v);
    v += dpp_f<0x140>(v);
    return sum_x16_x32(v);
}
#else
__device__ __forceinline__ float sum_x16_x32(float v) { v += __shfl_xor(v, 16); v += __shfl_xor(v, 32); return v; }
__device__ __forceinline__ float max_x16_x32(float v) { v = fmaxf(v, __shfl_xor(v, 16)); v = fmaxf(v, __shfl_xor(v, 32)); return v; }
__device__ __forceinline__ float wave_sum(float v) {
#pragma unroll
    for (int o = 1; o < 64; o <<= 1) v += __shfl_xor(v, o);
    return v;
}
#endif

typedef int v8i32 __attribute__((ext_vector_type(8)));
typedef int v4i32 __attribute__((ext_vector_type(4)));
__device__ __forceinline__ v8i32 cat8i(bf16x8 a, bf16x8 b) { const v4i32 x = __builtin_bit_cast(v4i32, a), y = __builtin_bit_cast(v4i32, b); return (v8i32){x[0], x[1], x[2], x[3], y[0], y[1], y[2], y[3]}; }
namespace pg8 {
constexpr int BM = 256, BK = 64, HALF = 128, HTB = HALF * BK * 2, STAGE_BYTES = 8 * HTB, NXCD = 8, WGM = 8;
__host__ __device__ __forceinline__ int lds_byte(int r, int c) { const int st = (r >> 4) * 2 + (c >> 5), rr = r & 15, cc = c & 31, ob = rr * 64 + cc * 2; return st * 1024 + (ob ^ (((ob >> 9) & 1) << 5)); }
__host__ __device__ __forceinline__ void stage_rc(int b, int& R, int& C) { const int st = b / 1024, sb = b % 1024, swz = sb ^ (((sb >> 9) & 1) << 5); R = (st >> 1) * 16 + swz / 64; C = (st & 1) * 32 + (swz % 64) / 2; }
__host__ __device__ __forceinline__ int perm32(int rho) { const int n = rho >> 4, i = rho & 15; return 8 * (i >> 2) + 4 * n + (i & 3); }

struct Unit { int pm, pn, e, lr0, cnt, koff; };
struct Gemm { const bf16_t* A; const bf16_t* Bt; int K; size_t b_estride; const int* gidx; int ld; };

struct StaticOrder {
    int nM, nN, nwg, G, c;
    __device__ __forceinline__ void init(int M, int N, int G_, int c_) { nM = M / BM; nN = N / BM; nwg = nM * nN; G = G_; c = c_; }
    __device__ __forceinline__ bool short_deal() const { const int r = nwg % G; return r != 0 && c >= r; }
    __device__ __forceinline__ bool next(int i, Unit& u) const {
        const long L = (long)i * G + c; if (L >= nwg) return false;
        int wgid = (int)L; { const int q = nwg / NXCD, r = nwg % NXCD, xcd = wgid % NXCD, off = wgid / NXCD; wgid = (xcd < r ? xcd * (q + 1) : r * (q + 1) + (xcd - r) * q) + off; }
        const int nig = WGM * nN, gid = wgid / nig, fm = gid * WGM, gsz = (nM - fm) < WGM ? (nM - fm) : WGM;
        u.pm = fm + ((wgid % nig) % gsz); u.pn = (wgid % nig) / gsz; u.e = 0; u.lr0 = 0; u.cnt = 0; u.koff = 0; return true;
    }
};
struct GroupedOrder {
    int pb[9]; int cnt[8]; int nN, G, c, nwg, np;
    int i0 = 0, i1 = 1 << 30;
    __device__ __forceinline__ void init(const unsigned* counts, int N, int G_, int c_, int pmax = 1 << 30) {
        int acc = 0;
#pragma unroll
        for (int e = 0; e < 8; ++e) { const int n = (int)counts[e]; cnt[e] = n; pb[e] = acc; acc += (n + 255) >> 8; }
        pb[8] = acc; nN = N / BM; G = G_; c = c_; np = acc < pmax ? acc : pmax; nwg = np * nN;
    }
    __device__ __forceinline__ bool short_deal() const { const int r = nwg % G; return r != 0 && c >= r; }
    __device__ __forceinline__ bool next(int i, Unit& u) const {
        if (i + i0 >= i1) return false;
        const long L = (long)(i + i0) * G + c; if (L >= nwg) return false;
        const int nig = WGM * nN, gid = (int)L / nig, fm = gid * WGM, gsz = (np - fm) < WGM ? (np - fm) : WGM;
        const int pm = fm + (((int)L % nig) % gsz), pn = ((int)L % nig) / gsz;
        int e = 0;
#pragma unroll
        for (int k = 1; k < 8; ++k) e += (pm >= pb[k]) ? 1 : 0;
        int pbe = 0, ce = 0;
#pragma unroll
        for (int k = 0; k < 8; ++k) { pbe = (k == e) ? pb[k] : pbe; ce = (k == e) ? cnt[k] : ce; }
        u.pm = pm; u.pn = pn; u.e = e; u.lr0 = (pm - pbe) * 256; u.cnt = ce; u.koff = 0; return true;
    }
};

struct TailOrder {
    int pb[9]; int nN, G, c, nwg, p0, KC, KCH;
    __device__ __forceinline__ void init(const unsigned* counts, int N, int G_, int c_, int p0_, int KC_, int KCH_) {
        int acc = 0;
#pragma unroll
        for (int e = 0; e < 8; ++e) { pb[e] = acc; acc += ((int)counts[e] + 255) >> 8; }
        pb[8] = acc; nN = N / BM; G = G_; c = c_; p0 = p0_; KC = KC_; KCH = KCH_; nwg = acc > p0 ? (acc - p0) * nN * KC : 0;
    }
    __device__ __forceinline__ bool short_deal() const { return false; }
    __device__ __forceinline__ bool next(int i, Unit& u) const {
        const long L = (long)i * G + c; if (L >= nwg) return false;
        const int kc = (int)L % KC, t = (int)L / KC, pm = p0 + t / nN, pn = t % nN;
        int e = 0;
#pragma unroll
        for (int k = 1; k < 8; ++k) e += (pm >= pb[k]) ? 1 : 0;
        u.pm = pm; u.pn = pn; u.e = e; u.lr0 = 0; u.cnt = 0; u.koff = kc * KCH; return true;
    }
};

template <class Epi, class Sched, bool GATHER, bool F8 = false>
__device__ __forceinline__ void gemm_phase(LAS unsigned char* lds, const Gemm g, const Sched& S, const Epi& E, int stag = 0) {
    int tid = threadIdx.x; asm volatile("" : "+v"(tid));
    const int wid = __builtin_amdgcn_readfirstlane(tid >> 6), lane = tid & 63, wr = wid >> 2, wc = wid & 3, fr = lane & 15, fq = lane >> 4;
    const int K = g.K, nt = K / BK, LD = g.ld ? g.ld : g.K;
    unsigned voffA[2], voffB[2]; int rA[2];
#pragma unroll
    for (int i = 0; i < 2; ++i) { int R, C; stage_rc(tid * 16 + i * 8192, R, C); const int Rb = Epi::PERM ? ((R & ~31) + perm32(R & 31)) : R;
        voffA[i] = GATHER ? (unsigned)(C * 2) : (unsigned)(R * LD + C) * 2u; voffB[i] = (unsigned)(Rb * LD + C) * 2u; rA[i] = R; }
    const size_t kstep = (size_t)(BK * 2);
    const size_t hstep = (size_t)HALF * LD * 2;
    const size_t tstep = 2 * hstep;
    const unsigned ldsw = (unsigned)wid * 1024u;
    const int aoff = F8 ? lds_byte(wr * 64 + fr, fq * 16) : lds_byte(wr * 64 + fr, fq * 8), boff = F8 ? lds_byte(wc * 32 + fr, fq * 16) : lds_byte(wc * 32 + fr, fq * 8);
    const int aof1 = F8 ? lds_byte(wr * 64 + fr, fq * 16 + 8) : aoff + 1024, bof1 = F8 ? lds_byte(wc * 32 + fr, fq * 16 + 8) : boff + 1024;
#define PG8_SA(b, h) (((b) * 2 + (h)) * HTB)
#define PG8_SB(b, h) ((4 + (b) * 2 + (h)) * HTB)
#define PG8_STAGE2(bufoff, gbase, v0, v1) do { unsigned _a = (v0), _b = (v1); asm volatile("" : "+v"(_a), "+v"(_b));     \
        __builtin_amdgcn_global_load_lds((const unsigned*)((const char*)(gbase) + _a), (LAS unsigned*)(lds + (bufoff) + ldsw), 16, 0, 0); \
        __builtin_amdgcn_global_load_lds((const unsigned*)((const char*)(gbase) + _b), (LAS unsigned*)(lds + (bufoff) + ldsw + 8192), 16, 0, 0); } while (0)
#define PG8_STAGE(bufoff, gbase, voff) PG8_STAGE2(bufoff, gbase, (voff)[0], (voff)[1])
#define PG8_STAGE_A(bufoff, nx, h, kt) do { \
        if constexpr (GATHER) { const char* _p = (const char*)g.A + (size_t)(kt) * kstep; \
            if (nx) { PG8_STAGE2(bufoff, _p, nG[h][0], nG[h][1]); } else { PG8_STAGE2(bufoff, _p, cG[h][0], cG[h][1]); } } \
        else { const char* _p = ((nx) ? nA : cA) + (size_t)(h) * hstep + (size_t)(kt) * kstep; PG8_STAGE2(bufoff, _p, voffA[0], voffA[1]); } } while (0)
#define PG8_LDA(dst, b, h) do { _Pragma("unroll") for (int m = 0; m < 4; ++m) { \
        if constexpr (F8) { dst##8[m].lo = *(const LAS v4i32*)(lds + PG8_SA(b, h) + aoff + m * 2048); dst##8[m].hi = *(const LAS v4i32*)(lds + PG8_SA(b, h) + aof1 + m * 2048); } \
        else { dst[m][0] = *(const LAS bf16x8*)(lds + PG8_SA(b, h) + aoff + m * 2048); dst[m][1] = *(const LAS bf16x8*)(lds + PG8_SA(b, h) + aof1 + m * 2048); } } } while (0)
#define PG8_LDB(dst, b, h) do { _Pragma("unroll") for (int n = 0; n < 2; ++n) { \
        if constexpr (F8) { dst##8[n].lo = *(const LAS v4i32*)(lds + PG8_SB(b, h) + boff + n * 2048); dst##8[n].hi = *(const LAS v4i32*)(lds + PG8_SB(b, h) + bof1 + n * 2048); } \
        else { dst[n][0] = *(const LAS bf16x8*)(lds + PG8_SB(b, h) + boff + n * 2048); dst[n][1] = *(const LAS bf16x8*)(lds + PG8_SB(b, h) + bof1 + n * 2048); } } } while (0)
#define PG8_MMA(ai, bj, At, Bt) do { __builtin_amdgcn_s_setprio(1); _Pragma("unroll") for (int m = 0; m < 4; ++m) _Pragma("unroll") for (int n = 0; n < 2; ++n) { \
        if constexpr (F8) asm volatile("v_mfma_scale_f32_16x16x128_f8f6f4 %0, %1, %2, %0, %3, %3 op_sel_hi:[0,0,0]" : "+v"(acc[ai][bj][m][n]) : "v"(Bt##8[n]), "v"(At##8[m]), "v"(one8));   \
        else { _Pragma("unroll") for (int k = 0; k < 2; ++k) acc[ai][bj][m][n] = __builtin_amdgcn_mfma_f32_16x16x32_bf16(Bt[n][k], At[m][k], acc[ai][bj][m][n], 0, 0, 0); } } __builtin_amdgcn_s_setprio(0); } while (0)
#define PG8_WAIT_V(n) asm volatile("s_waitcnt vmcnt(" #n ")" ::: "memory")
#define PG8_WAIT_L(n) asm volatile("s_waitcnt lgkmcnt(" #n ")" ::: "memory")
#ifndef GRACE
#define GRACE 0
#endif
#define PG8_WAIT_VG(first) do { if (first) { asm volatile("s_waitcnt vmcnt(%0)" :: "n"(8 + Epi::NVM) : "memory"); } else { PG8_WAIT_V(8); } } while (0)
#define PG8_BAR __builtin_amdgcn_s_barrier()
#define PG8_SCHED __builtin_amdgcn_sched_barrier(0)
#define PG8_GIDX(dst, u) do { _Pragma("unroll") for (int h = 0; h < 2; ++h) _Pragma("unroll") for (int i = 0; i < 2; ++i) { \
        const int _lr = (u).lr0 + h * HALF + rA[i]; const int _tok = (_lr < (u).cnt) ? g.gidx[(u).e * 16384 + _lr] : 0; dst[h][i] = (unsigned)_tok * (unsigned)(LD * 2) + voffA[i]; } } while (0)
    Unit cur, nxt; int ui = 0;
    if (!S.next(0, cur)) return;
    if (stag > 0) { const int grp = ((int)blockIdx.x >> 3) & 3;
        if (grp) { const unsigned long long t0 = __builtin_amdgcn_s_memrealtime(); while (__builtin_amdgcn_s_memrealtime() - t0 < (unsigned long long)(grp * stag)) __builtin_amdgcn_s_sleep(2); } }
#ifdef STAGGER_TICKS
    if (S.short_deal()) { const unsigned long long t0 = __builtin_amdgcn_s_memrealtime(); while (__builtin_amdgcn_s_memrealtime() - t0 < (unsigned long long)(STAGGER_TICKS)) __builtin_amdgcn_s_sleep(8); }
#endif
    f32x4 acc[2][2][4][2];
#pragma unroll
    for (int a = 0; a < 2; ++a)
#pragma unroll
        for (int b = 0; b < 2; ++b)
#pragma unroll
            for (int m = 0; m < 4; ++m)
#pragma unroll
                for (int n = 0; n < 2; ++n) acc[a][b][m][n] = (f32x4){0.f, 0.f, 0.f, 0.f};
    const int one8 = 0x7f7f7f7f;
    bf16x8 At[4][2], B0[2][2], B1[2][2]; v8i32 At8[4], B08[2], B18[2];
    unsigned cG[2][2] = {{0u, 0u}, {0u, 0u}}, nG[2][2] = {{0u, 0u}, {0u, 0u}};
    const char* cA = (const char*)g.A + (size_t)cur.pm * tstep + (size_t)cur.koff * 2; const char* cB = (const char*)g.Bt + ((size_t)cur.e * g.b_estride + (size_t)cur.koff) * 2 + (size_t)cur.pn * tstep;
    const char* nA = cA;
    if constexpr (GATHER) { PG8_GIDX(cG, cur); }
    PG8_STAGE(PG8_SB(0, 0), cB, voffB); PG8_STAGE(PG8_SB(0, 1), cB + hstep, voffB); PG8_STAGE_A(PG8_SA(0, 0), false, 0, 0); PG8_STAGE_A(PG8_SA(0, 1), false, 1, 0);
    if (wr == 1) PG8_BAR;
    PG8_WAIT_V(2); PG8_BAR;
    PG8_STAGE(PG8_SB(1, 0), cB + kstep, voffB); PG8_STAGE_A(PG8_SA(1, 0), false, 0, 1); PG8_STAGE(PG8_SB(1, 1), cB + hstep + kstep, voffB);
    PG8_WAIT_V(6); PG8_BAR;
    for (;;) {
        const bool has_next = S.next(ui + 1, nxt);
        nA = has_next ? (const char*)g.A + (size_t)nxt.pm * tstep + (size_t)nxt.koff * 2 : cA;
        const char* nB = has_next ? (const char*)g.Bt + ((size_t)nxt.e * g.b_estride + (size_t)nxt.koff) * 2 + (size_t)nxt.pn * tstep : cB;
        if constexpr (GATHER) { if (has_next) { PG8_GIDX(nG, nxt); } else {
#pragma unroll
            for (int h = 0; h < 2; ++h)
#pragma unroll
                for (int i = 0; i < 2; ++i) nG[h][i] = cG[h][i]; } }
#pragma nounroll
        for (int t = 0; t < nt; t += 2) {
            const bool last = (t == nt - 2);
            const bool first = GRACE && (t == 0) && (ui > 0);
            const int kt2 = last ? 0 : t + 2, kt3 = kt2 + 1;
            const char* b2 = last ? nB : cB + (size_t)(t + 2) * kstep;
            const char* b3 = b2 + kstep;
            PG8_LDB(B0, 0, 0); PG8_LDB(B1, 0, 1); PG8_SCHED; PG8_LDA(At, 0, 0); if (!first) { PG8_STAGE_A(PG8_SA(1, 1), false, 1, t + 1); }
            PG8_WAIT_VG(first); PG8_WAIT_L(0); PG8_BAR; PG8_MMA(0, 0, At, B0); PG8_MMA(0, 1, At, B1); PG8_BAR; PG8_SCHED;
            PG8_LDA(At, 0, 1); PG8_STAGE(PG8_SB(0, 0), b2, voffB); PG8_STAGE(PG8_SB(0, 1), b2 + hstep, voffB); PG8_STAGE_A(PG8_SA(0, 0), last, 0, kt2);
            PG8_WAIT_VG(first); PG8_WAIT_L(0); PG8_BAR; PG8_MMA(1, 0, At, B0); PG8_MMA(1, 1, At, B1); PG8_BAR; PG8_SCHED;
            PG8_LDB(B0, 1, 0); PG8_LDB(B1, 1, 1); PG8_SCHED; PG8_LDA(At, 1, 0); PG8_STAGE_A(PG8_SA(0, 1), last, 1, kt2);
            PG8_WAIT_VG(first); PG8_WAIT_L(0); PG8_BAR; PG8_MMA(0, 0, At, B0); PG8_MMA(0, 1, At, B1); PG8_BAR; PG8_SCHED;
            PG8_LDA(At, 1, 1); PG8_STAGE(PG8_SB(1, 0), b3, voffB); PG8_STAGE(PG8_SB(1, 1), b3 + hstep, voffB); PG8_STAGE_A(PG8_SA(1, 0), last, 0, kt3);
            PG8_WAIT_V(8); PG8_WAIT_L(0); PG8_BAR; PG8_MMA(1, 0, At, B0); PG8_MMA(1, 1, At, B1); PG8_BAR; PG8_SCHED;
        }
        if (GRACE && has_next) { PG8_STAGE_A(PG8_SA(1, 1), true, 1, 1); }
        if constexpr (F8) asm volatile("s_nop 15\n\ts_nop 15" ::: "memory");
        if (wr == 0) PG8_BAR;
        { Unit eu = cur; eu.pm = __builtin_amdgcn_readfirstlane(eu.pm); eu.pn = __builtin_amdgcn_readfirstlane(eu.pn); asm volatile("" : "+s"(eu.pm), "+s"(eu.pn));
          E(acc, eu, wr, wc, fr, fq);
#ifdef EPI2
          if constexpr (Epi::P2) { if (EPI2 == 1) E(acc, eu, wr, wc, fr, fq); else E.template run<EPI2 == 2 ? 0 : EPI2 - 1>(acc, eu, wr, wc, fr, fq); }
#endif
        }
        if (!has_next) break;
#pragma unroll
        for (int a = 0; a < 2; ++a)
#pragma unroll
            for (int b = 0; b < 2; ++b)
#pragma unroll
                for (int m = 0; m < 4; ++m)
#pragma unroll
                    for (int n = 0; n < 2; ++n) acc[a][b][m][n] = (f32x4){0.f, 0.f, 0.f, 0.f};
        cur = nxt; cA = nA; cB = nB; ++ui;
        if constexpr (GATHER) {
#pragma unroll
            for (int h = 0; h < 2; ++h)
#pragma unroll
                for (int i = 0; i < 2; ++i) cG[h][i] = nG[h][i]; }
        if (wr == 1) PG8_BAR;
    }
    PG8_WAIT_V(0);
    PG8_BAR;
#undef PG8_SA
#undef PG8_SB
#undef PG8_STAGE
#undef PG8_STAGE2
#undef PG8_STAGE_A
#undef PG8_LDA
#undef PG8_LDB
#undef PG8_MMA
#undef PG8_WAIT_V
#undef PG8_WAIT_VG
#undef PG8_WAIT_L
#undef PG8_BAR
#undef PG8_SCHED
#undef PG8_GIDX
}
}
namespace pg8 {
constexpr size_t WS_DUMMY = (size_t)467 << 20;
constexpr float QA_SCALE = 0.125f * 1.4426950408889634f;
constexpr float QB_SCALE = 0.125f;

struct EpiInProj {
    static constexpr bool PERM = true, IDEM = true; static constexpr bool P2 = true; static constexpr int NVM = 16;
    bf16_t* base; WT wt;
    template <int ACT>
    __device__ __forceinline__ void body(const f32x4 (&acc)[2][2][4][2], bf16_t* O, int row0, int col0, int ld, float sc) const {
#pragma unroll
        for (int ai = 0; ai < 2; ++ai)
#pragma unroll
            for (int m = 0; m < 4; ++m) { bf16_t* rowp = O + (size_t)(row0 + ai * HALF + m * 16) * ld + col0;
#pragma unroll
                for (int bj = 0; bj < 2; ++bj) { f32x4 v0 = acc[ai][bj][m][0], v1 = acc[ai][bj][m][1];
                    if (ACT == 3) { v0 = v0 * sc; v1 = v1 * sc; }
                    if (ACT == 2) { v0 = sigmoid4(v0); v1 = sigmoid4(v1); }
                    if (ACT == 1) { v0 = v0 * sigmoid4(v0); v1 = v1 * sigmoid4(v1); }
                    u32x4 w; w.x = cvt_pk_bf16(v0[0], v0[1]); w.y = cvt_pk_bf16(v0[2], v0[3]); w.z = cvt_pk_bf16(v1[0], v1[1]); w.w = cvt_pk_bf16(v1[2], v1[3]);
                    st16(wt, rowp + bj * HALF, w); } }
    }
    __device__ __forceinline__ void operator()(const f32x4 (&acc)[2][2][4][2], const Unit& u, int wr, int wc, int fr, int fq) const { run<1>(acc, u, wr, wc, fr, fq); }
    template <int ST> __device__ __forceinline__ void run(const f32x4 (&acc)[2][2][4][2], const Unit& u, int wr, int wc, int fr, int fq) const {
        const int pn = u.pn;
        size_t toff; int ld, ct; float sc = 1.f; int act = 0;
        constexpr size_t Mi = 1u << 20;
        if (pn < 2)       { toff = 16 * Mi; ld = 512; ct = pn; sc = QA_SCALE; }
        else if (pn < 4)  { toff = 24 * Mi; ld = 512; ct = pn - 2; }
        else if (pn < 6)  { toff = 32 * Mi; ld = 512; ct = pn - 4; }
        else if (pn < 7)  { toff = 0; ld = 256; ct = 0; sc = QB_SCALE; }
        else if (pn < 8)  { toff = 4 * Mi; ld = 256; ct = 0; }
        else if (pn < 10) { toff = 8 * Mi; ld = 512; ct = pn - 8; }
        else if (pn < 12) { toff = 40 * Mi; ld = 512; ct = pn - 10; act = 1; }
        else if (pn < 16) { toff = 48 * Mi; ld = 1024; ct = pn - 12; act = 2; }
        else              { toff = 64 * Mi; ld = 1024; ct = pn - 16; act = 2; }
        const int row0 = u.pm * BM + wr * 64 + fr, col0 = ct * BM + wc * 32 + 8 * fq;
        bf16_t* O = base + toff;
#ifdef EPI_PK
        if (ST == 1) {
            if (act == 2) body<2>(acc, O, row0, col0, ld, 1.f); else if (act == 1) body<1>(acc, O, row0, col0, ld, 1.f); else if (sc != 1.f) body<3>(acc, O, row0, col0, ld, sc); else body<0>(acc, O, row0, col0, ld, 1.f);
            return; }
#endif
#pragma unroll
        for (int ai = 0; ai < 2; ++ai)
#pragma unroll
            for (int m = 0; m < 4; ++m) { bf16_t* rowp = O + (size_t)(row0 + ai * HALF + m * 16) * ld + col0;
#pragma unroll
                for (int bj = 0; bj < 2; ++bj) { f32x4 v0 = acc[ai][bj][m][0] * sc, v1 = acc[ai][bj][m][1] * sc;
                    if (act) {
#pragma unroll
                        for (int j = 0; j < 4; ++j) { const float s0 = fast_sigmoid(v0[j]), s1 = fast_sigmoid(v1[j]); v0[j] = (act == 1) ? v0[j] * s0 : s0; v1[j] = (act == 1) ? v1[j] * s1 : s1; } }
                    u32x4 w; w.x = cvt_pk_bf16(v0[0], v0[1]); w.y = cvt_pk_bf16(v0[2], v0[3]); w.z = cvt_pk_bf16(v1[0], v1[1]); w.w = cvt_pk_bf16(v1[2], v1[3]);
                    if (ST == 1) st16(wt, rowp + bj * HALF, w);
                    else if (ST == 0) asm volatile("" :: "v"(w.x), "v"(w.y), "v"(w.z), "v"(w.w), "v"(rowp));
                    else { unsigned char* db = (unsigned char*)wt.base + WS_DUMMY + (size_t)blockIdx.x * 131072 + (wr * 4 + wc) * 16384; const int k = (ai * 4 + m) * 2 + bj;
                        st16(wt, db + (ST == 2 ? fr * 1024 + k * 64 + fq * 16 : k * 1024 + (fq * 16 + fr) * 16), w); } } }
    }
};

template <int MODE> struct EpiEw {
    static constexpr bool PERM = true, IDEM = (MODE != 2 && MODE != 4); static constexpr bool P2 = false; static constexpr int NVM = 16;
    bf16_t* O; const bf16_t* G; int ldc; WT wt; float sc = 1.f;
    __device__ __forceinline__ void operator()(const f32x4 (&acc)[2][2][4][2], const Unit& u, int wr, int wc, int fr, int fq) const {
        const int row0 = u.pm * BM + wr * 64 + fr, col0 = u.pn * BM + wc * 32 + 8 * fq;
#pragma unroll
        for (int ai = 0; ai < 2; ++ai)
#pragma unroll
            for (int m = 0; m < 4; ++m) { const size_t ro = (size_t)(row0 + ai * HALF + m * 16) * ldc + col0;
#pragma unroll
                for (int bj = 0; bj < 2; ++bj) { f32x4 v0 = acc[ai][bj][m][0], v1 = acc[ai][bj][m][1];
                    if (MODE == 0) { v0 = v0 * sc; v1 = v1 * sc; }
                    if (MODE == 1 || MODE == 2) { const u32x4 gw = *(const u32x4*)(G + ro + bj * HALF);
                        v0[0] *= bf_lo(gw.x); v0[1] *= bf_hi(gw.x); v0[2] *= bf_lo(gw.y); v0[3] *= bf_hi(gw.y); v1[0] *= bf_lo(gw.z); v1[1] *= bf_hi(gw.z); v1[2] *= bf_lo(gw.w); v1[3] *= bf_hi(gw.w); }
                    if (MODE == 3) {
#ifdef EPI_PK
                        v0 = sigmoid4(v0); v1 = sigmoid4(v1);
#else
#pragma unroll
                        for (int j = 0; j < 4; ++j) { v0[j] = fast_sigmoid(v0[j]); v1[j] = fast_sigmoid(v1[j]); }
#endif
                    }
                    if (MODE == 2 || MODE == 4) { const u32x4 ow = *(const u32x4*)(O + ro + bj * HALF);
                        if (MODE == 2) { v0[0] += bf_lo(ow.x); v0[1] += bf_hi(ow.x); v0[2] += bf_lo(ow.y); v0[3] += bf_hi(ow.y); v1[0] += bf_lo(ow.z); v1[1] += bf_hi(ow.z); v1[2] += bf_lo(ow.w); v1[3] += bf_hi(ow.w); }
                        else { v0[0] *= bf_lo(ow.x); v0[1] *= bf_hi(ow.x); v0[2] *= bf_lo(ow.y); v0[3] *= bf_hi(ow.y); v1[0] *= bf_lo(ow.z); v1[1] *= bf_hi(ow.z); v1[2] *= bf_lo(ow.w); v1[3] *= bf_hi(ow.w); } }
                    u32x4 w; w.x = cvt_pk_bf16(v0[0], v0[1]); w.y = cvt_pk_bf16(v0[2], v0[3]); w.z = cvt_pk_bf16(v1[0], v1[1]); w.w = cvt_pk_bf16(v1[2], v1[3]);
                    st16(wt, O + ro + bj * HALF, w); } }
    }
};

struct EpiPart {
    static constexpr bool PERM = true, IDEM = true, P2 = false; static constexpr int NVM = 16;
    bf16_t* P; int ldc, p0, KCH; size_t plane; WT wt; float sc = 1.f;
    __device__ __forceinline__ void operator()(const f32x4 (&acc)[2][2][4][2], const Unit& u, int wr, int wc, int fr, int fq) const {
        const int row0 = (u.pm - p0) * BM + wr * 64 + fr, col0 = u.pn * BM + wc * 32 + 8 * fq;
        bf16_t* O = P + (size_t)(u.koff / KCH) * plane;
#pragma unroll
        for (int ai = 0; ai < 2; ++ai)
#pragma unroll
            for (int m = 0; m < 4; ++m) { const size_t ro = (size_t)(row0 + ai * HALF + m * 16) * ldc + col0;
#pragma unroll
                for (int bj = 0; bj < 2; ++bj) { const f32x4 v0 = acc[ai][bj][m][0] * sc, v1 = acc[ai][bj][m][1] * sc;
                    u32x4 w; w.x = cvt_pk_bf16(v0[0], v0[1]); w.y = cvt_pk_bf16(v0[2], v0[3]); w.z = cvt_pk_bf16(v1[0], v1[1]); w.w = cvt_pk_bf16(v1[2], v1[3]);
                    st16(wt, O + ro + bj * HALF, w); } }
    }
};

struct EpiGateUp {
    static constexpr bool PERM = true, IDEM = true, P2 = false; static constexpr int NVM = 8;
    bf16_t* O; int ldc; WT wt; float qs;
    __device__ __forceinline__ void operator()(const f32x4 (&acc)[2][2][4][2], const Unit& u, int wr, int wc, int fr, int fq) const {
        const int row0 = u.pm * BM + wr * 64 + fr, col0 = u.pn * HALF + wc * 32 + 8 * fq;
#pragma unroll
        for (int ai = 0; ai < 2; ++ai)
#pragma unroll
            for (int m = 0; m < 4; ++m) { bf16_t* rowp = O + (size_t)(row0 + ai * HALF + m * 16) * ldc + col0;
                f32x4 v0, v1;
#if defined(EPI_PK) && !defined(SIM_FP8) && !defined(SIM_FFN0)
                v0 = acc[ai][0][m][0] * acc[ai][1][m][0] * sigmoid4(acc[ai][0][m][0]); v1 = acc[ai][0][m][1] * acc[ai][1][m][1] * sigmoid4(acc[ai][0][m][1]);
#endif
#pragma unroll
                for (int j = 0; j < 4; ++j) {
#if defined(EPI_PK) && !defined(SIM_FP8) && !defined(SIM_FFN0)
                    break;
#endif
                    const float g0 = acc[ai][0][m][0][j], g1 = acc[ai][0][m][1][j];
                    v0[j] = g0 * fast_sigmoid(g0) * acc[ai][1][m][0][j]; v1[j] = g1 * fast_sigmoid(g1) * acc[ai][1][m][1][j];
#if defined(SIM_FP8) || defined(SIM_FFN0)
                    if (qs != 0.f) { v0[j] = q8(v0[j], qs); v1[j] = q8(v1[j], qs); }
#endif
                }
                u32x4 w; w.x = cvt_pk_bf16(v0[0], v0[1]); w.y = cvt_pk_bf16(v0[2], v0[3]); w.z = cvt_pk_bf16(v1[0], v1[1]); w.w = cvt_pk_bf16(v1[2], v1[3]);
                st16(wt, rowp, w); }
    }
};
struct EpiGateUp8 {
    static constexpr bool PERM = true, IDEM = true, P2 = false; static constexpr int NVM = 8;
    unsigned char* O; int ldc; WT wt; float sin, sout;
    __device__ __forceinline__ void operator()(const f32x4 (&acc)[2][2][4][2], const Unit& u, int wr, int wc, int fr, int fq) const {
        const int row0 = u.pm * BM + wr * 64 + fr, col0 = u.pn * HALF + wc * 32 + 8 * fq;
#pragma unroll
        for (int ai = 0; ai < 2; ++ai)
#pragma unroll
            for (int m = 0; m < 4; ++m) { unsigned char* rowp = O + (size_t)(row0 + ai * HALF + m * 16) * ldc + col0;
                f32x4 v0, v1;
#ifdef EPI_PK
                { const float ca = -1.4426950408889634f * sin, cs = sin * sin * sout;
                  const f32x4 g0 = acc[ai][0][m][0], g1 = acc[ai][0][m][1];
                  v0 = (g0 * acc[ai][1][m][0]) * cs * cat2(rcp_1p_exp2(lo2(g0) * (f32x2){ca, ca}), rcp_1p_exp2(hi2(g0) * (f32x2){ca, ca}));
                  v1 = (g1 * acc[ai][1][m][1]) * cs * cat2(rcp_1p_exp2(lo2(g1) * (f32x2){ca, ca}), rcp_1p_exp2(hi2(g1) * (f32x2){ca, ca})); }
#else
#pragma unroll
                for (int j = 0; j < 4; ++j) { const float g0 = acc[ai][0][m][0][j] * sin, g1 = acc[ai][0][m][1][j] * sin;
                    v0[j] = g0 * fast_sigmoid(g0) * (acc[ai][1][m][0][j] * (sin * sout)); v1[j] = g1 * fast_sigmoid(g1) * (acc[ai][1][m][1][j] * (sin * sout)); }
#endif
                u32x2 w; w.x = pk4_fp8(v0[0], v0[1], v0[2], v0[3]); w.y = pk4_fp8(v1[0], v1[1], v1[2], v1[3]);
                *(u32x2*)rowp = w; }
    }
};
}
#ifndef MK_DBG
#define MK_DBG 0
#endif
#ifndef MOE_FP8
#define MOE_FP8 1
#endif
constexpr int D = 1024, NB = 8, SEQ = 2048, T = NB * SEQ, DEPTH = 2, CH = 64, NCH = SEQ / CH, NPREV = 8;
constexpr int AH = 8, BH = 4, GR = 16, DFF = 2816, NE = 8, DFE = 3584, PLE = 256, INW = 5136, INWG = 5120, RELN = 257;
constexpr float EPS = 1e-6f, LOG2E = 1.4426950408889634f;
constexpr int NWAVES = 8, NTHR = 512;
constexpr int MOE_ROWS = 34816;

constexpr size_t MiB = 1u << 20;
constexpr size_t WS_CTL = 0, CTL_ZERO_BYTES = 256 * 1024;
constexpr size_t WS_TOKINFO = 1 * MiB;
constexpr size_t WS_IDXE = 2 * MiB;
constexpr size_t WS_DEC = 3 * MiB;
constexpr size_t WS_W1 = 4 * MiB;
constexpr size_t WS_PB = 189 * MiB;
constexpr size_t WS_G = 205 * MiB;
constexpr size_t WS_HB = WS_G, WS_DST = WS_G + 32 * MiB, WS_YSLOT = WS_G;
constexpr size_t WS_BIG = 273 * MiB;
constexpr size_t WS_W0 = WS_BIG, WS_PROJ = WS_BIG + 34 * MiB, WS_MACT = WS_BIG;
constexpr size_t WS_Y = WS_PROJ;
constexpr size_t WS_QB = WS_PROJ, WS_KB = WS_PROJ + 8 * MiB, WS_VB = WS_PROJ + 16 * MiB, WS_QA = WS_PROJ + 32 * MiB, WS_KA = WS_PROJ + 48 * MiB, WS_VA = WS_PROJ + 64 * MiB;
constexpr size_t WS_SR = WS_PROJ + 80 * MiB, WS_SGA = WS_PROJ + 96 * MiB, WS_SGB = WS_PROJ + 128 * MiB;
constexpr size_t WS_MERGED = WS_KA;
constexpr size_t WS_ST = WS_KA;
constexpr size_t WS_FACT = WS_QA;
constexpr size_t WS_YA = WS_PROJ + 160 * MiB, WS_YB = WS_PROJ + 176 * MiB;
constexpr size_t WS_XB = WS_SGB;
constexpr int MOE_MAIN_PANELS = 128, MOE_MAIN_ROWS = MOE_MAIN_PANELS * 256, TAIL_KC = MOE_FP8 ? 7 : 14, TAIL_KCH = 256  , TAIL_ROWS = MOE_ROWS - MOE_MAIN_ROWS;
constexpr size_t WS_END = 511 * MiB;
static_assert(WS_FACT + (size_t)T * DFF * 2 <= WS_XB && WS_MACT + (size_t)MOE_ROWS * DFE * 2 <= WS_END && WS_YSLOT + (size_t)MOE_ROWS * D * 2 <= WS_BIG && WS_SGB + 32 * MiB <= WS_YA && WS_YB + 16 * MiB <= WS_END, "d_ws map");
constexpr size_t OFF_WIN = 0, OFF_WGD = 10 * MiB, OFF_WBA = 10 * MiB + 65536, OFF_WBB = OFF_WBA + 1 * MiB, OFF_WOUT = OFF_WBB + 1 * MiB, OFF_WPP = OFF_WOUT + 2 * MiB, OFF_WPG = OFF_WPP + MiB / 2;
constexpr size_t OFF_FFN = 17 * MiB;
constexpr size_t OFF_FDN = OFF_FFN + 11 * MiB, OFF_MDN = OFF_FFN + 8 * 14 * MiB;
constexpr size_t OFF_MDN8 = OFF_FFN + 8 * 7 * MiB;
constexpr float W8_SCALE = 64.f, ACT8_SCALE = 8.f;
constexpr size_t WS_XS = WS_W1 + OFF_MDN8 + 8 * 7 * MiB / 2;
static_assert(MOE_FP8 && WS_XS + (size_t)T * D * 2 <= WS_PB, "x stream placement needs the e4m3 weight layout");
constexpr size_t WS_PBUF = WS_W1 + OFF_FFN;
static_assert((size_t)TAIL_KC * TAIL_ROWS * D * 2 <= (MOE_FP8 ? 8 * 7 : 8 * 14) * MiB, "partial planes");
static_assert(OFF_WPG + 2 * MiB <= OFF_FFN && WS_W1 + OFF_MDN + 8 * 7 * MiB <= WS_PB && OFF_FDN + (size_t)D * DFF * 2 <= 34 * MiB, "weight map");
constexpr int CW_BAR = 4096;
constexpr int CW_CNT = 8192;
constexpr int CW_DBG = 16384;

constexpr int RING_BYTES = 131072;
constexpr int LDSCTL_OFF = RING_BYTES, MISC_OFF = LDSCTL_OFF + 320;
constexpr int XTRA_OFF = RING_BYTES + 1024;
constexpr int LDS_BYTES = 147456;

typedef GAS unsigned gu32;
#define RLX_AGENT __ATOMIC_RELAXED, __HIP_MEMORY_SCOPE_AGENT
#define LDS_WAIT() asm volatile("s_waitcnt lgkmcnt(0)" ::: "memory")
#define VM_WAIT() asm volatile("s_waitcnt vmcnt(0)" ::: "memory")

#define XB_TMO      128
#define XB_XCNT(j)  (256  + 64 * (j))
#define XB_XSUB(j)  (1280 + 64 * (j))
#define XB_XGEN(j)  (2304 + 64 * (j))
#define XB_TOP      3328
#define XB_TOPGEN   3392
#define XCD_BAR_WORDS 3456
#define XB_SPIN_CAP (1u << 18)
__device__ __forceinline__ unsigned xb_ld(unsigned* p)              { return __hip_atomic_load(p, __ATOMIC_RELAXED, __HIP_MEMORY_SCOPE_AGENT); }
__device__ __forceinline__ unsigned xb_add(unsigned* p, unsigned v) { return __hip_atomic_fetch_add(p, v, __ATOMIC_RELAXED, __HIP_MEMORY_SCOPE_AGENT); }
__device__ __forceinline__ unsigned xb_xcc_id() { return (unsigned)__builtin_amdgcn_s_getreg((3 << 11) | 20) & 0xFu; }
#define XB_SPIN(cond, bar) do { unsigned _sp = 0; while (cond) { __builtin_amdgcn_s_sleep(1); \
    if ((++_sp & 255u) == 0u) { if (xb_ld(&(bar)[XB_TMO])) break; if (_sp > XB_SPIN_CAP) { atomicAdd(&(bar)[XB_TMO], 1u); break; } } } } while (0)
struct XcdBarrier { unsigned* bar; unsigned x; volatile LAS unsigned* st; };
__device__ __forceinline__ XcdBarrier xcd_barrier_post(unsigned* bar, volatile LAS unsigned* st) {
    XcdBarrier b; b.bar = bar; b.x = xb_xcc_id(); b.st = st;
    if (threadIdx.x == 0) (void)xb_add(&bar[XB_XCNT(b.x)], 1u);
    return b;
}
__device__ __forceinline__ void xcd_barrier_complete(unsigned* bar, unsigned x, unsigned& nloc, unsigned& nx) {
    const unsigned G = gridDim.x * gridDim.y * gridDim.z;
    unsigned sum, cnt, mine, sp = 0u;
    for (;;) {
        sum = 0u; cnt = 0u; mine = 0u;
#pragma unroll
        for (unsigned j = 0; j < 16; ++j) { const unsigned c = xb_ld(&bar[XB_XCNT(j)]); sum += c; cnt += (c > 0u) ? 1u : 0u; mine = (j == x) ? c : mine; }
        if (sum == G) break;
        __builtin_amdgcn_s_sleep(1);
        if ((++sp & 255u) == 0u) { if (xb_ld(&bar[XB_TMO])) break; if (sp > XB_SPIN_CAP) { atomicAdd(&bar[XB_TMO], 1u); break; } }
    }
    nloc = mine > 0u ? mine : 1u; nx = cnt > 0u ? cnt : 1u;
}
__device__ __forceinline__ void xcd_barrier(const XcdBarrier& b) {
    asm volatile("s_waitcnt vmcnt(0)" ::: "memory");
    __syncthreads();
    if (threadIdx.x == 0) {
        unsigned* bar = b.bar;
        __builtin_amdgcn_s_waitcnt(0);
        unsigned nloc = b.st[0], nx = b.st[1];
        if (nloc == 0u) { xcd_barrier_complete(bar, b.x, nloc, nx); b.st[0] = nloc; b.st[1] = nx; }
        const unsigned old = xb_add(&bar[XB_XSUB(b.x)], 1u);
        const unsigned gen = old / nloc;
        if (old + 1u == (gen + 1u) * nloc) {
            __builtin_amdgcn_fence(__ATOMIC_RELEASE, "agent");
            asm volatile("s_waitcnt vmcnt(0)" ::: "memory");
            const unsigned og = xb_add(&bar[XB_TOP], 1u);
            const unsigned tg = og / nx;
            if (og + 1u == (tg + 1u) * nx) xb_add(&bar[XB_TOPGEN], 1u);
            else XB_SPIN(xb_ld(&bar[XB_TOPGEN]) == tg, bar);
            __builtin_amdgcn_fence(__ATOMIC_ACQUIRE, "agent");
            xb_add(&bar[XB_XGEN(b.x)], 1u);
            asm volatile("s_waitcnt vmcnt(0)" ::: "memory");
        } else {
            XB_SPIN(xb_ld(&bar[XB_XGEN(b.x)]) == gen, bar);
            __builtin_amdgcn_fence(__ATOMIC_ACQUIRE, "agent");
            asm volatile("s_waitcnt vmcnt(0)" ::: "memory");
        }
    }
    __syncthreads();
}

struct Args { const float* in[24]; float* out; unsigned char* ws; int ph_lo, ph_hi, sub, pad; };
enum { I_X = 0, I_P, I_WIN, I_RELB, I_WGUP, I_BG, I_GNORM, I_WBA, I_WBB, I_WOUT, I_NMPRE, I_NMPOST, I_NFPRE, I_NFPOST, I_FG, I_FU, I_FD, I_RW, I_MG, I_MU, I_MD, I_PP, I_PG, I_PNORM };
#define FRESH(F) do { int _t = threadIdx.x; asm volatile("" : "+v"(_t)); (F).tid = _t; (F).lane = _t & 63; (F).wave = __builtin_amdgcn_readfirstlane(_t >> 6); } while (0)
struct Frame {
    LAS unsigned char* lds;
    volatile LAS unsigned* MISC;
    gu32* ctl;
    unsigned char* ws;
    int tid, lane, wave;
    int vcu, G;
    float* x;
    bf16_t* xs;
};

__device__ __forceinline__ float sumsq16(const f32x4 (&v)[4]) {
    float s = 0.f;
#pragma unroll
    for (int j = 0; j < 4; ++j) s += (v[j].x * v[j].x + v[j].y * v[j].y) + (v[j].z * v[j].z + v[j].w * v[j].w);
    return wave_sum(s);
}
__device__ __forceinline__ void ld_bf16_row(const bf16_t* row, int lane, f32x4 (&v)[4]) {
#pragma unroll
    for (int j = 0; j < 4; ++j) { const u32x2 w = ((const u32x2*)row)[lane + 64 * j]; v[j] = (f32x4){bf_lo(w.x), bf_hi(w.x), bf_lo(w.y), bf_hi(w.y)}; }
}
__device__ __forceinline__ void st_bf16_row(bf16_t* row, int lane, const f32x4 (&v)[4]) {
#pragma unroll
    for (int j = 0; j < 4; ++j) { u32x2 w; w.x = cvt_pk_bf16(v[j].x, v[j].y); w.y = cvt_pk_bf16(v[j].z, v[j].w); ((u32x2*)row)[lane + 64 * j] = w; }
}
__device__ __forceinline__ void ld_moe_row(const unsigned char* ws, int s, int lane, f32x4 (&v)[4]) {
    if (s < MOE_MAIN_ROWS) { ld_bf16_row((const bf16_t*)(ws + WS_YSLOT) + (size_t)s * D, lane, v); return; }
    const bf16_t* p = (const bf16_t*)(ws + WS_PBUF) + (size_t)(s - MOE_MAIN_ROWS) * D;
#pragma unroll
    for (int j = 0; j < 4; ++j) v[j] = (f32x4){0.f, 0.f, 0.f, 0.f};
#pragma unroll 1
    for (int k0 = 0; k0 < TAIL_KC; k0 += 7) {
        u32x2 w[7][4];
#pragma unroll
        for (int q = 0; q < 7; ++q)
#pragma unroll
            for (int j = 0; j < 4; ++j) w[q][j] = ((const u32x2*)(p + (size_t)(k0 + q) * TAIL_ROWS * D))[lane + 64 * j];
#pragma unroll
        for (int q = 0; q < 7; ++q)
#pragma unroll
            for (int j = 0; j < 4; ++j) v[j] = v[j] + (f32x4){bf_lo(w[q][j].x), bf_hi(w[q][j].x), bf_lo(w[q][j].y), bf_hi(w[q][j].y)};
    }
}
template <int SRC, int OUT, bool ROUTE>
__device__ __forceinline__ void thin_phase(Frame& F, const float* xin, const bf16_t* ysrc, const float* g_add, const float* g_out, bf16_t* obuf, const float* router_w) {
    FRESH(F);
    const int lane = F.lane;
    unsigned* tokinfo = (unsigned*)(F.ws + WS_TOKINFO);
    int* idxe = (int*)(F.ws + WS_IDXE);
    unsigned* gcnt = (unsigned*)(F.ctl + CW_CNT);
    LAS float* rwT = (LAS float*)(F.lds);
    LAS unsigned* lcnt = (LAS unsigned*)(F.lds + 32768);
    LAS unsigned* rinfo = (LAS unsigned*)(F.lds + 32768 + 64);
    if constexpr (ROUTE) {
        for (int i = F.tid; i < D * NE; i += NTHR) rwT[(i & 7) * D + (i >> 3)] = router_w[i];
        if (F.tid < 16) lcnt[F.tid] = 0u;
        __syncthreads();
    }
    int pbase[8];
    if constexpr (SRC == 2) { int acc = 0;
#pragma unroll
        for (int e = 0; e < 8; ++e) { pbase[e] = acc; acc += (((int)gcnt[e] + 255) >> 8) << 8; } }
    f32x4 ga[4], go[4];
#pragma unroll
    for (int j = 0; j < 4; ++j) { ga[j] = (SRC != 0) ? ((const f32x4*)g_add)[lane + 64 * j] : (f32x4){0.f, 0.f, 0.f, 0.f}; go[j] = (OUT == 1) ? ((const f32x4*)g_out)[lane + 64 * j] : (f32x4){0.f, 0.f, 0.f, 0.f}; }
    const int gw = F.vcu * NWAVES + F.wave, NGW = F.G * NWAVES;
    int rs = 0;
#ifdef THIN_PF
    f32x4 nxf[4]; u32x2 nxb[4], nyb[4];
#define THIN_LOAD(mm) do { const int m_ = (mm); \
        if (SRC == 0 || xin != nullptr) { _Pragma("unroll") for (int j = 0; j < 4; ++j) nxf[j] = ((const f32x4*)(xin + (size_t)m_ * D))[lane + 64 * j]; } \
        else { _Pragma("unroll") for (int j = 0; j < 4; ++j) nxb[j] = ((const u32x2*)(F.xs + (size_t)m_ * D))[lane + 64 * j]; } \
        if (SRC == 1) { _Pragma("unroll") for (int j = 0; j < 4; ++j) nyb[j] = ((const u32x2*)(ysrc + (size_t)m_ * D))[lane + 64 * j]; } } while (0)
    if (gw < T) THIN_LOAD(gw);
#endif
    for (int m = gw; m < T; m += NGW, ++rs) {
        f32x4 xv[4];
#ifdef THIN_PF
        f32x4 cxf[4]; u32x2 cxb[4], cyb[4];
#pragma unroll
        for (int j = 0; j < 4; ++j) { cxf[j] = nxf[j]; cxb[j] = nxb[j]; cyb[j] = nyb[j]; }
        if (m + NGW < T) THIN_LOAD(m + NGW);
#endif
        if constexpr (SRC == 0) {
#pragma unroll
#ifdef THIN_PF
            for (int j = 0; j < 4; ++j) xv[j] = cxf[j];
#else
            for (int j = 0; j < 4; ++j) xv[j] = ((const f32x4*)(xin + (size_t)m * D))[lane + 64 * j];
#endif
        } else {
            f32x4 yv[4];
#ifdef THIN_PF
            if constexpr (SRC == 1) {
#pragma unroll
                for (int j = 0; j < 4; ++j) yv[j] = (f32x4){bf_lo(cyb[j].x), bf_hi(cyb[j].x), bf_lo(cyb[j].y), bf_hi(cyb[j].y)}; }
#else
            if constexpr (SRC == 1) ld_bf16_row(ysrc + (size_t)m * D, lane, yv);
#endif
            else {
                const unsigned* ti = tokinfo + (size_t)m * 8;
                const int e1 = (int)ti[0], p1 = (int)ti[1], e2 = (int)ti[2], p2 = (int)ti[3]; const float w1 = __uint_as_float(ti[4]), w2 = __uint_as_float(ti[5]);
                int b1 = 0, b2 = 0;
#pragma unroll
                for (int e = 0; e < 8; ++e) { b1 = (e == e1) ? pbase[e] : b1; b2 = (e == e2) ? pbase[e] : b2; }
                f32x4 ya[4], yb[4];
                ld_moe_row(F.ws, b1 + p1, lane, ya); ld_moe_row(F.ws, b2 + p2, lane, yb);
#pragma unroll
                for (int j = 0; j < 4; ++j) yv[j] = ya[j] * w1 + yb[j] * w2;
            }
            const float rstd = __builtin_amdgcn_rsqf(sumsq16(yv) * (1.f / D) + EPS);
#ifdef THIN_PF
            if (xin) {
#pragma unroll
                for (int j = 0; j < 4; ++j) xv[j] = cxf[j] + yv[j] * rstd * ga[j];
            } else {
#pragma unroll
                for (int j = 0; j < 4; ++j) xv[j] = (f32x4){bf_lo(cxb[j].x), bf_hi(cxb[j].x), bf_lo(cxb[j].y), bf_hi(cxb[j].y)} + yv[j] * rstd * ga[j]; }
#else
            if (xin) {
#pragma unroll
                for (int j = 0; j < 4; ++j) { const f32x4 xo = ((const f32x4*)(xin + (size_t)m * D))[lane + 64 * j]; xv[j] = xo + yv[j] * rstd * ga[j]; }
            } else { f32x4 xo[4]; ld_bf16_row(F.xs + (size_t)m * D, lane, xo);
#pragma unroll
                for (int j = 0; j < 4; ++j) xv[j] = xo[j] + yv[j] * rstd * ga[j]; }
#endif
        }
#ifdef SIM_XBF16
        if constexpr (SRC != 0 && OUT != 0) {
#pragma unroll
            for (int j = 0; j < 4; ++j) { const unsigned a = cvt_pk_bf16(xv[j].x, xv[j].y), b = cvt_pk_bf16(xv[j].z, xv[j].w); xv[j] = (f32x4){bf_lo(a), bf_hi(a), bf_lo(b), bf_hi(b)}; } }
#endif
        if constexpr (SRC != 0) {
#pragma unroll
            for (int j = 0; j < 4; ++j) { if constexpr (OUT == 0) ((f32x4*)(F.x + (size_t)m * D))[lane + 64 * j] = xv[j]; }
            if constexpr (OUT != 0) st_bf16_row(F.xs + (size_t)m * D, lane, xv); }
        if constexpr (OUT == 1) {
            const float rstd = __builtin_amdgcn_rsqf(sumsq16(xv) * (1.f / D) + EPS);
            f32x4 hv[4];
#pragma unroll
            for (int j = 0; j < 4; ++j) hv[j] = xv[j] * rstd * go[j];
#ifdef SIM_FFN0
            if (!ROUTE && xin != nullptr) {
#pragma unroll
                for (int j = 0; j < 4; ++j) hv[j] = (f32x4){q8(hv[j].x, 1.f), q8(hv[j].y, 1.f), q8(hv[j].z, 1.f), q8(hv[j].w, 1.f)}; }
#endif
#if MOE_FP8
            if constexpr (ROUTE) {
#pragma unroll
                for (int j = 0; j < 4; ++j) ((unsigned*)((unsigned char*)obuf + (size_t)m * D))[lane + 64 * j] = pk4_fp8(hv[j].x, hv[j].y, hv[j].z, hv[j].w);
            } else
#elif defined(SIM_FP8)
            if constexpr (ROUTE) { f32x4 hq[4];
#pragma unroll
                for (int j = 0; j < 4; ++j) hq[j] = (f32x4){q8(hv[j].x, 1.f), q8(hv[j].y, 1.f), q8(hv[j].z, 1.f), q8(hv[j].w, 1.f)};
                st_bf16_row(obuf + (size_t)m * D, lane, hq); } else
#endif

            st_bf16_row(obuf + (size_t)m * D, lane, hv);
            if constexpr (ROUTE) {
                float lg[8];
#pragma unroll
                for (int e = 0; e < 8; ++e) { float s = 0.f;
#pragma unroll
                    for (int j = 0; j < 4; ++j) { const f32x4 w = *(const LAS f32x4*)(rwT + e * D + 4 * lane + 256 * j); s += (hv[j].x * w.x + hv[j].y * w.y) + (hv[j].z * w.z + hv[j].w * w.w); }
                    lg[e] = wave_sum(s); }
                int e1 = 0; float v1 = lg[0];
#pragma unroll
                for (int e = 1; e < 8; ++e) if (lg[e] > v1) { v1 = lg[e]; e1 = e; }
                int e2 = -1; float v2 = -3.0e38f;
#pragma unroll
                for (int e = 0; e < 8; ++e) if (e != e1 && lg[e] > v2) { v2 = lg[e]; e2 = e; }
                const float ex = __expf(v2 - v1), w1 = 1.f / (1.f + ex), w2 = ex * w1;
                if (lane == 0) {
                    const unsigned p1 = atomicAdd((unsigned*)&lcnt[e1], 1u), p2 = atomicAdd((unsigned*)&lcnt[e2], 1u);
                    LAS unsigned* ri = rinfo + (F.wave * 8 + rs) * 6;
                    ri[0] = (unsigned)e1; ri[1] = p1; ri[2] = (unsigned)e2; ri[3] = p2; ri[4] = __float_as_uint(w1); ri[5] = __float_as_uint(w2);
                }
            }
        }
    }
    if constexpr (ROUTE) {
        __syncthreads();
        if (F.tid < 8) lcnt[8 + F.tid] = __hip_atomic_fetch_add(gcnt + F.tid, lcnt[F.tid], RLX_AGENT);
        __syncthreads();
        if (lane < rs) {
            const int m = gw + lane * NGW; const LAS unsigned* ri = rinfo + (F.wave * 8 + lane) * 6;
            const unsigned e1 = ri[0], e2 = ri[2]; const unsigned p1 = ri[1] + lcnt[8 + e1], p2 = ri[3] + lcnt[8 + e2];
            unsigned* ti = tokinfo + (size_t)m * 8; ti[0] = e1; ti[1] = p1; ti[2] = e2; ti[3] = p2; ti[4] = ri[4]; ti[5] = ri[5];
            idxe[e1 * 16384 + p1] = m; idxe[e2 * 16384 + p2] = m;
        }
    }
}
#if defined(SIM_FP8) || defined(SIM_FFN0)
#define SIMQ(x, s) (((s) != 0.f) ? q8((x), (s)) : (x))
#else
#define SIMQ(x, s) (x)
#endif
struct TrItem { const float* src; int pitch; bf16_t* dst; int dstK; int ncols; float qs; int f8; };
#ifdef TR_NT
#define TR_LD(p) __builtin_nontemporal_load(p)
#else
#define TR_LD(p) (*(p))
#endif
#define TR_LOAD(t, v) do { _Pragma("unroll") for (int i = 0; i < 64; ++i) { const int kk = 2 * i + (lane >> 5); v[i] = ((lane & 31) < (t).ncols) ? TR_LD((t).src + (size_t)kk * (t).pitch + (lane & 31)) : 0.f; } } while (0)
__device__ __forceinline__ void tr_finish(const TrItem& t, float (&v)[64], LAS float* scr, int lane, bool nostore = false) {
    const int c = lane & 31;
#pragma unroll
    for (int p = 0; p < 2; ++p) {
#pragma unroll
        for (int i = 0; i < 32; ++i) { const int kk = 2 * i + (lane >> 5); scr[kk * 33 + c] = SIMQ(v[32 * p + i], t.qs); }
        LDS_WAIT(); asm volatile("" ::: "memory");
        if (t.f8) {
            const int c4 = lane & 3;
#pragma unroll
            for (int j = 0; j < 2; ++j) { const int n = (lane >> 2) + 16 * j; const LAS float* s = scr + (16 * c4) * 33 + n;
                u32x4 o; o.x = pk4_fp8(s[0 * 33] * W8_SCALE, s[1 * 33] * W8_SCALE, s[2 * 33] * W8_SCALE, s[3 * 33] * W8_SCALE); o.y = pk4_fp8(s[4 * 33] * W8_SCALE, s[5 * 33] * W8_SCALE, s[6 * 33] * W8_SCALE, s[7 * 33] * W8_SCALE);
                o.z = pk4_fp8(s[8 * 33] * W8_SCALE, s[9 * 33] * W8_SCALE, s[10 * 33] * W8_SCALE, s[11 * 33] * W8_SCALE); o.w = pk4_fp8(s[12 * 33] * W8_SCALE, s[13 * 33] * W8_SCALE, s[14 * 33] * W8_SCALE, s[15 * 33] * W8_SCALE);
                if (!nostore) *(u32x4*)((unsigned char*)t.dst + (size_t)n * t.dstK + 64 * p + 16 * c4) = o; }
        } else {
            const int c8 = lane & 7;
#pragma unroll
            for (int j = 0; j < 4; ++j) { const int n = (lane >> 3) + 8 * j; const LAS float* s = scr + (8 * c8) * 33 + n;
                u32x4 o; o.x = cvt_pk_bf16(s[0 * 33], s[1 * 33]); o.y = cvt_pk_bf16(s[2 * 33], s[3 * 33]); o.z = cvt_pk_bf16(s[4 * 33], s[5 * 33]); o.w = cvt_pk_bf16(s[6 * 33], s[7 * 33]);
                if (n < t.ncols && !nostore) *(u32x4*)(t.dst + (size_t)n * t.dstK + 64 * p + 8 * c8) = o; }
        }
        LDS_WAIT(); asm volatile("" ::: "memory");
    }
}
constexpr int IT_COMMON = 640 + 640 + 8 + 128 + 128 + 256 + 64 + 256;
constexpr int IT_FFN = 3 * 704, IT_MOE1 = 8 * 896;
constexpr int IT_TOTAL = 2 * IT_COMMON + IT_FFN + 3 * IT_MOE1;
__device__ __forceinline__ TrItem seg_plain(const float* src, int K, int N, int pitch, bf16_t* dst, int r) {
#ifdef TR_NFAST
    const int nnb = N / 32, kb = r / nnb, nb = r % nnb;
#else
    const int nkb = K / 128, nb = r / nkb, kb = r % nkb;
#endif
    return TrItem{src + (size_t)kb * 128 * pitch + nb * 32, pitch, dst + (size_t)(nb * 32) * K + kb * 128, K, 32, 0.f, 0};
}
__device__ __forceinline__ TrItem seg_gu(const float* src, int N, bf16_t* dst, int up, int r) {
#ifdef TR_NFAST
    const int kb = r / (N / 32), nb = r % (N / 32), n0 = nb * 32;
#else
    const int nb = r / (D / 128), kb = r % (D / 128), n0 = nb * 32;
#endif
    return TrItem{src + (size_t)kb * 128 * N + n0, N, dst + (size_t)((n0 >> 7) * 256 + (n0 & 127) + up * 128) * D + kb * 128, D, 32, 0.f, 0};
}
__device__ __forceinline__ TrItem decode_item(const Args& a, unsigned char* ws, int it) {
    if (it < 2 * IT_COMMON) {
        const int l = it / IT_COMMON; int r = it % IT_COMMON; unsigned char* wb = ws + (l ? WS_W1 : WS_W0);
        const float* win = a.in[I_WIN] + (size_t)l * D * INW;
        if (r < 640) return seg_plain(win, D, 2560, INW, (bf16_t*)(wb + OFF_WIN), r); r -= 640;
        if (r < 640) return seg_plain(win + 2576, D, 2560, INW, (bf16_t*)(wb + OFF_WIN) + (size_t)2560 * D, r); r -= 640;
        if (r < 8) return TrItem{win + (size_t)r * 128 * INW + 2560, INW, (bf16_t*)(wb + OFF_WGD) + r * 128, D, 16, 0.f, 0}; r -= 8;
        if (r < 128) return seg_plain(a.in[I_WBA] + (size_t)l * 512 * D, 512, D, D, (bf16_t*)(wb + OFF_WBA), r); r -= 128;
        if (r < 128) return seg_plain(a.in[I_WBB] + (size_t)l * 512 * D, 512, D, D, (bf16_t*)(wb + OFF_WBB), r); r -= 128;
        if (r < 256) return seg_plain(a.in[I_WOUT] + (size_t)l * D * D, D, D, D, (bf16_t*)(wb + OFF_WOUT), r); r -= 256;
        if (r < 64) return seg_plain(a.in[I_PP] + (size_t)l * PLE * D, PLE, D, D, (bf16_t*)(wb + OFF_WPP), r); r -= 64;
        return seg_plain(a.in[I_PG] + (size_t)l * D * D, D, D, D, (bf16_t*)(wb + OFF_WPG), r);
    }
    it -= 2 * IT_COMMON;
    if (it < IT_FFN) {
        unsigned char* wb = ws + WS_W0;
        TrItem t;
        if (it < 704) t = seg_gu(a.in[I_FG], DFF, (bf16_t*)(wb + OFF_FFN), 0, it);
        else if (it < 1408) t = seg_gu(a.in[I_FU], DFF, (bf16_t*)(wb + OFF_FFN), 1, it - 704);
        else t = seg_plain(a.in[I_FD], DFF, D, D, (bf16_t*)(wb + OFF_FDN), it - 1408);
#ifdef SIM_FFN0
        t.qs = 64.f;
#endif
        return t;
    }
    it -= IT_FFN;
    unsigned char* wb = ws + WS_W1;
    const int kind = it / IT_MOE1, r0 = it % IT_MOE1, e = r0 / 896, r = r0 % 896;
    TrItem t;
#if MOE_FP8
    {
#ifdef TR_NFAST
      const int nnb8 = (kind == 2 ? D : DFE) / 32, kb8 = r / nnb8, nb8 = r % nnb8, n0 = nb8 * 32;
#else
      const int nkb8 = (kind == 2 ? DFE : D) / 128, nb8 = r / nkb8, kb8 = r % nkb8, n0 = nb8 * 32;
#endif
      if (kind == 2) return TrItem{a.in[I_MD] + (size_t)e * DFE * D + (size_t)kb8 * 128 * D + n0, D, (bf16_t*)(wb + OFF_MDN8 + (size_t)e * D * DFE + (size_t)n0 * DFE + kb8 * 128), DFE, 32, 0.f, 1};
      const float* src = (kind == 0 ? a.in[I_MG] : a.in[I_MU]) + (size_t)e * D * DFE + (size_t)kb8 * 128 * DFE + n0;
      return TrItem{src, DFE, (bf16_t*)(wb + OFF_FFN + (size_t)e * 7168 * D + (size_t)((n0 >> 7) * 256 + (n0 & 127) + (kind == 1 ? 128 : 0)) * D + kb8 * 128), D, 32, 0.f, 1}; }
#endif
    if (kind == 0) t = seg_gu(a.in[I_MG] + (size_t)e * D * DFE, DFE, (bf16_t*)(wb + OFF_FFN) + (size_t)e * 7168 * D, 0, r);
    else if (kind == 1) t = seg_gu(a.in[I_MU] + (size_t)e * D * DFE, DFE, (bf16_t*)(wb + OFF_FFN) + (size_t)e * 7168 * D, 1, r);
    else t = seg_plain(a.in[I_MD] + (size_t)e * DFE * D, DFE, D, D, (bf16_t*)(wb + OFF_MDN) + (size_t)e * D * DFE, r);
#ifdef SIM_FP8
    t.qs = 64.f;
#endif
    return t;
}
__device__ __forceinline__ void p0_prologue(Frame& F, const Args& a, int probe = 0) {
    FRESH(F);
    LAS float* scr = (LAS float*)(F.lds + F.wave * 16384);
    const int gw = F.vcu * NWAVES + F.wave, NGW = F.G * NWAVES;
    { const int lane = F.lane;
      for (int it = gw; it < IT_TOTAL; it += NGW) { const TrItem t = decode_item(a, F.ws, it); float v[64]; TR_LOAD(t, v); tr_finish(t, v, scr, lane, probe == 1); } }
    if (probe) return;
    { const f32x4* ps = (const f32x4*)a.in[I_P]; u32x4* pd = (u32x4*)(F.ws + WS_PB); const int n8 = 2 * T * PLE / 8;
#ifdef PCV_BATCH
      const int stride = F.G * NTHR;
      for (int i0 = blockIdx.x * NTHR + F.tid; i0 < n8; i0 += 8 * stride) { f32x4 v[8][2];
#pragma unroll
          for (int q = 0; q < 8; ++q) { const int i = i0 + q * stride; if (i < n8) { v[q][0] = ps[2 * i]; v[q][1] = ps[2 * i + 1]; } }
#pragma unroll
          for (int q = 0; q < 8; ++q) { const int i = i0 + q * stride; if (i < n8) { u32x4 w; w.x = cvt_pk_bf16(v[q][0].x, v[q][0].y); w.y = cvt_pk_bf16(v[q][0].z, v[q][0].w); w.z = cvt_pk_bf16(v[q][1].x, v[q][1].y); w.w = cvt_pk_bf16(v[q][1].z, v[q][1].w); pd[i] = w; } } }
#else
      for (int i = blockIdx.x * NTHR + F.tid; i < n8; i += F.G * NTHR) { const f32x4 v0 = ps[2 * i], v1 = ps[2 * i + 1];
          u32x4 w; w.x = cvt_pk_bf16(v0.x, v0.y); w.y = cvt_pk_bf16(v0.z, v0.w); w.z = cvt_pk_bf16(v1.x, v1.y); w.w = cvt_pk_bf16(v1.z, v1.w); pd[i] = w; }
#endif
    }
    thin_phase<0, 1, false>(F, a.in[I_X], nullptr, nullptr, a.in[I_NMPRE], (bf16_t*)(F.ws + WS_HB), nullptr);
}
typedef short v4i16_t __attribute__((ext_vector_type(4)));
__device__ __forceinline__ s16x4 lds_tr16(const LAS unsigned char* p) { return __builtin_bit_cast(s16x4, __builtin_amdgcn_ds_read_tr16_b64_v4i16((LAS v4i16_t*)p)); }
__device__ __forceinline__ bf16x8 cat8(s16x4 a, s16x4 b) { return (bf16x8){a[0], a[1], a[2], a[3], b[0], b[1], b[2], b[3]}; }

__device__ __forceinline__ void attn_unit(Frame& F, int b, int c, const float* relb) {
    FRESH(F);
    const int lane = F.lane, h = F.wave, n = lane & 15, mq = lane >> 4;
    const bf16_t* qa = (const bf16_t*)(F.ws + WS_QA); const bf16_t* ka = (const bf16_t*)(F.ws + WS_KA); const bf16_t* va = (const bf16_t*)(F.ws + WS_VA);
    LAS unsigned char* kbuf = F.lds + h * 16384; LAS unsigned char* vbuf = kbuf + 8192;
    LAS float* rt = (LAS float*)(F.lds + XTRA_OFF + h * 1056);
    for (int i = lane; i < 256; i += 64) { const int j = i - 64; rt[i] = relb[h * RELN + 256 - (j > 0 ? j : 0)] * LOG2E; }
    const float bfar = relb[h * RELN + 256] * LOG2E;
    const int tok0 = b * SEQ + c * CH;
    bf16x8 qf[4][2];
#pragma unroll
    for (int qt = 0; qt < 4; ++qt)
#pragma unroll
        for (int ks = 0; ks < 2; ++ks) qf[qt][ks] = *(const bf16x8*)(qa + (size_t)(tok0 + 16 * qt + n) * 512 + h * 64 + 32 * ks + 8 * mq);
    const int koff_e = (lane >> 3) * 512 + (((lane & 7) ^ ((lane >> 4) & 7)) * 8), koff_o = (lane >> 3) * 512 + (((lane & 7) ^ ((4 + (lane >> 4)) & 7)) * 8);
    const int voff = (lane >> 3) * 512 + ((2 * (((lane & 7) >> 1) ^ (lane >> 4)) + (lane & 1)) * 8);
#define ATT_DMA_K(j) do { const bf16_t* _s = ka + (size_t)(b * SEQ + (j) * CH) * 512 + h * 64; _Pragma("unroll") for (int _i = 0; _i < 8; ++_i) \
        __builtin_amdgcn_global_load_lds((const unsigned*)(_s + (size_t)_i * 8 * 512 + ((_i & 1) ? koff_o : koff_e)), (LAS unsigned*)(kbuf + _i * 1024), 16, 0, 0); } while (0)
#define ATT_DMA_V(j) do { const bf16_t* _s = va + (size_t)(b * SEQ + (j) * CH) * 512 + h * 64; _Pragma("unroll") for (int _i = 0; _i < 8; ++_i) \
        __builtin_amdgcn_global_load_lds((const unsigned*)(_s + (size_t)_i * 8 * 512 + voff), (LAS unsigned*)(vbuf + _i * 1024), 16, 0, 0); } while (0)
    const int ka0 = n * 128 + (((0 + mq) ^ (n >> 1)) * 16), ka1 = n * 128 + (((4 + mq) ^ (n >> 1)) * 16);
    const int qp = n >> 2, pp = lane & 3, sw = 2 * (mq & 1) + (qp >> 1);
    const int vrow = (4 * mq + qp) * 128 + 8 * pp;
    f32x4 O[4][4]; float mrun[4], lsum[4];
#pragma unroll
    for (int qt = 0; qt < 4; ++qt) { mrun[qt] = -1.0e30f; lsum[qt] = 0.f;
#pragma unroll
        for (int dt = 0; dt < 4; ++dt) O[qt][dt] = (f32x4){0.f, 0.f, 0.f, 0.f}; }
#if defined(ATT_REG) && ATT_REG == 1
    constexpr int QN = 1;
#else
    constexpr int QN = 2;
#endif
    const int j0 = (c - NPREV) > 0 ? (c - NPREV) : 0;
    ATT_DMA_K(j0); ATT_DMA_V(j0);
    for (int j = j0; j <= c; ++j) {
        const int dc = c - j;
        asm volatile("s_waitcnt vmcnt(8)" ::: "memory");
#ifdef ATT_REG
        bf16x8 kf[4][2], vfr[4][2];
#if ATT_REG == 1
#pragma unroll
        for (int kt = 0; kt < 4; ++kt) { kf[kt][0] = *(const LAS bf16x8*)(kbuf + kt * 2048 + ka0); kf[kt][1] = *(const LAS bf16x8*)(kbuf + kt * 2048 + ka1); }
        LDS_WAIT();
        if (j < c) { ATT_DMA_K(j + 1); asm volatile("s_waitcnt vmcnt(8)" ::: "memory"); } else asm volatile("s_waitcnt vmcnt(0)" ::: "memory");
#else
        asm volatile("s_waitcnt vmcnt(0)" ::: "memory");
#endif
#pragma unroll
        for (int dt = 0; dt < 4; ++dt)
#pragma unroll
            for (int u = 0; u < 2; ++u) { const LAS unsigned char* vp = vbuf + vrow + (32 * u) * 128 + ((dt ^ sw) * 32); vfr[dt][u] = cat8(lds_tr16(vp), lds_tr16(vp + 16 * 128)); }
        LDS_WAIT();
        if (j < c) { ATT_DMA_V(j + 1); }
#endif
#pragma unroll
        for (int qg = 0; qg < 4 / QN; ++qg) {
            f32x4 S[4][QN];
#pragma unroll
            for (int kt = 0; kt < 4; ++kt) {
#if defined(ATT_REG) && ATT_REG == 1
                const bf16x8 k0 = kf[kt][0], k1 = kf[kt][1];
#else
                const bf16x8 k0 = *(const LAS bf16x8*)(kbuf + kt * 2048 + ka0), k1 = *(const LAS bf16x8*)(kbuf + kt * 2048 + ka1);
#endif
#pragma unroll
                for (int q2 = 0; q2 < QN; ++q2) { f32x4 z = (f32x4){0.f, 0.f, 0.f, 0.f};
                    z = __builtin_amdgcn_mfma_f32_16x16x32_bf16(k0, qf[QN * qg + q2][0], z, 0, 0, 0);
                    S[kt][q2] = __builtin_amdgcn_mfma_f32_16x16x32_bf16(k1, qf[QN * qg + q2][1], z, 0, 0, 0); }
            }
#if !defined(ATT_REG) || ATT_REG != 1
            if (qg == 4 / QN - 1) { if (j < c) { LDS_WAIT(); ATT_DMA_K(j + 1); } }
#endif
            bf16x8 P[QN][2];
#pragma unroll
            for (int q2 = 0; q2 < QN; ++q2) { const int qt = QN * qg + q2;
                if (dc >= 3) {
                    asm volatile("" ::: "memory");
#pragma unroll
                    for (int kt = 0; kt < 4; ++kt) S[kt][q2] = S[kt][q2] + bfar;
                } else {
                    asm volatile("" ::: "memory");
                    const LAS float* rp = rt + (64 + 128 - (64 * dc + 16 * qt + n - 4 * mq));
                    float bv[4][4];
#pragma unroll
                    for (int kt = 0; kt < 4; ++kt)
#pragma unroll
                        for (int i = 0; i < 4; ++i) bv[kt][i] = rp[16 * kt + i];
#pragma unroll
                    for (int kt = 0; kt < 4; ++kt)
#pragma unroll
                        for (int i = 0; i < 4; ++i) S[kt][q2][i] += bv[kt][i];
                }
                float cm = S[0][q2][0];
#pragma unroll
                for (int kt = 0; kt < 4; ++kt)
#pragma unroll
                    for (int i = 0; i < 4; ++i) cm = fmaxf(cm, S[kt][q2][i]);
                cm = max_x16_x32(cm);
                const float mn = fmaxf(mrun[qt], cm), alpha = __builtin_amdgcn_exp2f(mrun[qt] - mn); mrun[qt] = mn;
                float ps = 0.f;
#pragma unroll
                for (int kt = 0; kt < 4; ++kt)
#pragma unroll
                    for (int i = 0; i < 4; ++i) { const float p = __builtin_amdgcn_exp2f(S[kt][q2][i] - mn); S[kt][q2][i] = p; ps += p; }
                lsum[qt] = lsum[qt] * alpha + ps;
#pragma unroll
                for (int dt = 0; dt < 4; ++dt) O[qt][dt] = O[qt][dt] * alpha;
#pragma unroll
                for (int u = 0; u < 2; ++u) { u32x4 w; w.x = cvt_pk_bf16(S[2 * u][q2][0], S[2 * u][q2][1]); w.y = cvt_pk_bf16(S[2 * u][q2][2], S[2 * u][q2][3]);
                    w.z = cvt_pk_bf16(S[2 * u + 1][q2][0], S[2 * u + 1][q2][1]); w.w = cvt_pk_bf16(S[2 * u + 1][q2][2], S[2 * u + 1][q2][3]); P[q2][u] = __builtin_bit_cast(bf16x8, w); }
            }
#ifndef ATT_REG
            if (qg == 0) asm volatile("s_waitcnt vmcnt(0)" ::: "memory");
#endif
#pragma unroll
            for (int dt = 0; dt < 4; ++dt)
#pragma unroll
                for (int u = 0; u < 2; ++u) {
#ifdef ATT_REG
                    const bf16x8 vf = vfr[dt][u];
#else
                    const LAS unsigned char* vp = vbuf + vrow + (32 * u) * 128 + ((dt ^ sw) * 32);
                    const bf16x8 vf = cat8(lds_tr16(vp), lds_tr16(vp + 16 * 128));
#endif
#pragma unroll
                    for (int q2 = 0; q2 < QN; ++q2) O[QN * qg + q2][dt] = __builtin_amdgcn_mfma_f32_16x16x32_bf16(vf, P[q2][u], O[QN * qg + q2][dt], 0, 0, 0);
                }
#ifndef ATT_REG
            if (qg == 4 / QN - 1) { if (j < c) { LDS_WAIT(); ATT_DMA_V(j + 1); } }
#endif
        }
    }
#undef ATT_DMA_K
#undef ATT_DMA_V
    bf16_t* ya = (bf16_t*)(F.ws + WS_YA);
    int ln = lane; asm volatile("" : "+v"(ln)); const int n_o = ln & 15, mq_o = ln >> 4;
#pragma unroll
    for (int qt = 0; qt < 4; ++qt) { float l = sum_x16_x32(lsum[qt]); const float rl = __builtin_amdgcn_rcpf(l);
#pragma unroll
        for (int dt = 0; dt < 4; ++dt) { const f32x4 o = O[qt][dt] * rl; u32x2 w; w.x = cvt_pk_bf16(o[0], o[1]); w.y = cvt_pk_bf16(o[2], o[3]);
            *(u32x2*)(ya + (size_t)(tok0 + 16 * qt + n_o) * 512 + h * 64 + 16 * dt + 4 * mq_o) = w; } }
}

__device__ __forceinline__ void gla_dstate_unit(Frame& F, int b, int c, const bf16_t* wgd_t, const float* wup, const float* bgate) {
    FRESH(F);
    const int lane = F.lane, w = F.wave, tid = F.tid, n = lane & 15, mq = lane >> 4;
    const int tok0 = b * SEQ + c * CH;
    const bf16_t* hb = (const bf16_t*)(F.ws + WS_HB); const bf16_t* kb = (const bf16_t*)(F.ws + WS_KB); const bf16_t* vb = (const bf16_t*)(F.ws + WS_VB);
    LAS float* GD8 = (LAS float*)(F.lds); LAS unsigned char* VB = F.lds + 32768; LAS unsigned char* KD = F.lds + 98304;
    LAS float* GDF = (LAS float*)(F.lds + XTRA_OFF); LAS float* TOT = (LAS float*)(F.lds + XTRA_OFF + 4096);
    __syncthreads();
    const int col = tid & 255, hf = tid >> 8;
    float wu[16];
#pragma unroll
    for (int r = 0; r < 16; ++r) wu[r] = wup[r * 256 + col];
    const float bb = bgate[col];
    unsigned short kraw[32];
#pragma unroll
    for (int l = 0; l < 32; ++l) kraw[l] = kb[(size_t)(tok0 + 32 * hf + l) * 256 + col];
#pragma unroll
    for (int i = 0; i < 8; ++i) { const int p = (w * 8 + i) * 64 + lane, row = p >> 6, ch = p & 63;
        __builtin_amdgcn_global_load_lds((const unsigned*)(vb + (size_t)(tok0 + row) * 512 + ch * 8), (LAS unsigned*)(VB + (w * 8 + i) * 1024), 16, 0, 0); }
    { bf16x8 af[4][4], bf[4];
#pragma unroll
      for (int ks = 0; ks < 4; ++ks) { bf[ks] = *(const bf16x8*)(wgd_t + (size_t)n * D + 128 * w + 32 * ks + 8 * mq);
#pragma unroll
          for (int mt = 0; mt < 4; ++mt) af[mt][ks] = *(const bf16x8*)(hb + (size_t)(tok0 + 16 * mt + n) * D + 128 * w + 32 * ks + 8 * mq); }
#pragma unroll
      for (int mt = 0; mt < 4; ++mt) { f32x4 acc = (f32x4){0.f, 0.f, 0.f, 0.f};
#pragma unroll
          for (int ks = 0; ks < 4; ++ks) acc = __builtin_amdgcn_mfma_f32_16x16x32_bf16(af[mt][ks], bf[ks], acc, 0, 0, 0);
#pragma unroll
          for (int i = 0; i < 4; ++i) GD8[(w * 64 + 16 * mt + 4 * mq + i) * 16 + n] = acc[i]; } }
    __syncthreads();
    { const f32x2 z2 = (f32x2){0.f, 0.f}; f32x2 sacc = z2;
#pragma unroll
      for (int q = 0; q < 8; ++q) sacc = sacc + *(const LAS f32x2*)(GD8 + q * 1024 + 2 * tid);
      *(LAS f32x2*)(GDF + 2 * tid) = sacc; }
    __syncthreads();
    { float cum[32]; float run = 0.f;
#pragma unroll
      for (int l = 0; l < 32; ++l) { const int row = 32 * hf + l; float z = bb;
#pragma unroll
          for (int r4 = 0; r4 < 4; ++r4) { const f32x4 a = *(const LAS f32x4*)(GDF + row * 16 + 4 * r4);
              z += a.x * wu[4 * r4] + a.y * wu[4 * r4 + 1] + a.z * wu[4 * r4 + 2] + a.w * wu[4 * r4 + 3]; }
          const float la = (fminf(z, 0.f) - __logf(1.f + __expf(-fabsf(z)))) * (1.f / 16.f);
          run += la; cum[l] = run; }
      LAS float* TOT1 = TOT + 256;
      if (hf == 0) TOT[col] = run;
      __syncthreads();
      const float tot = (hf == 1) ? TOT[col] : 0.f;
      if (hf == 1) TOT1[col] = run + tot;
      __syncthreads();
      const float ctot = TOT1[col];
      if (hf == 1) ((float*)(F.ws + WS_DEC))[(size_t)(b * NCH + c) * 256 + col] = __expf(ctot);
      unsigned pk[16];
#pragma unroll
      for (int l = 0; l < 32; l += 2) { const float k0 = bf2f(kraw[l]), k1 = bf2f(kraw[l + 1]);
          pk[l >> 1] = cvt_pk_bf16(k0 * __expf(ctot - (cum[l] + tot)), k1 * __expf(ctot - (cum[l + 1] + tot))); }
#pragma unroll
      for (int q = 0; q < 4; ++q) *(LAS u32x4*)(KD + col * 128 + hf * 64 + q * 16) = (u32x4){pk[4 * q], pk[4 * q + 1], pk[4 * q + 2], pk[4 * q + 3]}; }
    VM_WAIT();
    __syncthreads();
    { const int hh = w >> 1, vh = w & 1, qp = n >> 2, pp = lane & 3;
      f32x4 acc[4][4];
#pragma unroll
      for (int mt = 0; mt < 4; ++mt)
#pragma unroll
          for (int nt = 0; nt < 4; ++nt) acc[mt][nt] = (f32x4){0.f, 0.f, 0.f, 0.f};
#pragma unroll
      for (int ks = 0; ks < 2; ++ks) {
          bf16x8 af[4];
#pragma unroll
          for (int mt = 0; mt < 4; ++mt) af[mt] = *(const LAS bf16x8*)(KD + (hh * 64 + 16 * mt + n) * 128 + (32 * ks + 8 * mq) * 2);
#pragma unroll
          for (int nt = 0; nt < 4; ++nt) {
              const LAS unsigned char* vp = VB + (size_t)(32 * ks + 8 * mq + qp) * 1024 + (hh * 128 + vh * 64 + 16 * nt + 4 * pp) * 2;
              const bf16x8 bfr = cat8(lds_tr16(vp), lds_tr16(vp + 4 * 1024));
#pragma unroll
              for (int mt = 0; mt < 4; ++mt) acc[mt][nt] = __builtin_amdgcn_mfma_f32_16x16x32_bf16(af[mt], bfr, acc[mt][nt], 0, 0, 0);
          }
      }
      float* dst = (float*)(F.ws + WS_DST) + ((size_t)((b * NCH + c) * BH + hh) * 128) * 64;
#pragma unroll
      for (int mt = 0; mt < 4; ++mt)
#pragma unroll
          for (int nt = 0; nt < 4; ++nt) *(f32x4*)(dst + (size_t)(vh * 64 + 16 * nt + n) * 64 + 16 * mt + 4 * mq) = acc[mt][nt]; }
    __syncthreads();
}

__device__ __forceinline__ void gla_scan_phase(Frame& F) {
    FRESH(F);
    const float* ds = (const float*)(F.ws + WS_DST); const float* dec = (const float*)(F.ws + WS_DEC); bf16_t* st = (bf16_t*)(F.ws + WS_ST);
    for (int e2 = blockIdx.x * NTHR + F.tid; e2 < NB * BH * 128 * 32; e2 += F.G * NTHR) {
        const int k2 = e2 & 31, v = (e2 >> 5) & 127, hh = (e2 >> 12) & 3, b = e2 >> 14;
        f32x2 s = (f32x2){0.f, 0.f};
#pragma unroll 8
        for (int c = 0; c < NCH; ++c) {
            const size_t off = ((size_t)((b * NCH + c) * BH + hh) * 128 + v) * 64 + 2 * k2;
            const f32x2 d = *(const f32x2*)(ds + off); const f32x2 a = *(const f32x2*)(dec + (size_t)(b * NCH + c) * 256 + hh * 64 + 2 * k2);
            s = a * s + d;
            *(unsigned*)(st + off) = cvt_pk_bf16(s.x, s.y);
        }
    }
}

__device__ __forceinline__ void gla_out_unit(Frame& F, int b, int c, const float* gnorm) {
    FRESH(F);
    const int lane = F.lane, w = F.wave, n = lane & 15, mq = lane >> 4;
    const int hh = w >> 1, th = w & 1, tok0 = b * SEQ + c * CH + 32 * th;
    const bf16_t* qb = (const bf16_t*)(F.ws + WS_QB); const bf16_t* st = (const bf16_t*)(F.ws + WS_ST) + ((size_t)((b * NCH + c) * BH + hh) * 128) * 64;
    const bf16_t* sr = (const bf16_t*)(F.ws + WS_SR); bf16_t* yb = (bf16_t*)(F.ws + WS_YB);
    bf16x8 qf[2][2];
#pragma unroll
    for (int nt = 0; nt < 2; ++nt)
#pragma unroll
        for (int ks = 0; ks < 2; ++ks) qf[nt][ks] = *(const bf16x8*)(qb + (size_t)(tok0 + 16 * nt + n) * 256 + hh * 64 + 32 * ks + 8 * mq);
    f32x4 acc[8][2];
#pragma unroll
    for (int mt = 0; mt < 8; ++mt) {
        const bf16x8 a0 = *(const bf16x8*)(st + (size_t)(16 * mt + n) * 64 + 8 * mq), a1 = *(const bf16x8*)(st + (size_t)(16 * mt + n) * 64 + 32 + 8 * mq);
#pragma unroll
        for (int nt = 0; nt < 2; ++nt) { f32x4 z = (f32x4){0.f, 0.f, 0.f, 0.f};
            z = __builtin_amdgcn_mfma_f32_16x16x32_bf16(a0, qf[nt][0], z, 0, 0, 0);
            acc[mt][nt] = __builtin_amdgcn_mfma_f32_16x16x32_bf16(a1, qf[nt][1], z, 0, 0, 0); }
    }
#pragma unroll
    for (int nt = 0; nt < 2; ++nt) { float ss = 0.f;
#pragma unroll
        for (int mt = 0; mt < 8; ++mt) ss += (acc[mt][nt][0] * acc[mt][nt][0] + acc[mt][nt][1] * acc[mt][nt][1]) + (acc[mt][nt][2] * acc[mt][nt][2] + acc[mt][nt][3] * acc[mt][nt][3]);
        ss = sum_x16_x32(ss);
        const float rstd = __builtin_amdgcn_rsqf(ss * (1.f / 128.f) + EPS);
#pragma unroll
        for (int mt = 0; mt < 8; ++mt) { const int col = hh * 128 + 16 * mt + 4 * mq; const f32x4 gn = *(const f32x4*)(gnorm + col);
            const size_t po = (size_t)(tok0 + 16 * nt + n) * 512 + col; const u32x2 rw = *(const u32x2*)(sr + po);
            const f32x4 o = acc[mt][nt] * rstd * gn; u32x2 wv; wv.x = cvt_pk_bf16(o[0] * bf_lo(rw.x), o[1] * bf_hi(rw.x)); wv.y = cvt_pk_bf16(o[2] * bf_lo(rw.y), o[3] * bf_hi(rw.y));
            *(u32x2*)(yb + po) = wv; } }
}
#ifndef PLE_MODE1
#define PLE_MODE1 3
#endif
#ifdef SIM_FP8
constexpr float MOE_ACT_QS = 8.f;
#else
constexpr float MOE_ACT_QS = 0.f;
#endif
#ifdef SIM_FFN0
constexpr float FFN0_ACT_QS = 8.f;
#else
constexpr float FFN0_ACT_QS = 0.f;
#endif
#ifndef PRO_PROBE
#define PRO_PROBE 0
#endif
#ifndef STAG_INPROJ
#define STAG_INPROJ 0
#endif
constexpr int N_PHASES = 25;
__global__ void __launch_bounds__(NTHR, 2) fwd(Args args) {
    extern __shared__ __attribute__((aligned(16))) unsigned char lds[];
    Frame F;
    F.lds = (LAS unsigned char*)lds;
    F.MISC = (volatile LAS unsigned*)(F.lds + MISC_OFF);
    F.tid = threadIdx.x; F.lane = F.tid & 63; F.wave = __builtin_amdgcn_readfirstlane(F.tid >> 6);
    F.G = gridDim.x; { const int bx = blockIdx.x; F.vcu = (F.G % 8 == 0) ? (bx % 8) * (F.G / 8) + bx / 8 : bx; }
    F.ws = args.ws; F.ctl = (gu32*)(args.ws + WS_CTL); F.x = args.out; F.xs = (bf16_t*)(args.ws + WS_XS);
    unsigned char* ws = args.ws;
    for (int u = F.tid; u < (LDS_BYTES - LDSCTL_OFF) / 4; u += NTHR) ((LAS unsigned*)(F.lds + LDSCTL_OFF))[u] = 0u;
    __syncthreads();
    XcdBarrier bar = xcd_barrier_post((unsigned*)(F.ctl + CW_BAR), F.MISC + 8);
    const WT wt = make_wt(ws, (unsigned)WS_END);
    const int lo = args.ph_lo, hi = args.ph_hi;
#define PH_BEGIN const __attribute__((address_space(4))) Args* _ap = (const __attribute__((address_space(4))) Args*)__builtin_amdgcn_kernarg_segment_ptr(); asm volatile("" : "+s"(_ap)); const __attribute__((address_space(4))) Args& A = *_ap; unsigned char* ws = A.ws; \
    unsigned char* wb = ws + (l ? WS_W1 : WS_W0); bf16_t* hb = (bf16_t*)(ws + WS_HB); bf16_t* Y = (bf16_t*)(ws + WS_Y); const WT wt = make_wt(ws, (unsigned)WS_END); (void)wb; (void)hb; (void)Y; (void)wt; (void)A
#ifndef PHMASK
#define PHMASK 0x1fff
#endif
#define EN(i) (((PHMASK) >> (i)) & 1)
#ifndef REPMASK
#define REPMASK 0
#endif
#ifndef REPLAYER
#define REPLAYER 2
#endif
#define ZEROG ((const float*)(ws + WS_CTL + 131072))
#ifndef ZSKIP
#define ZSKIP 0
#endif
#define REPS(i) (((((REPMASK) >> (i)) & 1) && (REPLAYER == 2 || REPLAYER == l)) ? 2 : 1)
#define IN(k) (lo <= (k) && (k) < hi)
#ifndef SEAMREP
#define SEAMREP 1
#endif
#ifndef MK_STAMP
#define MK_STAMP 0
#endif
#ifndef STAMP_SEL
#define STAMP_SEL -1
#endif
#define SEAM(k) do { if (MK_STAMP && IN(k) && F.tid == 0) ((unsigned long long*)(ws + WS_CTL + 786432))[(k) * 256 + blockIdx.x] = __builtin_amdgcn_s_memrealtime(); \
    if (IN(k) && IN((k) + 1)) for (int _r = 0; _r < SEAMREP; ++_r) xcd_barrier(bar); } while (0)

    { const int l = 0; if (EN(12) && IN(0)) for (int rep = 0; rep < REPS(12); ++rep) { p0_prologue(F, args, rep == 0 ? 0 : PRO_PROBE); } }
    SEAM(0);
#ifndef LAYERREP
#define LAYERREP 0
#endif
    for (int l2 = 0; l2 < DEPTH + LAYERREP; ++l2) {
        const int l = (l2 < LAYERREP) ? 0 : l2 - LAYERREP; const bool zpass = (l2 < LAYERREP);
        const int pb = 1 + 12 * l;
        if (EN(0) && IN(pb + 0) && !(zpass && ((ZSKIP >> 0) & 1))) for (int rep = 0; rep < REPS(0); ++rep) { PH_BEGIN;
            pg8::Gemm g{hb, (const bf16_t*)(wb + OFF_WIN), D, 0, nullptr}; pg8::StaticOrder S; S.init(T, INWG, F.G, (int)blockIdx.x);
            pg8::EpiInProj E{(bf16_t*)(ws + WS_PROJ), wt};
            pg8::gemm_phase<pg8::EpiInProj, pg8::StaticOrder, false>(F.lds, g, S, E, STAG_INPROJ);
        }
        SEAM(pb + 0);
        if (EN(1) && IN(pb + 1) && !(zpass && ((ZSKIP >> 1) & 1))) for (int rep = 0; rep < REPS(1); ++rep) { PH_BEGIN;
            for (int u = F.vcu; u < NB * NCH; u += F.G) {
#ifndef NO_ATTN
#ifdef REP1_NO_ATTN
                if (rep == 0)
#endif
                attn_unit(F, u / NCH, u % NCH, A.in[I_RELB] + (size_t)l * AH * RELN);
#endif
#ifndef NO_GLA1
#ifdef REP1_NO_GLA
                if (rep == 0)
#endif
                gla_dstate_unit(F, u / NCH, u % NCH, (const bf16_t*)(wb + OFF_WGD), A.in[I_WGUP] + (size_t)l * GR * 256, A.in[I_BG] + (size_t)l * 256);
#endif
            }
        }
        SEAM(pb + 1);
        if (EN(2) && IN(pb + 2) && !(zpass && ((ZSKIP >> 2) & 1))) for (int rep = 0; rep < REPS(2); ++rep) { PH_BEGIN; gla_scan_phase(F); }
        SEAM(pb + 2);
        if (EN(3) && IN(pb + 3) && !(zpass && ((ZSKIP >> 3) & 1))) for (int rep = 0; rep < REPS(3); ++rep) { PH_BEGIN; for (int u = F.vcu; u < NB * NCH; u += F.G) gla_out_unit(F, u / NCH, u % NCH, A.in[I_GNORM] + (size_t)l * 512); }
        SEAM(pb + 3);
        if (EN(4) && IN(pb + 4) && !(zpass && ((ZSKIP >> 4) & 1))) for (int rep = 0; rep < REPS(4); ++rep) { PH_BEGIN;
            pg8::StaticOrder S; S.init(T, D, F.G, (int)blockIdx.x);
            { pg8::Gemm g{(const bf16_t*)(ws + WS_YA), (const bf16_t*)(wb + OFF_WBA), 512, 0, nullptr}; pg8::EpiEw<1> E{(bf16_t*)(ws + WS_MERGED), (const bf16_t*)(ws + WS_SGA), D, wt};
              pg8::gemm_phase<pg8::EpiEw<1>, pg8::StaticOrder, false>(F.lds, g, S, E); }
            { pg8::Gemm g{(const bf16_t*)(ws + WS_YB), (const bf16_t*)(wb + OFF_WBB), 512, 0, nullptr}; pg8::EpiEw<2> E{(bf16_t*)(ws + WS_MERGED), (const bf16_t*)(ws + WS_SGB), D, wt};
              pg8::gemm_phase<pg8::EpiEw<2>, pg8::StaticOrder, false>(F.lds, g, S, E); }
        }
        SEAM(pb + 4);
        if (EN(5) && IN(pb + 5) && !(zpass && ((ZSKIP >> 5) & 1))) for (int rep = 0; rep < REPS(5); ++rep) { PH_BEGIN;
            pg8::StaticOrder S; S.init(T, D, F.G, (int)blockIdx.x);
            pg8::Gemm g{(const bf16_t*)(ws + WS_MERGED), (const bf16_t*)(wb + OFF_WOUT), D, 0, nullptr}; pg8::EpiEw<0> E{Y, nullptr, D, wt};
            pg8::gemm_phase<pg8::EpiEw<0>, pg8::StaticOrder, false>(F.lds, g, S, E);
        }
        SEAM(pb + 5);
        if (EN(6) && IN(pb + 6) && !(zpass && ((ZSKIP >> 6) & 1))) for (int rep = 0; rep < ((l == 0) ? REPS(6) : 1); ++rep) { PH_BEGIN;
            if (l == 0) thin_phase<1, 1, false>(F, (LAYERREP == 0 && REPS(6) == 1) ? A.in[I_X] : nullptr, Y, (zpass || rep + 1 < REPS(6)) ? ZEROG : A.in[I_NMPOST] + (size_t)l * D, A.in[I_NFPRE] + (size_t)l * D, hb, nullptr);
            else        thin_phase<1, 1, true>(F, nullptr, Y, A.in[I_NMPOST] + (size_t)l * D, A.in[I_NFPRE] + (size_t)l * D, hb, A.in[I_RW]);
        }
        SEAM(pb + 6);
        if (EN(7) && IN(pb + 7) && !(zpass && ((ZSKIP >> 7) & 1))) for (int rep = 0; rep < REPS(7); ++rep) { PH_BEGIN;
            if (l == 0) { pg8::StaticOrder S; S.init(T, 2 * DFF, F.G, (int)blockIdx.x);
                pg8::Gemm g{hb, (const bf16_t*)(wb + OFF_FFN), D, 0, nullptr}; pg8::EpiGateUp E{(bf16_t*)(ws + WS_FACT), DFF, wt, FFN0_ACT_QS};
                pg8::gemm_phase<pg8::EpiGateUp, pg8::StaticOrder, false>(F.lds, g, S, E);
            } else { pg8::GroupedOrder S; S.init((const unsigned*)(F.ctl + CW_CNT), 2 * DFE, F.G, (int)blockIdx.x);
#if MOE_FP8
                pg8::Gemm g{hb, (const bf16_t*)(wb + OFF_FFN), D / 2, (size_t)2 * DFE * D / 2, (const int*)(ws + WS_IDXE), D / 2}; pg8::EpiGateUp8 E{ws + WS_MACT, DFE, wt, 1.f / W8_SCALE, ACT8_SCALE};
#ifdef SPLIT_GU
                S.i1 = SPLIT_GU; pg8::gemm_phase<pg8::EpiGateUp8, pg8::GroupedOrder, true, true>(F.lds, g, S, E);
                xcd_barrier(bar);
                S.i0 = SPLIT_GU; S.i1 = 1 << 30;
#endif
                pg8::gemm_phase<pg8::EpiGateUp8, pg8::GroupedOrder, true, true>(F.lds, g, S, E);
#else
                pg8::Gemm g{hb, (const bf16_t*)(wb + OFF_FFN), D, (size_t)2 * DFE * D, (const int*)(ws + WS_IDXE)}; pg8::EpiGateUp E{(bf16_t*)(ws + WS_MACT), DFE, wt, MOE_ACT_QS};
                pg8::gemm_phase<pg8::EpiGateUp, pg8::GroupedOrder, true>(F.lds, g, S, E);
#endif
            }
        }
        SEAM(pb + 7);
        if (EN(8) && IN(pb + 8) && !(zpass && ((ZSKIP >> 8) & 1))) for (int rep = 0; rep < REPS(8); ++rep) { PH_BEGIN;
            if (l == 0) { pg8::StaticOrder S; S.init(T, D, F.G, (int)blockIdx.x);
                pg8::Gemm g{(const bf16_t*)(ws + WS_FACT), (const bf16_t*)(wb + OFF_FDN), DFF, 0, nullptr}; pg8::EpiEw<0> E{Y, nullptr, D, wt};
                pg8::gemm_phase<pg8::EpiEw<0>, pg8::StaticOrder, false>(F.lds, g, S, E);
            } else {
#if MOE_FP8
                constexpr float dsc = 1.f / (W8_SCALE * ACT8_SCALE);
                { pg8::GroupedOrder S; S.init((const unsigned*)(F.ctl + CW_CNT), D, F.G, (int)blockIdx.x, MOE_MAIN_PANELS);
                  pg8::Gemm g{(const bf16_t*)(ws + WS_MACT), (const bf16_t*)(wb + OFF_MDN8), DFE / 2, (size_t)D * DFE / 2, nullptr}; pg8::EpiEw<0> E{(bf16_t*)(ws + WS_YSLOT), nullptr, D, wt, dsc};
                  pg8::gemm_phase<pg8::EpiEw<0>, pg8::GroupedOrder, false, true>(F.lds, g, S, E); }
                { pg8::TailOrder S; S.init((const unsigned*)(F.ctl + CW_CNT), D, F.G, (int)blockIdx.x, MOE_MAIN_PANELS, TAIL_KC, TAIL_KCH);
                  pg8::Gemm g{(const bf16_t*)(ws + WS_MACT), (const bf16_t*)(wb + OFF_MDN8), TAIL_KCH, (size_t)D * DFE / 2, nullptr, DFE / 2}; pg8::EpiPart E{(bf16_t*)(ws + WS_PBUF), D, MOE_MAIN_PANELS, TAIL_KCH, (size_t)TAIL_ROWS * D, wt, dsc};
                  pg8::gemm_phase<pg8::EpiPart, pg8::TailOrder, false, true>(F.lds, g, S, E); }
#else
                { pg8::GroupedOrder S; S.init((const unsigned*)(F.ctl + CW_CNT), D, F.G, (int)blockIdx.x, MOE_MAIN_PANELS);
                  pg8::Gemm g{(const bf16_t*)(ws + WS_MACT), (const bf16_t*)(wb + OFF_MDN), DFE, (size_t)D * DFE, nullptr}; pg8::EpiEw<0> E{(bf16_t*)(ws + WS_YSLOT), nullptr, D, wt};
                  pg8::gemm_phase<pg8::EpiEw<0>, pg8::GroupedOrder, false>(F.lds, g, S, E); }
                { pg8::TailOrder S; S.init((const unsigned*)(F.ctl + CW_CNT), D, F.G, (int)blockIdx.x, MOE_MAIN_PANELS, TAIL_KC, TAIL_KCH);
                  pg8::Gemm g{(const bf16_t*)(ws + WS_MACT), (const bf16_t*)(wb + OFF_MDN), TAIL_KCH, (size_t)D * DFE, nullptr, DFE}; pg8::EpiPart E{(bf16_t*)(ws + WS_PBUF), D, MOE_MAIN_PANELS, TAIL_KCH, (size_t)TAIL_ROWS * D, wt};
                  pg8::gemm_phase<pg8::EpiPart, pg8::TailOrder, false>(F.lds, g, S, E); }
#endif
            }
        }
        SEAM(pb + 8);
        if (EN(9) && IN(pb + 9) && !(zpass && ((ZSKIP >> 9) & 1))) for (int rep = 0; rep < REPS(9); ++rep) { PH_BEGIN;
            if (l == 0) thin_phase<1, 2, false>(F, nullptr, Y, (zpass || rep + 1 < REPS(9)) ? ZEROG : A.in[I_NFPOST] + (size_t)l * D, nullptr, nullptr, nullptr);
            else        thin_phase<2, 2, false>(F, nullptr, (const bf16_t*)(ws + WS_YSLOT), (zpass || rep + 1 < REPS(9)) ? ZEROG : A.in[I_NFPOST] + (size_t)l * D, nullptr, nullptr, nullptr);
        }
        SEAM(pb + 9);
        if (EN(10) && IN(pb + 10) && !(zpass && ((ZSKIP >> 10) & 1))) for (int rep = 0; rep < REPS(10); ++rep) { PH_BEGIN;
            pg8::StaticOrder S; S.init(T, D, F.G, (int)blockIdx.x);
            if (MK_DBG == 0 || A.sub != 2) { pg8::Gemm g{(const bf16_t*)(ws + WS_XS), (const bf16_t*)(wb + OFF_WPG), D, 0, nullptr}; pg8::EpiEw<PLE_MODE1> E{Y, nullptr, D, wt};
              pg8::gemm_phase<pg8::EpiEw<PLE_MODE1>, pg8::StaticOrder, false>(F.lds, g, S, E); }
            if (MK_DBG == 0 || A.sub != 1) { pg8::Gemm g{(const bf16_t*)(ws + WS_PB) + (size_t)l * T * PLE, (const bf16_t*)(wb + OFF_WPP), PLE, 0, nullptr}; pg8::EpiEw<4> E{Y, nullptr, D, wt};
              pg8::gemm_phase<pg8::EpiEw<4>, pg8::StaticOrder, false>(F.lds, g, S, E); }
        }
        SEAM(pb + 10);
        if (EN(11) && IN(pb + 11) && !(zpass && ((ZSKIP >> 11) & 1))) for (int rep = 0; rep < REPS(11); ++rep) { PH_BEGIN;
            if (l + 1 < DEPTH) thin_phase<1, 1, false>(F, nullptr, Y, (zpass || rep + 1 < REPS(11)) ? ZEROG : A.in[I_PNORM] + (size_t)l * D, A.in[I_NMPRE] + (size_t)(zpass ? 0 : l + 1) * D, hb, nullptr);
            else               thin_phase<1, 0, false>(F, nullptr, Y, (zpass || rep + 1 < REPS(11)) ? ZEROG : A.in[I_PNORM] + (size_t)l * D, nullptr, nullptr, nullptr);
        }
        SEAM(pb + 11);
    }
#if MK_STAMP
    {
        xcd_barrier(bar);
        const unsigned long long* st = (const unsigned long long*)(ws + WS_CTL + 786432);
        LAS float* res = (LAS float*)(F.lds);
        if (F.tid < N_PHASES) { const int k = F.tid; unsigned long long mx = 0, mxp = 0; double sum = 0.0;
            for (int g = 0; g < F.G; ++g) { const unsigned long long t = st[k * 256 + g]; mx = t > mx ? t : mx; sum += (double)t; if (k > 0) { const unsigned long long tp = st[(k - 1) * 256 + g]; mxp = tp > mxp ? tp : mxp; } }
            if (k == 0) { mxp = ~0ull; for (int g = 0; g < F.G; ++g) { const unsigned long long t = st[g]; mxp = t < mxp ? t : mxp; } mxp -= 0; }
            res[k] = (float)((double)(mx - mxp) * 0.01); res[32 + k] = (float)(((double)mx - sum / F.G) * 0.01); }
        __syncthreads();
        float t1, t2;
        if (STAMP_SEL < 0) { t1 = 0.f; t2 = 0.f; for (int k = 1; k < N_PHASES; ++k) { t1 += res[32 + k]; t2 += res[k]; } }
        else { t1 = res[STAMP_SEL]; t2 = res[32 + STAMP_SEL]; }
        const float A = 300.f * t1 + 1000.f, B = 10.f * t2 + 20.f;
        for (size_t i = (size_t)blockIdx.x * NTHR + F.tid; i < (size_t)T * D; i += (size_t)F.G * NTHR) args.out[i] = (i == 0) ? A : B;
    }
#endif
#undef IN
#undef SEAM
}
#ifndef MK_DBG
#define MK_DBG 0
#endif
#if MK_DBG
#ifndef MK_DBG_SHOW
#define MK_DBG_SHOW -1
#endif
constexpr size_t WS_SNAP = 512 * 1024;
__device__ __forceinline__ unsigned dh(unsigned x) { x ^= x >> 16; x *= 0x7feb352du; x ^= x >> 15; x *= 0x846ca68bu; x ^= x >> 16; return x; }
__device__ __forceinline__ void dbg_acc(float* dbg, int stage, float d2, float e2, int lane) { d2 = wave_sum(d2); e2 = wave_sum(e2); if (lane == 0) { atomicAdd(dbg + 2 * stage, d2); atomicAdd(dbg + 2 * stage + 1, e2); } }
__device__ __forceinline__ float ddot(const bf16_t* arow, const float* W, int K, int pitch, int col, int lane) { float s = 0.f; for (int k = lane; k < K; k += 64) s += bf2f(arow[k]) * W[(size_t)k * pitch + col]; return wave_sum(s); }
__device__ __forceinline__ float dsig(float v) { return 1.f / (1.f + expf(-v)); }
__device__ __forceinline__ int dbg_pbase(const unsigned* gcnt, int e) { int acc = 0; for (int q = 0; q < 8; ++q) if (q < e) acc += (((int)gcnt[q] + 255) >> 8) << 8; return acc; }
__device__ __forceinline__ float dbg_moe_el(const unsigned char* ws, int s, int k) { if (s < MOE_MAIN_ROWS) return bf2f(((const bf16_t*)(ws + WS_YSLOT))[(size_t)s * D + k]); float a = 0.f; for (int kc = 0; kc < TAIL_KC; ++kc) a += bf2f(((const bf16_t*)(ws + WS_PBUF))[((size_t)kc * TAIL_ROWS + (s - MOE_MAIN_ROWS)) * D + k]); return a; }
__device__ __forceinline__ float dbg_f8(const unsigned char* p, size_t i) { return __builtin_amdgcn_cvt_f32_fp8((int)p[i], 0); }
__device__ __forceinline__ float ddot8(const unsigned char* arow, float ascale, const float* W, int K, int pitch, int col, int lane) { float s = 0.f; for (int k = lane; k < K; k += 64) s += dbg_f8(arow, k) * ascale * W[(size_t)k * pitch + col]; return wave_sum(s); }
#define DBGP float* dbg = (float*)(a.ws + WS_CTL) + CW_DBG; const int lane = threadIdx.x & 63; const unsigned sid = blockIdx.x; (void)sid

__global__ void dbg_t1(Args a, int stage) { DBGP;
    const int r = dh(sid * 3 + 1) % T; const float* x = a.in[I_X] + (size_t)r * D; const bf16_t* hb = (const bf16_t*)(a.ws + WS_HB) + (size_t)r * D;
    float ss = 0.f; for (int k = lane; k < D; k += 64) ss += x[k] * x[k]; ss = wave_sum(ss); const float rstd = 1.f / sqrtf(ss / D + EPS);
    float d2 = 0.f, e2 = 0.f; for (int k = lane; k < D; k += 64) { const float e = x[k] * rstd * a.in[I_NMPRE][k], g = bf2f(hb[k]); d2 += (g - e) * (g - e); e2 += e * e; }
    dbg_acc(dbg, stage, d2, e2, lane); }

__global__ void dbg_gemm(Args a, int kind, int l, int stage) { DBGP;
    unsigned char* ws = a.ws; const unsigned h1 = dh(sid * 7 + 1), h2 = dh(sid * 7 + 2), h3 = dh(sid * 7 + 3);
    const bf16_t* hb = (const bf16_t*)(ws + WS_HB); float e = 0.f, g = 0.f;
    const unsigned* gcnt = (const unsigned*)(ws + WS_CTL) + CW_CNT;
    if (kind == 1) { const int row = h1 % T, col = h2 % INWG, sc = col < 2560 ? col : col + 16; const float v = ddot(hb + (size_t)row * D, a.in[I_WIN] + (size_t)l * D * INW, D, INW, sc, lane);
        const bf16_t* P = (const bf16_t*)(ws + WS_PROJ);
        if (col < 512) { e = v * pg8::QA_SCALE; g = bf2f(((const bf16_t*)(ws + WS_QA))[(size_t)row * 512 + col]); }
        else if (col < 1024) { e = v; g = bf2f(((const bf16_t*)(ws + WS_KA))[(size_t)row * 512 + col - 512]); }
        else if (col < 1536) { e = v; g = bf2f(((const bf16_t*)(ws + WS_VA))[(size_t)row * 512 + col - 1024]); }
        else if (col < 1792) { e = v * 0.125f; g = bf2f(((const bf16_t*)(ws + WS_QB))[(size_t)row * 256 + col - 1536]); }
        else if (col < 2048) { e = v; g = bf2f(((const bf16_t*)(ws + WS_KB))[(size_t)row * 256 + col - 1792]); }
        else if (col < 2560) { e = v; g = bf2f(((const bf16_t*)(ws + WS_VB))[(size_t)row * 512 + col - 2048]); }
        else if (col < 3072) { e = v * dsig(v); g = bf2f(((const bf16_t*)(ws + WS_SR))[(size_t)row * 512 + col - 2560]); }
        else if (col < 4096) { e = dsig(v); g = bf2f(((const bf16_t*)(ws + WS_SGA))[(size_t)row * 1024 + col - 3072]); }
        else { e = dsig(v); g = bf2f(((const bf16_t*)(ws + WS_SGB))[(size_t)row * 1024 + col - 4096]); } (void)P;
    } else if (kind == 2) { const int row = h1 % T, col = h2 % D;
        const float va = ddot((const bf16_t*)(ws + WS_YA) + (size_t)row * 512, a.in[I_WBA] + (size_t)l * 512 * D, 512, D, col, lane), vb = ddot((const bf16_t*)(ws + WS_YB) + (size_t)row * 512, a.in[I_WBB] + (size_t)l * 512 * D, 512, D, col, lane);
        e = bf2f(((const bf16_t*)(ws + WS_SGA))[(size_t)row * D + col]) * va + bf2f(((const bf16_t*)(ws + WS_SGB))[(size_t)row * D + col]) * vb; g = bf2f(((const bf16_t*)(ws + WS_MERGED))[(size_t)row * D + col]);
    } else if (kind == 3) { const int row = h1 % T, col = h2 % D; e = ddot((const bf16_t*)(ws + WS_MERGED) + (size_t)row * D, a.in[I_WOUT] + (size_t)l * D * D, D, D, col, lane); g = bf2f(((const bf16_t*)(ws + WS_Y))[(size_t)row * D + col]);
    } else if (kind == 4) { const int row = h1 % T, c = h2 % DFF; const float vg = ddot(hb + (size_t)row * D, a.in[I_FG], D, DFF, c, lane), vu = ddot(hb + (size_t)row * D, a.in[I_FU], D, DFF, c, lane);
        e = vg * dsig(vg) * vu; g = bf2f(((const bf16_t*)(ws + WS_FACT))[(size_t)row * DFF + c]);
    } else if (kind == 5) { const int row = h1 % T, col = h2 % D; e = ddot((const bf16_t*)(ws + WS_FACT) + (size_t)row * DFF, a.in[I_FD], DFF, D, col, lane); g = bf2f(((const bf16_t*)(ws + WS_Y))[(size_t)row * D + col]);
    } else if (kind == 6 || kind == 7) { const int ex = h1 % NE; const int pbase = dbg_pbase(gcnt, ex); const int cnt = (int)gcnt[ex];
        if (cnt == 0) return; const int i = h2 % cnt, tok = ((const int*)(ws + WS_IDXE))[ex * 16384 + i], row = pbase + i;
#if MOE_FP8
        const unsigned char* hb8 = ws + WS_HB; const unsigned char* act8 = ws + WS_MACT;
        if (kind == 6) { const int c = h3 % DFE; const float vg = ddot8(hb8 + (size_t)tok * D, 1.f, a.in[I_MG] + (size_t)ex * D * DFE, D, DFE, c, lane), vu = ddot8(hb8 + (size_t)tok * D, 1.f, a.in[I_MU] + (size_t)ex * D * DFE, D, DFE, c, lane);
            e = vg * dsig(vg) * vu; g = dbg_f8(act8, (size_t)row * DFE + c) * (1.f / ACT8_SCALE); }
        else { const int col = h3 % D; e = ddot8(act8 + (size_t)row * DFE, 1.f / ACT8_SCALE, a.in[I_MD] + (size_t)ex * DFE * D, DFE, D, col, lane); g = dbg_moe_el(ws, row, col); }
#else
        if (kind == 6) { const int c = h3 % DFE; const float vg = ddot(hb + (size_t)tok * D, a.in[I_MG] + (size_t)ex * D * DFE, D, DFE, c, lane), vu = ddot(hb + (size_t)tok * D, a.in[I_MU] + (size_t)ex * D * DFE, D, DFE, c, lane);
            e = vg * dsig(vg) * vu; g = bf2f(((const bf16_t*)(ws + WS_MACT))[(size_t)row * DFE + c]); }
        else { const int col = h3 % D; e = ddot((const bf16_t*)(ws + WS_MACT) + (size_t)row * DFE, a.in[I_MD] + (size_t)ex * DFE * D, DFE, D, col, lane); g = dbg_moe_el(ws, row, col); }
#endif
    } else if (kind == 12) { const int row = h1 % T, col = h2 % D; e = a.out[(size_t)row * D + col]; g = bf2f(((const bf16_t*)(ws + WS_XS))[(size_t)row * D + col]);
    } else if (kind == 13) { const int row = h1 % T, col = h2 % D; e = ddot((const bf16_t*)(ws + WS_XS) + (size_t)row * D, a.in[I_PG] + (size_t)l * D * D, D, D, col, lane); g = bf2f(((const bf16_t*)(ws + WS_Y))[(size_t)row * D + col]);
    } else if (kind == 11) { const int n = h1 % D, k = h2 % D; e = a.in[I_PG][(size_t)l * D * D + (size_t)k * D + n]; g = bf2f(((const bf16_t*)(ws + (l ? WS_W1 : WS_W0) + OFF_WPG))[(size_t)n * D + k]);
    } else if (kind == 9) { const int row = h1 % T, col = h2 % D; e = dsig(ddot((const bf16_t*)(ws + WS_XS) + (size_t)row * D, a.in[I_PG] + (size_t)l * D * D, D, D, col, lane)); g = bf2f(((const bf16_t*)(ws + WS_Y))[(size_t)row * D + col]);
    } else { const int row = h1 % T, col = h2 % D; const float vg = ddot((const bf16_t*)(ws + WS_XS) + (size_t)row * D, a.in[I_PG] + (size_t)l * D * D, D, D, col, lane), vp = ddot((const bf16_t*)(ws + WS_PB) + ((size_t)l * T + row) * PLE, a.in[I_PP] + (size_t)l * PLE * D, PLE, D, col, lane);
        e = dsig(vg) * vp; g = bf2f(((const bf16_t*)(ws + WS_Y))[(size_t)row * D + col]); }
    if (lane == 0) { atomicAdd(dbg + 2 * stage, (g - e) * (g - e)); atomicAdd(dbg + 2 * stage + 1, e * e); } }

__global__ void dbg_attn(Args a, int l, int stage) { DBGP;
    unsigned char* ws = a.ws; const unsigned h1 = dh(sid * 5 + 1); const int tok = h1 % T, h = dh(sid * 5 + 2) % AH, b = tok / SEQ, c = (tok % SEQ) / CH, ql = tok % CH;
    const bf16_t* hb = (const bf16_t*)(ws + WS_HB) + (size_t)tok * D; const float* win = a.in[I_WIN] + (size_t)l * D * INW;
    float q = 0.f; for (int k = 0; k < D; ++k) q += bf2f(hb[k]) * win[(size_t)k * INW + h * 64 + lane]; q *= pg8::QA_SCALE;
    const bf16_t* ka = (const bf16_t*)(ws + WS_KA); const bf16_t* va = (const bf16_t*)(ws + WS_VA); const float* rb = a.in[I_RELB] + ((size_t)l * AH + h) * RELN;
    float m = -1e30f, ls = 0.f, o = 0.f;
    for (int kc = (c - 8 > 0 ? c - 8 : 0); kc <= c; ++kc) for (int kl = 0; kl < CH; ++kl) { const int kt = b * SEQ + kc * CH + kl; int dist = (c - kc) * 64 + ql - kl; dist = dist > 128 ? 128 : (dist < -128 ? -128 : dist);
        const float s = wave_sum(q * bf2f(ka[(size_t)kt * 512 + h * 64 + lane])) + rb[dist + 128] * LOG2E; const float mn = fmaxf(m, s), al = exp2f(m - mn), p = exp2f(s - mn); m = mn; ls = ls * al + p; o = o * al + p * bf2f(va[(size_t)kt * 512 + h * 64 + lane]); }
    const float e = o / ls, g = bf2f(((const bf16_t*)(ws + WS_YA))[(size_t)tok * 512 + h * 64 + lane]);
    dbg_acc(dbg, stage, (g - e) * (g - e), e * e, lane); }

__global__ void dbg_dstate(Args a, int l, int stage) { DBGP;
    unsigned char* ws = a.ws; const int b = dh(sid * 5 + 1) % NB, c = dh(sid * 5 + 2) % NCH, hh = dh(sid * 5 + 3) % BH, v = dh(sid * 5 + 4) % 128, k = dh(sid * 5 + 5) % 64, col = hh * 64 + k;
    const int tok = b * SEQ + c * CH + lane; const bf16_t* hb = (const bf16_t*)(ws + WS_HB) + (size_t)tok * D; const float* win = a.in[I_WIN] + (size_t)l * D * INW;
    float z = a.in[I_BG][l * 256 + col];
    for (int r = 0; r < GR; ++r) { float gd = 0.f; for (int kk = 0; kk < D; ++kk) gd += bf2f(hb[kk]) * win[(size_t)kk * INW + 2560 + r]; z += gd * a.in[I_WGUP][((size_t)l * GR + r) * 256 + col]; }
    const float la = (fminf(z, 0.f) - log1pf(expf(-fabsf(z)))) / 16.f; float cum = la;
    for (int o = 1; o < 64; o <<= 1) { const float t = __shfl_up(cum, o); if (lane >= o) cum += t; }
    const float tot = __shfl(cum, 63);
    const float kd = bf2f(((const bf16_t*)(ws + WS_KB))[(size_t)tok * 256 + col]) * expf(tot - cum);
    const float e = wave_sum(kd * bf2f(((const bf16_t*)(ws + WS_VB))[(size_t)tok * 512 + hh * 128 + v]));
    const float g = ((const float*)(ws + WS_DST))[((size_t)((b * NCH + c) * BH + hh) * 128 + v) * 64 + k];
    const float ed = expf(tot), gdc = ((const float*)(ws + WS_DEC))[(size_t)(b * NCH + c) * 256 + col];
    if (lane == 0) { atomicAdd(dbg + 2 * stage, (g - e) * (g - e) + (gdc - ed) * (gdc - ed)); atomicAdd(dbg + 2 * stage + 1, e * e + ed * ed); } }

__global__ void dbg_scan(Args a, int stage) { DBGP;
    unsigned char* ws = a.ws; const unsigned s0 = sid * 64 + lane; const int b = dh(s0 * 5 + 1) % NB, c = dh(s0 * 5 + 2) % NCH, hh = dh(s0 * 5 + 3) % BH, v = dh(s0 * 5 + 4) % 128, k = dh(s0 * 5 + 5) % 64;
    float s = 0.f; for (int cc = 0; cc <= c; ++cc) s = ((const float*)(ws + WS_DEC))[(size_t)(b * NCH + cc) * 256 + hh * 64 + k] * s + ((const float*)(ws + WS_DST))[((size_t)((b * NCH + cc) * BH + hh) * 128 + v) * 64 + k];
    const float g = bf2f(((const bf16_t*)(ws + WS_ST))[((size_t)((b * NCH + c) * BH + hh) * 128 + v) * 64 + k]);
    dbg_acc(dbg, stage, (g - s) * (g - s), s * s, lane); }

__global__ void dbg_glaout(Args a, int l, int stage) { DBGP;
    unsigned char* ws = a.ws; const int tok = dh(sid * 3 + 1) % T, hh = dh(sid * 3 + 2) % BH, b = tok / SEQ, c = (tok % SEQ) / CH;
    const bf16_t* st = (const bf16_t*)(ws + WS_ST) + ((size_t)((b * NCH + c) * BH + hh) * 128) * 64; const bf16_t* qb = (const bf16_t*)(ws + WS_QB) + (size_t)tok * 256 + hh * 64;
    const bf16_t* hb = (const bf16_t*)(ws + WS_HB) + (size_t)tok * D; const float* win = a.in[I_WIN] + (size_t)l * D * INW;
    float o[2], r[2];
#pragma unroll
    for (int j = 0; j < 2; ++j) { const int v = lane + 64 * j; float s = 0.f; for (int k = 0; k < 64; ++k) s += bf2f(qb[k]) * bf2f(st[(size_t)v * 64 + k]); o[j] = s;
        float rr = 0.f; for (int kk = 0; kk < D; ++kk) rr += bf2f(hb[kk]) * win[(size_t)kk * INW + 2576 + hh * 128 + v]; r[j] = rr * dsig(rr); }
    const float ss = wave_sum(o[0] * o[0] + o[1] * o[1]), rstd = 1.f / sqrtf(ss / 128.f + EPS); float d2 = 0.f, e2 = 0.f;
#pragma unroll
    for (int j = 0; j < 2; ++j) { const int v = lane + 64 * j; const float e = o[j] * rstd * a.in[I_GNORM][l * 512 + hh * 128 + v] * r[j], g = bf2f(((const bf16_t*)(ws + WS_YB))[(size_t)tok * 512 + hh * 128 + v]); d2 += (g - e) * (g - e); e2 += e * e; }
    dbg_acc(dbg, stage, d2, e2, lane); }

__device__ __forceinline__ int dbg_row(unsigned i) { return (int)((i * 257u + 11u) % T); }
__global__ void dbg_snap(Args a, int from_in) { const int i = blockIdx.x, r = dbg_row(i); float* snap = (float*)(a.ws + WS_SNAP) + (size_t)i * D; const bf16_t* xs = (const bf16_t*)(a.ws + WS_XS); for (int k = threadIdx.x; k < D; k += 64) snap[k] = from_in ? a.in[I_X][(size_t)r * D + k] : bf2f(xs[(size_t)r * D + k]); }
__global__ void dbg_thin(Args a, int src, int outk, int route, const float* g_add, const float* g_out, const bf16_t* obuf, int st_x, int st_o, int st_r) { DBGP;
    unsigned char* ws = a.ws; const int i = sid, r = dbg_row(i); const float* snap = (const float*)(ws + WS_SNAP) + (size_t)i * D;
    const unsigned* gcnt = (const unsigned*)(ws + WS_CTL) + CW_CNT; const unsigned* ti = (const unsigned*)(ws + WS_TOKINFO) + (size_t)r * 8;
    float y[16], xn[16]; float ss = 0.f;
#pragma unroll
    for (int j = 0; j < 16; ++j) { const int k = lane + 64 * j; float v;
        if (src == 1) v = bf2f(((const bf16_t*)(ws + WS_Y))[(size_t)r * D + k]);
        else { v = __uint_as_float(ti[4]) * dbg_moe_el(ws, dbg_pbase(gcnt, (int)ti[0]) + (int)ti[1], k) + __uint_as_float(ti[5]) * dbg_moe_el(ws, dbg_pbase(gcnt, (int)ti[2]) + (int)ti[3], k); }
        y[j] = v; ss += v * v; }
    ss = wave_sum(ss); const float rstd = 1.f / sqrtf(ss / D + EPS); float d2 = 0.f, e2 = 0.f, s2 = 0.f;
#pragma unroll
    for (int j = 0; j < 16; ++j) { const int k = lane + 64 * j; xn[j] = snap[k] + y[j] * rstd * g_add[k]; const float g = (outk == 0) ? a.out[(size_t)r * D + k] : bf2f(((const bf16_t*)(ws + WS_XS))[(size_t)r * D + k]); d2 += (g - xn[j]) * (g - xn[j]); e2 += xn[j] * xn[j]; s2 += xn[j] * xn[j]; }
    dbg_acc(dbg, st_x, d2, e2, lane);
    if (outk != 1) return;
    s2 = wave_sum(s2); const float rs2 = 1.f / sqrtf(s2 / D + EPS); d2 = 0.f; e2 = 0.f; float hn[16];
#pragma unroll
    for (int j = 0; j < 16; ++j) { const int k = lane + 64 * j; hn[j] = (outk == 1) ? xn[j] * rs2 * g_out[k] : xn[j]; const float g = (MOE_FP8 && route) ? dbg_f8((const unsigned char*)obuf, (size_t)r * D + k) : bf2f(obuf[(size_t)r * D + k]); d2 += (g - hn[j]) * (g - hn[j]); e2 += hn[j] * hn[j]; }
    dbg_acc(dbg, st_o, d2, e2, lane);
    if (!route) return;
    float lg[8];
#pragma unroll
    for (int e = 0; e < 8; ++e) { float s = 0.f;
#pragma unroll
        for (int j = 0; j < 16; ++j) s += hn[j] * a.in[I_RW][(size_t)(lane + 64 * j) * NE + e]; lg[e] = wave_sum(s); }
    int e1 = 0; float v1 = lg[0];
#pragma unroll
    for (int e = 1; e < 8; ++e) if (lg[e] > v1) { v1 = lg[e]; e1 = e; }
    int e2i = -1; float v2 = -3.0e38f;
#pragma unroll
    for (int e = 0; e < 8; ++e) if (e != e1 && lg[e] > v2) { v2 = lg[e]; e2i = e; }
    const float ex = expf(v2 - v1), w1 = 1.f / (1.f + ex);
    float bad = 0.f; if ((int)ti[0] != e1 || (int)ti[2] != e2i) bad = 1.f; else { bad = fabsf(__uint_as_float(ti[4]) - w1) + fabsf(__uint_as_float(ti[5]) - (1.f - w1));
        const int* idxe = (const int*)(ws + WS_IDXE); if (ti[1] >= gcnt[e1] || ti[3] >= gcnt[e2i] || idxe[e1 * 16384 + ti[1]] != r || idxe[e2i * 16384 + ti[3]] != r) bad = 1.f; }
    if (lane == 0) { atomicAdd(dbg + 2 * st_r, bad * bad); atomicAdd(dbg + 2 * st_r + 1, 1.f); } }

__global__ void dbg_report(Args a) {
    const float* dbg = (const float*)(a.ws + WS_CTL) + CW_DBG; int bad = -1; float errk = 0.f;
    for (int k = 0; k < 33; ++k) { const float d2 = dbg[2 * k], e2 = dbg[2 * k + 1]; if (d2 == 0.f && e2 == 0.f) continue; const float err = d2 / e2; if (MK_DBG_SHOW == k) errk = (err == err) ? err : 1e6f; const float thr = (MOE_FP8 && (k == 25 || k == 27 || k == 28)) ? 3e-2f : 1e-3f; if (bad < 0 && !(err < thr)) bad = k; }
    float V = 0.f; bool fill = false;
    if (MK_DBG_SHOW >= 0) { V = sqrtf(7.f * 100.f * errk) + 1e-3f; fill = true; } else if (bad >= 0) { V = exp10f(1.f + 0.25f * (float)bad); fill = true; }
    if (fill) for (size_t i = (size_t)blockIdx.x * blockDim.x + threadIdx.x; i < (size_t)T * D; i += (size_t)gridDim.x * blockDim.x) a.out[i] = V; }

static void dbg_run(Args a, int grid, hipStream_t st) {
    auto ph = [&](int p) { a.ph_lo = p; a.ph_hi = p + 1; hipLaunchKernelGGL(fwd, dim3(grid), dim3(NTHR), LDS_BYTES, st, a); };
    const int NS = 2048;
    ph(0); hipLaunchKernelGGL(dbg_t1, dim3(256), dim3(64), 0, st, a, 0);
    for (int l = 0; l < DEPTH; ++l) { const int pb = 1 + 12 * l, sb = 16 * l; const size_t lo = (size_t)l * D;
        ph(pb + 0); hipLaunchKernelGGL(dbg_gemm, dim3(NS), dim3(64), 0, st, a, 1, l, sb + 1);
        ph(pb + 1); hipLaunchKernelGGL(dbg_attn, dim3(512), dim3(64), 0, st, a, l, sb + 2); hipLaunchKernelGGL(dbg_dstate, dim3(256), dim3(64), 0, st, a, l, sb + 3);
        ph(pb + 2); hipLaunchKernelGGL(dbg_scan, dim3(64), dim3(64), 0, st, a, sb + 4);
        ph(pb + 3); hipLaunchKernelGGL(dbg_glaout, dim3(256), dim3(64), 0, st, a, l, sb + 5);
        ph(pb + 4); hipLaunchKernelGGL(dbg_gemm, dim3(NS), dim3(64), 0, st, a, 2, l, sb + 6);
        ph(pb + 5); hipLaunchKernelGGL(dbg_gemm, dim3(NS), dim3(64), 0, st, a, 3, l, sb + 7);
        hipLaunchKernelGGL(dbg_snap, dim3(64), dim3(64), 0, st, a, l == 0 ? 1 : 0);
        ph(pb + 6); hipLaunchKernelGGL(dbg_thin, dim3(64), dim3(64), 0, st, a, 1, 1, l == 1 ? 1 : 0, a.in[I_NMPOST] + lo, a.in[I_NFPRE] + lo, (const bf16_t*)(a.ws + WS_HB), sb + 8, sb + 9, sb + 10);
        ph(pb + 7); hipLaunchKernelGGL(dbg_gemm, dim3(NS), dim3(64), 0, st, a, l == 0 ? 4 : 6, l, sb + 11);
        ph(pb + 8); hipLaunchKernelGGL(dbg_gemm, dim3(NS), dim3(64), 0, st, a, l == 0 ? 5 : 7, l, sb + 12);
        hipLaunchKernelGGL(dbg_snap, dim3(64), dim3(64), 0, st, a, 0);
        ph(pb + 9); hipLaunchKernelGGL(dbg_thin, dim3(64), dim3(64), 0, st, a, l == 0 ? 1 : 2, 2, 0, a.in[I_NFPOST] + lo, (const float*)nullptr, (const bf16_t*)nullptr, sb + 13, sb + 13, 0);
        a.sub = 1; ph(pb + 10); hipLaunchKernelGGL(dbg_gemm, dim3(NS), dim3(64), 0, st, a, 9, l, sb + 14);
        a.sub = 2; ph(pb + 10); a.sub = 0; hipLaunchKernelGGL(dbg_gemm, dim3(NS), dim3(64), 0, st, a, 8, l, sb + 15);
        hipLaunchKernelGGL(dbg_snap, dim3(64), dim3(64), 0, st, a, 0);
        ph(pb + 11); hipLaunchKernelGGL(dbg_thin, dim3(64), dim3(64), 0, st, a, 1, l == 0 ? 1 : 0, 0, a.in[I_PNORM] + lo, l == 0 ? a.in[I_NMPRE] + D : (const float*)nullptr, (const bf16_t*)(a.ws + WS_HB), sb + 16, sb + 16, 0);
    }
    hipLaunchKernelGGL(dbg_report, dim3(1024), dim3(256), 0, st, a);
}
#endif
#ifndef MK_SPLIT
#define MK_SPLIT 0
#endif
#ifndef MK_DBG
#define MK_DBG 0
#endif
extern "C" void kernel_launch(void* const* d_in, const int* in_sizes, int n_in, void* d_out, int out_size, void* d_ws, size_t ws_size, hipStream_t stream) {
    static int grid = 0;
    if (grid == 0) {
        if (n_in != 24 || in_sizes[0] != T * D || out_size != T * D || ws_size < WS_END) { fprintf(stderr, "kernel_launch: unexpected problem (n_in %d, in0 %d, out %d, ws %zu < %zu); nothing launched\n", n_in, n_in > 0 ? in_sizes[0] : -1, out_size, ws_size, (size_t)WS_END); grid = -1; return; }
        int dev = 0, cus = 0, per_cu = 0;
        if (hipGetDevice(&dev) != hipSuccess || hipDeviceGetAttribute(&cus, hipDeviceAttributeMultiprocessorCount, dev) != hipSuccess) { grid = -1; return; }
        if (hipFuncSetAttribute((const void*)fwd, hipFuncAttributeMaxDynamicSharedMemorySize, LDS_BYTES) != hipSuccess) { fprintf(stderr, "kernel_launch: hipFuncSetAttribute failed\n"); grid = -1; return; }
        if (hipOccupancyMaxActiveBlocksPerMultiprocessor(&per_cu, (const void*)fwd, NTHR, LDS_BYTES) != hipSuccess || per_cu < 1) { fprintf(stderr, "kernel_launch: occupancy query says %d blocks per CU\n", per_cu); }
        (void)hipGetLastError();
        grid = cus;
    }
    if (grid < 0) return;
    (void)hipMemsetAsync((char*)d_ws + WS_CTL, 0, CTL_ZERO_BYTES, stream);
    Args a{};
    for (int i = 0; i < 24; ++i) a.in[i] = (const float*)d_in[i];
    a.out = (float*)d_out; a.ws = (unsigned char*)d_ws;
#if MK_DBG
    dbg_run(a, grid, stream);
#elif MK_SPLIT
    for (int p = 0; p < N_PHASES; ++p) { a.ph_lo = p; a.ph_hi = p + 1; hipLaunchKernelGGL(fwd, dim3(grid), dim3(NTHR), LDS_BYTES, stream, a); }
#else
    a.ph_lo = 0; a.ph_hi = N_PHASES;
    hipLaunchKernelGGL(fwd, dim3(grid), dim3(NTHR), LDS_BYTES, stream, a);
#endif
}
```

```cpp
#define TR_NFAST 1
#define THIN_PF 1
#define EPI_PK 1
#define XL_DPP 1
#include <hip/hip_runtime.h>
#include <cstdio>
#include <cstdint>

#define LAS __attribute__((address_space(3)))
#define GAS __attribute__((address_space(1)))
typedef unsigned short bf16_t;
typedef short bf16x8 __attribute__((ext_vector_type(8)));
typedef short s16x4 __attribute__((ext_vector_type(4)));
typedef float f32x4 __attribute__((ext_vector_type(4)));
typedef float f32x2 __attribute__((ext_vector_type(2)));
typedef unsigned u32x4 __attribute__((ext_vector_type(4)));
typedef unsigned u32x2 __attribute__((ext_vector_type(2)));

typedef __bf16 bf16x2_t __attribute__((ext_vector_type(2)));
__device__ __forceinline__ unsigned cvt_pk_bf16(float lo, float hi) { f32x2 v = {lo, hi}; const bf16x2_t b = __builtin_convertvector(v, bf16x2_t); return __builtin_bit_cast(unsigned, b); }
#ifndef WT_STORES
#define WT_STORES 1
#endif
#ifndef WT_AUX
#define WT_AUX 16
#endif
struct WT { __amdgpu_buffer_rsrc_t rs; const char* base; };
__device__ __forceinline__ WT make_wt(void* ws_base, unsigned nbytes) { WT w; w.rs = __builtin_amdgcn_make_buffer_rsrc(ws_base, 0, (int)nbytes, 0x00020000); w.base = (const char*)ws_base; return w; }
__device__ __forceinline__ void st16(const WT& w, void* p, u32x4 v) {
#if WT_STORES
    __builtin_amdgcn_raw_buffer_store_b128(v, w.rs, (int)(unsigned)((const char*)p - w.base), 0, WT_AUX);
#else
    *(u32x4*)p = v;
#endif
}
__device__ __forceinline__ void st8(const WT& w, void* p, u32x2 v) {
#if WT_STORES
    __builtin_amdgcn_raw_buffer_store_b64(v, w.rs, (int)(unsigned)((const char*)p - w.base), 0, WT_AUX);
#else
    *(u32x2*)p = v;
#endif
}
__device__ __forceinline__ float clamp8(float v) { return __builtin_amdgcn_fmed3f(v, -448.f, 448.f); }
__device__ __forceinline__ unsigned pk4_fp8(float a, float b, float c, float d) { int w = __builtin_amdgcn_cvt_pk_fp8_f32(clamp8(a), clamp8(b), 0, false); w = __builtin_amdgcn_cvt_pk_fp8_f32(clamp8(c), clamp8(d), w, true); return (unsigned)w; }
__device__ __forceinline__ float q8(float x, float s) { const int w = __builtin_amdgcn_cvt_pk_fp8_f32(x * s, 0.f, 0, false); return __builtin_amdgcn_cvt_f32_fp8(w, 0) * (1.0f / s); }
__device__ __forceinline__ float bf_lo(unsigned w) { return __uint_as_float(w << 16); }
__device__ __forceinline__ float bf_hi(unsigned w) { return __uint_as_float(w & 0xffff0000u); }
__device__ __forceinline__ float bf2f(bf16_t b) { return __uint_as_float(((unsigned)b) << 16); }
__device__ __forceinline__ float fast_sigmoid(float v) { return __builtin_amdgcn_rcpf(1.0f + __builtin_amdgcn_exp2f(-1.4426950408889634f * v)); }
__device__ __forceinline__ f32x2 lo2(f32x4 v) { return __builtin_shufflevector(v, v, 0, 1); }
__device__ __forceinline__ f32x2 hi2(f32x4 v) { return __builtin_shufflevector(v, v, 2, 3); }
__device__ __forceinline__ f32x4 cat2(f32x2 a, f32x2 b) { return __builtin_shufflevector(a, b, 0, 1, 2, 3); }
__device__ __forceinline__ f32x2 rcp_1p_exp2(f32x2 a) { const f32x2 d = (f32x2){__builtin_amdgcn_exp2f(a.x), __builtin_amdgcn_exp2f(a.y)} + (f32x2){1.0f, 1.0f}; return (f32x2){__builtin_amdgcn_rcpf(d.x), __builtin_amdgcn_rcpf(d.y)}; }
__device__ __forceinline__ f32x2 sigmoid2(f32x2 v) { return rcp_1p_exp2(v * (f32x2){-1.4426950408889634f, -1.4426950408889634f}); }
__device__ __forceinline__ f32x4 sigmoid4(f32x4 v) { return cat2(sigmoid2(lo2(v)), sigmoid2(hi2(v))); }
#ifdef XL_DPP
template <int CTRL> __device__ __forceinline__ float dpp_f(float v) { return __builtin_bit_cast(float, __builtin_amdgcn_update_dpp(0, __builtin_bit_cast(int, v), CTRL, 0xF, 0xF, true)); }
#define XL_SWAP16(v, a, b) do { const auto _r = __builtin_amdgcn_permlane16_swap(__builtin_bit_cast(unsigned, (v)), __builtin_bit_cast(unsigned, (v)), false, false); a = __builtin_bit_cast(float, (unsigned)_r[0]); b = __builtin_bit_cast(float, (unsigned)_r[1]); } while (0)
#define XL_SWAP32(v, a, b) do { const auto _r = __builtin_amdgcn_permlane32_swap(__builtin_bit_cast(unsigned, (v)), __builtin_bit_cast(unsigned, (v)), false, false); a = __builtin_bit_cast(float, (unsigned)_r[0]); b = __builtin_bit_cast(float, (unsigned)_r[1]); } while (0)
__device__ __forceinline__ float sum_x16_x32(float v) { float a, b; XL_SWAP16(v, a, b); v = a + b; XL_SWAP32(v, a, b); return a + b; }
__device__ __forceinline__ float max_x16_x32(float v) { float a, b; XL_SWAP16(v, a, b); v = fmaxf(a, b); XL_SWAP32(v, a, b); return fmaxf(a, b); }
__device__ __forceinline__ float wave_sum(float v) {
    v += dpp_f<0xB1>(v);
    v += dpp_f<0x4E>(v);
    v += dpp_f<0x141>(v);
    v += dpp_f<0x140>(v);
    return sum_x16_x32(v);
}
#else
__device__ __forceinline__ float sum_x16_x32(float v) { v += __shfl_xor(v, 16); v += __shfl_xor(v, 32); return v; }
__device__ __forceinline__ float max_x16_x32(float v) { v = fmaxf(v, __shfl_xor(v, 16)); v = fmaxf(v, __shfl_xor(v, 32)); return v; }
__device__ __forceinline__ float wave_sum(float v) {
#pragma unroll
    for (int o = 1; o < 64; o <<= 1) v += __shfl_xor(v, o);
    return v;
}
#endif

typedef int v8i32 __attribute__((ext_vector_type(8)));
typedef int v4i32 __attribute__((ext_vector_type(4)));
__device__ __forceinline__ v8i32 cat8i(bf16x8 a, bf16x8 b) { const v4i32 x = __builtin_bit_cast(v4i32, a), y = __builtin_bit_cast(v4i32, b); return (v8i32){x[0], x[1], x[2], x[3], y[0], y[1], y[2], y[3]}; }
namespace pg8 {
constexpr int BM = 256, BK = 64, HALF = 128, HTB = HALF * BK * 2, STAGE_BYTES = 8 * HTB, NXCD = 8, WGM = 8;
__host__ __device__ __forceinline__ int lds_byte(int r, int c) { const int st = (r >> 4) * 2 + (c >> 5), rr = r & 15, cc = c & 31, ob = rr * 64 + cc * 2; return st * 1024 + (ob ^ (((ob >> 9) & 1) << 5)); }
__host__ __device__ __forceinline__ void stage_rc(int b, int& R, int& C) { const int st = b / 1024, sb = b % 1024, swz = sb ^ (((sb >> 9) & 1) << 5); R = (st >> 1) * 16 + swz / 64; C = (st & 1) * 32 + (swz % 64) / 2; }
__host__ __device__ __forceinline__ int perm32(int rho) { const int n = rho >> 4, i = rho & 15; return 8 * (i >> 2) + 4 * n + (i & 3); }

struct Unit { int pm, pn, e, lr0, cnt, koff; };
struct Gemm { const bf16_t* A; const bf16_t* Bt; int K; size_t b_estride; const int* gidx; int ld; };

struct StaticOrder {
    int nM, nN, nwg, G, c;
    __device__ __forceinline__ void init(int M, int N, int G_, int c_) { nM = M / BM; nN = N / BM; nwg = nM * nN; G = G_; c = c_; }
    __device__ __forceinline__ bool short_deal() const { const int r = nwg % G; return r != 0 && c >= r; }
    __device__ __forceinline__ bool next(int i, Unit& u) const {
        const long L = (long)i * G + c; if (L >= nwg) return false;
        int wgid = (int)L; { const int q = nwg / NXCD, r = nwg % NXCD, xcd = wgid % NXCD, off = wgid / NXCD; wgid = (xcd < r ? xcd * (q + 1) : r * (q + 1) + (xcd - r) * q) + off; }
        const int nig = WGM * nN, gid = wgid / nig, fm = gid * WGM, gsz = (nM - fm) < WGM ? (nM - fm) : WGM;
        u.pm = fm + ((wgid % nig) % gsz); u.pn = (wgid % nig) / gsz; u.e = 0; u.lr0 = 0; u.cnt = 0; u.koff = 0; return true;
    }
};
struct GroupedOrder {
    int pb[9]; int cnt[8]; int nN, G, c, nwg, np;
    int i0 = 0, i1 = 1 << 30;
    __device__ __forceinline__ void init(const unsigned* counts, int N, int G_, int c_, int pmax = 1 << 30) {
        int acc = 0;
#pragma unroll
        for (int e = 0; e < 8; ++e) { const int n = (int)counts[e]; cnt[e] = n; pb[e] = acc; acc += (n + 255) >> 8; }
        pb[8] = acc; nN = N / BM; G = G_; c = c_; np = acc < pmax ? acc : pmax; nwg = np * nN;
    }
    __device__ __forceinline__ bool short_deal() const { const int r = nwg % G; return r != 0 && c >= r; }
    __device__ __forceinline__ bool next(int i, Unit& u) const {
        if (i + i0 >= i1) return false;
        const long L = (long)(i + i0) * G + c; if (L >= nwg) return false;
        const int nig = WGM * nN, gid = (int)L / nig, fm = gid * WGM, gsz = (np - fm) < WGM ? (np - fm) : WGM;
        const int pm = fm + (((int)L % nig) % gsz), pn = ((int)L % nig) / gsz;
        int e = 0;
#pragma unroll
        for (int k = 1; k < 8; ++k) e += (pm >= pb[k]) ? 1 : 0;
        int pbe = 0, ce = 0;
#pragma unroll
        for (int k = 0; k < 8; ++k) { pbe = (k == e) ? pb[k] : pbe; ce = (k == e) ? cnt[k] : ce; }
        u.pm = pm; u.pn = pn; u.e = e; u.lr0 = (pm - pbe) * 256; u.cnt = ce; u.koff = 0; return true;
    }
};

struct TailOrder {
    int pb[9]; int nN, G, c, nwg, p0, KC, KCH;
    __device__ __forceinline__ void init(const unsigned* counts, int N, int G_, int c_, int p0_, int KC_, int KCH_) {
        int acc = 0;
#pragma unroll
        for (int e = 0; e < 8; ++e) { pb[e] = acc; acc += ((int)counts[e] + 255) >> 8; }
        pb[8] = acc; nN = N / BM; G = G_; c = c_; p0 = p0_; KC = KC_; KCH = KCH_; nwg = acc > p0 ? (acc - p0) * nN * KC : 0;
    }
    __device__ __forceinline__ bool short_deal() const { return false; }
    __device__ __forceinline__ bool next(int i, Unit& u) const {
        const long L = (long)i * G + c; if (L >= nwg) return false;
        const int kc = (int)L % KC, t = (int)L / KC, pm = p0 + t / nN, pn = t % nN;
        int e = 0;
#pragma unroll
        for (int k = 1; k < 8; ++k) e += (pm >= pb[k]) ? 1 : 0;
        u.pm = pm; u.pn = pn; u.e = e; u.lr0 = 0; u.cnt = 0; u.koff = kc * KCH; return true;
    }
};

template <class Epi, class Sched, bool GATHER, bool F8 = false>
__device__ __forceinline__ void gemm_phase(LAS unsigned char* lds, const Gemm g, const Sched& S, const Epi& E, int stag = 0) {
    int tid = threadIdx.x; asm volatile("" : "+v"(tid));
    const int wid = __builtin_amdgcn_readfirstlane(tid >> 6), lane = tid & 63, wr = wid >> 2, wc = wid & 3, fr = lane & 15, fq = lane >> 4;
    const int K = g.K, nt = K / BK, LD = g.ld ? g.ld : g.K;
    unsigned voffA[2], voffB[2]; int rA[2];
#pragma unroll
    for (int i = 0; i < 2; ++i) { int R, C; stage_rc(tid * 16 + i * 8192, R, C); const int Rb = Epi::PERM ? ((R & ~31) + perm32(R & 31)) : R;
#ifndef F8_OLDLDS
        if constexpr (F8) { const int q = C >> 3; C = (2 * (q & 3) + (q >> 2)) * 8 + (C & 7); }
#endif
        voffA[i] = GATHER ? (unsigned)(C * 2) : (unsigned)(R * LD + C) * 2u; voffB[i] = (unsigned)(Rb * LD + C) * 2u; rA[i] = R; }
    const size_t kstep = (size_t)(BK * 2);
    const size_t hstep = (size_t)HALF * LD * 2;
    const size_t tstep = 2 * hstep;
    const unsigned ldsw = (unsigned)wid * 1024u;
#ifdef F8_OLDLDS
    const int aoff = F8 ? lds_byte(wr * 64 + fr, fq * 16) : lds_byte(wr * 64 + fr, fq * 8), boff = F8 ? lds_byte(wc * 32 + fr, fq * 16) : lds_byte(wc * 32 + fr, fq * 8);
    const int aof1 = F8 ? lds_byte(wr * 64 + fr, fq * 16 + 8) : aoff + 1024, bof1 = F8 ? lds_byte(wc * 32 + fr, fq * 16 + 8) : boff + 1024;
#else
    const int aoff = lds_byte(wr * 64 + fr, fq * 8), boff = lds_byte(wc * 32 + fr, fq * 8), aof1 = aoff + 1024, bof1 = boff + 1024;
#endif
#define PG8_SA(b, h) (((b) * 2 + (h)) * HTB)
#define PG8_SB(b, h) ((4 + (b) * 2 + (h)) * HTB)
#define PG8_STAGE2(bufoff, gbase, v0, v1) do { unsigned _a = (v0), _b = (v1); asm volatile("" : "+v"(_a), "+v"(_b));     \
        __builtin_amdgcn_global_load_lds((const unsigned*)((const char*)(gbase) + _a), (LAS unsigned*)(lds + (bufoff) + ldsw), 16, 0, 0); \
        __builtin_amdgcn_global_load_lds((const unsigned*)((const char*)(gbase) + _b), (LAS unsigned*)(lds + (bufoff) + ldsw + 8192), 16, 0, 0); } while (0)
#define PG8_STAGE(bufoff, gbase, voff) PG8_STAGE2(bufoff, gbase, (voff)[0], (voff)[1])
#define PG8_STAGE_A(bufoff, nx, h, kt) do { \
        if constexpr (GATHER) { const char* _p = (const char*)g.A + (size_t)(kt) * kstep; \
            if (nx) { PG8_STAGE2(bufoff, _p, nG[h][0], nG[h][1]); } else { PG8_STAGE2(bufoff, _p, cG[h][0], cG[h][1]); } } \
        else { const char* _p = ((nx) ? nA : cA) + (size_t)(h) * hstep + (size_t)(kt) * kstep; PG8_STAGE2(bufoff, _p, voffA[0], voffA[1]); } } while (0)
#define PG8_LDA(dst, b, h) do { _Pragma("unroll") for (int m = 0; m < 4; ++m) { \
        if constexpr (F8) { dst##8[m].lo = *(const LAS v4i32*)(lds + PG8_SA(b, h) + aoff + m * 2048); dst##8[m].hi = *(const LAS v4i32*)(lds + PG8_SA(b, h) + aof1 + m * 2048); } \
        else { dst[m][0] = *(const LAS bf16x8*)(lds + PG8_SA(b, h) + aoff + m * 2048); dst[m][1] = *(const LAS bf16x8*)(lds + PG8_SA(b, h) + aof1 + m * 2048); } } } while (0)
#define PG8_LDB(dst, b, h) do { _Pragma("unroll") for (int n = 0; n < 2; ++n) { \
        if constexpr (F8) { dst##8[n].lo = *(const LAS v4i32*)(lds + PG8_SB(b, h) + boff + n * 2048); dst##8[n].hi = *(const LAS v4i32*)(lds + PG8_SB(b, h) + bof1 + n * 2048); } \
        else { dst[n][0] = *(const LAS bf16x8*)(lds + PG8_SB(b, h) + boff + n * 2048); dst[n][1] = *(const LAS bf16x8*)(lds + PG8_SB(b, h) + bof1 + n * 2048); } } } while (0)
#define PG8_MMA(ai, bj, At, Bt) do { __builtin_amdgcn_s_setprio(1); _Pragma("unroll") for (int m = 0; m < 4; ++m) _Pragma("unroll") for (int n = 0; n < 2; ++n) { \
        if constexpr (F8) asm volatile("v_mfma_scale_f32_16x16x128_f8f6f4 %0, %1, %2, %0, %3, %3 op_sel_hi:[0,0,0]" : "+v"(acc[ai][bj][m][n]) : "v"(Bt##8[n]), "v"(At##8[m]), "v"(one8));   \
        else { _Pragma("unroll") for (int k = 0; k < 2; ++k) acc[ai][bj][m][n] = __builtin_amdgcn_mfma_f32_16x16x32_bf16(Bt[n][k], At[m][k], acc[ai][bj][m][n], 0, 0, 0); } } __builtin_amdgcn_s_setprio(0); } while (0)
#define PG8_WAIT_V(n) asm volatile("s_waitcnt vmcnt(" #n ")" ::: "memory")
#define PG8_WAIT_L(n) asm volatile("s_waitcnt lgkmcnt(" #n ")" ::: "memory")
#ifndef GRACE
#define GRACE 0
#endif
#define PG8_WAIT_VG(first) do { if (first) { asm volatile("s_waitcnt vmcnt(%0)" :: "n"(8 + Epi::NVM) : "memory"); } else { PG8_WAIT_V(8); } } while (0)
#define PG8_BAR __builtin_amdgcn_s_barrier()
#define PG8_SCHED __builtin_amdgcn_sched_barrier(0)
#define PG8_GIDX(dst, u) do { _Pragma("unroll") for (int h = 0; h < 2; ++h) _Pragma("unroll") for (int i = 0; i < 2; ++i) { \
        const int _lr = (u).lr0 + h * HALF + rA[i]; const int _tok = (_lr < (u).cnt) ? g.gidx[(u).e * 16384 + _lr] : 0; dst[h][i] = (unsigned)_tok * (unsigned)(LD * 2) + voffA[i]; } } while (0)
#define PG8_GIDX_LOAD(raw, u) do { _Pragma("unroll") for (int h = 0; h < 2; ++h) _Pragma("unroll") for (int i = 0; i < 2; ++i) { \
        const int _lr = (u).lr0 + h * HALF + rA[i]; raw[h][i] = (_lr < (u).cnt) ? g.gidx[(u).e * 16384 + _lr] : 0; } } while (0)
#define PG8_GIDX_FIN(dst, raw) do { _Pragma("unroll") for (int h = 0; h < 2; ++h) _Pragma("unroll") for (int i = 0; i < 2; ++i) dst[h][i] = (unsigned)raw[h][i] * (unsigned)(LD * 2) + voffA[i]; } while (0)
    Unit cur, nxt; int ui = 0;
    if (!S.next(0, cur)) return;
    if (stag > 0) { const int grp = ((int)blockIdx.x >> 3) & 3;
        if (grp) { const unsigned long long t0 = __builtin_amdgcn_s_memrealtime(); while (__builtin_amdgcn_s_memrealtime() - t0 < (unsigned long long)(grp * stag)) __builtin_amdgcn_s_sleep(2); } }
#ifdef STAGGER_TICKS
    if (S.short_deal()) { const unsigned long long t0 = __builtin_amdgcn_s_memrealtime(); while (__builtin_amdgcn_s_memrealtime() - t0 < (unsigned long long)(STAGGER_TICKS)) __builtin_amdgcn_s_sleep(8); }
#endif
    f32x4 acc[2][2][4][2];
#pragma unroll
    for (int a = 0; a < 2; ++a)
#pragma unroll
        for (int b = 0; b < 2; ++b)
#pragma unroll
            for (int m = 0; m < 4; ++m)
#pragma unroll
                for (int n = 0; n < 2; ++n) acc[a][b][m][n] = (f32x4){0.f, 0.f, 0.f, 0.f};
    const int one8 = 0x7f7f7f7f;
    bf16x8 At[4][2], B0[2][2], B1[2][2]; v8i32 At8[4], B08[2], B18[2];
    unsigned cG[2][2] = {{0u, 0u}, {0u, 0u}}, nG[2][2] = {{0u, 0u}, {0u, 0u}};
    const char* cA = (const char*)g.A + (size_t)cur.pm * tstep + (size_t)cur.koff * 2; const char* cB = (const char*)g.Bt + ((size_t)cur.e * g.b_estride + (size_t)cur.koff) * 2 + (size_t)cur.pn * tstep;
    const char* nA = cA;
    if constexpr (GATHER) { PG8_GIDX(cG, cur); }
    PG8_STAGE(PG8_SB(0, 0), cB, voffB); PG8_STAGE(PG8_SB(0, 1), cB + hstep, voffB); PG8_STAGE_A(PG8_SA(0, 0), false, 0, 0); PG8_STAGE_A(PG8_SA(0, 1), false, 1, 0);
    if (wr == 1) PG8_BAR;
    PG8_WAIT_V(2); PG8_BAR;
    PG8_STAGE(PG8_SB(1, 0), cB + kstep, voffB); PG8_STAGE_A(PG8_SA(1, 0), false, 0, 1); PG8_STAGE(PG8_SB(1, 1), cB + hstep + kstep, voffB);
    PG8_WAIT_V(6); PG8_BAR;
    for (;;) {
        const bool has_next = S.next(ui + 1, nxt);
        nA = has_next ? (const char*)g.A + (size_t)nxt.pm * tstep + (size_t)nxt.koff * 2 : cA;
        const char* nB = has_next ? (const char*)g.Bt + ((size_t)nxt.e * g.b_estride + (size_t)nxt.koff) * 2 + (size_t)nxt.pn * tstep : cB;
#ifdef GIDX_LATE
        int graw[2][2] = {{0, 0}, {0, 0}};
        if constexpr (GATHER) { if (has_next) { PG8_GIDX_LOAD(graw, nxt); } }
#else
        if constexpr (GATHER) { if (has_next) { PG8_GIDX(nG, nxt); } else {
#pragma unroll
            for (int h = 0; h < 2; ++h)
#pragma unroll
                for (int i = 0; i < 2; ++i) nG[h][i] = cG[h][i]; } }
#endif
#ifdef KDBL
        const int ntl = (F8 && GATHER) ? 2 * nt : nt, kmask = nt - 1;
#else
        const int ntl = nt, kmask = -1;
#endif
#pragma nounroll
        for (int t = 0; t < ntl; t += 2) {
            const bool last = (t == ntl - 2);
            const bool first = GRACE && (t == 0) && (ui > 0);
            const int kt2 = last ? 0 : ((t + 2) & kmask), kt3 = kt2 + 1;
            const char* b2 = last ? nB : cB + (size_t)((t + 2) & kmask) * kstep;
            const char* b3 = b2 + kstep;
            PG8_LDB(B0, 0, 0); PG8_LDB(B1, 0, 1); PG8_SCHED; PG8_LDA(At, 0, 0); if (!first) { PG8_STAGE_A(PG8_SA(1, 1), false, 1, ((t + 1) & kmask)); }
            PG8_WAIT_VG(first); PG8_WAIT_L(0); PG8_BAR; PG8_MMA(0, 0, At, B0); PG8_MMA(0, 1, At, B1); PG8_BAR; PG8_SCHED;
            PG8_LDA(At, 0, 1); PG8_STAGE(PG8_SB(0, 0), b2, voffB); PG8_STAGE(PG8_SB(0, 1), b2 + hstep, voffB); PG8_STAGE_A(PG8_SA(0, 0), last, 0, kt2);
            PG8_WAIT_VG(first); PG8_WAIT_L(0); PG8_BAR; PG8_MMA(1, 0, At, B0); PG8_MMA(1, 1, At, B1); PG8_BAR; PG8_SCHED;
#ifdef GIDX_LATE
            if constexpr (GATHER) { if (t == 0) { if (has_next) { PG8_GIDX_FIN(nG, graw); } else {
#pragma unroll
                for (int h = 0; h < 2; ++h)
#pragma unroll
                    for (int i = 0; i < 2; ++i) nG[h][i] = cG[h][i]; } } }
#endif
            PG8_LDB(B0, 1, 0); PG8_LDB(B1, 1, 1); PG8_SCHED; PG8_LDA(At, 1, 0); PG8_STAGE_A(PG8_SA(0, 1), last, 1, kt2);
            PG8_WAIT_VG(first); PG8_WAIT_L(0); PG8_BAR; PG8_MMA(0, 0, At, B0); PG8_MMA(0, 1, At, B1); PG8_BAR; PG8_SCHED;
            PG8_LDA(At, 1, 1); PG8_STAGE(PG8_SB(1, 0), b3, voffB); PG8_STAGE(PG8_SB(1, 1), b3 + hstep, voffB); PG8_STAGE_A(PG8_SA(1, 0), last, 0, kt3);
            PG8_WAIT_V(8); PG8_WAIT_L(0); PG8_BAR; PG8_MMA(1, 0, At, B0); PG8_MMA(1, 1, At, B1); PG8_BAR; PG8_SCHED;
        }
        if (GRACE && has_next) { PG8_STAGE_A(PG8_SA(1, 1), true, 1, 1); }
        if constexpr (F8) asm volatile("s_nop 15\n\ts_nop 15" ::: "memory");
        if (wr == 0) PG8_BAR;
        { Unit eu = cur; eu.pm = __builtin_amdgcn_readfirstlane(eu.pm); eu.pn = __builtin_amdgcn_readfirstlane(eu.pn); asm volatile("" : "+s"(eu.pm), "+s"(eu.pn));
          E(acc, eu, wr, wc, fr, fq);
#ifdef EPI2
          if constexpr (Epi::P2) { if (EPI2 == 1) E(acc, eu, wr, wc, fr, fq); else E.template run<EPI2 == 2 ? 0 : EPI2 - 1>(acc, eu, wr, wc, fr, fq); }
#endif
        }
        if (!has_next) break;
#pragma unroll
        for (int a = 0; a < 2; ++a)
#pragma unroll
            for (int b = 0; b < 2; ++b)
#pragma unroll
                for (int m = 0; m < 4; ++m)
#pragma unroll
                    for (int n = 0; n < 2; ++n) acc[a][b][m][n] = (f32x4){0.f, 0.f, 0.f, 0.f};
        cur = nxt; cA = nA; cB = nB; ++ui;
        if constexpr (GATHER) {
#pragma unroll
            for (int h = 0; h < 2; ++h)
#pragma unroll
                for (int i = 0; i < 2; ++i) cG[h][i] = nG[h][i]; }
        if (wr == 1) PG8_BAR;
    }
    PG8_WAIT_V(0);
    PG8_BAR;
#undef PG8_SA
#undef PG8_SB
#undef PG8_STAGE
#undef PG8_STAGE2
#undef PG8_STAGE_A
#undef PG8_LDA
#undef PG8_LDB
#undef PG8_MMA
#undef PG8_WAIT_V
#undef PG8_WAIT_VG
#undef PG8_WAIT_L
#undef PG8_BAR
#undef PG8_SCHED
#undef PG8_GIDX
#undef PG8_GIDX_LOAD
#undef PG8_GIDX_FIN
}
}
#ifndef P2SEL
#define P2SEL 0
#endif
namespace pg8 {
constexpr size_t WS_DUMMY = (size_t)467 << 20;
constexpr float QA_SCALE = 0.125f * 1.4426950408889634f;
constexpr float QB_SCALE = 0.125f;

struct EpiInProj {
    static constexpr bool PERM = true, IDEM = true; static constexpr bool P2 = (P2SEL == 0); static constexpr int NVM = 16;
    bf16_t* base; WT wt;
    template <int ACT>
    __device__ __forceinline__ void body(const f32x4 (&acc)[2][2][4][2], bf16_t* O, int row0, int col0, int ld, float sc) const {
#pragma unroll
        for (int ai = 0; ai < 2; ++ai)
#pragma unroll
            for (int m = 0; m < 4; ++m) { bf16_t* rowp = O + (size_t)(row0 + ai * HALF + m * 16) * ld + col0;
#pragma unroll
                for (int bj = 0; bj < 2; ++bj) { f32x4 v0 = acc[ai][bj][m][0], v1 = acc[ai][bj][m][1];
                    if (ACT == 3) { v0 = v0 * sc; v1 = v1 * sc; }
                    if (ACT == 2) { v0 = sigmoid4(v0); v1 = sigmoid4(v1); }
                    if (ACT == 1) { v0 = v0 * sigmoid4(v0); v1 = v1 * sigmoid4(v1); }
                    u32x4 w; w.x = cvt_pk_bf16(v0[0], v0[1]); w.y = cvt_pk_bf16(v0[2], v0[3]); w.z = cvt_pk_bf16(v1[0], v1[1]); w.w = cvt_pk_bf16(v1[2], v1[3]);
                    st16(wt, rowp + bj * HALF, w); } }
    }
    __device__ __forceinline__ void operator()(const f32x4 (&acc)[2][2][4][2], const Unit& u, int wr, int wc, int fr, int fq) const { run<1>(acc, u, wr, wc, fr, fq); }
    template <int ST> __device__ __forceinline__ void run(const f32x4 (&acc)[2][2][4][2], const Unit& u, int wr, int wc, int fr, int fq) const {
        const int pn = u.pn;
        size_t toff; int ld, ct; float sc = 1.f; int act = 0;
        constexpr size_t Mi = 1u << 20;
        if (pn < 2)       { toff = 16 * Mi; ld = 512; ct = pn; sc = QA_SCALE; }
        else if (pn < 4)  { toff = 24 * Mi; ld = 512; ct = pn - 2; }
        else if (pn < 6)  { toff = 32 * Mi; ld = 512; ct = pn - 4; }
        else if (pn < 7)  { toff = 0; ld = 256; ct = 0; sc = QB_SCALE; }
        else if (pn < 8)  { toff = 4 * Mi; ld = 256; ct = 0; }
        else if (pn < 10) { toff = 8 * Mi; ld = 512; ct = pn - 8; }
        else if (pn < 12) { toff = 40 * Mi; ld = 512; ct = pn - 10; act = 1; }
        else if (pn < 16) { toff = 48 * Mi; ld = 1024; ct = pn - 12; act = 2; }
        else              { toff = 64 * Mi; ld = 1024; ct = pn - 16; act = 2; }
        const int row0 = u.pm * BM + wr * 64 + fr, col0 = ct * BM + wc * 32 + 8 * fq;
        bf16_t* O = base + toff;
#ifdef EPI_PK
        if (ST == 1) {
            if (act == 2) body<2>(acc, O, row0, col0, ld, 1.f); else if (act == 1) body<1>(acc, O, row0, col0, ld, 1.f); else if (sc != 1.f) body<3>(acc, O, row0, col0, ld, sc); else body<0>(acc, O, row0, col0, ld, 1.f);
            return; }
#endif
#pragma unroll
        for (int ai = 0; ai < 2; ++ai)
#pragma unroll
            for (int m = 0; m < 4; ++m) { bf16_t* rowp = O + (size_t)(row0 + ai * HALF + m * 16) * ld + col0;
#pragma unroll
                for (int bj = 0; bj < 2; ++bj) { f32x4 v0 = acc[ai][bj][m][0] * sc, v1 = acc[ai][bj][m][1] * sc;
                    if (act) {
#pragma unroll
                        for (int j = 0; j < 4; ++j) { const float s0 = fast_sigmoid(v0[j]), s1 = fast_sigmoid(v1[j]); v0[j] = (act == 1) ? v0[j] * s0 : s0; v1[j] = (act == 1) ? v1[j] * s1 : s1; } }
                    u32x4 w; w.x = cvt_pk_bf16(v0[0], v0[1]); w.y = cvt_pk_bf16(v0[2], v0[3]); w.z = cvt_pk_bf16(v1[0], v1[1]); w.w = cvt_pk_bf16(v1[2], v1[3]);
                    if (ST == 1) st16(wt, rowp + bj * HALF, w);
                    else if (ST == 0) asm volatile("" :: "v"(w.x), "v"(w.y), "v"(w.z), "v"(w.w), "v"(rowp));
                    else { unsigned char* db = (unsigned char*)wt.base + WS_DUMMY + (size_t)blockIdx.x * 131072 + (wr * 4 + wc) * 16384; const int k = (ai * 4 + m) * 2 + bj;
                        st16(wt, db + (ST == 2 ? fr * 1024 + k * 64 + fq * 16 : k * 1024 + (fq * 16 + fr) * 16), w); } } }
    }
};

template <int MODE> struct EpiEw {
    static constexpr bool PERM = true, IDEM = (MODE != 2 && MODE != 4); static constexpr bool P2 = false; static constexpr int NVM = 16;
    bf16_t* O; const bf16_t* G; int ldc; WT wt; float sc = 1.f;
    __device__ __forceinline__ void operator()(const f32x4 (&acc)[2][2][4][2], const Unit& u, int wr, int wc, int fr, int fq) const {
        const int row0 = u.pm * BM + wr * 64 + fr, col0 = u.pn * BM + wc * 32 + 8 * fq;
#pragma unroll
        for (int ai = 0; ai < 2; ++ai)
#pragma unroll
            for (int m = 0; m < 4; ++m) { const size_t ro = (size_t)(row0 + ai * HALF + m * 16) * ldc + col0;
#pragma unroll
                for (int bj = 0; bj < 2; ++bj) { f32x4 v0 = acc[ai][bj][m][0], v1 = acc[ai][bj][m][1];
                    if (MODE == 0) { v0 = v0 * sc; v1 = v1 * sc; }
                    if (MODE == 1 || MODE == 2) { const u32x4 gw = *(const u32x4*)(G + ro + bj * HALF);
                        v0[0] *= bf_lo(gw.x); v0[1] *= bf_hi(gw.x); v0[2] *= bf_lo(gw.y); v0[3] *= bf_hi(gw.y); v1[0] *= bf_lo(gw.z); v1[1] *= bf_hi(gw.z); v1[2] *= bf_lo(gw.w); v1[3] *= bf_hi(gw.w); }
                    if (MODE == 3) {
#ifdef EPI_PK
                        v0 = sigmoid4(v0); v1 = sigmoid4(v1);
#else
#pragma unroll
                        for (int j = 0; j < 4; ++j) { v0[j] = fast_sigmoid(v0[j]); v1[j] = fast_sigmoid(v1[j]); }
#endif
                    }
                    if (MODE == 2 || MODE == 4) { const u32x4 ow = *(const u32x4*)(O + ro + bj * HALF);
                        if (MODE == 2) { v0[0] += bf_lo(ow.x); v0[1] += bf_hi(ow.x); v0[2] += bf_lo(ow.y); v0[3] += bf_hi(ow.y); v1[0] += bf_lo(ow.z); v1[1] += bf_hi(ow.z); v1[2] += bf_lo(ow.w); v1[3] += bf_hi(ow.w); }
                        else { v0[0] *= bf_lo(ow.x); v0[1] *= bf_hi(ow.x); v0[2] *= bf_lo(ow.y); v0[3] *= bf_hi(ow.y); v1[0] *= bf_lo(ow.z); v1[1] *= bf_hi(ow.z); v1[2] *= bf_lo(ow.w); v1[3] *= bf_hi(ow.w); } }
                    u32x4 w; w.x = cvt_pk_bf16(v0[0], v0[1]); w.y = cvt_pk_bf16(v0[2], v0[3]); w.z = cvt_pk_bf16(v1[0], v1[1]); w.w = cvt_pk_bf16(v1[2], v1[3]);
                    st16(wt, O + ro + bj * HALF, w); } }
    }
};

struct EpiPart {
    static constexpr bool PERM = true, IDEM = true, P2 = false; static constexpr int NVM = 16;
    bf16_t* P; int ldc, p0, KCH; size_t plane; WT wt; float sc = 1.f;
    __device__ __forceinline__ void operator()(const f32x4 (&acc)[2][2][4][2], const Unit& u, int wr, int wc, int fr, int fq) const {
        const int row0 = (u.pm - p0) * BM + wr * 64 + fr, col0 = u.pn * BM + wc * 32 + 8 * fq;
        bf16_t* O = P + (size_t)(u.koff / KCH) * plane;
#pragma unroll
        for (int ai = 0; ai < 2; ++ai)
#pragma unroll
            for (int m = 0; m < 4; ++m) { const size_t ro = (size_t)(row0 + ai * HALF + m * 16) * ldc + col0;
#pragma unroll
                for (int bj = 0; bj < 2; ++bj) { const f32x4 v0 = acc[ai][bj][m][0] * sc, v1 = acc[ai][bj][m][1] * sc;
                    u32x4 w; w.x = cvt_pk_bf16(v0[0], v0[1]); w.y = cvt_pk_bf16(v0[2], v0[3]); w.z = cvt_pk_bf16(v1[0], v1[1]); w.w = cvt_pk_bf16(v1[2], v1[3]);
                    st16(wt, O + ro + bj * HALF, w); } }
    }
};

struct EpiGateUp {
    static constexpr bool PERM = true, IDEM = true, P2 = false; static constexpr int NVM = 8;
    bf16_t* O; int ldc; WT wt; float qs;
    __device__ __forceinline__ void operator()(const f32x4 (&acc)[2][2][4][2], const Unit& u, int wr, int wc, int fr, int fq) const {
        const int row0 = u.pm * BM + wr * 64 + fr, col0 = u.pn * HALF + wc * 32 + 8 * fq;
#pragma unroll
        for (int ai = 0; ai < 2; ++ai)
#pragma unroll
            for (int m = 0; m < 4; ++m) { bf16_t* rowp = O + (size_t)(row0 + ai * HALF + m * 16) * ldc + col0;
                f32x4 v0, v1;
#if defined(EPI_PK) && !defined(SIM_FP8) && !defined(SIM_FFN0)
                v0 = acc[ai][0][m][0] * acc[ai][1][m][0] * sigmoid4(acc[ai][0][m][0]); v1 = acc[ai][0][m][1] * acc[ai][1][m][1] * sigmoid4(acc[ai][0][m][1]);
#endif
#pragma unroll
                for (int j = 0; j < 4; ++j) {
#if defined(EPI_PK) && !defined(SIM_FP8) && !defined(SIM_FFN0)
                    break;
#endif
                    const float g0 = acc[ai][0][m][0][j], g1 = acc[ai][0][m][1][j];
                    v0[j] = g0 * fast_sigmoid(g0) * acc[ai][1][m][0][j]; v1[j] = g1 * fast_sigmoid(g1) * acc[ai][1][m][1][j];
#if defined(SIM_FP8) || defined(SIM_FFN0)
                    if (qs != 0.f) { v0[j] = q8(v0[j], qs); v1[j] = q8(v1[j], qs); }
#endif
                }
                u32x4 w; w.x = cvt_pk_bf16(v0[0], v0[1]); w.y = cvt_pk_bf16(v0[2], v0[3]); w.z = cvt_pk_bf16(v1[0], v1[1]); w.w = cvt_pk_bf16(v1[2], v1[3]);
                st16(wt, rowp, w); }
    }
};
struct EpiGateUp8 {
    static constexpr bool PERM = true, IDEM = true, P2 = (P2SEL == 1); static constexpr int NVM = 8;
    unsigned char* O; int ldc; WT wt; float sin, sout;
    template <int ST> __device__ __forceinline__ void run(const f32x4 (&acc)[2][2][4][2], const Unit& u, int wr, int wc, int fr, int fq) const { (*this)(acc, u, wr, wc, fr, fq); }
    __device__ __forceinline__ void operator()(const f32x4 (&acc)[2][2][4][2], const Unit& u, int wr, int wc, int fr, int fq) const {
        const int row0 = u.pm * BM + wr * 64 + fr, col0 = u.pn * HALF + wc * 32 + 8 * fq;
#pragma unroll
        for (int ai = 0; ai < 2; ++ai)
#pragma unroll
            for (int m = 0; m < 4; ++m) { unsigned char* rowp = O + (size_t)(row0 + ai * HALF + m * 16) * ldc + col0;
                f32x4 v0, v1;
#ifdef EPI_PK
                { const float ca = -1.4426950408889634f * sin, cs = sin * sin * sout;
                  const f32x4 g0 = acc[ai][0][m][0], g1 = acc[ai][0][m][1];
                  v0 = (g0 * acc[ai][1][m][0]) * cs * cat2(rcp_1p_exp2(lo2(g0) * (f32x2){ca, ca}), rcp_1p_exp2(hi2(g0) * (f32x2){ca, ca}));
                  v1 = (g1 * acc[ai][1][m][1]) * cs * cat2(rcp_1p_exp2(lo2(g1) * (f32x2){ca, ca}), rcp_1p_exp2(hi2(g1) * (f32x2){ca, ca})); }
#else
#pragma unroll
                for (int j = 0; j < 4; ++j) { const float g0 = acc[ai][0][m][0][j] * sin, g1 = acc[ai][0][m][1][j] * sin;
                    v0[j] = g0 * fast_sigmoid(g0) * (acc[ai][1][m][0][j] * (sin * sout)); v1[j] = g1 * fast_sigmoid(g1) * (acc[ai][1][m][1][j] * (sin * sout)); }
#endif
                u32x2 w; w.x = pk4_fp8(v0[0], v0[1], v0[2], v0[3]); w.y = pk4_fp8(v1[0], v1[1], v1[2], v1[3]);
                *(u32x2*)rowp = w; }
    }
};
}
#ifndef MK_DBG
#define MK_DBG 0
#endif
#ifndef MOE_FP8
#define MOE_FP8 1
#endif
constexpr int D = 1024, NB = 8, SEQ = 2048, T = NB * SEQ, DEPTH = 2, CH = 64, NCH = SEQ / CH, NPREV = 8;
constexpr int AH = 8, BH = 4, GR = 16, DFF = 2816, NE = 8, DFE = 3584, PLE = 256, INW = 5136, INWG = 5120, RELN = 257;
constexpr float EPS = 1e-6f, LOG2E = 1.4426950408889634f;
constexpr int NWAVES = 8, NTHR = 512;
constexpr int MOE_ROWS = 34816;

constexpr size_t MiB = 1u << 20;
constexpr size_t WS_CTL = 0, CTL_ZERO_BYTES = 256 * 1024;
constexpr size_t WS_TOKINFO = 1 * MiB;
constexpr size_t WS_IDXE = 2 * MiB;
constexpr size_t WS_DEC = 3 * MiB;
constexpr size_t WS_W1 = 4 * MiB;
constexpr size_t WS_PB = 189 * MiB;
constexpr size_t WS_G = 205 * MiB;
constexpr size_t WS_HB = WS_G, WS_DST = WS_G + 32 * MiB, WS_YSLOT = WS_G;
constexpr size_t WS_BIG = 273 * MiB;
constexpr size_t WS_W0 = WS_BIG, WS_PROJ = WS_BIG + 34 * MiB, WS_MACT = WS_BIG;
constexpr size_t WS_Y = WS_PROJ;
constexpr size_t WS_QB = WS_PROJ, WS_KB = WS_PROJ + 8 * MiB, WS_VB = WS_PROJ + 16 * MiB, WS_QA = WS_PROJ + 32 * MiB, WS_KA = WS_PROJ + 48 * MiB, WS_VA = WS_PROJ + 64 * MiB;
constexpr size_t WS_SR = WS_PROJ + 80 * MiB, WS_SGA = WS_PROJ + 96 * MiB, WS_SGB = WS_PROJ + 128 * MiB;
constexpr size_t WS_MERGED = WS_KA;
constexpr size_t WS_ST = WS_KA;
constexpr size_t WS_FACT = WS_QA;
constexpr size_t WS_YA = WS_PROJ + 160 * MiB, WS_YB = WS_PROJ + 176 * MiB;
constexpr size_t WS_XB = WS_SGB;
constexpr int MOE_MAIN_PANELS = 128, MOE_MAIN_ROWS = MOE_MAIN_PANELS * 256, TAIL_KC = MOE_FP8 ? 7 : 14, TAIL_KCH = 256  , TAIL_ROWS = MOE_ROWS - MOE_MAIN_ROWS;
constexpr size_t WS_END = 511 * MiB;
static_assert(WS_FACT + (size_t)T * DFF * 2 <= WS_XB && WS_MACT + (size_t)MOE_ROWS * DFE * 2 <= WS_END && WS_YSLOT + (size_t)MOE_ROWS * D * 2 <= WS_BIG && WS_SGB + 32 * MiB <= WS_YA && WS_YB + 16 * MiB <= WS_END, "d_ws map");
constexpr size_t OFF_WIN = 0, OFF_WGD = 10 * MiB, OFF_WBA = 10 * MiB + 65536, OFF_WBB = OFF_WBA + 1 * MiB, OFF_WOUT = OFF_WBB + 1 * MiB, OFF_WPP = OFF_WOUT + 2 * MiB, OFF_WPG = OFF_WPP + MiB / 2;
constexpr size_t OFF_FFN = 17 * MiB;
constexpr size_t OFF_FDN = OFF_FFN + 11 * MiB, OFF_MDN = OFF_FFN + 8 * 14 * MiB;
constexpr size_t OFF_MDN8 = OFF_FFN + 8 * 7 * MiB;
constexpr float W8_SCALE = 64.f, ACT8_SCALE = 8.f;
constexpr size_t WS_XS = WS_W1 + OFF_MDN8 + 8 * 7 * MiB / 2;
static_assert(MOE_FP8 && WS_XS + (size_t)T * D * 2 <= WS_PB, "x stream placement needs the e4m3 weight layout");
constexpr size_t WS_PBUF = WS_W1 + OFF_FFN;
static_assert((size_t)TAIL_KC * TAIL_ROWS * D * 2 <= (MOE_FP8 ? 8 * 7 : 8 * 14) * MiB, "partial planes");
static_assert(OFF_WPG + 2 * MiB <= OFF_FFN && WS_W1 + OFF_MDN + 8 * 7 * MiB <= WS_PB && OFF_FDN + (size_t)D * DFF * 2 <= 34 * MiB, "weight map");
constexpr int CW_BAR = 4096;
constexpr int CW_CNT = 8192;
constexpr int CW_DBG = 16384;

constexpr int RING_BYTES = 131072;
constexpr int LDSCTL_OFF = RING_BYTES, MISC_OFF = LDSCTL_OFF + 320;
constexpr int XTRA_OFF = RING_BYTES + 1024;
constexpr int LDS_BYTES = 147456;

typedef GAS unsigned gu32;
#define RLX_AGENT __ATOMIC_RELAXED, __HIP_MEMORY_SCOPE_AGENT
#define LDS_WAIT() asm volatile("s_waitcnt lgkmcnt(0)" ::: "memory")
#define VM_WAIT() asm volatile("s_waitcnt vmcnt(0)" ::: "memory")

#define XB_TMO      128
#define XB_XCNT(j)  (256  + 64 * (j))
#define XB_XSUB(j)  (1280 + 64 * (j))
#define XB_XGEN(j)  (2304 + 64 * (j))
#define XB_TOP      3328
#define XB_TOPGEN   3392
#define XCD_BAR_WORDS 3456
#define XB_SPIN_CAP (1u << 18)
__device__ __forceinline__ unsigned xb_ld(unsigned* p)              { return __hip_atomic_load(p, __ATOMIC_RELAXED, __HIP_MEMORY_SCOPE_AGENT); }
__device__ __forceinline__ unsigned xb_add(unsigned* p, unsigned v) { return __hip_atomic_fetch_add(p, v, __ATOMIC_RELAXED, __HIP_MEMORY_SCOPE_AGENT); }
__device__ __forceinline__ unsigned xb_xcc_id() { return (unsigned)__builtin_amdgcn_s_getreg((3 << 11) | 20) & 0xFu; }
#define XB_SPIN(cond, bar) do { unsigned _sp = 0; while (cond) { __builtin_amdgcn_s_sleep(1); \
    if ((++_sp & 255u) == 0u) { if (xb_ld(&(bar)[XB_TMO])) break; if (_sp > XB_SPIN_CAP) { atomicAdd(&(bar)[XB_TMO], 1u); break; } } } } while (0)
struct XcdBarrier { unsigned* bar; unsigned x; volatile LAS unsigned* st; };
__device__ __forceinline__ XcdBarrier xcd_barrier_post(unsigned* bar, volatile LAS unsigned* st) {
    XcdBarrier b; b.bar = bar; b.x = xb_xcc_id(); b.st = st;
    if (threadIdx.x == 0) (void)xb_add(&bar[XB_XCNT(b.x)], 1u);
    return b;
}
__device__ __forceinline__ void xcd_barrier_complete(unsigned* bar, unsigned x, unsigned& nloc, unsigned& nx) {
    const unsigned G = gridDim.x * gridDim.y * gridDim.z;
    unsigned sum, cnt, mine, sp = 0u;
    for (;;) {
        sum = 0u; cnt = 0u; mine = 0u;
#pragma unroll
        for (unsigned j = 0; j < 16; ++j) { const unsigned c = xb_ld(&bar[XB_XCNT(j)]); sum += c; cnt += (c > 0u) ? 1u : 0u; mine = (j == x) ? c : mine; }
        if (sum == G) break;
        __builtin_amdgcn_s_sleep(1);
        if ((++sp & 255u) == 0u) { if (xb_ld(&bar[XB_TMO])) break; if (sp > XB_SPIN_CAP) { atomicAdd(&bar[XB_TMO], 1u); break; } }
    }
    nloc = mine > 0u ? mine : 1u; nx = cnt > 0u ? cnt : 1u;
}
__device__ __forceinline__ void xcd_barrier(const XcdBarrier& b) {
    asm volatile("s_waitcnt vmcnt(0)" ::: "memory");
    __syncthreads();
    if (threadIdx.x == 0) {
        unsigned* bar = b.bar;
        __builtin_amdgcn_s_waitcnt(0);
        unsigned nloc = b.st[0], nx = b.st[1];
        if (nloc == 0u) { xcd_barrier_complete(bar, b.x, nloc, nx); b.st[0] = nloc; b.st[1] = nx; }
        const unsigned old = xb_add(&bar[XB_XSUB(b.x)], 1u);
        const unsigned gen = old / nloc;
        if (old + 1u == (gen + 1u) * nloc) {
            __builtin_amdgcn_fence(__ATOMIC_RELEASE, "agent");
            asm volatile("s_waitcnt vmcnt(0)" ::: "memory");
            const unsigned og = xb_add(&bar[XB_TOP], 1u);
            const unsigned tg = og / nx;
            if (og + 1u == (tg + 1u) * nx) xb_add(&bar[XB_TOPGEN], 1u);
            else XB_SPIN(xb_ld(&bar[XB_TOPGEN]) == tg, bar);
            __builtin_amdgcn_fence(__ATOMIC_ACQUIRE, "agent");
            xb_add(&bar[XB_XGEN(b.x)], 1u);
            asm volatile("s_waitcnt vmcnt(0)" ::: "memory");
        } else {
            XB_SPIN(xb_ld(&bar[XB_XGEN(b.x)]) == gen, bar);
            __builtin_amdgcn_fence(__ATOMIC_ACQUIRE, "agent");
            asm volatile("s_waitcnt vmcnt(0)" ::: "memory");
        }
    }
    __syncthreads();
}

struct Args { const float* in[24]; float* out; unsigned char* ws; int ph_lo, ph_hi, sub, pad; };
enum { I_X = 0, I_P, I_WIN, I_RELB, I_WGUP, I_BG, I_GNORM, I_WBA, I_WBB, I_WOUT, I_NMPRE, I_NMPOST, I_NFPRE, I_NFPOST, I_FG, I_FU, I_FD, I_RW, I_MG, I_MU, I_MD, I_PP, I_PG, I_PNORM };
#define FRESH(F) do { int _t = threadIdx.x; asm volatile("" : "+v"(_t)); (F).tid = _t; (F).lane = _t & 63; (F).wave = __builtin_amdgcn_readfirstlane(_t >> 6); } while (0)
struct Frame {
    LAS unsigned char* lds;
    volatile LAS unsigned* MISC;
    gu32* ctl;
    unsigned char* ws;
    int tid, lane, wave;
    int vcu, G;
    float* x;
    bf16_t* xs;
};

__device__ __forceinline__ float sumsq16(const f32x4 (&v)[4]) {
    float s = 0.f;
#pragma unroll
    for (int j = 0; j < 4; ++j) s += (v[j].x * v[j].x + v[j].y * v[j].y) + (v[j].z * v[j].z + v[j].w * v[j].w);
    return wave_sum(s);
}
__device__ __forceinline__ void ld_bf16_row(const bf16_t* row, int lane, f32x4 (&v)[4]) {
#pragma unroll
    for (int j = 0; j < 4; ++j) { const u32x2 w = ((const u32x2*)row)[lane + 64 * j]; v[j] = (f32x4){bf_lo(w.x), bf_hi(w.x), bf_lo(w.y), bf_hi(w.y)}; }
}
__device__ __forceinline__ void st_bf16_row(bf16_t* row, int lane, const f32x4 (&v)[4]) {
#pragma unroll
    for (int j = 0; j < 4; ++j) { u32x2 w; w.x = cvt_pk_bf16(v[j].x, v[j].y); w.y = cvt_pk_bf16(v[j].z, v[j].w); ((u32x2*)row)[lane + 64 * j] = w; }
}
__device__ __forceinline__ void ld_moe_row(const unsigned char* ws, int s, int lane, f32x4 (&v)[4]) {
    if (s < MOE_MAIN_ROWS) { ld_bf16_row((const bf16_t*)(ws + WS_YSLOT) + (size_t)s * D, lane, v); return; }
    const bf16_t* p = (const bf16_t*)(ws + WS_PBUF) + (size_t)(s - MOE_MAIN_ROWS) * D;
#pragma unroll
    for (int j = 0; j < 4; ++j) v[j] = (f32x4){0.f, 0.f, 0.f, 0.f};
#pragma unroll 1
    for (int k0 = 0; k0 < TAIL_KC; k0 += 7) {
        u32x2 w[7][4];
#pragma unroll
        for (int q = 0; q < 7; ++q)
#pragma unroll
            for (int j = 0; j < 4; ++j) w[q][j] = ((const u32x2*)(p + (size_t)(k0 + q) * TAIL_ROWS * D))[lane + 64 * j];
#pragma unroll
        for (int q = 0; q < 7; ++q)
#pragma unroll
            for (int j = 0; j < 4; ++j) v[j] = v[j] + (f32x4){bf_lo(w[q][j].x), bf_hi(w[q][j].x), bf_lo(w[q][j].y), bf_hi(w[q][j].y)};
    }
}
template <int SRC, int OUT, bool ROUTE>
__device__ __forceinline__ void thin_phase(Frame& F, const float* xin, const bf16_t* ysrc, const float* g_add, const float* g_out, bf16_t* obuf, const float* router_w) {
    FRESH(F);
    const int lane = F.lane;
    unsigned* tokinfo = (unsigned*)(F.ws + WS_TOKINFO);
    int* idxe = (int*)(F.ws + WS_IDXE);
    unsigned* gcnt = (unsigned*)(F.ctl + CW_CNT);
    LAS float* rwT = (LAS float*)(F.lds);
    LAS unsigned* lcnt = (LAS unsigned*)(F.lds + 32768);
    LAS unsigned* rinfo = (LAS unsigned*)(F.lds + 32768 + 64);
    if constexpr (ROUTE) {
        for (int i = F.tid; i < D * NE; i += NTHR) rwT[(i & 7) * D + (i >> 3)] = router_w[i];
        if (F.tid < 16) lcnt[F.tid] = 0u;
        __syncthreads();
    }
    int pbase[8];
    if constexpr (SRC == 2) { int acc = 0;
#pragma unroll
        for (int e = 0; e < 8; ++e) { pbase[e] = acc; acc += (((int)gcnt[e] + 255) >> 8) << 8; } }
    f32x4 ga[4], go[4];
#pragma unroll
    for (int j = 0; j < 4; ++j) { ga[j] = (SRC != 0) ? ((const f32x4*)g_add)[lane + 64 * j] : (f32x4){0.f, 0.f, 0.f, 0.f}; go[j] = (OUT == 1) ? ((const f32x4*)g_out)[lane + 64 * j] : (f32x4){0.f, 0.f, 0.f, 0.f}; }
    const int gw = F.vcu * NWAVES + F.wave, NGW = F.G * NWAVES;
    int rs = 0;
#ifdef THIN_PF
    f32x4 nxf[4]; u32x2 nxb[4], nyb[4];
#define THIN_LOAD(mm) do { const int m_ = (mm); \
        if (SRC == 0 || xin != nullptr) { _Pragma("unroll") for (int j = 0; j < 4; ++j) nxf[j] = ((const f32x4*)(xin + (size_t)m_ * D))[lane + 64 * j]; } \
        else { _Pragma("unroll") for (int j = 0; j < 4; ++j) nxb[j] = ((const u32x2*)(F.xs + (size_t)m_ * D))[lane + 64 * j]; } \
        if (SRC == 1) { _Pragma("unroll") for (int j = 0; j < 4; ++j) nyb[j] = ((const u32x2*)(ysrc + (size_t)m_ * D))[lane + 64 * j]; } } while (0)
    if (gw < T) THIN_LOAD(gw);
#endif
    for (int m = gw; m < T; m += NGW, ++rs) {
        f32x4 xv[4];
#ifdef THIN_PF
        f32x4 cxf[4]; u32x2 cxb[4], cyb[4];
#pragma unroll
        for (int j = 0; j < 4; ++j) { cxf[j] = nxf[j]; cxb[j] = nxb[j]; cyb[j] = nyb[j]; }
        if (m + NGW < T) THIN_LOAD(m + NGW);
#endif
        if constexpr (SRC == 0) {
#pragma unroll
#ifdef THIN_PF
            for (int j = 0; j < 4; ++j) xv[j] = cxf[j];
#else
            for (int j = 0; j < 4; ++j) xv[j] = ((const f32x4*)(xin + (size_t)m * D))[lane + 64 * j];
#endif
        } else {
            f32x4 yv[4];
#ifdef THIN_PF
            if constexpr (SRC == 1) {
#pragma unroll
                for (int j = 0; j < 4; ++j) yv[j] = (f32x4){bf_lo(cyb[j].x), bf_hi(cyb[j].x), bf_lo(cyb[j].y), bf_hi(cyb[j].y)}; }
#else
            if constexpr (SRC == 1) ld_bf16_row(ysrc + (size_t)m * D, lane, yv);
#endif
            else {
                const unsigned* ti = tokinfo + (size_t)m * 8;
                const int e1 = (int)ti[0], p1 = (int)ti[1], e2 = (int)ti[2], p2 = (int)ti[3]; const float w1 = __uint_as_float(ti[4]), w2 = __uint_as_float(ti[5]);
                int b1 = 0, b2 = 0;
#pragma unroll
                for (int e = 0; e < 8; ++e) { b1 = (e == e1) ? pbase[e] : b1; b2 = (e == e2) ? pbase[e] : b2; }
                f32x4 ya[4], yb[4];
                ld_moe_row(F.ws, b1 + p1, lane, ya); ld_moe_row(F.ws, b2 + p2, lane, yb);
#pragma unroll
                for (int j = 0; j < 4; ++j) yv[j] = ya[j] * w1 + yb[j] * w2;
            }
            const float rstd = __builtin_amdgcn_rsqf(sumsq16(yv) * (1.f / D) + EPS);
#ifdef THIN_PF
            if (xin) {
#pragma unroll
                for (int j = 0; j < 4; ++j) xv[j] = cxf[j] + yv[j] * rstd * ga[j];
            } else {
#pragma unroll
                for (int j = 0; j < 4; ++j) xv[j] = (f32x4){bf_lo(cxb[j].x), bf_hi(cxb[j].x), bf_lo(cxb[j].y), bf_hi(cxb[j].y)} + yv[j] * rstd * ga[j]; }
#else
            if (xin) {
#pragma unroll
                for (int j = 0; j < 4; ++j) { const f32x4 xo = ((const f32x4*)(xin + (size_t)m * D))[lane + 64 * j]; xv[j] = xo + yv[j] * rstd * ga[j]; }
            } else { f32x4 xo[4]; ld_bf16_row(F.xs + (size_t)m * D, lane, xo);
#pragma unroll
                for (int j = 0; j < 4; ++j) xv[j] = xo[j] + yv[j] * rstd * ga[j]; }
#endif
        }
#ifdef SIM_XBF16
        if constexpr (SRC != 0 && OUT != 0) {
#pragma unroll
            for (int j = 0; j < 4; ++j) { const unsigned a = cvt_pk_bf16(xv[j].x, xv[j].y), b = cvt_pk_bf16(xv[j].z, xv[j].w); xv[j] = (f32x4){bf_lo(a), bf_hi(a), bf_lo(b), bf_hi(b)}; } }
#endif
        if constexpr (SRC != 0) {
#pragma unroll
            for (int j = 0; j < 4; ++j) { if constexpr (OUT == 0) ((f32x4*)(F.x + (size_t)m * D))[lane + 64 * j] = xv[j]; }
            if constexpr (OUT != 0) st_bf16_row(F.xs + (size_t)m * D, lane, xv); }
        if constexpr (OUT == 1) {
            const float rstd = __builtin_amdgcn_rsqf(sumsq16(xv) * (1.f / D) + EPS);
            f32x4 hv[4];
#pragma unroll
            for (int j = 0; j < 4; ++j) hv[j] = xv[j] * rstd * go[j];
#ifdef SIM_FFN0
            if (!ROUTE && xin != nullptr) {
#pragma unroll
                for (int j = 0; j < 4; ++j) hv[j] = (f32x4){q8(hv[j].x, 1.f), q8(hv[j].y, 1.f), q8(hv[j].z, 1.f), q8(hv[j].w, 1.f)}; }
#endif
#if MOE_FP8
            if constexpr (ROUTE) {
#pragma unroll
                for (int j = 0; j < 4; ++j) ((unsigned*)((unsigned char*)obuf + (size_t)m * D))[lane + 64 * j] = pk4_fp8(hv[j].x, hv[j].y, hv[j].z, hv[j].w);
            } else
#elif defined(SIM_FP8)
            if constexpr (ROUTE) { f32x4 hq[4];
#pragma unroll
                for (int j = 0; j < 4; ++j) hq[j] = (f32x4){q8(hv[j].x, 1.f), q8(hv[j].y, 1.f), q8(hv[j].z, 1.f), q8(hv[j].w, 1.f)};
                st_bf16_row(obuf + (size_t)m * D, lane, hq); } else
#endif

            st_bf16_row(obuf + (size_t)m * D, lane, hv);
            if constexpr (ROUTE) {
                float lg[8];
#pragma unroll
                for (int e = 0; e < 8; ++e) { float s = 0.f;
#pragma unroll
                    for (int j = 0; j < 4; ++j) { const f32x4 w = *(const LAS f32x4*)(rwT + e * D + 4 * lane + 256 * j); s += (hv[j].x * w.x + hv[j].y * w.y) + (hv[j].z * w.z + hv[j].w * w.w); }
                    lg[e] = wave_sum(s); }
                int e1 = 0; float v1 = lg[0];
#pragma unroll
                for (int e = 1; e < 8; ++e) if (lg[e] > v1) { v1 = lg[e]; e1 = e; }
                int e2 = -1; float v2 = -3.0e38f;
#pragma unroll
                for (int e = 0; e < 8; ++e) if (e != e1 && lg[e] > v2) { v2 = lg[e]; e2 = e; }
                const float ex = __expf(v2 - v1), w1 = 1.f / (1.f + ex), w2 = ex * w1;
                if (lane == 0) {
                    const unsigned p1 = atomicAdd((unsigned*)&lcnt[e1], 1u), p2 = atomicAdd((unsigned*)&lcnt[e2], 1u);
                    LAS unsigned* ri = rinfo + (F.wave * 8 + rs) * 6;
                    ri[0] = (unsigned)e1; ri[1] = p1; ri[2] = (unsigned)e2; ri[3] = p2; ri[4] = __float_as_uint(w1); ri[5] = __float_as_uint(w2);
                }
            }
        }
    }
    if constexpr (ROUTE) {
        __syncthreads();
        if (F.tid < 8) lcnt[8 + F.tid] = __hip_atomic_fetch_add(gcnt + F.tid, lcnt[F.tid], RLX_AGENT);
        __syncthreads();
        if (lane < rs) {
            const int m = gw + lane * NGW; const LAS unsigned* ri = rinfo + (F.wave * 8 + lane) * 6;
            const unsigned e1 = ri[0], e2 = ri[2]; const unsigned p1 = ri[1] + lcnt[8 + e1], p2 = ri[3] + lcnt[8 + e2];
            unsigned* ti = tokinfo + (size_t)m * 8; ti[0] = e1; ti[1] = p1; ti[2] = e2; ti[3] = p2; ti[4] = ri[4]; ti[5] = ri[5];
            idxe[e1 * 16384 + p1] = m; idxe[e2 * 16384 + p2] = m;
        }
    }
}
#if defined(SIM_FP8) || defined(SIM_FFN0)
#define SIMQ(x, s) (((s) != 0.f) ? q8((x), (s)) : (x))
#else
#define SIMQ(x, s) (x)
#endif
struct TrItem { const float* src; int pitch; bf16_t* dst; int dstK; int ncols; float qs; int f8; };
#ifdef TR_NT
#define TR_LD(p) __builtin_nontemporal_load(p)
#else
#define TR_LD(p) (*(p))
#endif
#define TR_LOAD(t, v) do { _Pragma("unroll") for (int i = 0; i < 64; ++i) { const int kk = 2 * i + (lane >> 5); v[i] = ((lane & 31) < (t).ncols) ? TR_LD((t).src + (size_t)kk * (t).pitch + (lane & 31)) : 0.f; } } while (0)
__device__ __forceinline__ void tr_finish(const TrItem& t, float (&v)[64], LAS float* scr, int lane, bool nostore = false) {
    const int c = lane & 31;
#pragma unroll
    for (int p = 0; p < 2; ++p) {
#pragma unroll
        for (int i = 0; i < 32; ++i) { const int kk = 2 * i + (lane >> 5); scr[kk * 33 + c] = SIMQ(v[32 * p + i], t.qs); }
        LDS_WAIT(); asm volatile("" ::: "memory");
        if (t.f8) {
            const int c4 = lane & 3;
#pragma unroll
            for (int j = 0; j < 2; ++j) { const int n = (lane >> 2) + 16 * j; const LAS float* s = scr + (16 * c4) * 33 + n;
                u32x4 o; o.x = pk4_fp8(s[0 * 33] * W8_SCALE, s[1 * 33] * W8_SCALE, s[2 * 33] * W8_SCALE, s[3 * 33] * W8_SCALE); o.y = pk4_fp8(s[4 * 33] * W8_SCALE, s[5 * 33] * W8_SCALE, s[6 * 33] * W8_SCALE, s[7 * 33] * W8_SCALE);
                o.z = pk4_fp8(s[8 * 33] * W8_SCALE, s[9 * 33] * W8_SCALE, s[10 * 33] * W8_SCALE, s[11 * 33] * W8_SCALE); o.w = pk4_fp8(s[12 * 33] * W8_SCALE, s[13 * 33] * W8_SCALE, s[14 * 33] * W8_SCALE, s[15 * 33] * W8_SCALE);
                if (!nostore) *(u32x4*)((unsigned char*)t.dst + (size_t)n * t.dstK + 64 * p + 16 * c4) = o; }
        } else {
            const int c8 = lane & 7;
#pragma unroll
            for (int j = 0; j < 4; ++j) { const int n = (lane >> 3) + 8 * j; const LAS float* s = scr + (8 * c8) * 33 + n;
                u32x4 o; o.x = cvt_pk_bf16(s[0 * 33], s[1 * 33]); o.y = cvt_pk_bf16(s[2 * 33], s[3 * 33]); o.z = cvt_pk_bf16(s[4 * 33], s[5 * 33]); o.w = cvt_pk_bf16(s[6 * 33], s[7 * 33]);
                if (n < t.ncols && !nostore) *(u32x4*)(t.dst + (size_t)n * t.dstK + 64 * p + 8 * c8) = o; }
        }
        LDS_WAIT(); asm volatile("" ::: "memory");
    }
}
constexpr int IT_COMMON = 640 + 640 + 8 + 128 + 128 + 256 + 64 + 256;
constexpr int IT_FFN = 3 * 704, IT_MOE1 = 8 * 896;
constexpr int IT_TOTAL = 2 * IT_COMMON + IT_FFN + 3 * IT_MOE1;
__device__ __forceinline__ TrItem seg_plain(const float* src, int K, int N, int pitch, bf16_t* dst, int r) {
#ifdef TR_NFAST
    const int nnb = N / 32, kb = r / nnb, nb = r % nnb;
#else
    const int nkb = K / 128, nb = r / nkb, kb = r % nkb;
#endif
    return TrItem{src + (size_t)kb * 128 * pitch + nb * 32, pitch, dst + (size_t)(nb * 32) * K + kb * 128, K, 32, 0.f, 0};
}
__device__ __forceinline__ TrItem seg_gu(const float* src, int N, bf16_t* dst, int up, int r) {
#ifdef TR_NFAST
    const int kb = r / (N / 32), nb = r % (N / 32), n0 = nb * 32;
#else
    const int nb = r / (D / 128), kb = r % (D / 128), n0 = nb * 32;
#endif
    return TrItem{src + (size_t)kb * 128 * N + n0, N, dst + (size_t)((n0 >> 7) * 256 + (n0 & 127) + up * 128) * D + kb * 128, D, 32, 0.f, 0};
}
__device__ __forceinline__ TrItem decode_item(const Args& a, unsigned char* ws, int it) {
    if (it < 2 * IT_COMMON) {
        const int l = it / IT_COMMON; int r = it % IT_COMMON; unsigned char* wb = ws + (l ? WS_W1 : WS_W0);
        const float* win = a.in[I_WIN] + (size_t)l * D * INW;
        if (r < 640) return seg_plain(win, D, 2560, INW, (bf16_t*)(wb + OFF_WIN), r); r -= 640;
        if (r < 640) return seg_plain(win + 2576, D, 2560, INW, (bf16_t*)(wb + OFF_WIN) + (size_t)2560 * D, r); r -= 640;
        if (r < 8) return TrItem{win + (size_t)r * 128 * INW + 2560, INW, (bf16_t*)(wb + OFF_WGD) + r * 128, D, 16, 0.f, 0}; r -= 8;
        if (r < 128) return seg_plain(a.in[I_WBA] + (size_t)l * 512 * D, 512, D, D, (bf16_t*)(wb + OFF_WBA), r); r -= 128;
        if (r < 128) return seg_plain(a.in[I_WBB] + (size_t)l * 512 * D, 512, D, D, (bf16_t*)(wb + OFF_WBB), r); r -= 128;
        if (r < 256) return seg_plain(a.in[I_WOUT] + (size_t)l * D * D, D, D, D, (bf16_t*)(wb + OFF_WOUT), r); r -= 256;
        if (r < 64) return seg_plain(a.in[I_PP] + (size_t)l * PLE * D, PLE, D, D, (bf16_t*)(wb + OFF_WPP), r); r -= 64;
        return seg_plain(a.in[I_PG] + (size_t)l * D * D, D, D, D, (bf16_t*)(wb + OFF_WPG), r);
    }
    it -= 2 * IT_COMMON;
    if (it < IT_FFN) {
        unsigned char* wb = ws + WS_W0;
        TrItem t;
        if (it < 704) t = seg_gu(a.in[I_FG], DFF, (bf16_t*)(wb + OFF_FFN), 0, it);
        else if (it < 1408) t = seg_gu(a.in[I_FU], DFF, (bf16_t*)(wb + OFF_FFN), 1, it - 704);
        else t = seg_plain(a.in[I_FD], DFF, D, D, (bf16_t*)(wb + OFF_FDN), it - 1408);
#ifdef SIM_FFN0
        t.qs = 64.f;
#endif
        return t;
    }
    it -= IT_FFN;
    unsigned char* wb = ws + WS_W1;
    const int kind = it / IT_MOE1, r0 = it % IT_MOE1, e = r0 / 896, r = r0 % 896;
    TrItem t;
#if MOE_FP8
    {
#ifdef TR_NFAST
      const int nnb8 = (kind == 2 ? D : DFE) / 32, kb8 = r / nnb8, nb8 = r % nnb8, n0 = nb8 * 32;
#else
      const int nkb8 = (kind == 2 ? DFE : D) / 128, nb8 = r / nkb8, kb8 = r % nkb8, n0 = nb8 * 32;
#endif
      if (kind == 2) return TrItem{a.in[I_MD] + (size_t)e * DFE * D + (size_t)kb8 * 128 * D + n0, D, (bf16_t*)(wb + OFF_MDN8 + (size_t)e * D * DFE + (size_t)n0 * DFE + kb8 * 128), DFE, 32, 0.f, 1};
      const float* src = (kind == 0 ? a.in[I_MG] : a.in[I_MU]) + (size_t)e * D * DFE + (size_t)kb8 * 128 * DFE + n0;
      return TrItem{src, DFE, (bf16_t*)(wb + OFF_FFN + (size_t)e * 7168 * D + (size_t)((n0 >> 7) * 256 + (n0 & 127) + (kind == 1 ? 128 : 0)) * D + kb8 * 128), D, 32, 0.f, 1}; }
#endif
    if (kind == 0) t = seg_gu(a.in[I_MG] + (size_t)e * D * DFE, DFE, (bf16_t*)(wb + OFF_FFN) + (size_t)e * 7168 * D, 0, r);
    else if (kind == 1) t = seg_gu(a.in[I_MU] + (size_t)e * D * DFE, DFE, (bf16_t*)(wb + OFF_FFN) + (size_t)e * 7168 * D, 1, r);
    else t = seg_plain(a.in[I_MD] + (size_t)e * DFE * D, DFE, D, D, (bf16_t*)(wb + OFF_MDN) + (size_t)e * D * DFE, r);
#ifdef SIM_FP8
    t.qs = 64.f;
#endif
    return t;
}
__device__ __forceinline__ void p0_prologue(Frame& F, const Args& a, int probe = 0) {
    FRESH(F);
    LAS float* scr = (LAS float*)(F.lds + F.wave * 16384);
    const int gw = F.vcu * NWAVES + F.wave, NGW = F.G * NWAVES;
    { const int lane = F.lane;
      for (int it = gw; it < IT_TOTAL; it += NGW) { const TrItem t = decode_item(a, F.ws, it); float v[64]; TR_LOAD(t, v); tr_finish(t, v, scr, lane, probe == 1); } }
    if (probe) return;
    { const f32x4* ps = (const f32x4*)a.in[I_P]; u32x4* pd = (u32x4*)(F.ws + WS_PB); const int n8 = 2 * T * PLE / 8;
#ifdef PCV_BATCH
      const int stride = F.G * NTHR;
      for (int i0 = blockIdx.x * NTHR + F.tid; i0 < n8; i0 += 8 * stride) { f32x4 v[8][2];
#pragma unroll
          for (int q = 0; q < 8; ++q) { const int i = i0 + q * stride; if (i < n8) { v[q][0] = ps[2 * i]; v[q][1] = ps[2 * i + 1]; } }
#pragma unroll
          for (int q = 0; q < 8; ++q) { const int i = i0 + q * stride; if (i < n8) { u32x4 w; w.x = cvt_pk_bf16(v[q][0].x, v[q][0].y); w.y = cvt_pk_bf16(v[q][0].z, v[q][0].w); w.z = cvt_pk_bf16(v[q][1].x, v[q][1].y); w.w = cvt_pk_bf16(v[q][1].z, v[q][1].w); pd[i] = w; } } }
#else
      for (int i = blockIdx.x * NTHR + F.tid; i < n8; i += F.G * NTHR) { const f32x4 v0 = ps[2 * i], v1 = ps[2 * i + 1];
          u32x4 w; w.x = cvt_pk_bf16(v0.x, v0.y); w.y = cvt_pk_bf16(v0.z, v0.w); w.z = cvt_pk_bf16(v1.x, v1.y); w.w = cvt_pk_bf16(v1.z, v1.w); pd[i] = w; }
#endif
    }
    thin_phase<0, 1, false>(F, a.in[I_X], nullptr, nullptr, a.in[I_NMPRE], (bf16_t*)(F.ws + WS_HB), nullptr);
}
typedef short v4i16_t __attribute__((ext_vector_type(4)));
__device__ __forceinline__ s16x4 lds_tr16(const LAS unsigned char* p) { return __builtin_bit_cast(s16x4, __builtin_amdgcn_ds_read_tr16_b64_v4i16((LAS v4i16_t*)p)); }
__device__ __forceinline__ bf16x8 cat8(s16x4 a, s16x4 b) { return (bf16x8){a[0], a[1], a[2], a[3], b[0], b[1], b[2], b[3]}; }

__device__ __forceinline__ void attn_unit(Frame& F, int b, int c, const float* relb) {
    FRESH(F);
    const int lane = F.lane, h = F.wave, n = lane & 15, mq = lane >> 4;
    const bf16_t* qa = (const bf16_t*)(F.ws + WS_QA); const bf16_t* ka = (const bf16_t*)(F.ws + WS_KA); const bf16_t* va = (const bf16_t*)(F.ws + WS_VA);
    LAS unsigned char* kbuf = F.lds + h * 16384; LAS unsigned char* vbuf = kbuf + 8192;
    LAS float* rt = (LAS float*)(F.lds + XTRA_OFF + h * 1056);
    for (int i = lane; i < 256; i += 64) { const int j = i - 64; rt[i] = relb[h * RELN + 256 - (j > 0 ? j : 0)] * LOG2E; }
    const float bfar = relb[h * RELN + 256] * LOG2E;
    const int tok0 = b * SEQ + c * CH;
    bf16x8 qf[4][2];
#pragma unroll
    for (int qt = 0; qt < 4; ++qt)
#pragma unroll
        for (int ks = 0; ks < 2; ++ks) qf[qt][ks] = *(const bf16x8*)(qa + (size_t)(tok0 + 16 * qt + n) * 512 + h * 64 + 32 * ks + 8 * mq);
    const int koff_e = (lane >> 3) * 512 + (((lane & 7) ^ ((lane >> 4) & 7)) * 8), koff_o = (lane >> 3) * 512 + (((lane & 7) ^ ((4 + (lane >> 4)) & 7)) * 8);
    const int voff = (lane >> 3) * 512 + ((2 * (((lane & 7) >> 1) ^ (lane >> 4)) + (lane & 1)) * 8);
#define ATT_DMA_K(j) do { const bf16_t* _s = ka + (size_t)(b * SEQ + (j) * CH) * 512 + h * 64; _Pragma("unroll") for (int _i = 0; _i < 8; ++_i) \
        __builtin_amdgcn_global_load_lds((const unsigned*)(_s + (size_t)_i * 8 * 512 + ((_i & 1) ? koff_o : koff_e)), (LAS unsigned*)(kbuf + _i * 1024), 16, 0, 0); } while (0)
#define ATT_DMA_V(j) do { const bf16_t* _s = va + (size_t)(b * SEQ + (j) * CH) * 512 + h * 64; _Pragma("unroll") for (int _i = 0; _i < 8; ++_i) \
        __builtin_amdgcn_global_load_lds((const unsigned*)(_s + (size_t)_i * 8 * 512 + voff), (LAS unsigned*)(vbuf + _i * 1024), 16, 0, 0); } while (0)
    const int ka0 = n * 128 + (((0 + mq) ^ (n >> 1)) * 16), ka1 = n * 128 + (((4 + mq) ^ (n >> 1)) * 16);
    const int qp = n >> 2, pp = lane & 3, sw = 2 * (mq & 1) + (qp >> 1);
    const int vrow = (4 * mq + qp) * 128 + 8 * pp;
    f32x4 O[4][4]; float mrun[4], lsum[4];
#pragma unroll
    for (int qt = 0; qt < 4; ++qt) { mrun[qt] = -1.0e30f; lsum[qt] = 0.f;
#pragma unroll
        for (int dt = 0; dt < 4; ++dt) O[qt][dt] = (f32x4){0.f, 0.f, 0.f, 0.f}; }
#if defined(ATT_REG) && ATT_REG == 1
    constexpr int QN = 1;
#else
    constexpr int QN = 2;
#endif
    const int j0 = (c - NPREV) > 0 ? (c - NPREV) : 0;
    ATT_DMA_K(j0); ATT_DMA_V(j0);
    for (int j = j0; j <= c; ++j) {
        const int dc = c - j;
        asm volatile("s_waitcnt vmcnt(8)" ::: "memory");
#ifdef ATT_REG
        bf16x8 kf[4][2], vfr[4][2];
#if ATT_REG == 1
#pragma unroll
        for (int kt = 0; kt < 4; ++kt) { kf[kt][0] = *(const LAS bf16x8*)(kbuf + kt * 2048 + ka0); kf[kt][1] = *(const LAS bf16x8*)(kbuf + kt * 2048 + ka1); }
        LDS_WAIT();
        if (j < c) { ATT_DMA_K(j + 1); asm volatile("s_waitcnt vmcnt(8)" ::: "memory"); } else asm volatile("s_waitcnt vmcnt(0)" ::: "memory");
#else
        asm volatile("s_waitcnt vmcnt(0)" ::: "memory");
#endif
#pragma unroll
        for (int dt = 0; dt < 4; ++dt)
#pragma unroll
            for (int u = 0; u < 2; ++u) { const LAS unsigned char* vp = vbuf + vrow + (32 * u) * 128 + ((dt ^ sw) * 32); vfr[dt][u] = cat8(lds_tr16(vp), lds_tr16(vp + 16 * 128)); }
        LDS_WAIT();
        if (j < c) { ATT_DMA_V(j + 1); }
#endif
#pragma unroll
        for (int qg = 0; qg < 4 / QN; ++qg) {
            f32x4 S[4][QN];
#pragma unroll
            for (int kt = 0; kt < 4; ++kt) {
#if defined(ATT_REG) && ATT_REG == 1
                const bf16x8 k0 = kf[kt][0], k1 = kf[kt][1];
#else
                const bf16x8 k0 = *(const LAS bf16x8*)(kbuf + kt * 2048 + ka0), k1 = *(const LAS bf16x8*)(kbuf + kt * 2048 + ka1);
#endif
#pragma unroll
                for (int q2 = 0; q2 < QN; ++q2) { f32x4 z = (f32x4){0.f, 0.f, 0.f, 0.f};
                    z = __builtin_amdgcn_mfma_f32_16x16x32_bf16(k0, qf[QN * qg + q2][0], z, 0, 0, 0);
                    S[kt][q2] = __builtin_amdgcn_mfma_f32_16x16x32_bf16(k1, qf[QN * qg + q2][1], z, 0, 0, 0); }
            }
#if !defined(ATT_REG) || ATT_REG != 1
            if (qg == 4 / QN - 1) { if (j < c) { LDS_WAIT(); ATT_DMA_K(j + 1); } }
#endif
            bf16x8 P[QN][2];
#pragma unroll
            for (int q2 = 0; q2 < QN; ++q2) { const int qt = QN * qg + q2;
                if (dc >= 3) {
                    asm volatile("" ::: "memory");
#pragma unroll
                    for (int kt = 0; kt < 4; ++kt) S[kt][q2] = S[kt][q2] + bfar;
                } else {
                    asm volatile("" ::: "memory");
                    const LAS float* rp = rt + (64 + 128 - (64 * dc + 16 * qt + n - 4 * mq));
                    float bv[4][4];
#pragma unroll
                    for (int kt = 0; kt < 4; ++kt)
#pragma unroll
                        for (int i = 0; i < 4; ++i) bv[kt][i] = rp[16 * kt + i];
#pragma unroll
                    for (int kt = 0; kt < 4; ++kt)
#pragma unroll
                        for (int i = 0; i < 4; ++i) S[kt][q2][i] += bv[kt][i];
                }
                float cm = S[0][q2][0];
#pragma unroll
                for (int kt = 0; kt < 4; ++kt)
#pragma unroll
                    for (int i = 0; i < 4; ++i) cm = fmaxf(cm, S[kt][q2][i]);
                cm = max_x16_x32(cm);
                const float mn = fmaxf(mrun[qt], cm), alpha = __builtin_amdgcn_exp2f(mrun[qt] - mn); mrun[qt] = mn;
                float ps = 0.f;
#pragma unroll
                for (int kt = 0; kt < 4; ++kt)
#pragma unroll
                    for (int i = 0; i < 4; ++i) { const float p = __builtin_amdgcn_exp2f(S[kt][q2][i] - mn); S[kt][q2][i] = p; ps += p; }
                lsum[qt] = lsum[qt] * alpha + ps;
#pragma unroll
                for (int dt = 0; dt < 4; ++dt) O[qt][dt] = O[qt][dt] * alpha;
#pragma unroll
                for (int u = 0; u < 2; ++u) { u32x4 w; w.x = cvt_pk_bf16(S[2 * u][q2][0], S[2 * u][q2][1]); w.y = cvt_pk_bf16(S[2 * u][q2][2], S[2 * u][q2][3]);
                    w.z = cvt_pk_bf16(S[2 * u + 1][q2][0], S[2 * u + 1][q2][1]); w.w = cvt_pk_bf16(S[2 * u + 1][q2][2], S[2 * u + 1][q2][3]); P[q2][u] = __builtin_bit_cast(bf16x8, w); }
            }
#ifndef ATT_REG
            if (qg == 0) asm volatile("s_waitcnt vmcnt(0)" ::: "memory");
#endif
#pragma unroll
            for (int dt = 0; dt < 4; ++dt)
#pragma unroll
                for (int u = 0; u < 2; ++u) {
#ifdef ATT_REG
                    const bf16x8 vf = vfr[dt][u];
#else
                    const LAS unsigned char* vp = vbuf + vrow + (32 * u) * 128 + ((dt ^ sw) * 32);
                    const bf16x8 vf = cat8(lds_tr16(vp), lds_tr16(vp + 16 * 128));
#endif
#pragma unroll
                    for (int q2 = 0; q2 < QN; ++q2) O[QN * qg + q2][dt] = __builtin_amdgcn_mfma_f32_16x16x32_bf16(vf, P[q2][u], O[QN * qg + q2][dt], 0, 0, 0);
                }
#ifndef ATT_REG
            if (qg == 4 / QN - 1) { if (j < c) { LDS_WAIT(); ATT_DMA_V(j + 1); } }
#endif
        }
    }
#undef ATT_DMA_K
#undef ATT_DMA_V
    bf16_t* ya = (bf16_t*)(F.ws + WS_YA);
    int ln = lane; asm volatile("" : "+v"(ln)); const int n_o = ln & 15, mq_o = ln >> 4;
#pragma unroll
    for (int qt = 0; qt < 4; ++qt) { float l = sum_x16_x32(lsum[qt]); const float rl = __builtin_amdgcn_rcpf(l);
#pragma unroll
        for (int dt = 0; dt < 4; ++dt) { const f32x4 o = O[qt][dt] * rl; u32x2 w; w.x = cvt_pk_bf16(o[0], o[1]); w.y = cvt_pk_bf16(o[2], o[3]);
            *(u32x2*)(ya + (size_t)(tok0 + 16 * qt + n_o) * 512 + h * 64 + 16 * dt + 4 * mq_o) = w; } }
}

__device__ __forceinline__ void gla_dstate_unit(Frame& F, int b, int c, const bf16_t* wgd_t, const float* wup, const float* bgate) {
    FRESH(F);
    const int lane = F.lane, w = F.wave, tid = F.tid, n = lane & 15, mq = lane >> 4;
    const int tok0 = b * SEQ + c * CH;
    const bf16_t* hb = (const bf16_t*)(F.ws + WS_HB); const bf16_t* kb = (const bf16_t*)(F.ws + WS_KB); const bf16_t* vb = (const bf16_t*)(F.ws + WS_VB);
    LAS float* GD8 = (LAS float*)(F.lds); LAS unsigned char* VB = F.lds + 32768; LAS unsigned char* KD = F.lds + 98304;
    LAS float* GDF = (LAS float*)(F.lds + XTRA_OFF); LAS float* TOT = (LAS float*)(F.lds + XTRA_OFF + 4096);
    __syncthreads();
    const int col = tid & 255, hf = tid >> 8;
    float wu[16];
#pragma unroll
    for (int r = 0; r < 16; ++r) wu[r] = wup[r * 256 + col];
    const float bb = bgate[col];
    unsigned short kraw[32];
#pragma unroll
    for (int l = 0; l < 32; ++l) kraw[l] = kb[(size_t)(tok0 + 32 * hf + l) * 256 + col];
#pragma unroll
    for (int i = 0; i < 8; ++i) { const int p = (w * 8 + i) * 64 + lane, row = p >> 6, ch = p & 63;
        __builtin_amdgcn_global_load_lds((const unsigned*)(vb + (size_t)(tok0 + row) * 512 + ch * 8), (LAS unsigned*)(VB + (w * 8 + i) * 1024), 16, 0, 0); }
    { bf16x8 af[4][4], bf[4];
#pragma unroll
      for (int ks = 0; ks < 4; ++ks) { bf[ks] = *(const bf16x8*)(wgd_t + (size_t)n * D + 128 * w + 32 * ks + 8 * mq);
#pragma unroll
          for (int mt = 0; mt < 4; ++mt) af[mt][ks] = *(const bf16x8*)(hb + (size_t)(tok0 + 16 * mt + n) * D + 128 * w + 32 * ks + 8 * mq); }
#pragma unroll
      for (int mt = 0; mt < 4; ++mt) { f32x4 acc = (f32x4){0.f, 0.f, 0.f, 0.f};
#pragma unroll
          for (int ks = 0; ks < 4; ++ks) acc = __builtin_amdgcn_mfma_f32_16x16x32_bf16(af[mt][ks], bf[ks], acc, 0, 0, 0);
#pragma unroll
          for (int i = 0; i < 4; ++i) GD8[(w * 64 + 16 * mt + 4 * mq + i) * 16 + n] = acc[i]; } }
    __syncthreads();
    { const f32x2 z2 = (f32x2){0.f, 0.f}; f32x2 sacc = z2;
#pragma unroll
      for (int q = 0; q < 8; ++q) sacc = sacc + *(const LAS f32x2*)(GD8 + q * 1024 + 2 * tid);
      *(LAS f32x2*)(GDF + 2 * tid) = sacc; }
    __syncthreads();
    { float cum[32]; float run = 0.f;
#pragma unroll
      for (int l = 0; l < 32; ++l) { const int row = 32 * hf + l; float z = bb;
#pragma unroll
          for (int r4 = 0; r4 < 4; ++r4) { const f32x4 a = *(const LAS f32x4*)(GDF + row * 16 + 4 * r4);
              z += a.x * wu[4 * r4] + a.y * wu[4 * r4 + 1] + a.z * wu[4 * r4 + 2] + a.w * wu[4 * r4 + 3]; }
          const float la = (fminf(z, 0.f) - __logf(1.f + __expf(-fabsf(z)))) * (1.f / 16.f);
          run += la; cum[l] = run; }
      LAS float* TOT1 = TOT + 256;
      if (hf == 0) TOT[col] = run;
      __syncthreads();
      const float tot = (hf == 1) ? TOT[col] : 0.f;
      if (hf == 1) TOT1[col] = run + tot;
      __syncthreads();
      const float ctot = TOT1[col];
      if (hf == 1) ((float*)(F.ws + WS_DEC))[(size_t)(b * NCH + c) * 256 + col] = __expf(ctot);
      unsigned pk[16];
#pragma unroll
      for (int l = 0; l < 32; l += 2) { const float k0 = bf2f(kraw[l]), k1 = bf2f(kraw[l + 1]);
          pk[l >> 1] = cvt_pk_bf16(k0 * __expf(ctot - (cum[l] + tot)), k1 * __expf(ctot - (cum[l + 1] + tot))); }
#pragma unroll
      for (int q = 0; q < 4; ++q) *(LAS u32x4*)(KD + col * 128 + hf * 64 + q * 16) = (u32x4){pk[4 * q], pk[4 * q + 1], pk[4 * q + 2], pk[4 * q + 3]}; }
    VM_WAIT();
    __syncthreads();
    { const int hh = w >> 1, vh = w & 1, qp = n >> 2, pp = lane & 3;
      f32x4 acc[4][4];
#pragma unroll
      for (int mt = 0; mt < 4; ++mt)
#pragma unroll
          for (int nt = 0; nt < 4; ++nt) acc[mt][nt] = (f32x4){0.f, 0.f, 0.f, 0.f};
#pragma unroll
      for (int ks = 0; ks < 2; ++ks) {
          bf16x8 af[4];
#pragma unroll
          for (int mt = 0; mt < 4; ++mt) af[mt] = *(const LAS bf16x8*)(KD + (hh * 64 + 16 * mt + n) * 128 + (32 * ks + 8 * mq) * 2);
#pragma unroll
          for (int nt = 0; nt < 4; ++nt) {
              const LAS unsigned char* vp = VB + (size_t)(32 * ks + 8 * mq + qp) * 1024 + (hh * 128 + vh * 64 + 16 * nt + 4 * pp) * 2;
              const bf16x8 bfr = cat8(lds_tr16(vp), lds_tr16(vp + 4 * 1024));
#pragma unroll
              for (int mt = 0; mt < 4; ++mt) acc[mt][nt] = __builtin_amdgcn_mfma_f32_16x16x32_bf16(af[mt], bfr, acc[mt][nt], 0, 0, 0);
          }
      }
      float* dst = (float*)(F.ws + WS_DST) + ((size_t)((b * NCH + c) * BH + hh) * 128) * 64;
#pragma unroll
      for (int mt = 0; mt < 4; ++mt)
#pragma unroll
          for (int nt = 0; nt < 4; ++nt) *(f32x4*)(dst + (size_t)(vh * 64 + 16 * nt + n) * 64 + 16 * mt + 4 * mq) = acc[mt][nt]; }
    __syncthreads();
}

__device__ __forceinline__ void gla_scan_phase(Frame& F) {
    FRESH(F);
    const float* ds = (const float*)(F.ws + WS_DST); const float* dec = (const float*)(F.ws + WS_DEC); bf16_t* st = (bf16_t*)(F.ws + WS_ST);
    for (int e2 = blockIdx.x * NTHR + F.tid; e2 < NB * BH * 128 * 32; e2 += F.G * NTHR) {
        const int k2 = e2 & 31, v = (e2 >> 5) & 127, hh = (e2 >> 12) & 3, b = e2 >> 14;
        f32x2 s = (f32x2){0.f, 0.f};
#pragma unroll 8
        for (int c = 0; c < NCH; ++c) {
            const size_t off = ((size_t)((b * NCH + c) * BH + hh) * 128 + v) * 64 + 2 * k2;
            const f32x2 d = *(const f32x2*)(ds + off); const f32x2 a = *(const f32x2*)(dec + (size_t)(b * NCH + c) * 256 + hh * 64 + 2 * k2);
            s = a * s + d;
            *(unsigned*)(st + off) = cvt_pk_bf16(s.x, s.y);
        }
    }
}

__device__ __forceinline__ void gla_out_unit(Frame& F, int b, int c, const float* gnorm) {
    FRESH(F);
    const int lane = F.lane, w = F.wave, n = lane & 15, mq = lane >> 4;
    const int hh = w >> 1, th = w & 1, tok0 = b * SEQ + c * CH + 32 * th;
    const bf16_t* qb = (const bf16_t*)(F.ws + WS_QB); const bf16_t* st = (const bf16_t*)(F.ws + WS_ST) + ((size_t)((b * NCH + c) * BH + hh) * 128) * 64;
    const bf16_t* sr = (const bf16_t*)(F.ws + WS_SR); bf16_t* yb = (bf16_t*)(F.ws + WS_YB);
    bf16x8 qf[2][2];
#pragma unroll
    for (int nt = 0; nt < 2; ++nt)
#pragma unroll
        for (int ks = 0; ks < 2; ++ks) qf[nt][ks] = *(const bf16x8*)(qb + (size_t)(tok0 + 16 * nt + n) * 256 + hh * 64 + 32 * ks + 8 * mq);
    f32x4 acc[8][2];
#pragma unroll
    for (int mt = 0; mt < 8; ++mt) {
        const bf16x8 a0 = *(const bf16x8*)(st + (size_t)(16 * mt + n) * 64 + 8 * mq), a1 = *(const bf16x8*)(st + (size_t)(16 * mt + n) * 64 + 32 + 8 * mq);
#pragma unroll
        for (int nt = 0; nt < 2; ++nt) { f32x4 z = (f32x4){0.f, 0.f, 0.f, 0.f};
            z = __builtin_amdgcn_mfma_f32_16x16x32_bf16(a0, qf[nt][0], z, 0, 0, 0);
            acc[mt][nt] = __builtin_amdgcn_mfma_f32_16x16x32_bf16(a1, qf[nt][1], z, 0, 0, 0); }
    }
#pragma unroll
    for (int nt = 0; nt < 2; ++nt) { float ss = 0.f;
#pragma unroll
        for (int mt = 0; mt < 8; ++mt) ss += (acc[mt][nt][0] * acc[mt][nt][0] + acc[mt][nt][1] * acc[mt][nt][1]) + (acc[mt][nt][2] * acc[mt][nt][2] + acc[mt][nt][3] * acc[mt][nt][3]);
        ss = sum_x16_x32(ss);
        const float rstd = __builtin_amdgcn_rsqf(ss * (1.f / 128.f) + EPS);
#pragma unroll
        for (int mt = 0; mt < 8; ++mt) { const int col = hh * 128 + 16 * mt + 4 * mq; const f32x4 gn = *(const f32x4*)(gnorm + col);
            const size_t po = (size_t)(tok0 + 16 * nt + n) * 512 + col; const u32x2 rw = *(const u32x2*)(sr + po);
            const f32x4 o = acc[mt][nt] * rstd * gn; u32x2 wv; wv.x = cvt_pk_bf16(o[0] * bf_lo(rw.x), o[1] * bf_hi(rw.x)); wv.y = cvt_pk_bf16(o[2] * bf_lo(rw.y), o[3] * bf_hi(rw.y));
            *(u32x2*)(yb + po) = wv; } }
}
#ifndef PLE_MODE1
#define PLE_MODE1 3
#endif
#ifdef SIM_FP8
constexpr float MOE_ACT_QS = 8.f;
#else
constexpr float MOE_ACT_QS = 0.f;
#endif
#ifdef SIM_FFN0
constexpr float FFN0_ACT_QS = 8.f;
#else
constexpr float FFN0_ACT_QS = 0.f;
#endif
#ifndef PRO_PROBE
#define PRO_PROBE 0
#endif
#ifndef STAG_INPROJ
#define STAG_INPROJ 0
#endif
#ifdef KDBL
#define KDBL_F 0.5f
#else
#define KDBL_F 1.f
#endif
constexpr int N_PHASES = 25;
__global__ void __launch_bounds__(NTHR, 2) fwd(Args args) {
    extern __shared__ __attribute__((aligned(16))) unsigned char lds[];
    Frame F;
    F.lds = (LAS unsigned char*)lds;
    F.MISC = (volatile LAS unsigned*)(F.lds + MISC_OFF);
    F.tid = threadIdx.x; F.lane = F.tid & 63; F.wave = __builtin_amdgcn_readfirstlane(F.tid >> 6);
    F.G = gridDim.x; { const int bx = blockIdx.x; F.vcu = (F.G % 8 == 0) ? (bx % 8) * (F.G / 8) + bx / 8 : bx; }
    F.ws = args.ws; F.ctl = (gu32*)(args.ws + WS_CTL); F.x = args.out; F.xs = (bf16_t*)(args.ws + WS_XS);
    unsigned char* ws = args.ws;
    for (int u = F.tid; u < (LDS_BYTES - LDSCTL_OFF) / 4; u += NTHR) ((LAS unsigned*)(F.lds + LDSCTL_OFF))[u] = 0u;
    __syncthreads();
#ifdef MFMA_BENCH
    { f32x4 c0 = {0.f, 0.f, 0.f, 0.f}, c1 = c0, c2 = c0, c3 = c0; const int one = 0x7f7f7f7f;
      v8i32 a8 = {0x38383838, 0x38383838, 0x38383838, 0x38383838, 0x38383838, 0x38383838, 0x38383838, 0x38383838}, b8 = a8; bf16x8 ab = {0x3f80, 0x3f80, 0x3f80, 0x3f80, 0x3f80, 0x3f80, 0x3f80, 0x3f80}, bb = ab;
#ifdef MFMA_RAND
      { unsigned hsh = (threadIdx.x + 1u) * 2654435761u;
#pragma unroll
        for (int q = 0; q < 8; ++q) { hsh = hsh * 1664525u + 1013904223u; a8[q] = (int)(hsh & 0xbfbfbfbfu); hsh = hsh * 1664525u + 1013904223u; b8[q] = (int)(hsh & 0xbfbfbfbfu);
            hsh = hsh * 1664525u + 1013904223u; ab[q] = (short)(hsh & 0xbfff); hsh = hsh * 1664525u + 1013904223u; bb[q] = (short)(hsh & 0xbfff); } }
#endif
      asm volatile("" : "+v"(a8), "+v"(b8), "+v"(ab), "+v"(bb));
#pragma nounroll
      for (int i = 0; i < MFMA_BENCH; ++i) {
#if MFMA_KIND == 0
          asm volatile("v_mfma_scale_f32_16x16x128_f8f6f4 %0, %1, %2, %0, %3, %3 op_sel_hi:[0,0,0]" : "+v"(c0) : "v"(a8), "v"(b8), "v"(one));
          asm volatile("v_mfma_scale_f32_16x16x128_f8f6f4 %0, %1, %2, %0, %3, %3 op_sel_hi:[0,0,0]" : "+v"(c1) : "v"(a8), "v"(b8), "v"(one));
          asm volatile("v_mfma_scale_f32_16x16x128_f8f6f4 %0, %1, %2, %0, %3, %3 op_sel_hi:[0,0,0]" : "+v"(c2) : "v"(a8), "v"(b8), "v"(one));
          asm volatile("v_mfma_scale_f32_16x16x128_f8f6f4 %0, %1, %2, %0, %3, %3 op_sel_hi:[0,0,0]" : "+v"(c3) : "v"(a8), "v"(b8), "v"(one));
#else
          asm volatile("v_mfma_f32_16x16x32_bf16 %0, %1, %2, %0" : "+v"(c0) : "v"(ab), "v"(bb));
          asm volatile("v_mfma_f32_16x16x32_bf16 %0, %1, %2, %0" : "+v"(c1) : "v"(ab), "v"(bb));
          asm volatile("v_mfma_f32_16x16x32_bf16 %0, %1, %2, %0" : "+v"(c2) : "v"(ab), "v"(bb));
          asm volatile("v_mfma_f32_16x16x32_bf16 %0, %1, %2, %0" : "+v"(c3) : "v"(ab), "v"(bb));
#endif
      }
      asm volatile("s_nop 15\n\ts_nop 15" :: "v"(c0), "v"(c1), "v"(c2), "v"(c3)); }
#endif
    XcdBarrier bar = xcd_barrier_post((unsigned*)(F.ctl + CW_BAR), F.MISC + 8);
    const WT wt = make_wt(ws, (unsigned)WS_END);
    const int lo = args.ph_lo, hi = args.ph_hi;
#define PH_BEGIN const __attribute__((address_space(4))) Args* _ap = (const __attribute__((address_space(4))) Args*)__builtin_amdgcn_kernarg_segment_ptr(); asm volatile("" : "+s"(_ap)); const __attribute__((address_space(4))) Args& A = *_ap; unsigned char* ws = A.ws; \
    unsigned char* wb = ws + (l ? WS_W1 : WS_W0); bf16_t* hb = (bf16_t*)(ws + WS_HB); bf16_t* Y = (bf16_t*)(ws + WS_Y); const WT wt = make_wt(ws, (unsigned)WS_END); (void)wb; (void)hb; (void)Y; (void)wt; (void)A
#ifndef PHMASK
#define PHMASK 0x1fff
#endif
#define EN(i) (((PHMASK) >> (i)) & 1)
#ifndef REPMASK
#define REPMASK 0
#endif
#ifndef REPLAYER
#define REPLAYER 2
#endif
#define ZEROG ((const float*)(ws + WS_CTL + 131072))
#ifndef ZSKIP
#define ZSKIP 0
#endif
#define REPS(i) (((((REPMASK) >> (i)) & 1) && (REPLAYER == 2 || REPLAYER == l)) ? 2 : 1)
#define IN(k) (lo <= (k) && (k) < hi)
#ifndef SEAMREP
#define SEAMREP 1
#endif
#ifndef MK_STAMP
#define MK_STAMP 0
#endif
#ifndef STAMP_SEL
#define STAMP_SEL -1
#endif
#define SEAM(k) do { if (MK_STAMP && IN(k) && F.tid == 0) ((unsigned long long*)(ws + WS_CTL + 786432))[(k) * 256 + blockIdx.x] = __builtin_amdgcn_s_memrealtime(); \
    if (IN(k) && IN((k) + 1)) for (int _r = 0; _r < SEAMREP; ++_r) xcd_barrier(bar); } while (0)

    { const int l = 0; if (EN(12) && IN(0)) for (int rep = 0; rep < REPS(12); ++rep) { p0_prologue(F, args, rep == 0 ? 0 : PRO_PROBE); } }
    SEAM(0);
#ifndef LAYERREP
#define LAYERREP 0
#endif
    for (int l2 = 0; l2 < DEPTH + LAYERREP; ++l2) {
        const int l = (l2 < LAYERREP) ? 0 : l2 - LAYERREP; const bool zpass = (l2 < LAYERREP);
        const int pb = 1 + 12 * l;
        if (EN(0) && IN(pb + 0) && !(zpass && ((ZSKIP >> 0) & 1))) for (int rep = 0; rep < REPS(0); ++rep) { PH_BEGIN;
            pg8::Gemm g{hb, (const bf16_t*)(wb + OFF_WIN), D, 0, nullptr}; pg8::StaticOrder S; S.init(T, INWG, F.G, (int)blockIdx.x);
            pg8::EpiInProj E{(bf16_t*)(ws + WS_PROJ), wt};
            pg8::gemm_phase<pg8::EpiInProj, pg8::StaticOrder, false>(F.lds, g, S, E, STAG_INPROJ);
        }
        SEAM(pb + 0);
        if (EN(1) && IN(pb + 1) && !(zpass && ((ZSKIP >> 1) & 1))) for (int rep = 0; rep < REPS(1); ++rep) { PH_BEGIN;
            for (int u = F.vcu; u < NB * NCH; u += F.G) {
#ifndef NO_ATTN
#ifdef REP1_NO_ATTN
                if (rep == 0)
#endif
                attn_unit(F, u / NCH, u % NCH, A.in[I_RELB] + (size_t)l * AH * RELN);
#endif
#ifndef NO_GLA1
#ifdef REP1_NO_GLA
                if (rep == 0)
#endif
                gla_dstate_unit(F, u / NCH, u % NCH, (const bf16_t*)(wb + OFF_WGD), A.in[I_WGUP] + (size_t)l * GR * 256, A.in[I_BG] + (size_t)l * 256);
#endif
            }
        }
        SEAM(pb + 1);
        if (EN(2) && IN(pb + 2) && !(zpass && ((ZSKIP >> 2) & 1))) for (int rep = 0; rep < REPS(2); ++rep) { PH_BEGIN; gla_scan_phase(F); }
        SEAM(pb + 2);
        if (EN(3) && IN(pb + 3) && !(zpass && ((ZSKIP >> 3) & 1))) for (int rep = 0; rep < REPS(3); ++rep) { PH_BEGIN; for (int u = F.vcu; u < NB * NCH; u += F.G) gla_out_unit(F, u / NCH, u % NCH, A.in[I_GNORM] + (size_t)l * 512); }
        SEAM(pb + 3);
        if (EN(4) && IN(pb + 4) && !(zpass && ((ZSKIP >> 4) & 1))) for (int rep = 0; rep < REPS(4); ++rep) { PH_BEGIN;
            pg8::StaticOrder S; S.init(T, D, F.G, (int)blockIdx.x);
            { pg8::Gemm g{(const bf16_t*)(ws + WS_YA), (const bf16_t*)(wb + OFF_WBA), 512, 0, nullptr}; pg8::EpiEw<1> E{(bf16_t*)(ws + WS_MERGED), (const bf16_t*)(ws + WS_SGA), D, wt};
              pg8::gemm_phase<pg8::EpiEw<1>, pg8::StaticOrder, false>(F.lds, g, S, E); }
            { pg8::Gemm g{(const bf16_t*)(ws + WS_YB), (const bf16_t*)(wb + OFF_WBB), 512, 0, nullptr}; pg8::EpiEw<2> E{(bf16_t*)(ws + WS_MERGED), (const bf16_t*)(ws + WS_SGB), D, wt};
              pg8::gemm_phase<pg8::EpiEw<2>, pg8::StaticOrder, false>(F.lds, g, S, E); }
        }
        SEAM(pb + 4);
        if (EN(5) && IN(pb + 5) && !(zpass && ((ZSKIP >> 5) & 1))) for (int rep = 0; rep < REPS(5); ++rep) { PH_BEGIN;
            pg8::StaticOrder S; S.init(T, D, F.G, (int)blockIdx.x);
            pg8::Gemm g{(const bf16_t*)(ws + WS_MERGED), (const bf16_t*)(wb + OFF_WOUT), D, 0, nullptr}; pg8::EpiEw<0> E{Y, nullptr, D, wt};
            pg8::gemm_phase<pg8::EpiEw<0>, pg8::StaticOrder, false>(F.lds, g, S, E);
        }
        SEAM(pb + 5);
        if (EN(6) && IN(pb + 6) && !(zpass && ((ZSKIP >> 6) & 1))) for (int rep = 0; rep < ((l == 0) ? REPS(6) : 1); ++rep) { PH_BEGIN;
            if (l == 0) thin_phase<1, 1, false>(F, (LAYERREP == 0 && REPS(6) == 1) ? A.in[I_X] : nullptr, Y, (zpass || rep + 1 < REPS(6)) ? ZEROG : A.in[I_NMPOST] + (size_t)l * D, A.in[I_NFPRE] + (size_t)l * D, hb, nullptr);
            else        thin_phase<1, 1, true>(F, nullptr, Y, A.in[I_NMPOST] + (size_t)l * D, A.in[I_NFPRE] + (size_t)l * D, hb, A.in[I_RW]);
        }
        SEAM(pb + 6);
        if (EN(7) && IN(pb + 7) && !(zpass && ((ZSKIP >> 7) & 1))) for (int rep = 0; rep < REPS(7); ++rep) { PH_BEGIN;
            if (l == 0) { pg8::StaticOrder S; S.init(T, 2 * DFF, F.G, (int)blockIdx.x);
                pg8::Gemm g{hb, (const bf16_t*)(wb + OFF_FFN), D, 0, nullptr}; pg8::EpiGateUp E{(bf16_t*)(ws + WS_FACT), DFF, wt, FFN0_ACT_QS};
                pg8::gemm_phase<pg8::EpiGateUp, pg8::StaticOrder, false>(F.lds, g, S, E);
            } else { pg8::GroupedOrder S; S.init((const unsigned*)(F.ctl + CW_CNT), 2 * DFE, F.G, (int)blockIdx.x);
#if MOE_FP8
                pg8::Gemm g{hb, (const bf16_t*)(wb + OFF_FFN), D / 2, (size_t)2 * DFE * D / 2, (const int*)(ws + WS_IDXE), D / 2}; pg8::EpiGateUp8 E{ws + WS_MACT, DFE, wt, KDBL_F / W8_SCALE, ACT8_SCALE};
#ifdef SPLIT_GU
                S.i1 = SPLIT_GU; pg8::gemm_phase<pg8::EpiGateUp8, pg8::GroupedOrder, true, true>(F.lds, g, S, E);
                xcd_barrier(bar);
                S.i0 = SPLIT_GU; S.i1 = 1 << 30;
#endif
                pg8::gemm_phase<pg8::EpiGateUp8, pg8::GroupedOrder, true, true>(F.lds, g, S, E);
#else
                pg8::Gemm g{hb, (const bf16_t*)(wb + OFF_FFN), D, (size_t)2 * DFE * D, (const int*)(ws + WS_IDXE)}; pg8::EpiGateUp E{(bf16_t*)(ws + WS_MACT), DFE, wt, MOE_ACT_QS};
                pg8::gemm_phase<pg8::EpiGateUp, pg8::GroupedOrder, true>(F.lds, g, S, E);
#endif
            }
        }
        SEAM(pb + 7);
        if (EN(8) && IN(pb + 8) && !(zpass && ((ZSKIP >> 8) & 1))) for (int rep = 0; rep < REPS(8); ++rep) { PH_BEGIN;
            if (l == 0) { pg8::StaticOrder S; S.init(T, D, F.G, (int)blockIdx.x);
                pg8::Gemm g{(const bf16_t*)(ws + WS_FACT), (const bf16_t*)(wb + OFF_FDN), DFF, 0, nullptr}; pg8::EpiEw<0> E{Y, nullptr, D, wt};
                pg8::gemm_phase<pg8::EpiEw<0>, pg8::StaticOrder, false>(F.lds, g, S, E);
            } else {
#if MOE_FP8
                constexpr float dsc = 1.f / (W8_SCALE * ACT8_SCALE);
                { pg8::GroupedOrder S; S.init((const unsigned*)(F.ctl + CW_CNT), D, F.G, (int)blockIdx.x, MOE_MAIN_PANELS);
                  pg8::Gemm g{(const bf16_t*)(ws + WS_MACT), (const bf16_t*)(wb + OFF_MDN8), DFE / 2, (size_t)D * DFE / 2, nullptr}; pg8::EpiEw<0> E{(bf16_t*)(ws + WS_YSLOT), nullptr, D, wt, dsc};
                  pg8::gemm_phase<pg8::EpiEw<0>, pg8::GroupedOrder, false, true>(F.lds, g, S, E); }
                { pg8::TailOrder S; S.init((const unsigned*)(F.ctl + CW_CNT), D, F.G, (int)blockIdx.x, MOE_MAIN_PANELS, TAIL_KC, TAIL_KCH);
                  pg8::Gemm g{(const bf16_t*)(ws + WS_MACT), (const bf16_t*)(wb + OFF_MDN8), TAIL_KCH, (size_t)D * DFE / 2, nullptr, DFE / 2}; pg8::EpiPart E{(bf16_t*)(ws + WS_PBUF), D, MOE_MAIN_PANELS, TAIL_KCH, (size_t)TAIL_ROWS * D, wt, dsc};
                  pg8::gemm_phase<pg8::EpiPart, pg8::TailOrder, false, true>(F.lds, g, S, E); }
#else
                { pg8::GroupedOrder S; S.init((const unsigned*)(F.ctl + CW_CNT), D, F.G, (int)blockIdx.x, MOE_MAIN_PANELS);
                  pg8::Gemm g{(const bf16_t*)(ws + WS_MACT), (const bf16_t*)(wb + OFF_MDN), DFE, (size_t)D * DFE, nullptr}; pg8::EpiEw<0> E{(bf16_t*)(ws + WS_YSLOT), nullptr, D, wt};
                  pg8::gemm_phase<pg8::EpiEw<0>, pg8::GroupedOrder, false>(F.lds, g, S, E); }
                { pg8::TailOrder S; S.init((const unsigned*)(F.ctl + CW_CNT), D, F.G, (int)blockIdx.x, MOE_MAIN_PANELS, TAIL_KC, TAIL_KCH);
                  pg8::Gemm g{(const bf16_t*)(ws + WS_MACT), (const bf16_t*)(wb + OFF_MDN), TAIL_KCH, (size_t)D * DFE, nullptr, DFE}; pg8::EpiPart E{(bf16_t*)(ws + WS_PBUF), D, MOE_MAIN_PANELS, TAIL_KCH, (size_t)TAIL_ROWS * D, wt};
                  pg8::gemm_phase<pg8::EpiPart, pg8::TailOrder, false>(F.lds, g, S, E); }
#endif
            }
        }
        SEAM(pb + 8);
        if (EN(9) && IN(pb + 9) && !(zpass && ((ZSKIP >> 9) & 1))) for (int rep = 0; rep < REPS(9); ++rep) { PH_BEGIN;
            if (l == 0) thin_phase<1, 2, false>(F, nullptr, Y, (zpass || rep + 1 < REPS(9)) ? ZEROG : A.in[I_NFPOST] + (size_t)l * D, nullptr, nullptr, nullptr);
            else        thin_phase<2, 2, false>(F, nullptr, (const bf16_t*)(ws + WS_YSLOT), (zpass || rep + 1 < REPS(9)) ? ZEROG : A.in[I_NFPOST] + (size_t)l * D, nullptr, nullptr, nullptr);
        }
        SEAM(pb + 9);
        if (EN(10) && IN(pb + 10) && !(zpass && ((ZSKIP >> 10) & 1))) for (int rep = 0; rep < REPS(10); ++rep) { PH_BEGIN;
            pg8::StaticOrder S; S.init(T, D, F.G, (int)blockIdx.x);
            if (MK_DBG == 0 || A.sub != 2) { pg8::Gemm g{(const bf16_t*)(ws + WS_XS), (const bf16_t*)(wb + OFF_WPG), D, 0, nullptr}; pg8::EpiEw<PLE_MODE1> E{Y, nullptr, D, wt};
              pg8::gemm_phase<pg8::EpiEw<PLE_MODE1>, pg8::StaticOrder, false>(F.lds, g, S, E); }
            if (MK_DBG == 0 || A.sub != 1) { pg8::Gemm g{(const bf16_t*)(ws + WS_PB) + (size_t)l * T * PLE, (const bf16_t*)(wb + OFF_WPP), PLE, 0, nullptr}; pg8::EpiEw<4> E{Y, nullptr, D, wt};
              pg8::gemm_phase<pg8::EpiEw<4>, pg8::StaticOrder, false>(F.lds, g, S, E); }
        }
        SEAM(pb + 10);
        if (EN(11) && IN(pb + 11) && !(zpass && ((ZSKIP >> 11) & 1))) for (int rep = 0; rep < REPS(11); ++rep) { PH_BEGIN;
            if (l + 1 < DEPTH) thin_phase<1, 1, false>(F, nullptr, Y, (zpass || rep + 1 < REPS(11)) ? ZEROG : A.in[I_PNORM] + (size_t)l * D, A.in[I_NMPRE] + (size_t)(zpass ? 0 : l + 1) * D, hb, nullptr);
            else               thin_phase<1, 0, false>(F, nullptr, Y, (zpass || rep + 1 < REPS(11)) ? ZEROG : A.in[I_PNORM] + (size_t)l * D, nullptr, nullptr, nullptr);
        }
        SEAM(pb + 11);
    }
#if MK_STAMP
    {
        xcd_barrier(bar);
        const unsigned long long* st = (const unsigned long long*)(ws + WS_CTL + 786432);
        LAS float* res = (LAS float*)(F.lds);
        if (F.tid < N_PHASES) { const int k = F.tid; unsigned long long mx = 0, mxp = 0; double sum = 0.0;
            for (int g = 0; g < F.G; ++g) { const unsigned long long t = st[k * 256 + g]; mx = t > mx ? t : mx; sum += (double)t; if (k > 0) { const unsigned long long tp = st[(k - 1) * 256 + g]; mxp = tp > mxp ? tp : mxp; } }
            if (k == 0) { mxp = ~0ull; for (int g = 0; g < F.G; ++g) { const unsigned long long t = st[g]; mxp = t < mxp ? t : mxp; } mxp -= 0; }
            res[k] = (float)((double)(mx - mxp) * 0.01); res[32 + k] = (float)(((double)mx - sum / F.G) * 0.01); }
        __syncthreads();
        float t1, t2;
        if (STAMP_SEL < 0) { t1 = 0.f; t2 = 0.f; for (int k = 1; k < N_PHASES; ++k) { t1 += res[32 + k]; t2 += res[k]; } }
        else { t1 = res[STAMP_SEL]; t2 = res[32 + STAMP_SEL]; }
        const float A = 300.f * t1 + 1000.f, B = 10.f * t2 + 20.f;
        for (size_t i = (size_t)blockIdx.x * NTHR + F.tid; i < (size_t)T * D; i += (size_t)F.G * NTHR) args.out[i] = (i == 0) ? A : B;
    }
#endif
#undef IN
#undef SEAM
}
#ifndef MK_DBG
#define MK_DBG 0
#endif
#if MK_DBG
#ifndef MK_DBG_SHOW
#define MK_DBG_SHOW -1
#endif
constexpr size_t WS_SNAP = 512 * 1024;
__device__ __forceinline__ unsigned dh(unsigned x) { x ^= x >> 16; x *= 0x7feb352du; x ^= x >> 15; x *= 0x846ca68bu; x ^= x >> 16; return x; }
__device__ __forceinline__ void dbg_acc(float* dbg, int stage, float d2, float e2, int lane) { d2 = wave_sum(d2); e2 = wave_sum(e2); if (lane == 0) { atomicAdd(dbg + 2 * stage, d2); atomicAdd(dbg + 2 * stage + 1, e2); } }
__device__ __forceinline__ float ddot(const bf16_t* arow, const float* W, int K, int pitch, int col, int lane) { float s = 0.f; for (int k = lane; k < K; k += 64) s += bf2f(arow[k]) * W[(size_t)k * pitch + col]; return wave_sum(s); }
__device__ __forceinline__ float dsig(float v) { return 1.f / (1.f + expf(-v)); }
__device__ __forceinline__ int dbg_pbase(const unsigned* gcnt, int e) { int acc = 0; for (int q = 0; q < 8; ++q) if (q < e) acc += (((int)gcnt[q] + 255) >> 8) << 8; return acc; }
__device__ __forceinline__ float dbg_moe_el(const unsigned char* ws, int s, int k) { if (s < MOE_MAIN_ROWS) return bf2f(((const bf16_t*)(ws + WS_YSLOT))[(size_t)s * D + k]); float a = 0.f; for (int kc = 0; kc < TAIL_KC; ++kc) a += bf2f(((const bf16_t*)(ws + WS_PBUF))[((size_t)kc * TAIL_ROWS + (s - MOE_MAIN_ROWS)) * D + k]); return a; }
__device__ __forceinline__ float dbg_f8(const unsigned char* p, size_t i) { return __builtin_amdgcn_cvt_f32_fp8((int)p[i], 0); }
__device__ __forceinline__ float ddot8(const unsigned char* arow, float ascale, const float* W, int K, int pitch, int col, int lane) { float s = 0.f; for (int k = lane; k < K; k += 64) s += dbg_f8(arow, k) * ascale * W[(size_t)k * pitch + col]; return wave_sum(s); }
#define DBGP float* dbg = (float*)(a.ws + WS_CTL) + CW_DBG; const int lane = threadIdx.x & 63; const unsigned sid = blockIdx.x; (void)sid

__global__ void dbg_t1(Args a, int stage) { DBGP;
    const int r = dh(sid * 3 + 1) % T; const float* x = a.in[I_X] + (size_t)r * D; const bf16_t* hb = (const bf16_t*)(a.ws + WS_HB) + (size_t)r * D;
    float ss = 0.f; for (int k = lane; k < D; k += 64) ss += x[k] * x[k]; ss = wave_sum(ss); const float rstd = 1.f / sqrtf(ss / D + EPS);
    float d2 = 0.f, e2 = 0.f; for (int k = lane; k < D; k += 64) { const float e = x[k] * rstd * a.in[I_NMPRE][k], g = bf2f(hb[k]); d2 += (g - e) * (g - e); e2 += e * e; }
    dbg_acc(dbg, stage, d2, e2, lane); }

__global__ void dbg_gemm(Args a, int kind, int l, int stage) { DBGP;
    unsigned char* ws = a.ws; const unsigned h1 = dh(sid * 7 + 1), h2 = dh(sid * 7 + 2), h3 = dh(sid * 7 + 3);
    const bf16_t* hb = (const bf16_t*)(ws + WS_HB); float e = 0.f, g = 0.f;
    const unsigned* gcnt = (const unsigned*)(ws + WS_CTL) + CW_CNT;
    if (kind == 1) { const int row = h1 % T, col = h2 % INWG, sc = col < 2560 ? col : col + 16; const float v = ddot(hb + (size_t)row * D, a.in[I_WIN] + (size_t)l * D * INW, D, INW, sc, lane);
        const bf16_t* P = (const bf16_t*)(ws + WS_PROJ);
        if (col < 512) { e = v * pg8::QA_SCALE; g = bf2f(((const bf16_t*)(ws + WS_QA))[(size_t)row * 512 + col]); }
        else if (col < 1024) { e = v; g = bf2f(((const bf16_t*)(ws + WS_KA))[(size_t)row * 512 + col - 512]); }
        else if (col < 1536) { e = v; g = bf2f(((const bf16_t*)(ws + WS_VA))[(size_t)row * 512 + col - 1024]); }
        else if (col < 1792) { e = v * 0.125f; g = bf2f(((const bf16_t*)(ws + WS_QB))[(size_t)row * 256 + col - 1536]); }
        else if (col < 2048) { e = v; g = bf2f(((const bf16_t*)(ws + WS_KB))[(size_t)row * 256 + col - 1792]); }
        else if (col < 2560) { e = v; g = bf2f(((const bf16_t*)(ws + WS_VB))[(size_t)row * 512 + col - 2048]); }
        else if (col < 3072) { e = v * dsig(v); g = bf2f(((const bf16_t*)(ws + WS_SR))[(size_t)row * 512 + col - 2560]); }
        else if (col < 4096) { e = dsig(v); g = bf2f(((const bf16_t*)(ws + WS_SGA))[(size_t)row * 1024 + col - 3072]); }
        else { e = dsig(v); g = bf2f(((const bf16_t*)(ws + WS_SGB))[(size_t)row * 1024 + col - 4096]); } (void)P;
    } else if (kind == 2) { const int row = h1 % T, col = h2 % D;
        const float va = ddot((const bf16_t*)(ws + WS_YA) + (size_t)row * 512, a.in[I_WBA] + (size_t)l * 512 * D, 512, D, col, lane), vb = ddot((const bf16_t*)(ws + WS_YB) + (size_t)row * 512, a.in[I_WBB] + (size_t)l * 512 * D, 512, D, col, lane);
        e = bf2f(((const bf16_t*)(ws + WS_SGA))[(size_t)row * D + col]) * va + bf2f(((const bf16_t*)(ws + WS_SGB))[(size_t)row * D + col]) * vb; g = bf2f(((const bf16_t*)(ws + WS_MERGED))[(size_t)row * D + col]);
    } else if (kind == 3) { const int row = h1 % T, col = h2 % D; e = ddot((const bf16_t*)(ws + WS_MERGED) + (size_t)row * D, a.in[I_WOUT] + (size_t)l * D * D, D, D, col, lane); g = bf2f(((const bf16_t*)(ws + WS_Y))[(size_t)row * D + col]);
    } else if (kind == 4) { const int row = h1 % T, c = h2 % DFF; const float vg = ddot(hb + (size_t)row * D, a.in[I_FG], D, DFF, c, lane), vu = ddot(hb + (size_t)row * D, a.in[I_FU], D, DFF, c, lane);
        e = vg * dsig(vg) * vu; g = bf2f(((const bf16_t*)(ws + WS_FACT))[(size_t)row * DFF + c]);
    } else if (kind == 5) { const int row = h1 % T, col = h2 % D; e = ddot((const bf16_t*)(ws + WS_FACT) + (size_t)row * DFF, a.in[I_FD], DFF, D, col, lane); g = bf2f(((const bf16_t*)(ws + WS_Y))[(size_t)row * D + col]);
    } else if (kind == 6 || kind == 7) { const int ex = h1 % NE; const int pbase = dbg_pbase(gcnt, ex); const int cnt = (int)gcnt[ex];
        if (cnt == 0) return; const int i = h2 % cnt, tok = ((const int*)(ws + WS_IDXE))[ex * 16384 + i], row = pbase + i;
#if MOE_FP8
        const unsigned char* hb8 = ws + WS_HB; const unsigned char* act8 = ws + WS_MACT;
        if (kind == 6) { const int c = h3 % DFE; const float vg = ddot8(hb8 + (size_t)tok * D, 1.f, a.in[I_MG] + (size_t)ex * D * DFE, D, DFE, c, lane), vu = ddot8(hb8 + (size_t)tok * D, 1.f, a.in[I_MU] + (size_t)ex * D * DFE, D, DFE, c, lane);
            e = vg * dsig(vg) * vu; g = dbg_f8(act8, (size_t)row * DFE + c) * (1.f / ACT8_SCALE); }
        else { const int col = h3 % D; e = ddot8(act8 + (size_t)row * DFE, 1.f / ACT8_SCALE, a.in[I_MD] + (size_t)ex * DFE * D, DFE, D, col, lane); g = dbg_moe_el(ws, row, col); }
#else
        if (kind == 6) { const int c = h3 % DFE; const float vg = ddot(hb + (size_t)tok * D, a.in[I_MG] + (size_t)ex * D * DFE, D, DFE, c, lane), vu = ddot(hb + (size_t)tok * D, a.in[I_MU] + (size_t)ex * D * DFE, D, DFE, c, lane);
            e = vg * dsig(vg) * vu; g = bf2f(((const bf16_t*)(ws + WS_MACT))[(size_t)row * DFE + c]); }
        else { const int col = h3 % D; e = ddot((const bf16_t*)(ws + WS_MACT) + (size_t)row * DFE, a.in[I_MD] + (size_t)ex * DFE * D, DFE, D, col, lane); g = dbg_moe_el(ws, row, col); }
#endif
    } else if (kind == 12) { const int row = h1 % T, col = h2 % D; e = a.out[(size_t)row * D + col]; g = bf2f(((const bf16_t*)(ws + WS_XS))[(size_t)row * D + col]);
    } else if (kind == 13) { const int row = h1 % T, col = h2 % D; e = ddot((const bf16_t*)(ws + WS_XS) + (size_t)row * D, a.in[I_PG] + (size_t)l * D * D, D, D, col, lane); g = bf2f(((const bf16_t*)(ws + WS_Y))[(size_t)row * D + col]);
    } else if (kind == 11) { const int n = h1 % D, k = h2 % D; e = a.in[I_PG][(size_t)l * D * D + (size_t)k * D + n]; g = bf2f(((const bf16_t*)(ws + (l ? WS_W1 : WS_W0) + OFF_WPG))[(size_t)n * D + k]);
    } else if (kind == 9) { const int row = h1 % T, col = h2 % D; e = dsig(ddot((const bf16_t*)(ws + WS_XS) + (size_t)row * D, a.in[I_PG] + (size_t)l * D * D, D, D, col, lane)); g = bf2f(((const bf16_t*)(ws + WS_Y))[(size_t)row * D + col]);
    } else { const int row = h1 % T, col = h2 % D; const float vg = ddot((const bf16_t*)(ws + WS_XS) + (size_t)row * D, a.in[I_PG] + (size_t)l * D * D, D, D, col, lane), vp = ddot((const bf16_t*)(ws + WS_PB) + ((size_t)l * T + row) * PLE, a.in[I_PP] + (size_t)l * PLE * D, PLE, D, col, lane);
        e = dsig(vg) * vp; g = bf2f(((const bf16_t*)(ws + WS_Y))[(size_t)row * D + col]); }
    if (lane == 0) { atomicAdd(dbg + 2 * stage, (g - e) * (g - e)); atomicAdd(dbg + 2 * stage + 1, e * e); } }

__global__ void dbg_attn(Args a, int l, int stage) { DBGP;
    unsigned char* ws = a.ws; const unsigned h1 = dh(sid * 5 + 1); const int tok = h1 % T, h = dh(sid * 5 + 2) % AH, b = tok / SEQ, c = (tok % SEQ) / CH, ql = tok % CH;
    const bf16_t* hb = (const bf16_t*)(ws + WS_HB) + (size_t)tok * D; const float* win = a.in[I_WIN] + (size_t)l * D * INW;
    float q = 0.f; for (int k = 0; k < D; ++k) q += bf2f(hb[k]) * win[(size_t)k * INW + h * 64 + lane]; q *= pg8::QA_SCALE;
    const bf16_t* ka = (const bf16_t*)(ws + WS_KA); const bf16_t* va = (const bf16_t*)(ws + WS_VA); const float* rb = a.in[I_RELB] + ((size_t)l * AH + h) * RELN;
    float m = -1e30f, ls = 0.f, o = 0.f;
    for (int kc = (c - 8 > 0 ? c - 8 : 0); kc <= c; ++kc) for (int kl = 0; kl < CH; ++kl) { const int kt = b * SEQ + kc * CH + kl; int dist = (c - kc) * 64 + ql - kl; dist = dist > 128 ? 128 : (dist < -128 ? -128 : dist);
        const float s = wave_sum(q * bf2f(ka[(size_t)kt * 512 + h * 64 + lane])) + rb[dist + 128] * LOG2E; const float mn = fmaxf(m, s), al = exp2f(m - mn), p = exp2f(s - mn); m = mn; ls = ls * al + p; o = o * al + p * bf2f(va[(size_t)kt * 512 + h * 64 + lane]); }
    const float e = o / ls, g = bf2f(((const bf16_t*)(ws + WS_YA))[(size_t)tok * 512 + h * 64 + lane]);
    dbg_acc(dbg, stage, (g - e) * (g - e), e * e, lane); }

__global__ void dbg_dstate(Args a, int l, int stage) { DBGP;
    unsigned char* ws = a.ws; const int b = dh(sid * 5 + 1) % NB, c = dh(sid * 5 + 2) % NCH, hh = dh(sid * 5 + 3) % BH, v = dh(sid * 5 + 4) % 128, k = dh(sid * 5 + 5) % 64, col = hh * 64 + k;
    const int tok = b * SEQ + c * CH + lane; const bf16_t* hb = (const bf16_t*)(ws + WS_HB) + (size_t)tok * D; const float* win = a.in[I_WIN] + (size_t)l * D * INW;
    float z = a.in[I_BG][l * 256 + col];
    for (int r = 0; r < GR; ++r) { float gd = 0.f; for (int kk = 0; kk < D; ++kk) gd += bf2f(hb[kk]) * win[(size_t)kk * INW + 2560 + r]; z += gd * a.in[I_WGUP][((size_t)l * GR + r) * 256 + col]; }
    const float la = (fminf(z, 0.f) - log1pf(expf(-fabsf(z)))) / 16.f; float cum = la;
    for (int o = 1; o < 64; o <<= 1) { const float t = __shfl_up(cum, o); if (lane >= o) cum += t; }
    const float tot = __shfl(cum, 63);
    const float kd = bf2f(((const bf16_t*)(ws + WS_KB))[(size_t)tok * 256 + col]) * expf(tot - cum);
    const float e = wave_sum(kd * bf2f(((const bf16_t*)(ws + WS_VB))[(size_t)tok * 512 + hh * 128 + v]));
    const float g = ((const float*)(ws + WS_DST))[((size_t)((b * NCH + c) * BH + hh) * 128 + v) * 64 + k];
    const float ed = expf(tot), gdc = ((const float*)(ws + WS_DEC))[(size_t)(b * NCH + c) * 256 + col];
    if (lane == 0) { atomicAdd(dbg + 2 * stage, (g - e) * (g - e) + (gdc - ed) * (gdc - ed)); atomicAdd(dbg + 2 * stage + 1, e * e + ed * ed); } }

__global__ void dbg_scan(Args a, int stage) { DBGP;
    unsigned char* ws = a.ws; const unsigned s0 = sid * 64 + lane; const int b = dh(s0 * 5 + 1) % NB, c = dh(s0 * 5 + 2) % NCH, hh = dh(s0 * 5 + 3) % BH, v = dh(s0 * 5 + 4) % 128, k = dh(s0 * 5 + 5) % 64;
    float s = 0.f; for (int cc = 0; cc <= c; ++cc) s = ((const float*)(ws + WS_DEC))[(size_t)(b * NCH + cc) * 256 + hh * 64 + k] * s + ((const float*)(ws + WS_DST))[((size_t)((b * NCH + cc) * BH + hh) * 128 + v) * 64 + k];
    const float g = bf2f(((const bf16_t*)(ws + WS_ST))[((size_t)((b * NCH + c) * BH + hh) * 128 + v) * 64 + k]);
    dbg_acc(dbg, stage, (g - s) * (g - s), s * s, lane); }

__global__ void dbg_glaout(Args a, int l, int stage) { DBGP;
    unsigned char* ws = a.ws; const int tok = dh(sid * 3 + 1) % T, hh = dh(sid * 3 + 2) % BH, b = tok / SEQ, c = (tok % SEQ) / CH;
    const bf16_t* st = (const bf16_t*)(ws + WS_ST) + ((size_t)((b * NCH + c) * BH + hh) * 128) * 64; const bf16_t* qb = (const bf16_t*)(ws + WS_QB) + (size_t)tok * 256 + hh * 64;
    const bf16_t* hb = (const bf16_t*)(ws + WS_HB) + (size_t)tok * D; const float* win = a.in[I_WIN] + (size_t)l * D * INW;
    float o[2], r[2];
#pragma unroll
    for (int j = 0; j < 2; ++j) { const int v = lane + 64 * j; float s = 0.f; for (int k = 0; k < 64; ++k) s += bf2f(qb[k]) * bf2f(st[(size_t)v * 64 + k]); o[j] = s;
        float rr = 0.f; for (int kk = 0; kk < D; ++kk) rr += bf2f(hb[kk]) * win[(size_t)kk * INW + 2576 + hh * 128 + v]; r[j] = rr * dsig(rr); }
    const float ss = wave_sum(o[0] * o[0] + o[1] * o[1]), rstd = 1.f / sqrtf(ss / 128.f + EPS); float d2 = 0.f, e2 = 0.f;
#pragma unroll
    for (int j = 0; j < 2; ++j) { const int v = lane + 64 * j; const float e = o[j] * rstd * a.in[I_GNORM][l * 512 + hh * 128 + v] * r[j], g = bf2f(((const bf16_t*)(ws + WS_YB))[(size_t)tok * 512 + hh * 128 + v]); d2 += (g - e) * (g - e); e2 += e * e; }
    dbg_acc(dbg, stage, d2, e2, lane); }

__device__ __forceinline__ int dbg_row(unsigned i) { return (int)((i * 257u + 11u) % T); }
__global__ void dbg_snap(Args a, int from_in) { const int i = blockIdx.x, r = dbg_row(i); float* snap = (float*)(a.ws + WS_SNAP) + (size_t)i * D; const bf16_t* xs = (const bf16_t*)(a.ws + WS_XS); for (int k = threadIdx.x; k < D; k += 64) snap[k] = from_in ? a.in[I_X][(size_t)r * D + k] : bf2f(xs[(size_t)r * D + k]); }
__global__ void dbg_thin(Args a, int src, int outk, int route, const float* g_add, const float* g_out, const bf16_t* obuf, int st_x, int st_o, int st_r) { DBGP;
    unsigned char* ws = a.ws; const int i = sid, r = dbg_row(i); const float* snap = (const float*)(ws + WS_SNAP) + (size_t)i * D;
    const unsigned* gcnt = (const unsigned*)(ws + WS_CTL) + CW_CNT; const unsigned* ti = (const unsigned*)(ws + WS_TOKINFO) + (size_t)r * 8;
    float y[16], xn[16]; float ss = 0.f;
#pragma unroll
    for (int j = 0; j < 16; ++j) { const int k = lane + 64 * j; float v;
        if (src == 1) v = bf2f(((const bf16_t*)(ws + WS_Y))[(size_t)r * D + k]);
        else { v = __uint_as_float(ti[4]) * dbg_moe_el(ws, dbg_pbase(gcnt, (int)ti[0]) + (int)ti[1], k) + __uint_as_float(ti[5]) * dbg_moe_el(ws, dbg_pbase(gcnt, (int)ti[2]) + (int)ti[3], k); }
        y[j] = v; ss += v * v; }
    ss = wave_sum(ss); const float rstd = 1.f / sqrtf(ss / D + EPS); float d2 = 0.f, e2 = 0.f, s2 = 0.f;
#pragma unroll
    for (int j = 0; j < 16; ++j) { const int k = lane + 64 * j; xn[j] = snap[k] + y[j] * rstd * g_add[k]; const float g = (outk == 0) ? a.out[(size_t)r * D + k] : bf2f(((const bf16_t*)(ws + WS_XS))[(size_t)r * D + k]); d2 += (g - xn[j]) * (g - xn[j]); e2 += xn[j] * xn[j]; s2 += xn[j] * xn[j]; }
    dbg_acc(dbg, st_x, d2, e2, lane);
    if (outk != 1) return;
    s2 = wave_sum(s2); const float rs2 = 1.f / sqrtf(s2 / D + EPS); d2 = 0.f; e2 = 0.f; float hn[16];
#pragma unroll
    for (int j = 0; j < 16; ++j) { const int k = lane + 64 * j; hn[j] = (outk == 1) ? xn[j] * rs2 * g_out[k] : xn[j]; const float g = (MOE_FP8 && route) ? dbg_f8((const unsigned char*)obuf, (size_t)r * D + k) : bf2f(obuf[(size_t)r * D + k]); d2 += (g - hn[j]) * (g - hn[j]); e2 += hn[j] * hn[j]; }
    dbg_acc(dbg, st_o, d2, e2, lane);
    if (!route) return;
    float lg[8];
#pragma unroll
    for (int e = 0; e < 8; ++e) { float s = 0.f;
#pragma unroll
        for (int j = 0; j < 16; ++j) s += hn[j] * a.in[I_RW][(size_t)(lane + 64 * j) * NE + e]; lg[e] = wave_sum(s); }
    int e1 = 0; float v1 = lg[0];
#pragma unroll
    for (int e = 1; e < 8; ++e) if (lg[e] > v1) { v1 = lg[e]; e1 = e; }
    int e2i = -1; float v2 = -3.0e38f;
#pragma unroll
    for (int e = 0; e < 8; ++e) if (e != e1 && lg[e] > v2) { v2 = lg[e]; e2i = e; }
    const float ex = expf(v2 - v1), w1 = 1.f / (1.f + ex);
    float bad = 0.f; if ((int)ti[0] != e1 || (int)ti[2] != e2i) bad = 1.f; else { bad = fabsf(__uint_as_float(ti[4]) - w1) + fabsf(__uint_as_float(ti[5]) - (1.f - w1));
        const int* idxe = (const int*)(ws + WS_IDXE); if (ti[1] >= gcnt[e1] || ti[3] >= gcnt[e2i] || idxe[e1 * 16384 + ti[1]] != r || idxe[e2i * 16384 + ti[3]] != r) bad = 1.f; }
    if (lane == 0) { atomicAdd(dbg + 2 * st_r, bad * bad); atomicAdd(dbg + 2 * st_r + 1, 1.f); } }

__global__ void dbg_report(Args a) {
    const float* dbg = (const float*)(a.ws + WS_CTL) + CW_DBG; int bad = -1; float errk = 0.f;
    for (int k = 0; k < 33; ++k) { const float d2 = dbg[2 * k], e2 = dbg[2 * k + 1]; if (d2 == 0.f && e2 == 0.f) continue; const float err = d2 / e2; if (MK_DBG_SHOW == k) errk = (err == err) ? err : 1e6f; const float thr = (MOE_FP8 && (k == 25 || k == 27 || k == 28)) ? 3e-2f : 1e-3f; if (bad < 0 && !(err < thr)) bad = k; }
    float V = 0.f; bool fill = false;
    if (MK_DBG_SHOW >= 0) { V = sqrtf(7.f * 100.f * errk) + 1e-3f; fill = true; } else if (bad >= 0) { V = exp10f(1.f + 0.25f * (float)bad); fill = true; }
    if (fill) for (size_t i = (size_t)blockIdx.x * blockDim.x + threadIdx.x; i < (size_t)T * D; i += (size_t)gridDim.x * blockDim.x) a.out[i] = V; }

static void dbg_run(Args a, int grid, hipStream_t st) {
    auto ph = [&](int p) { a.ph_lo = p; a.ph_hi = p + 1; hipLaunchKernelGGL(fwd, dim3(grid), dim3(NTHR), LDS_BYTES, st, a); };
    const int NS = 2048;
    ph(0); hipLaunchKernelGGL(dbg_t1, dim3(256), dim3(64), 0, st, a, 0);
    for (int l = 0; l < DEPTH; ++l) { const int pb = 1 + 12 * l, sb = 16 * l; const size_t lo = (size_t)l * D;
        ph(pb + 0); hipLaunchKernelGGL(dbg_gemm, dim3(NS), dim3(64), 0, st, a, 1, l, sb + 1);
        ph(pb + 1); hipLaunchKernelGGL(dbg_attn, dim3(512), dim3(64), 0, st, a, l, sb + 2); hipLaunchKernelGGL(dbg_dstate, dim3(256), dim3(64), 0, st, a, l, sb + 3);
        ph(pb + 2); hipLaunchKernelGGL(dbg_scan, dim3(64), dim3(64), 0, st, a, sb + 4);
        ph(pb + 3); hipLaunchKernelGGL(dbg_glaout, dim3(256), dim3(64), 0, st, a, l, sb + 5);
        ph(pb + 4); hipLaunchKernelGGL(dbg_gemm, dim3(NS), dim3(64), 0, st, a, 2, l, sb + 6);
        ph(pb + 5); hipLaunchKernelGGL(dbg_gemm, dim3(NS), dim3(64), 0, st, a, 3, l, sb + 7);
        hipLaunchKernelGGL(dbg_snap, dim3(64), dim3(64), 0, st, a, l == 0 ? 1 : 0);
        ph(pb + 6); hipLaunchKernelGGL(dbg_thin, dim3(64), dim3(64), 0, st, a, 1, 1, l == 1 ? 1 : 0, a.in[I_NMPOST] + lo, a.in[I_NFPRE] + lo, (const bf16_t*)(a.ws + WS_HB), sb + 8, sb + 9, sb + 10);
        ph(pb + 7); hipLaunchKernelGGL(dbg_gemm, dim3(NS), dim3(64), 0, st, a, l == 0 ? 4 : 6, l, sb + 11);
        ph(pb + 8); hipLaunchKernelGGL(dbg_gemm, dim3(NS), dim3(64), 0, st, a, l == 0 ? 5 : 7, l, sb + 12);
        hipLaunchKernelGGL(dbg_snap, dim3(64), dim3(64), 0, st, a, 0);
        ph(pb + 9); hipLaunchKernelGGL(dbg_thin, dim3(64), dim3(64), 0, st, a, l == 0 ? 1 : 2, 2, 0, a.in[I_NFPOST] + lo, (const float*)nullptr, (const bf16_t*)nullptr, sb + 13, sb + 13, 0);
        a.sub = 1; ph(pb + 10); hipLaunchKernelGGL(dbg_gemm, dim3(NS), dim3(64), 0, st, a, 9, l, sb + 14);
        a.sub = 2; ph(pb + 10); a.sub = 0; hipLaunchKernelGGL(dbg_gemm, dim3(NS), dim3(64), 0, st, a, 8, l, sb + 15);
        hipLaunchKernelGGL(dbg_snap, dim3(64), dim3(64), 0, st, a, 0);
        ph(pb + 11); hipLaunchKernelGGL(dbg_thin, dim3(64), dim3(64), 0, st, a, 1, l == 0 ? 1 : 0, 0, a.in[I_PNORM] + lo, l == 0 ? a.in[I_NMPRE] + D : (const float*)nullptr, (const bf16_t*)(a.ws + WS_HB), sb + 16, sb + 16, 0);
    }
    hipLaunchKernelGGL(dbg_report, dim3(1024), dim3(256), 0, st, a);
}
#endif
#ifndef MK_SPLIT
#define MK_SPLIT 0
#endif
#ifndef MK_DBG
#define MK_DBG 0
#endif
extern "C" void kernel_launch(void* const* d_in, const int* in_sizes, int n_in, void* d_out, int out_size, void* d_ws, size_t ws_size, hipStream_t stream) {
    static int grid = 0;
    if (grid == 0) {
        if (n_in != 24 || in_sizes[0] != T * D || out_size != T * D || ws_size < WS_END) { fprintf(stderr, "kernel_launch: unexpected problem (n_in %d, in0 %d, out %d, ws %zu < %zu); nothing launched\n", n_in, n_in > 0 ? in_sizes[0] : -1, out_size, ws_size, (size_t)WS_END); grid = -1; return; }
        int dev = 0, cus = 0, per_cu = 0;
        if (hipGetDevice(&dev) != hipSuccess || hipDeviceGetAttribute(&cus, hipDeviceAttributeMultiprocessorCount, dev) != hipSuccess) { grid = -1; return; }
        if (hipFuncSetAttribute((const void*)fwd, hipFuncAttributeMaxDynamicSharedMemorySize, LDS_BYTES) != hipSuccess) { fprintf(stderr, "kernel_launch: hipFuncSetAttribute failed\n"); grid = -1; return; }
        if (hipOccupancyMaxActiveBlocksPerMultiprocessor(&per_cu, (const void*)fwd, NTHR, LDS_BYTES) != hipSuccess || per_cu < 1) { fprintf(stderr, "kernel_launch: occupancy query says %d blocks per CU\n", per_cu); }
        (void)hipGetLastError();
        grid = cus;
    }
    if (grid < 0) return;
    (void)hipMemsetAsync((char*)d_ws + WS_CTL, 0, CTL_ZERO_BYTES, stream);
    Args a{};
    for (int i = 0; i < 24; ++i) a.in[i] = (const float*)d_in[i];
    a.out = (float*)d_out; a.ws = (unsigned char*)d_ws;
#if MK_DBG
    dbg_run(a, grid, stream);
#elif MK_SPLIT
    for (int p = 0; p < N_PHASES; ++p) { a.ph_lo = p; a.ph_hi = p + 1; hipLaunchKernelGGL(fwd, dim3(grid), dim3(NTHR), LDS_BYTES, stream, a); }
#else
    a.ph_lo = 0; a.ph_hi = N_PHASES;
    hipLaunchKernelGGL(fwd, dim3(grid), dim3(NTHR), LDS_BYTES, stream, a);
#endif
}
```

```cpp
#define TR_NFAST 1
#define THIN_PF 1
#define EPI_PK 1
#define XL_DPP 1
#define XB_FLAT 1
#include <hip/hip_runtime.h>
#include <cstdio>
#include <cstdint>

#define LAS __attribute__((address_space(3)))
#define GAS __attribute__((address_space(1)))
typedef unsigned short bf16_t;
typedef short bf16x8 __attribute__((ext_vector_type(8)));
typedef short s16x4 __attribute__((ext_vector_type(4)));
typedef float f32x4 __attribute__((ext_vector_type(4)));
typedef float f32x2 __attribute__((ext_vector_type(2)));
typedef unsigned u32x4 __attribute__((ext_vector_type(4)));
typedef unsigned u32x2 __attribute__((ext_vector_type(2)));

typedef __bf16 bf16x2_t __attribute__((ext_vector_type(2)));
__device__ __forceinline__ unsigned cvt_pk_bf16(float lo, float hi) { f32x2 v = {lo, hi}; const bf16x2_t b = __builtin_convertvector(v, bf16x2_t); return __builtin_bit_cast(unsigned, b); }
#ifndef WT_STORES
#define WT_STORES 1
#endif
#ifndef WT_AUX
#define WT_AUX 16
#endif
struct WT { __amdgpu_buffer_rsrc_t rs; const char* base; };
__device__ __forceinline__ WT make_wt(void* ws_base, unsigned nbytes) { WT w; w.rs = __builtin_amdgcn_make_buffer_rsrc(ws_base, 0, (int)nbytes, 0x00020000); w.base = (const char*)ws_base; return w; }
__device__ __forceinline__ void st16(const WT& w, void* p, u32x4 v) {
#if WT_STORES
    __builtin_amdgcn_raw_buffer_store_b128(v, w.rs, (int)(unsigned)((const char*)p - w.base), 0, WT_AUX);
#else
    *(u32x4*)p = v;
#endif
}
__device__ __forceinline__ void st8(const WT& w, void* p, u32x2 v) {
#if WT_STORES
    __builtin_amdgcn_raw_buffer_store_b64(v, w.rs, (int)(unsigned)((const char*)p - w.base), 0, WT_AUX);
#else
    *(u32x2*)p = v;
#endif
}
__device__ __forceinline__ float clamp8(float v) { return __builtin_amdgcn_fmed3f(v, -448.f, 448.f); }
__device__ __forceinline__ unsigned pk4_fp8(float a, float b, float c, float d) { int w = __builtin_amdgcn_cvt_pk_fp8_f32(clamp8(a), clamp8(b), 0, false); w = __builtin_amdgcn_cvt_pk_fp8_f32(clamp8(c), clamp8(d), w, true); return (unsigned)w; }
__device__ __forceinline__ float q8(float x, float s) { const int w = __builtin_amdgcn_cvt_pk_fp8_f32(x * s, 0.f, 0, false); return __builtin_amdgcn_cvt_f32_fp8(w, 0) * (1.0f / s); }
__device__ __forceinline__ float bf_lo(unsigned w) { return __uint_as_float(w << 16); }
__device__ __forceinline__ float bf_hi(unsigned w) { return __uint_as_float(w & 0xffff0000u); }
__device__ __forceinline__ float bf2f(bf16_t b) { return __uint_as_float(((unsigned)b) << 16); }
__device__ __forceinline__ float fast_sigmoid(float v) { return __builtin_amdgcn_rcpf(1.0f + __builtin_amdgcn_exp2f(-1.4426950408889634f * v)); }
__device__ __forceinline__ f32x2 lo2(f32x4 v) { return __builtin_shufflevector(v, v, 0, 1); }
__device__ __forceinline__ f32x2 hi2(f32x4 v) { return __builtin_shufflevector(v, v, 2, 3); }
__device__ __forceinline__ f32x4 cat2(f32x2 a, f32x2 b) { return __builtin_shufflevector(a, b, 0, 1, 2, 3); }
__device__ __forceinline__ f32x2 rcp_1p_exp2(f32x2 a) { const f32x2 d = (f32x2){__builtin_amdgcn_exp2f(a.x), __builtin_amdgcn_exp2f(a.y)} + (f32x2){1.0f, 1.0f}; return (f32x2){__builtin_amdgcn_rcpf(d.x), __builtin_amdgcn_rcpf(d.y)}; }
__device__ __forceinline__ f32x2 sigmoid2(f32x2 v) { return rcp_1p_exp2(v * (f32x2){-1.4426950408889634f, -1.4426950408889634f}); }
__device__ __forceinline__ f32x4 sigmoid4(f32x4 v) { return cat2(sigmoid2(lo2(v)), sigmoid2(hi2(v))); }
#ifdef XL_DPP
template <int CTRL> __device__ __forceinline__ float dpp_f(float v) { return __builtin_bit_cast(float, __builtin_amdgcn_update_dpp(0, __builtin_bit_cast(int, v), CTRL, 0xF, 0xF, true)); }
#define XL_SWAP16(v, a, b) do { const auto _r = __builtin_amdgcn_permlane16_swap(__builtin_bit_cast(unsigned, (v)), __builtin_bit_cast(unsigned, (v)), false, false); a = __builtin_bit_cast(float, (unsigned)_r[0]); b = __builtin_bit_cast(float, (unsigned)_r[1]); } while (0)
#define XL_SWAP32(v, a, b) do { const auto _r = __builtin_amdgcn_permlane32_swap(__builtin_bit_cast(unsigned, (v)), __builtin_bit_cast(unsigned, (v)), false, false); a = __builtin_bit_cast(float, (unsigned)_r[0]); b = __builtin_bit_cast(float, (unsigned)_r[1]); } while (0)
__device__ __forceinline__ float sum_x16_x32(float v) { float a, b; XL_SWAP16(v, a, b); v = a + b; XL_SWAP32(v, a, b); return a + b; }
__device__ __forceinline__ float max_x16_x32(float v) { float a, b; XL_SWAP16(v, a, b); v = fmaxf(a, b); XL_SWAP32(v, a, b); return fmaxf(a, b); }
__device__ __forceinline__ float wave_sum(float v) {
    v += dpp_f<0xB1>(v);
    v += dpp_f<0x4E>(v);
    v += dpp_f<0x141>(v);
    v += dpp_f<0x140>(v);
    return sum_x16_x32(v);
}
#else
__device__ __forceinline__ float sum_x16_x32(float v) { v += __shfl_xor(v, 16); v += __shfl_xor(v, 32); return v; }
__device__ __forceinline__ float max_x16_x32(float v) { v = fmaxf(v, __shfl_xor(v, 16)); v = fmaxf(v, __shfl_xor(v, 32)); return v; }
__device__ __forceinline__ float wave_sum(float v) {
#pragma unroll
    for (int o = 1; o < 64; o <<= 1) v += __shfl_xor(v, o);
    return v;
}
#endif

typedef int v8i32 __attribute__((ext_vector_type(8)));
typedef int v4i32 __attribute__((ext_vector_type(4)));
__device__ __forceinline__ v8i32 cat8i(bf16x8 a, bf16x8 b) { const v4i32 x = __builtin_bit_cast(v4i32, a), y = __builtin_bit_cast(v4i32, b); return (v8i32){x[0], x[1], x[2], x[3], y[0], y[1], y[2], y[3]}; }
namespace pg8 {
constexpr int BM = 256, BK = 64, HALF = 128, HTB = HALF * BK * 2, STAGE_BYTES = 8 * HTB, NXCD = 8, WGM = 8;
__host__ __device__ __forceinline__ int lds_byte(int r, int c) { const int st = (r >> 4) * 2 + (c >> 5), rr = r & 15, cc = c & 31, ob = rr * 64 + cc * 2; return st * 1024 + (ob ^ (((ob >> 9) & 1) << 5)); }
__host__ __device__ __forceinline__ void stage_rc(int b, int& R, int& C) { const int st = b / 1024, sb = b % 1024, swz = sb ^ (((sb >> 9) & 1) << 5); R = (st >> 1) * 16 + swz / 64; C = (st & 1) * 32 + (swz % 64) / 2; }
__host__ __device__ __forceinline__ int perm32(int rho) { const int n = rho >> 4, i = rho & 15; return 8 * (i >> 2) + 4 * n + (i & 3); }

struct Unit { int pm, pn, e, lr0, cnt, koff, half; };
struct Gemm { const bf16_t* A; const bf16_t* Bt; int K; size_t b_estride; const int* gidx; int ld; };

struct StaticOrder {
    int nM, nN, nwg, G, c; int ht = 0;
    __device__ __forceinline__ void init(int M, int N, int G_, int c_) { nM = M / BM; nN = N / BM; nwg = nM * nN; G = G_; c = c_; }
    __device__ __forceinline__ bool short_deal() const { const int r = nwg % G; return r != 0 && c >= r; }
    __device__ __forceinline__ bool next(int i, Unit& u) const {
        long L = (long)i * G + c; int half = 0;
        if (ht) { const int full = nwg / G, rem = nwg % G;
          if (rem > 0 && 2 * rem <= G && i == full) { if (c >= 2 * rem) return false; L = (long)full * G + (c >> 1); half = 1 + (c & 1); } }
        if (L >= nwg) return false;
        u.half = half;
        int wgid = (int)L; { const int q = nwg / NXCD, r = nwg % NXCD, xcd = wgid % NXCD, off = wgid / NXCD; wgid = (xcd < r ? xcd * (q + 1) : r * (q + 1) + (xcd - r) * q) + off; }
        const int nig = WGM * nN, gid = wgid / nig, fm = gid * WGM, gsz = (nM - fm) < WGM ? (nM - fm) : WGM;
        u.pm = fm + ((wgid % nig) % gsz); u.pn = (wgid % nig) / gsz; u.e = 0; u.lr0 = 0; u.cnt = 0; u.koff = 0; return true;
    }
};
struct GroupedOrder {
    int pb[9]; int cnt[8]; int nN, G, c, nwg, np;
    int i0 = 0, i1 = 1 << 30;
    int ht = 0;
    __device__ __forceinline__ void init(const unsigned* counts, int N, int G_, int c_, int pmax = 1 << 30) {
        int acc = 0;
#pragma unroll
        for (int e = 0; e < 8; ++e) { const int n = (int)counts[e]; cnt[e] = n; pb[e] = acc; acc += (n + 255) >> 8; }
        pb[8] = acc; nN = N / BM; G = G_; c = c_; np = acc < pmax ? acc : pmax; nwg = np * nN;
    }
    __device__ __forceinline__ bool short_deal() const { const int r = nwg % G; return r != 0 && c >= r; }
    __device__ __forceinline__ bool next(int i, Unit& u) const {
        if (i + i0 >= i1) return false;
        long L = (long)(i + i0) * G + c; int half = 0;
        if (ht) { const int full = nwg / G, rem = nwg % G;
          if (rem > 0 && 2 * rem <= G && i + i0 == full) { if (c >= 2 * rem) return false; L = (long)full * G + (c >> 1); half = 1 + (c & 1); } }
        if (L >= nwg) return false;
        u.half = half;
        const int nig = WGM * nN, gid = (int)L / nig, fm = gid * WGM, gsz = (np - fm) < WGM ? (np - fm) : WGM;
        const int pm = fm + (((int)L % nig) % gsz), pn = ((int)L % nig) / gsz;
        int e = 0;
#pragma unroll
        for (int k = 1; k < 8; ++k) e += (pm >= pb[k]) ? 1 : 0;
        int pbe = 0, ce = 0;
#pragma unroll
        for (int k = 0; k < 8; ++k) { pbe = (k == e) ? pb[k] : pbe; ce = (k == e) ? cnt[k] : ce; }
        u.pm = pm; u.pn = pn; u.e = e; u.lr0 = (pm - pbe) * 256 + (half == 2 ? HALF : 0); u.cnt = ce; u.koff = 0; return true;
    }
};

struct TailOrder {
    int pb[9]; int nN, G, c, nwg, p0, KC, KCH;
    __device__ __forceinline__ void init(const unsigned* counts, int N, int G_, int c_, int p0_, int KC_, int KCH_) {
        int acc = 0;
#pragma unroll
        for (int e = 0; e < 8; ++e) { pb[e] = acc; acc += ((int)counts[e] + 255) >> 8; }
        pb[8] = acc; nN = N / BM; G = G_; c = c_; p0 = p0_; KC = KC_; KCH = KCH_; nwg = acc > p0 ? (acc - p0) * nN * KC : 0;
    }
    __device__ __forceinline__ bool short_deal() const { return false; }
    __device__ __forceinline__ bool next(int i, Unit& u) const {
        const long L = (long)i * G + c; if (L >= nwg) return false;
        const int kc = (int)L % KC, t = (int)L / KC, pm = p0 + t / nN, pn = t % nN;
        int e = 0;
#pragma unroll
        for (int k = 1; k < 8; ++k) e += (pm >= pb[k]) ? 1 : 0;
        u.pm = pm; u.pn = pn; u.e = e; u.lr0 = 0; u.cnt = 0; u.koff = kc * KCH; u.half = 0; return true;
    }
};

template <class Epi, class Sched, bool GATHER, bool F8 = false, bool HT = false>
__device__ __forceinline__ void gemm_phase(LAS unsigned char* lds, const Gemm g, const Sched& S, const Epi& E, int stag = 0) {
    int tid = threadIdx.x; asm volatile("" : "+v"(tid));
    const int wid = __builtin_amdgcn_readfirstlane(tid >> 6), lane = tid & 63, wr = wid >> 2, wc = wid & 3, fr = lane & 15, fq = lane >> 4;
    const int K = g.K, nt = K / BK, LD = g.ld ? g.ld : g.K;
    unsigned voffA[2], voffB[2]; int rA[2];
#pragma unroll
    for (int i = 0; i < 2; ++i) { int R, C; stage_rc(tid * 16 + i * 8192, R, C); const int Rb = Epi::PERM ? ((R & ~31) + perm32(R & 31)) : R;
#ifndef F8_OLDLDS
        if constexpr (F8) { const int q = C >> 3; C = (2 * (q & 3) + (q >> 2)) * 8 + (C & 7); }
#endif
        voffA[i] = GATHER ? (unsigned)(C * 2) : (unsigned)(R * LD + C) * 2u; voffB[i] = (unsigned)(Rb * LD + C) * 2u; rA[i] = R; }
    const size_t kstep = (size_t)(BK * 2);
    const size_t hstep = (size_t)HALF * LD * 2;
    const size_t tstep = 2 * hstep;
    const unsigned ldsw = (unsigned)wid * 1024u;
#ifdef F8_OLDLDS
    const int aoff = F8 ? lds_byte(wr * 64 + fr, fq * 16) : lds_byte(wr * 64 + fr, fq * 8), boff = F8 ? lds_byte(wc * 32 + fr, fq * 16) : lds_byte(wc * 32 + fr, fq * 8);
    const int aof1 = F8 ? lds_byte(wr * 64 + fr, fq * 16 + 8) : aoff + 1024, bof1 = F8 ? lds_byte(wc * 32 + fr, fq * 16 + 8) : boff + 1024;
#else
    const int aoff = lds_byte(wr * 64 + fr, fq * 8), boff = lds_byte(wc * 32 + fr, fq * 8), aof1 = aoff + 1024, bof1 = boff + 1024;
#endif
#define PG8_SA(b, h) (((b) * 2 + (h)) * HTB)
#define PG8_SB(b, h) ((4 + (b) * 2 + (h)) * HTB)
#define PG8_STAGE2(bufoff, gbase, v0, v1) do { unsigned _a = (v0), _b = (v1); asm volatile("" : "+v"(_a), "+v"(_b));     \
        __builtin_amdgcn_global_load_lds((const unsigned*)((const char*)(gbase) + _a), (LAS unsigned*)(lds + (bufoff) + ldsw), 16, 0, 0); \
        __builtin_amdgcn_global_load_lds((const unsigned*)((const char*)(gbase) + _b), (LAS unsigned*)(lds + (bufoff) + ldsw + 8192), 16, 0, 0); } while (0)
#define PG8_STAGE(bufoff, gbase, voff) PG8_STAGE2(bufoff, gbase, (voff)[0], (voff)[1])
#define PG8_STAGE_A(bufoff, nx, h, kt) do { \
        if constexpr (GATHER) { const char* _p = (const char*)g.A + (size_t)(kt) * kstep; \
            if (nx) { PG8_STAGE2(bufoff, _p, nG[h][0], nG[h][1]); } else { PG8_STAGE2(bufoff, _p, cG[h][0], cG[h][1]); } } \
        else { const char* _p = ((nx) ? nA : cA) + (size_t)(h) * hstep + (size_t)(kt) * kstep; PG8_STAGE2(bufoff, _p, voffA[0], voffA[1]); } } while (0)
#define PG8_LDA(dst, b, h) do { _Pragma("unroll") for (int m = 0; m < 4; ++m) { \
        if constexpr (F8) { dst##8[m].lo = *(const LAS v4i32*)(lds + PG8_SA(b, h) + aoff + m * 2048); dst##8[m].hi = *(const LAS v4i32*)(lds + PG8_SA(b, h) + aof1 + m * 2048); } \
        else { dst[m][0] = *(const LAS bf16x8*)(lds + PG8_SA(b, h) + aoff + m * 2048); dst[m][1] = *(const LAS bf16x8*)(lds + PG8_SA(b, h) + aof1 + m * 2048); } } } while (0)
#define PG8_LDB(dst, b, h) do { _Pragma("unroll") for (int n = 0; n < 2; ++n) { \
        if constexpr (F8) { dst##8[n].lo = *(const LAS v4i32*)(lds + PG8_SB(b, h) + boff + n * 2048); dst##8[n].hi = *(const LAS v4i32*)(lds + PG8_SB(b, h) + bof1 + n * 2048); } \
        else { dst[n][0] = *(const LAS bf16x8*)(lds + PG8_SB(b, h) + boff + n * 2048); dst[n][1] = *(const LAS bf16x8*)(lds + PG8_SB(b, h) + bof1 + n * 2048); } } } while (0)
#define PG8_MMA(ai, bj, At, Bt) do { __builtin_amdgcn_s_setprio(1); _Pragma("unroll") for (int m = 0; m < 4; ++m) _Pragma("unroll") for (int n = 0; n < 2; ++n) { \
        if constexpr (F8) asm volatile("v_mfma_scale_f32_16x16x128_f8f6f4 %0, %1, %2, %0, %3, %3 op_sel_hi:[0,0,0]" : "+v"(acc[ai][bj][m][n]) : "v"(Bt##8[n]), "v"(At##8[m]), "v"(one8));   \
        else { _Pragma("unroll") for (int k = 0; k < 2; ++k) acc[ai][bj][m][n] = __builtin_amdgcn_mfma_f32_16x16x32_bf16(Bt[n][k], At[m][k], acc[ai][bj][m][n], 0, 0, 0); } } __builtin_amdgcn_s_setprio(0); } while (0)
#define PG8_WAIT_V(n) asm volatile("s_waitcnt vmcnt(" #n ")" ::: "memory")
#define PG8_WAIT_L(n) asm volatile("s_waitcnt lgkmcnt(" #n ")" ::: "memory")
#define PG8_BAR __builtin_amdgcn_s_barrier()
#define PG8_SCHED __builtin_amdgcn_sched_barrier(0)
#define PG8_GIDX(dst, u) do { _Pragma("unroll") for (int h = 0; h < 2; ++h) _Pragma("unroll") for (int i = 0; i < 2; ++i) { \
        const int _lr = (u).lr0 + h * HALF + rA[i]; const int _tok = (_lr < (u).cnt) ? g.gidx[(u).e * 16384 + _lr] : 0; dst[h][i] = (unsigned)_tok * (unsigned)(LD * 2) + voffA[i]; } } while (0)
    Unit cur, nxt; int ui = 0;
    if (!S.next(0, cur)) return;
    if (stag > 0) { const int grp = ((int)blockIdx.x >> 3) & 3;
        if (grp) { const unsigned long long t0 = __builtin_amdgcn_s_memrealtime(); while (__builtin_amdgcn_s_memrealtime() - t0 < (unsigned long long)(grp * stag)) __builtin_amdgcn_s_sleep(2); } }
#ifdef STAGGER_TICKS
    if (S.short_deal()) { const unsigned long long t0 = __builtin_amdgcn_s_memrealtime(); while (__builtin_amdgcn_s_memrealtime() - t0 < (unsigned long long)(STAGGER_TICKS)) __builtin_amdgcn_s_sleep(8); }
#endif
    f32x4 acc[2][2][4][2];
#pragma unroll
    for (int a = 0; a < 2; ++a)
#pragma unroll
        for (int b = 0; b < 2; ++b)
#pragma unroll
            for (int m = 0; m < 4; ++m)
#pragma unroll
                for (int n = 0; n < 2; ++n) acc[a][b][m][n] = (f32x4){0.f, 0.f, 0.f, 0.f};
    const int one8 = 0x7f7f7f7f;
    bf16x8 At[4][2], B0[2][2], B1[2][2]; v8i32 At8[4], B08[2], B18[2];
    unsigned cG[2][2] = {{0u, 0u}, {0u, 0u}}, nG[2][2] = {{0u, 0u}, {0u, 0u}};
    const char* cA = (const char*)g.A + (size_t)cur.pm * tstep + (size_t)cur.koff * 2 + (cur.half == 2 ? hstep : (size_t)0); const char* cB = (const char*)g.Bt + ((size_t)cur.e * g.b_estride + (size_t)cur.koff) * 2 + (size_t)cur.pn * tstep;
    const char* nA = cA;
    if constexpr (GATHER) { PG8_GIDX(cG, cur); }
    PG8_STAGE(PG8_SB(0, 0), cB, voffB); PG8_STAGE(PG8_SB(0, 1), cB + hstep, voffB); PG8_STAGE_A(PG8_SA(0, 0), false, 0, 0); PG8_STAGE_A(PG8_SA(0, 1), false, 1, 0);
    if (wr == 1) PG8_BAR;
    PG8_WAIT_V(2); PG8_BAR;
    PG8_STAGE(PG8_SB(1, 0), cB + kstep, voffB); PG8_STAGE_A(PG8_SA(1, 0), false, 0, 1); PG8_STAGE(PG8_SB(1, 1), cB + hstep + kstep, voffB);
    PG8_WAIT_V(6); PG8_BAR;
    for (;;) {
        const bool has_next = S.next(ui + 1, nxt);
        nA = has_next ? (const char*)g.A + (size_t)nxt.pm * tstep + (size_t)nxt.koff * 2 + (nxt.half == 2 ? hstep : (size_t)0) : cA;
        const char* nB = has_next ? (const char*)g.Bt + ((size_t)nxt.e * g.b_estride + (size_t)nxt.koff) * 2 + (size_t)nxt.pn * tstep : cB;
        if constexpr (GATHER) { if (has_next) { PG8_GIDX(nG, nxt); } else {
#pragma unroll
            for (int h = 0; h < 2; ++h)
#pragma unroll
                for (int i = 0; i < 2; ++i) nG[h][i] = cG[h][i]; } }
#define PG8_KLOOP(WH) _Pragma("nounroll") for (int t = 0; t < nt; t += 2) { \
            const bool last = (t == nt - 2); \
            const int kt2 = last ? 0 : t + 2, kt3 = kt2 + 1; \
            const char* b2 = last ? nB : cB + (size_t)(t + 2) * kstep; \
            const char* b3 = b2 + kstep; \
              \
            PG8_LDB(B0, 0, 0); PG8_LDB(B1, 0, 1); PG8_SCHED; PG8_LDA(At, 0, 0); PG8_STAGE_A(PG8_SA(1, 1), false, 1, t + 1); \
            PG8_WAIT_V(8); PG8_WAIT_L(0); PG8_BAR; PG8_MMA(0, 0, At, B0); PG8_MMA(0, 1, At, B1); PG8_BAR; PG8_SCHED; \
              \
            if (WH) { PG8_LDA(At, 0, 1); } PG8_STAGE(PG8_SB(0, 0), b2, voffB); PG8_STAGE(PG8_SB(0, 1), b2 + hstep, voffB); PG8_STAGE_A(PG8_SA(0, 0), last, 0, kt2); \
            PG8_WAIT_V(8); PG8_WAIT_L(0); PG8_BAR; if (WH) { PG8_MMA(1, 0, At, B0); PG8_MMA(1, 1, At, B1); } PG8_BAR; PG8_SCHED; \
              \
            PG8_LDB(B0, 1, 0); PG8_LDB(B1, 1, 1); PG8_SCHED; PG8_LDA(At, 1, 0); PG8_STAGE_A(PG8_SA(0, 1), last, 1, kt2); \
            PG8_WAIT_V(8); PG8_WAIT_L(0); PG8_BAR; PG8_MMA(0, 0, At, B0); PG8_MMA(0, 1, At, B1); PG8_BAR; PG8_SCHED; \
              \
            if (WH) { PG8_LDA(At, 1, 1); } PG8_STAGE(PG8_SB(1, 0), b3, voffB); PG8_STAGE(PG8_SB(1, 1), b3 + hstep, voffB); PG8_STAGE_A(PG8_SA(1, 0), last, 0, kt3); \
            PG8_WAIT_V(8); PG8_WAIT_L(0); PG8_BAR; if (WH) { PG8_MMA(1, 0, At, B0); PG8_MMA(1, 1, At, B1); } PG8_BAR; PG8_SCHED; \
        }
        if constexpr (HT) { if (cur.half == 0) { PG8_KLOOP(true) } else { PG8_KLOOP(false) } } else { PG8_KLOOP(true) }
#undef PG8_KLOOP
        if constexpr (F8) asm volatile("s_nop 15\n\ts_nop 15" ::: "memory");
        if (wr == 0) PG8_BAR;
        { Unit eu = cur; eu.pm = __builtin_amdgcn_readfirstlane(eu.pm); eu.pn = __builtin_amdgcn_readfirstlane(eu.pn); asm volatile("" : "+s"(eu.pm), "+s"(eu.pn));
          E(acc, eu, wr, wc, fr, fq);
#ifdef EPI2
          if constexpr (Epi::P2) { if (EPI2 == 1) E(acc, eu, wr, wc, fr, fq); else E.template run<EPI2 == 2 ? 0 : EPI2 - 1>(acc, eu, wr, wc, fr, fq); }
#endif
        }
        if (!has_next) break;
#pragma unroll
        for (int a = 0; a < 2; ++a)
#pragma unroll
            for (int b = 0; b < 2; ++b)
#pragma unroll
                for (int m = 0; m < 4; ++m)
#pragma unroll
                    for (int n = 0; n < 2; ++n) acc[a][b][m][n] = (f32x4){0.f, 0.f, 0.f, 0.f};
        cur = nxt; cA = nA; cB = nB; ++ui;
        if constexpr (GATHER) {
#pragma unroll
            for (int h = 0; h < 2; ++h)
#pragma unroll
                for (int i = 0; i < 2; ++i) cG[h][i] = nG[h][i]; }
        if (wr == 1) PG8_BAR;
    }
    PG8_WAIT_V(0);
    PG8_BAR;
#undef PG8_SA
#undef PG8_SB
#undef PG8_STAGE
#undef PG8_STAGE2
#undef PG8_STAGE_A
#undef PG8_LDA
#undef PG8_LDB
#undef PG8_MMA
#undef PG8_WAIT_V
#undef PG8_WAIT_L
#undef PG8_BAR
#undef PG8_SCHED
#undef PG8_GIDX
}
}
#ifndef P2SEL
#define P2SEL 0
#endif
namespace pg8 {
constexpr size_t WS_DUMMY = (size_t)467 << 20;
constexpr float QA_SCALE = 0.125f * 1.4426950408889634f;
constexpr float QB_SCALE = 0.125f;

struct EpiInProj {
    static constexpr bool PERM = true, IDEM = true; static constexpr bool P2 = (P2SEL == 0); static constexpr int NVM = 16;
    bf16_t* base; WT wt;
    template <int ACT>
    __device__ __forceinline__ void body(const f32x4 (&acc)[2][2][4][2], bf16_t* O, int row0, int col0, int ld, float sc) const {
#pragma unroll
        for (int ai = 0; ai < 2; ++ai)
#pragma unroll
            for (int m = 0; m < 4; ++m) { bf16_t* rowp = O + (size_t)(row0 + ai * HALF + m * 16) * ld + col0;
#pragma unroll
                for (int bj = 0; bj < 2; ++bj) { f32x4 v0 = acc[ai][bj][m][0], v1 = acc[ai][bj][m][1];
                    if (ACT == 3) { v0 = v0 * sc; v1 = v1 * sc; }
                    if (ACT == 2) { v0 = sigmoid4(v0); v1 = sigmoid4(v1); }
                    if (ACT == 1) { v0 = v0 * sigmoid4(v0); v1 = v1 * sigmoid4(v1); }
                    u32x4 w; w.x = cvt_pk_bf16(v0[0], v0[1]); w.y = cvt_pk_bf16(v0[2], v0[3]); w.z = cvt_pk_bf16(v1[0], v1[1]); w.w = cvt_pk_bf16(v1[2], v1[3]);
                    st16(wt, rowp + bj * HALF, w); } }
    }
    __device__ __forceinline__ void operator()(const f32x4 (&acc)[2][2][4][2], const Unit& u, int wr, int wc, int fr, int fq) const { run<1>(acc, u, wr, wc, fr, fq); }
    template <int ST> __device__ __forceinline__ void run(const f32x4 (&acc)[2][2][4][2], const Unit& u, int wr, int wc, int fr, int fq) const {
        const int pn = u.pn;
        size_t toff; int ld, ct; float sc = 1.f; int act = 0;
        constexpr size_t Mi = 1u << 20;
        if (pn < 2)       { toff = 16 * Mi; ld = 512; ct = pn; sc = QA_SCALE; }
        else if (pn < 4)  { toff = 24 * Mi; ld = 512; ct = pn - 2; }
        else if (pn < 6)  { toff = 32 * Mi; ld = 512; ct = pn - 4; }
        else if (pn < 7)  { toff = 0; ld = 256; ct = 0; sc = QB_SCALE; }
        else if (pn < 8)  { toff = 4 * Mi; ld = 256; ct = 0; }
        else if (pn < 10) { toff = 8 * Mi; ld = 512; ct = pn - 8; }
        else if (pn < 12) { toff = 40 * Mi; ld = 512; ct = pn - 10; act = 1; }
        else if (pn < 16) { toff = 48 * Mi; ld = 1024; ct = pn - 12; act = 2; }
        else              { toff = 64 * Mi; ld = 1024; ct = pn - 16; act = 2; }
        const int row0 = u.pm * BM + wr * 64 + fr, col0 = ct * BM + wc * 32 + 8 * fq;
        bf16_t* O = base + toff;
#ifdef EPI_PK
        if (ST == 1) {
            if (act == 2) body<2>(acc, O, row0, col0, ld, 1.f); else if (act == 1) body<1>(acc, O, row0, col0, ld, 1.f); else if (sc != 1.f) body<3>(acc, O, row0, col0, ld, sc); else body<0>(acc, O, row0, col0, ld, 1.f);
            return; }
#endif
#pragma unroll
        for (int ai = 0; ai < 2; ++ai)
#pragma unroll
            for (int m = 0; m < 4; ++m) { bf16_t* rowp = O + (size_t)(row0 + ai * HALF + m * 16) * ld + col0;
#pragma unroll
                for (int bj = 0; bj < 2; ++bj) { f32x4 v0 = acc[ai][bj][m][0] * sc, v1 = acc[ai][bj][m][1] * sc;
                    if (act) {
#pragma unroll
                        for (int j = 0; j < 4; ++j) { const float s0 = fast_sigmoid(v0[j]), s1 = fast_sigmoid(v1[j]); v0[j] = (act == 1) ? v0[j] * s0 : s0; v1[j] = (act == 1) ? v1[j] * s1 : s1; } }
                    u32x4 w; w.x = cvt_pk_bf16(v0[0], v0[1]); w.y = cvt_pk_bf16(v0[2], v0[3]); w.z = cvt_pk_bf16(v1[0], v1[1]); w.w = cvt_pk_bf16(v1[2], v1[3]);
                    if (ST == 1) st16(wt, rowp + bj * HALF, w);
                    else if (ST == 0) asm volatile("" :: "v"(w.x), "v"(w.y), "v"(w.z), "v"(w.w), "v"(rowp));
                    else { unsigned char* db = (unsigned char*)wt.base + WS_DUMMY + (size_t)blockIdx.x * 131072 + (wr * 4 + wc) * 16384; const int k = (ai * 4 + m) * 2 + bj;
                        st16(wt, db + (ST == 2 ? fr * 1024 + k * 64 + fq * 16 : k * 1024 + (fq * 16 + fr) * 16), w); } } }
    }
};

template <int MODE> struct EpiEw {
    static constexpr bool PERM = true, IDEM = (MODE != 2 && MODE != 4); static constexpr bool P2 = false; static constexpr int NVM = 16;
    bf16_t* O; const bf16_t* G; int ldc; WT wt; float sc = 1.f;
    __device__ __forceinline__ void operator()(const f32x4 (&acc)[2][2][4][2], const Unit& u, int wr, int wc, int fr, int fq) const {
        const int row0 = u.pm * BM + wr * 64 + fr, col0 = u.pn * BM + wc * 32 + 8 * fq;
#pragma unroll
        for (int ai = 0; ai < 2; ++ai)
#pragma unroll
            for (int m = 0; m < 4; ++m) { const size_t ro = (size_t)(row0 + ai * HALF + m * 16) * ldc + col0;
#pragma unroll
                for (int bj = 0; bj < 2; ++bj) { f32x4 v0 = acc[ai][bj][m][0], v1 = acc[ai][bj][m][1];
                    if (MODE == 0) { v0 = v0 * sc; v1 = v1 * sc; }
                    if (MODE == 1 || MODE == 2) { const u32x4 gw = *(const u32x4*)(G + ro + bj * HALF);
                        v0[0] *= bf_lo(gw.x); v0[1] *= bf_hi(gw.x); v0[2] *= bf_lo(gw.y); v0[3] *= bf_hi(gw.y); v1[0] *= bf_lo(gw.z); v1[1] *= bf_hi(gw.z); v1[2] *= bf_lo(gw.w); v1[3] *= bf_hi(gw.w); }
                    if (MODE == 3) {
#ifdef EPI_PK
                        v0 = sigmoid4(v0); v1 = sigmoid4(v1);
#else
#pragma unroll
                        for (int j = 0; j < 4; ++j) { v0[j] = fast_sigmoid(v0[j]); v1[j] = fast_sigmoid(v1[j]); }
#endif
                    }
                    if (MODE == 2 || MODE == 4) { const u32x4 ow = *(const u32x4*)(O + ro + bj * HALF);
                        if (MODE == 2) { v0[0] += bf_lo(ow.x); v0[1] += bf_hi(ow.x); v0[2] += bf_lo(ow.y); v0[3] += bf_hi(ow.y); v1[0] += bf_lo(ow.z); v1[1] += bf_hi(ow.z); v1[2] += bf_lo(ow.w); v1[3] += bf_hi(ow.w); }
                        else { v0[0] *= bf_lo(ow.x); v0[1] *= bf_hi(ow.x); v0[2] *= bf_lo(ow.y); v0[3] *= bf_hi(ow.y); v1[0] *= bf_lo(ow.z); v1[1] *= bf_hi(ow.z); v1[2] *= bf_lo(ow.w); v1[3] *= bf_hi(ow.w); } }
                    u32x4 w; w.x = cvt_pk_bf16(v0[0], v0[1]); w.y = cvt_pk_bf16(v0[2], v0[3]); w.z = cvt_pk_bf16(v1[0], v1[1]); w.w = cvt_pk_bf16(v1[2], v1[3]);
                    st16(wt, O + ro + bj * HALF, w); } }
    }
};

struct EpiPart {
    static constexpr bool PERM = true, IDEM = true, P2 = false; static constexpr int NVM = 16;
    bf16_t* P; int ldc, p0, KCH; size_t plane; WT wt; float sc = 1.f;
    __device__ __forceinline__ void operator()(const f32x4 (&acc)[2][2][4][2], const Unit& u, int wr, int wc, int fr, int fq) const {
        const int row0 = (u.pm - p0) * BM + wr * 64 + fr, col0 = u.pn * BM + wc * 32 + 8 * fq;
        bf16_t* O = P + (size_t)(u.koff / KCH) * plane;
#pragma unroll
        for (int ai = 0; ai < 2; ++ai)
#pragma unroll
            for (int m = 0; m < 4; ++m) { const size_t ro = (size_t)(row0 + ai * HALF + m * 16) * ldc + col0;
#pragma unroll
                for (int bj = 0; bj < 2; ++bj) { const f32x4 v0 = acc[ai][bj][m][0] * sc, v1 = acc[ai][bj][m][1] * sc;
                    u32x4 w; w.x = cvt_pk_bf16(v0[0], v0[1]); w.y = cvt_pk_bf16(v0[2], v0[3]); w.z = cvt_pk_bf16(v1[0], v1[1]); w.w = cvt_pk_bf16(v1[2], v1[3]);
                    st16(wt, O + ro + bj * HALF, w); } }
    }
};

struct EpiGateUp {
    static constexpr bool PERM = true, IDEM = true, P2 = false; static constexpr int NVM = 8;
    bf16_t* O; int ldc; WT wt; float qs;
    __device__ __forceinline__ void operator()(const f32x4 (&acc)[2][2][4][2], const Unit& u, int wr, int wc, int fr, int fq) const {
        const int row0 = u.pm * BM + (u.half == 2 ? HALF : 0) + wr * 64 + fr, col0 = u.pn * HALF + wc * 32 + 8 * fq;
#pragma unroll
        for (int ai = 0; ai < 2; ++ai) { if (ai == 1 && u.half != 0) break;
#pragma unroll
            for (int m = 0; m < 4; ++m) { bf16_t* rowp = O + (size_t)(row0 + ai * HALF + m * 16) * ldc + col0;
                f32x4 v0, v1;
#if defined(EPI_PK) && !defined(SIM_FP8) && !defined(SIM_FFN0)
                v0 = acc[ai][0][m][0] * acc[ai][1][m][0] * sigmoid4(acc[ai][0][m][0]); v1 = acc[ai][0][m][1] * acc[ai][1][m][1] * sigmoid4(acc[ai][0][m][1]);
#endif
#pragma unroll
                for (int j = 0; j < 4; ++j) {
#if defined(EPI_PK) && !defined(SIM_FP8) && !defined(SIM_FFN0)
                    break;
#endif
                    const float g0 = acc[ai][0][m][0][j], g1 = acc[ai][0][m][1][j];
                    v0[j] = g0 * fast_sigmoid(g0) * acc[ai][1][m][0][j]; v1[j] = g1 * fast_sigmoid(g1) * acc[ai][1][m][1][j];
#if defined(SIM_FP8) || defined(SIM_FFN0)
                    if (qs != 0.f) { v0[j] = q8(v0[j], qs); v1[j] = q8(v1[j], qs); }
#endif
                }
                u32x4 w; w.x = cvt_pk_bf16(v0[0], v0[1]); w.y = cvt_pk_bf16(v0[2], v0[3]); w.z = cvt_pk_bf16(v1[0], v1[1]); w.w = cvt_pk_bf16(v1[2], v1[3]);
                st16(wt, rowp, w); } }
    }
};
struct EpiGateUp8 {
    static constexpr bool PERM = true, IDEM = true, P2 = (P2SEL == 1); static constexpr int NVM = 8;
    unsigned char* O; int ldc; WT wt; float sin, sout;
    template <int ST> __device__ __forceinline__ void run(const f32x4 (&acc)[2][2][4][2], const Unit& u, int wr, int wc, int fr, int fq) const { (*this)(acc, u, wr, wc, fr, fq); }
    __device__ __forceinline__ void operator()(const f32x4 (&acc)[2][2][4][2], const Unit& u, int wr, int wc, int fr, int fq) const {
        const int row0 = u.pm * BM + (u.half == 2 ? HALF : 0) + wr * 64 + fr, col0 = u.pn * HALF + wc * 32 + 8 * fq;
#pragma unroll
        for (int ai = 0; ai < 2; ++ai) { if (ai == 1 && u.half != 0) break;
#pragma unroll
            for (int m = 0; m < 4; ++m) { unsigned char* rowp = O + (size_t)(row0 + ai * HALF + m * 16) * ldc + col0;
                f32x4 v0, v1;
#ifdef EPI_PK
                { const float ca = -1.4426950408889634f * sin, cs = sin * sin * sout;
                  const f32x4 g0 = acc[ai][0][m][0], g1 = acc[ai][0][m][1];
                  v0 = (g0 * acc[ai][1][m][0]) * cs * cat2(rcp_1p_exp2(lo2(g0) * (f32x2){ca, ca}), rcp_1p_exp2(hi2(g0) * (f32x2){ca, ca}));
                  v1 = (g1 * acc[ai][1][m][1]) * cs * cat2(rcp_1p_exp2(lo2(g1) * (f32x2){ca, ca}), rcp_1p_exp2(hi2(g1) * (f32x2){ca, ca})); }
#else
#pragma unroll
                for (int j = 0; j < 4; ++j) { const float g0 = acc[ai][0][m][0][j] * sin, g1 = acc[ai][0][m][1][j] * sin;
                    v0[j] = g0 * fast_sigmoid(g0) * (acc[ai][1][m][0][j] * (sin * sout)); v1[j] = g1 * fast_sigmoid(g1) * (acc[ai][1][m][1][j] * (sin * sout)); }
#endif
                u32x2 w; w.x = pk4_fp8(v0[0], v0[1], v0[2], v0[3]); w.y = pk4_fp8(v1[0], v1[1], v1[2], v1[3]);
                *(u32x2*)rowp = w; } }
    }
};
}
#ifndef MK_DBG
#define MK_DBG 0
#endif
#ifndef MOE_FP8
#define MOE_FP8 1
#endif
constexpr int D = 1024, NB = 8, SEQ = 2048, T = NB * SEQ, DEPTH = 2, CH = 64, NCH = SEQ / CH, NPREV = 8;
constexpr int AH = 8, BH = 4, GR = 16, DFF = 2816, NE = 8, DFE = 3584, PLE = 256, INW = 5136, INWG = 5120, RELN = 257;
constexpr float EPS = 1e-6f, LOG2E = 1.4426950408889634f;
constexpr int NWAVES = 8, NTHR = 512;
constexpr int MOE_ROWS = 34816;

constexpr size_t MiB = 1u << 20;
constexpr size_t WS_CTL = 0, CTL_ZERO_BYTES = 256 * 1024;
constexpr size_t WS_TOKINFO = 1 * MiB;
constexpr size_t WS_IDXE = 2 * MiB;
constexpr size_t WS_DEC = 3 * MiB;
constexpr size_t WS_W1 = 4 * MiB;
constexpr size_t WS_PB = 189 * MiB;
constexpr size_t WS_G = 205 * MiB;
constexpr size_t WS_HB = WS_G, WS_DST = WS_G + 32 * MiB, WS_YSLOT = WS_G;
constexpr size_t WS_BIG = 273 * MiB;
constexpr size_t WS_W0 = WS_BIG, WS_PROJ = WS_BIG + 34 * MiB, WS_MACT = WS_BIG;
constexpr size_t WS_Y = WS_PROJ;
constexpr size_t WS_QB = WS_PROJ, WS_KB = WS_PROJ + 8 * MiB, WS_VB = WS_PROJ + 16 * MiB, WS_QA = WS_PROJ + 32 * MiB, WS_KA = WS_PROJ + 48 * MiB, WS_VA = WS_PROJ + 64 * MiB;
constexpr size_t WS_SR = WS_PROJ + 80 * MiB, WS_SGA = WS_PROJ + 96 * MiB, WS_SGB = WS_PROJ + 128 * MiB;
constexpr size_t WS_MERGED = WS_KA;
constexpr size_t WS_ST = WS_KA;
constexpr size_t WS_FACT = WS_QA;
constexpr size_t WS_YA = WS_PROJ + 160 * MiB, WS_YB = WS_PROJ + 176 * MiB;
constexpr size_t WS_XB = WS_SGB;
constexpr int MOE_MAIN_PANELS = 128, MOE_MAIN_ROWS = MOE_MAIN_PANELS * 256, TAIL_KC = MOE_FP8 ? 7 : 14, TAIL_KCH = 256  , TAIL_ROWS = MOE_ROWS - MOE_MAIN_ROWS;
constexpr size_t WS_END = 511 * MiB;
static_assert(WS_FACT + (size_t)T * DFF * 2 <= WS_XB && WS_MACT + (size_t)MOE_ROWS * DFE * 2 <= WS_END && WS_YSLOT + (size_t)MOE_ROWS * D * 2 <= WS_BIG && WS_SGB + 32 * MiB <= WS_YA && WS_YB + 16 * MiB <= WS_END, "d_ws map");
constexpr size_t OFF_WIN = 0, OFF_WGD = 10 * MiB, OFF_WBA = 10 * MiB + 65536, OFF_WBB = OFF_WBA + 1 * MiB, OFF_WOUT = OFF_WBB + 1 * MiB, OFF_WPP = OFF_WOUT + 2 * MiB, OFF_WPG = OFF_WPP + MiB / 2;
constexpr size_t OFF_FFN = 17 * MiB;
constexpr size_t OFF_FDN = OFF_FFN + 11 * MiB, OFF_MDN = OFF_FFN + 8 * 14 * MiB;
constexpr size_t OFF_MDN8 = OFF_FFN + 8 * 7 * MiB;
constexpr float W8_SCALE = 64.f, ACT8_SCALE = 8.f;
constexpr size_t WS_XS = WS_W1 + OFF_MDN8 + 8 * 7 * MiB / 2;
static_assert(MOE_FP8 && WS_XS + (size_t)T * D * 2 <= WS_PB, "x stream placement needs the e4m3 weight layout");
constexpr size_t WS_PBUF = WS_W1 + OFF_FFN;
static_assert((size_t)TAIL_KC * TAIL_ROWS * D * 2 <= (MOE_FP8 ? 8 * 7 : 8 * 14) * MiB, "partial planes");
static_assert(OFF_WPG + 2 * MiB <= OFF_FFN && WS_W1 + OFF_MDN + 8 * 7 * MiB <= WS_PB && OFF_FDN + (size_t)D * DFF * 2 <= 34 * MiB, "weight map");
constexpr int CW_BAR = 4096;
constexpr int CW_CNT = 8192;
constexpr int CW_DBG = 16384;

constexpr int RING_BYTES = 131072;
constexpr int LDSCTL_OFF = RING_BYTES, MISC_OFF = LDSCTL_OFF + 320;
constexpr int XTRA_OFF = RING_BYTES + 1024;
constexpr int LDS_BYTES = 147456;

typedef GAS unsigned gu32;
#define RLX_AGENT __ATOMIC_RELAXED, __HIP_MEMORY_SCOPE_AGENT
#define LDS_WAIT() asm volatile("s_waitcnt lgkmcnt(0)" ::: "memory")
#define VM_WAIT() asm volatile("s_waitcnt vmcnt(0)" ::: "memory")

#define XB_TMO      128
#define XB_XCNT(j)  (256  + 64 * (j))
#define XB_XSUB(j)  (1280 + 64 * (j))
#define XB_XGEN(j)  (2304 + 64 * (j))
#define XB_TOP      3328
#define XB_TOPGEN   3392
#define XCD_BAR_WORDS 3456
#define XB_SPIN_CAP (1u << 18)
__device__ __forceinline__ unsigned xb_ld(unsigned* p)              { return __hip_atomic_load(p, __ATOMIC_RELAXED, __HIP_MEMORY_SCOPE_AGENT); }
__device__ __forceinline__ unsigned xb_add(unsigned* p, unsigned v) { return __hip_atomic_fetch_add(p, v, __ATOMIC_RELAXED, __HIP_MEMORY_SCOPE_AGENT); }
__device__ __forceinline__ unsigned xb_xcc_id() { return (unsigned)__builtin_amdgcn_s_getreg((3 << 11) | 20) & 0xFu; }
#define XB_SPIN(cond, bar) do { unsigned _sp = 0; while (cond) { __builtin_amdgcn_s_sleep(1); \
    if ((++_sp & 255u) == 0u) { if (xb_ld(&(bar)[XB_TMO])) break; if (_sp > XB_SPIN_CAP) { atomicAdd(&(bar)[XB_TMO], 1u); break; } } } } while (0)
struct XcdBarrier { unsigned* bar; unsigned x; volatile LAS unsigned* st; };
__device__ __forceinline__ XcdBarrier xcd_barrier_post(unsigned* bar, volatile LAS unsigned* st) {
    XcdBarrier b; b.bar = bar; b.x = xb_xcc_id(); b.st = st;
    if (threadIdx.x == 0) (void)xb_add(&bar[XB_XCNT(b.x)], 1u);
    return b;
}
__device__ __forceinline__ void xcd_barrier_complete(unsigned* bar, unsigned x, unsigned& nloc, unsigned& nx) {
    const unsigned G = gridDim.x * gridDim.y * gridDim.z;
    unsigned sum, cnt, mine, sp = 0u;
    for (;;) {
        sum = 0u; cnt = 0u; mine = 0u;
#pragma unroll
        for (unsigned j = 0; j < 16; ++j) { const unsigned c = xb_ld(&bar[XB_XCNT(j)]); sum += c; cnt += (c > 0u) ? 1u : 0u; mine = (j == x) ? c : mine; }
        if (sum == G) break;
        __builtin_amdgcn_s_sleep(1);
        if ((++sp & 255u) == 0u) { if (xb_ld(&bar[XB_TMO])) break; if (sp > XB_SPIN_CAP) { atomicAdd(&bar[XB_TMO], 1u); break; } }
    }
    nloc = mine > 0u ? mine : 1u; nx = cnt > 0u ? cnt : 1u;
}
__device__ __forceinline__ void xcd_barrier(const XcdBarrier& b) {
    asm volatile("s_waitcnt vmcnt(0)" ::: "memory");
    __syncthreads();
    if (threadIdx.x == 0) {
        unsigned* bar = b.bar;
        __builtin_amdgcn_s_waitcnt(0);
        unsigned nloc = b.st[0], nx = b.st[1];
        if (nloc == 0u) { xcd_barrier_complete(bar, b.x, nloc, nx); b.st[0] = nloc; b.st[1] = nx; }
        const unsigned old = xb_add(&bar[XB_XSUB(b.x)], 1u);
        const unsigned gen = old / nloc;
        if (old + 1u == (gen + 1u) * nloc) {
            __builtin_amdgcn_fence(__ATOMIC_RELEASE, "agent");
            asm volatile("s_waitcnt vmcnt(0)" ::: "memory");
            const unsigned og = xb_add(&bar[XB_TOP], 1u);
            const unsigned tg = og / nx;
            if (og + 1u == (tg + 1u) * nx) xb_add(&bar[XB_TOPGEN], 1u);
            else XB_SPIN(xb_ld(&bar[XB_TOPGEN]) == tg, bar);
            __builtin_amdgcn_fence(__ATOMIC_ACQUIRE, "agent");
#ifndef XB_FLAT
            xb_add(&bar[XB_XGEN(b.x)], 1u);
#endif
            asm volatile("s_waitcnt vmcnt(0)" ::: "memory");
        } else {
#ifdef XB_FLAT
            XB_SPIN(xb_ld(&bar[XB_TOPGEN]) == gen, bar);
#else
            XB_SPIN(xb_ld(&bar[XB_XGEN(b.x)]) == gen, bar);
#endif
            __builtin_amdgcn_fence(__ATOMIC_ACQUIRE, "agent");
            asm volatile("s_waitcnt vmcnt(0)" ::: "memory");
        }
    }
    __syncthreads();
}

struct Args { const float* in[24]; float* out; unsigned char* ws; int ph_lo, ph_hi, sub, pad; };
enum { I_X = 0, I_P, I_WIN, I_RELB, I_WGUP, I_BG, I_GNORM, I_WBA, I_WBB, I_WOUT, I_NMPRE, I_NMPOST, I_NFPRE, I_NFPOST, I_FG, I_FU, I_FD, I_RW, I_MG, I_MU, I_MD, I_PP, I_PG, I_PNORM };
#define FRESH(F) do { int _t = threadIdx.x; asm volatile("" : "+v"(_t)); (F).tid = _t; (F).lane = _t & 63; (F).wave = __builtin_amdgcn_readfirstlane(_t >> 6); } while (0)
struct Frame {
    LAS unsigned char* lds;
    volatile LAS unsigned* MISC;
    gu32* ctl;
    unsigned char* ws;
    int tid, lane, wave;
    int vcu, G;
    float* x;
    bf16_t* xs;
};

__device__ __forceinline__ float sumsq16(const f32x4 (&v)[4]) {
    float s = 0.f;
#pragma unroll
    for (int j = 0; j < 4; ++j) s += (v[j].x * v[j].x + v[j].y * v[j].y) + (v[j].z * v[j].z + v[j].w * v[j].w);
    return wave_sum(s);
}
__device__ __forceinline__ void ld_bf16_row(const bf16_t* row, int lane, f32x4 (&v)[4]) {
#pragma unroll
    for (int j = 0; j < 4; ++j) { const u32x2 w = ((const u32x2*)row)[lane + 64 * j]; v[j] = (f32x4){bf_lo(w.x), bf_hi(w.x), bf_lo(w.y), bf_hi(w.y)}; }
}
__device__ __forceinline__ void st_bf16_row(bf16_t* row, int lane, const f32x4 (&v)[4]) {
#pragma unroll
    for (int j = 0; j < 4; ++j) { u32x2 w; w.x = cvt_pk_bf16(v[j].x, v[j].y); w.y = cvt_pk_bf16(v[j].z, v[j].w); ((u32x2*)row)[lane + 64 * j] = w; }
}
__device__ __forceinline__ void ld_moe_row(const unsigned char* ws, int s, int lane, f32x4 (&v)[4]) {
    if (s < MOE_MAIN_ROWS) { ld_bf16_row((const bf16_t*)(ws + WS_YSLOT) + (size_t)s * D, lane, v); return; }
    const bf16_t* p = (const bf16_t*)(ws + WS_PBUF) + (size_t)(s - MOE_MAIN_ROWS) * D;
#pragma unroll
    for (int j = 0; j < 4; ++j) v[j] = (f32x4){0.f, 0.f, 0.f, 0.f};
#pragma unroll 1
    for (int k0 = 0; k0 < TAIL_KC; k0 += 7) {
        u32x2 w[7][4];
#pragma unroll
        for (int q = 0; q < 7; ++q)
#pragma unroll
            for (int j = 0; j < 4; ++j) w[q][j] = ((const u32x2*)(p + (size_t)(k0 + q) * TAIL_ROWS * D))[lane + 64 * j];
#pragma unroll
        for (int q = 0; q < 7; ++q)
#pragma unroll
            for (int j = 0; j < 4; ++j) v[j] = v[j] + (f32x4){bf_lo(w[q][j].x), bf_hi(w[q][j].x), bf_lo(w[q][j].y), bf_hi(w[q][j].y)};
    }
}
template <int SRC, int OUT, bool ROUTE>
__device__ __forceinline__ void thin_phase(Frame& F, const float* xin, const bf16_t* ysrc, const float* g_add, const float* g_out, bf16_t* obuf, const float* router_w) {
    FRESH(F);
    const int lane = F.lane;
    unsigned* tokinfo = (unsigned*)(F.ws + WS_TOKINFO);
    int* idxe = (int*)(F.ws + WS_IDXE);
    unsigned* gcnt = (unsigned*)(F.ctl + CW_CNT);
    LAS float* rwT = (LAS float*)(F.lds);
    LAS unsigned* lcnt = (LAS unsigned*)(F.lds + 32768);
    LAS unsigned* rinfo = (LAS unsigned*)(F.lds + 32768 + 64);
    if constexpr (ROUTE) {
        for (int i = F.tid; i < D * NE; i += NTHR) rwT[(i & 7) * D + (i >> 3)] = router_w[i];
        if (F.tid < 16) lcnt[F.tid] = 0u;
        __syncthreads();
    }
    int pbase[8];
    if constexpr (SRC == 2) { int acc = 0;
#pragma unroll
        for (int e = 0; e < 8; ++e) { pbase[e] = acc; acc += (((int)gcnt[e] + 255) >> 8) << 8; } }
    f32x4 ga[4], go[4];
#pragma unroll
    for (int j = 0; j < 4; ++j) { ga[j] = (SRC != 0) ? ((const f32x4*)g_add)[lane + 64 * j] : (f32x4){0.f, 0.f, 0.f, 0.f}; go[j] = (OUT == 1) ? ((const f32x4*)g_out)[lane + 64 * j] : (f32x4){0.f, 0.f, 0.f, 0.f}; }
    const int gw = F.vcu * NWAVES + F.wave, NGW = F.G * NWAVES;
    int rs = 0;
#ifdef THIN_PF
    f32x4 nxf[4]; u32x2 nxb[4], nyb[4];
#define THIN_LOAD(mm) do { const int m_ = (mm); \
        if (SRC == 0 || xin != nullptr) { _Pragma("unroll") for (int j = 0; j < 4; ++j) nxf[j] = ((const f32x4*)(xin + (size_t)m_ * D))[lane + 64 * j]; } \
        else { _Pragma("unroll") for (int j = 0; j < 4; ++j) nxb[j] = ((const u32x2*)(F.xs + (size_t)m_ * D))[lane + 64 * j]; } \
        if (SRC == 1) { _Pragma("unroll") for (int j = 0; j < 4; ++j) nyb[j] = ((const u32x2*)(ysrc + (size_t)m_ * D))[lane + 64 * j]; } } while (0)
    if (gw < T) THIN_LOAD(gw);
#endif
    for (int m = gw; m < T; m += NGW, ++rs) {
        f32x4 xv[4];
#ifdef THIN_PF
        f32x4 cxf[4]; u32x2 cxb[4], cyb[4];
#pragma unroll
        for (int j = 0; j < 4; ++j) { cxf[j] = nxf[j]; cxb[j] = nxb[j]; cyb[j] = nyb[j]; }
        if (m + NGW < T) THIN_LOAD(m + NGW);
#endif
        if constexpr (SRC == 0) {
#pragma unroll
#ifdef THIN_PF
            for (int j = 0; j < 4; ++j) xv[j] = cxf[j];
#else
            for (int j = 0; j < 4; ++j) xv[j] = ((const f32x4*)(xin + (size_t)m * D))[lane + 64 * j];
#endif
        } else {
            f32x4 yv[4];
#ifdef THIN_PF
            if constexpr (SRC == 1) {
#pragma unroll
                for (int j = 0; j < 4; ++j) yv[j] = (f32x4){bf_lo(cyb[j].x), bf_hi(cyb[j].x), bf_lo(cyb[j].y), bf_hi(cyb[j].y)}; }
#else
            if constexpr (SRC == 1) ld_bf16_row(ysrc + (size_t)m * D, lane, yv);
#endif
            else {
                const unsigned* ti = tokinfo + (size_t)m * 8;
                const int e1 = (int)ti[0], p1 = (int)ti[1], e2 = (int)ti[2], p2 = (int)ti[3]; const float w1 = __uint_as_float(ti[4]), w2 = __uint_as_float(ti[5]);
                int b1 = 0, b2 = 0;
#pragma unroll
                for (int e = 0; e < 8; ++e) { b1 = (e == e1) ? pbase[e] : b1; b2 = (e == e2) ? pbase[e] : b2; }
                f32x4 ya[4], yb[4];
                ld_moe_row(F.ws, b1 + p1, lane, ya); ld_moe_row(F.ws, b2 + p2, lane, yb);
#pragma unroll
                for (int j = 0; j < 4; ++j) yv[j] = ya[j] * w1 + yb[j] * w2;
            }
            const float rstd = __builtin_amdgcn_rsqf(sumsq16(yv) * (1.f / D) + EPS);
#ifdef THIN_PF
            if (xin) {
#pragma unroll
                for (int j = 0; j < 4; ++j) xv[j] = cxf[j] + yv[j] * rstd * ga[j];
            } else {
#pragma unroll
                for (int j = 0; j < 4; ++j) xv[j] = (f32x4){bf_lo(cxb[j].x), bf_hi(cxb[j].x), bf_lo(cxb[j].y), bf_hi(cxb[j].y)} + yv[j] * rstd * ga[j]; }
#else
            if (xin) {
#pragma unroll
                for (int j = 0; j < 4; ++j) { const f32x4 xo = ((const f32x4*)(xin + (size_t)m * D))[lane + 64 * j]; xv[j] = xo + yv[j] * rstd * ga[j]; }
            } else { f32x4 xo[4]; ld_bf16_row(F.xs + (size_t)m * D, lane, xo);
#pragma unroll
                for (int j = 0; j < 4; ++j) xv[j] = xo[j] + yv[j] * rstd * ga[j]; }
#endif
        }
#ifdef SIM_XBF16
        if constexpr (SRC != 0 && OUT != 0) {
#pragma unroll
            for (int j = 0; j < 4; ++j) { const unsigned a = cvt_pk_bf16(xv[j].x, xv[j].y), b = cvt_pk_bf16(xv[j].z, xv[j].w); xv[j] = (f32x4){bf_lo(a), bf_hi(a), bf_lo(b), bf_hi(b)}; } }
#endif
        if constexpr (SRC != 0) {
#pragma unroll
            for (int j = 0; j < 4; ++j) { if constexpr (OUT == 0) ((f32x4*)(F.x + (size_t)m * D))[lane + 64 * j] = xv[j]; }
            if constexpr (OUT != 0) st_bf16_row(F.xs + (size_t)m * D, lane, xv); }
        if constexpr (OUT == 1) {
            const float rstd = __builtin_amdgcn_rsqf(sumsq16(xv) * (1.f / D) + EPS);
            f32x4 hv[4];
#pragma unroll
            for (int j = 0; j < 4; ++j) hv[j] = xv[j] * rstd * go[j];
#ifdef SIM_FFN0
            if (!ROUTE && xin != nullptr) {
#pragma unroll
                for (int j = 0; j < 4; ++j) hv[j] = (f32x4){q8(hv[j].x, 1.f), q8(hv[j].y, 1.f), q8(hv[j].z, 1.f), q8(hv[j].w, 1.f)}; }
#endif
#if MOE_FP8
            if constexpr (ROUTE) {
#pragma unroll
                for (int j = 0; j < 4; ++j) ((unsigned*)((unsigned char*)obuf + (size_t)m * D))[lane + 64 * j] = pk4_fp8(hv[j].x, hv[j].y, hv[j].z, hv[j].w);
            } else
#elif defined(SIM_FP8)
            if constexpr (ROUTE) { f32x4 hq[4];
#pragma unroll
                for (int j = 0; j < 4; ++j) hq[j] = (f32x4){q8(hv[j].x, 1.f), q8(hv[j].y, 1.f), q8(hv[j].z, 1.f), q8(hv[j].w, 1.f)};
                st_bf16_row(obuf + (size_t)m * D, lane, hq); } else
#endif

            st_bf16_row(obuf + (size_t)m * D, lane, hv);
            if constexpr (ROUTE) {
                float lg[8];
#pragma unroll
                for (int e = 0; e < 8; ++e) { float s = 0.f;
#pragma unroll
                    for (int j = 0; j < 4; ++j) { const f32x4 w = *(const LAS f32x4*)(rwT + e * D + 4 * lane + 256 * j); s += (hv[j].x * w.x + hv[j].y * w.y) + (hv[j].z * w.z + hv[j].w * w.w); }
                    lg[e] = wave_sum(s); }
                int e1 = 0; float v1 = lg[0];
#pragma unroll
                for (int e = 1; e < 8; ++e) if (lg[e] > v1) { v1 = lg[e]; e1 = e; }
                int e2 = -1; float v2 = -3.0e38f;
#pragma unroll
                for (int e = 0; e < 8; ++e) if (e != e1 && lg[e] > v2) { v2 = lg[e]; e2 = e; }
                const float ex = __expf(v2 - v1), w1 = 1.f / (1.f + ex), w2 = ex * w1;
                if (lane == 0) {
                    const unsigned p1 = atomicAdd((unsigned*)&lcnt[e1], 1u), p2 = atomicAdd((unsigned*)&lcnt[e2], 1u);
                    LAS unsigned* ri = rinfo + (F.wave * 8 + rs) * 6;
                    ri[0] = (unsigned)e1; ri[1] = p1; ri[2] = (unsigned)e2; ri[3] = p2; ri[4] = __float_as_uint(w1); ri[5] = __float_as_uint(w2);
                }
            }
        }
    }
    if constexpr (ROUTE) {
        __syncthreads();
        if (F.tid < 8) lcnt[8 + F.tid] = __hip_atomic_fetch_add(gcnt + F.tid, lcnt[F.tid], RLX_AGENT);
        __syncthreads();
        if (lane < rs) {
            const int m = gw + lane * NGW; const LAS unsigned* ri = rinfo + (F.wave * 8 + lane) * 6;
            const unsigned e1 = ri[0], e2 = ri[2]; const unsigned p1 = ri[1] + lcnt[8 + e1], p2 = ri[3] + lcnt[8 + e2];
            unsigned* ti = tokinfo + (size_t)m * 8; ti[0] = e1; ti[1] = p1; ti[2] = e2; ti[3] = p2; ti[4] = ri[4]; ti[5] = ri[5];
            idxe[e1 * 16384 + p1] = m; idxe[e2 * 16384 + p2] = m;
        }
    }
}
#if defined(SIM_FP8) || defined(SIM_FFN0)
#define SIMQ(x, s) (((s) != 0.f) ? q8((x), (s)) : (x))
#else
#define SIMQ(x, s) (x)
#endif
struct TrItem { const float* src; int pitch; bf16_t* dst; int dstK; int ncols; float qs; int f8; };
#ifdef TR_NT
#define TR_LD(p) __builtin_nontemporal_load(p)
#else
#define TR_LD(p) (*(p))
#endif
#define TR_LOAD(t, v) do { _Pragma("unroll") for (int i = 0; i < 64; ++i) { const int kk = 2 * i + (lane >> 5); v[i] = ((lane & 31) < (t).ncols) ? TR_LD((t).src + (size_t)kk * (t).pitch + (lane & 31)) : 0.f; } } while (0)
__device__ __forceinline__ void tr_finish(const TrItem& t, float (&v)[64], LAS float* scr, int lane, bool nostore = false) {
    const int c = lane & 31;
#pragma unroll
    for (int p = 0; p < 2; ++p) {
#pragma unroll
        for (int i = 0; i < 32; ++i) { const int kk = 2 * i + (lane >> 5); scr[kk * 33 + c] = SIMQ(v[32 * p + i], t.qs); }
        LDS_WAIT(); asm volatile("" ::: "memory");
        if (t.f8) {
            const int c4 = lane & 3;
#pragma unroll
            for (int j = 0; j < 2; ++j) { const int n = (lane >> 2) + 16 * j; const LAS float* s = scr + (16 * c4) * 33 + n;
                u32x4 o; o.x = pk4_fp8(s[0 * 33] * W8_SCALE, s[1 * 33] * W8_SCALE, s[2 * 33] * W8_SCALE, s[3 * 33] * W8_SCALE); o.y = pk4_fp8(s[4 * 33] * W8_SCALE, s[5 * 33] * W8_SCALE, s[6 * 33] * W8_SCALE, s[7 * 33] * W8_SCALE);
                o.z = pk4_fp8(s[8 * 33] * W8_SCALE, s[9 * 33] * W8_SCALE, s[10 * 33] * W8_SCALE, s[11 * 33] * W8_SCALE); o.w = pk4_fp8(s[12 * 33] * W8_SCALE, s[13 * 33] * W8_SCALE, s[14 * 33] * W8_SCALE, s[15 * 33] * W8_SCALE);
                if (!nostore) *(u32x4*)((unsigned char*)t.dst + (size_t)n * t.dstK + 64 * p + 16 * c4) = o; }
        } else {
            const int c8 = lane & 7;
#pragma unroll
            for (int j = 0; j < 4; ++j) { const int n = (lane >> 3) + 8 * j; const LAS float* s = scr + (8 * c8) * 33 + n;
                u32x4 o; o.x = cvt_pk_bf16(s[0 * 33], s[1 * 33]); o.y = cvt_pk_bf16(s[2 * 33], s[3 * 33]); o.z = cvt_pk_bf16(s[4 * 33], s[5 * 33]); o.w = cvt_pk_bf16(s[6 * 33], s[7 * 33]);
                if (n < t.ncols && !nostore) *(u32x4*)(t.dst + (size_t)n * t.dstK + 64 * p + 8 * c8) = o; }
        }
        LDS_WAIT(); asm volatile("" ::: "memory");
    }
}
constexpr int IT_COMMON = 640 + 640 + 8 + 128 + 128 + 256 + 64 + 256;
constexpr int IT_FFN = 3 * 704, IT_MOE1 = 8 * 896;
constexpr int IT_TOTAL = 2 * IT_COMMON + IT_FFN + 3 * IT_MOE1;
__device__ __forceinline__ TrItem seg_plain(const float* src, int K, int N, int pitch, bf16_t* dst, int r) {
#ifdef TR_NFAST
    const int nnb = N / 32, kb = r / nnb, nb = r % nnb;
#else
    const int nkb = K / 128, nb = r / nkb, kb = r % nkb;
#endif
    return TrItem{src + (size_t)kb * 128 * pitch + nb * 32, pitch, dst + (size_t)(nb * 32) * K + kb * 128, K, 32, 0.f, 0};
}
__device__ __forceinline__ TrItem seg_gu(const float* src, int N, bf16_t* dst, int up, int r) {
#ifdef TR_NFAST
    const int kb = r / (N / 32), nb = r % (N / 32), n0 = nb * 32;
#else
    const int nb = r / (D / 128), kb = r % (D / 128), n0 = nb * 32;
#endif
    return TrItem{src + (size_t)kb * 128 * N + n0, N, dst + (size_t)((n0 >> 7) * 256 + (n0 & 127) + up * 128) * D + kb * 128, D, 32, 0.f, 0};
}
__device__ __forceinline__ TrItem decode_item(const Args& a, unsigned char* ws, int it) {
    if (it < 2 * IT_COMMON) {
        const int l = it / IT_COMMON; int r = it % IT_COMMON; unsigned char* wb = ws + (l ? WS_W1 : WS_W0);
        const float* win = a.in[I_WIN] + (size_t)l * D * INW;
        if (r < 640) return seg_plain(win, D, 2560, INW, (bf16_t*)(wb + OFF_WIN), r); r -= 640;
        if (r < 640) return seg_plain(win + 2576, D, 2560, INW, (bf16_t*)(wb + OFF_WIN) + (size_t)2560 * D, r); r -= 640;
        if (r < 8) return TrItem{win + (size_t)r * 128 * INW + 2560, INW, (bf16_t*)(wb + OFF_WGD) + r * 128, D, 16, 0.f, 0}; r -= 8;
        if (r < 128) return seg_plain(a.in[I_WBA] + (size_t)l * 512 * D, 512, D, D, (bf16_t*)(wb + OFF_WBA), r); r -= 128;
        if (r < 128) return seg_plain(a.in[I_WBB] + (size_t)l * 512 * D, 512, D, D, (bf16_t*)(wb + OFF_WBB), r); r -= 128;
        if (r < 256) return seg_plain(a.in[I_WOUT] + (size_t)l * D * D, D, D, D, (bf16_t*)(wb + OFF_WOUT), r); r -= 256;
        if (r < 64) return seg_plain(a.in[I_PP] + (size_t)l * PLE * D, PLE, D, D, (bf16_t*)(wb + OFF_WPP), r); r -= 64;
        return seg_plain(a.in[I_PG] + (size_t)l * D * D, D, D, D, (bf16_t*)(wb + OFF_WPG), r);
    }
    it -= 2 * IT_COMMON;
    if (it < IT_FFN) {
        unsigned char* wb = ws + WS_W0;
        TrItem t;
        if (it < 704) t = seg_gu(a.in[I_FG], DFF, (bf16_t*)(wb + OFF_FFN), 0, it);
        else if (it < 1408) t = seg_gu(a.in[I_FU], DFF, (bf16_t*)(wb + OFF_FFN), 1, it - 704);
        else t = seg_plain(a.in[I_FD], DFF, D, D, (bf16_t*)(wb + OFF_FDN), it - 1408);
#ifdef SIM_FFN0
        t.qs = 64.f;
#endif
        return t;
    }
    it -= IT_FFN;
    unsigned char* wb = ws + WS_W1;
    const int kind = it / IT_MOE1, r0 = it % IT_MOE1, e = r0 / 896, r = r0 % 896;
    TrItem t;
#if MOE_FP8
    {
#ifdef TR_NFAST
      const int nnb8 = (kind == 2 ? D : DFE) / 32, kb8 = r / nnb8, nb8 = r % nnb8, n0 = nb8 * 32;
#else
      const int nkb8 = (kind == 2 ? DFE : D) / 128, nb8 = r / nkb8, kb8 = r % nkb8, n0 = nb8 * 32;
#endif
      if (kind == 2) return TrItem{a.in[I_MD] + (size_t)e * DFE * D + (size_t)kb8 * 128 * D + n0, D, (bf16_t*)(wb + OFF_MDN8 + (size_t)e * D * DFE + (size_t)n0 * DFE + kb8 * 128), DFE, 32, 0.f, 1};
      const float* src = (kind == 0 ? a.in[I_MG] : a.in[I_MU]) + (size_t)e * D * DFE + (size_t)kb8 * 128 * DFE + n0;
      return TrItem{src, DFE, (bf16_t*)(wb + OFF_FFN + (size_t)e * 7168 * D + (size_t)((n0 >> 7) * 256 + (n0 & 127) + (kind == 1 ? 128 : 0)) * D + kb8 * 128), D, 32, 0.f, 1}; }
#endif
    if (kind == 0) t = seg_gu(a.in[I_MG] + (size_t)e * D * DFE, DFE, (bf16_t*)(wb + OFF_FFN) + (size_t)e * 7168 * D, 0, r);
    else if (kind == 1) t = seg_gu(a.in[I_MU] + (size_t)e * D * DFE, DFE, (bf16_t*)(wb + OFF_FFN) + (size_t)e * 7168 * D, 1, r);
    else t = seg_plain(a.in[I_MD] + (size_t)e * DFE * D, DFE, D, D, (bf16_t*)(wb + OFF_MDN) + (size_t)e * D * DFE, r);
#ifdef SIM_FP8
    t.qs = 64.f;
#endif
    return t;
}
__device__ __forceinline__ void p0_prologue(Frame& F, const Args& a, int probe = 0) {
    FRESH(F);
    LAS float* scr = (LAS float*)(F.lds + F.wave * 16384);
    const int gw = F.vcu * NWAVES + F.wave, NGW = F.G * NWAVES;
    { const int lane = F.lane;
      for (int it = gw; it < IT_TOTAL; it += NGW) { const TrItem t = decode_item(a, F.ws, it); float v[64]; TR_LOAD(t, v); tr_finish(t, v, scr, lane, probe == 1); } }
    if (probe) return;
    { const f32x4* ps = (const f32x4*)a.in[I_P]; u32x4* pd = (u32x4*)(F.ws + WS_PB); const int n8 = 2 * T * PLE / 8;
#ifdef PCV_BATCH
      const int stride = F.G * NTHR;
      for (int i0 = blockIdx.x * NTHR + F.tid; i0 < n8; i0 += 8 * stride) { f32x4 v[8][2];
#pragma unroll
          for (int q = 0; q < 8; ++q) { const int i = i0 + q * stride; if (i < n8) { v[q][0] = ps[2 * i]; v[q][1] = ps[2 * i + 1]; } }
#pragma unroll
          for (int q = 0; q < 8; ++q) { const int i = i0 + q * stride; if (i < n8) { u32x4 w; w.x = cvt_pk_bf16(v[q][0].x, v[q][0].y); w.y = cvt_pk_bf16(v[q][0].z, v[q][0].w); w.z = cvt_pk_bf16(v[q][1].x, v[q][1].y); w.w = cvt_pk_bf16(v[q][1].z, v[q][1].w); pd[i] = w; } } }
#else
      for (int i = blockIdx.x * NTHR + F.tid; i < n8; i += F.G * NTHR) { const f32x4 v0 = ps[2 * i], v1 = ps[2 * i + 1];
          u32x4 w; w.x = cvt_pk_bf16(v0.x, v0.y); w.y = cvt_pk_bf16(v0.z, v0.w); w.z = cvt_pk_bf16(v1.x, v1.y); w.w = cvt_pk_bf16(v1.z, v1.w); pd[i] = w; }
#endif
    }
    thin_phase<0, 1, false>(F, a.in[I_X], nullptr, nullptr, a.in[I_NMPRE], (bf16_t*)(F.ws + WS_HB), nullptr);
}
typedef short v4i16_t __attribute__((ext_vector_type(4)));
__device__ __forceinline__ s16x4 lds_tr16(const LAS unsigned char* p) { return __builtin_bit_cast(s16x4, __builtin_amdgcn_ds_read_tr16_b64_v4i16((LAS v4i16_t*)p)); }
__device__ __forceinline__ bf16x8 cat8(s16x4 a, s16x4 b) { return (bf16x8){a[0], a[1], a[2], a[3], b[0], b[1], b[2], b[3]}; }

__device__ __forceinline__ void attn_unit(Frame& F, int b, int c, const float* relb) {
    FRESH(F);
    const int lane = F.lane, h = F.wave, n = lane & 15, mq = lane >> 4;
    const bf16_t* qa = (const bf16_t*)(F.ws + WS_QA); const bf16_t* ka = (const bf16_t*)(F.ws + WS_KA); const bf16_t* va = (const bf16_t*)(F.ws + WS_VA);
    LAS unsigned char* kbuf = F.lds + h * 16384; LAS unsigned char* vbuf = kbuf + 8192;
    LAS float* rt = (LAS float*)(F.lds + XTRA_OFF + h * 1056);
    for (int i = lane; i < 256; i += 64) { const int j = i - 64; rt[i] = relb[h * RELN + 256 - (j > 0 ? j : 0)] * LOG2E; }
    const float bfar = relb[h * RELN + 256] * LOG2E;
    const int tok0 = b * SEQ + c * CH;
    bf16x8 qf[4][2];
#pragma unroll
    for (int qt = 0; qt < 4; ++qt)
#pragma unroll
        for (int ks = 0; ks < 2; ++ks) qf[qt][ks] = *(const bf16x8*)(qa + (size_t)(tok0 + 16 * qt + n) * 512 + h * 64 + 32 * ks + 8 * mq);
    const int koff_e = (lane >> 3) * 512 + (((lane & 7) ^ ((lane >> 4) & 7)) * 8), koff_o = (lane >> 3) * 512 + (((lane & 7) ^ ((4 + (lane >> 4)) & 7)) * 8);
    const int voff = (lane >> 3) * 512 + ((2 * (((lane & 7) >> 1) ^ (lane >> 4)) + (lane & 1)) * 8);
#define ATT_DMA_K(j) do { const bf16_t* _s = ka + (size_t)(b * SEQ + (j) * CH) * 512 + h * 64; _Pragma("unroll") for (int _i = 0; _i < 8; ++_i) \
        __builtin_amdgcn_global_load_lds((const unsigned*)(_s + (size_t)_i * 8 * 512 + ((_i & 1) ? koff_o : koff_e)), (LAS unsigned*)(kbuf + _i * 1024), 16, 0, 0); } while (0)
#define ATT_DMA_V(j) do { const bf16_t* _s = va + (size_t)(b * SEQ + (j) * CH) * 512 + h * 64; _Pragma("unroll") for (int _i = 0; _i < 8; ++_i) \
        __builtin_amdgcn_global_load_lds((const unsigned*)(_s + (size_t)_i * 8 * 512 + voff), (LAS unsigned*)(vbuf + _i * 1024), 16, 0, 0); } while (0)
    const int ka0 = n * 128 + (((0 + mq) ^ (n >> 1)) * 16), ka1 = n * 128 + (((4 + mq) ^ (n >> 1)) * 16);
    const int qp = n >> 2, pp = lane & 3, sw = 2 * (mq & 1) + (qp >> 1);
    const int vrow = (4 * mq + qp) * 128 + 8 * pp;
    f32x4 O[4][4]; float mrun[4], lsum[4];
#pragma unroll
    for (int qt = 0; qt < 4; ++qt) { mrun[qt] = -1.0e30f; lsum[qt] = 0.f;
#pragma unroll
        for (int dt = 0; dt < 4; ++dt) O[qt][dt] = (f32x4){0.f, 0.f, 0.f, 0.f}; }
#if defined(ATT_REG) && ATT_REG == 1
    constexpr int QN = 1;
#else
    constexpr int QN = 2;
#endif
    const int j0 = (c - NPREV) > 0 ? (c - NPREV) : 0;
    ATT_DMA_K(j0); ATT_DMA_V(j0);
    for (int j = j0; j <= c; ++j) {
        const int dc = c - j;
        asm volatile("s_waitcnt vmcnt(8)" ::: "memory");
#ifdef ATT_REG
        bf16x8 kf[4][2], vfr[4][2];
#if ATT_REG == 1
#pragma unroll
        for (int kt = 0; kt < 4; ++kt) { kf[kt][0] = *(const LAS bf16x8*)(kbuf + kt * 2048 + ka0); kf[kt][1] = *(const LAS bf16x8*)(kbuf + kt * 2048 + ka1); }
        LDS_WAIT();
        if (j < c) { ATT_DMA_K(j + 1); asm volatile("s_waitcnt vmcnt(8)" ::: "memory"); } else asm volatile("s_waitcnt vmcnt(0)" ::: "memory");
#else
        asm volatile("s_waitcnt vmcnt(0)" ::: "memory");
#endif
#pragma unroll
        for (int dt = 0; dt < 4; ++dt)
#pragma unroll
            for (int u = 0; u < 2; ++u) { const LAS unsigned char* vp = vbuf + vrow + (32 * u) * 128 + ((dt ^ sw) * 32); vfr[dt][u] = cat8(lds_tr16(vp), lds_tr16(vp + 16 * 128)); }
        LDS_WAIT();
        if (j < c) { ATT_DMA_V(j + 1); }
#endif
#pragma unroll
        for (int qg = 0; qg < 4 / QN; ++qg) {
            f32x4 S[4][QN];
#pragma unroll
            for (int kt = 0; kt < 4; ++kt) {
#if defined(ATT_REG) && ATT_REG == 1
                const bf16x8 k0 = kf[kt][0], k1 = kf[kt][1];
#else
                const bf16x8 k0 = *(const LAS bf16x8*)(kbuf + kt * 2048 + ka0), k1 = *(const LAS bf16x8*)(kbuf + kt * 2048 + ka1);
#endif
#pragma unroll
                for (int q2 = 0; q2 < QN; ++q2) { f32x4 z = (f32x4){0.f, 0.f, 0.f, 0.f};
                    z = __builtin_amdgcn_mfma_f32_16x16x32_bf16(k0, qf[QN * qg + q2][0], z, 0, 0, 0);
                    S[kt][q2] = __builtin_amdgcn_mfma_f32_16x16x32_bf16(k1, qf[QN * qg + q2][1], z, 0, 0, 0); }
            }
#if !defined(ATT_REG) || ATT_REG != 1
            if (qg == 4 / QN - 1) { if (j < c) { LDS_WAIT(); ATT_DMA_K(j + 1); } }
#endif
            bf16x8 P[QN][2];
#pragma unroll
            for (int q2 = 0; q2 < QN; ++q2) { const int qt = QN * qg + q2;
                if (dc >= 3) {
                    asm volatile("" ::: "memory");
#pragma unroll
                    for (int kt = 0; kt < 4; ++kt) S[kt][q2] = S[kt][q2] + bfar;
                } else {
                    asm volatile("" ::: "memory");
                    const LAS float* rp = rt + (64 + 128 - (64 * dc + 16 * qt + n - 4 * mq));
                    float bv[4][4];
#pragma unroll
                    for (int kt = 0; kt < 4; ++kt)
#pragma unroll
                        for (int i = 0; i < 4; ++i) bv[kt][i] = rp[16 * kt + i];
#pragma unroll
                    for (int kt = 0; kt < 4; ++kt)
#pragma unroll
                        for (int i = 0; i < 4; ++i) S[kt][q2][i] += bv[kt][i];
                }
                float cm = S[0][q2][0];
#pragma unroll
                for (int kt = 0; kt < 4; ++kt)
#pragma unroll
                    for (int i = 0; i < 4; ++i) cm = fmaxf(cm, S[kt][q2][i]);
                cm = max_x16_x32(cm);
                const float mn = fmaxf(mrun[qt], cm), alpha = __builtin_amdgcn_exp2f(mrun[qt] - mn); mrun[qt] = mn;
                float ps = 0.f;
#pragma unroll
                for (int kt = 0; kt < 4; ++kt)
#pragma unroll
                    for (int i = 0; i < 4; ++i) { const float p = __builtin_amdgcn_exp2f(S[kt][q2][i] - mn); S[kt][q2][i] = p; ps += p; }
                lsum[qt] = lsum[qt] * alpha + ps;
#pragma unroll
                for (int dt = 0; dt < 4; ++dt) O[qt][dt] = O[qt][dt] * alpha;
#pragma unroll
                for (int u = 0; u < 2; ++u) { u32x4 w; w.x = cvt_pk_bf16(S[2 * u][q2][0], S[2 * u][q2][1]); w.y = cvt_pk_bf16(S[2 * u][q2][2], S[2 * u][q2][3]);
                    w.z = cvt_pk_bf16(S[2 * u + 1][q2][0], S[2 * u + 1][q2][1]); w.w = cvt_pk_bf16(S[2 * u + 1][q2][2], S[2 * u + 1][q2][3]); P[q2][u] = __builtin_bit_cast(bf16x8, w); }
            }
#ifndef ATT_REG
            if (qg == 0) asm volatile("s_waitcnt vmcnt(0)" ::: "memory");
#endif
#pragma unroll
            for (int dt = 0; dt < 4; ++dt)
#pragma unroll
                for (int u = 0; u < 2; ++u) {
#ifdef ATT_REG
                    const bf16x8 vf = vfr[dt][u];
#else
                    const LAS unsigned char* vp = vbuf + vrow + (32 * u) * 128 + ((dt ^ sw) * 32);
                    const bf16x8 vf = cat8(lds_tr16(vp), lds_tr16(vp + 16 * 128));
#endif
#pragma unroll
                    for (int q2 = 0; q2 < QN; ++q2) O[QN * qg + q2][dt] = __builtin_amdgcn_mfma_f32_16x16x32_bf16(vf, P[q2][u], O[QN * qg + q2][dt], 0, 0, 0);
                }
#ifndef ATT_REG
            if (qg == 4 / QN - 1) { if (j < c) { LDS_WAIT(); ATT_DMA_V(j + 1); } }
#endif
        }
    }
#undef ATT_DMA_K
#undef ATT_DMA_V
    bf16_t* ya = (bf16_t*)(F.ws + WS_YA);
    int ln = lane; asm volatile("" : "+v"(ln)); const int n_o = ln & 15, mq_o = ln >> 4;
#pragma unroll
    for (int qt = 0; qt < 4; ++qt) { float l = sum_x16_x32(lsum[qt]); const float rl = __builtin_amdgcn_rcpf(l);
#pragma unroll
        for (int dt = 0; dt < 4; ++dt) { const f32x4 o = O[qt][dt] * rl; u32x2 w; w.x = cvt_pk_bf16(o[0], o[1]); w.y = cvt_pk_bf16(o[2], o[3]);
            *(u32x2*)(ya + (size_t)(tok0 + 16 * qt + n_o) * 512 + h * 64 + 16 * dt + 4 * mq_o) = w; } }
}

__device__ __forceinline__ void gla_dstate_unit(Frame& F, int b, int c, const bf16_t* wgd_t, const float* wup, const float* bgate) {
    FRESH(F);
    const int lane = F.lane, w = F.wave, tid = F.tid, n = lane & 15, mq = lane >> 4;
    const int tok0 = b * SEQ + c * CH;
    const bf16_t* hb = (const bf16_t*)(F.ws + WS_HB); const bf16_t* kb = (const bf16_t*)(F.ws + WS_KB); const bf16_t* vb = (const bf16_t*)(F.ws + WS_VB);
    LAS float* GD8 = (LAS float*)(F.lds); LAS unsigned char* VB = F.lds + 32768; LAS unsigned char* KD = F.lds + 98304;
    LAS float* GDF = (LAS float*)(F.lds + XTRA_OFF); LAS float* TOT = (LAS float*)(F.lds + XTRA_OFF + 4096);
    __syncthreads();
    const int col = tid & 255, hf = tid >> 8;
    float wu[16];
#pragma unroll
    for (int r = 0; r < 16; ++r) wu[r] = wup[r * 256 + col];
    const float bb = bgate[col];
    unsigned short kraw[32];
#pragma unroll
    for (int l = 0; l < 32; ++l) kraw[l] = kb[(size_t)(tok0 + 32 * hf + l) * 256 + col];
#pragma unroll
    for (int i = 0; i < 8; ++i) { const int p = (w * 8 + i) * 64 + lane, row = p >> 6, ch = p & 63;
        __builtin_amdgcn_global_load_lds((const unsigned*)(vb + (size_t)(tok0 + row) * 512 + ch * 8), (LAS unsigned*)(VB + (w * 8 + i) * 1024), 16, 0, 0); }
    { bf16x8 af[4][4], bf[4];
#pragma unroll
      for (int ks = 0; ks < 4; ++ks) { bf[ks] = *(const bf16x8*)(wgd_t + (size_t)n * D + 128 * w + 32 * ks + 8 * mq);
#pragma unroll
          for (int mt = 0; mt < 4; ++mt) af[mt][ks] = *(const bf16x8*)(hb + (size_t)(tok0 + 16 * mt + n) * D + 128 * w + 32 * ks + 8 * mq); }
#pragma unroll
      for (int mt = 0; mt < 4; ++mt) { f32x4 acc = (f32x4){0.f, 0.f, 0.f, 0.f};
#pragma unroll
          for (int ks = 0; ks < 4; ++ks) acc = __builtin_amdgcn_mfma_f32_16x16x32_bf16(af[mt][ks], bf[ks], acc, 0, 0, 0);
#pragma unroll
          for (int i = 0; i < 4; ++i) GD8[(w * 64 + 16 * mt + 4 * mq + i) * 16 + n] = acc[i]; } }
    __syncthreads();
    { const f32x2 z2 = (f32x2){0.f, 0.f}; f32x2 sacc = z2;
#pragma unroll
      for (int q = 0; q < 8; ++q) sacc = sacc + *(const LAS f32x2*)(GD8 + q * 1024 + 2 * tid);
      *(LAS f32x2*)(GDF + 2 * tid) = sacc; }
    __syncthreads();
    { float cum[32]; float run = 0.f;
#pragma unroll
      for (int l = 0; l < 32; ++l) { const int row = 32 * hf + l; float z = bb;
#pragma unroll
          for (int r4 = 0; r4 < 4; ++r4) { const f32x4 a = *(const LAS f32x4*)(GDF + row * 16 + 4 * r4);
              z += a.x * wu[4 * r4] + a.y * wu[4 * r4 + 1] + a.z * wu[4 * r4 + 2] + a.w * wu[4 * r4 + 3]; }
          const float la = (fminf(z, 0.f) - __logf(1.f + __expf(-fabsf(z)))) * (1.f / 16.f);
          run += la; cum[l] = run; }
      LAS float* TOT1 = TOT + 256;
      if (hf == 0) TOT[col] = run;
      __syncthreads();
      const float tot = (hf == 1) ? TOT[col] : 0.f;
      if (hf == 1) TOT1[col] = run + tot;
      __syncthreads();
      const float ctot = TOT1[col];
      if (hf == 1) ((float*)(F.ws + WS_DEC))[(size_t)(b * NCH + c) * 256 + col] = __expf(ctot);
      unsigned pk[16];
#pragma unroll
      for (int l = 0; l < 32; l += 2) { const float k0 = bf2f(kraw[l]), k1 = bf2f(kraw[l + 1]);
          pk[l >> 1] = cvt_pk_bf16(k0 * __expf(ctot - (cum[l] + tot)), k1 * __expf(ctot - (cum[l + 1] + tot))); }
#pragma unroll
      for (int q = 0; q < 4; ++q) *(LAS u32x4*)(KD + col * 128 + hf * 64 + q * 16) = (u32x4){pk[4 * q], pk[4 * q + 1], pk[4 * q + 2], pk[4 * q + 3]}; }
    VM_WAIT();
    __syncthreads();
    { const int hh = w >> 1, vh = w & 1, qp = n >> 2, pp = lane & 3;
      f32x4 acc[4][4];
#pragma unroll
      for (int mt = 0; mt < 4; ++mt)
#pragma unroll
          for (int nt = 0; nt < 4; ++nt) acc[mt][nt] = (f32x4){0.f, 0.f, 0.f, 0.f};
#pragma unroll
      for (int ks = 0; ks < 2; ++ks) {
          bf16x8 af[4];
#pragma unroll
          for (int mt = 0; mt < 4; ++mt) af[mt] = *(const LAS bf16x8*)(KD + (hh * 64 + 16 * mt + n) * 128 + (32 * ks + 8 * mq) * 2);
#pragma unroll
          for (int nt = 0; nt < 4; ++nt) {
              const LAS unsigned char* vp = VB + (size_t)(32 * ks + 8 * mq + qp) * 1024 + (hh * 128 + vh * 64 + 16 * nt + 4 * pp) * 2;
              const bf16x8 bfr = cat8(lds_tr16(vp), lds_tr16(vp + 4 * 1024));
#pragma unroll
              for (int mt = 0; mt < 4; ++mt) acc[mt][nt] = __builtin_amdgcn_mfma_f32_16x16x32_bf16(af[mt], bfr, acc[mt][nt], 0, 0, 0);
          }
      }
      float* dst = (float*)(F.ws + WS_DST) + ((size_t)((b * NCH + c) * BH + hh) * 128) * 64;
#pragma unroll
      for (int mt = 0; mt < 4; ++mt)
#pragma unroll
          for (int nt = 0; nt < 4; ++nt) *(f32x4*)(dst + (size_t)(vh * 64 + 16 * nt + n) * 64 + 16 * mt + 4 * mq) = acc[mt][nt]; }
    __syncthreads();
}

__device__ __forceinline__ void gla_scan_phase(Frame& F) {
    FRESH(F);
    const float* ds = (const float*)(F.ws + WS_DST); const float* dec = (const float*)(F.ws + WS_DEC); bf16_t* st = (bf16_t*)(F.ws + WS_ST);
    for (int e2 = blockIdx.x * NTHR + F.tid; e2 < NB * BH * 128 * 32; e2 += F.G * NTHR) {
        const int k2 = e2 & 31, v = (e2 >> 5) & 127, hh = (e2 >> 12) & 3, b = e2 >> 14;
        f32x2 s = (f32x2){0.f, 0.f};
#pragma unroll 8
        for (int c = 0; c < NCH; ++c) {
            const size_t off = ((size_t)((b * NCH + c) * BH + hh) * 128 + v) * 64 + 2 * k2;
            const f32x2 d = *(const f32x2*)(ds + off); const f32x2 a = *(const f32x2*)(dec + (size_t)(b * NCH + c) * 256 + hh * 64 + 2 * k2);
            s = a * s + d;
            *(unsigned*)(st + off) = cvt_pk_bf16(s.x, s.y);
        }
    }
}

__device__ __forceinline__ void gla_out_unit(Frame& F, int b, int c, const float* gnorm) {
    FRESH(F);
    const int lane = F.lane, w = F.wave, n = lane & 15, mq = lane >> 4;
    const int hh = w >> 1, th = w & 1, tok0 = b * SEQ + c * CH + 32 * th;
    const bf16_t* qb = (const bf16_t*)(F.ws + WS_QB); const bf16_t* st = (const bf16_t*)(F.ws + WS_ST) + ((size_t)((b * NCH + c) * BH + hh) * 128) * 64;
    const bf16_t* sr = (const bf16_t*)(F.ws + WS_SR); bf16_t* yb = (bf16_t*)(F.ws + WS_YB);
    bf16x8 qf[2][2];
#pragma unroll
    for (int nt = 0; nt < 2; ++nt)
#pragma unroll
        for (int ks = 0; ks < 2; ++ks) qf[nt][ks] = *(const bf16x8*)(qb + (size_t)(tok0 + 16 * nt + n) * 256 + hh * 64 + 32 * ks + 8 * mq);
    f32x4 acc[8][2];
#pragma unroll
    for (int mt = 0; mt < 8; ++mt) {
        const bf16x8 a0 = *(const bf16x8*)(st + (size_t)(16 * mt + n) * 64 + 8 * mq), a1 = *(const bf16x8*)(st + (size_t)(16 * mt + n) * 64 + 32 + 8 * mq);
#pragma unroll
        for (int nt = 0; nt < 2; ++nt) { f32x4 z = (f32x4){0.f, 0.f, 0.f, 0.f};
            z = __builtin_amdgcn_mfma_f32_16x16x32_bf16(a0, qf[nt][0], z, 0, 0, 0);
            acc[mt][nt] = __builtin_amdgcn_mfma_f32_16x16x32_bf16(a1, qf[nt][1], z, 0, 0, 0); }
    }
#pragma unroll
    for (int nt = 0; nt < 2; ++nt) { float ss = 0.f;
#pragma unroll
        for (int mt = 0; mt < 8; ++mt) ss += (acc[mt][nt][0] * acc[mt][nt][0] + acc[mt][nt][1] * acc[mt][nt][1]) + (acc[mt][nt][2] * acc[mt][nt][2] + acc[mt][nt][3] * acc[mt][nt][3]);
        ss = sum_x16_x32(ss);
        const float rstd = __builtin_amdgcn_rsqf(ss * (1.f / 128.f) + EPS);
#pragma unroll
        for (int mt = 0; mt < 8; ++mt) { const int col = hh * 128 + 16 * mt + 4 * mq; const f32x4 gn = *(const f32x4*)(gnorm + col);
            const size_t po = (size_t)(tok0 + 16 * nt + n) * 512 + col; const u32x2 rw = *(const u32x2*)(sr + po);
            const f32x4 o = acc[mt][nt] * rstd * gn; u32x2 wv; wv.x = cvt_pk_bf16(o[0] * bf_lo(rw.x), o[1] * bf_hi(rw.x)); wv.y = cvt_pk_bf16(o[2] * bf_lo(rw.y), o[3] * bf_hi(rw.y));
            *(u32x2*)(yb + po) = wv; } }
}
#ifndef PLE_MODE1
#define PLE_MODE1 3
#endif
#ifdef SIM_FP8
constexpr float MOE_ACT_QS = 8.f;
#else
constexpr float MOE_ACT_QS = 0.f;
#endif
#ifdef SIM_FFN0
constexpr float FFN0_ACT_QS = 8.f;
#else
constexpr float FFN0_ACT_QS = 0.f;
#endif
#ifndef PRO_PROBE
#define PRO_PROBE 0
#endif
#ifndef STAG_INPROJ
#define STAG_INPROJ 0
#endif
#ifndef HALFTAIL
#define HALFTAIL 0
#endif
constexpr int N_PHASES = 25;
__global__ void __launch_bounds__(NTHR, 2) fwd(Args args) {
    extern __shared__ __attribute__((aligned(16))) unsigned char lds[];
    Frame F;
    F.lds = (LAS unsigned char*)lds;
    F.MISC = (volatile LAS unsigned*)(F.lds + MISC_OFF);
    F.tid = threadIdx.x; F.lane = F.tid & 63; F.wave = __builtin_amdgcn_readfirstlane(F.tid >> 6);
    F.G = gridDim.x; { const int bx = blockIdx.x; F.vcu = (F.G % 8 == 0) ? (bx % 8) * (F.G / 8) + bx / 8 : bx; }
    F.ws = args.ws; F.ctl = (gu32*)(args.ws + WS_CTL); F.x = args.out; F.xs = (bf16_t*)(args.ws + WS_XS);
    unsigned char* ws = args.ws;
    for (int u = F.tid; u < (LDS_BYTES - LDSCTL_OFF) / 4; u += NTHR) ((LAS unsigned*)(F.lds + LDSCTL_OFF))[u] = 0u;
    __syncthreads();
#ifdef MFMA_BENCH
    { f32x4 c0 = {0.f, 0.f, 0.f, 0.f}, c1 = c0, c2 = c0, c3 = c0; const int one = 0x7f7f7f7f;
      v8i32 a8 = {0x38383838, 0x38383838, 0x38383838, 0x38383838, 0x38383838, 0x38383838, 0x38383838, 0x38383838}, b8 = a8; bf16x8 ab = {0x3f80, 0x3f80, 0x3f80, 0x3f80, 0x3f80, 0x3f80, 0x3f80, 0x3f80}, bb = ab;
#ifdef MFMA_RAND
      { unsigned hsh = (threadIdx.x + 1u) * 2654435761u;
#pragma unroll
        for (int q = 0; q < 8; ++q) { hsh = hsh * 1664525u + 1013904223u; a8[q] = (int)(hsh & 0xbfbfbfbfu); hsh = hsh * 1664525u + 1013904223u; b8[q] = (int)(hsh & 0xbfbfbfbfu);
            hsh = hsh * 1664525u + 1013904223u; ab[q] = (short)(hsh & 0xbfff); hsh = hsh * 1664525u + 1013904223u; bb[q] = (short)(hsh & 0xbfff); } }
#endif
      asm volatile("" : "+v"(a8), "+v"(b8), "+v"(ab), "+v"(bb));
#pragma nounroll
      for (int i = 0; i < MFMA_BENCH; ++i) {
#if MFMA_KIND == 0
          asm volatile("v_mfma_scale_f32_16x16x128_f8f6f4 %0, %1, %2, %0, %3, %3 op_sel_hi:[0,0,0]" : "+v"(c0) : "v"(a8), "v"(b8), "v"(one));
          asm volatile("v_mfma_scale_f32_16x16x128_f8f6f4 %0, %1, %2, %0, %3, %3 op_sel_hi:[0,0,0]" : "+v"(c1) : "v"(a8), "v"(b8), "v"(one));
          asm volatile("v_mfma_scale_f32_16x16x128_f8f6f4 %0, %1, %2, %0, %3, %3 op_sel_hi:[0,0,0]" : "+v"(c2) : "v"(a8), "v"(b8), "v"(one));
          asm volatile("v_mfma_scale_f32_16x16x128_f8f6f4 %0, %1, %2, %0, %3, %3 op_sel_hi:[0,0,0]" : "+v"(c3) : "v"(a8), "v"(b8), "v"(one));
#else
          asm volatile("v_mfma_f32_16x16x32_bf16 %0, %1, %2, %0" : "+v"(c0) : "v"(ab), "v"(bb));
          asm volatile("v_mfma_f32_16x16x32_bf16 %0, %1, %2, %0" : "+v"(c1) : "v"(ab), "v"(bb));
          asm volatile("v_mfma_f32_16x16x32_bf16 %0, %1, %2, %0" : "+v"(c2) : "v"(ab), "v"(bb));
          asm volatile("v_mfma_f32_16x16x32_bf16 %0, %1, %2, %0" : "+v"(c3) : "v"(ab), "v"(bb));
#endif
      }
      asm volatile("s_nop 15\n\ts_nop 15" :: "v"(c0), "v"(c1), "v"(c2), "v"(c3)); }
#endif
    XcdBarrier bar = xcd_barrier_post((unsigned*)(F.ctl + CW_BAR), F.MISC + 8);
    const WT wt = make_wt(ws, (unsigned)WS_END);
    const int lo = args.ph_lo, hi = args.ph_hi;
#define PH_BEGIN const __attribute__((address_space(4))) Args* _ap = (const __attribute__((address_space(4))) Args*)__builtin_amdgcn_kernarg_segment_ptr(); asm volatile("" : "+s"(_ap)); const __attribute__((address_space(4))) Args& A = *_ap; unsigned char* ws = A.ws; \
    unsigned char* wb = ws + (l ? WS_W1 : WS_W0); bf16_t* hb = (bf16_t*)(ws + WS_HB); bf16_t* Y = (bf16_t*)(ws + WS_Y); const WT wt = make_wt(ws, (unsigned)WS_END); (void)wb; (void)hb; (void)Y; (void)wt; (void)A
#ifndef PHMASK
#define PHMASK 0x1fff
#endif
#define EN(i) (((PHMASK) >> (i)) & 1)
#ifndef REPMASK
#define REPMASK 0
#endif
#ifndef REPLAYER
#define REPLAYER 2
#endif
#define ZEROG ((const float*)(ws + WS_CTL + 131072))
#ifndef ZSKIP
#define ZSKIP 0
#endif
#define REPS(i) (((((REPMASK) >> (i)) & 1) && (REPLAYER == 2 || REPLAYER == l)) ? 2 : 1)
#define IN(k) (lo <= (k) && (k) < hi)
#ifndef SEAMREP
#define SEAMREP 1
#endif
#ifndef MK_STAMP
#define MK_STAMP 0
#endif
#ifndef STAMP_SEL
#define STAMP_SEL -1
#endif
#define SEAM(k) do { if (MK_STAMP && IN(k) && F.tid == 0) ((unsigned long long*)(ws + WS_CTL + 786432))[(k) * 256 + blockIdx.x] = __builtin_amdgcn_s_memrealtime(); \
    if (IN(k) && IN((k) + 1)) for (int _r = 0; _r < SEAMREP; ++_r) xcd_barrier(bar); } while (0)

    { const int l = 0; if (EN(12) && IN(0)) for (int rep = 0; rep < REPS(12); ++rep) { p0_prologue(F, args, rep == 0 ? 0 : PRO_PROBE); } }
    SEAM(0);
#ifndef LAYERREP
#define LAYERREP 0
#endif
    for (int l2 = 0; l2 < DEPTH + LAYERREP; ++l2) {
        const int l = (l2 < LAYERREP) ? 0 : l2 - LAYERREP; const bool zpass = (l2 < LAYERREP);
        const int pb = 1 + 12 * l;
        if (EN(0) && IN(pb + 0) && !(zpass && ((ZSKIP >> 0) & 1))) for (int rep = 0; rep < REPS(0); ++rep) { PH_BEGIN;
            pg8::Gemm g{hb, (const bf16_t*)(wb + OFF_WIN), D, 0, nullptr}; pg8::StaticOrder S; S.init(T, INWG, F.G, (int)blockIdx.x);
            pg8::EpiInProj E{(bf16_t*)(ws + WS_PROJ), wt};
            pg8::gemm_phase<pg8::EpiInProj, pg8::StaticOrder, false>(F.lds, g, S, E, STAG_INPROJ);
        }
        SEAM(pb + 0);
        if (EN(1) && IN(pb + 1) && !(zpass && ((ZSKIP >> 1) & 1))) for (int rep = 0; rep < REPS(1); ++rep) { PH_BEGIN;
            for (int u = F.vcu; u < NB * NCH; u += F.G) {
#ifndef NO_ATTN
#ifdef REP1_NO_ATTN
                if (rep == 0)
#endif
                attn_unit(F, u / NCH, u % NCH, A.in[I_RELB] + (size_t)l * AH * RELN);
#endif
#ifndef NO_GLA1
#ifdef REP1_NO_GLA
                if (rep == 0)
#endif
                gla_dstate_unit(F, u / NCH, u % NCH, (const bf16_t*)(wb + OFF_WGD), A.in[I_WGUP] + (size_t)l * GR * 256, A.in[I_BG] + (size_t)l * 256);
#endif
            }
        }
        SEAM(pb + 1);
        if (EN(2) && IN(pb + 2) && !(zpass && ((ZSKIP >> 2) & 1))) for (int rep = 0; rep < REPS(2); ++rep) { PH_BEGIN; gla_scan_phase(F); }
        SEAM(pb + 2);
        if (EN(3) && IN(pb + 3) && !(zpass && ((ZSKIP >> 3) & 1))) for (int rep = 0; rep < REPS(3); ++rep) { PH_BEGIN; for (int u = F.vcu; u < NB * NCH; u += F.G) gla_out_unit(F, u / NCH, u % NCH, A.in[I_GNORM] + (size_t)l * 512); }
        SEAM(pb + 3);
        if (EN(4) && IN(pb + 4) && !(zpass && ((ZSKIP >> 4) & 1))) for (int rep = 0; rep < REPS(4); ++rep) { PH_BEGIN;
            pg8::StaticOrder S; S.init(T, D, F.G, (int)blockIdx.x);
            { pg8::Gemm g{(const bf16_t*)(ws + WS_YA), (const bf16_t*)(wb + OFF_WBA), 512, 0, nullptr}; pg8::EpiEw<1> E{(bf16_t*)(ws + WS_MERGED), (const bf16_t*)(ws + WS_SGA), D, wt};
              pg8::gemm_phase<pg8::EpiEw<1>, pg8::StaticOrder, false>(F.lds, g, S, E); }
            { pg8::Gemm g{(const bf16_t*)(ws + WS_YB), (const bf16_t*)(wb + OFF_WBB), 512, 0, nullptr}; pg8::EpiEw<2> E{(bf16_t*)(ws + WS_MERGED), (const bf16_t*)(ws + WS_SGB), D, wt};
              pg8::gemm_phase<pg8::EpiEw<2>, pg8::StaticOrder, false>(F.lds, g, S, E); }
        }
        SEAM(pb + 4);
        if (EN(5) && IN(pb + 5) && !(zpass && ((ZSKIP >> 5) & 1))) for (int rep = 0; rep < REPS(5); ++rep) { PH_BEGIN;
            pg8::StaticOrder S; S.init(T, D, F.G, (int)blockIdx.x);
            pg8::Gemm g{(const bf16_t*)(ws + WS_MERGED), (const bf16_t*)(wb + OFF_WOUT), D, 0, nullptr}; pg8::EpiEw<0> E{Y, nullptr, D, wt};
            pg8::gemm_phase<pg8::EpiEw<0>, pg8::StaticOrder, false>(F.lds, g, S, E);
        }
        SEAM(pb + 5);
        if (EN(6) && IN(pb + 6) && !(zpass && ((ZSKIP >> 6) & 1))) for (int rep = 0; rep < ((l == 0) ? REPS(6) : 1); ++rep) { PH_BEGIN;
            if (l == 0) thin_phase<1, 1, false>(F, (LAYERREP == 0 && REPS(6) == 1) ? A.in[I_X] : nullptr, Y, (zpass || rep + 1 < REPS(6)) ? ZEROG : A.in[I_NMPOST] + (size_t)l * D, A.in[I_NFPRE] + (size_t)l * D, hb, nullptr);
            else        thin_phase<1, 1, true>(F, nullptr, Y, A.in[I_NMPOST] + (size_t)l * D, A.in[I_NFPRE] + (size_t)l * D, hb, A.in[I_RW]);
        }
        SEAM(pb + 6);
        if (EN(7) && IN(pb + 7) && !(zpass && ((ZSKIP >> 7) & 1))) for (int rep = 0; rep < REPS(7); ++rep) { PH_BEGIN;
            if (l == 0) { pg8::StaticOrder S; S.init(T, 2 * DFF, F.G, (int)blockIdx.x);
                pg8::Gemm g{hb, (const bf16_t*)(wb + OFF_FFN), D, 0, nullptr}; pg8::EpiGateUp E{(bf16_t*)(ws + WS_FACT), DFF, wt, FFN0_ACT_QS};
                S.ht = HALFTAIL; pg8::gemm_phase<pg8::EpiGateUp, pg8::StaticOrder, false, false, HALFTAIL != 0>(F.lds, g, S, E);
            } else { pg8::GroupedOrder S; S.init((const unsigned*)(F.ctl + CW_CNT), 2 * DFE, F.G, (int)blockIdx.x);
#if MOE_FP8
                pg8::Gemm g{hb, (const bf16_t*)(wb + OFF_FFN), D / 2, (size_t)2 * DFE * D / 2, (const int*)(ws + WS_IDXE), D / 2}; pg8::EpiGateUp8 E{ws + WS_MACT, DFE, wt, 1.f / W8_SCALE, ACT8_SCALE};
#ifdef SPLIT_GU
                S.i1 = SPLIT_GU; pg8::gemm_phase<pg8::EpiGateUp8, pg8::GroupedOrder, true, true>(F.lds, g, S, E);
                xcd_barrier(bar);
                S.i0 = SPLIT_GU; S.i1 = 1 << 30;
#endif
                S.ht = HALFTAIL; pg8::gemm_phase<pg8::EpiGateUp8, pg8::GroupedOrder, true, true, HALFTAIL != 0>(F.lds, g, S, E);
#else
                pg8::Gemm g{hb, (const bf16_t*)(wb + OFF_FFN), D, (size_t)2 * DFE * D, (const int*)(ws + WS_IDXE)}; pg8::EpiGateUp E{(bf16_t*)(ws + WS_MACT), DFE, wt, MOE_ACT_QS};
                pg8::gemm_phase<pg8::EpiGateUp, pg8::GroupedOrder, true>(F.lds, g, S, E);
#endif
            }
        }
        SEAM(pb + 7);
        if (EN(8) && IN(pb + 8) && !(zpass && ((ZSKIP >> 8) & 1))) for (int rep = 0; rep < REPS(8); ++rep) { PH_BEGIN;
            if (l == 0) { pg8::StaticOrder S; S.init(T, D, F.G, (int)blockIdx.x);
                pg8::Gemm g{(const bf16_t*)(ws + WS_FACT), (const bf16_t*)(wb + OFF_FDN), DFF, 0, nullptr}; pg8::EpiEw<0> E{Y, nullptr, D, wt};
                pg8::gemm_phase<pg8::EpiEw<0>, pg8::StaticOrder, false>(F.lds, g, S, E);
            } else {
#if MOE_FP8
                constexpr float dsc = 1.f / (W8_SCALE * ACT8_SCALE);
                { pg8::GroupedOrder S; S.init((const unsigned*)(F.ctl + CW_CNT), D, F.G, (int)blockIdx.x, MOE_MAIN_PANELS);
                  pg8::Gemm g{(const bf16_t*)(ws + WS_MACT), (const bf16_t*)(wb + OFF_MDN8), DFE / 2, (size_t)D * DFE / 2, nullptr}; pg8::EpiEw<0> E{(bf16_t*)(ws + WS_YSLOT), nullptr, D, wt, dsc};
                  pg8::gemm_phase<pg8::EpiEw<0>, pg8::GroupedOrder, false, true>(F.lds, g, S, E); }
                { pg8::TailOrder S; S.init((const unsigned*)(F.ctl + CW_CNT), D, F.G, (int)blockIdx.x, MOE_MAIN_PANELS, TAIL_KC, TAIL_KCH);
                  pg8::Gemm g{(const bf16_t*)(ws + WS_MACT), (const bf16_t*)(wb + OFF_MDN8), TAIL_KCH, (size_t)D * DFE / 2, nullptr, DFE / 2}; pg8::EpiPart E{(bf16_t*)(ws + WS_PBUF), D, MOE_MAIN_PANELS, TAIL_KCH, (size_t)TAIL_ROWS * D, wt, dsc};
                  pg8::gemm_phase<pg8::EpiPart, pg8::TailOrder, false, true>(F.lds, g, S, E); }
#else
                { pg8::GroupedOrder S; S.init((const unsigned*)(F.ctl + CW_CNT), D, F.G, (int)blockIdx.x, MOE_MAIN_PANELS);
                  pg8::Gemm g{(const bf16_t*)(ws + WS_MACT), (const bf16_t*)(wb + OFF_MDN), DFE, (size_t)D * DFE, nullptr}; pg8::EpiEw<0> E{(bf16_t*)(ws + WS_YSLOT), nullptr, D, wt};
                  pg8::gemm_phase<pg8::EpiEw<0>, pg8::GroupedOrder, false>(F.lds, g, S, E); }
                { pg8::TailOrder S; S.init((const unsigned*)(F.ctl + CW_CNT), D, F.G, (int)blockIdx.x, MOE_MAIN_PANELS, TAIL_KC, TAIL_KCH);
                  pg8::Gemm g{(const bf16_t*)(ws + WS_MACT), (const bf16_t*)(wb + OFF_MDN), TAIL_KCH, (size_t)D * DFE, nullptr, DFE}; pg8::EpiPart E{(bf16_t*)(ws + WS_PBUF), D, MOE_MAIN_PANELS, TAIL_KCH, (size_t)TAIL_ROWS * D, wt};
                  pg8::gemm_phase<pg8::EpiPart, pg8::TailOrder, false>(F.lds, g, S, E); }
#endif
            }
        }
        SEAM(pb + 8);
        if (EN(9) && IN(pb + 9) && !(zpass && ((ZSKIP >> 9) & 1))) for (int rep = 0; rep < REPS(9); ++rep) { PH_BEGIN;
            if (l == 0) thin_phase<1, 2, false>(F, nullptr, Y, (zpass || rep + 1 < REPS(9)) ? ZEROG : A.in[I_NFPOST] + (size_t)l * D, nullptr, nullptr, nullptr);
            else        thin_phase<2, 2, false>(F, nullptr, (const bf16_t*)(ws + WS_YSLOT), (zpass || rep + 1 < REPS(9)) ? ZEROG : A.in[I_NFPOST] + (size_t)l * D, nullptr, nullptr, nullptr);
        }
        SEAM(pb + 9);
        if (EN(10) && IN(pb + 10) && !(zpass && ((ZSKIP >> 10) & 1))) for (int rep = 0; rep < REPS(10); ++rep) { PH_BEGIN;
            pg8::StaticOrder S; S.init(T, D, F.G, (int)blockIdx.x);
            if (MK_DBG == 0 || A.sub != 2) { pg8::Gemm g{(const bf16_t*)(ws + WS_XS), (const bf16_t*)(wb + OFF_WPG), D, 0, nullptr}; pg8::EpiEw<PLE_MODE1> E{Y, nullptr, D, wt};
              pg8::gemm_phase<pg8::EpiEw<PLE_MODE1>, pg8::StaticOrder, false>(F.lds, g, S, E); }
            if (MK_DBG == 0 || A.sub != 1) { pg8::Gemm g{(const bf16_t*)(ws + WS_PB) + (size_t)l * T * PLE, (const bf16_t*)(wb + OFF_WPP), PLE, 0, nullptr}; pg8::EpiEw<4> E{Y, nullptr, D, wt};
              pg8::gemm_phase<pg8::EpiEw<4>, pg8::StaticOrder, false>(F.lds, g, S, E); }
        }
        SEAM(pb + 10);
        if (EN(11) && IN(pb + 11) && !(zpass && ((ZSKIP >> 11) & 1))) for (int rep = 0; rep < REPS(11); ++rep) { PH_BEGIN;
            if (l + 1 < DEPTH) thin_phase<1, 1, false>(F, nullptr, Y, (zpass || rep + 1 < REPS(11)) ? ZEROG : A.in[I_PNORM] + (size_t)l * D, A.in[I_NMPRE] + (size_t)(zpass ? 0 : l + 1) * D, hb, nullptr);
            else               thin_phase<1, 0, false>(F, nullptr, Y, (zpass || rep + 1 < REPS(11)) ? ZEROG : A.in[I_PNORM] + (size_t)l * D, nullptr, nullptr, nullptr);
        }
        SEAM(pb + 11);
    }
#if MK_STAMP
    {
        xcd_barrier(bar);
        const unsigned long long* st = (const unsigned long long*)(ws + WS_CTL + 786432);
        LAS float* res = (LAS float*)(F.lds);
        if (F.tid < N_PHASES) { const int k = F.tid; unsigned long long mx = 0, mxp = 0; double sum = 0.0;
            for (int g = 0; g < F.G; ++g) { const unsigned long long t = st[k * 256 + g]; mx = t > mx ? t : mx; sum += (double)t; if (k > 0) { const unsigned long long tp = st[(k - 1) * 256 + g]; mxp = tp > mxp ? tp : mxp; } }
            if (k == 0) { mxp = ~0ull; for (int g = 0; g < F.G; ++g) { const unsigned long long t = st[g]; mxp = t < mxp ? t : mxp; } mxp -= 0; }
            res[k] = (float)((double)(mx - mxp) * 0.01); res[32 + k] = (float)(((double)mx - sum / F.G) * 0.01); }
        __syncthreads();
        float t1, t2;
        if (STAMP_SEL < 0) { t1 = 0.f; t2 = 0.f; for (int k = 1; k < N_PHASES; ++k) { t1 += res[32 + k]; t2 += res[k]; } }
        else { t1 = res[STAMP_SEL]; t2 = res[32 + STAMP_SEL]; }
        const float A = 300.f * t1 + 1000.f, B = 10.f * t2 + 20.f;
        for (size_t i = (size_t)blockIdx.x * NTHR + F.tid; i < (size_t)T * D; i += (size_t)F.G * NTHR) args.out[i] = (i == 0) ? A : B;
    }
#endif
#undef IN
#undef SEAM
}
#ifndef MK_DBG
#define MK_DBG 0
#endif
#if MK_DBG
#ifndef MK_DBG_SHOW
#define MK_DBG_SHOW -1
#endif
constexpr size_t WS_SNAP = 512 * 1024;
__device__ __forceinline__ unsigned dh(unsigned x) { x ^= x >> 16; x *= 0x7feb352du; x ^= x >> 15; x *= 0x846ca68bu; x ^= x >> 16; return x; }
__device__ __forceinline__ void dbg_acc(float* dbg, int stage, float d2, float e2, int lane) { d2 = wave_sum(d2); e2 = wave_sum(e2); if (lane == 0) { atomicAdd(dbg + 2 * stage, d2); atomicAdd(dbg + 2 * stage + 1, e2); } }
__device__ __forceinline__ float ddot(const bf16_t* arow, const float* W, int K, int pitch, int col, int lane) { float s = 0.f; for (int k = lane; k < K; k += 64) s += bf2f(arow[k]) * W[(size_t)k * pitch + col]; return wave_sum(s); }
__device__ __forceinline__ float dsig(float v) { return 1.f / (1.f + expf(-v)); }
__device__ __forceinline__ int dbg_pbase(const unsigned* gcnt, int e) { int acc = 0; for (int q = 0; q < 8; ++q) if (q < e) acc += (((int)gcnt[q] + 255) >> 8) << 8; return acc; }
__device__ __forceinline__ float dbg_moe_el(const unsigned char* ws, int s, int k) { if (s < MOE_MAIN_ROWS) return bf2f(((const bf16_t*)(ws + WS_YSLOT))[(size_t)s * D + k]); float a = 0.f; for (int kc = 0; kc < TAIL_KC; ++kc) a += bf2f(((const bf16_t*)(ws + WS_PBUF))[((size_t)kc * TAIL_ROWS + (s - MOE_MAIN_ROWS)) * D + k]); return a; }
__device__ __forceinline__ float dbg_f8(const unsigned char* p, size_t i) { return __builtin_amdgcn_cvt_f32_fp8((int)p[i], 0); }
__device__ __forceinline__ float ddot8(const unsigned char* arow, float ascale, const float* W, int K, int pitch, int col, int lane) { float s = 0.f; for (int k = lane; k < K; k += 64) s += dbg_f8(arow, k) * ascale * W[(size_t)k * pitch + col]; return wave_sum(s); }
#define DBGP float* dbg = (float*)(a.ws + WS_CTL) + CW_DBG; const int lane = threadIdx.x & 63; const unsigned sid = blockIdx.x; (void)sid

__global__ void dbg_t1(Args a, int stage) { DBGP;
    const int r = dh(sid * 3 + 1) % T; const float* x = a.in[I_X] + (size_t)r * D; const bf16_t* hb = (const bf16_t*)(a.ws + WS_HB) + (size_t)r * D;
    float ss = 0.f; for (int k = lane; k < D; k += 64) ss += x[k] * x[k]; ss = wave_sum(ss); const float rstd = 1.f / sqrtf(ss / D + EPS);
    float d2 = 0.f, e2 = 0.f; for (int k = lane; k < D; k += 64) { const float e = x[k] * rstd * a.in[I_NMPRE][k], g = bf2f(hb[k]); d2 += (g - e) * (g - e); e2 += e * e; }
    dbg_acc(dbg, stage, d2, e2, lane); }

__global__ void dbg_gemm(Args a, int kind, int l, int stage) { DBGP;
    unsigned char* ws = a.ws; const unsigned h1 = dh(sid * 7 + 1), h2 = dh(sid * 7 + 2), h3 = dh(sid * 7 + 3);
    const bf16_t* hb = (const bf16_t*)(ws + WS_HB); float e = 0.f, g = 0.f;
    const unsigned* gcnt = (const unsigned*)(ws + WS_CTL) + CW_CNT;
    if (kind == 1) { const int row = h1 % T, col = h2 % INWG, sc = col < 2560 ? col : col + 16; const float v = ddot(hb + (size_t)row * D, a.in[I_WIN] + (size_t)l * D * INW, D, INW, sc, lane);
        const bf16_t* P = (const bf16_t*)(ws + WS_PROJ);
        if (col < 512) { e = v * pg8::QA_SCALE; g = bf2f(((const bf16_t*)(ws + WS_QA))[(size_t)row * 512 + col]); }
        else if (col < 1024) { e = v; g = bf2f(((const bf16_t*)(ws + WS_KA))[(size_t)row * 512 + col - 512]); }
        else if (col < 1536) { e = v; g = bf2f(((const bf16_t*)(ws + WS_VA))[(size_t)row * 512 + col - 1024]); }
        else if (col < 1792) { e = v * 0.125f; g = bf2f(((const bf16_t*)(ws + WS_QB))[(size_t)row * 256 + col - 1536]); }
        else if (col < 2048) { e = v; g = bf2f(((const bf16_t*)(ws + WS_KB))[(size_t)row * 256 + col - 1792]); }
        else if (col < 2560) { e = v; g = bf2f(((const bf16_t*)(ws + WS_VB))[(size_t)row * 512 + col - 2048]); }
        else if (col < 3072) { e = v * dsig(v); g = bf2f(((const bf16_t*)(ws + WS_SR))[(size_t)row * 512 + col - 2560]); }
        else if (col < 4096) { e = dsig(v); g = bf2f(((const bf16_t*)(ws + WS_SGA))[(size_t)row * 1024 + col - 3072]); }
        else { e = dsig(v); g = bf2f(((const bf16_t*)(ws + WS_SGB))[(size_t)row * 1024 + col - 4096]); } (void)P;
    } else if (kind == 2) { const int row = h1 % T, col = h2 % D;
        const float va = ddot((const bf16_t*)(ws + WS_YA) + (size_t)row * 512, a.in[I_WBA] + (size_t)l * 512 * D, 512, D, col, lane), vb = ddot((const bf16_t*)(ws + WS_YB) + (size_t)row * 512, a.in[I_WBB] + (size_t)l * 512 * D, 512, D, col, lane);
        e = bf2f(((const bf16_t*)(ws + WS_SGA))[(size_t)row * D + col]) * va + bf2f(((const bf16_t*)(ws + WS_SGB))[(size_t)row * D + col]) * vb; g = bf2f(((const bf16_t*)(ws + WS_MERGED))[(size_t)row * D + col]);
    } else if (kind == 3) { const int row = h1 % T, col = h2 % D; e = ddot((const bf16_t*)(ws + WS_MERGED) + (size_t)row * D, a.in[I_WOUT] + (size_t)l * D * D, D, D, col, lane); g = bf2f(((const bf16_t*)(ws + WS_Y))[(size_t)row * D + col]);
    } else if (kind == 4) { const int row = h1 % T, c = h2 % DFF; const float vg = ddot(hb + (size_t)row * D, a.in[I_FG], D, DFF, c, lane), vu = ddot(hb + (size_t)row * D, a.in[I_FU], D, DFF, c, lane);
        e = vg * dsig(vg) * vu; g = bf2f(((const bf16_t*)(ws + WS_FACT))[(size_t)row * DFF + c]);
    } else if (kind == 5) { const int row = h1 % T, col = h2 % D; e = ddot((const bf16_t*)(ws + WS_FACT) + (size_t)row * DFF, a.in[I_FD], DFF, D, col, lane); g = bf2f(((const bf16_t*)(ws + WS_Y))[(size_t)row * D + col]);
    } else if (kind == 6 || kind == 7) { const int ex = h1 % NE; const int pbase = dbg_pbase(gcnt, ex); const int cnt = (int)gcnt[ex];
        if (cnt == 0) return; const int i = h2 % cnt, tok = ((const int*)(ws + WS_IDXE))[ex * 16384 + i], row = pbase + i;
#if MOE_FP8
        const unsigned char* hb8 = ws + WS_HB; const unsigned char* act8 = ws + WS_MACT;
        if (kind == 6) { const int c = h3 % DFE; const float vg = ddot8(hb8 + (size_t)tok * D, 1.f, a.in[I_MG] + (size_t)ex * D * DFE, D, DFE, c, lane), vu = ddot8(hb8 + (size_t)tok * D, 1.f, a.in[I_MU] + (size_t)ex * D * DFE, D, DFE, c, lane);
            e = vg * dsig(vg) * vu; g = dbg_f8(act8, (size_t)row * DFE + c) * (1.f / ACT8_SCALE); }
        else { const int col = h3 % D; e = ddot8(act8 + (size_t)row * DFE, 1.f / ACT8_SCALE, a.in[I_MD] + (size_t)ex * DFE * D, DFE, D, col, lane); g = dbg_moe_el(ws, row, col); }
#else
        if (kind == 6) { const int c = h3 % DFE; const float vg = ddot(hb + (size_t)tok * D, a.in[I_MG] + (size_t)ex * D * DFE, D, DFE, c, lane), vu = ddot(hb + (size_t)tok * D, a.in[I_MU] + (size_t)ex * D * DFE, D, DFE, c, lane);
            e = vg * dsig(vg) * vu; g = bf2f(((const bf16_t*)(ws + WS_MACT))[(size_t)row * DFE + c]); }
        else { const int col = h3 % D; e = ddot((const bf16_t*)(ws + WS_MACT) + (size_t)row * DFE, a.in[I_MD] + (size_t)ex * DFE * D, DFE, D, col, lane); g = dbg_moe_el(ws, row, col); }
#endif
    } else if (kind == 12) { const int row = h1 % T, col = h2 % D; e = a.out[(size_t)row * D + col]; g = bf2f(((const bf16_t*)(ws + WS_XS))[(size_t)row * D + col]);
    } else if (kind == 13) { const int row = h1 % T, col = h2 % D; e = ddot((const bf16_t*)(ws + WS_XS) + (size_t)row * D, a.in[I_PG] + (size_t)l * D * D, D, D, col, lane); g = bf2f(((const bf16_t*)(ws + WS_Y))[(size_t)row * D + col]);
    } else if (kind == 11) { const int n = h1 % D, k = h2 % D; e = a.in[I_PG][(size_t)l * D * D + (size_t)k * D + n]; g = bf2f(((const bf16_t*)(ws + (l ? WS_W1 : WS_W0) + OFF_WPG))[(size_t)n * D + k]);
    } else if (kind == 9) { const int row = h1 % T, col = h2 % D; e = dsig(ddot((const bf16_t*)(ws + WS_XS) + (size_t)row * D, a.in[I_PG] + (size_t)l * D * D, D, D, col, lane)); g = bf2f(((const bf16_t*)(ws + WS_Y))[(size_t)row * D + col]);
    } else { const int row = h1 % T, col = h2 % D; const float vg = ddot((const bf16_t*)(ws + WS_XS) + (size_t)row * D, a.in[I_PG] + (size_t)l * D * D, D, D, col, lane), vp = ddot((const bf16_t*)(ws + WS_PB) + ((size_t)l * T + row) * PLE, a.in[I_PP] + (size_t)l * PLE * D, PLE, D, col, lane);
        e = dsig(vg) * vp; g = bf2f(((const bf16_t*)(ws + WS_Y))[(size_t)row * D + col]); }
    if (lane == 0) { atomicAdd(dbg + 2 * stage, (g - e) * (g - e)); atomicAdd(dbg + 2 * stage + 1, e * e); } }

__global__ void dbg_attn(Args a, int l, int stage) { DBGP;
    unsigned char* ws = a.ws; const unsigned h1 = dh(sid * 5 + 1); const int tok = h1 % T, h = dh(sid * 5 + 2) % AH, b = tok / SEQ, c = (tok % SEQ) / CH, ql = tok % CH;
    const bf16_t* hb = (const bf16_t*)(ws + WS_HB) + (size_t)tok * D; const float* win = a.in[I_WIN] + (size_t)l * D * INW;
    float q = 0.f; for (int k = 0; k < D; ++k) q += bf2f(hb[k]) * win[(size_t)k * INW + h * 64 + lane]; q *= pg8::QA_SCALE;
    const bf16_t* ka = (const bf16_t*)(ws + WS_KA); const bf16_t* va = (const bf16_t*)(ws + WS_VA); const float* rb = a.in[I_RELB] + ((size_t)l * AH + h) * RELN;
    float m = -1e30f, ls = 0.f, o = 0.f;
    for (int kc = (c - 8 > 0 ? c - 8 : 0); kc <= c; ++kc) for (int kl = 0; kl < CH; ++kl) { const int kt = b * SEQ + kc * CH + kl; int dist = (c - kc) * 64 + ql - kl; dist = dist > 128 ? 128 : (dist < -128 ? -128 : dist);
        const float s = wave_sum(q * bf2f(ka[(size_t)kt * 512 + h * 64 + lane])) + rb[dist + 128] * LOG2E; const float mn = fmaxf(m, s), al = exp2f(m - mn), p = exp2f(s - mn); m = mn; ls = ls * al + p; o = o * al + p * bf2f(va[(size_t)kt * 512 + h * 64 + lane]); }
    const float e = o / ls, g = bf2f(((const bf16_t*)(ws + WS_YA))[(size_t)tok * 512 + h * 64 + lane]);
    dbg_acc(dbg, stage, (g - e) * (g - e), e * e, lane); }

__global__ void dbg_dstate(Args a, int l, int stage) { DBGP;
    unsigned char* ws = a.ws; const int b = dh(sid * 5 + 1) % NB, c = dh(sid * 5 + 2) % NCH, hh = dh(sid * 5 + 3) % BH, v = dh(sid * 5 + 4) % 128, k = dh(sid * 5 + 5) % 64, col = hh * 64 + k;
    const int tok = b * SEQ + c * CH + lane; const bf16_t* hb = (const bf16_t*)(ws + WS_HB) + (size_t)tok * D; const float* win = a.in[I_WIN] + (size_t)l * D * INW;
    float z = a.in[I_BG][l * 256 + col];
    for (int r = 0; r < GR; ++r) { float gd = 0.f; for (int kk = 0; kk < D; ++kk) gd += bf2f(hb[kk]) * win[(size_t)kk * INW + 2560 + r]; z += gd * a.in[I_WGUP][((size_t)l * GR + r) * 256 + col]; }
    const float la = (fminf(z, 0.f) - log1pf(expf(-fabsf(z)))) / 16.f; float cum = la;
    for (int o = 1; o < 64; o <<= 1) { const float t = __shfl_up(cum, o); if (lane >= o) cum += t; }
    const float tot = __shfl(cum, 63);
    const float kd = bf2f(((const bf16_t*)(ws + WS_KB))[(size_t)tok * 256 + col]) * expf(tot - cum);
    const float e = wave_sum(kd * bf2f(((const bf16_t*)(ws + WS_VB))[(size_t)tok * 512 + hh * 128 + v]));
    const float g = ((const float*)(ws + WS_DST))[((size_t)((b * NCH + c) * BH + hh) * 128 + v) * 64 + k];
    const float ed = expf(tot), gdc = ((const float*)(ws + WS_DEC))[(size_t)(b * NCH + c) * 256 + col];
    if (lane == 0) { atomicAdd(dbg + 2 * stage, (g - e) * (g - e) + (gdc - ed) * (gdc - ed)); atomicAdd(dbg + 2 * stage + 1, e * e + ed * ed); } }

__global__ void dbg_scan(Args a, int stage) { DBGP;
    unsigned char* ws = a.ws; const unsigned s0 = sid * 64 + lane; const int b = dh(s0 * 5 + 1) % NB, c = dh(s0 * 5 + 2) % NCH, hh = dh(s0 * 5 + 3) % BH, v = dh(s0 * 5 + 4) % 128, k = dh(s0 * 5 + 5) % 64;
    float s = 0.f; for (int cc = 0; cc <= c; ++cc) s = ((const float*)(ws + WS_DEC))[(size_t)(b * NCH + cc) * 256 + hh * 64 + k] * s + ((const float*)(ws + WS_DST))[((size_t)((b * NCH + cc) * BH + hh) * 128 + v) * 64 + k];
    const float g = bf2f(((const bf16_t*)(ws + WS_ST))[((size_t)((b * NCH + c) * BH + hh) * 128 + v) * 64 + k]);
    dbg_acc(dbg, stage, (g - s) * (g - s), s * s, lane); }

__global__ void dbg_glaout(Args a, int l, int stage) { DBGP;
    unsigned char* ws = a.ws; const int tok = dh(sid * 3 + 1) % T, hh = dh(sid * 3 + 2) % BH, b = tok / SEQ, c = (tok % SEQ) / CH;
    const bf16_t* st = (const bf16_t*)(ws + WS_ST) + ((size_t)((b * NCH + c) * BH + hh) * 128) * 64; const bf16_t* qb = (const bf16_t*)(ws + WS_QB) + (size_t)tok * 256 + hh * 64;
    const bf16_t* hb = (const bf16_t*)(ws + WS_HB) + (size_t)tok * D; const float* win = a.in[I_WIN] + (size_t)l * D * INW;
    float o[2], r[2];
#pragma unroll
    for (int j = 0; j < 2; ++j) { const int v = lane + 64 * j; float s = 0.f; for (int k = 0; k < 64; ++k) s += bf2f(qb[k]) * bf2f(st[(size_t)v * 64 + k]); o[j] = s;
        float rr = 0.f; for (int kk = 0; kk < D; ++kk) rr += bf2f(hb[kk]) * win[(size_t)kk * INW + 2576 + hh * 128 + v]; r[j] = rr * dsig(rr); }
    const float ss = wave_sum(o[0] * o[0] + o[1] * o[1]), rstd = 1.f / sqrtf(ss / 128.f + EPS); float d2 = 0.f, e2 = 0.f;
#pragma unroll
    for (int j = 0; j < 2; ++j) { const int v = lane + 64 * j; const float e = o[j] * rstd * a.in[I_GNORM][l * 512 + hh * 128 + v] * r[j], g = bf2f(((const bf16_t*)(ws + WS_YB))[(size_t)tok * 512 + hh * 128 + v]); d2 += (g - e) * (g - e); e2 += e * e; }
    dbg_acc(dbg, stage, d2, e2, lane); }

__device__ __forceinline__ int dbg_row(unsigned i) { return (int)((i * 257u + 11u) % T); }
__global__ void dbg_snap(Args a, int from_in) { const int i = blockIdx.x, r = dbg_row(i); float* snap = (float*)(a.ws + WS_SNAP) + (size_t)i * D; const bf16_t* xs = (const bf16_t*)(a.ws + WS_XS); for (int k = threadIdx.x; k < D; k += 64) snap[k] = from_in ? a.in[I_X][(size_t)r * D + k] : bf2f(xs[(size_t)r * D + k]); }
__global__ void dbg_thin(Args a, int src, int outk, int route, const float* g_add, const float* g_out, const bf16_t* obuf, int st_x, int st_o, int st_r) { DBGP;
    unsigned char* ws = a.ws; const int i = sid, r = dbg_row(i); const float* snap = (const float*)(ws + WS_SNAP) + (size_t)i * D;
    const unsigned* gcnt = (const unsigned*)(ws + WS_CTL) + CW_CNT; const unsigned* ti = (const unsigned*)(ws + WS_TOKINFO) + (size_t)r * 8;
    float y[16], xn[16]; float ss = 0.f;
#pragma unroll
    for (int j = 0; j < 16; ++j) { const int k = lane + 64 * j; float v;
        if (src == 1) v = bf2f(((const bf16_t*)(ws + WS_Y))[(size_t)r * D + k]);
        else { v = __uint_as_float(ti[4]) * dbg_moe_el(ws, dbg_pbase(gcnt, (int)ti[0]) + (int)ti[1], k) + __uint_as_float(ti[5]) * dbg_moe_el(ws, dbg_pbase(gcnt, (int)ti[2]) + (int)ti[3], k); }
        y[j] = v; ss += v * v; }
    ss = wave_sum(ss); const float rstd = 1.f / sqrtf(ss / D + EPS); float d2 = 0.f, e2 = 0.f, s2 = 0.f;
#pragma unroll
    for (int j = 0; j < 16; ++j) { const int k = lane + 64 * j; xn[j] = snap[k] + y[j] * rstd * g_add[k]; const float g = (outk == 0) ? a.out[(size_t)r * D + k] : bf2f(((const bf16_t*)(ws + WS_XS))[(size_t)r * D + k]); d2 += (g - xn[j]) * (g - xn[j]); e2 += xn[j] * xn[j]; s2 += xn[j] * xn[j]; }
    dbg_acc(dbg, st_x, d2, e2, lane);
    if (outk != 1) return;
    s2 = wave_sum(s2); const float rs2 = 1.f / sqrtf(s2 / D + EPS); d2 = 0.f; e2 = 0.f; float hn[16];
#pragma unroll
    for (int j = 0; j < 16; ++j) { const int k = lane + 64 * j; hn[j] = (outk == 1) ? xn[j] * rs2 * g_out[k] : xn[j]; const float g = (MOE_FP8 && route) ? dbg_f8((const unsigned char*)obuf, (size_t)r * D + k) : bf2f(obuf[(size_t)r * D + k]); d2 += (g - hn[j]) * (g - hn[j]); e2 += hn[j] * hn[j]; }
    dbg_acc(dbg, st_o, d2, e2, lane);
    if (!route) return;
    float lg[8];
#pragma unroll
    for (int e = 0; e < 8; ++e) { float s = 0.f;
#pragma unroll
        for (int j = 0; j < 16; ++j) s += hn[j] * a.in[I_RW][(size_t)(lane + 64 * j) * NE + e]; lg[e] = wave_sum(s); }
    int e1 = 0; float v1 = lg[0];
#pragma unroll
    for (int e = 1; e < 8; ++e) if (lg[e] > v1) { v1 = lg[e]; e1 = e; }
    int e2i = -1; float v2 = -3.0e38f;
#pragma unroll
    for (int e = 0; e < 8; ++e) if (e != e1 && lg[e] > v2) { v2 = lg[e]; e2i = e; }
    const float ex = expf(v2 - v1), w1 = 1.f / (1.f + ex);
    float bad = 0.f; if ((int)ti[0] != e1 || (int)ti[2] != e2i) bad = 1.f; else { bad = fabsf(__uint_as_float(ti[4]) - w1) + fabsf(__uint_as_float(ti[5]) - (1.f - w1));
        const int* idxe = (const int*)(ws + WS_IDXE); if (ti[1] >= gcnt[e1] || ti[3] >= gcnt[e2i] || idxe[e1 * 16384 + ti[1]] != r || idxe[e2i * 16384 + ti[3]] != r) bad = 1.f; }
    if (lane == 0) { atomicAdd(dbg + 2 * st_r, bad * bad); atomicAdd(dbg + 2 * st_r + 1, 1.f); } }

__global__ void dbg_report(Args a) {
    const float* dbg = (const float*)(a.ws + WS_CTL) + CW_DBG; int bad = -1; float errk = 0.f;
    for (int k = 0; k < 33; ++k) { const float d2 = dbg[2 * k], e2 = dbg[2 * k + 1]; if (d2 == 0.f && e2 == 0.f) continue; const float err = d2 / e2; if (MK_DBG_SHOW == k) errk = (err == err) ? err : 1e6f; const float thr = (MOE_FP8 && (k == 25 || k == 27 || k == 28)) ? 3e-2f : 1e-3f; if (bad < 0 && !(err < thr)) bad = k; }
    float V = 0.f; bool fill = false;
    if (MK_DBG_SHOW >= 0) { V = sqrtf(7.f * 100.f * errk) + 1e-3f; fill = true; } else if (bad >= 0) { V = exp10f(1.f + 0.25f * (float)bad); fill = true; }
    if (fill) for (size_t i = (size_t)blockIdx.x * blockDim.x + threadIdx.x; i < (size_t)T * D; i += (size_t)gridDim.x * blockDim.x) a.out[i] = V; }

static void dbg_run(Args a, int grid, hipStream_t st) {
    auto ph = [&](int p) { a.ph_lo = p; a.ph_hi = p + 1; hipLaunchKernelGGL(fwd, dim3(grid), dim3(NTHR), LDS_BYTES, st, a); };
    const int NS = 2048;
    ph(0); hipLaunchKernelGGL(dbg_t1, dim3(256), dim3(64), 0, st, a, 0);
    for (int l = 0; l < DEPTH; ++l) { const int pb = 1 + 12 * l, sb = 16 * l; const size_t lo = (size_t)l * D;
        ph(pb + 0); hipLaunchKernelGGL(dbg_gemm, dim3(NS), dim3(64), 0, st, a, 1, l, sb + 1);
        ph(pb + 1); hipLaunchKernelGGL(dbg_attn, dim3(512), dim3(64), 0, st, a, l, sb + 2); hipLaunchKernelGGL(dbg_dstate, dim3(256), dim3(64), 0, st, a, l, sb + 3);
        ph(pb + 2); hipLaunchKernelGGL(dbg_scan, dim3(64), dim3(64), 0, st, a, sb + 4);
        ph(pb + 3); hipLaunchKernelGGL(dbg_glaout, dim3(256), dim3(64), 0, st, a, l, sb + 5);
        ph(pb + 4); hipLaunchKernelGGL(dbg_gemm, dim3(NS), dim3(64), 0, st, a, 2, l, sb + 6);
        ph(pb + 5); hipLaunchKernelGGL(dbg_gemm, dim3(NS), dim3(64), 0, st, a, 3, l, sb + 7);
        hipLaunchKernelGGL(dbg_snap, dim3(64), dim3(64), 0, st, a, l == 0 ? 1 : 0);
        ph(pb + 6); hipLaunchKernelGGL(dbg_thin, dim3(64), dim3(64), 0, st, a, 1, 1, l == 1 ? 1 : 0, a.in[I_NMPOST] + lo, a.in[I_NFPRE] + lo, (const bf16_t*)(a.ws + WS_HB), sb + 8, sb + 9, sb + 10);
        ph(pb + 7); hipLaunchKernelGGL(dbg_gemm, dim3(NS), dim3(64), 0, st, a, l == 0 ? 4 : 6, l, sb + 11);
        ph(pb + 8); hipLaunchKernelGGL(dbg_gemm, dim3(NS), dim3(64), 0, st, a, l == 0 ? 5 : 7, l, sb + 12);
        hipLaunchKernelGGL(dbg_snap, dim3(64), dim3(64), 0, st, a, 0);
        ph(pb + 9); hipLaunchKernelGGL(dbg_thin, dim3(64), dim3(64), 0, st, a, l == 0 ? 1 : 2, 2, 0, a.in[I_NFPOST] + lo, (const float*)nullptr, (const bf16_t*)nullptr, sb + 13, sb + 13, 0);
        a.sub = 1; ph(pb + 10); hipLaunchKernelGGL(dbg_gemm, dim3(NS), dim3(64), 0, st, a, 9, l, sb + 14);
        a.sub = 2; ph(pb + 10); a.sub = 0; hipLaunchKernelGGL(dbg_gemm, dim3(NS), dim3(64), 0, st, a, 8, l, sb + 15);
        hipLaunchKernelGGL(dbg_snap, dim3(64), dim3(64), 0, st, a, 0);
        ph(pb + 11); hipLaunchKernelGGL(dbg_thin, dim3(64), dim3(64), 0, st, a, 1, l == 0 ? 1 : 0, 0, a.in[I_PNORM] + lo, l == 0 ? a.in[I_NMPRE] + D : (const float*)nullptr, (const bf16_t*)(a.ws + WS_HB), sb + 16, sb + 16, 0);
    }
    hipLaunchKernelGGL(dbg_report, dim3(1024), dim3(256), 0, st, a);
}
#endif
#ifndef MK_SPLIT
#define MK_SPLIT 0
#endif
#ifndef MK_DBG
#define MK_DBG 0
#endif
extern "C" void kernel_launch(void* const* d_in, const int* in_sizes, int n_in, void* d_out, int out_size, void* d_ws, size_t ws_size, hipStream_t stream) {
    static int grid = 0;
    if (grid == 0) {
        if (n_in != 24 || in_sizes[0] != T * D || out_size != T * D || ws_size < WS_END) { fprintf(stderr, "kernel_launch: unexpected problem (n_in %d, in0 %d, out %d, ws %zu < %zu); nothing launched\n", n_in, n_in > 0 ? in_sizes[0] : -1, out_size, ws_size, (size_t)WS_END); grid = -1; return; }
        int dev = 0, cus = 0, per_cu = 0;
        if (hipGetDevice(&dev) != hipSuccess || hipDeviceGetAttribute(&cus, hipDeviceAttributeMultiprocessorCount, dev) != hipSuccess) { grid = -1; return; }
        if (hipFuncSetAttribute((const void*)fwd, hipFuncAttributeMaxDynamicSharedMemorySize, LDS_BYTES) != hipSuccess) { fprintf(stderr, "kernel_launch: hipFuncSetAttribute failed\n"); grid = -1; return; }
        if (hipOccupancyMaxActiveBlocksPerMultiprocessor(&per_cu, (const void*)fwd, NTHR, LDS_BYTES) != hipSuccess || per_cu < 1) { fprintf(stderr, "kernel_launch: occupancy query says %d blocks per CU\n", per_cu); }
        (void)hipGetLastError();
        grid = cus;
    }
    if (grid < 0) return;
    (void)hipMemsetAsync((char*)d_ws + WS_CTL, 0, CTL_ZERO_BYTES, stream);
    Args a{};
    for (int i = 0; i < 24; ++i) a.in[i] = (const float*)d_in[i];
    a.out = (float*)d_out; a.ws = (unsigned char*)d_ws;
#if MK_DBG
    dbg_run(a, grid, stream);
#elif MK_SPLIT
    for (int p = 0; p < N_PHASES; ++p) { a.ph_lo = p; a.ph_hi = p + 1; hipLaunchKernelGGL(fwd, dim3(grid), dim3(NTHR), LDS_BYTES, stream, a); }
#else
    a.ph_lo = 0; a.ph_hi = N_PHASES;
    hipLaunchKernelGGL(fwd, dim3(grid), dim3(NTHR), LDS_BYTES, stream, a);
#endif
}
```
